# Optimizing an MI355X kernel written in HIP

```python
import math
import jax
import jax.numpy as jnp
from jax import lax
import numpy as np

D_MODEL = 1024
BATCH = 2
SEQ = 8192
DEPTH = 2

GRID_W = 64
CTX_LEN = 256

F32 = jnp.float32
NORM_EPS = 1e-6

DN_ALPHA = (2.0 * DEPTH) ** 0.25
DN_BETA = (8.0 * DEPTH) ** -0.25

MLA_HEADS = 8
MLA_NOPE = 64
MLA_ROPE = 32
MLA_V = 64
MLA_Q_LORA = 384
MLA_KV_LORA = 256
MLA_SCALE = (MLA_NOPE + MLA_ROPE) ** -0.5
ROPE_BASE = 10000.0
Q_BLOCK = 128

S5_WIDTH = 512
S5_GROUP = 16
S5_GROUPS = S5_WIDTH // S5_GROUP
S5_STATE = 64
S5_DT_MIN = 1e-3
S5_DT_MAX = 1e-1

EVEN_IN = MLA_Q_LORA + MLA_KV_LORA + MLA_ROPE + S5_WIDTH
EVEN_MIX = MLA_HEADS * MLA_V + S5_WIDTH

HG_HEADS = 8
HG_DK = 128
HG_DV = D_MODEL // HG_HEADS
HG_WIDTH = HG_HEADS * HG_DK
HG_VWIDTH = HG_HEADS * HG_DV
HG_IN = 3 * HG_WIDTH + 2 * HG_VWIDTH
HG_CHUNK = 64

FFN_HIDDEN = 2816
CONV_WIDTH = 3

N_EVEN = (DEPTH + 1) // 2
N_ODD = DEPTH // 2

kernel_name = "hybrid_mla_s5_hgrn2_convffn_prefix_dit"


def _layer_norm(x, g, b):
    xf = x.astype(F32)
    mu = jnp.mean(xf, -1, keepdims=True)
    var = jnp.mean(jnp.square(xf - mu), -1, keepdims=True)
    y = (xf - mu) * lax.rsqrt(var + NORM_EPS)
    return (y * g.astype(F32) + b.astype(F32)).astype(x.dtype)


def _rms_norm(x, g):
    xf = x.astype(F32)
    y = xf * lax.rsqrt(jnp.mean(jnp.square(xf), -1, keepdims=True) + NORM_EPS)
    return (y * g.astype(F32)).astype(x.dtype)


def _axial_rope_tables(length):
    rows = length // GRID_W
    row = jnp.repeat(jnp.arange(rows, dtype=F32), GRID_W)
    col = jnp.tile(jnp.arange(GRID_W, dtype=F32), rows)
    n_freq = MLA_ROPE // 4
    inv = ROPE_BASE ** (-jnp.arange(n_freq, dtype=F32) / n_freq)
    ar = row[:, None] * inv
    ac = col[:, None] * inv
    ang = jnp.concatenate([ar, ar, ac, ac], axis=-1)
    return jnp.cos(ang), jnp.sin(ang)


def _rope(x, cos, sin):
    xs = x.reshape(x.shape[:-1] + (2, 2, MLA_ROPE // 4))
    rot = jnp.stack([-xs[..., 1, :], xs[..., 0, :]], axis=-2).reshape(x.shape)
    return (x * cos + rot * sin).astype(x.dtype)


def _mla_qkv(cq, ckv, kr, q_norm, w_uq, kv_norm, w_ukv, rope):
    b, l = cq.shape[:2]
    q = (_rms_norm(cq, q_norm) @ w_uq).reshape(b, l, MLA_HEADS, MLA_NOPE + MLA_ROPE)
    kv = (_rms_norm(ckv, kv_norm) @ w_ukv).reshape(b, l, MLA_HEADS, MLA_NOPE + MLA_V)
    q_nope, q_rope = q[..., :MLA_NOPE], q[..., MLA_NOPE:]
    k_nope, v = kv[..., :MLA_NOPE], kv[..., MLA_NOPE:]
    if rope is not None:
        cos, sin = rope
        q_rope = _rope(q_rope, cos[:, None], sin[:, None])
        kr = _rope(kr, cos, sin)
    q = jnp.concatenate([q_nope, q_rope], -1)
    k = jnp.concatenate([k_nope, jnp.broadcast_to(kr[:, :, None, :], (b, l, MLA_HEADS, MLA_ROPE))], -1)
    return q, k, v


def _softmax_attend(q, k, v):
    s = jnp.einsum('bqhd,bkhd->bhqk', q, k, preferred_element_type=F32) * MLA_SCALE
    p = jax.nn.softmax(s, axis=-1).astype(v.dtype)
    return jnp.einsum('bhqk,bkhd->bqhd', p, v)


def _blocked_attend(q, k, v):
    b, l, h, d = q.shape
    qb = q.reshape(b, l // Q_BLOCK, Q_BLOCK, h, d).transpose(1, 0, 2, 3, 4)
    ob = lax.map(lambda qq: _softmax_attend(qq, k, v), qb)
    return ob.transpose(1, 0, 2, 3, 4).reshape(b, l, h, v.shape[-1])


def _s5_discretize(lam_re, lam_im, log_dt, b_re, b_im):
    lam_re, lam_im = lam_re.astype(F32), lam_im.astype(F32)
    dt = jnp.exp(log_dt.astype(F32))[:, None]
    mag = jnp.exp(lam_re * dt)
    lb_re = mag * jnp.cos(lam_im * dt)
    lb_im = mag * jnp.sin(lam_im * dt)
    den = lam_re * lam_re + lam_im * lam_im
    nr = lb_re - 1.0
    fr = (nr * lam_re + lb_im * lam_im) / den
    fi = (lb_im * lam_re - nr * lam_im) / den
    b_re, b_im = b_re.astype(F32), b_im.astype(F32)
    bb_re = fr[..., None] * b_re - fi[..., None] * b_im
    bb_im = fr[..., None] * b_im + fi[..., None] * b_re
    return lb_re, lb_im, bb_re, bb_im


def _s5_combine(e1, e2):
    a1r, a1i, b1r, b1i = e1
    a2r, a2i, b2r, b2i = e2
    return (a2r * a1r - a2i * a1i,
            a2r * a1i + a2i * a1r,
            a2r * b1r - a2i * b1i + b2r,
            a2r * b1i + a2i * b1r + b2i)


def _s5_states(u, lb_re, lb_im, bb_re, bb_im, h0):
    x_re = jnp.einsum('blgp,gnp->blgn', u, bb_re)
    x_im = jnp.einsum('blgp,gnp->blgn', u, bb_im)
    if h0 is not None:
        h_re, h_im = h0
        x_re = x_re.at[:, 0].add(lb_re * h_re - lb_im * h_im)
        x_im = x_im.at[:, 0].add(lb_re * h_im + lb_im * h_re)
    a_re = jnp.broadcast_to(lb_re, x_re.shape)
    a_im = jnp.broadcast_to(lb_im, x_im.shape)
    _, _, s_re, s_im = lax.associative_scan(_s5_combine, (a_re, a_im, x_re, x_im), axis=1)
    return s_re, s_im


def _s5_bidirectional(u, disc, c_re, c_im, h0s, need_out):
    y = None
    finals = []
    for d in range(2):
        ud = u if d == 0 else jnp.flip(u, 1)
        s_re, s_im = _s5_states(ud, *disc[d], None if h0s is None else h0s[d])
        finals.append((s_re[:, -1], s_im[:, -1]))
        if need_out:
            yd = (jnp.einsum('blgn,gpn->blgp', s_re, c_re[d].astype(F32))
                  - jnp.einsum('blgn,gpn->blgp', s_im, c_im[d].astype(F32)))
            yd = yd if d == 0 else jnp.flip(yd, 1)
            y = yd if y is None else y + yd
    return y, finals


def _even_mixer(u_ctx, u_lat, w_in, q_norm, w_uq, kv_norm, w_ukv, lam_re, lam_im, log_dt,
                b_re, b_im, c_re, c_im, d_skip, w_glu, w_out, need_ctx):
    cuts = [MLA_Q_LORA, MLA_Q_LORA + MLA_KV_LORA, MLA_Q_LORA + MLA_KV_LORA + MLA_ROPE]
    cq_c, ckv_c, kr_c, s_c = jnp.split(u_ctx @ w_in, cuts, axis=-1)
    cq_l, ckv_l, kr_l, s_l = jnp.split(u_lat @ w_in, cuts, axis=-1)
    b, l = u_lat.shape[:2]
    lc = u_ctx.shape[1]
    rope = _axial_rope_tables(l)
    q_c, k_c, v_c = _mla_qkv(cq_c, ckv_c, kr_c, q_norm, w_uq, kv_norm, w_ukv, None)
    q_l, k_l, v_l = _mla_qkv(cq_l, ckv_l, kr_l, q_norm, w_uq, kv_norm, w_ukv, rope)
    k_all = jnp.concatenate([k_c, k_l], axis=1)
    v_all = jnp.concatenate([v_c, v_l], axis=1)
    att_l = _blocked_attend(q_l, k_all, v_all).reshape(b, l, MLA_HEADS * MLA_V)
    disc = [_s5_discretize(lam_re[d], lam_im[d], log_dt[d], b_re[d], b_im[d]) for d in range(2)]
    us_c = s_c.astype(F32).reshape(b, lc, S5_GROUPS, S5_GROUP)
    us_l = s_l.astype(F32).reshape(b, l, S5_GROUPS, S5_GROUP)
    ys_c, fin_c = _s5_bidirectional(us_c, disc, c_re, c_im, None, need_ctx)
    ys_l, _ = _s5_bidirectional(us_l, disc, c_re, c_im, fin_c, True)
    d_g = d_skip.astype(F32).reshape(S5_GROUPS, S5_GROUP)

    def s5_out(y, us):
        z = (y + d_g * us).reshape(us.shape[0], us.shape[1], S5_WIDTH)
        z = jax.nn.gelu(z).astype(u_lat.dtype)
        return z * jax.nn.sigmoid(z @ w_glu)

    y_lat = jnp.concatenate([att_l, s5_out(ys_l, us_l)], -1) @ w_out
    y_ctx = None
    if need_ctx:
        att_c = _softmax_attend(q_c, k_c, v_c).reshape(b, lc, MLA_HEADS * MLA_V)
        y_ctx = jnp.concatenate([att_c, s5_out(ys_c, us_c)], -1) @ w_out
    return y_ctx, y_lat


def _hgrn_chunk_scan(q, k, v, logf, s0):
    b, l, h, _ = q.shape
    nc = l // HG_CHUNK

    def to_chunks(t):
        return t.reshape(b, nc, HG_CHUNK, h, t.shape[-1]).transpose(1, 0, 3, 2, 4)

    tri = jnp.tril(jnp.ones((HG_CHUNK, HG_CHUNK), dtype=bool))[:, :, None]

    def step(state, xs):
        qc, kc, vc, gc = xs
        cum = jnp.cumsum(gc, axis=-2)
        last = cum[..., -1:, :]
        dec = jnp.exp(jnp.where(tri, cum[..., :, None, :] - cum[..., None, :, :], -jnp.inf))
        scores = jnp.einsum('bhtk,bhsk,bhtsk->bhts', qc, kc, dec)
        o = (jnp.einsum('bhts,bhsv->bhtv', scores, vc)
             + jnp.einsum('bhtk,bhkv->bhtv', qc * jnp.exp(cum), state))
        state = (jnp.exp(last)[..., 0, :, None] * state
                 + jnp.einsum('bhsk,bhsv->bhkv', kc * jnp.exp(last - cum), vc))
        return state, o

    s_fin, o = lax.scan(step, s0, (to_chunks(q), to_chunks(k), to_chunks(v), to_chunks(logf)))
    o = o.transpose(1, 0, 3, 2, 4).reshape(b, l, h, v.shape[-1])
    return o, s_fin


def _hgrn_final_state(k, v, logf):
    tail = jnp.flip(jnp.cumsum(jnp.flip(logf, 1), axis=1), 1) - logf
    return jnp.einsum('blhk,blhv->bhkv', k * jnp.exp(tail), v)


def _odd_mixer(u_ctx, u_lat, w_in, lb, norm_g, w_out, need_ctx):
    cuts = [HG_WIDTH, 2 * HG_WIDTH, 3 * HG_WIDTH, 3 * HG_WIDTH + HG_VWIDTH]

    def prep(u):
        bb, ll = u.shape[:2]
        q, ff, fb, i, g = jnp.split(u @ w_in, cuts, axis=-1)
        heads = lambda t: t.astype(F32).reshape(bb, ll, HG_HEADS, -1)
        dirs = []
        for d, fpre in enumerate((ff, fb)):
            lbd = lb[d].reshape(HG_HEADS, HG_DK)
            f = lbd + (1.0 - lbd) * jax.nn.sigmoid(heads(fpre))
            dirs.append((1.0 - f, jnp.log(f)))
        return heads(q), heads(i), g, dirs

    q_c, v_c, g_c, dirs_c = prep(u_ctx)
    q_l, v_l, g_l, dirs_l = prep(u_lat)
    ident = lambda t: t
    flip = lambda t: jnp.flip(t, 1)
    o_c = None
    o_l = None
    for d in range(2):
        fl = ident if d == 0 else flip
        k_c, lf_c = dirs_c[d]
        k_l, lf_l = dirs_l[d]
        if need_ctx:
            s0 = jnp.zeros((u_ctx.shape[0], HG_HEADS, HG_DK, HG_DV), F32)
            oc, s_c = _hgrn_chunk_scan(fl(q_c), fl(k_c), fl(v_c), fl(lf_c), s0)
            o_c = fl(oc) if o_c is None else o_c + fl(oc)
        else:
            s_c = _hgrn_final_state(fl(k_c), fl(v_c), fl(lf_c))
        ol, _ = _hgrn_chunk_scan(fl(q_l), fl(k_l), fl(v_l), fl(lf_l), s_c)
        o_l = fl(ol) if o_l is None else o_l + fl(ol)

    def out(o, g):
        bb, ll = o.shape[:2]
        o = _rms_norm(o, norm_g).reshape(bb, ll, HG_VWIDTH)
        return (o * jax.nn.silu(g.astype(F32))).astype(g.dtype) @ w_out

    y_ctx = out(o_c, g_c) if need_ctx else None
    return y_ctx, out(o_l, g_l)


def _conv_ffn(u, w_in, conv_w, conv_b, w_out):
    a, gt = jnp.split(u @ w_in, 2, axis=-1)
    l = a.shape[1]
    pad = CONV_WIDTH // 2
    ap = jnp.pad(a, ((0, 0), (pad, pad), (0, 0)))
    conv = conv_b
    for j in range(CONV_WIDTH):
        conv = conv + conv_w[j] * ap[:, j:j + l]
    return (jax.nn.silu(conv) * gt) @ w_out


def setup_inputs(seed: int = 0) -> dict:
    key = jax.random.key(seed)
    keys = iter(jax.random.split(key, 48))

    def nrm(shape, scale):
        return jax.random.normal(next(keys), shape, F32) * scale

    def gain(shape):
        return 1.0 + nrm(shape, 0.02)

    D = D_MODEL
    x = nrm((BATCH, SEQ, D), 1.0)
    c = nrm((BATCH, D), 1.0)
    ctx = nrm((BATCH, CTX_LEN, D), 1.0)
    c_ctx = nrm((D,), 1.0)
    ada_w = nrm((DEPTH, D, 6 * D), D ** -0.5)
    ada_b = nrm((DEPTH, 6 * D), 0.01)
    ln_g = gain((DEPTH, 2, D))
    ln_b = nrm((DEPTH, 2, D), 0.01)
    ffn_w_in = nrm((DEPTH, D, 2 * FFN_HIDDEN), D ** -0.5)
    ffn_conv_w = nrm((DEPTH, CONV_WIDTH, FFN_HIDDEN), CONV_WIDTH ** -0.5)
    ffn_conv_b = nrm((DEPTH, FFN_HIDDEN), 0.01)
    ffn_w_out = nrm((DEPTH, FFN_HIDDEN, D), DN_BETA * FFN_HIDDEN ** -0.5)
    ev_w_in = nrm((N_EVEN, D, EVEN_IN), D ** -0.5)
    mla_q_norm = gain((N_EVEN, MLA_Q_LORA))
    mla_w_uq = nrm((N_EVEN, MLA_Q_LORA, MLA_HEADS * (MLA_NOPE + MLA_ROPE)), MLA_Q_LORA ** -0.5)
    mla_kv_norm = gain((N_EVEN, MLA_KV_LORA))
    mla_w_ukv = nrm((N_EVEN, MLA_KV_LORA, MLA_HEADS * (MLA_NOPE + MLA_V)), MLA_KV_LORA ** -0.5)
    s5_lam_re = -0.5 + nrm((N_EVEN, 2, S5_GROUPS, S5_STATE), 0.01)
    s5_lam_im = math.pi * jnp.arange(S5_STATE, dtype=F32) + nrm((N_EVEN, 2, S5_GROUPS, S5_STATE), 0.01)
    s5_log_dt = jax.random.uniform(next(keys), (N_EVEN, 2, S5_GROUPS), F32,
                                   math.log(S5_DT_MIN), math.log(S5_DT_MAX))
    s5_b_re = nrm((N_EVEN, 2, S5_GROUPS, S5_STATE, S5_GROUP), (2 * S5_GROUP) ** -0.5)
    s5_b_im = nrm((N_EVEN, 2, S5_GROUPS, S5_STATE, S5_GROUP), (2 * S5_GROUP) ** -0.5)
    s5_c_re = nrm((N_EVEN, 2, S5_GROUPS, S5_GROUP, S5_STATE), S5_STATE ** -0.5)
    s5_c_im = nrm((N_EVEN, 2, S5_GROUPS, S5_GROUP, S5_STATE), S5_STATE ** -0.5)
    s5_d = nrm((N_EVEN, S5_WIDTH), 1.0)
    s5_w_glu = nrm((N_EVEN, S5_WIDTH, S5_WIDTH), S5_WIDTH ** -0.5)
    ev_w_out = nrm((N_EVEN, EVEN_MIX, D), DN_BETA * EVEN_MIX ** -0.5)
    hg_w_in = nrm((N_ODD, D, HG_IN), D ** -0.5)
    hg_lb = nrm((DEPTH, 2, HG_WIDTH), 0.1)
    hg_norm = gain((N_ODD, HG_DV))
    hg_w_out = nrm((N_ODD, HG_VWIDTH, D), DN_BETA * HG_VWIDTH ** -0.5)
    return {"x": x, "c": c, "ctx": ctx, "c_ctx": c_ctx, "ada_w": ada_w, "ada_b": ada_b,
            "ln_g": ln_g, "ln_b": ln_b, "ffn_w_in": ffn_w_in, "ffn_conv_w": ffn_conv_w,
            "ffn_conv_b": ffn_conv_b, "ffn_w_out": ffn_w_out, "ev_w_in": ev_w_in,
            "mla_q_norm": mla_q_norm, "mla_w_uq": mla_w_uq, "mla_kv_norm": mla_kv_norm,
            "mla_w_ukv": mla_w_ukv, "s5_lam_re": s5_lam_re, "s5_lam_im": s5_lam_im,
            "s5_log_dt": s5_log_dt, "s5_b_re": s5_b_re, "s5_b_im": s5_b_im,
            "s5_c_re": s5_c_re, "s5_c_im": s5_c_im, "s5_d": s5_d, "s5_w_glu": s5_w_glu,
            "ev_w_out": ev_w_out, "hg_w_in": hg_w_in, "hg_lb": hg_lb, "hg_norm": hg_norm,
            "hg_w_out": hg_w_out}


def reference(x, c, ctx, c_ctx, ada_w, ada_b, ln_g, ln_b, ffn_w_in, ffn_conv_w, ffn_conv_b,
              ffn_w_out, ev_w_in, mla_q_norm, mla_w_uq, mla_kv_norm, mla_w_ukv, s5_lam_re,
              s5_lam_im, s5_log_dt, s5_b_re, s5_b_im, s5_c_re, s5_c_im, s5_d, s5_w_glu,
              ev_w_out, hg_w_in, hg_lb, hg_norm, hg_w_out):
    sm = jax.nn.softmax(hg_lb.astype(F32), axis=0)
    lower_bounds = jnp.cumsum(sm, axis=0) - sm[0]
    s_lat = jax.nn.silu(c)
    s_ctx = jax.nn.silu(c_ctx)
    for layer in range(DEPTH):
        need_ctx = layer < DEPTH - 1
        mod_l = s_lat @ ada_w[layer] + ada_b[layer]
        mod_c = s_ctx @ ada_w[layer] + ada_b[layer]
        sh_m, sc_m, g_m, sh_f, sc_f, g_f = jnp.split(mod_l[:, None, :], 6, axis=-1)
        csh_m, csc_m, cg_m, csh_f, csc_f, cg_f = jnp.split(mod_c, 6, axis=-1)
        u_lat = x * (1.0 + sc_m) + sh_m
        u_ctx = ctx * (1.0 + csc_m) + csh_m
        if layer % 2 == 0:
            e = layer // 2
            y_ctx, y_lat = _even_mixer(u_ctx, u_lat, ev_w_in[e], mla_q_norm[e], mla_w_uq[e],
                                       mla_kv_norm[e], mla_w_ukv[e], s5_lam_re[e], s5_lam_im[e],
                                       s5_log_dt[e], s5_b_re[e], s5_b_im[e], s5_c_re[e],
                                       s5_c_im[e], s5_d[e], s5_w_glu[e], ev_w_out[e], need_ctx)
        else:
            o = layer // 2
            y_ctx, y_lat = _odd_mixer(u_ctx, u_lat, hg_w_in[o], lower_bounds[layer], hg_norm[o],
                                      hg_w_out[o], need_ctx)
        x = _layer_norm(DN_ALPHA * x + g_m * y_lat, ln_g[layer, 0], ln_b[layer, 0])
        f_lat = _conv_ffn(x * (1.0 + sc_f) + sh_f, ffn_w_in[layer], ffn_conv_w[layer],
                          ffn_conv_b[layer], ffn_w_out[layer])
        x = _layer_norm(DN_ALPHA * x + g_f * f_lat, ln_g[layer, 1], ln_b[layer, 1])
        if need_ctx:
            ctx = _layer_norm(DN_ALPHA * ctx + cg_m * y_ctx, ln_g[layer, 0], ln_b[layer, 0])
            f_ctx = _conv_ffn(ctx * (1.0 + csc_f) + csh_f, ffn_w_in[layer], ffn_conv_w[layer],
                              ffn_conv_b[layer], ffn_w_out[layer])
            ctx = _layer_norm(DN_ALPHA * ctx + cg_f * f_ctx, ln_g[layer, 1], ln_b[layer, 1])
    return x
```

```cpp
#include <hip/hip_runtime.h>
#include <cstdio>
#include <cstdint>
#include <cmath>
namespace pg8 {
#define PG8_LAS __attribute__((address_space(3)))
typedef unsigned short bf16_t;
typedef short bf16x8 __attribute__((ext_vector_type(8)));
typedef float f32x4 __attribute__((ext_vector_type(4)));
typedef unsigned u32x4 __attribute__((ext_vector_type(4)));
constexpr int BM = 256, BK = 64, HALF = 128, HTB = HALF * BK * 2  , STAGE_BYTES = 8 * HTB, NXCD = 8, WGM = 8;

__host__ __device__ __forceinline__ int lds_byte(int r, int c) { const int st = (r >> 4) * 2 + (c >> 5), rr = r & 15, cc = c & 31, ob = rr * 64 + cc * 2; return st * 1024 + (ob ^ (((ob >> 9) & 1) << 5)); }
__host__ __device__ __forceinline__ void stage_rc(int b, int& R, int& C) { const int st = b / 1024, sb = b % 1024, swz = sb ^ (((sb >> 9) & 1) << 5); R = (st >> 1) * 16 + swz / 64; C = (st & 1) * 32 + (swz % 64) / 2; }
__host__ __device__ __forceinline__ int perm32(int rho) { const int n = rho >> 4, i = rho & 15; return 8 * (i >> 2) + 4 * n + (i & 3); }

struct Unit { int pm, pn; };
struct Gemm { const bf16_t* A; const bf16_t* Bt; int M, N, K, lda, ldb; };

struct StaticOrder {
    int nM, nN, nwg, G, c;
    __host__ __device__ void init(int M, int N, int G_, int c_) { nM = M / BM; nN = N / BM; nwg = nM * nN; G = G_; c = c_; }
    __host__ __device__ bool next(int i, Unit& u) const {
        const long L = (long)i * G + c; if (L >= nwg) return false;
        int wgid = (int)L; { const int q = nwg / NXCD, r = nwg % NXCD, xcd = wgid % NXCD, off = wgid / NXCD; wgid = (xcd < r ? xcd * (q + 1) : r * (q + 1) + (xcd - r) * q) + off; }
        const int nig = WGM * nN, gid = wgid / nig, fm = gid * WGM, gsz = (nM - fm) < WGM ? (nM - fm) : WGM;
        u.pm = fm + ((wgid % nig) % gsz); u.pn = (wgid % nig) / gsz; return true;
    }
    __device__ __forceinline__ void a_ready(const Unit&) const {}
    __device__ __forceinline__ void done(const Unit&) const {}
};

__device__ __forceinline__ unsigned cvt_pk_bf16(float lo, float hi) { unsigned r; asm volatile("v_cvt_pk_bf16_f32 %0, %1, %2" : "=v"(r) : "v"(lo), "v"(hi)); return r; }
template <class F> struct Epi8 {
    static constexpr bool PERM = true, AFTER_DRAIN = false; F f;
    __device__ __forceinline__ void operator()(const f32x4 (&acc)[2][2][4][2], const Unit& u, int wr, int wc, int fr, int fq) const {
        const int row0 = u.pm * BM + wr * 64 + fr, col0 = u.pn * BM + wc * 32 + 8 * fq;
#pragma unroll
        for (int ai = 0; ai < 2; ++ai)
#pragma unroll
            for (int m = 0; m < 4; ++m)
#pragma unroll
                for (int bj = 0; bj < 2; ++bj) { f(row0 + ai * HALF + m * 16, col0 + bj * HALF, acc[ai][bj][m][0], acc[ai][bj][m][1]); __builtin_amdgcn_sched_barrier(0); }
    }
};
template <class F> struct Epi4 {
    static constexpr bool PERM = false, AFTER_DRAIN = false; F f;
    __device__ __forceinline__ void operator()(const f32x4 (&acc)[2][2][4][2], const Unit& u, int wr, int wc, int fr, int fq) const {
        const int row0 = u.pm * BM + wr * 64 + fr, col0 = u.pn * BM + wc * 32 + 4 * fq;
#pragma unroll
        for (int ai = 0; ai < 2; ++ai)
#pragma unroll
            for (int m = 0; m < 4; ++m)
#pragma unroll
                for (int bj = 0; bj < 2; ++bj)
#pragma unroll
                    for (int n = 0; n < 2; ++n) { f(row0 + ai * HALF + m * 16, col0 + bj * HALF + n * 16, acc[ai][bj][m][n]); __builtin_amdgcn_sched_barrier(0); }
    }
};
template <class Epi, class Sched, bool ALIGN_EPI = false, bool SP2 = false>
__device__ __forceinline__ void gemm_phase(PG8_LAS unsigned char* lds, const Gemm g, const Sched& S, const Epi& E) {
    int tid_ = threadIdx.x; asm volatile("" : "+v"(tid_));
    const int tid = tid_, wid = __builtin_amdgcn_readfirstlane(tid >> 6), lane = tid & 63, wr = wid >> 2, wc = wid & 3, fr = lane & 15, fq = lane >> 4;
    const int K = g.K, nt = K / BK;
    unsigned voffA[2], voffB[2];
#pragma unroll
    for (int i = 0; i < 2; ++i) { int R, C; stage_rc(tid * 16 + i * 8192, R, C); const int Rb = Epi::PERM ? ((R & ~31) + perm32(R & 31)) : R;
        voffA[i] = (unsigned)(R * g.lda + C) * 2u; voffB[i] = (unsigned)(Rb * g.ldb + C) * 2u; }
    const size_t kstep = (size_t)(BK * 2);
    const size_t hstepA = (size_t)HALF * g.lda * 2, hstepB = (size_t)HALF * g.ldb * 2;
    const size_t tstepA = 2 * hstepA, tstepB = 2 * hstepB;
    const unsigned ldsw = (unsigned)wid * 1024u;
    const int aoff = lds_byte(wr * 64 + fr, fq * 8), boff = lds_byte(wc * 32 + fr, fq * 8);
#define PG8_SA(b, h) (((b) * 2 + (h)) * HTB)
#define PG8_SB(b, h) ((4 + (b) * 2 + (h)) * HTB)
#define PG8_STAGE(bufoff, gbase, voff) do { _Pragma("unroll") for (int _i = 0; _i < 2; ++_i) \
        __builtin_amdgcn_global_load_lds((const unsigned*)((const char*)(gbase) + (voff)[_i]), (PG8_LAS unsigned*)(lds + (bufoff) + ldsw + _i * 8192), 16, 0, 0); } while (0)
#define PG8_LDA(dst, b, h) do { _Pragma("unroll") for (int m = 0; m < 4; ++m) _Pragma("unroll") for (int k = 0; k < 2; ++k) dst[m][k] = *(const PG8_LAS bf16x8*)(lds + PG8_SA(b, h) + aoff + m * 2048 + k * 1024); } while (0)
#define PG8_LDB(dst, b, h) do { _Pragma("unroll") for (int n = 0; n < 2; ++n) _Pragma("unroll") for (int k = 0; k < 2; ++k) dst[n][k] = *(const PG8_LAS bf16x8*)(lds + PG8_SB(b, h) + boff + n * 2048 + k * 1024); } while (0)
#define PG8_MMA(ai, bj, At, Bt) do { __builtin_amdgcn_s_setprio(1); _Pragma("unroll") for (int m = 0; m < 4; ++m) _Pragma("unroll") for (int n = 0; n < 2; ++n) _Pragma("unroll") for (int k = 0; k < 2; ++k) \
        acc[ai][bj][m][n] = __builtin_amdgcn_mfma_f32_16x16x32_bf16(Bt[n][k], At[m][k], acc[ai][bj][m][n], 0, 0, 0); __builtin_amdgcn_s_setprio(0); } while (0)
#define PG8_WAIT_V(n) asm volatile("s_waitcnt vmcnt(" #n ")" ::: "memory")
#define PG8_WAIT_L(n) asm volatile("s_waitcnt lgkmcnt(" #n ")" ::: "memory")
#define PG8_BAR __builtin_amdgcn_s_barrier()
#define PG8_SCHED __builtin_amdgcn_sched_barrier(0)
    Unit cur, nxt; int ui = 0;
    if (!S.next(0, cur)) return;
    f32x4 acc[2][2][4][2];
#pragma unroll
    for (int a = 0; a < 2; ++a)
#pragma unroll
        for (int b = 0; b < 2; ++b)
#pragma unroll
            for (int m = 0; m < 4; ++m)
#pragma unroll
                for (int n = 0; n < 2; ++n) acc[a][b][m][n] = (f32x4){0.f, 0.f, 0.f, 0.f};
    bf16x8 At[4][2], B0[2][2], B1[2][2];
    const char* cA = (const char*)g.A + (size_t)cur.pm * tstepA; const char* cB = (const char*)g.Bt + (size_t)cur.pn * tstepB;
    S.a_ready(cur);
    if constexpr (SP2) {
        PG8_STAGE(PG8_SB(0, 0), cB, voffB); PG8_STAGE(PG8_SB(0, 1), cB + hstepB, voffB); PG8_STAGE(PG8_SA(0, 0), cA, voffA); PG8_STAGE(PG8_SA(0, 1), cA + hstepA, voffA);
        if (wr == 1) PG8_BAR;
        PG8_WAIT_V(2); PG8_BAR;
        PG8_STAGE(PG8_SB(1, 0), cB + kstep, voffB); PG8_STAGE(PG8_SA(1, 0), cA + kstep, voffA); PG8_STAGE(PG8_SB(1, 1), cB + hstepB + kstep, voffB);
        PG8_WAIT_V(6); PG8_BAR;
    } else {
        PG8_STAGE(PG8_SB(0, 0), cB, voffB); PG8_STAGE(PG8_SA(0, 0), cA, voffA); PG8_STAGE(PG8_SB(0, 1), cB + hstepB, voffB); PG8_STAGE(PG8_SA(0, 1), cA + hstepA, voffA);
        if (wr == 1) PG8_BAR;
        PG8_WAIT_V(4); PG8_BAR;
        PG8_STAGE(PG8_SB(1, 0), cB + kstep, voffB); PG8_STAGE(PG8_SA(1, 0), cA + kstep, voffA); PG8_STAGE(PG8_SB(1, 1), cB + hstepB + kstep, voffB);
        PG8_WAIT_V(6); PG8_BAR;
    }
    for (;;) {
        const bool has_next = S.next(ui + 1, nxt);
        const char* nA = has_next ? (const char*)g.A + (size_t)nxt.pm * tstepA : cA; const char* nB = has_next ? (const char*)g.Bt + (size_t)nxt.pn * tstepB : cB;
#pragma unroll 1
        for (int t = 0; t < nt; t += 2) {
            const bool last = (t == nt - 2);
            const char* a1 = cA + (size_t)(t + 1) * kstep;
            const char* a2 = last ? nA : cA + (size_t)(t + 2) * kstep; const char* b2 = last ? nB : cB + (size_t)(t + 2) * kstep;
            const char* a3 = a2 + kstep; const char* b3 = b2 + kstep;
            if (last && has_next) S.a_ready(nxt);
            if constexpr (SP2) {
            PG8_LDB(B0, 0, 0); PG8_LDB(B1, 0, 1); PG8_SCHED; PG8_LDA(At, 0, 0); PG8_STAGE(PG8_SA(1, 1), a1 + hstepA, voffA);
            PG8_WAIT_V(8); PG8_WAIT_L(0); PG8_BAR; PG8_MMA(0, 0, At, B0); PG8_MMA(0, 1, At, B1); PG8_BAR; PG8_SCHED;
            PG8_LDA(At, 0, 1); PG8_STAGE(PG8_SB(0, 0), b2, voffB); PG8_STAGE(PG8_SB(0, 1), b2 + hstepB, voffB); PG8_STAGE(PG8_SA(0, 0), a2, voffA);
            PG8_WAIT_V(8); PG8_WAIT_L(0); PG8_BAR; PG8_MMA(1, 0, At, B0); PG8_MMA(1, 1, At, B1); PG8_BAR; PG8_SCHED;
            PG8_LDB(B0, 1, 0); PG8_LDB(B1, 1, 1); PG8_SCHED; PG8_LDA(At, 1, 0); PG8_STAGE(PG8_SA(0, 1), a2 + hstepA, voffA);
            PG8_WAIT_V(8); PG8_WAIT_L(0); PG8_BAR; PG8_MMA(0, 0, At, B0); PG8_MMA(0, 1, At, B1); PG8_BAR; PG8_SCHED;
            PG8_LDA(At, 1, 1); PG8_STAGE(PG8_SB(1, 0), b3, voffB); PG8_STAGE(PG8_SB(1, 1), b3 + hstepB, voffB); PG8_STAGE(PG8_SA(1, 0), a3, voffA);
            PG8_WAIT_V(8); PG8_WAIT_L(0); PG8_BAR; PG8_MMA(1, 0, At, B0); PG8_MMA(1, 1, At, B1); PG8_BAR; PG8_SCHED;
            } else {
            PG8_LDB(B0, 0, 0); PG8_SCHED; PG8_LDA(At, 0, 0); PG8_STAGE(PG8_SA(1, 1), a1 + hstepA, voffA);
            PG8_WAIT_L(8); PG8_BAR; PG8_WAIT_L(0); PG8_MMA(0, 0, At, B0); PG8_BAR; PG8_SCHED;
            PG8_LDB(B1, 0, 1); PG8_STAGE(PG8_SB(0, 0), b2, voffB);
            PG8_BAR; PG8_WAIT_L(0); PG8_MMA(0, 1, At, B1); PG8_BAR;
            PG8_LDA(At, 0, 1); PG8_STAGE(PG8_SA(0, 0), a2, voffA);
            PG8_BAR; PG8_WAIT_L(0); PG8_MMA(1, 0, At, B0); PG8_BAR; PG8_SCHED;
            PG8_STAGE(PG8_SB(0, 1), b2 + hstepB, voffB);
            PG8_WAIT_V(6); PG8_BAR; PG8_MMA(1, 1, At, B1); PG8_BAR;
            PG8_LDB(B0, 1, 0); PG8_SCHED; PG8_LDA(At, 1, 0); PG8_STAGE(PG8_SA(0, 1), a2 + hstepA, voffA);
            PG8_WAIT_L(8); PG8_BAR; PG8_WAIT_L(0); PG8_MMA(0, 0, At, B0); PG8_BAR; PG8_SCHED;
            PG8_LDB(B1, 1, 1); PG8_STAGE(PG8_SB(1, 0), b3, voffB);
            PG8_BAR; PG8_WAIT_L(0); PG8_MMA(0, 1, At, B1); PG8_BAR;
            PG8_LDA(At, 1, 1); PG8_STAGE(PG8_SA(1, 0), a3, voffA);
            PG8_BAR; PG8_WAIT_L(0); PG8_MMA(1, 0, At, B0); PG8_BAR; PG8_SCHED;
            PG8_STAGE(PG8_SB(1, 1), b3 + hstepB, voffB);
            PG8_WAIT_V(6); PG8_BAR; PG8_MMA(1, 1, At, B1); PG8_BAR;
            }
        }
        if constexpr (ALIGN_EPI) { if (wr == 0) PG8_BAR; }
        if constexpr (!Epi::AFTER_DRAIN) { E(acc, cur, wr, wc, fr, fq); S.done(cur); }
        if (!has_next) break;
#pragma unroll
        for (int a = 0; a < 2; ++a)
#pragma unroll
            for (int b = 0; b < 2; ++b)
#pragma unroll
                for (int m = 0; m < 4; ++m)
#pragma unroll
                    for (int n = 0; n < 2; ++n) acc[a][b][m][n] = (f32x4){0.f, 0.f, 0.f, 0.f};
        cur = nxt; cA = nA; cB = nB; ++ui;
        if constexpr (ALIGN_EPI) { if (wr == 1) PG8_BAR; }
    }
    PG8_WAIT_V(0);
    if constexpr (!ALIGN_EPI) { if (wr == 0) PG8_BAR; }
    PG8_BAR;
    if constexpr (Epi::AFTER_DRAIN) { E.fused(acc, cur, wr, wc, fr, fq, lds, wid, lane); S.done(cur); }
#undef PG8_SA
#undef PG8_SB
#undef PG8_STAGE
#undef PG8_LDA
#undef PG8_LDB
#undef PG8_MMA
#undef PG8_WAIT_V
#undef PG8_WAIT_L
#undef PG8_BAR
#undef PG8_SCHED
}
}

constexpr int NWAVES = 8;
constexpr int D = 1024, BATCH = 2, SEQ = 8192, CTXL = 256;
constexpr int TL = BATCH * SEQ;
constexpr int TC = BATCH * CTXL;
constexpr int TT = TL + TC;
constexpr int EVEN_IN = 1184, EVEN_IN_PAD = 1280, CQKV_LD = 672;
constexpr int FFH = 2816, FFG = 1408;
constexpr int TQK = SEQ + CTXL;
constexpr float NORM_EPS = 1e-6f;
constexpr float DN_ALPHA = 1.41421356237f;
constexpr float QSCALE = 0.10206207261596577f * 1.4426950408889634f;

constexpr size_t MiB = 1u << 20;
constexpr size_t WS_CTL = 0, CTL_ZERO_BYTES = 1 * MiB;
constexpr size_t WS_MOD = 1 * MiB;
constexpr size_t WS_LBV = WS_MOD + 160 * 1024;
constexpr size_t WS_ROPE = WS_LBV + 16 * 1024;
constexpr size_t WS_HGINT = 2 * MiB, WS_HGOUTT = 12 * MiB, WS_F1T1 = 14 * MiB, WS_F2T1 = 25 * MiB;
constexpr size_t WS_A = 31 * MiB;
constexpr size_t WS_XC = 64 * MiB;
constexpr size_t WS_WIN0 = 66 * MiB, WS_WUQ = WS_WIN0 + 2560 * 1024, WS_WUKV = WS_WUQ + 768 * 1024, WS_WGLU = WS_WUKV + 512 * 1024,
                 WS_WOUT0 = WS_WGLU + 512 * 1024, WS_F1T0 = 72 * MiB + 512 * 1024, WS_F2T0 = WS_F1T0 + 11 * MiB;
constexpr size_t WS_R = 89 * MiB;
constexpr size_t WS_CQKV = WS_R;
constexpr size_t WS_UG = WS_R + 22 * MiB;
constexpr size_t WS_WF = WS_R + 39 * MiB;
constexpr size_t WS_WC = WS_R + 64 * MiB;
constexpr size_t WS_TOEP = WS_R + 80 * MiB;
constexpr size_t WS_T0 = WS_R + 82 * MiB;
constexpr size_t WS_A64 = WS_T0 + 128 * 1024;
constexpr size_t WS_FIN = WS_R + 83 * MiB;
constexpr size_t WS_SIN = WS_R + 92 * MiB;
constexpr size_t WS_Z = WS_R + 97 * MiB;
constexpr size_t WS_MIX = WS_R + 134 * MiB;
constexpr size_t WS_QB = WS_R + 39 * MiB;
constexpr size_t WS_KB = 31 * MiB;
constexpr size_t WS_VB = WS_R + 114 * MiB;
constexpr size_t WS_H = WS_R;
constexpr size_t WS_HG = WS_R + 91 * MiB;
constexpr size_t WS_QFFI = 66 * MiB;
constexpr size_t WS_G = 198 * MiB;
constexpr size_t WS_O = WS_A;
constexpr size_t WS_END = 256 * MiB;
static_assert(WS_F2T0 + 5632 * 1024 <= WS_R, "layer-0 weights");
static_assert(WS_MIX + (size_t)TT * 1024 * 2 <= WS_END && WS_G + (size_t)TT * 1024 * 2 <= WS_END && WS_HG + (size_t)TT * FFG * 2 <= WS_END, "ws map");
static_assert(WS_WF + 16 * MiB <= WS_WC && WS_QB + (size_t)16 * TQK * 96 * 2 <= WS_WC && WS_WC + 16 * MiB <= WS_TOEP && WS_TOEP + 2 * MiB <= WS_T0 && WS_T0 + MiB <= WS_FIN && WS_FIN + (size_t)32 * 264 * 256 * 4 <= WS_SIN && WS_SIN + (size_t)32 * 264 * 256 * 2 <= WS_Z && WS_Z + (size_t)TT * 512 * 2 <= WS_VB && WS_VB + (size_t)16 * TQK * 64 * 2 <= WS_MIX && WS_KB + (size_t)16 * TQK * 96 * 2 <= WS_XC, "ws map 2");

constexpr int CW_BAR = 4096;
constexpr int RING_OFF = 0, RING_BYTES = 131072;
constexpr int LDSCTL_OFF = RING_BYTES, MISC_OFF = LDSCTL_OFF + 320;
constexpr int LDS_BYTES = 147456;

#define GAS __attribute__((address_space(1)))
#define LAS __attribute__((address_space(3)))
typedef unsigned short bf16;
typedef unsigned v4u __attribute__((ext_vector_type(4)));
typedef unsigned v2u __attribute__((ext_vector_type(2)));
typedef float f32x4 __attribute__((ext_vector_type(4)));
typedef GAS unsigned gu32;
#define RLX_AGENT __ATOMIC_RELAXED, __HIP_MEMORY_SCOPE_AGENT
#define LDS_WAIT() asm volatile("s_waitcnt lgkmcnt(0)" ::: "memory")
__device__ __forceinline__ unsigned f2bf(float f) { unsigned u = __builtin_bit_cast(unsigned, f); return (u + 0x7fffu + ((u >> 16) & 1u)) >> 16; }
__device__ __forceinline__ unsigned pk2(float lo, float hi) { return f2bf(lo) | (f2bf(hi) << 16); }
__device__ __forceinline__ float bflo(unsigned w) { return __builtin_bit_cast(float, w << 16); }
__device__ __forceinline__ float bfhi(unsigned w) { return __builtin_bit_cast(float, w & 0xffff0000u); }
__device__ __forceinline__ float bf2f(bf16 h) { return __builtin_bit_cast(float, (unsigned)h << 16); }
__device__ __forceinline__ void unpack8(v4u w, float* x) { x[0] = bflo(w.x); x[1] = bfhi(w.x); x[2] = bflo(w.y); x[3] = bfhi(w.y); x[4] = bflo(w.z); x[5] = bfhi(w.z); x[6] = bflo(w.w); x[7] = bfhi(w.w); }
__device__ __forceinline__ v4u pack8(const float* x) { v4u w; w.x = pk2(x[0], x[1]); w.y = pk2(x[2], x[3]); w.z = pk2(x[4], x[5]); w.w = pk2(x[6], x[7]); return w; }
__device__ __forceinline__ float sigmoidf_(float x) { return 1.0f / (1.0f + __expf(-x)); }
__device__ __forceinline__ float siluf_(float x) { return x / (1.0f + __expf(-x)); }
__device__ __forceinline__ float gelu_tanh(float x) { const float u = 0.7978845608028654f * (x + 0.044715f * x * x * x); return 0.5f * x * (1.0f + tanhf(u)); }
__device__ __forceinline__ float wave_sum(float v) {
#pragma unroll
    for (int o = 1; o < 64; o <<= 1) v += __shfl_xor(v, o);
    return v;
}

#define XB_TMO      128
#define XB_XCNT(j)  (256  + 64 * (j))
#define XB_XSUB(j)  (1280 + 64 * (j))
#define XB_XGEN(j)  (2304 + 64 * (j))
#define XB_TOP      3328
#define XB_TOPGEN   3392
#define XCD_BAR_WORDS 3456
#define XB_SPIN_CAP (1u << 18)

__device__ __forceinline__ unsigned xb_ld(unsigned* p)              { return __hip_atomic_load(p, __ATOMIC_RELAXED, __HIP_MEMORY_SCOPE_AGENT); }
__device__ __forceinline__ unsigned xb_add(unsigned* p, unsigned v) { return __hip_atomic_fetch_add(p, v, __ATOMIC_RELAXED, __HIP_MEMORY_SCOPE_AGENT); }
__device__ __forceinline__ unsigned xb_xcc_id() { return (unsigned)__builtin_amdgcn_s_getreg((3 << 11) | 20) & 0xFu; }
#define XB_SPIN(cond, bar) do { unsigned _sp = 0; while (cond) { __builtin_amdgcn_s_sleep(1); \
    if ((++_sp & 255u) == 0u) { if (xb_ld(&(bar)[XB_TMO])) break; if (_sp > XB_SPIN_CAP) { atomicAdd(&(bar)[XB_TMO], 1u); break; } } } } while (0)

struct XcdBarrier {
    unsigned* bar; unsigned x;
    volatile LAS unsigned* st;
};

__device__ __forceinline__ XcdBarrier xcd_barrier_post(unsigned* bar, volatile LAS unsigned* st) {
    XcdBarrier b; b.bar = bar; b.x = xb_xcc_id(); b.st = st;
    if (threadIdx.x == 0) (void)xb_add(&bar[XB_XCNT(b.x)], 1u);
    return b;
}
__device__ __forceinline__ void xcd_barrier_complete(unsigned* bar, unsigned x, unsigned& nloc, unsigned& nx) {
    const unsigned G = gridDim.x * gridDim.y * gridDim.z;
    unsigned sum, cnt, mine, sp = 0u;
    for (;;) {
        sum = 0u; cnt = 0u; mine = 0u;
#pragma unroll
        for (unsigned j = 0; j < 16; ++j) { const unsigned c = xb_ld(&bar[XB_XCNT(j)]); sum += c; cnt += (c > 0u) ? 1u : 0u; mine = (j == x) ? c : mine; }
        if (sum == G) break;
        __builtin_amdgcn_s_sleep(1);
        if ((++sp & 255u) == 0u) { if (xb_ld(&bar[XB_TMO])) break; if (sp > XB_SPIN_CAP) { atomicAdd(&bar[XB_TMO], 1u); break; } }
    }
    nloc = mine > 0u ? mine : 1u; nx = cnt > 0u ? cnt : 1u;
}

__device__ __forceinline__ void xcd_barrier(const XcdBarrier& b) {
    asm volatile("s_waitcnt vmcnt(0)" ::: "memory");
    __syncthreads();
    if (threadIdx.x == 0) {
        unsigned* bar = b.bar;
        __builtin_amdgcn_s_waitcnt(0);
        unsigned nloc = b.st[0], nx = b.st[1];
        if (nloc == 0u) { xcd_barrier_complete(bar, b.x, nloc, nx); b.st[0] = nloc; b.st[1] = nx; }
        const unsigned old = xb_add(&bar[XB_XSUB(b.x)], 1u);
        const unsigned gen = old / nloc;
        if (old + 1u == (gen + 1u) * nloc) {
            __builtin_amdgcn_fence(__ATOMIC_RELEASE, "agent");
            asm volatile("s_waitcnt vmcnt(0)" ::: "memory");
            const unsigned og = xb_add(&bar[XB_TOP], 1u);
            const unsigned tg = og / nx;
            if (og + 1u == (tg + 1u) * nx) xb_add(&bar[XB_TOPGEN], 1u);
            else XB_SPIN(xb_ld(&bar[XB_TOPGEN]) == tg, bar);
            __builtin_amdgcn_fence(__ATOMIC_ACQUIRE, "agent");
            xb_add(&bar[XB_XGEN(b.x)], 1u);
            asm volatile("s_waitcnt vmcnt(0)" ::: "memory");
        } else {
            XB_SPIN(xb_ld(&bar[XB_XGEN(b.x)]) == gen, bar);
            __builtin_amdgcn_fence(__ATOMIC_ACQUIRE, "agent");
            asm volatile("s_waitcnt vmcnt(0)" ::: "memory");
        }
    }
    __syncthreads();
}


struct Frame {
    LAS unsigned char* lds;
    int tid, lane, wave, vcu, G;
};
constexpr int PTR_OFF = LDSCTL_OFF + 1024;
__device__ __forceinline__ const float* inp(const Frame& F, int i) {
    const LAS unsigned* p = (const LAS unsigned*)(F.lds + PTR_OFF) + 2 * i;
    const unsigned lo = __builtin_amdgcn_readfirstlane(p[0]), hi = __builtin_amdgcn_readfirstlane(p[1]);
    return (const float*)(((unsigned long long)hi << 32) | lo);
}
__device__ __forceinline__ unsigned char* ws_(const Frame& F) { return (unsigned char*)inp(F, 31); }
__device__ __forceinline__ float* out_(const Frame& F) { return (float*)inp(F, 32); }
__device__ __forceinline__ int modrow_of(int m) { return m < TL ? (m >> 13) : 2; }
__device__ __forceinline__ const float* xin_row(const Frame& F, int m) { return m < TL ? inp(F, 0) + (size_t)m * D : inp(F, 2) + (size_t)(m - TL) * D; }
__device__ __forceinline__ float* xres_row(const Frame& F, int m) { return m < TL ? out_(F) + (size_t)m * D : (float*)(ws_(F) + WS_XC) + (size_t)(m - TL) * D; }
__device__ __forceinline__ const float* modvec(const Frame& F, int layer, int mr, int part) { return (const float*)(ws_(F) + WS_MOD) + (size_t)(layer * 3 + mr) * 6144 + part * 1024; }

__device__ __forceinline__ void tr_item(const float* W, int ldw, int k0, int n0, bf16* dst, int dpitch, LAS float* scr, int lane) {
    { f32x4 v[8];
#pragma unroll
      for (int i = 0; i < 8; ++i) v[i] = *(const GAS f32x4*)(W + (size_t)(k0 + 8 * i + (lane >> 3)) * ldw + n0 + 4 * (lane & 7));
#pragma unroll
      for (int i = 0; i < 8; ++i) { LAS float* d = scr + (8 * i + (lane >> 3)) * 33 + 4 * (lane & 7); d[0] = v[i].x; d[1] = v[i].y; d[2] = v[i].z; d[3] = v[i].w; } }
    LDS_WAIT(); asm volatile("" ::: "memory");
    const int c = lane & 7;
#pragma unroll
    for (int j = 0; j < 4; ++j) { const int n = (lane >> 3) + 8 * j; const LAS float* s = scr + (8 * c) * 33 + n;
        v4u o; o.x = pk2(s[0 * 33], s[1 * 33]); o.y = pk2(s[2 * 33], s[3 * 33]); o.z = pk2(s[4 * 33], s[5 * 33]); o.w = pk2(s[6 * 33], s[7 * 33]);
        *(GAS v4u*)(dst + (size_t)n * dpitch + 8 * c) = o; }
    LDS_WAIT(); asm volatile("" ::: "memory");
}
__device__ __forceinline__ bool tr_plain(int& r, const float* W, int K, int N, bf16* WT, LAS float* scr, int lane) {
    const int nblk = N / 32, cnt = (K / 64) * nblk;
    if (r >= cnt) { r -= cnt; return false; }
    const int kb = r / nblk, nb = r % nblk;
    tr_item(W, N, 64 * kb, 32 * nb, WT + (size_t)(32 * nb) * K + 64 * kb, K, scr, lane); return true;
}
__device__ __forceinline__ bool tr_ffn1(int& r, const float* W, bf16* WT, LAS float* scr, int lane) {
    const int nblk = 5632 / 32, cnt = 16 * nblk;
    if (r >= cnt) { r -= cnt; return false; }
    const int kb = r / nblk, nb = r % nblk, n0 = 32 * nb, half = n0 / FFH, j = n0 % FFH, g = j / FFG, jj = j % FFG, drow = g * FFH + half * FFG + jj;
    tr_item(W, 5632, 64 * kb, n0, WT + (size_t)drow * 1024 + 64 * kb, 1024, scr, lane); return true;
}
__device__ __forceinline__ void p0_prologue(Frame& F) {
    {
        LAS float* sv = (LAS float*)(F.lds + RING_OFF);
        LAS float* red = sv + 3072;
        for (int i = F.tid; i < 3072; i += 512) { const int r = i >> 10, k = i & 1023; const float cv = (r < 2) ? inp(F, 1)[r * 1024 + k] : inp(F, 3)[k]; sv[i] = cv / (1.0f + __expf(-cv)); }
        __syncthreads();
        for (int it = blockIdx.x; it < 192; it += F.G) {
            const int layer = it / 96, cg = it % 96, col = cg * 64 + F.lane, k0 = F.wave * 128;
            const float* w = inp(F, 4) + ((size_t)layer * 1024 + k0) * 6144 + col;
            float a0 = 0.f, a1 = 0.f, a2 = 0.f;
#pragma unroll 16
            for (int k = 0; k < 128; ++k) { const float wv = w[(size_t)k * 6144]; a0 += sv[k0 + k] * wv; a1 += sv[1024 + k0 + k] * wv; a2 += sv[2048 + k0 + k] * wv; }
            red[(F.wave * 3 + 0) * 64 + F.lane] = a0; red[(F.wave * 3 + 1) * 64 + F.lane] = a1; red[(F.wave * 3 + 2) * 64 + F.lane] = a2;
            __syncthreads();
            if (F.tid < 192) { const int r = F.tid >> 6, l = F.tid & 63; float s = inp(F, 5)[layer * 6144 + cg * 64 + l];
#pragma unroll
                for (int wv = 0; wv < 8; ++wv) s += red[(wv * 3 + r) * 64 + l];
                ((float*)(ws_(F) + WS_MOD))[(size_t)(layer * 3 + r) * 6144 + cg * 64 + l] = s; }
            __syncthreads();
        }
        __syncthreads();
    }
    {
        const int gt = F.vcu * 512 + F.tid, NT = F.G * 512;
        for (int i = gt; i < 2048; i += NT) { const int dir = i >> 10, c = i & 1023; const float l0 = inp(F, 28)[(0 * 2 + dir) * 1024 + c], l1 = inp(F, 28)[(1 * 2 + dir) * 1024 + c];
            ((float*)(ws_(F) + WS_LBV))[i] = 1.0f / (1.0f + expf(l0 - l1)); }
        for (int i = gt; i < 1024; i += NT) { const int pos = i >> 3, f = i & 7; const float inv = powf(10000.0f, -(float)f / 8.0f); const float ang = (float)pos * inv;
            ((float*)(ws_(F) + WS_ROPE))[2 * i] = cosf(ang); ((float*)(ws_(F) + WS_ROPE))[2 * i + 1] = sinf(ang); }
        for (int i = gt; i < 96 * 1024 / 8; i += NT) ((GAS v4u*)(ws_(F) + WS_WIN0 + (size_t)1184 * 1024 * 2))[i] = (v4u){0u, 0u, 0u, 0u};
    }
    {
        LAS float* scr = (LAS float*)(F.lds + RING_OFF + F.wave * 16384);
        const int gw = F.vcu * NWAVES + F.wave, NGW = F.G * NWAVES;
        constexpr int NITEMS = 592 + 144 + 128 + 128 + 512 + 2 * 2816 + 2 * 1408 + 2560 + 512;
        for (int it = gw; it < NITEMS; it += NGW) {
            int r = it;
            if (tr_plain(r, inp(F, 12), 1024, 1184, (bf16*)(ws_(F) + WS_WIN0), scr, F.lane)) continue;
            if (tr_plain(r, inp(F, 14), 384, 768, (bf16*)(ws_(F) + WS_WUQ), scr, F.lane)) continue;
            if (tr_plain(r, inp(F, 16), 256, 1024, (bf16*)(ws_(F) + WS_WUKV), scr, F.lane)) continue;
            if (tr_plain(r, inp(F, 25), 512, 512, (bf16*)(ws_(F) + WS_WGLU), scr, F.lane)) continue;
            if (tr_plain(r, inp(F, 26), 1024, 1024, (bf16*)(ws_(F) + WS_WOUT0), scr, F.lane)) continue;
            if (tr_ffn1(r, inp(F, 8), (bf16*)(ws_(F) + WS_F1T0), scr, F.lane)) continue;
            if (tr_ffn1(r, inp(F, 8) + (size_t)1024 * 5632, (bf16*)(ws_(F) + WS_F1T1), scr, F.lane)) continue;
            if (tr_plain(r, inp(F, 11), 2816, 1024, (bf16*)(ws_(F) + WS_F2T0), scr, F.lane)) continue;
            if (tr_plain(r, inp(F, 11) + (size_t)2816 * 1024, 2816, 1024, (bf16*)(ws_(F) + WS_F2T1), scr, F.lane)) continue;
            if (tr_plain(r, inp(F, 27), 1024, 5120, (bf16*)(ws_(F) + WS_HGINT), scr, F.lane)) continue;
            tr_plain(r, inp(F, 30), 1024, 1024, (bf16*)(ws_(F) + WS_HGOUTT), scr, F.lane);
        }
    }
}

__device__ __forceinline__ void store_mod_bf16(const Frame& F, const f32x4 (&v)[4], int m, int layer, int part_sh) {
    const int mr = modrow_of(m);
    const GAS f32x4* sh = (const GAS f32x4*)modvec(F, layer, mr, part_sh) + F.lane;
    const GAS f32x4* sc = (const GAS f32x4*)modvec(F, layer, mr, part_sh + 1) + F.lane;
    GAS v2u* o = (GAS v2u*)((bf16*)(ws_(F) + WS_A) + (size_t)m * D) + F.lane;
#pragma unroll
    for (int j = 0; j < 4; ++j) { const f32x4 s = sc[64 * j], h = sh[64 * j]; const f32x4 y = v[j] * (s + 1.0f) + h; v2u w; w.x = pk2(y.x, y.y); w.y = pk2(y.z, y.w); o[64 * j] = w; }
}
__device__ __forceinline__ void ph_init_rows(Frame& F) {
    const int gw = F.vcu * NWAVES + F.wave, NGW = F.G * NWAVES;
    for (int m = gw; m < TT; m += NGW) {
        const GAS f32x4* xr = (const GAS f32x4*)xin_row(F, m) + F.lane; GAS f32x4* xo = (GAS f32x4*)xres_row(F, m) + F.lane;
        f32x4 v[4];
#pragma unroll
        for (int j = 0; j < 4; ++j) { v[j] = xr[64 * j]; xo[64 * j] = (m >= TL) ? v[j] * DN_ALPHA : v[j]; }
        store_mod_bf16(F, v, m, 0, 0);
    }
}
__device__ __forceinline__ void ph_layernorm(Frame& F, int nrows, int layer, int which, int next_layer, int next_part_sh) {
    const int gw = F.vcu * NWAVES + F.wave, NGW = F.G * NWAVES;
    const GAS f32x4* gg = (const GAS f32x4*)(inp(F, 6) + (size_t)(layer * 2 + which) * D) + F.lane;
    const GAS f32x4* bb = (const GAS f32x4*)(inp(F, 7) + (size_t)(layer * 2 + which) * D) + F.lane;
    for (int m0 = gw; m0 < nrows; m0 += 2 * NGW) {
        const int m1 = m0 + NGW; const bool has1 = m1 < nrows; const int m1c = has1 ? m1 : m0;
        GAS f32x4* xr0 = (GAS f32x4*)xres_row(F, m0) + F.lane; GAS f32x4* xr1 = (GAS f32x4*)xres_row(F, m1c) + F.lane;
        f32x4 v[4], w[4]; float s0 = 0.f, s1 = 0.f;
#pragma unroll
        for (int j = 0; j < 4; ++j) { v[j] = xr0[64 * j]; w[j] = xr1[64 * j]; }
#pragma unroll
        for (int j = 0; j < 4; ++j) { s0 += (v[j].x + v[j].y) + (v[j].z + v[j].w); s1 += (w[j].x + w[j].y) + (w[j].z + w[j].w); }
        const float mean0 = wave_sum(s0) * (1.f / D), mean1 = wave_sum(s1) * (1.f / D); float q0 = 0.f, q1 = 0.f;
#pragma unroll
        for (int j = 0; j < 4; ++j) { v[j] = v[j] - mean0; w[j] = w[j] - mean1; q0 += (v[j].x * v[j].x + v[j].y * v[j].y) + (v[j].z * v[j].z + v[j].w * v[j].w); q1 += (w[j].x * w[j].x + w[j].y * w[j].y) + (w[j].z * w[j].z + w[j].w * w[j].w); }
        const float r0 = 1.f / sqrtf(wave_sum(q0) * (1.f / D) + NORM_EPS), r1 = 1.f / sqrtf(wave_sum(q1) * (1.f / D) + NORM_EPS);
#pragma unroll
        for (int j = 0; j < 4; ++j) { const f32x4 g4 = gg[64 * j], b4 = bb[64 * j]; v[j] = v[j] * r0 * g4 + b4; w[j] = w[j] * r1 * g4 + b4; xr0[64 * j] = (m0 >= TL) ? v[j] * DN_ALPHA : v[j]; if (has1) xr1[64 * j] = (m1 >= TL) ? w[j] * DN_ALPHA : w[j]; }
        if (next_layer >= 0) { store_mod_bf16(F, v, m0, next_layer, next_part_sh); if (has1) store_mod_bf16(F, w, m1, next_layer, next_part_sh); }
    }
}
__device__ __forceinline__ void ph_mla_norm(Frame& F) {
    const int gw = F.vcu * NWAVES + F.wave, NGW = F.G * NWAVES;
    bf16* CQ = (bf16*)(ws_(F) + WS_CQKV); bf16* Kb = (bf16*)(ws_(F) + WS_KB); const float* rope = (const float*)(ws_(F) + WS_ROPE);
    for (int m = gw; m < TT; m += NGW) {
        bf16* row = CQ + (size_t)m * CQKV_LD;
        {
            float x[8]; float ss = 0.f; const bool act = F.lane < 48;
            if (act) { unpack8(*(const GAS v4u*)(row + 8 * F.lane), x);
#pragma unroll
                for (int j = 0; j < 8; ++j) ss += x[j] * x[j]; }
            const float sc = 1.f / sqrtf(wave_sum(ss) * (1.f / 384.f) + NORM_EPS);
            if (act) {
#pragma unroll
                for (int j = 0; j < 8; ++j) x[j] = x[j] * sc * inp(F, 13)[8 * F.lane + j];
                *(GAS v4u*)(row + 8 * F.lane) = pack8(x); }
        }
        {
            float x[8]; float ss = 0.f; const bool act = F.lane < 32;
            if (act) { unpack8(*(const GAS v4u*)(row + 384 + 8 * F.lane), x);
#pragma unroll
                for (int j = 0; j < 8; ++j) ss += x[j] * x[j]; }
            const float sc = 1.f / sqrtf(wave_sum(ss) * (1.f / 256.f) + NORM_EPS);
            if (act) {
#pragma unroll
                for (int j = 0; j < 8; ++j) x[j] = x[j] * sc * inp(F, 15)[8 * F.lane + j];
                *(GAS v4u*)(row + 384 + 8 * F.lane) = pack8(x); }
        }
        {
            const bool isctx = m >= TL; const int b = isctx ? ((m - TL) >> 8) : (m >> 13), t = isctx ? ((m - TL) & 255) : (m & 8191), tk = isctx ? t : CTXL + t;
            const int h = F.lane >> 3, i0 = (F.lane & 7) * 4;
            const v2u w = *(const GAS v2u*)(row + 640 + i0);
            float x[4] = {bflo(w.x), bfhi(w.x), bflo(w.y), bfhi(w.y)}, o[4];
#pragma unroll
            for (int j = 0; j < 4; ++j) { const float p = __shfl_xor(x[j], 2); const int idx = i0 + j, a = idx >> 4, half = (idx >> 3) & 1, f = idx & 7, pos = a ? (t & 63) : (t >> 6);
                const float cs = rope[2 * (pos * 8 + f)], sn = rope[2 * (pos * 8 + f) + 1];
                o[j] = isctx ? x[j] : (half ? x[j] * cs + p * sn : x[j] * cs - p * sn); }
            v2u ow; ow.x = pk2(o[0], o[1]); ow.y = pk2(o[2], o[3]);
            *(GAS v2u*)(Kb + ((size_t)(b * 8 + h) * TQK + tk) * 96 + 64 + i0) = ow;
        }
    }
}
__device__ __forceinline__ void ph_convgate(Frame& F, int nrows, int layer, int grp) {
    const int gw = F.vcu * NWAVES + F.wave, NGW = F.G * NWAVES;
    const bf16* H = (const bf16*)(ws_(F) + WS_H); bf16* HG = (bf16*)(ws_(F) + WS_HG);
    const float* cw = inp(F, 9) + (size_t)layer * 3 * FFH + grp * FFG; const float* cb = inp(F, 10) + (size_t)layer * FFH + grp * FFG;
    for (int m = gw; m < nrows; m += NGW) {
        const bool isctx = m >= TL; const int t = isctx ? ((m - TL) & 255) : (m & 8191), len = isctx ? CTXL : SEQ;
        const bool hp = t > 0, hn = t < len - 1;
#pragma unroll
        for (int ci = 0; ci < 3; ++ci) { const int ch = F.lane + 64 * ci; if (ch >= FFG / 8) break;
            const int j0 = 8 * ch; float ac[8], ap[8], an[8], gt[8], o[8];
            unpack8(*(const GAS v4u*)(H + (size_t)m * FFH + j0), ac); unpack8(*(const GAS v4u*)(H + (size_t)m * FFH + FFG + j0), gt);
            if (hp) unpack8(*(const GAS v4u*)(H + (size_t)(m - 1) * FFH + j0), ap); else {
#pragma unroll
                for (int j = 0; j < 8; ++j) ap[j] = 0.f; }
            if (hn) unpack8(*(const GAS v4u*)(H + (size_t)(m + 1) * FFH + j0), an); else {
#pragma unroll
                for (int j = 0; j < 8; ++j) an[j] = 0.f; }
#pragma unroll
            for (int j = 0; j < 8; ++j) { const float cv = cb[j0 + j] + cw[j0 + j] * ap[j] + cw[FFH + j0 + j] * ac[j] + cw[2 * FFH + j0 + j] * an[j]; o[j] = siluf_(cv) * gt[j]; }
            *(GAS v4u*)(HG + (size_t)m * FFG + j0) = pack8(o);
        }
    }
}
__device__ __forceinline__ void ph_hg_gate(Frame& F) {
    const int gw = F.vcu * NWAVES + F.wave, NGW = F.G * NWAVES;
    bf16* O = (bf16*)(ws_(F) + WS_O); const bf16* G = (const bf16*)(ws_(F) + WS_G);
    const int c0 = 16 * F.lane; float ng[16];
#pragma unroll
    for (int j = 0; j < 16; ++j) ng[j] = inp(F, 29)[(c0 + j) & 127];
    for (int m = gw; m < TL; m += NGW) {
        float o[16], g[16]; unpack8(*(const GAS v4u*)(O + (size_t)m * D + c0), o); unpack8(*(const GAS v4u*)(O + (size_t)m * D + c0 + 8), o + 8);
        unpack8(*(const GAS v4u*)(G + (size_t)m * D + c0), g); unpack8(*(const GAS v4u*)(G + (size_t)m * D + c0 + 8), g + 8);
        float ss = 0.f;
#pragma unroll
        for (int j = 0; j < 16; ++j) ss += o[j] * o[j];
        ss += __shfl_xor(ss, 1); ss += __shfl_xor(ss, 2); ss += __shfl_xor(ss, 4);
        const float sc = 1.f / sqrtf(ss * (1.f / 128.f) + NORM_EPS);
#pragma unroll
        for (int j = 0; j < 16; ++j) o[j] = o[j] * sc * ng[j] * siluf_(g[j]);
        *(GAS v4u*)(O + (size_t)m * D + c0) = pack8(o); *(GAS v4u*)(O + (size_t)m * D + c0 + 8) = pack8(o + 8);
    }
}

typedef short bf16x8_t __attribute__((ext_vector_type(8)));
typedef float f32x16 __attribute__((ext_vector_type(16)));
__device__ __forceinline__ int crow(int r, int hi) { return (r & 3) + 8 * (r >> 2) + 4 * hi; }
constexpr int NCH = TT / 64;
__device__ __forceinline__ void p0_s5_tables(Frame& F) {
    LAS unsigned char* L = F.lds + RING_OFF;
    LAS double* lam = (LAS double*)L;
    LAS float* bb = (LAS float*)(L + 1024);
    LAS float* cc = (LAS float*)(L + 1024 + 8192);
    LAS float* pw = (LAS float*)(L + 1024 + 16384);
    unsigned char* ws = ws_(F);
    for (int item = (int)blockIdx.x - 192; item >= 0 && item < 64; item += F.G) {
        const int g = item >> 1, d = item & 1;
        __syncthreads();
        if (F.tid < 64) { const int n = F.tid, pi = (d * 32 + g) * 64 + n;
            const double lre = inp(F, 17)[pi], lim = inp(F, 18)[pi], dt = exp((double)inp(F, 19)[d * 32 + g]);
            const double mag = exp(lre * dt), are = mag * cos(lim * dt), aim = mag * sin(lim * dt), den = lre * lre + lim * lim, nr = are - 1.0;
            const double fr = (nr * lre + aim * lim) / den, fi = (aim * lre - nr * lim) / den;
            lam[2 * n] = lre * dt; lam[2 * n + 1] = lim * dt;
            for (int q = 0; q < 16; ++q) { const double br = inp(F, 20)[(size_t)pi * 16 + q], bi = inp(F, 21)[(size_t)pi * 16 + q];
                bb[(n * 16 + q) * 2] = (float)(fr * br - fi * bi); bb[(n * 16 + q) * 2 + 1] = (float)(fr * bi + fi * br); } }
        for (int i = F.tid; i < 1024; i += 512) { const int p = i >> 6, n = i & 63; cc[i * 2] = inp(F, 22)[((size_t)(d * 32 + g) * 16 + p) * 64 + n]; cc[i * 2 + 1] = inp(F, 23)[((size_t)(d * 32 + g) * 16 + p) * 64 + n]; }
        __syncthreads();
        for (int i = F.tid; i < 65 * 64; i += 512) { const int e = i >> 6, n = i & 63; const double m = exp((double)e * lam[2 * n]), ph = (double)e * lam[2 * n + 1];
            pw[2 * i] = (float)(m * cos(ph)); pw[2 * i + 1] = (float)(m * sin(ph)); }
        __syncthreads();
        { bf16* WF = (bf16*)(ws + WS_WF) + (size_t)g * 256 * 1024;
          for (int i = F.tid; i < 128 * 128; i += 512) { const int row = i >> 7, grp = i & 127, c = row >> 6, n = row & 63, sI = grp >> 1, q0 = (grp & 1) * 8, e = d ? sI : 63 - sI;
              const float pr = pw[(e * 64 + n) * 2], pim = pw[(e * 64 + n) * 2 + 1]; float o[8];
#pragma unroll
              for (int j = 0; j < 8; ++j) { const float br = bb[(n * 16 + q0 + j) * 2], bi = bb[(n * 16 + q0 + j) * 2 + 1]; o[j] = c ? (pr * bi + pim * br) : (pr * br - pim * bi); }
              *(GAS v4u*)(WF + (size_t)(d * 128 + row) * 1024 + sI * 16 + q0) = pack8(o); } }
        { bf16* WC = (bf16*)(ws + WS_WC) + (size_t)g * 1024 * 256;
          for (int i = F.tid; i < 1024 * 16; i += 512) { const int row = i >> 4, grp = i & 15, t = row >> 4, p = row & 15, c = grp >> 3, n0 = (grp & 7) * 8, ex = d ? 64 - t : t + 1; float o[8];
#pragma unroll
              for (int j = 0; j < 8; ++j) { const int n = n0 + j; const float pr = pw[(ex * 64 + n) * 2], pim = pw[(ex * 64 + n) * 2 + 1], cr = cc[(p * 64 + n) * 2], ci = cc[(p * 64 + n) * 2 + 1];
                  o[j] = c ? -(cr * pim + ci * pr) : (cr * pr - ci * pim); }
              *(GAS v4u*)(WC + (size_t)row * 256 + d * 128 + c * 64 + n0) = pack8(o); } }
        { bf16* TP = (bf16*)(ws + WS_TOEP) + (size_t)g * 127 * 256; float* T0 = (float*)(ws + WS_T0) + (size_t)(g * 2 + d) * 256;
          for (int i = F.tid; i < 64 * 16; i += 512) { const int tau = i >> 4, p = i & 15; float acc[16];
#pragma unroll
              for (int q = 0; q < 16; ++q) acc[q] = 0.f;
              for (int n = 0; n < 64; ++n) { const float pr = pw[(tau * 64 + n) * 2], pim = pw[(tau * 64 + n) * 2 + 1], cr = cc[(p * 64 + n) * 2], ci = cc[(p * 64 + n) * 2 + 1];
                  const float tr = cr * pr - ci * pim, ti = cr * pim + ci * pr;
                  const LAS f32x4* bq = (const LAS f32x4*)(bb + n * 32);
#pragma unroll
                  for (int q4 = 0; q4 < 8; ++q4) { const f32x4 v = bq[q4]; acc[2 * q4] += tr * v.x - ti * v.y; acc[2 * q4 + 1] += tr * v.z - ti * v.w; } }
              if (tau == 0) {
#pragma unroll
                  for (int q = 0; q < 16; ++q) T0[p * 16 + q] = acc[q]; }
              else { bf16* o = TP + (size_t)(d ? 63 - tau : 63 + tau) * 256 + p * 16; *(GAS v4u*)o = pack8(acc); *(GAS v4u*)(o + 8) = pack8(acc + 8); } } }
        if (F.tid < 64) { float* A64 = (float*)(ws + WS_A64) + (size_t)((g * 2 + d) * 64 + F.tid) * 2; A64[0] = pw[(64 * 64 + F.tid) * 2]; A64[1] = pw[(64 * 64 + F.tid) * 2 + 1]; }
    }
    __syncthreads();
}
__device__ __forceinline__ void ph_s5_finals(Frame& F) {
    const int lane = F.lane, r32 = lane & 31, hh = lane >> 5, wave = F.wave;
    unsigned char* ws = ws_(F);
    for (int u = blockIdx.x; u < 288; u += F.G) {
        const int g = u / 9, nb = u % 9; int chunk = nb * 32 + r32; const bool valid = chunk < NCH; if (!valid) chunk = NCH - 1;
        const bf16* ub = (const bf16*)(ws + WS_UG) + ((size_t)g * TT + (size_t)chunk * 64) * 16 + 8 * hh;
        const bf16* wf = (const bf16*)(ws + WS_WF) + ((size_t)(g * 256 + 32 * wave + r32)) * 1024 + 8 * hh;
        f32x16 acc;
#pragma unroll
        for (int r = 0; r < 16; ++r) acc[r] = 0.f;
#pragma unroll 16
        for (int sI = 0; sI < 64; ++sI) { const bf16x8_t a = *(const GAS bf16x8_t*)(wf + 16 * sI), b = *(const GAS bf16x8_t*)(ub + 16 * sI); acc = __builtin_amdgcn_mfma_f32_32x32x16_bf16(a, b, acc, 0, 0, 0); }
        if (valid) { float* fo = (float*)(ws + WS_FIN) + ((size_t)g * NCH + chunk) * 256 + 32 * wave + 4 * hh;
#pragma unroll
            for (int k = 0; k < 4; ++k) *(GAS f32x4*)(fo + 8 * k) = (f32x4){acc[4 * k], acc[4 * k + 1], acc[4 * k + 2], acc[4 * k + 3]}; }
    }
}
__device__ __forceinline__ int s5_chunk_of(int step, int d, int b) { return step < 4 ? 256 + 4 * b + (d ? 3 - step : step) : 128 * b + (d ? 127 - (step - 4) : step - 4); }
__device__ __forceinline__ void ph_s5_carry(Frame& F) {
    if (F.wave >= 3) return;
    unsigned char* ws = ws_(F);
    for (int item = ((int)F.G - 1 - (int)blockIdx.x) * 3 + F.wave; item < 128; item += 3 * F.G) {
        const int g = item >> 2, d = (item >> 1) & 1, b = item & 1, n = F.lane;
        const float a_r = ((const float*)(ws + WS_A64))[((g * 2 + d) * 64 + n) * 2], a_i = ((const float*)(ws + WS_A64))[((g * 2 + d) * 64 + n) * 2 + 1];
        const float* Fb = (const float*)(ws + WS_FIN) + (size_t)g * NCH * 256 + d * 128 + n; bf16* Sb = (bf16*)(ws + WS_SIN) + (size_t)g * NCH * 256 + d * 128 + n;
        float sr = 0.f, si = 0.f;
        for (int s0 = 0; s0 < 132; s0 += 12) {
            float fr[12], fi[12];
#pragma unroll
            for (int j = 0; j < 12; ++j) { const int c = s5_chunk_of(s0 + j, d, b); fr[j] = Fb[(size_t)c * 256]; fi[j] = Fb[(size_t)c * 256 + 64]; }
#pragma unroll
            for (int j = 0; j < 12; ++j) { const int c = s5_chunk_of(s0 + j, d, b); Sb[(size_t)c * 256] = (bf16)f2bf(sr); Sb[(size_t)c * 256 + 64] = (bf16)f2bf(si);
                const float nr = a_r * sr - a_i * si + fr[j], ni = a_r * si + a_i * sr + fi[j]; sr = nr; si = ni; }
        }
    }
}
constexpr int TP_PITCH = 48;
__device__ __forceinline__ void ph_s5_out(Frame& F) {
    LAS unsigned char* L = F.lds + RING_OFF;
    const int lane = F.lane, r32 = lane & 31, hh = lane >> 5, wave = F.wave, tid = F.tid;
    unsigned char* ws = ws_(F);
    for (int u = blockIdx.x; u < 288; u += F.G) {
        const int g = u / 9, nb = u % 9; int chunk = nb * 32 + r32; const bool valid = chunk < NCH; if (!valid) chunk = NCH - 1;
        __syncthreads();
        { const GAS v4u* tp = (const GAS v4u*)((const bf16*)(ws + WS_TOEP) + (size_t)g * 127 * 256); const float* t0 = (const float*)(ws + WS_T0) + (size_t)g * 512;
          for (int c = tid; c < 127 * 32; c += 512) { const int di = c >> 5, p = (c >> 1) & 15, half = c & 1; v4u v;
              if (di == 63) { float o[8];
#pragma unroll
                  for (int j = 0; j < 8; ++j) o[j] = t0[p * 16 + half * 8 + j] + t0[256 + p * 16 + half * 8 + j];
                  v = pack8(o); }
              else v = tp[c];
              *(LAS v4u*)(L + (di * 16 + p) * TP_PITCH + half * 16) = v; } }
        __syncthreads();
        const bf16* ub = (const bf16*)(ws + WS_UG) + ((size_t)g * TT + (size_t)chunk * 64) * 16 + 8 * hh;
        f32x16 acc[4];
#pragma unroll
        for (int i = 0; i < 4; ++i)
#pragma unroll
            for (int r = 0; r < 16; ++r) acc[i][r] = 0.f;
        const LAS unsigned char* tl = L + ((63 + 2 * wave + (r32 >> 4)) * 16 + (r32 & 15)) * TP_PITCH + hh * 16;
#pragma unroll 1
        for (int s0 = 0; s0 < 64; s0 += 16) {
            bf16x8_t bq[16];
#pragma unroll
            for (int e = 0; e < 16; ++e) bq[e] = *(const GAS bf16x8_t*)(ub + 16 * (s0 + e));
#pragma unroll
            for (int e = 0; e < 16; ++e) { const int sI = s0 + e; const bf16x8_t b = bq[e];
#pragma unroll
            for (int i = 0; i < 4; ++i) { const bf16x8_t a = *(const LAS bf16x8_t*)(tl + (16 * i - sI) * 16 * TP_PITCH); acc[i] = __builtin_amdgcn_mfma_f32_32x32x16_bf16(a, b, acc[i], 0, 0, 0); }
            }
        }
        { const bf16* sb = (const bf16*)(ws + WS_SIN) + ((size_t)g * NCH + chunk) * 256 + 8 * hh;
          const bf16* wc = (const bf16*)(ws + WS_WC) + ((size_t)g * 1024 + 32 * wave + r32) * 256 + 8 * hh;
#pragma unroll 4
          for (int kk = 0; kk < 16; ++kk) {
              const bf16x8_t b = *(const GAS bf16x8_t*)(sb + 16 * kk);
#pragma unroll
              for (int i = 0; i < 4; ++i) { const bf16x8_t a = *(const GAS bf16x8_t*)(wc + (size_t)(256 * i) * 256 + 16 * kk); acc[i] = __builtin_amdgcn_mfma_f32_32x32x16_bf16(a, b, acc[i], 0, 0, 0); }
          } }
        if (valid) {
            const float* dsk = inp(F, 24) + 16 * g;
#pragma unroll
            for (int i = 0; i < 4; ++i)
#pragma unroll
                for (int k = 0; k < 4; ++k) { const int tloc = 2 * (wave + 8 * i) + (k >> 1), p0 = 8 * (k & 1) + 4 * hh; const size_t m = (size_t)chunk * 64 + tloc;
                    const v2u uw = *(const GAS v2u*)((const bf16*)(ws + WS_UG) + ((size_t)g * TT + m) * 16 + p0);
                    const float y0 = gelu_tanh(acc[i][4 * k] + dsk[p0] * bflo(uw.x)), y1 = gelu_tanh(acc[i][4 * k + 1] + dsk[p0 + 1] * bfhi(uw.x));
                    const float y2 = gelu_tanh(acc[i][4 * k + 2] + dsk[p0 + 2] * bflo(uw.y)), y3 = gelu_tanh(acc[i][4 * k + 3] + dsk[p0 + 3] * bfhi(uw.y));
                    v2u zw; zw.x = pk2(y0, y1); zw.y = pk2(y2, y3);
                    *(GAS v2u*)((bf16*)(ws + WS_Z) + m * 512 + 16 * g + p0) = zw; }
        }
    }
}

__device__ __forceinline__ bf16x8_t pack_frag(const f32x16& p, int base) {
    v4u w; w.x = pg8::cvt_pk_bf16(p[base + 0], p[base + 1]); w.y = pg8::cvt_pk_bf16(p[base + 2], p[base + 3]); w.z = pg8::cvt_pk_bf16(p[base + 4], p[base + 5]); w.w = pg8::cvt_pk_bf16(p[base + 6], p[base + 7]);
    return __builtin_bit_cast(bf16x8_t, w);
}
constexpr int AT_KP = 208, AT_VP = 144;
constexpr int AT_KB = 64 * AT_KP, AT_VB = 64 * AT_VP;
constexpr int AT_K0 = 0, AT_V0 = 2 * AT_KB, AT_WS = 2 * AT_KB + 2 * AT_VB;
__device__ __forceinline__ void ph_attn(Frame& F) {
    LAS unsigned char* L = F.lds + RING_OFF;
    const int lane = F.lane, r32 = lane & 31, hi = lane >> 5, wave = F.wave, tid = F.tid;
    volatile LAS float* wsf = (volatile LAS float*)(L + AT_WS) + wave * 32;
    const bf16* Qb = (const bf16*)(ws_(F) + WS_QB); const bf16* Kb = (const bf16*)(ws_(F) + WS_KB); const bf16* Vt = (const bf16*)(ws_(F) + WS_VB);
    bf16* MIX = (bf16*)(ws_(F) + WS_MIX);
    const int kc0 = tid, kc1 = tid + 512;
    const int kl0 = (kc0 / 12) * AT_KP + (kc0 % 12) * 16, kl1 = (kc1 / 12) * AT_KP + (kc1 % 12) * 16, vl = (tid >> 3) * AT_VP + (tid & 7) * 16;
    const bool k1act = tid < 256;
    for (int it = 0; it < 3; ++it) {
        int u; if (it < 2) u = it * 256 + F.vcu; else { if (F.vcu >= 16) break; u = 512 + F.vcu; }
        int b, h, tq0, NT, m0;
        if (u < 512) { b = u >> 8; h = (u >> 5) & 7; tq0 = (u & 31) * 256; NT = TQK / 64; m0 = b * SEQ + tq0; }
        else { const int uc = u - 512; b = uc >> 3; h = uc & 7; tq0 = SEQ; NT = CTXL / 64; m0 = TL + b * CTXL; }
        const size_t bh = (size_t)(b * 8 + h);
        const GAS v4u* Kg = (const GAS v4u*)(Kb + bh * TQK * 96);
        const GAS v4u* Vg = (const GAS v4u*)(Vt + bh * (TQK / 64) * 4096);
        bf16x8_t qf[6];
        { const bf16* qp = Qb + (bh * TQK + tq0 + wave * 32 + r32) * 96 + hi * 8;
#pragma unroll
          for (int ks = 0; ks < 6; ++ks) qf[ks] = *(const GAS bf16x8_t*)(qp + ks * 16); }
        f32x16 o0, o1;
#pragma unroll
        for (int r = 0; r < 16; ++r) { o0[r] = 0.f; o1[r] = 0.f; }
        float m_run = -1e30f, l_run = 0.f;
        __syncthreads();
        { const v4u a = Kg[kc0]; v4u c = (v4u){0u, 0u, 0u, 0u}; if (k1act) c = Kg[kc1]; const v4u v = Vg[tid];
          *(LAS v4u*)(L + AT_K0 + kl0) = a; if (k1act) *(LAS v4u*)(L + AT_K0 + kl1) = c; *(LAS v4u*)(L + AT_V0 + vl) = v; }
        __syncthreads();
        for (int t = 0; t < NT; ++t) {
            const int cur = t & 1, nxt = cur ^ 1; const bool more = (t + 1 < NT);
            v4u na = (v4u){0u, 0u, 0u, 0u}, nc = (v4u){0u, 0u, 0u, 0u}, nv = (v4u){0u, 0u, 0u, 0u};
            if (more) { na = Kg[(size_t)(t + 1) * 768 + kc0]; if (k1act) nc = Kg[(size_t)(t + 1) * 768 + kc1]; nv = Vg[(size_t)(t + 1) * 512 + tid]; }
            const LAS unsigned char* Kl = L + AT_K0 + cur * AT_KB + r32 * AT_KP + hi * 16;
            const LAS unsigned char* Vl = L + AT_V0 + cur * AT_VB + r32 * AT_VP + hi * 16;
            f32x16 p0, p1;
#pragma unroll
            for (int r = 0; r < 16; ++r) { p0[r] = 0.f; p1[r] = 0.f; }
#pragma unroll
            for (int ks = 0; ks < 6; ++ks) {
                const bf16x8_t ka = *(const LAS bf16x8_t*)(Kl + ks * 32), kb = *(const LAS bf16x8_t*)(Kl + 32 * AT_KP + ks * 32);
                p0 = __builtin_amdgcn_mfma_f32_32x32x16_bf16(ka, qf[ks], p0, 0, 0, 0);
                p1 = __builtin_amdgcn_mfma_f32_32x32x16_bf16(kb, qf[ks], p1, 0, 0, 0);
            }
            float mt = fmaxf(p0[0], p1[0]);
#pragma unroll
            for (int r = 1; r < 16; ++r) mt = fmaxf(mt, fmaxf(p0[r], p1[r]));
            mt = fmaxf(mt, __shfl_xor(mt, 32));
            const bool need = mt > m_run + 8.0f;
            if (__any(need)) {
                const float mn = need ? mt : m_run, alpha = __builtin_amdgcn_exp2f(m_run - mn);
                l_run *= alpha; m_run = mn;
                if (hi == 0) wsf[r32] = alpha;
#pragma unroll
                for (int r = 0; r < 16; ++r) { const float a = wsf[crow(r, hi)]; o0[r] *= a; o1[r] *= a; }
            }
            float sum = 0.f;
#pragma unroll
            for (int r = 0; r < 16; ++r) { p0[r] = __builtin_amdgcn_exp2f(p0[r] - m_run); p1[r] = __builtin_amdgcn_exp2f(p1[r] - m_run); sum += p0[r] + p1[r]; }
            l_run += sum;
            const bf16x8_t pa0 = pack_frag(p0, 0), pa1 = pack_frag(p0, 8), pa2 = pack_frag(p1, 0), pa3 = pack_frag(p1, 8);
            {
                const bf16x8_t v00 = *(const LAS bf16x8_t*)(Vl + 0), v01 = *(const LAS bf16x8_t*)(Vl + 32), v02 = *(const LAS bf16x8_t*)(Vl + 64), v03 = *(const LAS bf16x8_t*)(Vl + 96);
                o0 = __builtin_amdgcn_mfma_f32_32x32x16_bf16(pa0, v00, o0, 0, 0, 0); o0 = __builtin_amdgcn_mfma_f32_32x32x16_bf16(pa1, v01, o0, 0, 0, 0);
                o0 = __builtin_amdgcn_mfma_f32_32x32x16_bf16(pa2, v02, o0, 0, 0, 0); o0 = __builtin_amdgcn_mfma_f32_32x32x16_bf16(pa3, v03, o0, 0, 0, 0);
                const bf16x8_t v10 = *(const LAS bf16x8_t*)(Vl + 32 * AT_VP + 0), v11 = *(const LAS bf16x8_t*)(Vl + 32 * AT_VP + 32), v12 = *(const LAS bf16x8_t*)(Vl + 32 * AT_VP + 64), v13 = *(const LAS bf16x8_t*)(Vl + 32 * AT_VP + 96);
                o1 = __builtin_amdgcn_mfma_f32_32x32x16_bf16(pa0, v10, o1, 0, 0, 0); o1 = __builtin_amdgcn_mfma_f32_32x32x16_bf16(pa1, v11, o1, 0, 0, 0);
                o1 = __builtin_amdgcn_mfma_f32_32x32x16_bf16(pa2, v12, o1, 0, 0, 0); o1 = __builtin_amdgcn_mfma_f32_32x32x16_bf16(pa3, v13, o1, 0, 0, 0);
            }
            if (more) { *(LAS v4u*)(L + AT_K0 + nxt * AT_KB + kl0) = na; if (k1act) *(LAS v4u*)(L + AT_K0 + nxt * AT_KB + kl1) = nc; *(LAS v4u*)(L + AT_V0 + nxt * AT_VB + vl) = nv; }
            __syncthreads();
        }
        l_run += __shfl_xor(l_run, 32);
        if (hi == 0) wsf[r32] = 1.0f / l_run;
#pragma unroll
        for (int r = 0; r < 16; ++r) { const int q = crow(r, hi); const float inv = wsf[q];
            bf16* op = MIX + (size_t)(m0 + wave * 32 + q) * D + h * 64 + r32;
            op[0] = (bf16)f2bf(o0[r] * inv); op[32] = (bf16)f2bf(o1[r] * inv); }
    }
}

constexpr int HG_QT = 0, HG_KT = 17408, HG_KH = 34816, HG_VT = 53248, HG_ST = 71680, HG_DEC = 106496, HG_TOT = 107008;
constexpr int HG_NSC = 17;
constexpr size_t WS_SD = 231 * MiB;
constexpr size_t WS_DECS = WS_SD + 18 * MiB;
static_assert(WS_DECS + 32 * 17 * 128 * 4 <= WS_END, "hgrn ws");
template <bool OUT>
__device__ __forceinline__ void hgrn_pass(Frame& F, int b, int h, int dir, int sc, f32x16 (&st)[2], float& dsum) {
    LAS unsigned char* L = F.lds + RING_OFF;
    unsigned char* ws = ws_(F);
    const int tid = F.tid, lane = F.lane, r32 = lane & 31, hh = lane >> 5, wave = F.wave;
    const int k = tid & 127, tg = tid >> 7;
    const int nch = sc == 0 ? 4 : 8; const size_t rowbase = sc == 0 ? (size_t)TL + b * CTXL : (size_t)b * SEQ + (size_t)(sc - 1) * 512;
    const bf16* QF = (const bf16*)(ws + WS_QFFI);
    const float lb = ((const float*)(ws + WS_LBV))[dir * 1024 + h * 128 + k];
    const int colf = 1024 * (1 + dir) + h * 128 + k, colq = h * 128 + k, colv = 3072 + h * 128 + k;
    const int dvb = wave & 3, jb = wave >> 2;
    bf16 rq[16], rf[16], rv[16];
#define HG_LOAD(ci) do { const int cc_ = dir ? nch - 1 - (ci) : (ci); const int tl0_ = dir ? 63 - 16 * tg : 16 * tg; \
        const bf16* pf_ = QF + (rowbase + 64 * cc_ + tl0_) * 4096 + colf; const bf16* pv_ = pf_ + (colv - colf); const bf16* pq_ = pf_ + (colq - colf); const long stp_ = dir ? -4096 : 4096; \
        _Pragma("unroll") for (int jj = 0; jj < 16; ++jj) { rf[jj] = *pf_; rv[jj] = *pv_; if (OUT) rq[jj] = *pq_; pf_ += stp_; pv_ += stp_; pq_ += stp_; asm volatile("" : "+v"(pf_), "+v"(pv_), "+v"(pq_)); } } while (0)
    HG_LOAD(0);
    for (int ci = 0; ci < nch; ++ci) {
        const int cc = dir ? nch - 1 - ci : ci;
        float cum[16], kk[16];
        { float run = 0.f;
#pragma unroll
          for (int jj = 0; jj < 16; ++jj) { const float f = lb + (1.f - lb) * sigmoidf_(bf2f(rf[jj])); run += __log2f(f); cum[jj] = run; kk[jj] = 1.f - f; }
          ((LAS float*)(L + HG_TOT))[tg * 128 + k] = run; }
        __syncthreads();
        { const LAS float* tot = (const LAS float*)(L + HG_TOT) + k; const float t0 = tot[0], t1 = tot[128], t2 = tot[256], t3 = tot[384];
          const float pre = tg == 0 ? 0.f : (tg == 1 ? t0 : (tg == 2 ? t0 + t1 : t0 + t1 + t2)), total = (t0 + t1) + (t2 + t3);
          if (tg == 0) { ((LAS float*)(L + HG_DEC))[k] = __builtin_amdgcn_exp2f(total); dsum += total; }
#define HG_KH(jj) (kk[jj] * __builtin_amdgcn_exp2f(total - (pre + cum[jj])))
#define HG_PKV(a, b_) ((unsigned)rv[a] | ((unsigned)rv[b_] << 16))
          if (OUT) {
#pragma unroll
              for (int jj = 0; jj < 16; ++jj) { const float c = pre + cum[jj]; const int j = 16 * tg + jj;
                  *(LAS bf16*)(L + HG_QT + j * 272 + k * 2) = (bf16)f2bf(bf2f(rq[jj]) * __builtin_amdgcn_exp2f(c)); *(LAS bf16*)(L + HG_KT + j * 272 + k * 2) = (bf16)f2bf(kk[jj] * __builtin_amdgcn_exp2f(-c)); } }
          v4u w0, w1;
          w0.x = pk2(HG_KH(0), HG_KH(1)); w0.y = pk2(HG_KH(2), HG_KH(3)); w0.z = pk2(HG_KH(8), HG_KH(9)); w0.w = pk2(HG_KH(10), HG_KH(11));
          w1.x = pk2(HG_KH(4), HG_KH(5)); w1.y = pk2(HG_KH(6), HG_KH(7)); w1.z = pk2(HG_KH(12), HG_KH(13)); w1.w = pk2(HG_KH(14), HG_KH(15));
          *(LAS v4u*)(L + HG_KH + k * 144 + tg * 32) = w0; *(LAS v4u*)(L + HG_KH + k * 144 + tg * 32 + 16) = w1;
          w0.x = HG_PKV(0, 1); w0.y = HG_PKV(2, 3); w0.z = HG_PKV(8, 9); w0.w = HG_PKV(10, 11);
          w1.x = HG_PKV(4, 5); w1.y = HG_PKV(6, 7); w1.z = HG_PKV(12, 13); w1.w = HG_PKV(14, 15);
          *(LAS v4u*)(L + HG_VT + k * 144 + tg * 32) = w0; *(LAS v4u*)(L + HG_VT + k * 144 + tg * 32 + 16) = w1; }
#undef HG_KH
#undef HG_PKV
        if (ci + 1 < nch) HG_LOAD(ci + 1);
        __syncthreads();
        if (OUT) {
            f32x16 oacc;
#pragma unroll
            for (int r = 0; r < 16; ++r) oacc[r] = 0.f;
            const LAS unsigned char* qrow = L + HG_QT + (32 * jb + r32) * 272 + hh * 16;
            const LAS unsigned char* srow = L + HG_ST + (32 * dvb + r32) * 272 + hh * 16;
            const LAS unsigned char* vrow = L + HG_VT + (32 * dvb + r32) * 144 + hh * 16;
#pragma unroll
            for (int ks = 0; ks < 8; ++ks) oacc = __builtin_amdgcn_mfma_f32_32x32x16_bf16(*(const LAS bf16x8_t*)(qrow + ks * 32), *(const LAS bf16x8_t*)(srow + ks * 32), oacc, 0, 0, 0);
            {
                f32x16 at;
#pragma unroll
                for (int r = 0; r < 16; ++r) at[r] = 0.f;
                const LAS unsigned char* krow = L + HG_KT + r32 * 272 + hh * 16;
#pragma unroll
                for (int ks = 0; ks < 8; ++ks) at = __builtin_amdgcn_mfma_f32_32x32x16_bf16(*(const LAS bf16x8_t*)(krow + ks * 32), *(const LAS bf16x8_t*)(qrow + ks * 32), at, 0, 0, 0);
                if (jb == 0) {
#pragma unroll
                    for (int r = 0; r < 16; ++r) if (crow(r, hh) > r32) at[r] = 0.f; }
                oacc = __builtin_amdgcn_mfma_f32_32x32x16_bf16(pack_frag(at, 0), *(const LAS bf16x8_t*)(vrow + 0), oacc, 0, 0, 0);
                oacc = __builtin_amdgcn_mfma_f32_32x32x16_bf16(pack_frag(at, 8), *(const LAS bf16x8_t*)(vrow + 32), oacc, 0, 0, 0);
            }
            if (jb == 1) {
                f32x16 at;
#pragma unroll
                for (int r = 0; r < 16; ++r) at[r] = 0.f;
                const LAS unsigned char* krow = L + HG_KT + (32 + r32) * 272 + hh * 16;
#pragma unroll
                for (int ks = 0; ks < 8; ++ks) at = __builtin_amdgcn_mfma_f32_32x32x16_bf16(*(const LAS bf16x8_t*)(krow + ks * 32), *(const LAS bf16x8_t*)(qrow + ks * 32), at, 0, 0, 0);
#pragma unroll
                for (int r = 0; r < 16; ++r) if (crow(r, hh) > r32) at[r] = 0.f;
                oacc = __builtin_amdgcn_mfma_f32_32x32x16_bf16(pack_frag(at, 0), *(const LAS bf16x8_t*)(vrow + 64), oacc, 0, 0, 0);
                oacc = __builtin_amdgcn_mfma_f32_32x32x16_bf16(pack_frag(at, 8), *(const LAS bf16x8_t*)(vrow + 96), oacc, 0, 0, 0);
            }
            bf16* O = (bf16*)(ws + WS_O);
#pragma unroll
            for (int r = 0; r < 16; ++r) { const int j = 32 * jb + crow(r, hh), tl = dir ? 63 - j : j;
                bf16* op = O + (rowbase + 64 * cc + tl) * D + h * 128 + 32 * dvb + r32; float ov = oacc[r];
                if (dir) ov += bf2f(*op);
                *op = (bf16)f2bf(ov); }
        }
#pragma unroll
        for (int t = 0; t < 2; ++t) { const int dkb = 2 * (wave >> 2) + t;
#pragma unroll
            for (int q4 = 0; q4 < 4; ++q4) { const f32x4 dd = *(const LAS f32x4*)(L + HG_DEC + (32 * dkb + 8 * q4 + 4 * hh) * 4);
                st[t][4 * q4] *= dd[0]; st[t][4 * q4 + 1] *= dd[1]; st[t][4 * q4 + 2] *= dd[2]; st[t][4 * q4 + 3] *= dd[3]; }
            const LAS unsigned char* arow = L + HG_KH + (32 * dkb + r32) * 144 + hh * 16; const LAS unsigned char* vrow = L + HG_VT + (32 * dvb + r32) * 144 + hh * 16;
#pragma unroll
            for (int ks = 0; ks < 4; ++ks) st[t] = __builtin_amdgcn_mfma_f32_32x32x16_bf16(*(const LAS bf16x8_t*)(arow + ks * 32), *(const LAS bf16x8_t*)(vrow + ks * 32), st[t], 0, 0, 0); }
        __syncthreads();
        if (OUT && ci + 1 < nch) {
#pragma unroll
            for (int t = 0; t < 2; ++t) { const int dkb = 2 * (wave >> 2) + t;
#pragma unroll
                for (int q4 = 0; q4 < 4; ++q4) { v2u w; w.x = pk2(st[t][4 * q4], st[t][4 * q4 + 1]); w.y = pk2(st[t][4 * q4 + 2], st[t][4 * q4 + 3]);
                    *(LAS v2u*)(L + HG_ST + (32 * dvb + r32) * 272 + (32 * dkb + 8 * q4 + 4 * hh) * 2) = w; } }
        }
    }
#undef HG_LOAD
}
__device__ __forceinline__ void ph_hgrn_states(Frame& F) {
    unsigned char* ws = ws_(F);
    for (int item = blockIdx.x; item < 32 * HG_NSC; item += F.G) {
        const int chain = item / HG_NSC, sc = item % HG_NSC, b = chain >> 4, h = (chain >> 1) & 7, dir = chain & 1;
        f32x16 st[2];
#pragma unroll
        for (int t = 0; t < 2; ++t)
#pragma unroll
            for (int r = 0; r < 16; ++r) st[t][r] = 0.f;
        float dsum = 0.f;
        hgrn_pass<false>(F, b, h, dir, sc, st, dsum);
        bf16* sd = (bf16*)(ws + WS_SD) + ((size_t)(chain * HG_NSC + sc) * 8 + F.wave) * 2048 + F.lane;
#pragma unroll
        for (int t = 0; t < 2; ++t)
#pragma unroll
            for (int r = 0; r < 16; ++r) sd[(t * 16 + r) * 64] = (bf16)f2bf(st[t][r]);
        if (F.tid < 128) ((float*)(ws + WS_DECS))[(size_t)(chain * HG_NSC + sc) * 128 + F.tid] = dsum;
    }
}
__device__ __forceinline__ void ph_hgrn_out(Frame& F) {
    LAS unsigned char* L = F.lds + RING_OFF;
    unsigned char* ws = ws_(F);
    const int lane = F.lane, r32 = lane & 31, hh = lane >> 5, wave = F.wave, dvb = wave & 3;
    for (int item = blockIdx.x; item < 256; item += F.G) {
        const int b = item >> 7, h = (item >> 4) & 7, Lsc = item & 15, sc = Lsc + 1;
        for (int dir = 0; dir < 2; ++dir) {
            const int chain = (b * 8 + h) * 2 + dir;
            f32x16 st[2];
#pragma unroll
            for (int t = 0; t < 2; ++t)
#pragma unroll
                for (int r = 0; r < 16; ++r) st[t][r] = 0.f;
            const int npre = dir ? 1 + (16 - sc) : sc;
            for (int i = 0; i < npre; ++i) {
                const int sp = (i == 0) ? 0 : (dir ? 17 - i : i);
                const bf16* sd = (const bf16*)(ws + WS_SD) + ((size_t)(chain * HG_NSC + sp) * 8 + wave) * 2048 + lane;
                const float* dl = (const float*)(ws + WS_DECS) + (size_t)(chain * HG_NSC + sp) * 128;
#pragma unroll
                for (int t = 0; t < 2; ++t) { const int dkb = 2 * (wave >> 2) + t;
#pragma unroll
                    for (int q4 = 0; q4 < 4; ++q4) { const f32x4 dd = *(const GAS f32x4*)(dl + 32 * dkb + 8 * q4 + 4 * hh);
#pragma unroll
                        for (int e = 0; e < 4; ++e) st[t][4 * q4 + e] = __builtin_amdgcn_exp2f(dd[e]) * st[t][4 * q4 + e] + bf2f(sd[(t * 16 + 4 * q4 + e) * 64]); } }
            }
            __syncthreads();
#pragma unroll
            for (int t = 0; t < 2; ++t) { const int dkb = 2 * (wave >> 2) + t;
#pragma unroll
                for (int q4 = 0; q4 < 4; ++q4) { v2u w; w.x = pk2(st[t][4 * q4], st[t][4 * q4 + 1]); w.y = pk2(st[t][4 * q4 + 2], st[t][4 * q4 + 3]);
                    *(LAS v2u*)(L + HG_ST + (32 * dvb + r32) * 272 + (32 * dkb + 8 * q4 + 4 * hh) * 2) = w; } }
            float dsum = 0.f;
            hgrn_pass<true>(F, b, h, dir, sc, st, dsum);
            __syncthreads();
        }
    }
}

struct FInProj {
    bf16* cqkv; bf16* ug;
    __device__ __forceinline__ void operator()(int row, int col, f32x4 v0, f32x4 v1) const {
        v4u w; w.x = pg8::cvt_pk_bf16(v0[0], v0[1]); w.y = pg8::cvt_pk_bf16(v0[2], v0[3]); w.z = pg8::cvt_pk_bf16(v1[0], v1[1]); w.w = pg8::cvt_pk_bf16(v1[2], v1[3]);
        if (col < 672) *(GAS v4u*)(cqkv + (size_t)row * CQKV_LD + col) = w;
        else if (col < EVEN_IN) { const int c = col - 672; *(GAS v4u*)(ug + ((size_t)(c >> 4) * TT + row) * 16 + (c & 15)) = w; }
    }
};
struct FBf16 {
    bf16* o; int ld;
    __device__ __forceinline__ void operator()(int row, int col, f32x4 v0, f32x4 v1) const {
        v4u w; w.x = pg8::cvt_pk_bf16(v0[0], v0[1]); w.y = pg8::cvt_pk_bf16(v0[2], v0[3]); w.z = pg8::cvt_pk_bf16(v1[0], v1[1]); w.w = pg8::cvt_pk_bf16(v1[2], v1[3]);
        *(GAS v4u*)(o + (size_t)row * ld + col) = w;
    }
};
struct FGlu {
    const bf16* z; bf16* mix;
    __device__ __forceinline__ void operator()(int row, int col, f32x4 v0, f32x4 v1) const {
        float zz[8]; unpack8(*(const GAS v4u*)(z + (size_t)row * 512 + col), zz);
        float o[8];
#pragma unroll
        for (int j = 0; j < 4; ++j) { o[j] = zz[j] * sigmoidf_(v0[j]); o[4 + j] = zz[4 + j] * sigmoidf_(v1[j]); }
        *(GAS v4u*)(mix + (size_t)row * D + 512 + col) = pack8(o);
    }
};
struct FQ {
    bf16* qb; const float* rope;
    __device__ __forceinline__ void operator()(int row, int col, f32x4 v0, f32x4 v1) const {
        float x[8] = {v0[0], v0[1], v0[2], v0[3], v1[0], v1[1], v1[2], v1[3]}, p[8];
#pragma unroll
        for (int j = 0; j < 8; ++j) p[j] = __shfl_xor(x[j], 16);
        const bool isctx = row >= TL; const int b = isctx ? ((row - TL) >> 8) : (row >> 13), t = isctx ? ((row - TL) & 255) : (row & 8191), tq = isctx ? SEQ + t : t;
        const int h = col / 96, d = col - h * 96;
        if (d >= 64 && !isctx) { const int idx = d - 64, a = idx >> 4, half = (idx >> 3) & 1, pos = a ? (t & 63) : (t >> 6);
#pragma unroll
            for (int f = 0; f < 8; ++f) { const float cs = rope[2 * (pos * 8 + f)], sn = rope[2 * (pos * 8 + f) + 1]; x[f] = half ? x[f] * cs + p[f] * sn : x[f] * cs - p[f] * sn; } }
#pragma unroll
        for (int j = 0; j < 8; ++j) x[j] *= QSCALE;
        *(GAS v4u*)(qb + ((size_t)(b * 8 + h) * TQK + tq) * 96 + d) = pack8(x);
        asm volatile("" ::: "memory");
    }
};
struct FKV {
    bf16* kb; bf16* vb;
    __device__ __forceinline__ void operator()(int row, int col, f32x4 v0, f32x4 v1) const {
        v4u w; w.x = pg8::cvt_pk_bf16(v0[0], v0[1]); w.y = pg8::cvt_pk_bf16(v0[2], v0[3]); w.z = pg8::cvt_pk_bf16(v1[0], v1[1]); w.w = pg8::cvt_pk_bf16(v1[2], v1[3]);
        const bool isctx = row >= TL; const int b = isctx ? ((row - TL) >> 8) : (row >> 13), t = isctx ? ((row - TL) & 255) : (row & 8191), tk = isctx ? t : CTXL + t;
        const int h = col >> 7, e = col & 127;
        if (e < 64) *(GAS v4u*)(kb + ((size_t)(b * 8 + h) * TQK + tk) * 96 + e) = w;
        else { const int kk = tk & 63, pos = (kk & 48) | (kk & 3) | ((kk & 4) << 1) | ((kk & 8) >> 1);
            bf16* p = vb + (((size_t)(b * 8 + h) * (TQK / 64) + (tk >> 6)) * 64 + (e - 64)) * 64 + pos;
            p[0] = (bf16)(w.x & 0xffffu); p[64] = (bf16)(w.x >> 16); p[128] = (bf16)(w.y & 0xffffu); p[192] = (bf16)(w.y >> 16);
            p[256] = (bf16)(w.z & 0xffffu); p[320] = (bf16)(w.z >> 16); p[384] = (bf16)(w.w & 0xffffu); p[448] = (bf16)(w.w >> 16); }
    }
};
struct FResid {
    float* xl; float* xc; const float* gate;
    int first; int row_off;
    __device__ __forceinline__ void operator()(int row_, int col, f32x4 v) const {
        const int row = row_ + row_off;
        const f32x4 gv = *(const GAS f32x4*)(gate + (size_t)modrow_of(row) * 6144 + col);
        if (row < TL) { float* xp = xl + (size_t)row * D + col; const f32x4 xo = *(const GAS f32x4*)xp; *(GAS f32x4*)xp = (first ? xo * DN_ALPHA : xo) + gv * v; }
        else { float* xp = xc + (size_t)(row - TL) * D + col; atomicAdd(xp, gv[0] * v[0]); atomicAdd(xp + 1, gv[1] * v[1]); atomicAdd(xp + 2, gv[2] * v[2]); atomicAdd(xp + 3, gv[3] * v[3]); }
    }
};
struct FHgIn {
    bf16* qffi; bf16* g;
    __device__ __forceinline__ void operator()(int row, int col, f32x4 v0, f32x4 v1) const {
        v4u w; w.x = pg8::cvt_pk_bf16(v0[0], v0[1]); w.y = pg8::cvt_pk_bf16(v0[2], v0[3]); w.z = pg8::cvt_pk_bf16(v1[0], v1[1]); w.w = pg8::cvt_pk_bf16(v1[2], v1[3]);
        if (col < 4096) *(GAS v4u*)(qffi + (size_t)row * 4096 + col) = w; else *(GAS v4u*)(g + (size_t)row * D + (col - 4096)) = w;
    }
};
template <class E> __device__ __forceinline__ void run_gemm_off(Frame& F, const bf16* A, int lda, const bf16* Bt, int ldb, int M, int N, int K, const E& e, int boff) {
    pg8::Gemm g{A, Bt, M, N, K, lda, ldb}; pg8::StaticOrder S; S.init(M, N, F.G, (int)((blockIdx.x + F.G - boff) % F.G));
    pg8::gemm_phase<E, pg8::StaticOrder, true, true>(F.lds + RING_OFF, g, S, e);
}
template <class E> __device__ __forceinline__ void run_gemm(Frame& F, const bf16* A, int lda, const bf16* Bt, int ldb, int M, int N, int K, const E& e) {
    pg8::Gemm g{A, Bt, M, N, K, lda, ldb}; pg8::StaticOrder S; S.init(M, N, F.G, (int)blockIdx.x);
    pg8::gemm_phase<E, pg8::StaticOrder, true, true>(F.lds + RING_OFF, g, S, e);
}

constexpr int NPH = 32;
struct Args { const float* in[31]; float* out; unsigned char* ws; int ph_lo, ph_hi; };
__global__ void __launch_bounds__(NWAVES * 64, 2) mk_fwd(Args args) {
    extern __shared__ __attribute__((aligned(16))) unsigned char lds[];
    Frame F;
    F.lds = (LAS unsigned char*)lds;
    F.tid = threadIdx.x; F.lane = F.tid & 63; F.wave = __builtin_amdgcn_readfirstlane(F.tid >> 6);
    F.G = gridDim.x; { const int bx = blockIdx.x; F.vcu = (F.G % 8 == 0) ? (bx % 8) * (F.G / 8) + bx / 8 : bx; }
    for (int u = F.tid; u < (LDS_BYTES - LDSCTL_OFF) / 4; u += NWAVES * 64) ((LAS unsigned*)(F.lds + LDSCTL_OFF))[u] = 0u;
    __syncthreads();
    if (F.tid == 0) {
#pragma unroll
        for (int i = 0; i < 31; ++i) ((LAS unsigned long long*)(F.lds + PTR_OFF))[i] = (unsigned long long)args.in[i];
        ((LAS unsigned long long*)(F.lds + PTR_OFF))[31] = (unsigned long long)args.ws; ((LAS unsigned long long*)(F.lds + PTR_OFF))[32] = (unsigned long long)args.out;
    }
    __syncthreads();
    const int lo = args.ph_lo, hi = args.ph_hi;
    const bool multi = (hi - lo) > 1;
    if (multi) (void)xcd_barrier_post((unsigned*)ws_(F) + CW_BAR, (volatile LAS unsigned*)(F.lds + MISC_OFF) + 8);
#ifndef ONLY_PHASE
#define ONLY_PHASE -1
#endif
#define WSP ws_(F)
#define MODP ((const float*)(ws_(F) + WS_MOD))
#define ABUF ((bf16*)(ws_(F) + WS_A))
#ifndef SKIP_PHASE
#define SKIP_PHASE -1
#endif
#define IN(k) ((ONLY_PHASE < 0 || ONLY_PHASE == (k)) && SKIP_PHASE != (k) && lo <= (k) && (k) < hi)
#define SEAM(k) do { if (IN(k) && IN((k) + 1)) { XcdBarrier bar_; bar_.bar = (unsigned*)ws_(F) + CW_BAR; bar_.x = xb_xcc_id(); bar_.st = (volatile LAS unsigned*)(F.lds + MISC_OFF) + 8; xcd_barrier(bar_); } asm volatile("" : "+v"(F.tid), "+v"(F.lane)); } while (0)
    int pk = 0;
#ifndef REPEAT_PHASE
#define REPEAT_PHASE -1
#endif
#define PHASE(...) do { if (IN(pk)) { __VA_ARGS__ } if (REPEAT_PHASE == pk && IN(pk)) { { XcdBarrier bar_; bar_.bar = (unsigned*)ws_(F) + CW_BAR; bar_.x = xb_xcc_id(); bar_.st = (volatile LAS unsigned*)(F.lds + MISC_OFF) + 8; xcd_barrier(bar_); } asm volatile("" : "+v"(F.tid), "+v"(F.lane)); { __VA_ARGS__ } } SEAM(pk); ++pk; } while (0)
    PHASE( p0_prologue(F); p0_s5_tables(F); );
    PHASE( ph_init_rows(F); );
    PHASE( pg8::Epi8<FInProj> e{{(bf16*)(WSP + WS_CQKV), (bf16*)(WSP + WS_UG)}}; run_gemm(F, ABUF, D, (const bf16*)(WSP + WS_WIN0), D, TT, EVEN_IN_PAD, D, e); );
    PHASE( ph_s5_finals(F); );
    PHASE( ph_s5_carry(F); );
    PHASE( ph_mla_norm(F); );
    PHASE(
        { pg8::Epi8<FQ> e{{(bf16*)(WSP + WS_QB), (const float*)(WSP + WS_ROPE)}}; run_gemm(F, (const bf16*)(WSP + WS_CQKV), CQKV_LD, (const bf16*)(WSP + WS_WUQ), 384, TT, 768, 384, e); }
        { pg8::Epi8<FKV> e{{(bf16*)(WSP + WS_KB), (bf16*)(WSP + WS_VB)}}; run_gemm(F, (const bf16*)(WSP + WS_CQKV) + 384, CQKV_LD, (const bf16*)(WSP + WS_WUKV), 256, TT, 1024, 256, e); }
    );
    PHASE( ph_s5_out(F); );
    PHASE( ph_attn(F); );
    PHASE( pg8::Epi8<FGlu> e{{(const bf16*)(WSP + WS_Z), (bf16*)(WSP + WS_MIX)}}; run_gemm(F, (const bf16*)(WSP + WS_Z), 512, (const bf16*)(WSP + WS_WGLU), 512, TT, 512, 512, e); );
    PHASE(
        { pg8::Epi4<FResid> e{{out_(F), (float*)(WSP + WS_XC), MODP + 0 * 3 * 6144 + 2 * 1024, 1, 0}}; run_gemm(F, (const bf16*)(WSP + WS_MIX), D, (const bf16*)(WSP + WS_WOUT0), D, TL, D, D, e); }
        _Pragma("unroll") for (int sp = 0; sp < 4; ++sp) { pg8::Epi4<FResid> e{{out_(F), (float*)(WSP + WS_XC), MODP + 0 * 3 * 6144 + 2 * 1024, 1, TL}};
            run_gemm_off(F, (const bf16*)(WSP + WS_MIX) + (size_t)TL * D + 256 * sp, D, (const bf16*)(WSP + WS_WOUT0) + 256 * sp, D, TC, D, 256, e, 8 * sp); }
    );
    PHASE( ph_layernorm(F, TT, 0, 0, 0, 3); );
#pragma unroll
    for (int grp = 0; grp < 2; ++grp) {
        PHASE( pg8::Epi8<FBf16> e{{(bf16*)(WSP + WS_H), FFH}}; run_gemm(F, ABUF, D, (const bf16*)(WSP + WS_F1T0) + (size_t)grp * FFH * D, D, TT, FFH, D, e); );
        PHASE( ph_convgate(F, TT, 0, grp); );
        PHASE(
            { pg8::Epi4<FResid> e{{out_(F), (float*)(WSP + WS_XC), MODP + 0 * 3 * 6144 + 5 * 1024, grp == 0 ? 1 : 0, 0}}; run_gemm(F, (const bf16*)(WSP + WS_HG), FFG, (const bf16*)(WSP + WS_F2T0) + grp * FFG, FFH, TL, D, FFG, e); }
            _Pragma("unroll") for (int sp = 0; sp < 3; ++sp) { pg8::Epi4<FResid> e{{out_(F), (float*)(WSP + WS_XC), MODP + 0 * 3 * 6144 + 5 * 1024, 0, TL}};
                run_gemm_off(F, (const bf16*)(WSP + WS_HG) + (size_t)TL * FFG + 512 * sp, FFG, (const bf16*)(WSP + WS_F2T0) + grp * FFG + 512 * sp, FFH, TC, D, sp == 2 ? 384 : 512, e, 8 * sp); }
        );
    }
    PHASE( ph_layernorm(F, TT, 0, 1, 1, 0); );
    PHASE( pg8::Epi8<FHgIn> e{{(bf16*)(WSP + WS_QFFI), (bf16*)(WSP + WS_G)}}; run_gemm(F, ABUF, D, (const bf16*)(WSP + WS_HGINT), D, TT, 5120, D, e); );
    PHASE( ph_hgrn_states(F); );
    PHASE( ph_hgrn_out(F); );
    PHASE( ph_hg_gate(F); );
    PHASE( pg8::Epi4<FResid> e{{out_(F), (float*)(WSP + WS_XC), MODP + 1 * 3 * 6144 + 2 * 1024, 1, 0}}; run_gemm(F, (const bf16*)(WSP + WS_O), D, (const bf16*)(WSP + WS_HGOUTT), D, TL, D, D, e); );
    PHASE( ph_layernorm(F, TL, 1, 0, 1, 3); );
#pragma unroll
    for (int grp = 0; grp < 2; ++grp) {
        PHASE( pg8::Epi8<FBf16> e{{(bf16*)(WSP + WS_H), FFH}}; run_gemm(F, ABUF, D, (const bf16*)(WSP + WS_F1T1) + (size_t)grp * FFH * D, D, TL, FFH, D, e); );
        PHASE( ph_convgate(F, TL, 1, grp); );
        PHASE( pg8::Epi4<FResid> e{{out_(F), (float*)(WSP + WS_XC), MODP + 1 * 3 * 6144 + 5 * 1024, grp == 0 ? 1 : 0, 0}}; run_gemm(F, (const bf16*)(WSP + WS_HG), FFG, (const bf16*)(WSP + WS_F2T1) + grp * FFG, FFH, TL, D, FFG, e); );
    }
    PHASE( ph_layernorm(F, TL, 1, 1, -1, 0); );
#undef PHASE
#undef IN
#undef SEAM
}

extern "C" void kernel_launch(void* const* d_in, const int* in_sizes, int n_in, void* d_out, int out_size, void* d_ws, size_t ws_size, hipStream_t stream) {
    static int grid = 0;
    if (grid == 0) {
        if (n_in != 31 || out_size != TL * D || ws_size < WS_END) { fprintf(stderr, "kernel_launch: unexpected shapes n_in %d out %d ws %zu\n", n_in, out_size, ws_size); grid = -1; return; }
        int dev = 0, cus = 0;
        if (hipGetDevice(&dev) != hipSuccess || hipDeviceGetAttribute(&cus, hipDeviceAttributeMultiprocessorCount, dev) != hipSuccess) { grid = -1; return; }
        if (hipFuncSetAttribute((const void*)mk_fwd, hipFuncAttributeMaxDynamicSharedMemorySize, LDS_BYTES) != hipSuccess) { fprintf(stderr, "kernel_launch: hipFuncSetAttribute failed\n"); grid = -1; return; }
        int per_cu = 0;
        if (hipOccupancyMaxActiveBlocksPerMultiprocessor(&per_cu, (const void*)mk_fwd, NWAVES * 64, LDS_BYTES) != hipSuccess || per_cu < 1) fprintf(stderr, "kernel_launch: occupancy query says %d\n", per_cu);
        (void)hipGetLastError();
        grid = cus;
    }
    if (grid < 0) return;
    if (hipMemsetAsync((char*)d_ws + WS_CTL, 0, CTL_ZERO_BYTES, stream) != hipSuccess) return;
    Args a{};
    for (int i = 0; i < 31; ++i) a.in[i] = (const float*)d_in[i];
    a.out = (float*)d_out; a.ws = (unsigned char*)d_ws;
#ifndef MK_ONE_LAUNCH
#define MK_ONE_LAUNCH 1
#endif
    if (MK_ONE_LAUNCH) { a.ph_lo = 0; a.ph_hi = NPH; hipLaunchKernelGGL(mk_fwd, dim3(grid), dim3(NWAVES * 64), LDS_BYTES, stream, a); }
    else for (int p = 0; p < NPH; ++p) { a.ph_lo = p; a.ph_hi = p + 1; hipLaunchKernelGGL(mk_fwd, dim3(grid), dim3(NWAVES * 64), LDS_BYTES, stream, a); }
}
```

```cpp
#include <hip/hip_runtime.h>
#include <cstdio>
#include <cstdint>
#include <cmath>
namespace pg8 {
#define PG8_LAS __attribute__((address_space(3)))
typedef unsigned short bf16_t;
typedef short bf16x8 __attribute__((ext_vector_type(8)));
typedef float f32x4 __attribute__((ext_vector_type(4)));
typedef unsigned u32x4 __attribute__((ext_vector_type(4)));
constexpr int BM = 256, BK = 64, HALF = 128, HTB = HALF * BK * 2  , STAGE_BYTES = 8 * HTB, NXCD = 8, WGM = 8;

__host__ __device__ __forceinline__ int lds_byte(int r, int c) { const int st = (r >> 4) * 2 + (c >> 5), rr = r & 15, cc = c & 31, ob = rr * 64 + cc * 2; return st * 1024 + (ob ^ (((ob >> 9) & 1) << 5)); }
__host__ __device__ __forceinline__ void stage_rc(int b, int& R, int& C) { const int st = b / 1024, sb = b % 1024, swz = sb ^ (((sb >> 9) & 1) << 5); R = (st >> 1) * 16 + swz / 64; C = (st & 1) * 32 + (swz % 64) / 2; }
__host__ __device__ __forceinline__ int perm32(int rho) { const int n = rho >> 4, i = rho & 15; return 8 * (i >> 2) + 4 * n + (i & 3); }

struct Unit { int pm, pn; };
struct Gemm { const bf16_t* A; const bf16_t* Bt; int M, N, K, lda, ldb; };

struct StaticOrder {
    int nM, nN, nwg, G, c;
    __host__ __device__ void init(int M, int N, int G_, int c_) { nM = M / BM; nN = N / BM; nwg = nM * nN; G = G_; c = c_; }
    __host__ __device__ bool next(int i, Unit& u) const {
        const long L = (long)i * G + c; if (L >= nwg) return false;
        int wgid = (int)L; { const int q = nwg / NXCD, r = nwg % NXCD, xcd = wgid % NXCD, off = wgid / NXCD; wgid = (xcd < r ? xcd * (q + 1) : r * (q + 1) + (xcd - r) * q) + off; }
        const int nig = WGM * nN, gid = wgid / nig, fm = gid * WGM, gsz = (nM - fm) < WGM ? (nM - fm) : WGM;
        u.pm = fm + ((wgid % nig) % gsz); u.pn = (wgid % nig) / gsz; return true;
    }
    __device__ __forceinline__ void a_ready(const Unit&) const {}
    __device__ __forceinline__ void done(const Unit&) const {}
};

__device__ __forceinline__ unsigned cvt_pk_bf16(float lo, float hi) { unsigned r; asm volatile("v_cvt_pk_bf16_f32 %0, %1, %2" : "=v"(r) : "v"(lo), "v"(hi)); return r; }
template <class F> struct Epi8 {
    static constexpr bool PERM = true, AFTER_DRAIN = false; F f;
    __device__ __forceinline__ void operator()(const f32x4 (&acc)[2][2][4][2], const Unit& u, int wr, int wc, int fr, int fq) const {
        const int row0 = u.pm * BM + wr * 64 + fr, col0 = u.pn * BM + wc * 32 + 8 * fq;
#pragma unroll
        for (int ai = 0; ai < 2; ++ai)
#pragma unroll
            for (int m = 0; m < 4; ++m)
#pragma unroll
                for (int bj = 0; bj < 2; ++bj) { f(row0 + ai * HALF + m * 16, col0 + bj * HALF, acc[ai][bj][m][0], acc[ai][bj][m][1]); __builtin_amdgcn_sched_barrier(0); }
    }
};
template <class F> struct Epi4 {
    static constexpr bool PERM = false, AFTER_DRAIN = false; F f;
    __device__ __forceinline__ void operator()(const f32x4 (&acc)[2][2][4][2], const Unit& u, int wr, int wc, int fr, int fq) const {
        const int row0 = u.pm * BM + wr * 64 + fr, col0 = u.pn * BM + wc * 32 + 4 * fq;
#pragma unroll
        for (int ai = 0; ai < 2; ++ai)
#pragma unroll
            for (int m = 0; m < 4; ++m)
#pragma unroll
                for (int bj = 0; bj < 2; ++bj)
#pragma unroll
                    for (int n = 0; n < 2; ++n) { f(row0 + ai * HALF + m * 16, col0 + bj * HALF + n * 16, acc[ai][bj][m][n]); __builtin_amdgcn_sched_barrier(0); }
    }
};
template <class Epi, class Sched, bool ALIGN_EPI = false, bool SP2 = false>
__device__ __forceinline__ void gemm_phase(PG8_LAS unsigned char* lds, const Gemm g, const Sched& S, const Epi& E) {
    int tid_ = threadIdx.x; asm volatile("" : "+v"(tid_));
    const int tid = tid_, wid = __builtin_amdgcn_readfirstlane(tid >> 6), lane = tid & 63, wr = wid >> 2, wc = wid & 3, fr = lane & 15, fq = lane >> 4;
    const int K = g.K, nt = K / BK;
    unsigned voffA[2], voffB[2];
#pragma unroll
    for (int i = 0; i < 2; ++i) { int R, C; stage_rc(tid * 16 + i * 8192, R, C); const int Rb = Epi::PERM ? ((R & ~31) + perm32(R & 31)) : R;
        voffA[i] = (unsigned)(R * g.lda + C) * 2u; voffB[i] = (unsigned)(Rb * g.ldb + C) * 2u; }
    const size_t kstep = (size_t)(BK * 2);
    const size_t hstepA = (size_t)HALF * g.lda * 2, hstepB = (size_t)HALF * g.ldb * 2;
    const size_t tstepA = 2 * hstepA, tstepB = 2 * hstepB;
    const unsigned ldsw = (unsigned)wid * 1024u;
    const int aoff = lds_byte(wr * 64 + fr, fq * 8), boff = lds_byte(wc * 32 + fr, fq * 8);
#define PG8_SA(b, h) (((b) * 2 + (h)) * HTB)
#define PG8_SB(b, h) ((4 + (b) * 2 + (h)) * HTB)
#define PG8_STAGE(bufoff, gbase, voff) do { _Pragma("unroll") for (int _i = 0; _i < 2; ++_i) \
        __builtin_amdgcn_global_load_lds((const unsigned*)((const char*)(gbase) + (voff)[_i]), (PG8_LAS unsigned*)(lds + (bufoff) + ldsw + _i * 8192), 16, 0, 0); } while (0)
#define PG8_LDA(dst, b, h) do { _Pragma("unroll") for (int m = 0; m < 4; ++m) _Pragma("unroll") for (int k = 0; k < 2; ++k) dst[m][k] = *(const PG8_LAS bf16x8*)(lds + PG8_SA(b, h) + aoff + m * 2048 + k * 1024); } while (0)
#define PG8_LDB(dst, b, h) do { _Pragma("unroll") for (int n = 0; n < 2; ++n) _Pragma("unroll") for (int k = 0; k < 2; ++k) dst[n][k] = *(const PG8_LAS bf16x8*)(lds + PG8_SB(b, h) + boff + n * 2048 + k * 1024); } while (0)
#define PG8_MMA(ai, bj, At, Bt) do { __builtin_amdgcn_s_setprio(1); _Pragma("unroll") for (int m = 0; m < 4; ++m) _Pragma("unroll") for (int n = 0; n < 2; ++n) _Pragma("unroll") for (int k = 0; k < 2; ++k) \
        acc[ai][bj][m][n] = __builtin_amdgcn_mfma_f32_16x16x32_bf16(Bt[n][k], At[m][k], acc[ai][bj][m][n], 0, 0, 0); __builtin_amdgcn_s_setprio(0); } while (0)
#define PG8_WAIT_V(n) asm volatile("s_waitcnt vmcnt(" #n ")" ::: "memory")
#define PG8_WAIT_L(n) asm volatile("s_waitcnt lgkmcnt(" #n ")" ::: "memory")
#define PG8_BAR __builtin_amdgcn_s_barrier()
#define PG8_SCHED __builtin_amdgcn_sched_barrier(0)
    Unit cur, nxt; int ui = 0;
    if (!S.next(0, cur)) return;
    f32x4 acc[2][2][4][2];
#pragma unroll
    for (int a = 0; a < 2; ++a)
#pragma unroll
        for (int b = 0; b < 2; ++b)
#pragma unroll
            for (int m = 0; m < 4; ++m)
#pragma unroll
                for (int n = 0; n < 2; ++n) acc[a][b][m][n] = (f32x4){0.f, 0.f, 0.f, 0.f};
    bf16x8 At[4][2], B0[2][2], B1[2][2];
    const char* cA = (const char*)g.A + (size_t)cur.pm * tstepA; const char* cB = (const char*)g.Bt + (size_t)cur.pn * tstepB;
    S.a_ready(cur);
    if constexpr (SP2) {
        PG8_STAGE(PG8_SB(0, 0), cB, voffB); PG8_STAGE(PG8_SB(0, 1), cB + hstepB, voffB); PG8_STAGE(PG8_SA(0, 0), cA, voffA); PG8_STAGE(PG8_SA(0, 1), cA + hstepA, voffA);
        if (wr == 1) PG8_BAR;
        PG8_WAIT_V(2); PG8_BAR;
        PG8_STAGE(PG8_SB(1, 0), cB + kstep, voffB); PG8_STAGE(PG8_SA(1, 0), cA + kstep, voffA); PG8_STAGE(PG8_SB(1, 1), cB + hstepB + kstep, voffB);
        PG8_WAIT_V(6); PG8_BAR;
    } else {
        PG8_STAGE(PG8_SB(0, 0), cB, voffB); PG8_STAGE(PG8_SA(0, 0), cA, voffA); PG8_STAGE(PG8_SB(0, 1), cB + hstepB, voffB); PG8_STAGE(PG8_SA(0, 1), cA + hstepA, voffA);
        if (wr == 1) PG8_BAR;
        PG8_WAIT_V(4); PG8_BAR;
        PG8_STAGE(PG8_SB(1, 0), cB + kstep, voffB); PG8_STAGE(PG8_SA(1, 0), cA + kstep, voffA); PG8_STAGE(PG8_SB(1, 1), cB + hstepB + kstep, voffB);
        PG8_WAIT_V(6); PG8_BAR;
    }
    for (;;) {
        const bool has_next = S.next(ui + 1, nxt);
        const char* nA = has_next ? (const char*)g.A + (size_t)nxt.pm * tstepA : cA; const char* nB = has_next ? (const char*)g.Bt + (size_t)nxt.pn * tstepB : cB;
#pragma unroll 1
        for (int t = 0; t < nt; t += 2) {
            const bool last = (t == nt - 2);
            const char* a1 = cA + (size_t)(t + 1) * kstep;
            const char* a2 = last ? nA : cA + (size_t)(t + 2) * kstep; const char* b2 = last ? nB : cB + (size_t)(t + 2) * kstep;
            const char* a3 = a2 + kstep; const char* b3 = b2 + kstep;
            if (last && has_next) S.a_ready(nxt);
            if constexpr (SP2) {
            PG8_LDB(B0, 0, 0); PG8_LDB(B1, 0, 1); PG8_SCHED; PG8_LDA(At, 0, 0); PG8_STAGE(PG8_SA(1, 1), a1 + hstepA, voffA);
            PG8_WAIT_V(8); PG8_WAIT_L(0); PG8_BAR; PG8_MMA(0, 0, At, B0); PG8_MMA(0, 1, At, B1); PG8_BAR; PG8_SCHED;
            PG8_LDA(At, 0, 1); PG8_STAGE(PG8_SB(0, 0), b2, voffB); PG8_STAGE(PG8_SB(0, 1), b2 + hstepB, voffB); PG8_STAGE(PG8_SA(0, 0), a2, voffA);
            PG8_WAIT_V(8); PG8_WAIT_L(0); PG8_BAR; PG8_MMA(1, 0, At, B0); PG8_MMA(1, 1, At, B1); PG8_BAR; PG8_SCHED;
            PG8_LDB(B0, 1, 0); PG8_LDB(B1, 1, 1); PG8_SCHED; PG8_LDA(At, 1, 0); PG8_STAGE(PG8_SA(0, 1), a2 + hstepA, voffA);
            PG8_WAIT_V(8); PG8_WAIT_L(0); PG8_BAR; PG8_MMA(0, 0, At, B0); PG8_MMA(0, 1, At, B1); PG8_BAR; PG8_SCHED;
            PG8_LDA(At, 1, 1); PG8_STAGE(PG8_SB(1, 0), b3, voffB); PG8_STAGE(PG8_SB(1, 1), b3 + hstepB, voffB); PG8_STAGE(PG8_SA(1, 0), a3, voffA);
            PG8_WAIT_V(8); PG8_WAIT_L(0); PG8_BAR; PG8_MMA(1, 0, At, B0); PG8_MMA(1, 1, At, B1); PG8_BAR; PG8_SCHED;
            } else {
            PG8_LDB(B0, 0, 0); PG8_SCHED; PG8_LDA(At, 0, 0); PG8_STAGE(PG8_SA(1, 1), a1 + hstepA, voffA);
            PG8_WAIT_L(8); PG8_BAR; PG8_WAIT_L(0); PG8_MMA(0, 0, At, B0); PG8_BAR; PG8_SCHED;
            PG8_LDB(B1, 0, 1); PG8_STAGE(PG8_SB(0, 0), b2, voffB);
            PG8_BAR; PG8_WAIT_L(0); PG8_MMA(0, 1, At, B1); PG8_BAR;
            PG8_LDA(At, 0, 1); PG8_STAGE(PG8_SA(0, 0), a2, voffA);
            PG8_BAR; PG8_WAIT_L(0); PG8_MMA(1, 0, At, B0); PG8_BAR; PG8_SCHED;
            PG8_STAGE(PG8_SB(0, 1), b2 + hstepB, voffB);
            PG8_WAIT_V(6); PG8_BAR; PG8_MMA(1, 1, At, B1); PG8_BAR;
            PG8_LDB(B0, 1, 0); PG8_SCHED; PG8_LDA(At, 1, 0); PG8_STAGE(PG8_SA(0, 1), a2 + hstepA, voffA);
            PG8_WAIT_L(8); PG8_BAR; PG8_WAIT_L(0); PG8_MMA(0, 0, At, B0); PG8_BAR; PG8_SCHED;
            PG8_LDB(B1, 1, 1); PG8_STAGE(PG8_SB(1, 0), b3, voffB);
            PG8_BAR; PG8_WAIT_L(0); PG8_MMA(0, 1, At, B1); PG8_BAR;
            PG8_LDA(At, 1, 1); PG8_STAGE(PG8_SA(1, 0), a3, voffA);
            PG8_BAR; PG8_WAIT_L(0); PG8_MMA(1, 0, At, B0); PG8_BAR; PG8_SCHED;
            PG8_STAGE(PG8_SB(1, 1), b3 + hstepB, voffB);
            PG8_WAIT_V(6); PG8_BAR; PG8_MMA(1, 1, At, B1); PG8_BAR;
            }
        }
        if constexpr (ALIGN_EPI) { if (wr == 0) PG8_BAR; }
        if constexpr (!Epi::AFTER_DRAIN) { E(acc, cur, wr, wc, fr, fq); S.done(cur); }
        if (!has_next) break;
#pragma unroll
        for (int a = 0; a < 2; ++a)
#pragma unroll
            for (int b = 0; b < 2; ++b)
#pragma unroll
                for (int m = 0; m < 4; ++m)
#pragma unroll
                    for (int n = 0; n < 2; ++n) acc[a][b][m][n] = (f32x4){0.f, 0.f, 0.f, 0.f};
        cur = nxt; cA = nA; cB = nB; ++ui;
        if constexpr (ALIGN_EPI) { if (wr == 1) PG8_BAR; }
    }
    PG8_WAIT_V(0);
    if constexpr (!ALIGN_EPI) { if (wr == 0) PG8_BAR; }
    PG8_BAR;
    if constexpr (Epi::AFTER_DRAIN) { E.fused(acc, cur, wr, wc, fr, fq, lds, wid, lane); S.done(cur); }
#undef PG8_SA
#undef PG8_SB
#undef PG8_STAGE
#undef PG8_LDA
#undef PG8_LDB
#undef PG8_MMA
#undef PG8_WAIT_V
#undef PG8_WAIT_L
#undef PG8_BAR
#undef PG8_SCHED
}
}

constexpr int NWAVES = 8;
constexpr int D = 1024, BATCH = 2, SEQ = 8192, CTXL = 256;
constexpr int TL = BATCH * SEQ;
constexpr int TC = BATCH * CTXL;
constexpr int TT = TL + TC;
constexpr int EVEN_IN = 1184, EVEN_IN_PAD = 1280, CQKV_LD = 672;
constexpr int FFH = 2816, FFG = 1408;
constexpr int TQK = SEQ + CTXL;
constexpr float NORM_EPS = 1e-6f;
constexpr float DN_ALPHA = 1.41421356237f;
constexpr float QSCALE = 0.10206207261596577f * 1.4426950408889634f;

constexpr size_t MiB = 1u << 20;
constexpr size_t WS_CTL = 0, CTL_ZERO_BYTES = 1 * MiB;
constexpr size_t WS_MOD = 1 * MiB;
constexpr size_t WS_LBV = WS_MOD + 160 * 1024;
constexpr size_t WS_ROPE = WS_LBV + 16 * 1024;
constexpr size_t WS_HGINT = 2 * MiB, WS_HGOUTT = 12 * MiB, WS_F1T1 = 14 * MiB, WS_F2T1 = 25 * MiB;
constexpr size_t WS_A = 31 * MiB;
constexpr size_t WS_XC = 64 * MiB;
constexpr size_t WS_WIN0 = 66 * MiB, WS_WUQ = WS_WIN0 + 2560 * 1024, WS_WUKV = WS_WUQ + 768 * 1024, WS_WGLU = WS_WUKV + 512 * 1024,
                 WS_WOUT0 = WS_WGLU + 512 * 1024, WS_F1T0 = 72 * MiB + 512 * 1024, WS_F2T0 = WS_F1T0 + 11 * MiB;
constexpr size_t WS_R = 89 * MiB;
constexpr size_t WS_CQKV = WS_R;
constexpr size_t WS_UG = WS_R + 22 * MiB;
constexpr size_t WS_WF = WS_R + 39 * MiB;
constexpr size_t WS_WC = WS_R + 64 * MiB;
constexpr size_t WS_TOEP = WS_R + 80 * MiB;
constexpr size_t WS_T0 = WS_R + 82 * MiB;
constexpr size_t WS_A64 = WS_T0 + 128 * 1024;
constexpr size_t WS_FIN = WS_R + 83 * MiB;
constexpr size_t WS_SIN = WS_R + 92 * MiB;
constexpr size_t WS_Z = WS_R + 97 * MiB;
constexpr size_t WS_MIX = WS_R + 134 * MiB;
constexpr size_t WS_QB = WS_R + 39 * MiB;
constexpr size_t WS_KB = 31 * MiB;
constexpr size_t WS_VB = WS_R + 114 * MiB;
constexpr size_t WS_H = WS_R;
constexpr size_t WS_HG = WS_R + 91 * MiB;
constexpr size_t WS_QFFI = 66 * MiB;
constexpr size_t WS_G = 198 * MiB;
constexpr size_t WS_O = WS_A;
constexpr size_t WS_SLAB1 = WS_R;
constexpr size_t WS_SLAB2 = WS_R + 140 * MiB;
constexpr size_t WS_END = 256 * MiB;
static_assert(WS_F2T0 + 5632 * 1024 <= WS_R, "layer-0 weights");
static_assert(WS_MIX + (size_t)TT * 1024 * 2 <= WS_END && WS_G + (size_t)TT * 1024 * 2 <= WS_END && WS_HG + (size_t)TT * FFG * 2 <= WS_END, "ws map");
static_assert(WS_WF + 16 * MiB <= WS_WC && WS_QB + (size_t)16 * TQK * 96 * 2 <= WS_WC && WS_WC + 16 * MiB <= WS_TOEP && WS_TOEP + 2 * MiB <= WS_T0 && WS_T0 + MiB <= WS_FIN && WS_FIN + (size_t)32 * 264 * 256 * 4 <= WS_SIN && WS_SIN + (size_t)32 * 264 * 256 * 2 <= WS_Z && WS_Z + (size_t)TT * 512 * 2 <= WS_VB && WS_VB + (size_t)16 * TQK * 64 * 2 <= WS_MIX && WS_KB + (size_t)16 * TQK * 96 * 2 <= WS_XC, "ws map 2");

constexpr int CW_BAR = 4096;
constexpr int RING_OFF = 0, RING_BYTES = 131072;
constexpr int LDSCTL_OFF = RING_BYTES, MISC_OFF = LDSCTL_OFF + 320;
constexpr int LDS_BYTES = 147456;

#define GAS __attribute__((address_space(1)))
#define LAS __attribute__((address_space(3)))
typedef unsigned short bf16;
typedef unsigned v4u __attribute__((ext_vector_type(4)));
typedef unsigned v2u __attribute__((ext_vector_type(2)));
typedef float f32x4 __attribute__((ext_vector_type(4)));
typedef GAS unsigned gu32;
#define RLX_AGENT __ATOMIC_RELAXED, __HIP_MEMORY_SCOPE_AGENT
#define LDS_WAIT() asm volatile("s_waitcnt lgkmcnt(0)" ::: "memory")
__device__ __forceinline__ unsigned f2bf(float f) { unsigned u = __builtin_bit_cast(unsigned, f); return (u + 0x7fffu + ((u >> 16) & 1u)) >> 16; }
__device__ __forceinline__ unsigned pk2(float lo, float hi) { return f2bf(lo) | (f2bf(hi) << 16); }
__device__ __forceinline__ float bflo(unsigned w) { return __builtin_bit_cast(float, w << 16); }
__device__ __forceinline__ float bfhi(unsigned w) { return __builtin_bit_cast(float, w & 0xffff0000u); }
__device__ __forceinline__ float bf2f(bf16 h) { return __builtin_bit_cast(float, (unsigned)h << 16); }
__device__ __forceinline__ void unpack8(v4u w, float* x) { x[0] = bflo(w.x); x[1] = bfhi(w.x); x[2] = bflo(w.y); x[3] = bfhi(w.y); x[4] = bflo(w.z); x[5] = bfhi(w.z); x[6] = bflo(w.w); x[7] = bfhi(w.w); }
__device__ __forceinline__ v4u pack8(const float* x) { v4u w; w.x = pk2(x[0], x[1]); w.y = pk2(x[2], x[3]); w.z = pk2(x[4], x[5]); w.w = pk2(x[6], x[7]); return w; }
__device__ __forceinline__ float sigmoidf_(float x) { return 1.0f / (1.0f + __expf(-x)); }
__device__ __forceinline__ float siluf_(float x) { return x / (1.0f + __expf(-x)); }
__device__ __forceinline__ float gelu_tanh(float x) { const float u = 0.7978845608028654f * (x + 0.044715f * x * x * x); return 0.5f * x * (1.0f + tanhf(u)); }
__device__ __forceinline__ float wave_sum(float v) {
#pragma unroll
    for (int o = 1; o < 64; o <<= 1) v += __shfl_xor(v, o);
    return v;
}

#define XB_TMO      128
#define XB_XCNT(j)  (256  + 64 * (j))
#define XB_XSUB(j)  (1280 + 64 * (j))
#define XB_XGEN(j)  (2304 + 64 * (j))
#define XB_TOP      3328
#define XB_TOPGEN   3392
#define XCD_BAR_WORDS 3456
#define XB_SPIN_CAP (1u << 18)

__device__ __forceinline__ unsigned xb_ld(unsigned* p)              { return __hip_atomic_load(p, __ATOMIC_RELAXED, __HIP_MEMORY_SCOPE_AGENT); }
__device__ __forceinline__ unsigned xb_add(unsigned* p, unsigned v) { return __hip_atomic_fetch_add(p, v, __ATOMIC_RELAXED, __HIP_MEMORY_SCOPE_AGENT); }
__device__ __forceinline__ unsigned xb_xcc_id() { return (unsigned)__builtin_amdgcn_s_getreg((3 << 11) | 20) & 0xFu; }
#define XB_SPIN(cond, bar) do { unsigned _sp = 0; while (cond) { __builtin_amdgcn_s_sleep(1); \
    if ((++_sp & 255u) == 0u) { if (xb_ld(&(bar)[XB_TMO])) break; if (_sp > XB_SPIN_CAP) { atomicAdd(&(bar)[XB_TMO], 1u); break; } } } } while (0)

struct XcdBarrier {
    unsigned* bar; unsigned x;
    volatile LAS unsigned* st;
};

__device__ __forceinline__ XcdBarrier xcd_barrier_post(unsigned* bar, volatile LAS unsigned* st) {
    XcdBarrier b; b.bar = bar; b.x = xb_xcc_id(); b.st = st;
    if (threadIdx.x == 0) (void)xb_add(&bar[XB_XCNT(b.x)], 1u);
    return b;
}
__device__ __forceinline__ void xcd_barrier_complete(unsigned* bar, unsigned x, unsigned& nloc, unsigned& nx) {
    const unsigned G = gridDim.x * gridDim.y * gridDim.z;
    unsigned sum, cnt, mine, sp = 0u;
    for (;;) {
        sum = 0u; cnt = 0u; mine = 0u;
#pragma unroll
        for (unsigned j = 0; j < 16; ++j) { const unsigned c = xb_ld(&bar[XB_XCNT(j)]); sum += c; cnt += (c > 0u) ? 1u : 0u; mine = (j == x) ? c : mine; }
        if (sum == G) break;
        __builtin_amdgcn_s_sleep(1);
        if ((++sp & 255u) == 0u) { if (xb_ld(&bar[XB_TMO])) break; if (sp > XB_SPIN_CAP) { atomicAdd(&bar[XB_TMO], 1u); break; } }
    }
    nloc = mine > 0u ? mine : 1u; nx = cnt > 0u ? cnt : 1u;
}

__device__ __forceinline__ void xcd_barrier(const XcdBarrier& b) {
    asm volatile("s_waitcnt vmcnt(0)" ::: "memory");
    __syncthreads();
    if (threadIdx.x == 0) {
        unsigned* bar = b.bar;
        __builtin_amdgcn_s_waitcnt(0);
        unsigned nloc = b.st[0], nx = b.st[1];
        if (nloc == 0u) { xcd_barrier_complete(bar, b.x, nloc, nx); b.st[0] = nloc; b.st[1] = nx; }
        const unsigned old = xb_add(&bar[XB_XSUB(b.x)], 1u);
        const unsigned gen = old / nloc;
        if (old + 1u == (gen + 1u) * nloc) {
            __builtin_amdgcn_fence(__ATOMIC_RELEASE, "agent");
            asm volatile("s_waitcnt vmcnt(0)" ::: "memory");
            const unsigned og = xb_add(&bar[XB_TOP], 1u);
            const unsigned tg = og / nx;
            if (og + 1u == (tg + 1u) * nx) xb_add(&bar[XB_TOPGEN], 1u);
            else XB_SPIN(xb_ld(&bar[XB_TOPGEN]) == tg, bar);
            __builtin_amdgcn_fence(__ATOMIC_ACQUIRE, "agent");
            xb_add(&bar[XB_XGEN(b.x)], 1u);
            asm volatile("s_waitcnt vmcnt(0)" ::: "memory");
        } else {
            XB_SPIN(xb_ld(&bar[XB_XGEN(b.x)]) == gen, bar);
            __builtin_amdgcn_fence(__ATOMIC_ACQUIRE, "agent");
            asm volatile("s_waitcnt vmcnt(0)" ::: "memory");
        }
    }
    __syncthreads();
}


struct Frame {
    LAS unsigned char* lds;
    int tid, lane, wave, vcu, G;
};
constexpr int PTR_OFF = LDSCTL_OFF + 1024;
__device__ __forceinline__ const float* inp(const Frame& F, int i) {
    const LAS unsigned* p = (const LAS unsigned*)(F.lds + PTR_OFF) + 2 * i;
    const unsigned lo = __builtin_amdgcn_readfirstlane(p[0]), hi = __builtin_amdgcn_readfirstlane(p[1]);
    return (const float*)(((unsigned long long)hi << 32) | lo);
}
__device__ __forceinline__ unsigned char* ws_(const Frame& F) { return (unsigned char*)inp(F, 31); }
__device__ __forceinline__ float* out_(const Frame& F) { return (float*)inp(F, 32); }
__device__ __forceinline__ int modrow_of(int m) { return m < TL ? (m >> 13) : 2; }
__device__ __forceinline__ const float* xin_row(const Frame& F, int m) { return m < TL ? inp(F, 0) + (size_t)m * D : inp(F, 2) + (size_t)(m - TL) * D; }
__device__ __forceinline__ float* xres_row(const Frame& F, int m) { return m < TL ? out_(F) + (size_t)m * D : (float*)(ws_(F) + WS_XC) + (size_t)(m - TL) * D; }
__device__ __forceinline__ const float* modvec(const Frame& F, int layer, int mr, int part) { return (const float*)(ws_(F) + WS_MOD) + (size_t)(layer * 3 + mr) * 6144 + part * 1024; }

__device__ __forceinline__ void tr_item(const float* W, int ldw, int k0, int n0, bf16* dst, int dpitch, LAS float* scr, int lane) {
    { f32x4 v[8];
#pragma unroll
      for (int i = 0; i < 8; ++i) v[i] = *(const GAS f32x4*)(W + (size_t)(k0 + 8 * i + (lane >> 3)) * ldw + n0 + 4 * (lane & 7));
#pragma unroll
      for (int i = 0; i < 8; ++i) { LAS float* d = scr + (8 * i + (lane >> 3)) * 33 + 4 * (lane & 7); d[0] = v[i].x; d[1] = v[i].y; d[2] = v[i].z; d[3] = v[i].w; } }
    LDS_WAIT(); asm volatile("" ::: "memory");
    const int c = lane & 7;
#pragma unroll
    for (int j = 0; j < 4; ++j) { const int n = (lane >> 3) + 8 * j; const LAS float* s = scr + (8 * c) * 33 + n;
        v4u o; o.x = pk2(s[0 * 33], s[1 * 33]); o.y = pk2(s[2 * 33], s[3 * 33]); o.z = pk2(s[4 * 33], s[5 * 33]); o.w = pk2(s[6 * 33], s[7 * 33]);
        *(GAS v4u*)(dst + (size_t)n * dpitch + 8 * c) = o; }
    LDS_WAIT(); asm volatile("" ::: "memory");
}
__device__ __forceinline__ bool tr_plain(int& r, const float* W, int K, int N, bf16* WT, LAS float* scr, int lane) {
    const int nblk = N / 32, cnt = (K / 64) * nblk;
    if (r >= cnt) { r -= cnt; return false; }
    const int kb = r / nblk, nb = r % nblk;
    tr_item(W, N, 64 * kb, 32 * nb, WT + (size_t)(32 * nb) * K + 64 * kb, K, scr, lane); return true;
}
__device__ __forceinline__ bool tr_ffn1(int& r, const float* W, bf16* WT, LAS float* scr, int lane) {
    const int nblk = 5632 / 32, cnt = 16 * nblk;
    if (r >= cnt) { r -= cnt; return false; }
    const int kb = r / nblk, nb = r % nblk, n0 = 32 * nb, half = n0 / FFH, j = n0 % FFH, g = j / FFG, jj = j % FFG, drow = g * FFH + half * FFG + jj;
    tr_item(W, 5632, 64 * kb, n0, WT + (size_t)drow * 1024 + 64 * kb, 1024, scr, lane); return true;
}
__device__ __forceinline__ void p0_prologue(Frame& F) {
    {
        LAS float* sv = (LAS float*)(F.lds + RING_OFF);
        LAS float* red = sv + 3072;
        for (int i = F.tid; i < 3072; i += 512) { const int r = i >> 10, k = i & 1023; const float cv = (r < 2) ? inp(F, 1)[r * 1024 + k] : inp(F, 3)[k]; sv[i] = cv / (1.0f + __expf(-cv)); }
        __syncthreads();
        for (int it = blockIdx.x; it < 192; it += F.G) {
            const int layer = it / 96, cg = it % 96, col = cg * 64 + F.lane, k0 = F.wave * 128;
            const float* w = inp(F, 4) + ((size_t)layer * 1024 + k0) * 6144 + col;
            float a0 = 0.f, a1 = 0.f, a2 = 0.f;
#pragma unroll 16
            for (int k = 0; k < 128; ++k) { const float wv = w[(size_t)k * 6144]; a0 += sv[k0 + k] * wv; a1 += sv[1024 + k0 + k] * wv; a2 += sv[2048 + k0 + k] * wv; }
            red[(F.wave * 3 + 0) * 64 + F.lane] = a0; red[(F.wave * 3 + 1) * 64 + F.lane] = a1; red[(F.wave * 3 + 2) * 64 + F.lane] = a2;
            __syncthreads();
            if (F.tid < 192) { const int r = F.tid >> 6, l = F.tid & 63; float s = inp(F, 5)[layer * 6144 + cg * 64 + l];
#pragma unroll
                for (int wv = 0; wv < 8; ++wv) s += red[(wv * 3 + r) * 64 + l];
                ((float*)(ws_(F) + WS_MOD))[(size_t)(layer * 3 + r) * 6144 + cg * 64 + l] = s; }
            __syncthreads();
        }
        __syncthreads();
    }
    {
        const int gt = F.vcu * 512 + F.tid, NT = F.G * 512;
        for (int i = gt; i < 2048; i += NT) { const int dir = i >> 10, c = i & 1023; const float l0 = inp(F, 28)[(0 * 2 + dir) * 1024 + c], l1 = inp(F, 28)[(1 * 2 + dir) * 1024 + c];
            ((float*)(ws_(F) + WS_LBV))[i] = 1.0f / (1.0f + expf(l0 - l1)); }
        for (int i = gt; i < 1024; i += NT) { const int pos = i >> 3, f = i & 7; const float inv = powf(10000.0f, -(float)f / 8.0f); const float ang = (float)pos * inv;
            ((float*)(ws_(F) + WS_ROPE))[2 * i] = cosf(ang); ((float*)(ws_(F) + WS_ROPE))[2 * i + 1] = sinf(ang); }
        for (int i = gt; i < 96 * 1024 / 8; i += NT) ((GAS v4u*)(ws_(F) + WS_WIN0 + (size_t)1184 * 1024 * 2))[i] = (v4u){0u, 0u, 0u, 0u};
    }
    {
        LAS float* scr = (LAS float*)(F.lds + RING_OFF + F.wave * 16384);
        const int gw = F.vcu * NWAVES + F.wave, NGW = F.G * NWAVES;
        constexpr int NITEMS = 592 + 144 + 128 + 128 + 512 + 2 * 2816 + 2 * 1408 + 2560 + 512;
        for (int it = gw; it < NITEMS; it += NGW) {
            int r = it;
            if (tr_plain(r, inp(F, 12), 1024, 1184, (bf16*)(ws_(F) + WS_WIN0), scr, F.lane)) continue;
            if (tr_plain(r, inp(F, 14), 384, 768, (bf16*)(ws_(F) + WS_WUQ), scr, F.lane)) continue;
            if (tr_plain(r, inp(F, 16), 256, 1024, (bf16*)(ws_(F) + WS_WUKV), scr, F.lane)) continue;
            if (tr_plain(r, inp(F, 25), 512, 512, (bf16*)(ws_(F) + WS_WGLU), scr, F.lane)) continue;
            if (tr_plain(r, inp(F, 26), 1024, 1024, (bf16*)(ws_(F) + WS_WOUT0), scr, F.lane)) continue;
            if (tr_ffn1(r, inp(F, 8), (bf16*)(ws_(F) + WS_F1T0), scr, F.lane)) continue;
            if (tr_ffn1(r, inp(F, 8) + (size_t)1024 * 5632, (bf16*)(ws_(F) + WS_F1T1), scr, F.lane)) continue;
            if (tr_plain(r, inp(F, 11), 2816, 1024, (bf16*)(ws_(F) + WS_F2T0), scr, F.lane)) continue;
            if (tr_plain(r, inp(F, 11) + (size_t)2816 * 1024, 2816, 1024, (bf16*)(ws_(F) + WS_F2T1), scr, F.lane)) continue;
            if (tr_plain(r, inp(F, 27), 1024, 5120, (bf16*)(ws_(F) + WS_HGINT), scr, F.lane)) continue;
            tr_plain(r, inp(F, 30), 1024, 1024, (bf16*)(ws_(F) + WS_HGOUTT), scr, F.lane);
        }
    }
}

__device__ __forceinline__ void store_mod_bf16(const Frame& F, const f32x4 (&v)[4], int m, int layer, int part_sh) {
    const int mr = modrow_of(m);
    const GAS f32x4* sh = (const GAS f32x4*)modvec(F, layer, mr, part_sh) + F.lane;
    const GAS f32x4* sc = (const GAS f32x4*)modvec(F, layer, mr, part_sh + 1) + F.lane;
    GAS v2u* o = (GAS v2u*)((bf16*)(ws_(F) + WS_A) + (size_t)m * D) + F.lane;
#pragma unroll
    for (int j = 0; j < 4; ++j) { const f32x4 s = sc[64 * j], h = sh[64 * j]; const f32x4 y = v[j] * (s + 1.0f) + h; v2u w; w.x = pk2(y.x, y.y); w.y = pk2(y.z, y.w); o[64 * j] = w; }
}
__device__ __forceinline__ void ph_init_rows(Frame& F) {
    const int gw = F.vcu * NWAVES + F.wave, NGW = F.G * NWAVES;
    for (int m = gw; m < TT; m += NGW) {
        const GAS f32x4* xr = (const GAS f32x4*)xin_row(F, m) + F.lane; GAS f32x4* xo = (GAS f32x4*)xres_row(F, m) + F.lane;
        f32x4 v[4];
#pragma unroll
        for (int j = 0; j < 4; ++j) { v[j] = xr[64 * j]; xo[64 * j] = (m >= TL) ? v[j] * DN_ALPHA : v[j]; }
        store_mod_bf16(F, v, m, 0, 0);
    }
}
__device__ __forceinline__ void ph_layernorm(Frame& F, int nrows, int layer, int which, int next_layer, int next_part_sh, const float* slabs = nullptr, int nslabs = 0) {
    const int gw = F.vcu * NWAVES + F.wave, NGW = F.G * NWAVES;
    const GAS f32x4* gg = (const GAS f32x4*)(inp(F, 6) + (size_t)(layer * 2 + which) * D) + F.lane;
    const GAS f32x4* bb = (const GAS f32x4*)(inp(F, 7) + (size_t)(layer * 2 + which) * D) + F.lane;
    for (int m0 = gw; m0 < nrows; m0 += 2 * NGW) {
        const int m1 = m0 + NGW; const bool has1 = m1 < nrows; const int m1c = has1 ? m1 : m0;
        GAS f32x4* xr0 = (GAS f32x4*)xres_row(F, m0) + F.lane; GAS f32x4* xr1 = (GAS f32x4*)xres_row(F, m1c) + F.lane;
        f32x4 v[4], w[4]; float s0 = 0.f, s1 = 0.f;
#pragma unroll
        for (int j = 0; j < 4; ++j) { v[j] = xr0[64 * j]; w[j] = xr1[64 * j]; }
        if (nslabs > 0 && m1c >= TL) {
            for (int sl = 0; sl < nslabs; ++sl) { const GAS f32x4* p1 = (const GAS f32x4*)(slabs + ((size_t)sl * TC + (m1c - TL)) * D) + F.lane;
#pragma unroll
                for (int j = 0; j < 4; ++j) w[j] += p1[64 * j];
                if (m0 >= TL) { const GAS f32x4* p0 = (const GAS f32x4*)(slabs + ((size_t)sl * TC + (m0 - TL)) * D) + F.lane;
#pragma unroll
                    for (int j = 0; j < 4; ++j) v[j] += p0[64 * j]; } }
        }
#pragma unroll
        for (int j = 0; j < 4; ++j) { s0 += (v[j].x + v[j].y) + (v[j].z + v[j].w); s1 += (w[j].x + w[j].y) + (w[j].z + w[j].w); }
        const float mean0 = wave_sum(s0) * (1.f / D), mean1 = wave_sum(s1) * (1.f / D); float q0 = 0.f, q1 = 0.f;
#pragma unroll
        for (int j = 0; j < 4; ++j) { v[j] = v[j] - mean0; w[j] = w[j] - mean1; q0 += (v[j].x * v[j].x + v[j].y * v[j].y) + (v[j].z * v[j].z + v[j].w * v[j].w); q1 += (w[j].x * w[j].x + w[j].y * w[j].y) + (w[j].z * w[j].z + w[j].w * w[j].w); }
        const float r0 = 1.f / sqrtf(wave_sum(q0) * (1.f / D) + NORM_EPS), r1 = 1.f / sqrtf(wave_sum(q1) * (1.f / D) + NORM_EPS);
#pragma unroll
        for (int j = 0; j < 4; ++j) { const f32x4 g4 = gg[64 * j], b4 = bb[64 * j]; v[j] = v[j] * r0 * g4 + b4; w[j] = w[j] * r1 * g4 + b4; xr0[64 * j] = (m0 >= TL) ? v[j] * DN_ALPHA : v[j]; if (has1) xr1[64 * j] = (m1 >= TL) ? w[j] * DN_ALPHA : w[j]; }
        if (next_layer >= 0) { store_mod_bf16(F, v, m0, next_layer, next_part_sh); if (has1) store_mod_bf16(F, w, m1, next_layer, next_part_sh); }
    }
}
__device__ __forceinline__ void ph_mla_norm(Frame& F) {
    const int gw = F.vcu * NWAVES + F.wave, NGW = F.G * NWAVES;
    bf16* CQ = (bf16*)(ws_(F) + WS_CQKV); bf16* Kb = (bf16*)(ws_(F) + WS_KB); const float* rope = (const float*)(ws_(F) + WS_ROPE);
    for (int m = gw; m < TT; m += NGW) {
        bf16* row = CQ + (size_t)m * CQKV_LD;
        {
            float x[8]; float ss = 0.f; const bool act = F.lane < 48;
            if (act) { unpack8(*(const GAS v4u*)(row + 8 * F.lane), x);
#pragma unroll
                for (int j = 0; j < 8; ++j) ss += x[j] * x[j]; }
            const float sc = 1.f / sqrtf(wave_sum(ss) * (1.f / 384.f) + NORM_EPS);
            if (act) {
#pragma unroll
                for (int j = 0; j < 8; ++j) x[j] = x[j] * sc * inp(F, 13)[8 * F.lane + j];
                *(GAS v4u*)(row + 8 * F.lane) = pack8(x); }
        }
        {
            float x[8]; float ss = 0.f; const bool act = F.lane < 32;
            if (act) { unpack8(*(const GAS v4u*)(row + 384 + 8 * F.lane), x);
#pragma unroll
                for (int j = 0; j < 8; ++j) ss += x[j] * x[j]; }
            const float sc = 1.f / sqrtf(wave_sum(ss) * (1.f / 256.f) + NORM_EPS);
            if (act) {
#pragma unroll
                for (int j = 0; j < 8; ++j) x[j] = x[j] * sc * inp(F, 15)[8 * F.lane + j];
                *(GAS v4u*)(row + 384 + 8 * F.lane) = pack8(x); }
        }
        {
            const bool isctx = m >= TL; const int b = isctx ? ((m - TL) >> 8) : (m >> 13), t = isctx ? ((m - TL) & 255) : (m & 8191), tk = isctx ? t : CTXL + t;
            const int h = F.lane >> 3, i0 = (F.lane & 7) * 4;
            const v2u w = *(const GAS v2u*)(row + 640 + i0);
            float x[4] = {bflo(w.x), bfhi(w.x), bflo(w.y), bfhi(w.y)}, o[4];
#pragma unroll
            for (int j = 0; j < 4; ++j) { const float p = __shfl_xor(x[j], 2); const int idx = i0 + j, a = idx >> 4, half = (idx >> 3) & 1, f = idx & 7, pos = a ? (t & 63) : (t >> 6);
                const float cs = rope[2 * (pos * 8 + f)], sn = rope[2 * (pos * 8 + f) + 1];
                o[j] = isctx ? x[j] : (half ? x[j] * cs + p * sn : x[j] * cs - p * sn); }
            v2u ow; ow.x = pk2(o[0], o[1]); ow.y = pk2(o[2], o[3]);
            *(GAS v2u*)(Kb + ((size_t)(b * 8 + h) * TQK + tk) * 96 + 64 + i0) = ow;
        }
    }
}
__device__ __forceinline__ void ph_convgate(Frame& F, int nrows, int layer, int grp) {
    const int gw = F.vcu * NWAVES + F.wave, NGW = F.G * NWAVES;
    const bf16* H = (const bf16*)(ws_(F) + WS_H); bf16* HG = (bf16*)(ws_(F) + WS_HG);
    const float* cw = inp(F, 9) + (size_t)layer * 3 * FFH + grp * FFG; const float* cb = inp(F, 10) + (size_t)layer * FFH + grp * FFG;
    for (int m = gw; m < nrows; m += NGW) {
        const bool isctx = m >= TL; const int t = isctx ? ((m - TL) & 255) : (m & 8191), len = isctx ? CTXL : SEQ;
        const bool hp = t > 0, hn = t < len - 1;
#pragma unroll
        for (int ci = 0; ci < 3; ++ci) { const int ch = F.lane + 64 * ci; if (ch >= FFG / 8) break;
            const int j0 = 8 * ch; float ac[8], ap[8], an[8], gt[8], o[8];
            unpack8(*(const GAS v4u*)(H + (size_t)m * FFH + j0), ac); unpack8(*(const GAS v4u*)(H + (size_t)m * FFH + FFG + j0), gt);
            if (hp) unpack8(*(const GAS v4u*)(H + (size_t)(m - 1) * FFH + j0), ap); else {
#pragma unroll
                for (int j = 0; j < 8; ++j) ap[j] = 0.f; }
            if (hn) unpack8(*(const GAS v4u*)(H + (size_t)(m + 1) * FFH + j0), an); else {
#pragma unroll
                for (int j = 0; j < 8; ++j) an[j] = 0.f; }
#pragma unroll
            for (int j = 0; j < 8; ++j) { const float cv = cb[j0 + j] + cw[j0 + j] * ap[j] + cw[FFH + j0 + j] * ac[j] + cw[2 * FFH + j0 + j] * an[j]; o[j] = siluf_(cv) * gt[j]; }
            *(GAS v4u*)(HG + (size_t)m * FFG + j0) = pack8(o);
        }
    }
}
__device__ __forceinline__ void ph_hg_gate(Frame& F) {
    const int gw = F.vcu * NWAVES + F.wave, NGW = F.G * NWAVES;
    bf16* O = (bf16*)(ws_(F) + WS_O); const bf16* G = (const bf16*)(ws_(F) + WS_G);
    const int c0 = 16 * F.lane; float ng[16];
#pragma unroll
    for (int j = 0; j < 16; ++j) ng[j] = inp(F, 29)[(c0 + j) & 127];
    for (int m = gw; m < TL; m += NGW) {
        float o[16], g[16]; unpack8(*(const GAS v4u*)(O + (size_t)m * D + c0), o); unpack8(*(const GAS v4u*)(O + (size_t)m * D + c0 + 8), o + 8);
        unpack8(*(const GAS v4u*)(G + (size_t)m * D + c0), g); unpack8(*(const GAS v4u*)(G + (size_t)m * D + c0 + 8), g + 8);
        float ss = 0.f;
#pragma unroll
        for (int j = 0; j < 16; ++j) ss += o[j] * o[j];
        ss += __shfl_xor(ss, 1); ss += __shfl_xor(ss, 2); ss += __shfl_xor(ss, 4);
        const float sc = 1.f / sqrtf(ss * (1.f / 128.f) + NORM_EPS);
#pragma unroll
        for (int j = 0; j < 16; ++j) o[j] = o[j] * sc * ng[j] * siluf_(g[j]);
        *(GAS v4u*)(O + (size_t)m * D + c0) = pack8(o); *(GAS v4u*)(O + (size_t)m * D + c0 + 8) = pack8(o + 8);
    }
}

typedef short bf16x8_t __attribute__((ext_vector_type(8)));
typedef float f32x16 __attribute__((ext_vector_type(16)));
__device__ __forceinline__ int crow(int r, int hi) { return (r & 3) + 8 * (r >> 2) + 4 * hi; }
constexpr int NCH = TT / 64;
__device__ __forceinline__ void p0_s5_tables(Frame& F) {
    LAS unsigned char* L = F.lds + RING_OFF;
    LAS double* lam = (LAS double*)L;
    LAS float* bb = (LAS float*)(L + 1024);
    LAS float* cc = (LAS float*)(L + 1024 + 8192);
    LAS float* pw = (LAS float*)(L + 1024 + 16384);
    unsigned char* ws = ws_(F);
    for (int item = (int)blockIdx.x - 192; item >= 0 && item < 64; item += F.G) {
        const int g = item >> 1, d = item & 1;
        __syncthreads();
        if (F.tid < 64) { const int n = F.tid, pi = (d * 32 + g) * 64 + n;
            const double lre = inp(F, 17)[pi], lim = inp(F, 18)[pi], dt = exp((double)inp(F, 19)[d * 32 + g]);
            const double mag = exp(lre * dt), are = mag * cos(lim * dt), aim = mag * sin(lim * dt), den = lre * lre + lim * lim, nr = are - 1.0;
            const double fr = (nr * lre + aim * lim) / den, fi = (aim * lre - nr * lim) / den;
            lam[2 * n] = lre * dt; lam[2 * n + 1] = lim * dt;
            for (int q = 0; q < 16; ++q) { const double br = inp(F, 20)[(size_t)pi * 16 + q], bi = inp(F, 21)[(size_t)pi * 16 + q];
                bb[(n * 16 + q) * 2] = (float)(fr * br - fi * bi); bb[(n * 16 + q) * 2 + 1] = (float)(fr * bi + fi * br); } }
        for (int i = F.tid; i < 1024; i += 512) { const int p = i >> 6, n = i & 63; cc[i * 2] = inp(F, 22)[((size_t)(d * 32 + g) * 16 + p) * 64 + n]; cc[i * 2 + 1] = inp(F, 23)[((size_t)(d * 32 + g) * 16 + p) * 64 + n]; }
        __syncthreads();
        if (F.tid < 64) { const int n = F.tid; const double m1 = exp(lam[2 * n]), ar = m1 * cos(lam[2 * n + 1]), ai = m1 * sin(lam[2 * n + 1]);
            double pr = 1.0, pim = 0.0;
            for (int e = 0; e <= 64; ++e) { pw[(e * 64 + n) * 2] = (float)pr; pw[(e * 64 + n) * 2 + 1] = (float)pim; const double nr = pr * ar - pim * ai, ni = pr * ai + pim * ar; pr = nr; pim = ni; } }
        __syncthreads();
        { bf16* WF = (bf16*)(ws + WS_WF) + (size_t)g * 256 * 1024;
          for (int i = F.tid; i < 128 * 128; i += 512) { const int row = i >> 7, grp = i & 127, c = row >> 6, n = row & 63, sI = grp >> 1, q0 = (grp & 1) * 8, e = d ? sI : 63 - sI;
              const float pr = pw[(e * 64 + n) * 2], pim = pw[(e * 64 + n) * 2 + 1]; float o[8];
#pragma unroll
              for (int j = 0; j < 8; ++j) { const float br = bb[(n * 16 + q0 + j) * 2], bi = bb[(n * 16 + q0 + j) * 2 + 1]; o[j] = c ? (pr * bi + pim * br) : (pr * br - pim * bi); }
              *(GAS v4u*)(WF + (size_t)(d * 128 + row) * 1024 + sI * 16 + q0) = pack8(o); } }
        { bf16* WC = (bf16*)(ws + WS_WC) + (size_t)g * 1024 * 256;
          for (int i = F.tid; i < 1024 * 16; i += 512) { const int row = i >> 4, grp = i & 15, t = row >> 4, p = row & 15, c = grp >> 3, n0 = (grp & 7) * 8, ex = d ? 64 - t : t + 1; float o[8];
#pragma unroll
              for (int j = 0; j < 8; ++j) { const int n = n0 + j; const float pr = pw[(ex * 64 + n) * 2], pim = pw[(ex * 64 + n) * 2 + 1], cr = cc[(p * 64 + n) * 2], ci = cc[(p * 64 + n) * 2 + 1];
                  o[j] = c ? -(cr * pim + ci * pr) : (cr * pr - ci * pim); }
              *(GAS v4u*)(WC + (size_t)row * 256 + d * 128 + c * 64 + n0) = pack8(o); } }
        { bf16* TP = (bf16*)(ws + WS_TOEP) + (size_t)g * 127 * 256; float* T0 = (float*)(ws + WS_T0) + (size_t)(g * 2 + d) * 256;
          for (int i = F.tid; i < 64 * 16; i += 512) { const int tau = i >> 4, p = i & 15; float acc[16];
#pragma unroll
              for (int q = 0; q < 16; ++q) acc[q] = 0.f;
              for (int n = 0; n < 64; ++n) { const float pr = pw[(tau * 64 + n) * 2], pim = pw[(tau * 64 + n) * 2 + 1], cr = cc[(p * 64 + n) * 2], ci = cc[(p * 64 + n) * 2 + 1];
                  const float tr = cr * pr - ci * pim, ti = cr * pim + ci * pr;
                  const LAS f32x4* bq = (const LAS f32x4*)(bb + n * 32);
#pragma unroll
                  for (int q4 = 0; q4 < 8; ++q4) { const f32x4 v = bq[q4]; acc[2 * q4] += tr * v.x - ti * v.y; acc[2 * q4 + 1] += tr * v.z - ti * v.w; } }
              if (tau == 0) {
#pragma unroll
                  for (int q = 0; q < 16; ++q) T0[p * 16 + q] = acc[q]; }
              else { bf16* o = TP + (size_t)(d ? 63 - tau : 63 + tau) * 256 + p * 16; *(GAS v4u*)o = pack8(acc); *(GAS v4u*)(o + 8) = pack8(acc + 8); } } }
        if (F.tid < 64) { float* A64 = (float*)(ws + WS_A64) + (size_t)((g * 2 + d) * 64 + F.tid) * 2; A64[0] = pw[(64 * 64 + F.tid) * 2]; A64[1] = pw[(64 * 64 + F.tid) * 2 + 1]; }
    }
    __syncthreads();
}
__device__ __forceinline__ void ph_s5_finals(Frame& F) {
    const int lane = F.lane, r32 = lane & 31, hh = lane >> 5, wave = F.wave;
    unsigned char* ws = ws_(F);
    for (int u = blockIdx.x; u < 288; u += F.G) {
        const int g = u / 9, nb = u % 9; int chunk = nb * 32 + r32; const bool valid = chunk < NCH; if (!valid) chunk = NCH - 1;
        const bf16* ub = (const bf16*)(ws + WS_UG) + ((size_t)g * TT + (size_t)chunk * 64) * 16 + 8 * hh;
        const bf16* wf = (const bf16*)(ws + WS_WF) + ((size_t)(g * 256 + 32 * wave + r32)) * 1024 + 8 * hh;
        f32x16 acc;
#pragma unroll
        for (int r = 0; r < 16; ++r) acc[r] = 0.f;
#pragma unroll 16
        for (int sI = 0; sI < 64; ++sI) { const bf16x8_t a = *(const GAS bf16x8_t*)(wf + 16 * sI), b = *(const GAS bf16x8_t*)(ub + 16 * sI); acc = __builtin_amdgcn_mfma_f32_32x32x16_bf16(a, b, acc, 0, 0, 0); }
        if (valid) { float* fo = (float*)(ws + WS_FIN) + ((size_t)g * NCH + chunk) * 256 + 32 * wave + 4 * hh;
#pragma unroll
            for (int k = 0; k < 4; ++k) *(GAS f32x4*)(fo + 8 * k) = (f32x4){acc[4 * k], acc[4 * k + 1], acc[4 * k + 2], acc[4 * k + 3]}; }
    }
}
__device__ __forceinline__ int s5_chunk_of(int step, int d, int b) { return step < 4 ? 256 + 4 * b + (d ? 3 - step : step) : 128 * b + (d ? 127 - (step - 4) : step - 4); }
__device__ __forceinline__ void ph_s5_carry(Frame& F) {
    if (F.wave >= 3) return;
    unsigned char* ws = ws_(F);
    for (int item = ((int)F.G - 1 - (int)blockIdx.x) * 3 + F.wave; item < 128; item += 3 * F.G) {
        const int g = item >> 2, d = (item >> 1) & 1, b = item & 1, n = F.lane;
        const float a_r = ((const float*)(ws + WS_A64))[((g * 2 + d) * 64 + n) * 2], a_i = ((const float*)(ws + WS_A64))[((g * 2 + d) * 64 + n) * 2 + 1];
        const float* Fb = (const float*)(ws + WS_FIN) + (size_t)g * NCH * 256 + d * 128 + n; bf16* Sb = (bf16*)(ws + WS_SIN) + (size_t)g * NCH * 256 + d * 128 + n;
        float sr = 0.f, si = 0.f;
        for (int s0 = 0; s0 < 132; s0 += 12) {
            float fr[12], fi[12];
#pragma unroll
            for (int j = 0; j < 12; ++j) { const int c = s5_chunk_of(s0 + j, d, b); fr[j] = Fb[(size_t)c * 256]; fi[j] = Fb[(size_t)c * 256 + 64]; }
#pragma unroll
            for (int j = 0; j < 12; ++j) { const int c = s5_chunk_of(s0 + j, d, b); Sb[(size_t)c * 256] = (bf16)f2bf(sr); Sb[(size_t)c * 256 + 64] = (bf16)f2bf(si);
                const float nr = a_r * sr - a_i * si + fr[j], ni = a_r * si + a_i * sr + fi[j]; sr = nr; si = ni; }
        }
    }
}
constexpr int TP_PITCH = 48;
__device__ __forceinline__ void ph_s5_out(Frame& F) {
    LAS unsigned char* L = F.lds + RING_OFF;
    const int lane = F.lane, r32 = lane & 31, hh = lane >> 5, wave = F.wave, tid = F.tid;
    unsigned char* ws = ws_(F);
    for (int u = blockIdx.x; u < 288; u += F.G) {
        const int g = u / 9, nb = u % 9; int chunk = nb * 32 + r32; const bool valid = chunk < NCH; if (!valid) chunk = NCH - 1;
        __syncthreads();
        { const GAS v4u* tp = (const GAS v4u*)((const bf16*)(ws + WS_TOEP) + (size_t)g * 127 * 256); const float* t0 = (const float*)(ws + WS_T0) + (size_t)g * 512;
          for (int c = tid; c < 127 * 32; c += 512) { const int di = c >> 5, p = (c >> 1) & 15, half = c & 1; v4u v;
              if (di == 63) { float o[8];
#pragma unroll
                  for (int j = 0; j < 8; ++j) o[j] = t0[p * 16 + half * 8 + j] + t0[256 + p * 16 + half * 8 + j];
                  v = pack8(o); }
              else v = tp[c];
              *(LAS v4u*)(L + (di * 16 + p) * TP_PITCH + half * 16) = v; } }
        __syncthreads();
        const bf16* ub = (const bf16*)(ws + WS_UG) + ((size_t)g * TT + (size_t)chunk * 64) * 16 + 8 * hh;
        f32x16 acc[4];
#pragma unroll
        for (int i = 0; i < 4; ++i)
#pragma unroll
            for (int r = 0; r < 16; ++r) acc[i][r] = 0.f;
        const LAS unsigned char* tl = L + ((63 + 2 * wave + (r32 >> 4)) * 16 + (r32 & 15)) * TP_PITCH + hh * 16;
#pragma unroll 1
        for (int s0 = 0; s0 < 64; s0 += 16) {
            bf16x8_t bq[16];
#pragma unroll
            for (int e = 0; e < 16; ++e) bq[e] = *(const GAS bf16x8_t*)(ub + 16 * (s0 + e));
#pragma unroll
            for (int e = 0; e < 16; ++e) { const int sI = s0 + e; const bf16x8_t b = bq[e];
#pragma unroll
            for (int i = 0; i < 4; ++i) { const bf16x8_t a = *(const LAS bf16x8_t*)(tl + (16 * i - sI) * 16 * TP_PITCH); acc[i] = __builtin_amdgcn_mfma_f32_32x32x16_bf16(a, b, acc[i], 0, 0, 0); }
            }
        }
        { const bf16* sb = (const bf16*)(ws + WS_SIN) + ((size_t)g * NCH + chunk) * 256 + 8 * hh;
          const bf16* wc = (const bf16*)(ws + WS_WC) + ((size_t)g * 1024 + 32 * wave + r32) * 256 + 8 * hh;
#pragma unroll 4
          for (int kk = 0; kk < 16; ++kk) {
              const bf16x8_t b = *(const GAS bf16x8_t*)(sb + 16 * kk);
#pragma unroll
              for (int i = 0; i < 4; ++i) { const bf16x8_t a = *(const GAS bf16x8_t*)(wc + (size_t)(256 * i) * 256 + 16 * kk); acc[i] = __builtin_amdgcn_mfma_f32_32x32x16_bf16(a, b, acc[i], 0, 0, 0); }
          } }
        if (valid) {
            const float* dsk = inp(F, 24) + 16 * g;
#pragma unroll
            for (int i = 0; i < 4; ++i)
#pragma unroll
                for (int k = 0; k < 4; ++k) { const int tloc = 2 * (wave + 8 * i) + (k >> 1), p0 = 8 * (k & 1) + 4 * hh; const size_t m = (size_t)chunk * 64 + tloc;
                    const v2u uw = *(const GAS v2u*)((const bf16*)(ws + WS_UG) + ((size_t)g * TT + m) * 16 + p0);
                    const float y0 = gelu_tanh(acc[i][4 * k] + dsk[p0] * bflo(uw.x)), y1 = gelu_tanh(acc[i][4 * k + 1] + dsk[p0 + 1] * bfhi(uw.x));
                    const float y2 = gelu_tanh(acc[i][4 * k + 2] + dsk[p0 + 2] * bflo(uw.y)), y3 = gelu_tanh(acc[i][4 * k + 3] + dsk[p0 + 3] * bfhi(uw.y));
                    v2u zw; zw.x = pk2(y0, y1); zw.y = pk2(y2, y3);
                    *(GAS v2u*)((bf16*)(ws + WS_Z) + m * 512 + 16 * g + p0) = zw; }
        }
    }
}

__device__ __forceinline__ bf16x8_t pack_frag(const f32x16& p, int base) {
    v4u w; w.x = pg8::cvt_pk_bf16(p[base + 0], p[base + 1]); w.y = pg8::cvt_pk_bf16(p[base + 2], p[base + 3]); w.z = pg8::cvt_pk_bf16(p[base + 4], p[base + 5]); w.w = pg8::cvt_pk_bf16(p[base + 6], p[base + 7]);
    return __builtin_bit_cast(bf16x8_t, w);
}
constexpr int AT_KP = 208, AT_VP = 272;
constexpr int AT_KB = 128 * AT_KP, AT_VB = 64 * AT_VP;
constexpr int AT_K0 = 0, AT_V0 = 2 * AT_KB, AT_WS = 2 * AT_KB + 2 * AT_VB;
__device__ __forceinline__ void ph_attn(Frame& F) {
    LAS unsigned char* L = F.lds + RING_OFF;
    const int lane = F.lane, r32 = lane & 31, hi = lane >> 5, wave = F.wave, tid = F.tid;
    volatile LAS float* wsf = (volatile LAS float*)(L + AT_WS) + wave * 32;
    const bf16* Qb = (const bf16*)(ws_(F) + WS_QB); const bf16* Kb = (const bf16*)(ws_(F) + WS_KB); const bf16* Vt = (const bf16*)(ws_(F) + WS_VB);
    bf16* MIX = (bf16*)(ws_(F) + WS_MIX);
    int kl[3], vl[2];
#pragma unroll
    for (int i = 0; i < 3; ++i) { const int c = tid + 512 * i; kl[i] = (c / 12) * AT_KP + (c % 12) * 16; }
#pragma unroll
    for (int i = 0; i < 2; ++i) { const int c = tid + 512 * i; vl[i] = ((c & 511) >> 3) * AT_VP + (c >> 9) * 128 + (c & 7) * 16; }
    for (int it = 0; it < 3; ++it) {
        int u; if (it < 2) u = it * 256 + F.vcu; else { if (F.vcu >= 16) break; u = 512 + F.vcu; }
        int b, h, tq0, NT, m0;
        if (u < 512) { b = u >> 8; h = (u >> 5) & 7; tq0 = (u & 31) * 256; NT = TQK / 128; m0 = b * SEQ + tq0; }
        else { const int uc = u - 512; b = uc >> 3; h = uc & 7; tq0 = SEQ; NT = CTXL / 128; m0 = TL + b * CTXL; }
        const size_t bh = (size_t)(b * 8 + h);
        const GAS v4u* Kg = (const GAS v4u*)(Kb + bh * TQK * 96);
        const GAS v4u* Vg = (const GAS v4u*)(Vt + bh * (TQK / 64) * 4096);
        bf16x8_t qf[6];
        { const bf16* qp = Qb + (bh * TQK + tq0 + wave * 32 + r32) * 96 + hi * 8;
#pragma unroll
          for (int ks = 0; ks < 6; ++ks) qf[ks] = *(const GAS bf16x8_t*)(qp + ks * 16); }
        f32x16 o0, o1;
#pragma unroll
        for (int r = 0; r < 16; ++r) { o0[r] = 0.f; o1[r] = 0.f; }
        float m_run = -1e30f, l_run = 0.f;
        __syncthreads();
        { v4u a[3], v[2];
#pragma unroll
          for (int i = 0; i < 3; ++i) a[i] = Kg[tid + 512 * i];
#pragma unroll
          for (int i = 0; i < 2; ++i) v[i] = Vg[tid + 512 * i];
#pragma unroll
          for (int i = 0; i < 3; ++i) *(LAS v4u*)(L + AT_K0 + kl[i]) = a[i];
#pragma unroll
          for (int i = 0; i < 2; ++i) *(LAS v4u*)(L + AT_V0 + vl[i]) = v[i]; }
        __syncthreads();
        for (int t = 0; t < NT; ++t) {
            const int cur = t & 1, nxt = cur ^ 1; const bool more = (t + 1 < NT);
            v4u na[3], nv[2];
#pragma unroll
            for (int i = 0; i < 3; ++i) na[i] = (v4u){0u, 0u, 0u, 0u};
#pragma unroll
            for (int i = 0; i < 2; ++i) nv[i] = (v4u){0u, 0u, 0u, 0u};
            if (more) {
#pragma unroll
                for (int i = 0; i < 3; ++i) na[i] = Kg[(size_t)(t + 1) * 1536 + tid + 512 * i];
#pragma unroll
                for (int i = 0; i < 2; ++i) nv[i] = Vg[(size_t)(t + 1) * 1024 + tid + 512 * i]; }
            const LAS unsigned char* Kl = L + AT_K0 + cur * AT_KB + r32 * AT_KP + hi * 16;
            const LAS unsigned char* Vl = L + AT_V0 + cur * AT_VB + r32 * AT_VP + hi * 16;
            f32x16 p[4];
#pragma unroll
            for (int kb = 0; kb < 4; ++kb) {
#pragma unroll
                for (int r = 0; r < 16; ++r) p[kb][r] = 0.f;
#pragma unroll
                for (int ks = 0; ks < 6; ++ks) p[kb] = __builtin_amdgcn_mfma_f32_32x32x16_bf16(*(const LAS bf16x8_t*)(Kl + kb * 32 * AT_KP + ks * 32), qf[ks], p[kb], 0, 0, 0);
            }
            float mt = fmaxf(fmaxf(p[0][0], p[1][0]), fmaxf(p[2][0], p[3][0]));
#pragma unroll
            for (int r = 1; r < 16; ++r) mt = fmaxf(mt, fmaxf(fmaxf(p[0][r], p[1][r]), fmaxf(p[2][r], p[3][r])));
            mt = fmaxf(mt, __shfl_xor(mt, 32));
            const bool need = mt > m_run + 8.0f;
            if (__any(need)) {
                const float mn = need ? mt : m_run, alpha = __builtin_amdgcn_exp2f(m_run - mn);
                l_run *= alpha; m_run = mn;
                if (hi == 0) wsf[r32] = alpha;
#pragma unroll
                for (int r = 0; r < 16; ++r) { const float a = wsf[crow(r, hi)]; o0[r] *= a; o1[r] *= a; }
            }
            float sum = 0.f;
#pragma unroll
            for (int kb = 0; kb < 4; ++kb)
#pragma unroll
                for (int r = 0; r < 16; ++r) { p[kb][r] = __builtin_amdgcn_exp2f(p[kb][r] - m_run); sum += p[kb][r]; }
            l_run += sum;
#pragma unroll
            for (int kb = 0; kb < 4; ++kb) {
                const bf16x8_t pa = pack_frag(p[kb], 0), pb = pack_frag(p[kb], 8);
                const LAS unsigned char* vp = Vl + (kb >> 1) * 128 + (kb & 1) * 64;
                o0 = __builtin_amdgcn_mfma_f32_32x32x16_bf16(pa, *(const LAS bf16x8_t*)(vp), o0, 0, 0, 0);
                o0 = __builtin_amdgcn_mfma_f32_32x32x16_bf16(pb, *(const LAS bf16x8_t*)(vp + 32), o0, 0, 0, 0);
                o1 = __builtin_amdgcn_mfma_f32_32x32x16_bf16(pa, *(const LAS bf16x8_t*)(vp + 32 * AT_VP), o1, 0, 0, 0);
                o1 = __builtin_amdgcn_mfma_f32_32x32x16_bf16(pb, *(const LAS bf16x8_t*)(vp + 32 * AT_VP + 32), o1, 0, 0, 0);
            }
            if (more) {
#pragma unroll
                for (int i = 0; i < 3; ++i) *(LAS v4u*)(L + AT_K0 + nxt * AT_KB + kl[i]) = na[i];
#pragma unroll
                for (int i = 0; i < 2; ++i) *(LAS v4u*)(L + AT_V0 + nxt * AT_VB + vl[i]) = nv[i]; }
            __syncthreads();
        }
        l_run += __shfl_xor(l_run, 32);
        if (hi == 0) wsf[r32] = 1.0f / l_run;
#pragma unroll
        for (int r = 0; r < 16; ++r) { const int q = crow(r, hi); const float inv = wsf[q];
            bf16* op = MIX + (size_t)(m0 + wave * 32 + q) * D + h * 64 + r32;
            op[0] = (bf16)f2bf(o0[r] * inv); op[32] = (bf16)f2bf(o1[r] * inv); }
    }
}

constexpr int HG_QT = 0, HG_KT = 17408, HG_KH = 34816, HG_VT = 53248, HG_ST = 71680, HG_DEC = 106496, HG_TOT = 107008;
constexpr int HG_NSC = 17;
constexpr size_t WS_SD = 231 * MiB;
constexpr size_t WS_DECS = WS_SD + 18 * MiB;
static_assert(WS_DECS + 32 * 17 * 128 * 4 <= WS_END, "hgrn ws");
template <bool OUT>
__device__ __forceinline__ void hgrn_pass(Frame& F, int b, int h, int dir, int sc, f32x16 (&st)[2], float& dsum) {
    LAS unsigned char* L = F.lds + RING_OFF;
    unsigned char* ws = ws_(F);
    const int tid = F.tid, lane = F.lane, r32 = lane & 31, hh = lane >> 5, wave = F.wave;
    const int k = tid & 127, tg = tid >> 7;
    const int nch = sc == 0 ? 4 : 8; const size_t rowbase = sc == 0 ? (size_t)TL + b * CTXL : (size_t)b * SEQ + (size_t)(sc - 1) * 512;
    const bf16* QF = (const bf16*)(ws + WS_QFFI);
    const float lb = ((const float*)(ws + WS_LBV))[dir * 1024 + h * 128 + k];
    const int colf = 1024 * (1 + dir) + h * 128 + k, colq = h * 128 + k, colv = 3072 + h * 128 + k;
    const int dvb = wave & 3, jb = wave >> 2;
    bf16 rq[16], rf[16], rv[16];
#define HG_LOAD(ci) do { const int cc_ = dir ? nch - 1 - (ci) : (ci); const int tl0_ = dir ? 63 - 16 * tg : 16 * tg; \
        const bf16* pf_ = QF + (rowbase + 64 * cc_ + tl0_) * 4096 + colf; const bf16* pv_ = pf_ + (colv - colf); const bf16* pq_ = pf_ + (colq - colf); const long stp_ = dir ? -4096 : 4096; \
        _Pragma("unroll") for (int jj = 0; jj < 16; ++jj) { rf[jj] = *pf_; rv[jj] = *pv_; if (OUT) rq[jj] = *pq_; pf_ += stp_; pv_ += stp_; pq_ += stp_; asm volatile("" : "+v"(pf_), "+v"(pv_), "+v"(pq_)); } } while (0)
    HG_LOAD(0);
    for (int ci = 0; ci < nch; ++ci) {
        const int cc = dir ? nch - 1 - ci : ci;
        float cum[16], kk[16];
        { float run = 0.f;
#pragma unroll
          for (int jj = 0; jj < 16; ++jj) { const float f = lb + (1.f - lb) * sigmoidf_(bf2f(rf[jj])); run += __log2f(f); cum[jj] = run; kk[jj] = 1.f - f; }
          ((LAS float*)(L + HG_TOT))[tg * 128 + k] = run; }
        __syncthreads();
        { const LAS float* tot = (const LAS float*)(L + HG_TOT) + k; const float t0 = tot[0], t1 = tot[128], t2 = tot[256], t3 = tot[384];
          const float pre = tg == 0 ? 0.f : (tg == 1 ? t0 : (tg == 2 ? t0 + t1 : t0 + t1 + t2)), total = (t0 + t1) + (t2 + t3);
          if (tg == 0) { ((LAS float*)(L + HG_DEC))[k] = __builtin_amdgcn_exp2f(total); dsum += total; }
#define HG_KH(jj) (kk[jj] * __builtin_amdgcn_exp2f(total - (pre + cum[jj])))
#define HG_PKV(a, b_) ((unsigned)rv[a] | ((unsigned)rv[b_] << 16))
          if (OUT) {
#pragma unroll
              for (int jj = 0; jj < 16; ++jj) { const float c = pre + cum[jj]; const int j = 16 * tg + jj;
                  *(LAS bf16*)(L + HG_QT + j * 272 + k * 2) = (bf16)f2bf(bf2f(rq[jj]) * __builtin_amdgcn_exp2f(c)); *(LAS bf16*)(L + HG_KT + j * 272 + k * 2) = (bf16)f2bf(kk[jj] * __builtin_amdgcn_exp2f(-c)); } }
          v4u w0, w1;
          w0.x = pk2(HG_KH(0), HG_KH(1)); w0.y = pk2(HG_KH(2), HG_KH(3)); w0.z = pk2(HG_KH(8), HG_KH(9)); w0.w = pk2(HG_KH(10), HG_KH(11));
          w1.x = pk2(HG_KH(4), HG_KH(5)); w1.y = pk2(HG_KH(6), HG_KH(7)); w1.z = pk2(HG_KH(12), HG_KH(13)); w1.w = pk2(HG_KH(14), HG_KH(15));
          *(LAS v4u*)(L + HG_KH + k * 144 + tg * 32) = w0; *(LAS v4u*)(L + HG_KH + k * 144 + tg * 32 + 16) = w1;
          w0.x = HG_PKV(0, 1); w0.y = HG_PKV(2, 3); w0.z = HG_PKV(8, 9); w0.w = HG_PKV(10, 11);
          w1.x = HG_PKV(4, 5); w1.y = HG_PKV(6, 7); w1.z = HG_PKV(12, 13); w1.w = HG_PKV(14, 15);
          *(LAS v4u*)(L + HG_VT + k * 144 + tg * 32) = w0; *(LAS v4u*)(L + HG_VT + k * 144 + tg * 32 + 16) = w1; }
#undef HG_KH
#undef HG_PKV
        if (ci + 1 < nch) HG_LOAD(ci + 1);
        __syncthreads();
        if (OUT) {
            f32x16 oacc;
#pragma unroll
            for (int r = 0; r < 16; ++r) oacc[r] = 0.f;
            const LAS unsigned char* qrow = L + HG_QT + (32 * jb + r32) * 272 + hh * 16;
            const LAS unsigned char* srow = L + HG_ST + (32 * dvb + r32) * 272 + hh * 16;
            const LAS unsigned char* vrow = L + HG_VT + (32 * dvb + r32) * 144 + hh * 16;
#pragma unroll
            for (int ks = 0; ks < 8; ++ks) oacc = __builtin_amdgcn_mfma_f32_32x32x16_bf16(*(const LAS bf16x8_t*)(qrow + ks * 32), *(const LAS bf16x8_t*)(srow + ks * 32), oacc, 0, 0, 0);
            {
                f32x16 at;
#pragma unroll
                for (int r = 0; r < 16; ++r) at[r] = 0.f;
                const LAS unsigned char* krow = L + HG_KT + r32 * 272 + hh * 16;
#pragma unroll
                for (int ks = 0; ks < 8; ++ks) at = __builtin_amdgcn_mfma_f32_32x32x16_bf16(*(const LAS bf16x8_t*)(krow + ks * 32), *(const LAS bf16x8_t*)(qrow + ks * 32), at, 0, 0, 0);
                if (jb == 0) {
#pragma unroll
                    for (int r = 0; r < 16; ++r) if (crow(r, hh) > r32) at[r] = 0.f; }
                oacc = __builtin_amdgcn_mfma_f32_32x32x16_bf16(pack_frag(at, 0), *(const LAS bf16x8_t*)(vrow + 0), oacc, 0, 0, 0);
                oacc = __builtin_amdgcn_mfma_f32_32x32x16_bf16(pack_frag(at, 8), *(const LAS bf16x8_t*)(vrow + 32), oacc, 0, 0, 0);
            }
            if (jb == 1) {
                f32x16 at;
#pragma unroll
                for (int r = 0; r < 16; ++r) at[r] = 0.f;
                const LAS unsigned char* krow = L + HG_KT + (32 + r32) * 272 + hh * 16;
#pragma unroll
                for (int ks = 0; ks < 8; ++ks) at = __builtin_amdgcn_mfma_f32_32x32x16_bf16(*(const LAS bf16x8_t*)(krow + ks * 32), *(const LAS bf16x8_t*)(qrow + ks * 32), at, 0, 0, 0);
#pragma unroll
                for (int r = 0; r < 16; ++r) if (crow(r, hh) > r32) at[r] = 0.f;
                oacc = __builtin_amdgcn_mfma_f32_32x32x16_bf16(pack_frag(at, 0), *(const LAS bf16x8_t*)(vrow + 64), oacc, 0, 0, 0);
                oacc = __builtin_amdgcn_mfma_f32_32x32x16_bf16(pack_frag(at, 8), *(const LAS bf16x8_t*)(vrow + 96), oacc, 0, 0, 0);
            }
            bf16* O = (bf16*)(ws + WS_O);
#pragma unroll
            for (int r = 0; r < 16; ++r) { const int j = 32 * jb + crow(r, hh), tl = dir ? 63 - j : j;
                bf16* op = O + (rowbase + 64 * cc + tl) * D + h * 128 + 32 * dvb + r32; float ov = oacc[r];
                if (dir) ov += bf2f(*op);
                *op = (bf16)f2bf(ov); }
        }
#pragma unroll
        for (int t = 0; t < 2; ++t) { const int dkb = 2 * (wave >> 2) + t;
#pragma unroll
            for (int q4 = 0; q4 < 4; ++q4) { const f32x4 dd = *(const LAS f32x4*)(L + HG_DEC + (32 * dkb + 8 * q4 + 4 * hh) * 4);
                st[t][4 * q4] *= dd[0]; st[t][4 * q4 + 1] *= dd[1]; st[t][4 * q4 + 2] *= dd[2]; st[t][4 * q4 + 3] *= dd[3]; }
            const LAS unsigned char* arow = L + HG_KH + (32 * dkb + r32) * 144 + hh * 16; const LAS unsigned char* vrow = L + HG_VT + (32 * dvb + r32) * 144 + hh * 16;
#pragma unroll
            for (int ks = 0; ks < 4; ++ks) st[t] = __builtin_amdgcn_mfma_f32_32x32x16_bf16(*(const LAS bf16x8_t*)(arow + ks * 32), *(const LAS bf16x8_t*)(vrow + ks * 32), st[t], 0, 0, 0); }
        __syncthreads();
        if (OUT && ci + 1 < nch) {
#pragma unroll
            for (int t = 0; t < 2; ++t) { const int dkb = 2 * (wave >> 2) + t;
#pragma unroll
                for (int q4 = 0; q4 < 4; ++q4) { v2u w; w.x = pk2(st[t][4 * q4], st[t][4 * q4 + 1]); w.y = pk2(st[t][4 * q4 + 2], st[t][4 * q4 + 3]);
                    *(LAS v2u*)(L + HG_ST + (32 * dvb + r32) * 272 + (32 * dkb + 8 * q4 + 4 * hh) * 2) = w; } }
        }
    }
#undef HG_LOAD
}
__device__ __forceinline__ void ph_hgrn_states(Frame& F) {
    unsigned char* ws = ws_(F);
    for (int item = blockIdx.x; item < 32 * HG_NSC; item += F.G) {
        const int chain = item / HG_NSC, sc = item % HG_NSC, b = chain >> 4, h = (chain >> 1) & 7, dir = chain & 1;
        f32x16 st[2];
#pragma unroll
        for (int t = 0; t < 2; ++t)
#pragma unroll
            for (int r = 0; r < 16; ++r) st[t][r] = 0.f;
        float dsum = 0.f;
        hgrn_pass<false>(F, b, h, dir, sc, st, dsum);
        bf16* sd = (bf16*)(ws + WS_SD) + ((size_t)(chain * HG_NSC + sc) * 8 + F.wave) * 2048 + F.lane;
#pragma unroll
        for (int t = 0; t < 2; ++t)
#pragma unroll
            for (int r = 0; r < 16; ++r) sd[(t * 16 + r) * 64] = (bf16)f2bf(st[t][r]);
        if (F.tid < 128) ((float*)(ws + WS_DECS))[(size_t)(chain * HG_NSC + sc) * 128 + F.tid] = dsum;
    }
}
__device__ __forceinline__ void ph_hgrn_out(Frame& F) {
    LAS unsigned char* L = F.lds + RING_OFF;
    unsigned char* ws = ws_(F);
    const int lane = F.lane, r32 = lane & 31, hh = lane >> 5, wave = F.wave, dvb = wave & 3;
    for (int item = blockIdx.x; item < 256; item += F.G) {
        const int b = item >> 7, h = (item >> 4) & 7, Lsc = item & 15, sc = Lsc + 1;
        for (int dir = 0; dir < 2; ++dir) {
            const int chain = (b * 8 + h) * 2 + dir;
            f32x16 st[2];
#pragma unroll
            for (int t = 0; t < 2; ++t)
#pragma unroll
                for (int r = 0; r < 16; ++r) st[t][r] = 0.f;
            const int npre = dir ? 1 + (16 - sc) : sc;
            for (int i = 0; i < npre; ++i) {
                const int sp = (i == 0) ? 0 : (dir ? 17 - i : i);
                const bf16* sd = (const bf16*)(ws + WS_SD) + ((size_t)(chain * HG_NSC + sp) * 8 + wave) * 2048 + lane;
                const float* dl = (const float*)(ws + WS_DECS) + (size_t)(chain * HG_NSC + sp) * 128;
#pragma unroll
                for (int t = 0; t < 2; ++t) { const int dkb = 2 * (wave >> 2) + t;
#pragma unroll
                    for (int q4 = 0; q4 < 4; ++q4) { const f32x4 dd = *(const GAS f32x4*)(dl + 32 * dkb + 8 * q4 + 4 * hh);
#pragma unroll
                        for (int e = 0; e < 4; ++e) st[t][4 * q4 + e] = __builtin_amdgcn_exp2f(dd[e]) * st[t][4 * q4 + e] + bf2f(sd[(t * 16 + 4 * q4 + e) * 64]); } }
            }
            __syncthreads();
#pragma unroll
            for (int t = 0; t < 2; ++t) { const int dkb = 2 * (wave >> 2) + t;
#pragma unroll
                for (int q4 = 0; q4 < 4; ++q4) { v2u w; w.x = pk2(st[t][4 * q4], st[t][4 * q4 + 1]); w.y = pk2(st[t][4 * q4 + 2], st[t][4 * q4 + 3]);
                    *(LAS v2u*)(L + HG_ST + (32 * dvb + r32) * 272 + (32 * dkb + 8 * q4 + 4 * hh) * 2) = w; } }
            float dsum = 0.f;
            hgrn_pass<true>(F, b, h, dir, sc, st, dsum);
            __syncthreads();
        }
    }
}

struct FInProj {
    bf16* cqkv; bf16* ug;
    __device__ __forceinline__ void operator()(int row, int col, f32x4 v0, f32x4 v1) const {
        v4u w; w.x = pg8::cvt_pk_bf16(v0[0], v0[1]); w.y = pg8::cvt_pk_bf16(v0[2], v0[3]); w.z = pg8::cvt_pk_bf16(v1[0], v1[1]); w.w = pg8::cvt_pk_bf16(v1[2], v1[3]);
        if (col < 672) *(GAS v4u*)(cqkv + (size_t)row * CQKV_LD + col) = w;
        else if (col < EVEN_IN) { const int c = col - 672; *(GAS v4u*)(ug + ((size_t)(c >> 4) * TT + row) * 16 + (c & 15)) = w; }
    }
};
struct FBf16 {
    bf16* o; int ld;
    __device__ __forceinline__ void operator()(int row, int col, f32x4 v0, f32x4 v1) const {
        v4u w; w.x = pg8::cvt_pk_bf16(v0[0], v0[1]); w.y = pg8::cvt_pk_bf16(v0[2], v0[3]); w.z = pg8::cvt_pk_bf16(v1[0], v1[1]); w.w = pg8::cvt_pk_bf16(v1[2], v1[3]);
        *(GAS v4u*)(o + (size_t)row * ld + col) = w;
    }
};
struct FGlu {
    const bf16* z; bf16* mix;
    __device__ __forceinline__ void operator()(int row, int col, f32x4 v0, f32x4 v1) const {
        float zz[8]; unpack8(*(const GAS v4u*)(z + (size_t)row * 512 + col), zz);
        float o[8];
#pragma unroll
        for (int j = 0; j < 4; ++j) { o[j] = zz[j] * sigmoidf_(v0[j]); o[4 + j] = zz[4 + j] * sigmoidf_(v1[j]); }
        *(GAS v4u*)(mix + (size_t)row * D + 512 + col) = pack8(o);
    }
};
struct FQ {
    bf16* qb; const float* rope;
    __device__ __forceinline__ void operator()(int row, int col, f32x4 v0, f32x4 v1) const {
        float x[8] = {v0[0], v0[1], v0[2], v0[3], v1[0], v1[1], v1[2], v1[3]}, p[8];
#pragma unroll
        for (int j = 0; j < 8; ++j) p[j] = __shfl_xor(x[j], 16);
        const bool isctx = row >= TL; const int b = isctx ? ((row - TL) >> 8) : (row >> 13), t = isctx ? ((row - TL) & 255) : (row & 8191), tq = isctx ? SEQ + t : t;
        const int h = col / 96, d = col - h * 96;
        if (d >= 64 && !isctx) { const int idx = d - 64, a = idx >> 4, half = (idx >> 3) & 1, pos = a ? (t & 63) : (t >> 6);
#pragma unroll
            for (int f = 0; f < 8; ++f) { const float cs = rope[2 * (pos * 8 + f)], sn = rope[2 * (pos * 8 + f) + 1]; x[f] = half ? x[f] * cs + p[f] * sn : x[f] * cs - p[f] * sn; } }
#pragma unroll
        for (int j = 0; j < 8; ++j) x[j] *= QSCALE;
        *(GAS v4u*)(qb + ((size_t)(b * 8 + h) * TQK + tq) * 96 + d) = pack8(x);
        asm volatile("" ::: "memory");
    }
};
struct FKV {
    bf16* kb; bf16* vb;
    __device__ __forceinline__ void operator()(int row, int col, f32x4 v0, f32x4 v1) const {
        v4u w; w.x = pg8::cvt_pk_bf16(v0[0], v0[1]); w.y = pg8::cvt_pk_bf16(v0[2], v0[3]); w.z = pg8::cvt_pk_bf16(v1[0], v1[1]); w.w = pg8::cvt_pk_bf16(v1[2], v1[3]);
        const bool isctx = row >= TL; const int b = isctx ? ((row - TL) >> 8) : (row >> 13), t = isctx ? ((row - TL) & 255) : (row & 8191), tk = isctx ? t : CTXL + t;
        const int h = col >> 7, e = col & 127;
        if (e < 64) *(GAS v4u*)(kb + ((size_t)(b * 8 + h) * TQK + tk) * 96 + e) = w;
        else { const int kk = tk & 63, pos = (kk & 48) | (kk & 3) | ((kk & 4) << 1) | ((kk & 8) >> 1);
            bf16* p = vb + (((size_t)(b * 8 + h) * (TQK / 64) + (tk >> 6)) * 64 + (e - 64)) * 64 + pos;
            p[0] = (bf16)(w.x & 0xffffu); p[64] = (bf16)(w.x >> 16); p[128] = (bf16)(w.y & 0xffffu); p[192] = (bf16)(w.y >> 16);
            p[256] = (bf16)(w.z & 0xffffu); p[320] = (bf16)(w.z >> 16); p[384] = (bf16)(w.w & 0xffffu); p[448] = (bf16)(w.w >> 16); }
    }
};
struct FResid {
    float* xl; float* xc; const float* gate;
    int first; int row_off;
    __device__ __forceinline__ void operator()(int row_, int col, f32x4 v) const {
        const int row = row_ + row_off;
        const f32x4 gv = *(const GAS f32x4*)(gate + (size_t)modrow_of(row) * 6144 + col);
        if (row < TL) { float* xp = xl + (size_t)row * D + col; const f32x4 xo = *(const GAS f32x4*)xp; *(GAS f32x4*)xp = (first ? xo * DN_ALPHA : xo) + gv * v; }
        else { float* xp = xc + (size_t)(row - TL) * D + col; *(GAS f32x4*)xp = *(const GAS f32x4*)xp + gv * v; }
    }
};
struct FHgIn {
    bf16* qffi; bf16* g;
    __device__ __forceinline__ void operator()(int row, int col, f32x4 v0, f32x4 v1) const {
        v4u w; w.x = pg8::cvt_pk_bf16(v0[0], v0[1]); w.y = pg8::cvt_pk_bf16(v0[2], v0[3]); w.z = pg8::cvt_pk_bf16(v1[0], v1[1]); w.w = pg8::cvt_pk_bf16(v1[2], v1[3]);
        if (col < 4096) *(GAS v4u*)(qffi + (size_t)row * 4096 + col) = w; else *(GAS v4u*)(g + (size_t)row * D + (col - 4096)) = w;
    }
};
template <class E> __device__ __forceinline__ void run_gemm_off(Frame& F, const bf16* A, int lda, const bf16* Bt, int ldb, int M, int N, int K, const E& e, int boff) {
    pg8::Gemm g{A, Bt, M, N, K, lda, ldb}; pg8::StaticOrder S; S.init(M, N, F.G, (int)((blockIdx.x + F.G - boff) % F.G));
    pg8::gemm_phase<E, pg8::StaticOrder, true, true>(F.lds + RING_OFF, g, S, e);
}
template <class E> __device__ __forceinline__ void run_gemm(Frame& F, const bf16* A, int lda, const bf16* Bt, int ldb, int M, int N, int K, const E& e) {
    pg8::Gemm g{A, Bt, M, N, K, lda, ldb}; pg8::StaticOrder S; S.init(M, N, F.G, (int)blockIdx.x);
    pg8::gemm_phase<E, pg8::StaticOrder, true, true>(F.lds + RING_OFF, g, S, e);
}

constexpr int NPH = 32;
struct Args { const float* in[31]; float* out; unsigned char* ws; int ph_lo, ph_hi; };
__global__ void __launch_bounds__(NWAVES * 64, 2) mk_fwd(Args args) {
    extern __shared__ __attribute__((aligned(16))) unsigned char lds[];
    Frame F;
    F.lds = (LAS unsigned char*)lds;
    F.tid = threadIdx.x; F.lane = F.tid & 63; F.wave = __builtin_amdgcn_readfirstlane(F.tid >> 6);
    F.G = gridDim.x; { const int bx = blockIdx.x; F.vcu = (F.G % 8 == 0) ? (bx % 8) * (F.G / 8) + bx / 8 : bx; }
    for (int u = F.tid; u < (LDS_BYTES - LDSCTL_OFF) / 4; u += NWAVES * 64) ((LAS unsigned*)(F.lds + LDSCTL_OFF))[u] = 0u;
    __syncthreads();
    if (F.tid == 0) {
#pragma unroll
        for (int i = 0; i < 31; ++i) ((LAS unsigned long long*)(F.lds + PTR_OFF))[i] = (unsigned long long)args.in[i];
        ((LAS unsigned long long*)(F.lds + PTR_OFF))[31] = (unsigned long long)args.ws; ((LAS unsigned long long*)(F.lds + PTR_OFF))[32] = (unsigned long long)args.out;
    }
    __syncthreads();
    const int lo = args.ph_lo, hi = args.ph_hi;
    const bool multi = (hi - lo) > 1;
    if (multi) (void)xcd_barrier_post((unsigned*)ws_(F) + CW_BAR, (volatile LAS unsigned*)(F.lds + MISC_OFF) + 8);
#ifndef ONLY_PHASE
#define ONLY_PHASE -1
#endif
#define WSP ws_(F)
#define MODP ((const float*)(ws_(F) + WS_MOD))
#define ABUF ((bf16*)(ws_(F) + WS_A))
#ifndef SKIP_PHASE
#define SKIP_PHASE -1
#endif
#define IN(k) ((ONLY_PHASE < 0 || ONLY_PHASE == (k)) && SKIP_PHASE != (k) && lo <= (k) && (k) < hi)
#define SEAM(k) do { if (IN(k) && IN((k) + 1)) { XcdBarrier bar_; bar_.bar = (unsigned*)ws_(F) + CW_BAR; bar_.x = xb_xcc_id(); bar_.st = (volatile LAS unsigned*)(F.lds + MISC_OFF) + 8; xcd_barrier(bar_); } asm volatile("" : "+v"(F.tid), "+v"(F.lane)); } while (0)
    int pk = 0;
#ifndef REPEAT_PHASE
#define REPEAT_PHASE -1
#endif
#define PHASE(...) do { if (IN(pk)) { __VA_ARGS__ } if (REPEAT_PHASE == pk && IN(pk)) { { XcdBarrier bar_; bar_.bar = (unsigned*)ws_(F) + CW_BAR; bar_.x = xb_xcc_id(); bar_.st = (volatile LAS unsigned*)(F.lds + MISC_OFF) + 8; xcd_barrier(bar_); } asm volatile("" : "+v"(F.tid), "+v"(F.lane)); { __VA_ARGS__ } } SEAM(pk); ++pk; } while (0)
    PHASE( p0_prologue(F); p0_s5_tables(F); );
    PHASE( ph_init_rows(F); );
    PHASE( pg8::Epi8<FInProj> e{{(bf16*)(WSP + WS_CQKV), (bf16*)(WSP + WS_UG)}}; run_gemm(F, ABUF, D, (const bf16*)(WSP + WS_WIN0), D, TT, EVEN_IN_PAD, D, e); );
    PHASE( ph_s5_finals(F); );
    PHASE( ph_s5_carry(F); );
    PHASE( ph_mla_norm(F); );
    PHASE(
        { pg8::Epi8<FQ> e{{(bf16*)(WSP + WS_QB), (const float*)(WSP + WS_ROPE)}}; run_gemm(F, (const bf16*)(WSP + WS_CQKV), CQKV_LD, (const bf16*)(WSP + WS_WUQ), 384, TT, 768, 384, e); }
        { pg8::Epi8<FKV> e{{(bf16*)(WSP + WS_KB), (bf16*)(WSP + WS_VB)}}; run_gemm(F, (const bf16*)(WSP + WS_CQKV) + 384, CQKV_LD, (const bf16*)(WSP + WS_WUKV), 256, TT, 1024, 256, e); }
    );
    PHASE( ph_s5_out(F); );
    PHASE( ph_attn(F); );
    PHASE( pg8::Epi8<FGlu> e{{(const bf16*)(WSP + WS_Z), (bf16*)(WSP + WS_MIX)}}; run_gemm(F, (const bf16*)(WSP + WS_Z), 512, (const bf16*)(WSP + WS_WGLU), 512, TT, 512, 512, e); );
    PHASE( pg8::Epi4<FResid> e{{out_(F), (float*)(WSP + WS_XC), MODP + 0 * 3 * 6144 + 2 * 1024, 1, 0}}; run_gemm(F, (const bf16*)(WSP + WS_MIX), D, (const bf16*)(WSP + WS_WOUT0), D, TT, D, D, e); );
    PHASE( ph_layernorm(F, TT, 0, 0, 0, 3, nullptr, 0); );
#pragma unroll
    for (int grp = 0; grp < 2; ++grp) {
        PHASE( pg8::Epi8<FBf16> e{{(bf16*)(WSP + WS_H), FFH}}; run_gemm(F, ABUF, D, (const bf16*)(WSP + WS_F1T0) + (size_t)grp * FFH * D, D, TT, FFH, D, e); );
        PHASE( ph_convgate(F, TT, 0, grp); );
        PHASE( pg8::Epi4<FResid> e{{out_(F), (float*)(WSP + WS_XC), MODP + 0 * 3 * 6144 + 5 * 1024, grp == 0 ? 1 : 0, 0}}; run_gemm(F, (const bf16*)(WSP + WS_HG), FFG, (const bf16*)(WSP + WS_F2T0) + grp * FFG, FFH, TT, D, FFG, e); );
    }
    PHASE( ph_layernorm(F, TT, 0, 1, 1, 0, nullptr, 0); );
    PHASE( pg8::Epi8<FHgIn> e{{(bf16*)(WSP + WS_QFFI), (bf16*)(WSP + WS_G)}}; run_gemm(F, ABUF, D, (const bf16*)(WSP + WS_HGINT), D, TT, 5120, D, e); );
    PHASE( ph_hgrn_states(F); );
    PHASE( ph_hgrn_out(F); );
    PHASE( ph_hg_gate(F); );
    PHASE( pg8::Epi4<FResid> e{{out_(F), (float*)(WSP + WS_XC), MODP + 1 * 3 * 6144 + 2 * 1024, 1, 0}}; run_gemm(F, (const bf16*)(WSP + WS_O), D, (const bf16*)(WSP + WS_HGOUTT), D, TL, D, D, e); );
    PHASE( ph_layernorm(F, TL, 1, 0, 1, 3); );
#pragma unroll
    for (int grp = 0; grp < 2; ++grp) {
        PHASE( pg8::Epi8<FBf16> e{{(bf16*)(WSP + WS_H), FFH}}; run_gemm(F, ABUF, D, (const bf16*)(WSP + WS_F1T1) + (size_t)grp * FFH * D, D, TL, FFH, D, e); );
        PHASE( ph_convgate(F, TL, 1, grp); );
        PHASE( pg8::Epi4<FResid> e{{out_(F), (float*)(WSP + WS_XC), MODP + 1 * 3 * 6144 + 5 * 1024, grp == 0 ? 1 : 0, 0}}; run_gemm(F, (const bf16*)(WSP + WS_HG), FFG, (const bf16*)(WSP + WS_F2T1) + grp * FFG, FFH, TL, D, FFG, e); );
    }
    PHASE( ph_layernorm(F, TL, 1, 1, -1, 0); );
#undef PHASE
#undef IN
#undef SEAM
}

extern "C" void kernel_launch(void* const* d_in, const int* in_sizes, int n_in, void* d_out, int out_size, void* d_ws, size_t ws_size, hipStream_t stream) {
    static int grid = 0;
    if (grid == 0) {
        if (n_in != 31 || out_size != TL * D || ws_size < WS_END) { fprintf(stderr, "kernel_launch: unexpected shapes n_in %d out %d ws %zu\n", n_in, out_size, ws_size); grid = -1; return; }
        int dev = 0, cus = 0;
        if (hipGetDevice(&dev) != hipSuccess || hipDeviceGetAttribute(&cus, hipDeviceAttributeMultiprocessorCount, dev) != hipSuccess) { grid = -1; return; }
        if (hipFuncSetAttribute((const void*)mk_fwd, hipFuncAttributeMaxDynamicSharedMemorySize, LDS_BYTES) != hipSuccess) { fprintf(stderr, "kernel_launch: hipFuncSetAttribute failed\n"); grid = -1; return; }
        int per_cu = 0;
        if (hipOccupancyMaxActiveBlocksPerMultiprocessor(&per_cu, (const void*)mk_fwd, NWAVES * 64, LDS_BYTES) != hipSuccess || per_cu < 1) fprintf(stderr, "kernel_launch: occupancy query says %d\n", per_cu);
        (void)hipGetLastError();
        grid = cus;
    }
    if (grid < 0) return;
    if (hipMemsetAsync((char*)d_ws + WS_CTL, 0, CTL_ZERO_BYTES, stream) != hipSuccess) return;
    Args a{};
    for (int i = 0; i < 31; ++i) a.in[i] = (const float*)d_in[i];
    a.out = (float*)d_out; a.ws = (unsigned char*)d_ws;
#ifndef MK_ONE_LAUNCH
#define MK_ONE_LAUNCH 1
#endif
    if (MK_ONE_LAUNCH) { a.ph_lo = 0; a.ph_hi = NPH; hipLaunchKernelGGL(mk_fwd, dim3(grid), dim3(NWAVES * 64), LDS_BYTES, stream, a); }
    else for (int p = 0; p < NPH; ++p) { a.ph_lo = p; a.ph_hi = p + 1; hipLaunchKernelGGL(mk_fwd, dim3(grid), dim3(NWAVES * 64), LDS_BYTES, stream, a); }
}
```

```cpp
#include <hip/hip_runtime.h>
#include <cstdio>
#include <cstdint>
#include <cmath>
namespace pg8 {
#define PG8_LAS __attribute__((address_space(3)))
typedef unsigned short bf16_t;
typedef short bf16x8 __attribute__((ext_vector_type(8)));
typedef float f32x4 __attribute__((ext_vector_type(4)));
typedef unsigned u32x4 __attribute__((ext_vector_type(4)));
constexpr int BM = 256, BK = 64, HALF = 128, HTB = HALF * BK * 2  , STAGE_BYTES = 8 * HTB, NXCD = 8, WGM = 8;

__host__ __device__ __forceinline__ int lds_byte(int r, int c) { const int st = (r >> 4) * 2 + (c >> 5), rr = r & 15, cc = c & 31, ob = rr * 64 + cc * 2; return st * 1024 + (ob ^ (((ob >> 9) & 1) << 5)); }
__host__ __device__ __forceinline__ void stage_rc(int b, int& R, int& C) { const int st = b / 1024, sb = b % 1024, swz = sb ^ (((sb >> 9) & 1) << 5); R = (st >> 1) * 16 + swz / 64; C = (st & 1) * 32 + (swz % 64) / 2; }
__host__ __device__ __forceinline__ int perm32(int rho) { const int n = rho >> 4, i = rho & 15; return 8 * (i >> 2) + 4 * n + (i & 3); }

struct Unit { int pm, pn; };
struct Gemm { const bf16_t* A; const bf16_t* Bt; int M, N, K, lda, ldb; };

struct StaticOrder {
    int nM, nN, nwg, G, c;
    __host__ __device__ void init(int M, int N, int G_, int c_) { nM = M / BM; nN = N / BM; nwg = nM * nN; G = G_; c = c_; }
    __host__ __device__ bool next(int i, Unit& u) const {
        const long L = (long)i * G + c; if (L >= nwg) return false;
        int wgid = (int)L; { const int q = nwg / NXCD, r = nwg % NXCD, xcd = wgid % NXCD, off = wgid / NXCD; wgid = (xcd < r ? xcd * (q + 1) : r * (q + 1) + (xcd - r) * q) + off; }
        const int nig = WGM * nN, gid = wgid / nig, fm = gid * WGM, gsz = (nM - fm) < WGM ? (nM - fm) : WGM;
        u.pm = fm + ((wgid % nig) % gsz); u.pn = (wgid % nig) / gsz; return true;
    }
    __device__ __forceinline__ void a_ready(const Unit&) const {}
    __device__ __forceinline__ void done(const Unit&) const {}
};

__device__ __forceinline__ unsigned cvt_pk_bf16(float lo, float hi) { unsigned r; asm volatile("v_cvt_pk_bf16_f32 %0, %1, %2" : "=v"(r) : "v"(lo), "v"(hi)); return r; }
template <class F> struct Epi8 {
    static constexpr bool PERM = true, AFTER_DRAIN = false; F f;
    __device__ __forceinline__ void operator()(const f32x4 (&acc)[2][2][4][2], const Unit& u, int wr, int wc, int fr, int fq) const {
        const int row0 = u.pm * BM + wr * 64 + fr, col0 = u.pn * BM + wc * 32 + 8 * fq;
#pragma unroll
        for (int ai = 0; ai < 2; ++ai)
#pragma unroll
            for (int m = 0; m < 4; ++m)
#pragma unroll
                for (int bj = 0; bj < 2; ++bj) { f(row0 + ai * HALF + m * 16, col0 + bj * HALF, acc[ai][bj][m][0], acc[ai][bj][m][1]); __builtin_amdgcn_sched_barrier(0); }
    }
};
template <class F> struct Epi4 {
    static constexpr bool PERM = false, AFTER_DRAIN = false; F f;
    __device__ __forceinline__ void operator()(const f32x4 (&acc)[2][2][4][2], const Unit& u, int wr, int wc, int fr, int fq) const {
        const int row0 = u.pm * BM + wr * 64 + fr, col0 = u.pn * BM + wc * 32 + 4 * fq;
#pragma unroll
        for (int ai = 0; ai < 2; ++ai)
#pragma unroll
            for (int m = 0; m < 4; ++m)
#pragma unroll
                for (int bj = 0; bj < 2; ++bj)
#pragma unroll
                    for (int n = 0; n < 2; ++n) { f(row0 + ai * HALF + m * 16, col0 + bj * HALF + n * 16, acc[ai][bj][m][n]); __builtin_amdgcn_sched_barrier(0); }
    }
};
template <class Epi, class Sched, bool ALIGN_EPI = false, bool SP2 = false>
__device__ __forceinline__ void gemm_phase(PG8_LAS unsigned char* lds, const Gemm g, const Sched& S, const Epi& E) {
    int tid_ = threadIdx.x; asm volatile("" : "+v"(tid_));
    const int tid = tid_, wid = __builtin_amdgcn_readfirstlane(tid >> 6), lane = tid & 63, wr = wid >> 2, wc = wid & 3, fr = lane & 15, fq = lane >> 4;
    const int K = g.K, nt = K / BK;
    unsigned voffA[2], voffB[2];
#pragma unroll
    for (int i = 0; i < 2; ++i) { int R, C; stage_rc(tid * 16 + i * 8192, R, C); const int Rb = Epi::PERM ? ((R & ~31) + perm32(R & 31)) : R;
        voffA[i] = (unsigned)(R * g.lda + C) * 2u; voffB[i] = (unsigned)(Rb * g.ldb + C) * 2u; }
    const size_t kstep = (size_t)(BK * 2);
    const size_t hstepA = (size_t)HALF * g.lda * 2, hstepB = (size_t)HALF * g.ldb * 2;
    const size_t tstepA = 2 * hstepA, tstepB = 2 * hstepB;
    const unsigned ldsw = (unsigned)wid * 1024u;
    const int aoff = lds_byte(wr * 64 + fr, fq * 8), boff = lds_byte(wc * 32 + fr, fq * 8);
#define PG8_SA(b, h) (((b) * 2 + (h)) * HTB)
#define PG8_SB(b, h) ((4 + (b) * 2 + (h)) * HTB)
#define PG8_STAGE(bufoff, gbase, voff) do { _Pragma("unroll") for (int _i = 0; _i < 2; ++_i) \
        __builtin_amdgcn_global_load_lds((const unsigned*)((const char*)(gbase) + (voff)[_i]), (PG8_LAS unsigned*)(lds + (bufoff) + ldsw + _i * 8192), 16, 0, 0); } while (0)
#define PG8_LDA(dst, b, h) do { _Pragma("unroll") for (int m = 0; m < 4; ++m) _Pragma("unroll") for (int k = 0; k < 2; ++k) dst[m][k] = *(const PG8_LAS bf16x8*)(lds + PG8_SA(b, h) + aoff + m * 2048 + k * 1024); } while (0)
#define PG8_LDB(dst, b, h) do { _Pragma("unroll") for (int n = 0; n < 2; ++n) _Pragma("unroll") for (int k = 0; k < 2; ++k) dst[n][k] = *(const PG8_LAS bf16x8*)(lds + PG8_SB(b, h) + boff + n * 2048 + k * 1024); } while (0)
#define PG8_MMA(ai, bj, At, Bt) do { __builtin_amdgcn_s_setprio(1); _Pragma("unroll") for (int m = 0; m < 4; ++m) _Pragma("unroll") for (int n = 0; n < 2; ++n) _Pragma("unroll") for (int k = 0; k < 2; ++k) \
        acc[ai][bj][m][n] = __builtin_amdgcn_mfma_f32_16x16x32_bf16(Bt[n][k], At[m][k], acc[ai][bj][m][n], 0, 0, 0); __builtin_amdgcn_s_setprio(0); } while (0)
#define PG8_WAIT_V(n) asm volatile("s_waitcnt vmcnt(" #n ")" ::: "memory")
#define PG8_WAIT_L(n) asm volatile("s_waitcnt lgkmcnt(" #n ")" ::: "memory")
#define PG8_BAR __builtin_amdgcn_s_barrier()
#define PG8_SCHED __builtin_amdgcn_sched_barrier(0)
    Unit cur, nxt; int ui = 0;
    if (!S.next(0, cur)) return;
    f32x4 acc[2][2][4][2];
#pragma unroll
    for (int a = 0; a < 2; ++a)
#pragma unroll
        for (int b = 0; b < 2; ++b)
#pragma unroll
            for (int m = 0; m < 4; ++m)
#pragma unroll
                for (int n = 0; n < 2; ++n) acc[a][b][m][n] = (f32x4){0.f, 0.f, 0.f, 0.f};
    bf16x8 At[4][2], B0[2][2], B1[2][2];
    const char* cA = (const char*)g.A + (size_t)cur.pm * tstepA; const char* cB = (const char*)g.Bt + (size_t)cur.pn * tstepB;
    S.a_ready(cur);
    if constexpr (SP2) {
        PG8_STAGE(PG8_SB(0, 0), cB, voffB); PG8_STAGE(PG8_SB(0, 1), cB + hstepB, voffB); PG8_STAGE(PG8_SA(0, 0), cA, voffA); PG8_STAGE(PG8_SA(0, 1), cA + hstepA, voffA);
        if (wr == 1) PG8_BAR;
        PG8_WAIT_V(2); PG8_BAR;
        PG8_STAGE(PG8_SB(1, 0), cB + kstep, voffB); PG8_STAGE(PG8_SA(1, 0), cA + kstep, voffA); PG8_STAGE(PG8_SB(1, 1), cB + hstepB + kstep, voffB);
        PG8_WAIT_V(6); PG8_BAR;
    } else {
        PG8_STAGE(PG8_SB(0, 0), cB, voffB); PG8_STAGE(PG8_SA(0, 0), cA, voffA); PG8_STAGE(PG8_SB(0, 1), cB + hstepB, voffB); PG8_STAGE(PG8_SA(0, 1), cA + hstepA, voffA);
        if (wr == 1) PG8_BAR;
        PG8_WAIT_V(4); PG8_BAR;
        PG8_STAGE(PG8_SB(1, 0), cB + kstep, voffB); PG8_STAGE(PG8_SA(1, 0), cA + kstep, voffA); PG8_STAGE(PG8_SB(1, 1), cB + hstepB + kstep, voffB);
        PG8_WAIT_V(6); PG8_BAR;
    }
    for (;;) {
        const bool has_next = S.next(ui + 1, nxt);
        const char* nA = has_next ? (const char*)g.A + (size_t)nxt.pm * tstepA : cA; const char* nB = has_next ? (const char*)g.Bt + (size_t)nxt.pn * tstepB : cB;
#pragma unroll 1
        for (int t = 0; t < nt; t += 2) {
            const bool last = (t == nt - 2);
            const char* a1 = cA + (size_t)(t + 1) * kstep;
            const char* a2 = last ? nA : cA + (size_t)(t + 2) * kstep; const char* b2 = last ? nB : cB + (size_t)(t + 2) * kstep;
            const char* a3 = a2 + kstep; const char* b3 = b2 + kstep;
            if (last && has_next) S.a_ready(nxt);
            if constexpr (SP2) {
            PG8_LDB(B0, 0, 0); PG8_LDB(B1, 0, 1); PG8_SCHED; PG8_LDA(At, 0, 0); PG8_STAGE(PG8_SA(1, 1), a1 + hstepA, voffA);
            PG8_WAIT_V(8); PG8_WAIT_L(0); PG8_BAR; PG8_MMA(0, 0, At, B0); PG8_MMA(0, 1, At, B1); PG8_BAR; PG8_SCHED;
            PG8_LDA(At, 0, 1); PG8_STAGE(PG8_SB(0, 0), b2, voffB); PG8_STAGE(PG8_SB(0, 1), b2 + hstepB, voffB); PG8_STAGE(PG8_SA(0, 0), a2, voffA);
            PG8_WAIT_V(8); PG8_WAIT_L(0); PG8_BAR; PG8_MMA(1, 0, At, B0); PG8_MMA(1, 1, At, B1); PG8_BAR; PG8_SCHED;
            PG8_LDB(B0, 1, 0); PG8_LDB(B1, 1, 1); PG8_SCHED; PG8_LDA(At, 1, 0); PG8_STAGE(PG8_SA(0, 1), a2 + hstepA, voffA);
            PG8_WAIT_V(8); PG8_WAIT_L(0); PG8_BAR; PG8_MMA(0, 0, At, B0); PG8_MMA(0, 1, At, B1); PG8_BAR; PG8_SCHED;
            PG8_LDA(At, 1, 1); PG8_STAGE(PG8_SB(1, 0), b3, voffB); PG8_STAGE(PG8_SB(1, 1), b3 + hstepB, voffB); PG8_STAGE(PG8_SA(1, 0), a3, voffA);
            PG8_WAIT_V(8); PG8_WAIT_L(0); PG8_BAR; PG8_MMA(1, 0, At, B0); PG8_MMA(1, 1, At, B1); PG8_BAR; PG8_SCHED;
            } else {
            PG8_LDB(B0, 0, 0); PG8_SCHED; PG8_LDA(At, 0, 0); PG8_STAGE(PG8_SA(1, 1), a1 + hstepA, voffA);
            PG8_WAIT_L(8); PG8_BAR; PG8_WAIT_L(0); PG8_MMA(0, 0, At, B0); PG8_BAR; PG8_SCHED;
            PG8_LDB(B1, 0, 1); PG8_STAGE(PG8_SB(0, 0), b2, voffB);
            PG8_BAR; PG8_WAIT_L(0); PG8_MMA(0, 1, At, B1); PG8_BAR;
            PG8_LDA(At, 0, 1); PG8_STAGE(PG8_SA(0, 0), a2, voffA);
            PG8_BAR; PG8_WAIT_L(0); PG8_MMA(1, 0, At, B0); PG8_BAR; PG8_SCHED;
            PG8_STAGE(PG8_SB(0, 1), b2 + hstepB, voffB);
            PG8_WAIT_V(6); PG8_BAR; PG8_MMA(1, 1, At, B1); PG8_BAR;
            PG8_LDB(B0, 1, 0); PG8_SCHED; PG8_LDA(At, 1, 0); PG8_STAGE(PG8_SA(0, 1), a2 + hstepA, voffA);
            PG8_WAIT_L(8); PG8_BAR; PG8_WAIT_L(0); PG8_MMA(0, 0, At, B0); PG8_BAR; PG8_SCHED;
            PG8_LDB(B1, 1, 1); PG8_STAGE(PG8_SB(1, 0), b3, voffB);
            PG8_BAR; PG8_WAIT_L(0); PG8_MMA(0, 1, At, B1); PG8_BAR;
            PG8_LDA(At, 1, 1); PG8_STAGE(PG8_SA(1, 0), a3, voffA);
            PG8_BAR; PG8_WAIT_L(0); PG8_MMA(1, 0, At, B0); PG8_BAR; PG8_SCHED;
            PG8_STAGE(PG8_SB(1, 1), b3 + hstepB, voffB);
            PG8_WAIT_V(6); PG8_BAR; PG8_MMA(1, 1, At, B1); PG8_BAR;
            }
        }
        if constexpr (ALIGN_EPI) { if (wr == 0) PG8_BAR; }
        if constexpr (!Epi::AFTER_DRAIN) { E(acc, cur, wr, wc, fr, fq); S.done(cur); }
        if (!has_next) break;
#pragma unroll
        for (int a = 0; a < 2; ++a)
#pragma unroll
            for (int b = 0; b < 2; ++b)
#pragma unroll
                for (int m = 0; m < 4; ++m)
#pragma unroll
                    for (int n = 0; n < 2; ++n) acc[a][b][m][n] = (f32x4){0.f, 0.f, 0.f, 0.f};
        cur = nxt; cA = nA; cB = nB; ++ui;
        if constexpr (ALIGN_EPI) { if (wr == 1) PG8_BAR; }
    }
    PG8_WAIT_V(0);
    if constexpr (!ALIGN_EPI) { if (wr == 0) PG8_BAR; }
    PG8_BAR;
    if constexpr (Epi::AFTER_DRAIN) { E.fused(acc, cur, wr, wc, fr, fq, lds, wid, lane); S.done(cur); }
#undef PG8_SA
#undef PG8_SB
#undef PG8_STAGE
#undef PG8_LDA
#undef PG8_LDB
#undef PG8_MMA
#undef PG8_WAIT_V
#undef PG8_WAIT_L
#undef PG8_BAR
#undef PG8_SCHED
}
}

constexpr int NWAVES = 8;
constexpr int D = 1024, BATCH = 2, SEQ = 8192, CTXL = 256;
constexpr int TL = BATCH * SEQ;
constexpr int TC = BATCH * CTXL;
constexpr int TT = TL + TC;
constexpr int EVEN_IN = 1184, EVEN_IN_PAD = 1280, CQKV_LD = 672;
constexpr int FFH = 2816, FFG = 1408;
constexpr int TQK = SEQ + CTXL;
constexpr float NORM_EPS = 1e-6f;
constexpr float DN_ALPHA = 1.41421356237f;
constexpr float QSCALE = 0.10206207261596577f * 1.4426950408889634f;

constexpr size_t MiB = 1u << 20;
constexpr size_t WS_CTL = 0, CTL_ZERO_BYTES = 1 * MiB;
constexpr size_t WS_MOD = 1 * MiB;
constexpr size_t WS_LBV = WS_MOD + 160 * 1024;
constexpr size_t WS_ROPE = WS_LBV + 16 * 1024;
constexpr size_t WS_HGINT = 2 * MiB, WS_HGOUTT = 12 * MiB, WS_F1T1 = 14 * MiB, WS_F2T1 = 25 * MiB;
constexpr size_t WS_A = 31 * MiB;
constexpr size_t WS_XC = 64 * MiB;
constexpr size_t WS_WIN0 = 66 * MiB, WS_WUQ = WS_WIN0 + 2560 * 1024, WS_WUKV = WS_WUQ + 768 * 1024, WS_WGLU = WS_WUKV + 512 * 1024,
                 WS_WOUT0 = WS_WGLU + 512 * 1024, WS_F1T0 = 72 * MiB + 512 * 1024, WS_F2T0 = WS_F1T0 + 11 * MiB;
constexpr size_t WS_R = 89 * MiB;
constexpr size_t WS_CQKV = WS_R;
constexpr size_t WS_UG = WS_R + 22 * MiB;
constexpr size_t WS_WF = WS_R + 39 * MiB;
constexpr size_t WS_WC = WS_R + 64 * MiB;
constexpr size_t WS_TOEP = WS_R + 80 * MiB;
constexpr size_t WS_T0 = WS_R + 82 * MiB;
constexpr size_t WS_A64 = WS_T0 + 128 * 1024;
constexpr size_t WS_FIN = WS_R + 83 * MiB;
constexpr size_t WS_SIN = WS_R + 92 * MiB;
constexpr size_t WS_Z = WS_R + 97 * MiB;
constexpr size_t WS_MIX = WS_R + 134 * MiB;
constexpr size_t WS_QB = WS_R + 39 * MiB;
constexpr size_t WS_KB = 31 * MiB;
constexpr size_t WS_VB = WS_R + 114 * MiB;
constexpr size_t WS_AB = WS_R;
constexpr size_t WS_GB = WS_R + 4 * MiB;
constexpr size_t WS_H = WS_R;
constexpr size_t WS_HG = WS_R + 91 * MiB;
constexpr size_t WS_QFFI = 66 * MiB;
constexpr size_t WS_G = 198 * MiB;
constexpr size_t WS_O = WS_A;
constexpr size_t WS_SLAB1 = WS_R;
constexpr size_t WS_SLAB2 = WS_R + 140 * MiB;
constexpr size_t WS_END = 256 * MiB;
static_assert(WS_F2T0 + 5632 * 1024 <= WS_R, "layer-0 weights");
static_assert(WS_MIX + (size_t)TT * 1024 * 2 <= WS_END && WS_G + (size_t)TT * 1024 * 2 <= WS_END && WS_HG + (size_t)TT * FFG * 2 <= WS_END, "ws map");
static_assert(WS_WF + 16 * MiB <= WS_WC && WS_QB + (size_t)16 * TQK * 96 * 2 <= WS_WC && WS_WC + 16 * MiB <= WS_TOEP && WS_TOEP + 2 * MiB <= WS_T0 && WS_T0 + MiB <= WS_FIN && WS_FIN + (size_t)32 * 264 * 256 * 4 <= WS_SIN && WS_SIN + (size_t)32 * 264 * 256 * 2 <= WS_Z && WS_Z + (size_t)TT * 512 * 2 <= WS_VB && WS_VB + (size_t)16 * TQK * 64 * 2 <= WS_MIX && WS_KB + (size_t)16 * TQK * 96 * 2 <= WS_XC, "ws map 2");

constexpr int CW_BAR = 4096;
constexpr int RING_OFF = 0, RING_BYTES = 131072;
constexpr int LDSCTL_OFF = RING_BYTES, MISC_OFF = LDSCTL_OFF + 320;
constexpr int LDS_BYTES = 147456;

#define GAS __attribute__((address_space(1)))
#define LAS __attribute__((address_space(3)))
typedef unsigned short bf16;
typedef unsigned v4u __attribute__((ext_vector_type(4)));
typedef unsigned v2u __attribute__((ext_vector_type(2)));
typedef float f32x4 __attribute__((ext_vector_type(4)));
typedef GAS unsigned gu32;
#define RLX_AGENT __ATOMIC_RELAXED, __HIP_MEMORY_SCOPE_AGENT
#define LDS_WAIT() asm volatile("s_waitcnt lgkmcnt(0)" ::: "memory")
__device__ __forceinline__ unsigned f2bf(float f) { unsigned u = __builtin_bit_cast(unsigned, f); return (u + 0x7fffu + ((u >> 16) & 1u)) >> 16; }
__device__ __forceinline__ unsigned pk2(float lo, float hi) { return f2bf(lo) | (f2bf(hi) << 16); }
__device__ __forceinline__ float bflo(unsigned w) { return __builtin_bit_cast(float, w << 16); }
__device__ __forceinline__ float bfhi(unsigned w) { return __builtin_bit_cast(float, w & 0xffff0000u); }
__device__ __forceinline__ float bf2f(bf16 h) { return __builtin_bit_cast(float, (unsigned)h << 16); }
__device__ __forceinline__ void unpack8(v4u w, float* x) { x[0] = bflo(w.x); x[1] = bfhi(w.x); x[2] = bflo(w.y); x[3] = bfhi(w.y); x[4] = bflo(w.z); x[5] = bfhi(w.z); x[6] = bflo(w.w); x[7] = bfhi(w.w); }
__device__ __forceinline__ v4u pack8(const float* x) { v4u w; w.x = pk2(x[0], x[1]); w.y = pk2(x[2], x[3]); w.z = pk2(x[4], x[5]); w.w = pk2(x[6], x[7]); return w; }
__device__ __forceinline__ float sigmoidf_(float x) { return 1.0f / (1.0f + __expf(-x)); }
__device__ __forceinline__ float siluf_(float x) { return x / (1.0f + __expf(-x)); }
__device__ __forceinline__ float gelu_tanh(float x) { const float u = 0.7978845608028654f * (x + 0.044715f * x * x * x); return 0.5f * x * (1.0f + tanhf(u)); }
__device__ __forceinline__ float wave_sum(float v) {
#pragma unroll
    for (int o = 1; o < 64; o <<= 1) v += __shfl_xor(v, o);
    return v;
}

#define XB_TMO      128
#define XB_XCNT(j)  (256  + 64 * (j))
#define XB_XSUB(j)  (1280 + 64 * (j))
#define XB_XGEN(j)  (2304 + 64 * (j))
#define XB_TOP      3328
#define XB_TOPGEN   3392
#define XCD_BAR_WORDS 3456
#define XB_SPIN_CAP (1u << 18)

__device__ __forceinline__ unsigned xb_ld(unsigned* p)              { return __hip_atomic_load(p, __ATOMIC_RELAXED, __HIP_MEMORY_SCOPE_AGENT); }
__device__ __forceinline__ unsigned xb_add(unsigned* p, unsigned v) { return __hip_atomic_fetch_add(p, v, __ATOMIC_RELAXED, __HIP_MEMORY_SCOPE_AGENT); }
__device__ __forceinline__ unsigned xb_xcc_id() { return (unsigned)__builtin_amdgcn_s_getreg((3 << 11) | 20) & 0xFu; }
#define XB_SPIN(cond, bar) do { unsigned _sp = 0; while (cond) { __builtin_amdgcn_s_sleep(1); \
    if ((++_sp & 255u) == 0u) { if (xb_ld(&(bar)[XB_TMO])) break; if (_sp > XB_SPIN_CAP) { atomicAdd(&(bar)[XB_TMO], 1u); break; } } } } while (0)

struct XcdBarrier {
    unsigned* bar; unsigned x;
    volatile LAS unsigned* st;
};

__device__ __forceinline__ XcdBarrier xcd_barrier_post(unsigned* bar, volatile LAS unsigned* st) {
    XcdBarrier b; b.bar = bar; b.x = xb_xcc_id(); b.st = st;
    if (threadIdx.x == 0) (void)xb_add(&bar[XB_XCNT(b.x)], 1u);
    return b;
}
__device__ __forceinline__ void xcd_barrier_complete(unsigned* bar, unsigned x, unsigned& nloc, unsigned& nx) {
    const unsigned G = gridDim.x * gridDim.y * gridDim.z;
    unsigned sum, cnt, mine, sp = 0u;
    for (;;) {
        sum = 0u; cnt = 0u; mine = 0u;
#pragma unroll
        for (unsigned j = 0; j < 16; ++j) { const unsigned c = xb_ld(&bar[XB_XCNT(j)]); sum += c; cnt += (c > 0u) ? 1u : 0u; mine = (j == x) ? c : mine; }
        if (sum == G) break;
        __builtin_amdgcn_s_sleep(1);
        if ((++sp & 255u) == 0u) { if (xb_ld(&bar[XB_TMO])) break; if (sp > XB_SPIN_CAP) { atomicAdd(&bar[XB_TMO], 1u); break; } }
    }
    nloc = mine > 0u ? mine : 1u; nx = cnt > 0u ? cnt : 1u;
}

__device__ __forceinline__ void xcd_barrier(const XcdBarrier& b) {
    asm volatile("s_waitcnt vmcnt(0)" ::: "memory");
    __syncthreads();
    if (threadIdx.x == 0) {
        unsigned* bar = b.bar;
        __builtin_amdgcn_s_waitcnt(0);
        unsigned nloc = b.st[0], nx = b.st[1];
        if (nloc == 0u) { xcd_barrier_complete(bar, b.x, nloc, nx); b.st[0] = nloc; b.st[1] = nx; }
        const unsigned old = xb_add(&bar[XB_XSUB(b.x)], 1u);
        const unsigned gen = old / nloc;
        if (old + 1u == (gen + 1u) * nloc) {
            __builtin_amdgcn_fence(__ATOMIC_RELEASE, "agent");
            asm volatile("s_waitcnt vmcnt(0)" ::: "memory");
            const unsigned og = xb_add(&bar[XB_TOP], 1u);
            const unsigned tg = og / nx;
            if (og + 1u == (tg + 1u) * nx) xb_add(&bar[XB_TOPGEN], 1u);
            else XB_SPIN(xb_ld(&bar[XB_TOPGEN]) == tg, bar);
            __builtin_amdgcn_fence(__ATOMIC_ACQUIRE, "agent");
            xb_add(&bar[XB_XGEN(b.x)], 1u);
            asm volatile("s_waitcnt vmcnt(0)" ::: "memory");
        } else {
            XB_SPIN(xb_ld(&bar[XB_XGEN(b.x)]) == gen, bar);
            __builtin_amdgcn_fence(__ATOMIC_ACQUIRE, "agent");
            asm volatile("s_waitcnt vmcnt(0)" ::: "memory");
        }
    }
    __syncthreads();
}


struct Frame {
    LAS unsigned char* lds;
    int tid, lane, wave, vcu, G;
};
constexpr int PTR_OFF = LDSCTL_OFF + 1024;
__device__ __forceinline__ const float* inp(const Frame& F, int i) {
    const LAS unsigned* p = (const LAS unsigned*)(F.lds + PTR_OFF) + 2 * i;
    const unsigned lo = __builtin_amdgcn_readfirstlane(p[0]), hi = __builtin_amdgcn_readfirstlane(p[1]);
    return (const float*)(((unsigned long long)hi << 32) | lo);
}
__device__ __forceinline__ unsigned char* ws_(const Frame& F) { return (unsigned char*)inp(F, 31); }
__device__ __forceinline__ float* out_(const Frame& F) { return (float*)inp(F, 32); }
__device__ __forceinline__ int modrow_of(int m) { return m < TL ? (m >> 13) : 2; }
__device__ __forceinline__ const float* xin_row(const Frame& F, int m) { return m < TL ? inp(F, 0) + (size_t)m * D : inp(F, 2) + (size_t)(m - TL) * D; }
__device__ __forceinline__ float* xres_row(const Frame& F, int m) { return m < TL ? out_(F) + (size_t)m * D : (float*)(ws_(F) + WS_XC) + (size_t)(m - TL) * D; }
__device__ __forceinline__ const float* modvec(const Frame& F, int layer, int mr, int part) { return (const float*)(ws_(F) + WS_MOD) + (size_t)(layer * 3 + mr) * 6144 + part * 1024; }

__device__ __forceinline__ void tr_item(const float* W, int ldw, int k0, int n0, bf16* dst, int dpitch, LAS float* scr, int lane) {
    { f32x4 v[8];
#pragma unroll
      for (int i = 0; i < 8; ++i) v[i] = *(const GAS f32x4*)(W + (size_t)(k0 + 8 * i + (lane >> 3)) * ldw + n0 + 4 * (lane & 7));
#pragma unroll
      for (int i = 0; i < 8; ++i) { LAS float* d = scr + (8 * i + (lane >> 3)) * 33 + 4 * (lane & 7); d[0] = v[i].x; d[1] = v[i].y; d[2] = v[i].z; d[3] = v[i].w; } }
    LDS_WAIT(); asm volatile("" ::: "memory");
    const int c = lane & 7;
#pragma unroll
    for (int j = 0; j < 4; ++j) { const int n = (lane >> 3) + 8 * j; const LAS float* s = scr + (8 * c) * 33 + n;
        v4u o; o.x = pk2(s[0 * 33], s[1 * 33]); o.y = pk2(s[2 * 33], s[3 * 33]); o.z = pk2(s[4 * 33], s[5 * 33]); o.w = pk2(s[6 * 33], s[7 * 33]);
        *(GAS v4u*)(dst + (size_t)n * dpitch + 8 * c) = o; }
    LDS_WAIT(); asm volatile("" ::: "memory");
}
__device__ __forceinline__ bool tr_plain(int& r, const float* W, int K, int N, bf16* WT, LAS float* scr, int lane) {
    const int nblk = N / 32, cnt = (K / 64) * nblk;
    if (r >= cnt) { r -= cnt; return false; }
    const int kb = r / nblk, nb = r % nblk;
    tr_item(W, N, 64 * kb, 32 * nb, WT + (size_t)(32 * nb) * K + 64 * kb, K, scr, lane); return true;
}
__device__ __forceinline__ bool tr_ffn1(int& r, const float* W, bf16* WT, LAS float* scr, int lane) {
    const int nblk = 5632 / 32, cnt = 16 * nblk;
    if (r >= cnt) { r -= cnt; return false; }
    const int kb = r / nblk, nb = r % nblk, n0 = 32 * nb, half = n0 / FFH, j = n0 % FFH, g = j / FFG, jj = j % FFG, drow = g * FFH + (jj >> 7) * 256 + half * 128 + (jj & 127);
    tr_item(W, 5632, 64 * kb, n0, WT + (size_t)drow * 1024 + 64 * kb, 1024, scr, lane); return true;
}
__device__ __forceinline__ void p0_prologue(Frame& F) {
    {
        LAS float* sv = (LAS float*)(F.lds + RING_OFF);
        LAS float* red = sv + 3072;
        for (int i = F.tid; i < 3072; i += 512) { const int r = i >> 10, k = i & 1023; const float cv = (r < 2) ? inp(F, 1)[r * 1024 + k] : inp(F, 3)[k]; sv[i] = cv / (1.0f + __expf(-cv)); }
        __syncthreads();
        for (int it = blockIdx.x; it < 192; it += F.G) {
            const int layer = it / 96, cg = it % 96, col = cg * 64 + F.lane, k0 = F.wave * 128;
            const float* w = inp(F, 4) + ((size_t)layer * 1024 + k0) * 6144 + col;
            float a0 = 0.f, a1 = 0.f, a2 = 0.f;
#pragma unroll 16
            for (int k = 0; k < 128; ++k) { const float wv = w[(size_t)k * 6144]; a0 += sv[k0 + k] * wv; a1 += sv[1024 + k0 + k] * wv; a2 += sv[2048 + k0 + k] * wv; }
            red[(F.wave * 3 + 0) * 64 + F.lane] = a0; red[(F.wave * 3 + 1) * 64 + F.lane] = a1; red[(F.wave * 3 + 2) * 64 + F.lane] = a2;
            __syncthreads();
            if (F.tid < 192) { const int r = F.tid >> 6, l = F.tid & 63; float s = inp(F, 5)[layer * 6144 + cg * 64 + l];
#pragma unroll
                for (int wv = 0; wv < 8; ++wv) s += red[(wv * 3 + r) * 64 + l];
                ((float*)(ws_(F) + WS_MOD))[(size_t)(layer * 3 + r) * 6144 + cg * 64 + l] = s; }
            __syncthreads();
        }
        __syncthreads();
    }
    {
        const int gt = F.vcu * 512 + F.tid, NT = F.G * 512;
        for (int i = gt; i < 2048; i += NT) { const int dir = i >> 10, c = i & 1023; const float l0 = inp(F, 28)[(0 * 2 + dir) * 1024 + c], l1 = inp(F, 28)[(1 * 2 + dir) * 1024 + c];
            ((float*)(ws_(F) + WS_LBV))[i] = 1.0f / (1.0f + expf(l0 - l1)); }
        for (int i = gt; i < 1024; i += NT) { const int pos = i >> 3, f = i & 7; const float inv = powf(10000.0f, -(float)f / 8.0f); const float ang = (float)pos * inv;
            ((float*)(ws_(F) + WS_ROPE))[2 * i] = cosf(ang); ((float*)(ws_(F) + WS_ROPE))[2 * i + 1] = sinf(ang); }
        for (int i = gt; i < 96 * 1024 / 8; i += NT) ((GAS v4u*)(ws_(F) + WS_WIN0 + (size_t)1184 * 1024 * 2))[i] = (v4u){0u, 0u, 0u, 0u};
    }
    {
        LAS float* scr = (LAS float*)(F.lds + RING_OFF + F.wave * 16384);
        const int gw = F.vcu * NWAVES + F.wave, NGW = F.G * NWAVES;
        constexpr int NITEMS = 592 + 144 + 128 + 128 + 512 + 2 * 2816 + 2 * 1408 + 2560 + 512;
        for (int it = gw; it < NITEMS; it += NGW) {
            int r = it;
            if (tr_plain(r, inp(F, 12), 1024, 1184, (bf16*)(ws_(F) + WS_WIN0), scr, F.lane)) continue;
            if (tr_plain(r, inp(F, 14), 384, 768, (bf16*)(ws_(F) + WS_WUQ), scr, F.lane)) continue;
            if (tr_plain(r, inp(F, 16), 256, 1024, (bf16*)(ws_(F) + WS_WUKV), scr, F.lane)) continue;
            if (tr_plain(r, inp(F, 25), 512, 512, (bf16*)(ws_(F) + WS_WGLU), scr, F.lane)) continue;
            if (tr_plain(r, inp(F, 26), 1024, 1024, (bf16*)(ws_(F) + WS_WOUT0), scr, F.lane)) continue;
            if (tr_ffn1(r, inp(F, 8), (bf16*)(ws_(F) + WS_F1T0), scr, F.lane)) continue;
            if (tr_ffn1(r, inp(F, 8) + (size_t)1024 * 5632, (bf16*)(ws_(F) + WS_F1T1), scr, F.lane)) continue;
            if (tr_plain(r, inp(F, 11), 2816, 1024, (bf16*)(ws_(F) + WS_F2T0), scr, F.lane)) continue;
            if (tr_plain(r, inp(F, 11) + (size_t)2816 * 1024, 2816, 1024, (bf16*)(ws_(F) + WS_F2T1), scr, F.lane)) continue;
            if (tr_plain(r, inp(F, 27), 1024, 5120, (bf16*)(ws_(F) + WS_HGINT), scr, F.lane)) continue;
            tr_plain(r, inp(F, 30), 1024, 1024, (bf16*)(ws_(F) + WS_HGOUTT), scr, F.lane);
        }
    }
}

__device__ __forceinline__ void store_mod_bf16(const Frame& F, const f32x4 (&v)[4], int m, int layer, int part_sh) {
    const int mr = modrow_of(m);
    const GAS f32x4* sh = (const GAS f32x4*)modvec(F, layer, mr, part_sh) + F.lane;
    const GAS f32x4* sc = (const GAS f32x4*)modvec(F, layer, mr, part_sh + 1) + F.lane;
    GAS v2u* o = (GAS v2u*)((bf16*)(ws_(F) + WS_A) + (size_t)m * D) + F.lane;
#pragma unroll
    for (int j = 0; j < 4; ++j) { const f32x4 s = sc[64 * j], h = sh[64 * j]; const f32x4 y = v[j] * (s + 1.0f) + h; v2u w; w.x = pk2(y.x, y.y); w.y = pk2(y.z, y.w); o[64 * j] = w; }
}
__device__ __forceinline__ void ph_init_rows(Frame& F) {
    const int gw = F.vcu * NWAVES + F.wave, NGW = F.G * NWAVES;
    for (int m = gw; m < TT; m += NGW) {
        const GAS f32x4* xr = (const GAS f32x4*)xin_row(F, m) + F.lane; GAS f32x4* xo = (GAS f32x4*)xres_row(F, m) + F.lane;
        f32x4 v[4];
#pragma unroll
        for (int j = 0; j < 4; ++j) { v[j] = xr[64 * j]; xo[64 * j] = (m >= TL) ? v[j] * DN_ALPHA : v[j]; }
        store_mod_bf16(F, v, m, 0, 0);
    }
}
__device__ __forceinline__ void ph_layernorm(Frame& F, int nrows, int layer, int which, int next_layer, int next_part_sh, const float* slabs = nullptr, int nslabs = 0) {
    const int gw = F.vcu * NWAVES + F.wave, NGW = F.G * NWAVES;
    const GAS f32x4* gg = (const GAS f32x4*)(inp(F, 6) + (size_t)(layer * 2 + which) * D) + F.lane;
    const GAS f32x4* bb = (const GAS f32x4*)(inp(F, 7) + (size_t)(layer * 2 + which) * D) + F.lane;
    for (int m0 = gw; m0 < nrows; m0 += 2 * NGW) {
        const int m1 = m0 + NGW; const bool has1 = m1 < nrows; const int m1c = has1 ? m1 : m0;
        GAS f32x4* xr0 = (GAS f32x4*)xres_row(F, m0) + F.lane; GAS f32x4* xr1 = (GAS f32x4*)xres_row(F, m1c) + F.lane;
        f32x4 v[4], w[4]; float s0 = 0.f, s1 = 0.f;
#pragma unroll
        for (int j = 0; j < 4; ++j) { v[j] = xr0[64 * j]; w[j] = xr1[64 * j]; }
        if (nslabs > 0 && m1c >= TL) {
            for (int sl = 0; sl < nslabs; ++sl) { const GAS f32x4* p1 = (const GAS f32x4*)(slabs + ((size_t)sl * TC + (m1c - TL)) * D) + F.lane;
#pragma unroll
                for (int j = 0; j < 4; ++j) w[j] += p1[64 * j];
                if (m0 >= TL) { const GAS f32x4* p0 = (const GAS f32x4*)(slabs + ((size_t)sl * TC + (m0 - TL)) * D) + F.lane;
#pragma unroll
                    for (int j = 0; j < 4; ++j) v[j] += p0[64 * j]; } }
        }
#pragma unroll
        for (int j = 0; j < 4; ++j) { s0 += (v[j].x + v[j].y) + (v[j].z + v[j].w); s1 += (w[j].x + w[j].y) + (w[j].z + w[j].w); }
        const float mean0 = wave_sum(s0) * (1.f / D), mean1 = wave_sum(s1) * (1.f / D); float q0 = 0.f, q1 = 0.f;
#pragma unroll
        for (int j = 0; j < 4; ++j) { v[j] = v[j] - mean0; w[j] = w[j] - mean1; q0 += (v[j].x * v[j].x + v[j].y * v[j].y) + (v[j].z * v[j].z + v[j].w * v[j].w); q1 += (w[j].x * w[j].x + w[j].y * w[j].y) + (w[j].z * w[j].z + w[j].w * w[j].w); }
        const float r0 = 1.f / sqrtf(wave_sum(q0) * (1.f / D) + NORM_EPS), r1 = 1.f / sqrtf(wave_sum(q1) * (1.f / D) + NORM_EPS);
#pragma unroll
        for (int j = 0; j < 4; ++j) { const f32x4 g4 = gg[64 * j], b4 = bb[64 * j]; v[j] = v[j] * r0 * g4 + b4; w[j] = w[j] * r1 * g4 + b4; xr0[64 * j] = (m0 >= TL) ? v[j] * DN_ALPHA : v[j]; if (has1) xr1[64 * j] = (m1 >= TL) ? w[j] * DN_ALPHA : w[j]; }
        if (next_layer >= 0) { store_mod_bf16(F, v, m0, next_layer, next_part_sh); if (has1) store_mod_bf16(F, w, m1, next_layer, next_part_sh); }
    }
}
__device__ __forceinline__ void ph_mla_norm(Frame& F) {
    const int gw = F.vcu * NWAVES + F.wave, NGW = F.G * NWAVES;
    bf16* CQ = (bf16*)(ws_(F) + WS_CQKV); bf16* Kb = (bf16*)(ws_(F) + WS_KB); const float* rope = (const float*)(ws_(F) + WS_ROPE);
    for (int m = gw; m < TT; m += NGW) {
        bf16* row = CQ + (size_t)m * CQKV_LD;
        {
            float x[8]; float ss = 0.f; const bool act = F.lane < 48;
            if (act) { unpack8(*(const GAS v4u*)(row + 8 * F.lane), x);
#pragma unroll
                for (int j = 0; j < 8; ++j) ss += x[j] * x[j]; }
            const float sc = 1.f / sqrtf(wave_sum(ss) * (1.f / 384.f) + NORM_EPS);
            if (act) {
#pragma unroll
                for (int j = 0; j < 8; ++j) x[j] = x[j] * sc * inp(F, 13)[8 * F.lane + j];
                *(GAS v4u*)(row + 8 * F.lane) = pack8(x); }
        }
        {
            float x[8]; float ss = 0.f; const bool act = F.lane < 32;
            if (act) { unpack8(*(const GAS v4u*)(row + 384 + 8 * F.lane), x);
#pragma unroll
                for (int j = 0; j < 8; ++j) ss += x[j] * x[j]; }
            const float sc = 1.f / sqrtf(wave_sum(ss) * (1.f / 256.f) + NORM_EPS);
            if (act) {
#pragma unroll
                for (int j = 0; j < 8; ++j) x[j] = x[j] * sc * inp(F, 15)[8 * F.lane + j];
                *(GAS v4u*)(row + 384 + 8 * F.lane) = pack8(x); }
        }
        {
            const bool isctx = m >= TL; const int b = isctx ? ((m - TL) >> 8) : (m >> 13), t = isctx ? ((m - TL) & 255) : (m & 8191), tk = isctx ? t : CTXL + t;
            const int h = F.lane >> 3, i0 = (F.lane & 7) * 4;
            const v2u w = *(const GAS v2u*)(row + 640 + i0);
            float x[4] = {bflo(w.x), bfhi(w.x), bflo(w.y), bfhi(w.y)}, o[4];
#pragma unroll
            for (int j = 0; j < 4; ++j) { const float p = __shfl_xor(x[j], 2); const int idx = i0 + j, a = idx >> 4, half = (idx >> 3) & 1, f = idx & 7, pos = a ? (t & 63) : (t >> 6);
                const float cs = rope[2 * (pos * 8 + f)], sn = rope[2 * (pos * 8 + f) + 1];
                o[j] = isctx ? x[j] : (half ? x[j] * cs + p * sn : x[j] * cs - p * sn); }
            v2u ow; ow.x = pk2(o[0], o[1]); ow.y = pk2(o[2], o[3]);
            *(GAS v2u*)(Kb + ((size_t)(b * 8 + h) * TQK + tk) * 96 + 64 + i0) = ow;
        }
    }
}
__device__ __forceinline__ void ph_convfix(Frame& F, int nrows, int layer, int grp) {
    const int gw = F.vcu * NWAVES + F.wave, NGW = F.G * NWAVES;
    const bf16* AB = (const bf16*)(ws_(F) + WS_AB); const bf16* GB = (const bf16*)(ws_(F) + WS_GB); bf16* HG = (bf16*)(ws_(F) + WS_HG);
    const float* cw = inp(F, 9) + (size_t)layer * 3 * FFH + grp * FFG; const float* cb = inp(F, 10) + (size_t)layer * FFH + grp * FFG;
    const int nedge = (nrows / 64) * 2;
    for (int er = gw; er < nedge; er += NGW) {
        const int g64 = er >> 1, which = er & 1, m = 64 * g64 + (which ? 63 : 0);
        const bool isctx = m >= TL; const int t = isctx ? ((m - TL) & 255) : (m & 8191), len = isctx ? CTXL : SEQ;
        const bool hp = t > 0, hn = t < len - 1;
        const bf16* ac_ = AB + (size_t)(g64 * 4 + (which ? 3 : 0)) * FFG;
        const bf16* ap_ = which ? AB + (size_t)(g64 * 4 + 2) * FFG : AB + (size_t)((g64 - 1) * 4 + 3) * FFG;
        const bf16* an_ = which ? AB + (size_t)((g64 + 1) * 4 + 0) * FFG : AB + (size_t)(g64 * 4 + 1) * FFG;
        const bf16* gt_ = GB + (size_t)(g64 * 2 + which) * FFG;
#pragma unroll
        for (int ci = 0; ci < 3; ++ci) { const int ch = F.lane + 64 * ci; if (ch >= FFG / 8) break;
            const int j0 = 8 * ch; float ac[8], ap[8], an[8], gt[8], o[8];
            unpack8(*(const GAS v4u*)(ac_ + j0), ac); unpack8(*(const GAS v4u*)(gt_ + j0), gt);
            if (hp) unpack8(*(const GAS v4u*)(ap_ + j0), ap); else {
#pragma unroll
                for (int j = 0; j < 8; ++j) ap[j] = 0.f; }
            if (hn) unpack8(*(const GAS v4u*)(an_ + j0), an); else {
#pragma unroll
                for (int j = 0; j < 8; ++j) an[j] = 0.f; }
#pragma unroll
            for (int j = 0; j < 8; ++j) { const float cv = cb[j0 + j] + cw[j0 + j] * ap[j] + cw[FFH + j0 + j] * ac[j] + cw[2 * FFH + j0 + j] * an[j]; o[j] = siluf_(cv) * gt[j]; }
            *(GAS v4u*)(HG + (size_t)m * FFG + j0) = pack8(o);
        }
    }
}
__device__ __forceinline__ void ph_hg_gate(Frame& F) {
    const int gw = F.vcu * NWAVES + F.wave, NGW = F.G * NWAVES;
    bf16* O = (bf16*)(ws_(F) + WS_O); const bf16* G = (const bf16*)(ws_(F) + WS_G);
    const int c0 = 16 * F.lane; float ng[16];
#pragma unroll
    for (int j = 0; j < 16; ++j) ng[j] = inp(F, 29)[(c0 + j) & 127];
    for (int m = gw; m < TL; m += NGW) {
        float o[16], g[16]; unpack8(*(const GAS v4u*)(O + (size_t)m * D + c0), o); unpack8(*(const GAS v4u*)(O + (size_t)m * D + c0 + 8), o + 8);
        unpack8(*(const GAS v4u*)(G + (size_t)m * D + c0), g); unpack8(*(const GAS v4u*)(G + (size_t)m * D + c0 + 8), g + 8);
        float ss = 0.f;
#pragma unroll
        for (int j = 0; j < 16; ++j) ss += o[j] * o[j];
        ss += __shfl_xor(ss, 1); ss += __shfl_xor(ss, 2); ss += __shfl_xor(ss, 4);
        const float sc = 1.f / sqrtf(ss * (1.f / 128.f) + NORM_EPS);
#pragma unroll
        for (int j = 0; j < 16; ++j) o[j] = o[j] * sc * ng[j] * siluf_(g[j]);
        *(GAS v4u*)(O + (size_t)m * D + c0) = pack8(o); *(GAS v4u*)(O + (size_t)m * D + c0 + 8) = pack8(o + 8);
    }
}

typedef short bf16x8_t __attribute__((ext_vector_type(8)));
typedef float f32x16 __attribute__((ext_vector_type(16)));
__device__ __forceinline__ int crow(int r, int hi) { return (r & 3) + 8 * (r >> 2) + 4 * hi; }
constexpr int NCH = TT / 64;
__device__ __forceinline__ void p0_s5_tables(Frame& F) {
    LAS unsigned char* L = F.lds + RING_OFF;
    LAS double* lam = (LAS double*)L;
    LAS float* bb = (LAS float*)(L + 1024);
    LAS float* cc = (LAS float*)(L + 1024 + 8192);
    LAS float* pw = (LAS float*)(L + 1024 + 16384);
    unsigned char* ws = ws_(F);
    for (int item = (int)blockIdx.x - 192; item >= 0 && item < 64; item += F.G) {
        const int g = item >> 1, d = item & 1;
        __syncthreads();
        if (F.tid < 64) { const int n = F.tid, pi = (d * 32 + g) * 64 + n;
            const double lre = inp(F, 17)[pi], lim = inp(F, 18)[pi], dt = exp((double)inp(F, 19)[d * 32 + g]);
            const double mag = exp(lre * dt), are = mag * cos(lim * dt), aim = mag * sin(lim * dt), den = lre * lre + lim * lim, nr = are - 1.0;
            const double fr = (nr * lre + aim * lim) / den, fi = (aim * lre - nr * lim) / den;
            lam[2 * n] = lre * dt; lam[2 * n + 1] = lim * dt;
            for (int q = 0; q < 16; ++q) { const double br = inp(F, 20)[(size_t)pi * 16 + q], bi = inp(F, 21)[(size_t)pi * 16 + q];
                bb[(n * 16 + q) * 2] = (float)(fr * br - fi * bi); bb[(n * 16 + q) * 2 + 1] = (float)(fr * bi + fi * br); } }
        for (int i = F.tid; i < 1024; i += 512) { const int p = i >> 6, n = i & 63; cc[i * 2] = inp(F, 22)[((size_t)(d * 32 + g) * 16 + p) * 64 + n]; cc[i * 2 + 1] = inp(F, 23)[((size_t)(d * 32 + g) * 16 + p) * 64 + n]; }
        __syncthreads();
        if (F.tid < 64) { const int n = F.tid; const double m1 = exp(lam[2 * n]), ar = m1 * cos(lam[2 * n + 1]), ai = m1 * sin(lam[2 * n + 1]);
            double pr = 1.0, pim = 0.0;
            for (int e = 0; e <= 64; ++e) { pw[(e * 64 + n) * 2] = (float)pr; pw[(e * 64 + n) * 2 + 1] = (float)pim; const double nr = pr * ar - pim * ai, ni = pr * ai + pim * ar; pr = nr; pim = ni; } }
        __syncthreads();
        { bf16* WF = (bf16*)(ws + WS_WF) + (size_t)g * 256 * 1024;
          for (int i = F.tid; i < 128 * 128; i += 512) { const int row = i >> 7, grp = i & 127, c = row >> 6, n = row & 63, sI = grp >> 1, q0 = (grp & 1) * 8, e = d ? sI : 63 - sI;
              const float pr = pw[(e * 64 + n) * 2], pim = pw[(e * 64 + n) * 2 + 1]; float o[8];
#pragma unroll
              for (int j = 0; j < 8; ++j) { const float br = bb[(n * 16 + q0 + j) * 2], bi = bb[(n * 16 + q0 + j) * 2 + 1]; o[j] = c ? (pr * bi + pim * br) : (pr * br - pim * bi); }
              *(GAS v4u*)(WF + (size_t)(d * 128 + row) * 1024 + sI * 16 + q0) = pack8(o); } }
        { bf16* WC = (bf16*)(ws + WS_WC) + (size_t)g * 1024 * 256;
          for (int i = F.tid; i < 1024 * 16; i += 512) { const int row = i >> 4, grp = i & 15, t = row >> 4, p = row & 15, c = grp >> 3, n0 = (grp & 7) * 8, ex = d ? 64 - t : t + 1; float o[8];
#pragma unroll
              for (int j = 0; j < 8; ++j) { const int n = n0 + j; const float pr = pw[(ex * 64 + n) * 2], pim = pw[(ex * 64 + n) * 2 + 1], cr = cc[(p * 64 + n) * 2], ci = cc[(p * 64 + n) * 2 + 1];
                  o[j] = c ? -(cr * pim + ci * pr) : (cr * pr - ci * pim); }
              *(GAS v4u*)(WC + (size_t)row * 256 + d * 128 + c * 64 + n0) = pack8(o); } }
        { bf16* TP = (bf16*)(ws + WS_TOEP) + (size_t)g * 127 * 256; float* T0 = (float*)(ws + WS_T0) + (size_t)(g * 2 + d) * 256;
          for (int i = F.tid; i < 64 * 16; i += 512) { const int tau = i >> 4, p = i & 15; float acc[16];
#pragma unroll
              for (int q = 0; q < 16; ++q) acc[q] = 0.f;
              for (int n = 0; n < 64; ++n) { const float pr = pw[(tau * 64 + n) * 2], pim = pw[(tau * 64 + n) * 2 + 1], cr = cc[(p * 64 + n) * 2], ci = cc[(p * 64 + n) * 2 + 1];
                  const float tr = cr * pr - ci * pim, ti = cr * pim + ci * pr;
                  const LAS f32x4* bq = (const LAS f32x4*)(bb + n * 32);
#pragma unroll
                  for (int q4 = 0; q4 < 8; ++q4) { const f32x4 v = bq[q4]; acc[2 * q4] += tr * v.x - ti * v.y; acc[2 * q4 + 1] += tr * v.z - ti * v.w; } }
              if (tau == 0) {
#pragma unroll
                  for (int q = 0; q < 16; ++q) T0[p * 16 + q] = acc[q]; }
              else { bf16* o = TP + (size_t)(d ? 63 - tau : 63 + tau) * 256 + p * 16; *(GAS v4u*)o = pack8(acc); *(GAS v4u*)(o + 8) = pack8(acc + 8); } } }
        if (F.tid < 64) { float* A64 = (float*)(ws + WS_A64) + (size_t)((g * 2 + d) * 64 + F.tid) * 2; A64[0] = pw[(64 * 64 + F.tid) * 2]; A64[1] = pw[(64 * 64 + F.tid) * 2 + 1]; }
    }
    __syncthreads();
}
__device__ __forceinline__ void ph_s5_finals(Frame& F) {
    const int lane = F.lane, r32 = lane & 31, hh = lane >> 5, wave = F.wave;
    unsigned char* ws = ws_(F);
    for (int u = blockIdx.x; u < 288; u += F.G) {
        const int g = u / 9, nb = u % 9; int chunk = nb * 32 + r32; const bool valid = chunk < NCH; if (!valid) chunk = NCH - 1;
        const bf16* ub = (const bf16*)(ws + WS_UG) + ((size_t)g * TT + (size_t)chunk * 64) * 16 + 8 * hh;
        const bf16* wf = (const bf16*)(ws + WS_WF) + ((size_t)(g * 256 + 32 * wave + r32)) * 1024 + 8 * hh;
        f32x16 acc;
#pragma unroll
        for (int r = 0; r < 16; ++r) acc[r] = 0.f;
#pragma unroll 16
        for (int sI = 0; sI < 64; ++sI) { const bf16x8_t a = *(const GAS bf16x8_t*)(wf + 16 * sI), b = *(const GAS bf16x8_t*)(ub + 16 * sI); acc = __builtin_amdgcn_mfma_f32_32x32x16_bf16(a, b, acc, 0, 0, 0); }
        if (valid) { float* fo = (float*)(ws + WS_FIN) + ((size_t)g * NCH + chunk) * 256 + 32 * wave + 4 * hh;
#pragma unroll
            for (int k = 0; k < 4; ++k) *(GAS f32x4*)(fo + 8 * k) = (f32x4){acc[4 * k], acc[4 * k + 1], acc[4 * k + 2], acc[4 * k + 3]}; }
    }
}
__device__ __forceinline__ int s5_chunk_of(int step, int d, int b) { return step < 4 ? 256 + 4 * b + (d ? 3 - step : step) : 128 * b + (d ? 127 - (step - 4) : step - 4); }
__device__ __forceinline__ void ph_s5_carry(Frame& F) {
    if (F.wave >= 3) return;
    unsigned char* ws = ws_(F);
    for (int item = ((int)F.G - 1 - (int)blockIdx.x) * 3 + F.wave; item < 128; item += 3 * F.G) {
        const int g = item >> 2, d = (item >> 1) & 1, b = item & 1, n = F.lane;
        const float a_r = ((const float*)(ws + WS_A64))[((g * 2 + d) * 64 + n) * 2], a_i = ((const float*)(ws + WS_A64))[((g * 2 + d) * 64 + n) * 2 + 1];
        const float* Fb = (const float*)(ws + WS_FIN) + (size_t)g * NCH * 256 + d * 128 + n; bf16* Sb = (bf16*)(ws + WS_SIN) + (size_t)g * NCH * 256 + d * 128 + n;
        float sr = 0.f, si = 0.f;
        for (int s0 = 0; s0 < 132; s0 += 12) {
            float fr[12], fi[12];
#pragma unroll
            for (int j = 0; j < 12; ++j) { const int c = s5_chunk_of(s0 + j, d, b); fr[j] = Fb[(size_t)c * 256]; fi[j] = Fb[(size_t)c * 256 + 64]; }
#pragma unroll
            for (int j = 0; j < 12; ++j) { const int c = s5_chunk_of(s0 + j, d, b); Sb[(size_t)c * 256] = (bf16)f2bf(sr); Sb[(size_t)c * 256 + 64] = (bf16)f2bf(si);
                const float nr = a_r * sr - a_i * si + fr[j], ni = a_r * si + a_i * sr + fi[j]; sr = nr; si = ni; }
        }
    }
}
constexpr int TP_PITCH = 48;
__device__ __forceinline__ void ph_s5_out(Frame& F) {
    LAS unsigned char* L = F.lds + RING_OFF;
    const int lane = F.lane, r32 = lane & 31, hh = lane >> 5, wave = F.wave, tid = F.tid;
    unsigned char* ws = ws_(F);
    for (int u = blockIdx.x; u < 288; u += F.G) {
        const int g = u / 9, nb = u % 9; int chunk = nb * 32 + r32; const bool valid = chunk < NCH; if (!valid) chunk = NCH - 1;
        __syncthreads();
        { const GAS v4u* tp = (const GAS v4u*)((const bf16*)(ws + WS_TOEP) + (size_t)g * 127 * 256); const float* t0 = (const float*)(ws + WS_T0) + (size_t)g * 512;
          for (int c = tid; c < 127 * 32; c += 512) { const int di = c >> 5, p = (c >> 1) & 15, half = c & 1; v4u v;
              if (di == 63) { float o[8];
#pragma unroll
                  for (int j = 0; j < 8; ++j) o[j] = t0[p * 16 + half * 8 + j] + t0[256 + p * 16 + half * 8 + j];
                  v = pack8(o); }
              else v = tp[c];
              *(LAS v4u*)(L + (di * 16 + p) * TP_PITCH + half * 16) = v; } }
        __syncthreads();
        const bf16* ub = (const bf16*)(ws + WS_UG) + ((size_t)g * TT + (size_t)chunk * 64) * 16 + 8 * hh;
        f32x16 acc[4];
#pragma unroll
        for (int i = 0; i < 4; ++i)
#pragma unroll
            for (int r = 0; r < 16; ++r) acc[i][r] = 0.f;
        const LAS unsigned char* tl = L + ((63 + 2 * wave + (r32 >> 4)) * 16 + (r32 & 15)) * TP_PITCH + hh * 16;
#pragma unroll 1
        for (int s0 = 0; s0 < 64; s0 += 16) {
            bf16x8_t bq[16];
#pragma unroll
            for (int e = 0; e < 16; ++e) bq[e] = *(const GAS bf16x8_t*)(ub + 16 * (s0 + e));
#pragma unroll
            for (int e = 0; e < 16; ++e) { const int sI = s0 + e; const bf16x8_t b = bq[e];
#pragma unroll
            for (int i = 0; i < 4; ++i) { const bf16x8_t a = *(const LAS bf16x8_t*)(tl + (16 * i - sI) * 16 * TP_PITCH); acc[i] = __builtin_amdgcn_mfma_f32_32x32x16_bf16(a, b, acc[i], 0, 0, 0); }
            }
        }
        { const bf16* sb = (const bf16*)(ws + WS_SIN) + ((size_t)g * NCH + chunk) * 256 + 8 * hh;
          const bf16* wc = (const bf16*)(ws + WS_WC) + ((size_t)g * 1024 + 32 * wave + r32) * 256 + 8 * hh;
#pragma unroll 4
          for (int kk = 0; kk < 16; ++kk) {
              const bf16x8_t b = *(const GAS bf16x8_t*)(sb + 16 * kk);
#pragma unroll
              for (int i = 0; i < 4; ++i) { const bf16x8_t a = *(const GAS bf16x8_t*)(wc + (size_t)(256 * i) * 256 + 16 * kk); acc[i] = __builtin_amdgcn_mfma_f32_32x32x16_bf16(a, b, acc[i], 0, 0, 0); }
          } }
        if (valid) {
            const float* dsk = inp(F, 24) + 16 * g;
#pragma unroll
            for (int i = 0; i < 4; ++i)
#pragma unroll
                for (int k = 0; k < 4; ++k) { const int tloc = 2 * (wave + 8 * i) + (k >> 1), p0 = 8 * (k & 1) + 4 * hh; const size_t m = (size_t)chunk * 64 + tloc;
                    const v2u uw = *(const GAS v2u*)((const bf16*)(ws + WS_UG) + ((size_t)g * TT + m) * 16 + p0);
                    const float y0 = gelu_tanh(acc[i][4 * k] + dsk[p0] * bflo(uw.x)), y1 = gelu_tanh(acc[i][4 * k + 1] + dsk[p0 + 1] * bfhi(uw.x));
                    const float y2 = gelu_tanh(acc[i][4 * k + 2] + dsk[p0 + 2] * bflo(uw.y)), y3 = gelu_tanh(acc[i][4 * k + 3] + dsk[p0 + 3] * bfhi(uw.y));
                    v2u zw; zw.x = pk2(y0, y1); zw.y = pk2(y2, y3);
                    *(GAS v2u*)((bf16*)(ws + WS_Z) + m * 512 + 16 * g + p0) = zw; }
        }
    }
}

__device__ __forceinline__ bf16x8_t pack_frag(const f32x16& p, int base) {
    v4u w; w.x = pg8::cvt_pk_bf16(p[base + 0], p[base + 1]); w.y = pg8::cvt_pk_bf16(p[base + 2], p[base + 3]); w.z = pg8::cvt_pk_bf16(p[base + 4], p[base + 5]); w.w = pg8::cvt_pk_bf16(p[base + 6], p[base + 7]);
    return __builtin_bit_cast(bf16x8_t, w);
}
constexpr int AT_KP = 208, AT_VP = 272;
constexpr int AT_KB = 128 * AT_KP, AT_VB = 64 * AT_VP;
constexpr int AT_K0 = 0, AT_V0 = 2 * AT_KB, AT_WS = 2 * AT_KB + 2 * AT_VB;
__device__ __forceinline__ void ph_attn(Frame& F) {
    LAS unsigned char* L = F.lds + RING_OFF;
    const int lane = F.lane, r32 = lane & 31, hi = lane >> 5, wave = F.wave, tid = F.tid;
    volatile LAS float* wsf = (volatile LAS float*)(L + AT_WS) + wave * 32;
    const bf16* Qb = (const bf16*)(ws_(F) + WS_QB); const bf16* Kb = (const bf16*)(ws_(F) + WS_KB); const bf16* Vt = (const bf16*)(ws_(F) + WS_VB);
    bf16* MIX = (bf16*)(ws_(F) + WS_MIX);
    int kl[3], vl[2];
#pragma unroll
    for (int i = 0; i < 3; ++i) { const int c = tid + 512 * i; kl[i] = (c / 12) * AT_KP + (c % 12) * 16; }
#pragma unroll
    for (int i = 0; i < 2; ++i) { const int c = tid + 512 * i; vl[i] = ((c & 511) >> 3) * AT_VP + (c >> 9) * 128 + (c & 7) * 16; }
    for (int it = 0; it < 3; ++it) {
        int u; if (it < 2) u = it * 256 + F.vcu; else { if (F.vcu >= 16) break; u = 512 + F.vcu; }
        int b, h, tq0, NT, m0;
        if (u < 512) { b = u >> 8; h = (u >> 5) & 7; tq0 = (u & 31) * 256; NT = TQK / 128; m0 = b * SEQ + tq0; }
        else { const int uc = u - 512; b = uc >> 3; h = uc & 7; tq0 = SEQ; NT = CTXL / 128; m0 = TL + b * CTXL; }
        const size_t bh = (size_t)(b * 8 + h);
        const GAS v4u* Kg = (const GAS v4u*)(Kb + bh * TQK * 96);
        const GAS v4u* Vg = (const GAS v4u*)(Vt + bh * (TQK / 64) * 4096);
        bf16x8_t qf[6];
        { const bf16* qp = Qb + (bh * TQK + tq0 + wave * 32 + r32) * 96 + hi * 8;
#pragma unroll
          for (int ks = 0; ks < 6; ++ks) qf[ks] = *(const GAS bf16x8_t*)(qp + ks * 16); }
        f32x16 o0, o1;
#pragma unroll
        for (int r = 0; r < 16; ++r) { o0[r] = 0.f; o1[r] = 0.f; }
        float m_run = -1e30f, l_run = 0.f;
        __syncthreads();
        { v4u a[3], v[2];
#pragma unroll
          for (int i = 0; i < 3; ++i) a[i] = Kg[tid + 512 * i];
#pragma unroll
          for (int i = 0; i < 2; ++i) v[i] = Vg[tid + 512 * i];
#pragma unroll
          for (int i = 0; i < 3; ++i) *(LAS v4u*)(L + AT_K0 + kl[i]) = a[i];
#pragma unroll
          for (int i = 0; i < 2; ++i) *(LAS v4u*)(L + AT_V0 + vl[i]) = v[i]; }
        __syncthreads();
        for (int t = 0; t < NT; ++t) {
            const int cur = t & 1, nxt = cur ^ 1; const bool more = (t + 1 < NT);
            v4u na[3], nv[2];
#pragma unroll
            for (int i = 0; i < 3; ++i) na[i] = (v4u){0u, 0u, 0u, 0u};
#pragma unroll
            for (int i = 0; i < 2; ++i) nv[i] = (v4u){0u, 0u, 0u, 0u};
            if (more) {
#pragma unroll
                for (int i = 0; i < 3; ++i) na[i] = Kg[(size_t)(t + 1) * 1536 + tid + 512 * i];
#pragma unroll
                for (int i = 0; i < 2; ++i) nv[i] = Vg[(size_t)(t + 1) * 1024 + tid + 512 * i]; }
            const LAS unsigned char* Kl = L + AT_K0 + cur * AT_KB + r32 * AT_KP + hi * 16;
            const LAS unsigned char* Vl = L + AT_V0 + cur * AT_VB + r32 * AT_VP + hi * 16;
            f32x16 p[4];
#pragma unroll
            for (int kb = 0; kb < 4; ++kb) {
#pragma unroll
                for (int r = 0; r < 16; ++r) p[kb][r] = 0.f;
#pragma unroll
                for (int ks = 0; ks < 6; ++ks) p[kb] = __builtin_amdgcn_mfma_f32_32x32x16_bf16(*(const LAS bf16x8_t*)(Kl + kb * 32 * AT_KP + ks * 32), qf[ks], p[kb], 0, 0, 0);
            }
            float mt = fmaxf(fmaxf(p[0][0], p[1][0]), fmaxf(p[2][0], p[3][0]));
#pragma unroll
            for (int r = 1; r < 16; ++r) mt = fmaxf(mt, fmaxf(fmaxf(p[0][r], p[1][r]), fmaxf(p[2][r], p[3][r])));
            mt = fmaxf(mt, __shfl_xor(mt, 32));
            const bool need = mt > m_run + 8.0f;
            if (__any(need)) {
                const float mn = need ? mt : m_run, alpha = __builtin_amdgcn_exp2f(m_run - mn);
                l_run *= alpha; m_run = mn;
                if (hi == 0) wsf[r32] = alpha;
#pragma unroll
                for (int r = 0; r < 16; ++r) { const float a = wsf[crow(r, hi)]; o0[r] *= a; o1[r] *= a; }
            }
            float sum = 0.f;
#pragma unroll
            for (int kb = 0; kb < 4; ++kb)
#pragma unroll
                for (int r = 0; r < 16; ++r) { p[kb][r] = __builtin_amdgcn_exp2f(p[kb][r] - m_run); sum += p[kb][r]; }
            l_run += sum;
#pragma unroll
            for (int kb = 0; kb < 4; ++kb) {
                const bf16x8_t pa = pack_frag(p[kb], 0), pb = pack_frag(p[kb], 8);
                const LAS unsigned char* vp = Vl + (kb >> 1) * 128 + (kb & 1) * 64;
                o0 = __builtin_amdgcn_mfma_f32_32x32x16_bf16(pa, *(const LAS bf16x8_t*)(vp), o0, 0, 0, 0);
                o0 = __builtin_amdgcn_mfma_f32_32x32x16_bf16(pb, *(const LAS bf16x8_t*)(vp + 32), o0, 0, 0, 0);
                o1 = __builtin_amdgcn_mfma_f32_32x32x16_bf16(pa, *(const LAS bf16x8_t*)(vp + 32 * AT_VP), o1, 0, 0, 0);
                o1 = __builtin_amdgcn_mfma_f32_32x32x16_bf16(pb, *(const LAS bf16x8_t*)(vp + 32 * AT_VP + 32), o1, 0, 0, 0);
            }
            if (more) {
#pragma unroll
                for (int i = 0; i < 3; ++i) *(LAS v4u*)(L + AT_K0 + nxt * AT_KB + kl[i]) = na[i];
#pragma unroll
                for (int i = 0; i < 2; ++i) *(LAS v4u*)(L + AT_V0 + nxt * AT_VB + vl[i]) = nv[i]; }
            __syncthreads();
        }
        l_run += __shfl_xor(l_run, 32);
        if (hi == 0) wsf[r32] = 1.0f / l_run;
#pragma unroll
        for (int r = 0; r < 16; ++r) { const int q = crow(r, hi); const float inv = wsf[q];
            bf16* op = MIX + (size_t)(m0 + wave * 32 + q) * D + h * 64 + r32;
            op[0] = (bf16)f2bf(o0[r] * inv); op[32] = (bf16)f2bf(o1[r] * inv); }
    }
}

constexpr int HG_QT = 0, HG_KT = 17408, HG_KH = 34816, HG_VT = 53248, HG_ST = 71680, HG_DEC = 106496, HG_TOT = 107008;
constexpr int HG_NSC = 17;
constexpr size_t WS_SD = 231 * MiB;
constexpr size_t WS_DECS = WS_SD + 18 * MiB;
static_assert(WS_DECS + 32 * 17 * 128 * 4 <= WS_END, "hgrn ws");
template <bool OUT>
__device__ __forceinline__ void hgrn_pass(Frame& F, int b, int h, int dir, int sc, f32x16 (&st)[2], float& dsum) {
    LAS unsigned char* L = F.lds + RING_OFF;
    unsigned char* ws = ws_(F);
    const int tid = F.tid, lane = F.lane, r32 = lane & 31, hh = lane >> 5, wave = F.wave;
    const int k = tid & 127, tg = tid >> 7;
    const int nch = sc == 0 ? 4 : 8; const size_t rowbase = sc == 0 ? (size_t)TL + b * CTXL : (size_t)b * SEQ + (size_t)(sc - 1) * 512;
    const bf16* QF = (const bf16*)(ws + WS_QFFI);
    const float lb = ((const float*)(ws + WS_LBV))[dir * 1024 + h * 128 + k];
    const int colf = 1024 * (1 + dir) + h * 128 + k, colq = h * 128 + k, colv = 3072 + h * 128 + k;
    const int dvb = wave & 3, jb = wave >> 2;
    bf16 rq[16], rf[16], rv[16];
#define HG_LOAD(ci) do { const int cc_ = dir ? nch - 1 - (ci) : (ci); const int tl0_ = dir ? 63 - 16 * tg : 16 * tg; \
        const bf16* pf_ = QF + (rowbase + 64 * cc_ + tl0_) * 4096 + colf; const bf16* pv_ = pf_ + (colv - colf); const bf16* pq_ = pf_ + (colq - colf); const long stp_ = dir ? -4096 : 4096; \
        _Pragma("unroll") for (int jj = 0; jj < 16; ++jj) { rf[jj] = *pf_; rv[jj] = *pv_; if (OUT) rq[jj] = *pq_; pf_ += stp_; pv_ += stp_; pq_ += stp_; asm volatile("" : "+v"(pf_), "+v"(pv_), "+v"(pq_)); } } while (0)
    HG_LOAD(0);
    for (int ci = 0; ci < nch; ++ci) {
        const int cc = dir ? nch - 1 - ci : ci;
        float cum[16], kk[16];
        { float run = 0.f;
#pragma unroll
          for (int jj = 0; jj < 16; ++jj) { const float f = lb + (1.f - lb) * sigmoidf_(bf2f(rf[jj])); run += __log2f(f); cum[jj] = run; kk[jj] = 1.f - f; }
          ((LAS float*)(L + HG_TOT))[tg * 128 + k] = run; }
        __syncthreads();
        { const LAS float* tot = (const LAS float*)(L + HG_TOT) + k; const float t0 = tot[0], t1 = tot[128], t2 = tot[256], t3 = tot[384];
          const float pre = tg == 0 ? 0.f : (tg == 1 ? t0 : (tg == 2 ? t0 + t1 : t0 + t1 + t2)), total = (t0 + t1) + (t2 + t3);
          if (tg == 0) { ((LAS float*)(L + HG_DEC))[k] = __builtin_amdgcn_exp2f(total); dsum += total; }
#define HG_KH(jj) (kk[jj] * __builtin_amdgcn_exp2f(total - (pre + cum[jj])))
#define HG_PKV(a, b_) ((unsigned)rv[a] | ((unsigned)rv[b_] << 16))
          if (OUT) {
#pragma unroll
              for (int jj = 0; jj < 16; ++jj) { const float c = pre + cum[jj]; const int j = 16 * tg + jj;
                  *(LAS bf16*)(L + HG_QT + j * 272 + k * 2) = (bf16)f2bf(bf2f(rq[jj]) * __builtin_amdgcn_exp2f(c)); *(LAS bf16*)(L + HG_KT + j * 272 + k * 2) = (bf16)f2bf(kk[jj] * __builtin_amdgcn_exp2f(-c)); } }
          v4u w0, w1;
          w0.x = pk2(HG_KH(0), HG_KH(1)); w0.y = pk2(HG_KH(2), HG_KH(3)); w0.z = pk2(HG_KH(8), HG_KH(9)); w0.w = pk2(HG_KH(10), HG_KH(11));
          w1.x = pk2(HG_KH(4), HG_KH(5)); w1.y = pk2(HG_KH(6), HG_KH(7)); w1.z = pk2(HG_KH(12), HG_KH(13)); w1.w = pk2(HG_KH(14), HG_KH(15));
          *(LAS v4u*)(L + HG_KH + k * 144 + tg * 32) = w0; *(LAS v4u*)(L + HG_KH + k * 144 + tg * 32 + 16) = w1;
          w0.x = HG_PKV(0, 1); w0.y = HG_PKV(2, 3); w0.z = HG_PKV(8, 9); w0.w = HG_PKV(10, 11);
          w1.x = HG_PKV(4, 5); w1.y = HG_PKV(6, 7); w1.z = HG_PKV(12, 13); w1.w = HG_PKV(14, 15);
          *(LAS v4u*)(L + HG_VT + k * 144 + tg * 32) = w0; *(LAS v4u*)(L + HG_VT + k * 144 + tg * 32 + 16) = w1; }
#undef HG_KH
#undef HG_PKV
        if (ci + 1 < nch) HG_LOAD(ci + 1);
        __syncthreads();
        if (OUT) {
            f32x16 oacc;
#pragma unroll
            for (int r = 0; r < 16; ++r) oacc[r] = 0.f;
            const LAS unsigned char* qrow = L + HG_QT + (32 * jb + r32) * 272 + hh * 16;
            const LAS unsigned char* srow = L + HG_ST + (32 * dvb + r32) * 272 + hh * 16;
            const LAS unsigned char* vrow = L + HG_VT + (32 * dvb + r32) * 144 + hh * 16;
#pragma unroll
            for (int ks = 0; ks < 8; ++ks) oacc = __builtin_amdgcn_mfma_f32_32x32x16_bf16(*(const LAS bf16x8_t*)(qrow + ks * 32), *(const LAS bf16x8_t*)(srow + ks * 32), oacc, 0, 0, 0);
            {
                f32x16 at;
#pragma unroll
                for (int r = 0; r < 16; ++r) at[r] = 0.f;
                const LAS unsigned char* krow = L + HG_KT + r32 * 272 + hh * 16;
#pragma unroll
                for (int ks = 0; ks < 8; ++ks) at = __builtin_amdgcn_mfma_f32_32x32x16_bf16(*(const LAS bf16x8_t*)(krow + ks * 32), *(const LAS bf16x8_t*)(qrow + ks * 32), at, 0, 0, 0);
                if (jb == 0) {
#pragma unroll
                    for (int r = 0; r < 16; ++r) if (crow(r, hh) > r32) at[r] = 0.f; }
                oacc = __builtin_amdgcn_mfma_f32_32x32x16_bf16(pack_frag(at, 0), *(const LAS bf16x8_t*)(vrow + 0), oacc, 0, 0, 0);
                oacc = __builtin_amdgcn_mfma_f32_32x32x16_bf16(pack_frag(at, 8), *(const LAS bf16x8_t*)(vrow + 32), oacc, 0, 0, 0);
            }
            if (jb == 1) {
                f32x16 at;
#pragma unroll
                for (int r = 0; r < 16; ++r) at[r] = 0.f;
                const LAS unsigned char* krow = L + HG_KT + (32 + r32) * 272 + hh * 16;
#pragma unroll
                for (int ks = 0; ks < 8; ++ks) at = __builtin_amdgcn_mfma_f32_32x32x16_bf16(*(const LAS bf16x8_t*)(krow + ks * 32), *(const LAS bf16x8_t*)(qrow + ks * 32), at, 0, 0, 0);
#pragma unroll
                for (int r = 0; r < 16; ++r) if (crow(r, hh) > r32) at[r] = 0.f;
                oacc = __builtin_amdgcn_mfma_f32_32x32x16_bf16(pack_frag(at, 0), *(const LAS bf16x8_t*)(vrow + 64), oacc, 0, 0, 0);
                oacc = __builtin_amdgcn_mfma_f32_32x32x16_bf16(pack_frag(at, 8), *(const LAS bf16x8_t*)(vrow + 96), oacc, 0, 0, 0);
            }
            bf16* O = (bf16*)(ws + WS_O);
#pragma unroll
            for (int r = 0; r < 16; ++r) { const int j = 32 * jb + crow(r, hh), tl = dir ? 63 - j : j;
                bf16* op = O + (rowbase + 64 * cc + tl) * D + h * 128 + 32 * dvb + r32; float ov = oacc[r];
                if (dir) ov += bf2f(*op);
                *op = (bf16)f2bf(ov); }
        }
#pragma unroll
        for (int t = 0; t < 2; ++t) { const int dkb = 2 * (wave >> 2) + t;
#pragma unroll
            for (int q4 = 0; q4 < 4; ++q4) { const f32x4 dd = *(const LAS f32x4*)(L + HG_DEC + (32 * dkb + 8 * q4 + 4 * hh) * 4);
                st[t][4 * q4] *= dd[0]; st[t][4 * q4 + 1] *= dd[1]; st[t][4 * q4 + 2] *= dd[2]; st[t][4 * q4 + 3] *= dd[3]; }
            const LAS unsigned char* arow = L + HG_KH + (32 * dkb + r32) * 144 + hh * 16; const LAS unsigned char* vrow = L + HG_VT + (32 * dvb + r32) * 144 + hh * 16;
#pragma unroll
            for (int ks = 0; ks < 4; ++ks) st[t] = __builtin_amdgcn_mfma_f32_32x32x16_bf16(*(const LAS bf16x8_t*)(arow + ks * 32), *(const LAS bf16x8_t*)(vrow + ks * 32), st[t], 0, 0, 0); }
        __syncthreads();
        if (OUT && ci + 1 < nch) {
#pragma unroll
            for (int t = 0; t < 2; ++t) { const int dkb = 2 * (wave >> 2) + t;
#pragma unroll
                for (int q4 = 0; q4 < 4; ++q4) { v2u w; w.x = pk2(st[t][4 * q4], st[t][4 * q4 + 1]); w.y = pk2(st[t][4 * q4 + 2], st[t][4 * q4 + 3]);
                    *(LAS v2u*)(L + HG_ST + (32 * dvb + r32) * 272 + (32 * dkb + 8 * q4 + 4 * hh) * 2) = w; } }
        }
    }
#undef HG_LOAD
}
__device__ __forceinline__ void ph_hgrn_states(Frame& F) {
    unsigned char* ws = ws_(F);
    for (int item = blockIdx.x; item < 32 * HG_NSC; item += F.G) {
        const int chain = item / HG_NSC, sc = item % HG_NSC, b = chain >> 4, h = (chain >> 1) & 7, dir = chain & 1;
        f32x16 st[2];
#pragma unroll
        for (int t = 0; t < 2; ++t)
#pragma unroll
            for (int r = 0; r < 16; ++r) st[t][r] = 0.f;
        float dsum = 0.f;
        hgrn_pass<false>(F, b, h, dir, sc, st, dsum);
        bf16* sd = (bf16*)(ws + WS_SD) + ((size_t)(chain * HG_NSC + sc) * 8 + F.wave) * 2048 + F.lane;
#pragma unroll
        for (int t = 0; t < 2; ++t)
#pragma unroll
            for (int r = 0; r < 16; ++r) sd[(t * 16 + r) * 64] = (bf16)f2bf(st[t][r]);
        if (F.tid < 128) ((float*)(ws + WS_DECS))[(size_t)(chain * HG_NSC + sc) * 128 + F.tid] = dsum;
    }
}
__device__ __forceinline__ void ph_hgrn_out(Frame& F) {
    LAS unsigned char* L = F.lds + RING_OFF;
    unsigned char* ws = ws_(F);
    const int lane = F.lane, r32 = lane & 31, hh = lane >> 5, wave = F.wave, dvb = wave & 3;
    for (int item = blockIdx.x; item < 256; item += F.G) {
        const int b = item >> 7, h = (item >> 4) & 7, Lsc = item & 15, sc = Lsc + 1;
        for (int dir = 0; dir < 2; ++dir) {
            const int chain = (b * 8 + h) * 2 + dir;
            f32x16 st[2];
#pragma unroll
            for (int t = 0; t < 2; ++t)
#pragma unroll
                for (int r = 0; r < 16; ++r) st[t][r] = 0.f;
            const int npre = dir ? 1 + (16 - sc) : sc;
            for (int i = 0; i < npre; ++i) {
                const int sp = (i == 0) ? 0 : (dir ? 17 - i : i);
                const bf16* sd = (const bf16*)(ws + WS_SD) + ((size_t)(chain * HG_NSC + sp) * 8 + wave) * 2048 + lane;
                const float* dl = (const float*)(ws + WS_DECS) + (size_t)(chain * HG_NSC + sp) * 128;
#pragma unroll
                for (int t = 0; t < 2; ++t) { const int dkb = 2 * (wave >> 2) + t;
#pragma unroll
                    for (int q4 = 0; q4 < 4; ++q4) { const f32x4 dd = *(const GAS f32x4*)(dl + 32 * dkb + 8 * q4 + 4 * hh);
#pragma unroll
                        for (int e = 0; e < 4; ++e) st[t][4 * q4 + e] = __builtin_amdgcn_exp2f(dd[e]) * st[t][4 * q4 + e] + bf2f(sd[(t * 16 + 4 * q4 + e) * 64]); } }
            }
            __syncthreads();
#pragma unroll
            for (int t = 0; t < 2; ++t) { const int dkb = 2 * (wave >> 2) + t;
#pragma unroll
                for (int q4 = 0; q4 < 4; ++q4) { v2u w; w.x = pk2(st[t][4 * q4], st[t][4 * q4 + 1]); w.y = pk2(st[t][4 * q4 + 2], st[t][4 * q4 + 3]);
                    *(LAS v2u*)(L + HG_ST + (32 * dvb + r32) * 272 + (32 * dkb + 8 * q4 + 4 * hh) * 2) = w; } }
            float dsum = 0.f;
            hgrn_pass<true>(F, b, h, dir, sc, st, dsum);
            __syncthreads();
        }
    }
}

struct FInProj {
    bf16* cqkv; bf16* ug;
    __device__ __forceinline__ void operator()(int row, int col, f32x4 v0, f32x4 v1) const {
        v4u w; w.x = pg8::cvt_pk_bf16(v0[0], v0[1]); w.y = pg8::cvt_pk_bf16(v0[2], v0[3]); w.z = pg8::cvt_pk_bf16(v1[0], v1[1]); w.w = pg8::cvt_pk_bf16(v1[2], v1[3]);
        if (col < 672) *(GAS v4u*)(cqkv + (size_t)row * CQKV_LD + col) = w;
        else if (col < EVEN_IN) { const int c = col - 672; *(GAS v4u*)(ug + ((size_t)(c >> 4) * TT + row) * 16 + (c & 15)) = w; }
    }
};
struct FBf16 {
    bf16* o; int ld;
    __device__ __forceinline__ void operator()(int row, int col, f32x4 v0, f32x4 v1) const {
        v4u w; w.x = pg8::cvt_pk_bf16(v0[0], v0[1]); w.y = pg8::cvt_pk_bf16(v0[2], v0[3]); w.z = pg8::cvt_pk_bf16(v1[0], v1[1]); w.w = pg8::cvt_pk_bf16(v1[2], v1[3]);
        *(GAS v4u*)(o + (size_t)row * ld + col) = w;
    }
};
struct FGlu {
    const bf16* z; bf16* mix;
    __device__ __forceinline__ void operator()(int row, int col, f32x4 v0, f32x4 v1) const {
        float zz[8]; unpack8(*(const GAS v4u*)(z + (size_t)row * 512 + col), zz);
        float o[8];
#pragma unroll
        for (int j = 0; j < 4; ++j) { o[j] = zz[j] * sigmoidf_(v0[j]); o[4 + j] = zz[4 + j] * sigmoidf_(v1[j]); }
        *(GAS v4u*)(mix + (size_t)row * D + 512 + col) = pack8(o);
    }
};
struct FQ {
    bf16* qb; const float* rope;
    __device__ __forceinline__ void operator()(int row, int col, f32x4 v0, f32x4 v1) const {
        float x[8] = {v0[0], v0[1], v0[2], v0[3], v1[0], v1[1], v1[2], v1[3]}, p[8];
#pragma unroll
        for (int j = 0; j < 8; ++j) p[j] = __shfl_xor(x[j], 16);
        const bool isctx = row >= TL; const int b = isctx ? ((row - TL) >> 8) : (row >> 13), t = isctx ? ((row - TL) & 255) : (row & 8191), tq = isctx ? SEQ + t : t;
        const int h = col / 96, d = col - h * 96;
        if (d >= 64 && !isctx) { const int idx = d - 64, a = idx >> 4, half = (idx >> 3) & 1, pos = a ? (t & 63) : (t >> 6);
#pragma unroll
            for (int f = 0; f < 8; ++f) { const float cs = rope[2 * (pos * 8 + f)], sn = rope[2 * (pos * 8 + f) + 1]; x[f] = half ? x[f] * cs + p[f] * sn : x[f] * cs - p[f] * sn; } }
#pragma unroll
        for (int j = 0; j < 8; ++j) x[j] *= QSCALE;
        *(GAS v4u*)(qb + ((size_t)(b * 8 + h) * TQK + tq) * 96 + d) = pack8(x);
        asm volatile("" ::: "memory");
    }
};
struct FKV {
    bf16* kb; bf16* vb;
    __device__ __forceinline__ void operator()(int row, int col, f32x4 v0, f32x4 v1) const {
        v4u w; w.x = pg8::cvt_pk_bf16(v0[0], v0[1]); w.y = pg8::cvt_pk_bf16(v0[2], v0[3]); w.z = pg8::cvt_pk_bf16(v1[0], v1[1]); w.w = pg8::cvt_pk_bf16(v1[2], v1[3]);
        const bool isctx = row >= TL; const int b = isctx ? ((row - TL) >> 8) : (row >> 13), t = isctx ? ((row - TL) & 255) : (row & 8191), tk = isctx ? t : CTXL + t;
        const int h = col >> 7, e = col & 127;
        if (e < 64) *(GAS v4u*)(kb + ((size_t)(b * 8 + h) * TQK + tk) * 96 + e) = w;
        else { const int kk = tk & 63, pos = (kk & 48) | (kk & 3) | ((kk & 4) << 1) | ((kk & 8) >> 1);
            bf16* p = vb + (((size_t)(b * 8 + h) * (TQK / 64) + (tk >> 6)) * 64 + (e - 64)) * 64 + pos;
            p[0] = (bf16)(w.x & 0xffffu); p[64] = (bf16)(w.x >> 16); p[128] = (bf16)(w.y & 0xffffu); p[192] = (bf16)(w.y >> 16);
            p[256] = (bf16)(w.z & 0xffffu); p[320] = (bf16)(w.z >> 16); p[384] = (bf16)(w.w & 0xffffu); p[448] = (bf16)(w.w >> 16); }
    }
};
struct FResid {
    float* xl; float* xc; const float* gate;
    int first; int row_off;
    __device__ __forceinline__ void operator()(int row_, int col, f32x4 v) const {
        const int row = row_ + row_off;
        const f32x4 gv = *(const GAS f32x4*)(gate + (size_t)modrow_of(row) * 6144 + col);
        if (row < TL) { float* xp = xl + (size_t)row * D + col; const f32x4 xo = *(const GAS f32x4*)xp; *(GAS f32x4*)xp = (first ? xo * DN_ALPHA : xo) + gv * v; }
        else { float* xp = xc + (size_t)(row - TL) * D + col; *(GAS f32x4*)xp = *(const GAS f32x4*)xp + gv * v; }
    }
};
struct FHgIn {
    bf16* qffi; bf16* g;
    __device__ __forceinline__ void operator()(int row, int col, f32x4 v0, f32x4 v1) const {
        v4u w; w.x = pg8::cvt_pk_bf16(v0[0], v0[1]); w.y = pg8::cvt_pk_bf16(v0[2], v0[3]); w.z = pg8::cvt_pk_bf16(v1[0], v1[1]); w.w = pg8::cvt_pk_bf16(v1[2], v1[3]);
        if (col < 4096) *(GAS v4u*)(qffi + (size_t)row * 4096 + col) = w; else *(GAS v4u*)(g + (size_t)row * D + (col - 4096)) = w;
    }
};
struct EpiConvGate {
    static constexpr bool PERM = true, AFTER_DRAIN = false;
    bf16* hg; bf16* ab; bf16* gb; const float* cw; const float* cb;
    __device__ __forceinline__ void operator()(const pg8::f32x4 (&acc)[2][2][4][2], const pg8::Unit& u, int wr, int wc, int fr, int fq) const {
        const int hc0 = 128 * u.pn + 32 * wc + 8 * fq;
#pragma unroll
        for (int ai = 0; ai < 2; ++ai) {
            const int rowbase = u.pm * 256 + 128 * ai + 64 * wr, g64 = rowbase >> 6;
#pragma unroll
            for (int n = 0; n < 2; ++n) {
                const int hc = hc0 + 4 * n;
                const f32x4 w0 = *(const GAS f32x4*)(cw + hc), w1 = *(const GAS f32x4*)(cw + FFH + hc), w2 = *(const GAS f32x4*)(cw + 2 * FFH + hc), b0 = *(const GAS f32x4*)(cb + hc);
                float out[4][4];
#pragma unroll
                for (int e = 0; e < 4; ++e) { float a[4], up[4], dn[4], l15[4], l0[4];
#pragma unroll
                    for (int m = 0; m < 4; ++m) { a[m] = acc[ai][0][m][n][e]; up[m] = __shfl_up(a[m], 1, 16); dn[m] = __shfl_down(a[m], 1, 16); l15[m] = __shfl(a[m], 15, 16); l0[m] = __shfl(a[m], 0, 16); }
#pragma unroll
                    for (int m = 0; m < 4; ++m) { const float prev = fr > 0 ? up[m] : (m > 0 ? l15[m > 0 ? m - 1 : 0] : 0.f), next = fr < 15 ? dn[m] : (m < 3 ? l0[m < 3 ? m + 1 : 3] : 0.f);
                        const float cv = b0[e] + w0[e] * prev + w1[e] * a[m] + w2[e] * next; out[m][e] = siluf_(cv) * acc[ai][1][m][n][e]; } }
#pragma unroll
                for (int m = 0; m < 4; ++m) { const int r64 = 16 * m + fr, row = rowbase + r64;
                    if (r64 != 0 && r64 != 63) { v2u w; w.x = pk2(out[m][0], out[m][1]); w.y = pk2(out[m][2], out[m][3]); *(GAS v2u*)(hg + (size_t)row * FFG + hc) = w; }
                    if (r64 <= 1 || r64 >= 62) { const int slot = r64 <= 1 ? r64 : r64 - 60; const f32x4 ra = acc[ai][0][m][n];
                        v2u w; w.x = pk2(ra[0], ra[1]); w.y = pk2(ra[2], ra[3]); *(GAS v2u*)(ab + (size_t)(g64 * 4 + slot) * FFG + hc) = w;
                        if (r64 == 0 || r64 == 63) { const f32x4 rg = acc[ai][1][m][n]; v2u wg; wg.x = pk2(rg[0], rg[1]); wg.y = pk2(rg[2], rg[3]); *(GAS v2u*)(gb + (size_t)(g64 * 2 + (r64 == 63 ? 1 : 0)) * FFG + hc) = wg; } }
                }
                __builtin_amdgcn_sched_barrier(0);
            }
        }
    }
};
template <class E> __device__ __forceinline__ void run_gemm_off(Frame& F, const bf16* A, int lda, const bf16* Bt, int ldb, int M, int N, int K, const E& e, int boff) {
    pg8::Gemm g{A, Bt, M, N, K, lda, ldb}; pg8::StaticOrder S; S.init(M, N, F.G, (int)((blockIdx.x + F.G - boff) % F.G));
    pg8::gemm_phase<E, pg8::StaticOrder, true, true>(F.lds + RING_OFF, g, S, e);
}
template <class E> __device__ __forceinline__ void run_gemm(Frame& F, const bf16* A, int lda, const bf16* Bt, int ldb, int M, int N, int K, const E& e) {
    pg8::Gemm g{A, Bt, M, N, K, lda, ldb}; pg8::StaticOrder S; S.init(M, N, F.G, (int)blockIdx.x);
    pg8::gemm_phase<E, pg8::StaticOrder, true, true>(F.lds + RING_OFF, g, S, e);
}

constexpr int NPH = 32;
struct Args { const float* in[31]; float* out; unsigned char* ws; int ph_lo, ph_hi; };
__global__ void __launch_bounds__(NWAVES * 64, 2) mk_fwd(Args args) {
    extern __shared__ __attribute__((aligned(16))) unsigned char lds[];
    Frame F;
    F.lds = (LAS unsigned char*)lds;
    F.tid = threadIdx.x; F.lane = F.tid & 63; F.wave = __builtin_amdgcn_readfirstlane(F.tid >> 6);
    F.G = gridDim.x; { const int bx = blockIdx.x; F.vcu = (F.G % 8 == 0) ? (bx % 8) * (F.G / 8) + bx / 8 : bx; }
    for (int u = F.tid; u < (LDS_BYTES - LDSCTL_OFF) / 4; u += NWAVES * 64) ((LAS unsigned*)(F.lds + LDSCTL_OFF))[u] = 0u;
    __syncthreads();
    if (F.tid == 0) {
#pragma unroll
        for (int i = 0; i < 31; ++i) ((LAS unsigned long long*)(F.lds + PTR_OFF))[i] = (unsigned long long)args.in[i];
        ((LAS unsigned long long*)(F.lds + PTR_OFF))[31] = (unsigned long long)args.ws; ((LAS unsigned long long*)(F.lds + PTR_OFF))[32] = (unsigned long long)args.out;
    }
    __syncthreads();
    const int lo = args.ph_lo, hi = args.ph_hi;
    const bool multi = (hi - lo) > 1;
    if (multi) (void)xcd_barrier_post((unsigned*)ws_(F) + CW_BAR, (volatile LAS unsigned*)(F.lds + MISC_OFF) + 8);
#ifndef ONLY_PHASE
#define ONLY_PHASE -1
#endif
#define WSP ws_(F)
#define MODP ((const float*)(ws_(F) + WS_MOD))
#define ABUF ((bf16*)(ws_(F) + WS_A))
#ifndef SKIP_PHASE
#define SKIP_PHASE -1
#endif
#define IN(k) ((ONLY_PHASE < 0 || ONLY_PHASE == (k)) && SKIP_PHASE != (k) && lo <= (k) && (k) < hi)
#define SEAM(k) do { if (IN(k) && IN((k) + 1)) { XcdBarrier bar_; bar_.bar = (unsigned*)ws_(F) + CW_BAR; bar_.x = xb_xcc_id(); bar_.st = (volatile LAS unsigned*)(F.lds + MISC_OFF) + 8; xcd_barrier(bar_); } asm volatile("" : "+v"(F.tid), "+v"(F.lane)); } while (0)
    int pk = 0;
#ifndef REPEAT_PHASE
#define REPEAT_PHASE -1
#endif
#define PHASE(...) do { if (IN(pk)) { __VA_ARGS__ } if (REPEAT_PHASE == pk && IN(pk)) { { XcdBarrier bar_; bar_.bar = (unsigned*)ws_(F) + CW_BAR; bar_.x = xb_xcc_id(); bar_.st = (volatile LAS unsigned*)(F.lds + MISC_OFF) + 8; xcd_barrier(bar_); } asm volatile("" : "+v"(F.tid), "+v"(F.lane)); { __VA_ARGS__ } } SEAM(pk); ++pk; } while (0)
    PHASE( p0_prologue(F); p0_s5_tables(F); );
    PHASE( ph_init_rows(F); );
    PHASE( pg8::Epi8<FInProj> e{{(bf16*)(WSP + WS_CQKV), (bf16*)(WSP + WS_UG)}}; run_gemm(F, ABUF, D, (const bf16*)(WSP + WS_WIN0), D, TT, EVEN_IN_PAD, D, e); );
    PHASE( ph_s5_finals(F); );
    PHASE( ph_s5_carry(F); );
    PHASE( ph_mla_norm(F); );
    PHASE(
        { pg8::Epi8<FQ> e{{(bf16*)(WSP + WS_QB), (const float*)(WSP + WS_ROPE)}}; run_gemm(F, (const bf16*)(WSP + WS_CQKV), CQKV_LD, (const bf16*)(WSP + WS_WUQ), 384, TT, 768, 384, e); }
        { pg8::Epi8<FKV> e{{(bf16*)(WSP + WS_KB), (bf16*)(WSP + WS_VB)}}; run_gemm(F, (const bf16*)(WSP + WS_CQKV) + 384, CQKV_LD, (const bf16*)(WSP + WS_WUKV), 256, TT, 1024, 256, e); }
    );
    PHASE( ph_s5_out(F); );
    PHASE( ph_attn(F); );
    PHASE( pg8::Epi8<FGlu> e{{(const bf16*)(WSP + WS_Z), (bf16*)(WSP + WS_MIX)}}; run_gemm(F, (const bf16*)(WSP + WS_Z), 512, (const bf16*)(WSP + WS_WGLU), 512, TT, 512, 512, e); );
    PHASE( pg8::Epi4<FResid> e{{out_(F), (float*)(WSP + WS_XC), MODP + 0 * 3 * 6144 + 2 * 1024, 1, 0}}; run_gemm(F, (const bf16*)(WSP + WS_MIX), D, (const bf16*)(WSP + WS_WOUT0), D, TT, D, D, e); );
    PHASE( ph_layernorm(F, TT, 0, 0, 0, 3, nullptr, 0); );
#pragma unroll
    for (int grp = 0; grp < 2; ++grp) {
        PHASE( EpiConvGate e{(bf16*)(WSP + WS_HG), (bf16*)(WSP + WS_AB), (bf16*)(WSP + WS_GB), inp(F, 9) + (size_t)0 * 3 * FFH + grp * FFG, inp(F, 10) + (size_t)0 * FFH + grp * FFG}; run_gemm(F, ABUF, D, (const bf16*)(WSP + WS_F1T0) + (size_t)grp * FFH * D, D, TT, FFH, D, e); );
        PHASE( ph_convfix(F, TT, 0, grp); );
        PHASE( pg8::Epi4<FResid> e{{out_(F), (float*)(WSP + WS_XC), MODP + 0 * 3 * 6144 + 5 * 1024, grp == 0 ? 1 : 0, 0}}; run_gemm(F, (const bf16*)(WSP + WS_HG), FFG, (const bf16*)(WSP + WS_F2T0) + grp * FFG, FFH, TT, D, FFG, e); );
    }
    PHASE( ph_layernorm(F, TT, 0, 1, 1, 0, nullptr, 0); );
    PHASE( pg8::Epi8<FHgIn> e{{(bf16*)(WSP + WS_QFFI), (bf16*)(WSP + WS_G)}}; run_gemm(F, ABUF, D, (const bf16*)(WSP + WS_HGINT), D, TT, 5120, D, e); );
    PHASE( ph_hgrn_states(F); );
    PHASE( ph_hgrn_out(F); );
    PHASE( ph_hg_gate(F); );
    PHASE( pg8::Epi4<FResid> e{{out_(F), (float*)(WSP + WS_XC), MODP + 1 * 3 * 6144 + 2 * 1024, 1, 0}}; run_gemm(F, (const bf16*)(WSP + WS_O), D, (const bf16*)(WSP + WS_HGOUTT), D, TL, D, D, e); );
    PHASE( ph_layernorm(F, TL, 1, 0, 1, 3); );
#pragma unroll
    for (int grp = 0; grp < 2; ++grp) {
        PHASE( EpiConvGate e{(bf16*)(WSP + WS_HG), (bf16*)(WSP + WS_AB), (bf16*)(WSP + WS_GB), inp(F, 9) + (size_t)1 * 3 * FFH + grp * FFG, inp(F, 10) + (size_t)1 * FFH + grp * FFG}; run_gemm(F, ABUF, D, (const bf16*)(WSP + WS_F1T1) + (size_t)grp * FFH * D, D, TL, FFH, D, e); );
        PHASE( ph_convfix(F, TL, 1, grp); );
        PHASE( pg8::Epi4<FResid> e{{out_(F), (float*)(WSP + WS_XC), MODP + 1 * 3 * 6144 + 5 * 1024, grp == 0 ? 1 : 0, 0}}; run_gemm(F, (const bf16*)(WSP + WS_HG), FFG, (const bf16*)(WSP + WS_F2T1) + grp * FFG, FFH, TL, D, FFG, e); );
    }
    PHASE( ph_layernorm(F, TL, 1, 1, -1, 0); );
#undef PHASE
#undef IN
#undef SEAM
}

extern "C" void kernel_launch(void* const* d_in, const int* in_sizes, int n_in, void* d_out, int out_size, void* d_ws, size_t ws_size, hipStream_t stream) {
    static int grid = 0;
    if (grid == 0) {
        if (n_in != 31 || out_size != TL * D || ws_size < WS_END) { fprintf(stderr, "kernel_launch: unexpected shapes n_in %d out %d ws %zu\n", n_in, out_size, ws_size); grid = -1; return; }
        int dev = 0, cus = 0;
        if (hipGetDevice(&dev) != hipSuccess || hipDeviceGetAttribute(&cus, hipDeviceAttributeMultiprocessorCount, dev) != hipSuccess) { grid = -1; return; }
        if (hipFuncSetAttribute((const void*)mk_fwd, hipFuncAttributeMaxDynamicSharedMemorySize, LDS_BYTES) != hipSuccess) { fprintf(stderr, "kernel_launch: hipFuncSetAttribute failed\n"); grid = -1; return; }
        int per_cu = 0;
        if (hipOccupancyMaxActiveBlocksPerMultiprocessor(&per_cu, (const void*)mk_fwd, NWAVES * 64, LDS_BYTES) != hipSuccess || per_cu < 1) fprintf(stderr, "kernel_launch: occupancy query says %d\n", per_cu);
        (void)hipGetLastError();
        grid = cus;
    }
    if (grid < 0) return;
    if (hipMemsetAsync((char*)d_ws + WS_CTL, 0, CTL_ZERO_BYTES, stream) != hipSuccess) return;
    Args a{};
    for (int i = 0; i < 31; ++i) a.in[i] = (const float*)d_in[i];
    a.out = (float*)d_out; a.ws = (unsigned char*)d_ws;
#ifndef MK_ONE_LAUNCH
#define MK_ONE_LAUNCH 1
#endif
    if (MK_ONE_LAUNCH) { a.ph_lo = 0; a.ph_hi = NPH; hipLaunchKernelGGL(mk_fwd, dim3(grid), dim3(NWAVES * 64), LDS_BYTES, stream, a); }
    else for (int p = 0; p < NPH; ++p) { a.ph_lo = p; a.ph_hi = p + 1; hipLaunchKernelGGL(mk_fwd, dim3(grid), dim3(NWAVES * 64), LDS_BYTES, stream, a); }
}
```

```cpp
#include <hip/hip_runtime.h>
#include <cstdio>
#include <cstdint>
#include <cmath>
namespace pg8 {
#define PG8_LAS __attribute__((address_space(3)))
typedef unsigned short bf16_t;
typedef short bf16x8 __attribute__((ext_vector_type(8)));
typedef float f32x4 __attribute__((ext_vector_type(4)));
typedef unsigned u32x4 __attribute__((ext_vector_type(4)));
constexpr int BM = 256, BK = 64, HALF = 128, HTB = HALF * BK * 2  , STAGE_BYTES = 8 * HTB, NXCD = 8, WGM = 8;

__host__ __device__ __forceinline__ int lds_byte(int r, int c) { const int st = (r >> 4) * 2 + (c >> 5), rr = r & 15, cc = c & 31, ob = rr * 64 + cc * 2; return st * 1024 + (ob ^ (((ob >> 9) & 1) << 5)); }
__host__ __device__ __forceinline__ void stage_rc(int b, int& R, int& C) { const int st = b / 1024, sb = b % 1024, swz = sb ^ (((sb >> 9) & 1) << 5); R = (st >> 1) * 16 + swz / 64; C = (st & 1) * 32 + (swz % 64) / 2; }
__host__ __device__ __forceinline__ int perm32(int rho) { const int n = rho >> 4, i = rho & 15; return 8 * (i >> 2) + 4 * n + (i & 3); }

struct Unit { int pm, pn; };
struct Gemm { const bf16_t* A; const bf16_t* Bt; int M, N, K, lda, ldb; };

struct StaticOrder {
    int nM, nN, nwg, G, c;
    __host__ __device__ void init(int M, int N, int G_, int c_) { nM = M / BM; nN = N / BM; nwg = nM * nN; G = G_; c = c_; }
    __host__ __device__ bool next(int i, Unit& u) const {
        const long L = (long)i * G + c; if (L >= nwg) return false;
        int wgid = (int)L; { const int q = nwg / NXCD, r = nwg % NXCD, xcd = wgid % NXCD, off = wgid / NXCD; wgid = (xcd < r ? xcd * (q + 1) : r * (q + 1) + (xcd - r) * q) + off; }
        const int nig = WGM * nN, gid = wgid / nig, fm = gid * WGM, gsz = (nM - fm) < WGM ? (nM - fm) : WGM;
        u.pm = fm + ((wgid % nig) % gsz); u.pn = (wgid % nig) / gsz; return true;
    }
    __device__ __forceinline__ void a_ready(const Unit&) const {}
    __device__ __forceinline__ void done(const Unit&) const {}
};

__device__ __forceinline__ unsigned cvt_pk_bf16(float lo, float hi) { unsigned r; asm volatile("v_cvt_pk_bf16_f32 %0, %1, %2" : "=v"(r) : "v"(lo), "v"(hi)); return r; }
template <class F> struct Epi8 {
    static constexpr bool PERM = true, AFTER_DRAIN = false; F f;
    __device__ __forceinline__ void operator()(const f32x4 (&acc)[2][2][4][2], const Unit& u, int wr, int wc, int fr, int fq) const {
        const int row0 = u.pm * BM + wr * 64 + fr, col0 = u.pn * BM + wc * 32 + 8 * fq;
#pragma unroll
        for (int ai = 0; ai < 2; ++ai)
#pragma unroll
            for (int m = 0; m < 4; ++m)
#pragma unroll
                for (int bj = 0; bj < 2; ++bj) { f(row0 + ai * HALF + m * 16, col0 + bj * HALF, acc[ai][bj][m][0], acc[ai][bj][m][1]); __builtin_amdgcn_sched_barrier(0); }
    }
};
template <class F> struct Epi4 {
    static constexpr bool PERM = false, AFTER_DRAIN = false; F f;
    __device__ __forceinline__ void operator()(const f32x4 (&acc)[2][2][4][2], const Unit& u, int wr, int wc, int fr, int fq) const {
        const int row0 = u.pm * BM + wr * 64 + fr, col0 = u.pn * BM + wc * 32 + 4 * fq;
#pragma unroll
        for (int ai = 0; ai < 2; ++ai)
#pragma unroll
            for (int m = 0; m < 4; ++m)
#pragma unroll
                for (int bj = 0; bj < 2; ++bj)
#pragma unroll
                    for (int n = 0; n < 2; ++n) { f(row0 + ai * HALF + m * 16, col0 + bj * HALF + n * 16, acc[ai][bj][m][n]); __builtin_amdgcn_sched_barrier(0); }
    }
};
template <class Epi, class Sched, bool ALIGN_EPI = false, bool SP2 = false>
__device__ __forceinline__ void gemm_phase(PG8_LAS unsigned char* lds, const Gemm g, const Sched& S, const Epi& E) {
    int tid_ = threadIdx.x; asm volatile("" : "+v"(tid_));
    const int tid = tid_, wid = __builtin_amdgcn_readfirstlane(tid >> 6), lane = tid & 63, wr = wid >> 2, wc = wid & 3, fr = lane & 15, fq = lane >> 4;
    const int K = g.K, nt = K / BK;
    unsigned voffA[2], voffB[2];
#pragma unroll
    for (int i = 0; i < 2; ++i) { int R, C; stage_rc(tid * 16 + i * 8192, R, C); const int Rb = Epi::PERM ? ((R & ~31) + perm32(R & 31)) : R;
        voffA[i] = (unsigned)(R * g.lda + C) * 2u; voffB[i] = (unsigned)(Rb * g.ldb + C) * 2u; }
    const size_t kstep = (size_t)(BK * 2);
    const size_t hstepA = (size_t)HALF * g.lda * 2, hstepB = (size_t)HALF * g.ldb * 2;
    const size_t tstepA = 2 * hstepA, tstepB = 2 * hstepB;
    const unsigned ldsw = (unsigned)wid * 1024u;
    const int aoff = lds_byte(wr * 64 + fr, fq * 8), boff = lds_byte(wc * 32 + fr, fq * 8);
#define PG8_SA(b, h) (((b) * 2 + (h)) * HTB)
#define PG8_SB(b, h) ((4 + (b) * 2 + (h)) * HTB)
#define PG8_STAGE(bufoff, gbase, voff) do { _Pragma("unroll") for (int _i = 0; _i < 2; ++_i) \
        __builtin_amdgcn_global_load_lds((const unsigned*)((const char*)(gbase) + (voff)[_i]), (PG8_LAS unsigned*)(lds + (bufoff) + ldsw + _i * 8192), 16, 0, 0); } while (0)
#define PG8_LDA(dst, b, h) do { _Pragma("unroll") for (int m = 0; m < 4; ++m) _Pragma("unroll") for (int k = 0; k < 2; ++k) dst[m][k] = *(const PG8_LAS bf16x8*)(lds + PG8_SA(b, h) + aoff + m * 2048 + k * 1024); } while (0)
#define PG8_LDB(dst, b, h) do { _Pragma("unroll") for (int n = 0; n < 2; ++n) _Pragma("unroll") for (int k = 0; k < 2; ++k) dst[n][k] = *(const PG8_LAS bf16x8*)(lds + PG8_SB(b, h) + boff + n * 2048 + k * 1024); } while (0)
#define PG8_MMA(ai, bj, At, Bt) do { __builtin_amdgcn_s_setprio(1); _Pragma("unroll") for (int m = 0; m < 4; ++m) _Pragma("unroll") for (int n = 0; n < 2; ++n) _Pragma("unroll") for (int k = 0; k < 2; ++k) \
        acc[ai][bj][m][n] = __builtin_amdgcn_mfma_f32_16x16x32_bf16(Bt[n][k], At[m][k], acc[ai][bj][m][n], 0, 0, 0); __builtin_amdgcn_s_setprio(0); } while (0)
#define PG8_WAIT_V(n) asm volatile("s_waitcnt vmcnt(" #n ")" ::: "memory")
#define PG8_WAIT_L(n) asm volatile("s_waitcnt lgkmcnt(" #n ")" ::: "memory")
#define PG8_BAR __builtin_amdgcn_s_barrier()
#define PG8_SCHED __builtin_amdgcn_sched_barrier(0)
    Unit cur, nxt; int ui = 0;
    if (!S.next(0, cur)) return;
    f32x4 acc[2][2][4][2];
#pragma unroll
    for (int a = 0; a < 2; ++a)
#pragma unroll
        for (int b = 0; b < 2; ++b)
#pragma unroll
            for (int m = 0; m < 4; ++m)
#pragma unroll
                for (int n = 0; n < 2; ++n) acc[a][b][m][n] = (f32x4){0.f, 0.f, 0.f, 0.f};
    bf16x8 At[4][2], B0[2][2], B1[2][2];
    const char* cA = (const char*)g.A + (size_t)cur.pm * tstepA; const char* cB = (const char*)g.Bt + (size_t)cur.pn * tstepB;
    S.a_ready(cur);
    if constexpr (SP2) {
        PG8_STAGE(PG8_SB(0, 0), cB, voffB); PG8_STAGE(PG8_SB(0, 1), cB + hstepB, voffB); PG8_STAGE(PG8_SA(0, 0), cA, voffA); PG8_STAGE(PG8_SA(0, 1), cA + hstepA, voffA);
        if (wr == 1) PG8_BAR;
        PG8_WAIT_V(2); PG8_BAR;
        PG8_STAGE(PG8_SB(1, 0), cB + kstep, voffB); PG8_STAGE(PG8_SA(1, 0), cA + kstep, voffA); PG8_STAGE(PG8_SB(1, 1), cB + hstepB + kstep, voffB);
        PG8_WAIT_V(6); PG8_BAR;
    } else {
        PG8_STAGE(PG8_SB(0, 0), cB, voffB); PG8_STAGE(PG8_SA(0, 0), cA, voffA); PG8_STAGE(PG8_SB(0, 1), cB + hstepB, voffB); PG8_STAGE(PG8_SA(0, 1), cA + hstepA, voffA);
        if (wr == 1) PG8_BAR;
        PG8_WAIT_V(4); PG8_BAR;
        PG8_STAGE(PG8_SB(1, 0), cB + kstep, voffB); PG8_STAGE(PG8_SA(1, 0), cA + kstep, voffA); PG8_STAGE(PG8_SB(1, 1), cB + hstepB + kstep, voffB);
        PG8_WAIT_V(6); PG8_BAR;
    }
    for (;;) {
        const bool has_next = S.next(ui + 1, nxt);
        const char* nA = has_next ? (const char*)g.A + (size_t)nxt.pm * tstepA : cA; const char* nB = has_next ? (const char*)g.Bt + (size_t)nxt.pn * tstepB : cB;
#pragma unroll 1
        for (int t = 0; t < nt; t += 2) {
            const bool last = (t == nt - 2);
            const char* a1 = cA + (size_t)(t + 1) * kstep;
            const char* a2 = last ? nA : cA + (size_t)(t + 2) * kstep; const char* b2 = last ? nB : cB + (size_t)(t + 2) * kstep;
            const char* a3 = a2 + kstep; const char* b3 = b2 + kstep;
            if (last && has_next) S.a_ready(nxt);
            if constexpr (SP2) {
            PG8_LDB(B0, 0, 0); PG8_LDB(B1, 0, 1); PG8_SCHED; PG8_LDA(At, 0, 0); PG8_STAGE(PG8_SA(1, 1), a1 + hstepA, voffA);
            PG8_WAIT_V(8); PG8_WAIT_L(0); PG8_BAR; PG8_MMA(0, 0, At, B0); PG8_MMA(0, 1, At, B1); PG8_BAR; PG8_SCHED;
            PG8_LDA(At, 0, 1); PG8_STAGE(PG8_SB(0, 0), b2, voffB); PG8_STAGE(PG8_SB(0, 1), b2 + hstepB, voffB); PG8_STAGE(PG8_SA(0, 0), a2, voffA);
            PG8_WAIT_V(8); PG8_WAIT_L(0); PG8_BAR; PG8_MMA(1, 0, At, B0); PG8_MMA(1, 1, At, B1); PG8_BAR; PG8_SCHED;
            PG8_LDB(B0, 1, 0); PG8_LDB(B1, 1, 1); PG8_SCHED; PG8_LDA(At, 1, 0); PG8_STAGE(PG8_SA(0, 1), a2 + hstepA, voffA);
            PG8_WAIT_V(8); PG8_WAIT_L(0); PG8_BAR; PG8_MMA(0, 0, At, B0); PG8_MMA(0, 1, At, B1); PG8_BAR; PG8_SCHED;
            PG8_LDA(At, 1, 1); PG8_STAGE(PG8_SB(1, 0), b3, voffB); PG8_STAGE(PG8_SB(1, 1), b3 + hstepB, voffB); PG8_STAGE(PG8_SA(1, 0), a3, voffA);
            PG8_WAIT_V(8); PG8_WAIT_L(0); PG8_BAR; PG8_MMA(1, 0, At, B0); PG8_MMA(1, 1, At, B1); PG8_BAR; PG8_SCHED;
            } else {
            PG8_LDB(B0, 0, 0); PG8_SCHED; PG8_LDA(At, 0, 0); PG8_STAGE(PG8_SA(1, 1), a1 + hstepA, voffA);
            PG8_WAIT_L(8); PG8_BAR; PG8_WAIT_L(0); PG8_MMA(0, 0, At, B0); PG8_BAR; PG8_SCHED;
            PG8_LDB(B1, 0, 1); PG8_STAGE(PG8_SB(0, 0), b2, voffB);
            PG8_BAR; PG8_WAIT_L(0); PG8_MMA(0, 1, At, B1); PG8_BAR;
            PG8_LDA(At, 0, 1); PG8_STAGE(PG8_SA(0, 0), a2, voffA);
            PG8_BAR; PG8_WAIT_L(0); PG8_MMA(1, 0, At, B0); PG8_BAR; PG8_SCHED;
            PG8_STAGE(PG8_SB(0, 1), b2 + hstepB, voffB);
            PG8_WAIT_V(6); PG8_BAR; PG8_MMA(1, 1, At, B1); PG8_BAR;
            PG8_LDB(B0, 1, 0); PG8_SCHED; PG8_LDA(At, 1, 0); PG8_STAGE(PG8_SA(0, 1), a2 + hstepA, voffA);
            PG8_WAIT_L(8); PG8_BAR; PG8_WAIT_L(0); PG8_MMA(0, 0, At, B0); PG8_BAR; PG8_SCHED;
            PG8_LDB(B1, 1, 1); PG8_STAGE(PG8_SB(1, 0), b3, voffB);
            PG8_BAR; PG8_WAIT_L(0); PG8_MMA(0, 1, At, B1); PG8_BAR;
            PG8_LDA(At, 1, 1); PG8_STAGE(PG8_SA(1, 0), a3, voffA);
            PG8_BAR; PG8_WAIT_L(0); PG8_MMA(1, 0, At, B0); PG8_BAR; PG8_SCHED;
            PG8_STAGE(PG8_SB(1, 1), b3 + hstepB, voffB);
            PG8_WAIT_V(6); PG8_BAR; PG8_MMA(1, 1, At, B1); PG8_BAR;
            }
        }
        if constexpr (ALIGN_EPI) { if (wr == 0) PG8_BAR; }
        if constexpr (!Epi::AFTER_DRAIN) { E(acc, cur, wr, wc, fr, fq); S.done(cur); }
        if (!has_next) break;
#pragma unroll
        for (int a = 0; a < 2; ++a)
#pragma unroll
            for (int b = 0; b < 2; ++b)
#pragma unroll
                for (int m = 0; m < 4; ++m)
#pragma unroll
                    for (int n = 0; n < 2; ++n) acc[a][b][m][n] = (f32x4){0.f, 0.f, 0.f, 0.f};
        cur = nxt; cA = nA; cB = nB; ++ui;
        if constexpr (ALIGN_EPI) { if (wr == 1) PG8_BAR; }
    }
    PG8_WAIT_V(0);
    if constexpr (!ALIGN_EPI) { if (wr == 0) PG8_BAR; }
    PG8_BAR;
    if constexpr (Epi::AFTER_DRAIN) { E.fused(acc, cur, wr, wc, fr, fq, lds, wid, lane); S.done(cur); }
#undef PG8_SA
#undef PG8_SB
#undef PG8_STAGE
#undef PG8_LDA
#undef PG8_LDB
#undef PG8_MMA
#undef PG8_WAIT_V
#undef PG8_WAIT_L
#undef PG8_BAR
#undef PG8_SCHED
}
}

constexpr int NWAVES = 8;
constexpr int D = 1024, BATCH = 2, SEQ = 8192, CTXL = 256;
constexpr int TL = BATCH * SEQ;
constexpr int TC = BATCH * CTXL;
constexpr int TT = TL + TC;
constexpr int EVEN_IN = 1184, EVEN_IN_PAD = 1280, CQKV_LD = 672;
constexpr int FFH = 2816, FFG = 1408;
constexpr int TQK = SEQ + CTXL;
constexpr float NORM_EPS = 1e-6f;
constexpr float DN_ALPHA = 1.41421356237f;
constexpr float QSCALE = 0.10206207261596577f * 1.4426950408889634f;

constexpr size_t MiB = 1u << 20;
constexpr size_t WS_CTL = 0, CTL_ZERO_BYTES = 1 * MiB;
constexpr size_t WS_MOD = 1 * MiB;
constexpr size_t WS_LBV = WS_MOD + 160 * 1024;
constexpr size_t WS_ROPE = WS_LBV + 16 * 1024;
constexpr size_t WS_HGINT = 2 * MiB, WS_HGOUTT = 12 * MiB, WS_F1T1 = 14 * MiB, WS_F2T1 = 25 * MiB;
constexpr size_t WS_A = 31 * MiB;
constexpr size_t WS_XC = 64 * MiB;
constexpr size_t WS_WIN0 = 66 * MiB, WS_WUQ = WS_WIN0 + 2560 * 1024, WS_WUKV = WS_WUQ + 768 * 1024, WS_WGLU = WS_WUKV + 512 * 1024,
                 WS_WOUT0 = WS_WGLU + 512 * 1024, WS_F1T0 = 72 * MiB + 512 * 1024, WS_F2T0 = WS_F1T0 + 11 * MiB;
constexpr size_t WS_R = 89 * MiB;
constexpr size_t WS_CQKV = WS_R;
constexpr size_t WS_UG = WS_R + 22 * MiB;
constexpr size_t WS_WF = WS_R + 39 * MiB;
constexpr size_t WS_WC = WS_R + 64 * MiB;
constexpr size_t WS_TOEP = WS_R + 80 * MiB;
constexpr size_t WS_T0 = WS_R + 82 * MiB;
constexpr size_t WS_A64 = WS_T0 + 128 * 1024;
constexpr size_t WS_FIN = WS_R + 83 * MiB;
constexpr size_t WS_SIN = WS_R + 92 * MiB;
constexpr size_t WS_Z = WS_R + 97 * MiB;
constexpr size_t WS_MIX = WS_R + 134 * MiB;
constexpr size_t WS_QB = WS_R + 39 * MiB;
constexpr size_t WS_KB = 31 * MiB;
constexpr size_t WS_VB = WS_R + 114 * MiB;
constexpr size_t WS_AB = WS_R;
constexpr size_t WS_GB = WS_R + 8 * MiB;
constexpr size_t WS_H = WS_R;
constexpr size_t WS_HG = WS_R + 16 * MiB;
constexpr size_t WS_QFFI = 66 * MiB;
constexpr size_t WS_G = 198 * MiB;
constexpr size_t WS_O = WS_A;
constexpr size_t WS_SLAB1 = WS_R;
constexpr size_t WS_SLAB2 = WS_R + 140 * MiB;
constexpr size_t WS_END = 256 * MiB;
static_assert(WS_F2T0 + 5632 * 1024 <= WS_R, "layer-0 weights");
static_assert(WS_MIX + (size_t)TT * 1024 * 2 <= WS_END && WS_G + (size_t)TT * 1024 * 2 <= WS_END && WS_HG + (size_t)TT * FFH * 2 <= WS_END, "ws map");
static_assert(WS_WF + 16 * MiB <= WS_WC && WS_QB + (size_t)16 * TQK * 96 * 2 <= WS_WC && WS_WC + 16 * MiB <= WS_TOEP && WS_TOEP + 2 * MiB <= WS_T0 && WS_T0 + MiB <= WS_FIN && WS_FIN + (size_t)32 * 264 * 256 * 4 <= WS_SIN && WS_SIN + (size_t)32 * 264 * 256 * 2 <= WS_Z && WS_Z + (size_t)TT * 512 * 2 <= WS_VB && WS_VB + (size_t)16 * TQK * 64 * 2 <= WS_MIX && WS_KB + (size_t)16 * TQK * 96 * 2 <= WS_XC, "ws map 2");

constexpr int CW_BAR = 4096;
constexpr int RING_OFF = 0, RING_BYTES = 131072;
constexpr int LDSCTL_OFF = RING_BYTES, MISC_OFF = LDSCTL_OFF + 320;
constexpr int LDS_BYTES = 147456;

#define GAS __attribute__((address_space(1)))
#define LAS __attribute__((address_space(3)))
typedef unsigned short bf16;
typedef unsigned v4u __attribute__((ext_vector_type(4)));
typedef unsigned v2u __attribute__((ext_vector_type(2)));
typedef float f32x4 __attribute__((ext_vector_type(4)));
typedef GAS unsigned gu32;
#define RLX_AGENT __ATOMIC_RELAXED, __HIP_MEMORY_SCOPE_AGENT
#define LDS_WAIT() asm volatile("s_waitcnt lgkmcnt(0)" ::: "memory")
__device__ __forceinline__ unsigned f2bf(float f) { unsigned u = __builtin_bit_cast(unsigned, f); return (u + 0x7fffu + ((u >> 16) & 1u)) >> 16; }
__device__ __forceinline__ unsigned pk2(float lo, float hi) { return f2bf(lo) | (f2bf(hi) << 16); }
__device__ __forceinline__ float bflo(unsigned w) { return __builtin_bit_cast(float, w << 16); }
__device__ __forceinline__ float bfhi(unsigned w) { return __builtin_bit_cast(float, w & 0xffff0000u); }
__device__ __forceinline__ float bf2f(bf16 h) { return __builtin_bit_cast(float, (unsigned)h << 16); }
__device__ __forceinline__ void unpack8(v4u w, float* x) { x[0] = bflo(w.x); x[1] = bfhi(w.x); x[2] = bflo(w.y); x[3] = bfhi(w.y); x[4] = bflo(w.z); x[5] = bfhi(w.z); x[6] = bflo(w.w); x[7] = bfhi(w.w); }
__device__ __forceinline__ v4u pack8(const float* x) { v4u w; w.x = pk2(x[0], x[1]); w.y = pk2(x[2], x[3]); w.z = pk2(x[4], x[5]); w.w = pk2(x[6], x[7]); return w; }
__device__ __forceinline__ float sigmoidf_(float x) { return 1.0f / (1.0f + __expf(-x)); }
__device__ __forceinline__ float siluf_(float x) { return x / (1.0f + __expf(-x)); }
__device__ __forceinline__ float gelu_tanh(float x) { const float u = 0.7978845608028654f * (x + 0.044715f * x * x * x); return 0.5f * x * (1.0f + tanhf(u)); }
__device__ __forceinline__ float wave_sum(float v) {
#pragma unroll
    for (int o = 1; o < 64; o <<= 1) v += __shfl_xor(v, o);
    return v;
}

#define XB_TMO      128
#define XB_XCNT(j)  (256  + 64 * (j))
#define XB_XSUB(j)  (1280 + 64 * (j))
#define XB_XGEN(j)  (2304 + 64 * (j))
#define XB_TOP      3328
#define XB_TOPGEN   3392
#define XCD_BAR_WORDS 3456
#define XB_SPIN_CAP (1u << 18)

__device__ __forceinline__ unsigned xb_ld(unsigned* p)              { return __hip_atomic_load(p, __ATOMIC_RELAXED, __HIP_MEMORY_SCOPE_AGENT); }
__device__ __forceinline__ unsigned xb_add(unsigned* p, unsigned v) { return __hip_atomic_fetch_add(p, v, __ATOMIC_RELAXED, __HIP_MEMORY_SCOPE_AGENT); }
__device__ __forceinline__ unsigned xb_xcc_id() { return (unsigned)__builtin_amdgcn_s_getreg((3 << 11) | 20) & 0xFu; }
#define XB_SPIN(cond, bar) do { unsigned _sp = 0; while (cond) { __builtin_amdgcn_s_sleep(1); \
    if ((++_sp & 255u) == 0u) { if (xb_ld(&(bar)[XB_TMO])) break; if (_sp > XB_SPIN_CAP) { atomicAdd(&(bar)[XB_TMO], 1u); break; } } } } while (0)

struct XcdBarrier {
    unsigned* bar; unsigned x;
    volatile LAS unsigned* st;
};

__device__ __forceinline__ XcdBarrier xcd_barrier_post(unsigned* bar, volatile LAS unsigned* st) {
    XcdBarrier b; b.bar = bar; b.x = xb_xcc_id(); b.st = st;
    if (threadIdx.x == 0) (void)xb_add(&bar[XB_XCNT(b.x)], 1u);
    return b;
}
__device__ __forceinline__ void xcd_barrier_complete(unsigned* bar, unsigned x, unsigned& nloc, unsigned& nx) {
    const unsigned G = gridDim.x * gridDim.y * gridDim.z;
    unsigned sum, cnt, mine, sp = 0u;
    for (;;) {
        sum = 0u; cnt = 0u; mine = 0u;
#pragma unroll
        for (unsigned j = 0; j < 16; ++j) { const unsigned c = xb_ld(&bar[XB_XCNT(j)]); sum += c; cnt += (c > 0u) ? 1u : 0u; mine = (j == x) ? c : mine; }
        if (sum == G) break;
        __builtin_amdgcn_s_sleep(1);
        if ((++sp & 255u) == 0u) { if (xb_ld(&bar[XB_TMO])) break; if (sp > XB_SPIN_CAP) { atomicAdd(&bar[XB_TMO], 1u); break; } }
    }
    nloc = mine > 0u ? mine : 1u; nx = cnt > 0u ? cnt : 1u;
}

__device__ __forceinline__ void xcd_barrier(const XcdBarrier& b) {
    asm volatile("s_waitcnt vmcnt(0)" ::: "memory");
    __syncthreads();
    if (threadIdx.x == 0) {
        unsigned* bar = b.bar;
        __builtin_amdgcn_s_waitcnt(0);
        unsigned nloc = b.st[0], nx = b.st[1];
        if (nloc == 0u) { xcd_barrier_complete(bar, b.x, nloc, nx); b.st[0] = nloc; b.st[1] = nx; }
        const unsigned old = xb_add(&bar[XB_XSUB(b.x)], 1u);
        const unsigned gen = old / nloc;
        if (old + 1u == (gen + 1u) * nloc) {
            __builtin_amdgcn_fence(__ATOMIC_RELEASE, "agent");
            asm volatile("s_waitcnt vmcnt(0)" ::: "memory");
            const unsigned og = xb_add(&bar[XB_TOP], 1u);
            const unsigned tg = og / nx;
            if (og + 1u == (tg + 1u) * nx) xb_add(&bar[XB_TOPGEN], 1u);
            else XB_SPIN(xb_ld(&bar[XB_TOPGEN]) == tg, bar);
            __builtin_amdgcn_fence(__ATOMIC_ACQUIRE, "agent");
            xb_add(&bar[XB_XGEN(b.x)], 1u);
            asm volatile("s_waitcnt vmcnt(0)" ::: "memory");
        } else {
            XB_SPIN(xb_ld(&bar[XB_XGEN(b.x)]) == gen, bar);
            __builtin_amdgcn_fence(__ATOMIC_ACQUIRE, "agent");
            asm volatile("s_waitcnt vmcnt(0)" ::: "memory");
        }
    }
    __syncthreads();
}


struct Frame {
    LAS unsigned char* lds;
    int tid, lane, wave, vcu, G;
};
constexpr int PTR_OFF = LDSCTL_OFF + 1024;
__device__ __forceinline__ const float* inp(const Frame& F, int i) {
    const LAS unsigned* p = (const LAS unsigned*)(F.lds + PTR_OFF) + 2 * i;
    const unsigned lo = __builtin_amdgcn_readfirstlane(p[0]), hi = __builtin_amdgcn_readfirstlane(p[1]);
    return (const float*)(((unsigned long long)hi << 32) | lo);
}
__device__ __forceinline__ unsigned char* ws_(const Frame& F) { return (unsigned char*)inp(F, 31); }
__device__ __forceinline__ float* out_(const Frame& F) { return (float*)inp(F, 32); }
__device__ __forceinline__ int modrow_of(int m) { return m < TL ? (m >> 13) : 2; }
__device__ __forceinline__ const float* xin_row(const Frame& F, int m) { return m < TL ? inp(F, 0) + (size_t)m * D : inp(F, 2) + (size_t)(m - TL) * D; }
__device__ __forceinline__ float* xres_row(const Frame& F, int m) { return m < TL ? out_(F) + (size_t)m * D : (float*)(ws_(F) + WS_XC) + (size_t)(m - TL) * D; }
__device__ __forceinline__ const float* modvec(const Frame& F, int layer, int mr, int part) { return (const float*)(ws_(F) + WS_MOD) + (size_t)(layer * 3 + mr) * 6144 + part * 1024; }

__device__ __forceinline__ void tr_item(const float* W, int ldw, int k0, int n0, bf16* dst, int dpitch, LAS float* scr, int lane) {
    { f32x4 v[8];
#pragma unroll
      for (int i = 0; i < 8; ++i) v[i] = *(const GAS f32x4*)(W + (size_t)(k0 + 8 * i + (lane >> 3)) * ldw + n0 + 4 * (lane & 7));
#pragma unroll
      for (int i = 0; i < 8; ++i) { LAS float* d = scr + (8 * i + (lane >> 3)) * 33 + 4 * (lane & 7); d[0] = v[i].x; d[1] = v[i].y; d[2] = v[i].z; d[3] = v[i].w; } }
    LDS_WAIT(); asm volatile("" ::: "memory");
    const int c = lane & 7;
#pragma unroll
    for (int j = 0; j < 4; ++j) { const int n = (lane >> 3) + 8 * j; const LAS float* s = scr + (8 * c) * 33 + n;
        v4u o; o.x = pk2(s[0 * 33], s[1 * 33]); o.y = pk2(s[2 * 33], s[3 * 33]); o.z = pk2(s[4 * 33], s[5 * 33]); o.w = pk2(s[6 * 33], s[7 * 33]);
        *(GAS v4u*)(dst + (size_t)n * dpitch + 8 * c) = o; }
    LDS_WAIT(); asm volatile("" ::: "memory");
}
__device__ __forceinline__ bool tr_plain(int& r, const float* W, int K, int N, bf16* WT, LAS float* scr, int lane) {
    const int nblk = N / 32, cnt = (K / 64) * nblk;
    if (r >= cnt) { r -= cnt; return false; }
    const int kb = r / nblk, nb = r % nblk;
    tr_item(W, N, 64 * kb, 32 * nb, WT + (size_t)(32 * nb) * K + 64 * kb, K, scr, lane); return true;
}
__device__ __forceinline__ bool tr_ffn1(int& r, const float* W, bf16* WT, LAS float* scr, int lane) {
    const int nblk = 5632 / 32, cnt = 16 * nblk;
    if (r >= cnt) { r -= cnt; return false; }
    const int kb = r / nblk, nb = r % nblk, n0 = 32 * nb, half = n0 / FFH, j = n0 % FFH, drow = (j >> 7) * 256 + half * 128 + (j & 127);
    tr_item(W, 5632, 64 * kb, n0, WT + (size_t)drow * 1024 + 64 * kb, 1024, scr, lane); return true;
}
__device__ __forceinline__ void p0_prologue(Frame& F) {
    {
        LAS float* sv = (LAS float*)(F.lds + RING_OFF);
        LAS float* red = sv + 3072;
        for (int i = F.tid; i < 3072; i += 512) { const int r = i >> 10, k = i & 1023; const float cv = (r < 2) ? inp(F, 1)[r * 1024 + k] : inp(F, 3)[k]; sv[i] = cv / (1.0f + __expf(-cv)); }
        __syncthreads();
        for (int it = blockIdx.x; it < 192; it += F.G) {
            const int layer = it / 96, cg = it % 96, col = cg * 64 + F.lane, k0 = F.wave * 128;
            const float* w = inp(F, 4) + ((size_t)layer * 1024 + k0) * 6144 + col;
            float a0 = 0.f, a1 = 0.f, a2 = 0.f;
#pragma unroll 16
            for (int k = 0; k < 128; ++k) { const float wv = w[(size_t)k * 6144]; a0 += sv[k0 + k] * wv; a1 += sv[1024 + k0 + k] * wv; a2 += sv[2048 + k0 + k] * wv; }
            red[(F.wave * 3 + 0) * 64 + F.lane] = a0; red[(F.wave * 3 + 1) * 64 + F.lane] = a1; red[(F.wave * 3 + 2) * 64 + F.lane] = a2;
            __syncthreads();
            if (F.tid < 192) { const int r = F.tid >> 6, l = F.tid & 63; float s = inp(F, 5)[layer * 6144 + cg * 64 + l];
#pragma unroll
                for (int wv = 0; wv < 8; ++wv) s += red[(wv * 3 + r) * 64 + l];
                ((float*)(ws_(F) + WS_MOD))[(size_t)(layer * 3 + r) * 6144 + cg * 64 + l] = s; }
            __syncthreads();
        }
        __syncthreads();
    }
    {
        const int gt = F.vcu * 512 + F.tid, NT = F.G * 512;
        for (int i = gt; i < 2048; i += NT) { const int dir = i >> 10, c = i & 1023; const float l0 = inp(F, 28)[(0 * 2 + dir) * 1024 + c], l1 = inp(F, 28)[(1 * 2 + dir) * 1024 + c];
            ((float*)(ws_(F) + WS_LBV))[i] = 1.0f / (1.0f + expf(l0 - l1)); }
        for (int i = gt; i < 1024; i += NT) { const int pos = i >> 3, f = i & 7; const float inv = powf(10000.0f, -(float)f / 8.0f); const float ang = (float)pos * inv;
            ((float*)(ws_(F) + WS_ROPE))[2 * i] = cosf(ang); ((float*)(ws_(F) + WS_ROPE))[2 * i + 1] = sinf(ang); }
        for (int i = gt; i < 96 * 1024 / 8; i += NT) ((GAS v4u*)(ws_(F) + WS_WIN0 + (size_t)1184 * 1024 * 2))[i] = (v4u){0u, 0u, 0u, 0u};
    }
    {
        LAS float* scr = (LAS float*)(F.lds + RING_OFF + F.wave * 16384);
        const int gw = F.vcu * NWAVES + F.wave, NGW = F.G * NWAVES;
        constexpr int NITEMS = 592 + 144 + 128 + 128 + 512 + 2 * 2816 + 2 * 1408 + 2560 + 512;
        for (int it = gw; it < NITEMS; it += NGW) {
            int r = it;
            if (tr_plain(r, inp(F, 12), 1024, 1184, (bf16*)(ws_(F) + WS_WIN0), scr, F.lane)) continue;
            if (tr_plain(r, inp(F, 14), 384, 768, (bf16*)(ws_(F) + WS_WUQ), scr, F.lane)) continue;
            if (tr_plain(r, inp(F, 16), 256, 1024, (bf16*)(ws_(F) + WS_WUKV), scr, F.lane)) continue;
            if (tr_plain(r, inp(F, 25), 512, 512, (bf16*)(ws_(F) + WS_WGLU), scr, F.lane)) continue;
            if (tr_plain(r, inp(F, 26), 1024, 1024, (bf16*)(ws_(F) + WS_WOUT0), scr, F.lane)) continue;
            if (tr_ffn1(r, inp(F, 8), (bf16*)(ws_(F) + WS_F1T0), scr, F.lane)) continue;
            if (tr_ffn1(r, inp(F, 8) + (size_t)1024 * 5632, (bf16*)(ws_(F) + WS_F1T1), scr, F.lane)) continue;
            if (tr_plain(r, inp(F, 11), 2816, 1024, (bf16*)(ws_(F) + WS_F2T0), scr, F.lane)) continue;
            if (tr_plain(r, inp(F, 11) + (size_t)2816 * 1024, 2816, 1024, (bf16*)(ws_(F) + WS_F2T1), scr, F.lane)) continue;
            if (tr_plain(r, inp(F, 27), 1024, 5120, (bf16*)(ws_(F) + WS_HGINT), scr, F.lane)) continue;
            tr_plain(r, inp(F, 30), 1024, 1024, (bf16*)(ws_(F) + WS_HGOUTT), scr, F.lane);
        }
    }
}

__device__ __forceinline__ void store_mod_bf16(const Frame& F, const f32x4 (&v)[4], int m, int layer, int part_sh) {
    const int mr = modrow_of(m);
    const GAS f32x4* sh = (const GAS f32x4*)modvec(F, layer, mr, part_sh) + F.lane;
    const GAS f32x4* sc = (const GAS f32x4*)modvec(F, layer, mr, part_sh + 1) + F.lane;
    GAS v2u* o = (GAS v2u*)((bf16*)(ws_(F) + WS_A) + (size_t)m * D) + F.lane;
#pragma unroll
    for (int j = 0; j < 4; ++j) { const f32x4 s = sc[64 * j], h = sh[64 * j]; const f32x4 y = v[j] * (s + 1.0f) + h; v2u w; w.x = pk2(y.x, y.y); w.y = pk2(y.z, y.w); o[64 * j] = w; }
}
__device__ __forceinline__ void ph_init_rows(Frame& F) {
    const int gw = F.vcu * NWAVES + F.wave, NGW = F.G * NWAVES;
    for (int m = gw; m < TT; m += NGW) {
        const GAS f32x4* xr = (const GAS f32x4*)xin_row(F, m) + F.lane; GAS f32x4* xo = (GAS f32x4*)xres_row(F, m) + F.lane;
        f32x4 v[4];
#pragma unroll
        for (int j = 0; j < 4; ++j) { v[j] = xr[64 * j]; xo[64 * j] = (m >= TL) ? v[j] * DN_ALPHA : v[j]; }
        store_mod_bf16(F, v, m, 0, 0);
    }
}
__device__ __forceinline__ void ph_layernorm(Frame& F, int nrows, int layer, int which, int next_layer, int next_part_sh, const float* slabs = nullptr, int nslabs = 0) {
    const int gw = F.vcu * NWAVES + F.wave, NGW = F.G * NWAVES;
    const GAS f32x4* gg = (const GAS f32x4*)(inp(F, 6) + (size_t)(layer * 2 + which) * D) + F.lane;
    const GAS f32x4* bb = (const GAS f32x4*)(inp(F, 7) + (size_t)(layer * 2 + which) * D) + F.lane;
    for (int m0 = gw; m0 < nrows; m0 += 2 * NGW) {
        const int m1 = m0 + NGW; const bool has1 = m1 < nrows; const int m1c = has1 ? m1 : m0;
        GAS f32x4* xr0 = (GAS f32x4*)xres_row(F, m0) + F.lane; GAS f32x4* xr1 = (GAS f32x4*)xres_row(F, m1c) + F.lane;
        f32x4 v[4], w[4]; float s0 = 0.f, s1 = 0.f;
#pragma unroll
        for (int j = 0; j < 4; ++j) { v[j] = xr0[64 * j]; w[j] = xr1[64 * j]; }
        if (nslabs > 0 && m1c >= TL) {
            for (int sl = 0; sl < nslabs; ++sl) { const GAS f32x4* p1 = (const GAS f32x4*)(slabs + ((size_t)sl * TC + (m1c - TL)) * D) + F.lane;
#pragma unroll
                for (int j = 0; j < 4; ++j) w[j] += p1[64 * j];
                if (m0 >= TL) { const GAS f32x4* p0 = (const GAS f32x4*)(slabs + ((size_t)sl * TC + (m0 - TL)) * D) + F.lane;
#pragma unroll
                    for (int j = 0; j < 4; ++j) v[j] += p0[64 * j]; } }
        }
#pragma unroll
        for (int j = 0; j < 4; ++j) { s0 += (v[j].x + v[j].y) + (v[j].z + v[j].w); s1 += (w[j].x + w[j].y) + (w[j].z + w[j].w); }
        const float mean0 = wave_sum(s0) * (1.f / D), mean1 = wave_sum(s1) * (1.f / D); float q0 = 0.f, q1 = 0.f;
#pragma unroll
        for (int j = 0; j < 4; ++j) { v[j] = v[j] - mean0; w[j] = w[j] - mean1; q0 += (v[j].x * v[j].x + v[j].y * v[j].y) + (v[j].z * v[j].z + v[j].w * v[j].w); q1 += (w[j].x * w[j].x + w[j].y * w[j].y) + (w[j].z * w[j].z + w[j].w * w[j].w); }
        const float r0 = 1.f / sqrtf(wave_sum(q0) * (1.f / D) + NORM_EPS), r1 = 1.f / sqrtf(wave_sum(q1) * (1.f / D) + NORM_EPS);
#pragma unroll
        for (int j = 0; j < 4; ++j) { const f32x4 g4 = gg[64 * j], b4 = bb[64 * j]; v[j] = v[j] * r0 * g4 + b4; w[j] = w[j] * r1 * g4 + b4; xr0[64 * j] = (m0 >= TL) ? v[j] * DN_ALPHA : v[j]; if (has1) xr1[64 * j] = (m1 >= TL) ? w[j] * DN_ALPHA : w[j]; }
        if (next_layer >= 0) { store_mod_bf16(F, v, m0, next_layer, next_part_sh); if (has1) store_mod_bf16(F, w, m1, next_layer, next_part_sh); }
    }
}
__device__ __forceinline__ void ph_mla_norm(Frame& F) {
    const int gw = F.vcu * NWAVES + F.wave, NGW = F.G * NWAVES;
    bf16* CQ = (bf16*)(ws_(F) + WS_CQKV); bf16* Kb = (bf16*)(ws_(F) + WS_KB); const float* rope = (const float*)(ws_(F) + WS_ROPE);
    for (int m = gw; m < TT; m += NGW) {
        bf16* row = CQ + (size_t)m * CQKV_LD;
        {
            float x[8]; float ss = 0.f; const bool act = F.lane < 48;
            if (act) { unpack8(*(const GAS v4u*)(row + 8 * F.lane), x);
#pragma unroll
                for (int j = 0; j < 8; ++j) ss += x[j] * x[j]; }
            const float sc = 1.f / sqrtf(wave_sum(ss) * (1.f / 384.f) + NORM_EPS);
            if (act) {
#pragma unroll
                for (int j = 0; j < 8; ++j) x[j] = x[j] * sc * inp(F, 13)[8 * F.lane + j];
                *(GAS v4u*)(row + 8 * F.lane) = pack8(x); }
        }
        {
            float x[8]; float ss = 0.f; const bool act = F.lane < 32;
            if (act) { unpack8(*(const GAS v4u*)(row + 384 + 8 * F.lane), x);
#pragma unroll
                for (int j = 0; j < 8; ++j) ss += x[j] * x[j]; }
            const float sc = 1.f / sqrtf(wave_sum(ss) * (1.f / 256.f) + NORM_EPS);
            if (act) {
#pragma unroll
                for (int j = 0; j < 8; ++j) x[j] = x[j] * sc * inp(F, 15)[8 * F.lane + j];
                *(GAS v4u*)(row + 384 + 8 * F.lane) = pack8(x); }
        }
        {
            const bool isctx = m >= TL; const int b = isctx ? ((m - TL) >> 8) : (m >> 13), t = isctx ? ((m - TL) & 255) : (m & 8191), tk = isctx ? t : CTXL + t;
            const int h = F.lane >> 3, i0 = (F.lane & 7) * 4;
            const v2u w = *(const GAS v2u*)(row + 640 + i0);
            float x[4] = {bflo(w.x), bfhi(w.x), bflo(w.y), bfhi(w.y)}, o[4];
#pragma unroll
            for (int j = 0; j < 4; ++j) { const float p = __shfl_xor(x[j], 2); const int idx = i0 + j, a = idx >> 4, half = (idx >> 3) & 1, f = idx & 7, pos = a ? (t & 63) : (t >> 6);
                const float cs = rope[2 * (pos * 8 + f)], sn = rope[2 * (pos * 8 + f) + 1];
                o[j] = isctx ? x[j] : (half ? x[j] * cs + p * sn : x[j] * cs - p * sn); }
            v2u ow; ow.x = pk2(o[0], o[1]); ow.y = pk2(o[2], o[3]);
            *(GAS v2u*)(Kb + ((size_t)(b * 8 + h) * TQK + tk) * 96 + 64 + i0) = ow;
        }
    }
}
__device__ __forceinline__ void ph_convfix(Frame& F, int nrows, int layer) {
    const int gw = F.vcu * NWAVES + F.wave, NGW = F.G * NWAVES;
    const bf16* AB = (const bf16*)(ws_(F) + WS_AB); const bf16* GB = (const bf16*)(ws_(F) + WS_GB); bf16* HG = (bf16*)(ws_(F) + WS_HG);
    const float* cw = inp(F, 9) + (size_t)layer * 3 * FFH; const float* cb = inp(F, 10) + (size_t)layer * FFH;
    const int nedge = (nrows / 64) * 2;
    for (int er = gw; er < nedge; er += NGW) {
        const int g64 = er >> 1, which = er & 1, m = 64 * g64 + (which ? 63 : 0);
        const bool isctx = m >= TL; const int t = isctx ? ((m - TL) & 255) : (m & 8191), len = isctx ? CTXL : SEQ;
        const bool hp = t > 0, hn = t < len - 1;
        const bf16* ac_ = AB + (size_t)(g64 * 4 + (which ? 3 : 0)) * FFH;
        const bf16* ap_ = which ? AB + (size_t)(g64 * 4 + 2) * FFH : AB + (size_t)((g64 - 1) * 4 + 3) * FFH;
        const bf16* an_ = which ? AB + (size_t)((g64 + 1) * 4 + 0) * FFH : AB + (size_t)(g64 * 4 + 1) * FFH;
        const bf16* gt_ = GB + (size_t)(g64 * 2 + which) * FFH;
#pragma unroll
        for (int ci = 0; ci < 6; ++ci) { const int ch = F.lane + 64 * ci; if (ch >= FFH / 8) break;
            const int j0 = 8 * ch; float ac[8], ap[8], an[8], gt[8], o[8];
            unpack8(*(const GAS v4u*)(ac_ + j0), ac); unpack8(*(const GAS v4u*)(gt_ + j0), gt);
            if (hp) unpack8(*(const GAS v4u*)(ap_ + j0), ap); else {
#pragma unroll
                for (int j = 0; j < 8; ++j) ap[j] = 0.f; }
            if (hn) unpack8(*(const GAS v4u*)(an_ + j0), an); else {
#pragma unroll
                for (int j = 0; j < 8; ++j) an[j] = 0.f; }
#pragma unroll
            for (int j = 0; j < 8; ++j) { const float cv = cb[j0 + j] + cw[j0 + j] * ap[j] + cw[FFH + j0 + j] * ac[j] + cw[2 * FFH + j0 + j] * an[j]; o[j] = siluf_(cv) * gt[j]; }
            *(GAS v4u*)(HG + (size_t)m * FFH + j0) = pack8(o);
        }
    }
}
__device__ __forceinline__ void ph_hg_gate(Frame& F) {
    const int gw = F.vcu * NWAVES + F.wave, NGW = F.G * NWAVES;
    bf16* O = (bf16*)(ws_(F) + WS_O); const bf16* G = (const bf16*)(ws_(F) + WS_G);
    const int c0 = 16 * F.lane; float ng[16];
#pragma unroll
    for (int j = 0; j < 16; ++j) ng[j] = inp(F, 29)[(c0 + j) & 127];
    for (int m = gw; m < TL; m += NGW) {
        float o[16], g[16]; unpack8(*(const GAS v4u*)(O + (size_t)m * D + c0), o); unpack8(*(const GAS v4u*)(O + (size_t)m * D + c0 + 8), o + 8);
        unpack8(*(const GAS v4u*)(G + (size_t)m * D + c0), g); unpack8(*(const GAS v4u*)(G + (size_t)m * D + c0 + 8), g + 8);
        float ss = 0.f;
#pragma unroll
        for (int j = 0; j < 16; ++j) ss += o[j] * o[j];
        ss += __shfl_xor(ss, 1); ss += __shfl_xor(ss, 2); ss += __shfl_xor(ss, 4);
        const float sc = 1.f / sqrtf(ss * (1.f / 128.f) + NORM_EPS);
#pragma unroll
        for (int j = 0; j < 16; ++j) o[j] = o[j] * sc * ng[j] * siluf_(g[j]);
        *(GAS v4u*)(O + (size_t)m * D + c0) = pack8(o); *(GAS v4u*)(O + (size_t)m * D + c0 + 8) = pack8(o + 8);
    }
}

typedef short bf16x8_t __attribute__((ext_vector_type(8)));
typedef float f32x16 __attribute__((ext_vector_type(16)));
__device__ __forceinline__ int crow(int r, int hi) { return (r & 3) + 8 * (r >> 2) + 4 * hi; }
constexpr int NCH = TT / 64;
__device__ __forceinline__ void p0_s5_tables(Frame& F) {
    LAS unsigned char* L = F.lds + RING_OFF;
    LAS double* lam = (LAS double*)L;
    LAS float* bb = (LAS float*)(L + 1024);
    LAS float* cc = (LAS float*)(L + 1024 + 8192);
    LAS float* pw = (LAS float*)(L + 1024 + 16384);
    unsigned char* ws = ws_(F);
    for (int item = (int)blockIdx.x - 192; item >= 0 && item < 64; item += F.G) {
        const int g = item >> 1, d = item & 1;
        __syncthreads();
        if (F.tid < 64) { const int n = F.tid, pi = (d * 32 + g) * 64 + n;
            const double lre = inp(F, 17)[pi], lim = inp(F, 18)[pi], dt = exp((double)inp(F, 19)[d * 32 + g]);
            const double mag = exp(lre * dt), are = mag * cos(lim * dt), aim = mag * sin(lim * dt), den = lre * lre + lim * lim, nr = are - 1.0;
            const double fr = (nr * lre + aim * lim) / den, fi = (aim * lre - nr * lim) / den;
            lam[2 * n] = lre * dt; lam[2 * n + 1] = lim * dt;
            for (int q = 0; q < 16; ++q) { const double br = inp(F, 20)[(size_t)pi * 16 + q], bi = inp(F, 21)[(size_t)pi * 16 + q];
                bb[(n * 16 + q) * 2] = (float)(fr * br - fi * bi); bb[(n * 16 + q) * 2 + 1] = (float)(fr * bi + fi * br); } }
        for (int i = F.tid; i < 1024; i += 512) { const int p = i >> 6, n = i & 63; cc[i * 2] = inp(F, 22)[((size_t)(d * 32 + g) * 16 + p) * 64 + n]; cc[i * 2 + 1] = inp(F, 23)[((size_t)(d * 32 + g) * 16 + p) * 64 + n]; }
        __syncthreads();
        if (F.tid < 64) { const int n = F.tid; const double m1 = exp(lam[2 * n]), ar = m1 * cos(lam[2 * n + 1]), ai = m1 * sin(lam[2 * n + 1]);
            double pr = 1.0, pim = 0.0;
            for (int e = 0; e <= 64; ++e) { pw[(e * 64 + n) * 2] = (float)pr; pw[(e * 64 + n) * 2 + 1] = (float)pim; const double nr = pr * ar - pim * ai, ni = pr * ai + pim * ar; pr = nr; pim = ni; } }
        __syncthreads();
        { bf16* WF = (bf16*)(ws + WS_WF) + (size_t)g * 256 * 1024;
          for (int i = F.tid; i < 128 * 128; i += 512) { const int row = i >> 7, grp = i & 127, c = row >> 6, n = row & 63, sI = grp >> 1, q0 = (grp & 1) * 8, e = d ? sI : 63 - sI;
              const float pr = pw[(e * 64 + n) * 2], pim = pw[(e * 64 + n) * 2 + 1]; float o[8];
#pragma unroll
              for (int j = 0; j < 8; ++j) { const float br = bb[(n * 16 + q0 + j) * 2], bi = bb[(n * 16 + q0 + j) * 2 + 1]; o[j] = c ? (pr * bi + pim * br) : (pr * br - pim * bi); }
              *(GAS v4u*)(WF + (size_t)(d * 128 + row) * 1024 + sI * 16 + q0) = pack8(o); } }
        { bf16* WC = (bf16*)(ws + WS_WC) + (size_t)g * 1024 * 256;
          for (int i = F.tid; i < 1024 * 16; i += 512) { const int row = i >> 4, grp = i & 15, t = row >> 4, p = row & 15, c = grp >> 3, n0 = (grp & 7) * 8, ex = d ? 64 - t : t + 1; float o[8];
#pragma unroll
              for (int j = 0; j < 8; ++j) { const int n = n0 + j; const float pr = pw[(ex * 64 + n) * 2], pim = pw[(ex * 64 + n) * 2 + 1], cr = cc[(p * 64 + n) * 2], ci = cc[(p * 64 + n) * 2 + 1];
                  o[j] = c ? -(cr * pim + ci * pr) : (cr * pr - ci * pim); }
              *(GAS v4u*)(WC + (size_t)row * 256 + d * 128 + c * 64 + n0) = pack8(o); } }
        { bf16* TP = (bf16*)(ws + WS_TOEP) + (size_t)g * 127 * 256; float* T0 = (float*)(ws + WS_T0) + (size_t)(g * 2 + d) * 256;
          for (int i = F.tid; i < 64 * 16; i += 512) { const int tau = i >> 4, p = i & 15; float acc[16];
#pragma unroll
              for (int q = 0; q < 16; ++q) acc[q] = 0.f;
              for (int n = 0; n < 64; ++n) { const float pr = pw[(tau * 64 + n) * 2], pim = pw[(tau * 64 + n) * 2 + 1], cr = cc[(p * 64 + n) * 2], ci = cc[(p * 64 + n) * 2 + 1];
                  const float tr = cr * pr - ci * pim, ti = cr * pim + ci * pr;
                  const LAS f32x4* bq = (const LAS f32x4*)(bb + n * 32);
#pragma unroll
                  for (int q4 = 0; q4 < 8; ++q4) { const f32x4 v = bq[q4]; acc[2 * q4] += tr * v.x - ti * v.y; acc[2 * q4 + 1] += tr * v.z - ti * v.w; } }
              if (tau == 0) {
#pragma unroll
                  for (int q = 0; q < 16; ++q) T0[p * 16 + q] = acc[q]; }
              else { bf16* o = TP + (size_t)(d ? 63 - tau : 63 + tau) * 256 + p * 16; *(GAS v4u*)o = pack8(acc); *(GAS v4u*)(o + 8) = pack8(acc + 8); } } }
        if (F.tid < 64) { float* A64 = (float*)(ws + WS_A64) + (size_t)((g * 2 + d) * 64 + F.tid) * 2; A64[0] = pw[(64 * 64 + F.tid) * 2]; A64[1] = pw[(64 * 64 + F.tid) * 2 + 1]; }
    }
    __syncthreads();
}
__device__ __forceinline__ void ph_s5_finals(Frame& F) {
    const int lane = F.lane, r32 = lane & 31, hh = lane >> 5, wave = F.wave;
    unsigned char* ws = ws_(F);
    for (int u = blockIdx.x; u < 288; u += F.G) {
        const int g = u / 9, nb = u % 9; int chunk = nb * 32 + r32; const bool valid = chunk < NCH; if (!valid) chunk = NCH - 1;
        const bf16* ub = (const bf16*)(ws + WS_UG) + ((size_t)g * TT + (size_t)chunk * 64) * 16 + 8 * hh;
        const bf16* wf = (const bf16*)(ws + WS_WF) + ((size_t)(g * 256 + 32 * wave + r32)) * 1024 + 8 * hh;
        f32x16 acc;
#pragma unroll
        for (int r = 0; r < 16; ++r) acc[r] = 0.f;
#pragma unroll 16
        for (int sI = 0; sI < 64; ++sI) { const bf16x8_t a = *(const GAS bf16x8_t*)(wf + 16 * sI), b = *(const GAS bf16x8_t*)(ub + 16 * sI); acc = __builtin_amdgcn_mfma_f32_32x32x16_bf16(a, b, acc, 0, 0, 0); }
        if (valid) { float* fo = (float*)(ws + WS_FIN) + ((size_t)g * NCH + chunk) * 256 + 32 * wave + 4 * hh;
#pragma unroll
            for (int k = 0; k < 4; ++k) *(GAS f32x4*)(fo + 8 * k) = (f32x4){acc[4 * k], acc[4 * k + 1], acc[4 * k + 2], acc[4 * k + 3]}; }
    }
}
__device__ __forceinline__ int s5_chunk_of(int step, int d, int b) { return step < 4 ? 256 + 4 * b + (d ? 3 - step : step) : 128 * b + (d ? 127 - (step - 4) : step - 4); }
__device__ __forceinline__ void ph_s5_carry(Frame& F) {
    if (F.wave >= 3) return;
    unsigned char* ws = ws_(F);
    for (int item = ((int)F.G - 1 - (int)blockIdx.x) * 3 + F.wave; item < 128; item += 3 * F.G) {
        const int g = item >> 2, d = (item >> 1) & 1, b = item & 1, n = F.lane;
        const float a_r = ((const float*)(ws + WS_A64))[((g * 2 + d) * 64 + n) * 2], a_i = ((const float*)(ws + WS_A64))[((g * 2 + d) * 64 + n) * 2 + 1];
        const float* Fb = (const float*)(ws + WS_FIN) + (size_t)g * NCH * 256 + d * 128 + n; bf16* Sb = (bf16*)(ws + WS_SIN) + (size_t)g * NCH * 256 + d * 128 + n;
        float sr = 0.f, si = 0.f;
        for (int s0 = 0; s0 < 132; s0 += 12) {
            float fr[12], fi[12];
#pragma unroll
            for (int j = 0; j < 12; ++j) { const int c = s5_chunk_of(s0 + j, d, b); fr[j] = Fb[(size_t)c * 256]; fi[j] = Fb[(size_t)c * 256 + 64]; }
#pragma unroll
            for (int j = 0; j < 12; ++j) { const int c = s5_chunk_of(s0 + j, d, b); Sb[(size_t)c * 256] = (bf16)f2bf(sr); Sb[(size_t)c * 256 + 64] = (bf16)f2bf(si);
                const float nr = a_r * sr - a_i * si + fr[j], ni = a_r * si + a_i * sr + fi[j]; sr = nr; si = ni; }
        }
    }
}
constexpr int TP_PITCH = 48;
__device__ __forceinline__ void ph_s5_out(Frame& F) {
    LAS unsigned char* L = F.lds + RING_OFF;
    const int lane = F.lane, r32 = lane & 31, hh = lane >> 5, wave = F.wave, tid = F.tid;
    unsigned char* ws = ws_(F);
    for (int u = blockIdx.x; u < 288; u += F.G) {
        const int g = u / 9, nb = u % 9; int chunk = nb * 32 + r32; const bool valid = chunk < NCH; if (!valid) chunk = NCH - 1;
        __syncthreads();
        { const GAS v4u* tp = (const GAS v4u*)((const bf16*)(ws + WS_TOEP) + (size_t)g * 127 * 256); const float* t0 = (const float*)(ws + WS_T0) + (size_t)g * 512;
          for (int c = tid; c < 127 * 32; c += 512) { const int di = c >> 5, p = (c >> 1) & 15, half = c & 1; v4u v;
              if (di == 63) { float o[8];
#pragma unroll
                  for (int j = 0; j < 8; ++j) o[j] = t0[p * 16 + half * 8 + j] + t0[256 + p * 16 + half * 8 + j];
                  v = pack8(o); }
              else v = tp[c];
              *(LAS v4u*)(L + (di * 16 + p) * TP_PITCH + half * 16) = v; } }
        __syncthreads();
        const bf16* ub = (const bf16*)(ws + WS_UG) + ((size_t)g * TT + (size_t)chunk * 64) * 16 + 8 * hh;
        f32x16 acc[4];
#pragma unroll
        for (int i = 0; i < 4; ++i)
#pragma unroll
            for (int r = 0; r < 16; ++r) acc[i][r] = 0.f;
        const LAS unsigned char* tl = L + ((63 + 2 * wave + (r32 >> 4)) * 16 + (r32 & 15)) * TP_PITCH + hh * 16;
#pragma unroll 1
        for (int s0 = 0; s0 < 64; s0 += 16) {
            bf16x8_t bq[16];
#pragma unroll
            for (int e = 0; e < 16; ++e) bq[e] = *(const GAS bf16x8_t*)(ub + 16 * (s0 + e));
#pragma unroll
            for (int e = 0; e < 16; ++e) { const int sI = s0 + e; const bf16x8_t b = bq[e];
#pragma unroll
            for (int i = 0; i < 4; ++i) { const bf16x8_t a = *(const LAS bf16x8_t*)(tl + (16 * i - sI) * 16 * TP_PITCH); acc[i] = __builtin_amdgcn_mfma_f32_32x32x16_bf16(a, b, acc[i], 0, 0, 0); }
            }
        }
        { const bf16* sb = (const bf16*)(ws + WS_SIN) + ((size_t)g * NCH + chunk) * 256 + 8 * hh;
          const bf16* wc = (const bf16*)(ws + WS_WC) + ((size_t)g * 1024 + 32 * wave + r32) * 256 + 8 * hh;
#pragma unroll 4
          for (int kk = 0; kk < 16; ++kk) {
              const bf16x8_t b = *(const GAS bf16x8_t*)(sb + 16 * kk);
#pragma unroll
              for (int i = 0; i < 4; ++i) { const bf16x8_t a = *(const GAS bf16x8_t*)(wc + (size_t)(256 * i) * 256 + 16 * kk); acc[i] = __builtin_amdgcn_mfma_f32_32x32x16_bf16(a, b, acc[i], 0, 0, 0); }
          } }
        if (valid) {
            const float* dsk = inp(F, 24) + 16 * g;
#pragma unroll
            for (int i = 0; i < 4; ++i)
#pragma unroll
                for (int k = 0; k < 4; ++k) { const int tloc = 2 * (wave + 8 * i) + (k >> 1), p0 = 8 * (k & 1) + 4 * hh; const size_t m = (size_t)chunk * 64 + tloc;
                    const v2u uw = *(const GAS v2u*)((const bf16*)(ws + WS_UG) + ((size_t)g * TT + m) * 16 + p0);
                    const float y0 = gelu_tanh(acc[i][4 * k] + dsk[p0] * bflo(uw.x)), y1 = gelu_tanh(acc[i][4 * k + 1] + dsk[p0 + 1] * bfhi(uw.x));
                    const float y2 = gelu_tanh(acc[i][4 * k + 2] + dsk[p0 + 2] * bflo(uw.y)), y3 = gelu_tanh(acc[i][4 * k + 3] + dsk[p0 + 3] * bfhi(uw.y));
                    v2u zw; zw.x = pk2(y0, y1); zw.y = pk2(y2, y3);
                    *(GAS v2u*)((bf16*)(ws + WS_Z) + m * 512 + 16 * g + p0) = zw; }
        }
    }
}

__device__ __forceinline__ bf16x8_t pack_frag(const f32x16& p, int base) {
    v4u w; w.x = pg8::cvt_pk_bf16(p[base + 0], p[base + 1]); w.y = pg8::cvt_pk_bf16(p[base + 2], p[base + 3]); w.z = pg8::cvt_pk_bf16(p[base + 4], p[base + 5]); w.w = pg8::cvt_pk_bf16(p[base + 6], p[base + 7]);
    return __builtin_bit_cast(bf16x8_t, w);
}
constexpr int AT_KP = 208, AT_VP = 272;
constexpr int AT_KB = 128 * AT_KP, AT_VB = 64 * AT_VP;
constexpr int AT_K0 = 0, AT_V0 = 2 * AT_KB, AT_WS = 2 * AT_KB + 2 * AT_VB;
__device__ __forceinline__ void ph_attn(Frame& F) {
    LAS unsigned char* L = F.lds + RING_OFF;
    const int lane = F.lane, r32 = lane & 31, hi = lane >> 5, wave = F.wave, tid = F.tid;
    volatile LAS float* wsf = (volatile LAS float*)(L + AT_WS) + wave * 32;
    const bf16* Qb = (const bf16*)(ws_(F) + WS_QB); const bf16* Kb = (const bf16*)(ws_(F) + WS_KB); const bf16* Vt = (const bf16*)(ws_(F) + WS_VB);
    bf16* MIX = (bf16*)(ws_(F) + WS_MIX);
    int kl[3], vl[2];
#pragma unroll
    for (int i = 0; i < 3; ++i) { const int c = tid + 512 * i; kl[i] = (c / 12) * AT_KP + (c % 12) * 16; }
#pragma unroll
    for (int i = 0; i < 2; ++i) { const int c = tid + 512 * i; vl[i] = ((c & 511) >> 3) * AT_VP + (c >> 9) * 128 + (c & 7) * 16; }
    for (int it = 0; it < 3; ++it) {
        int u; if (it < 2) u = it * 256 + F.vcu; else { if (F.vcu >= 16) break; u = 512 + F.vcu; }
        int b, h, tq0, NT, m0;
        if (u < 512) { b = u >> 8; h = (u >> 5) & 7; tq0 = (u & 31) * 256; NT = TQK / 128; m0 = b * SEQ + tq0; }
        else { const int uc = u - 512; b = uc >> 3; h = uc & 7; tq0 = SEQ; NT = CTXL / 128; m0 = TL + b * CTXL; }
        const size_t bh = (size_t)(b * 8 + h);
        const GAS v4u* Kg = (const GAS v4u*)(Kb + bh * TQK * 96);
        const GAS v4u* Vg = (const GAS v4u*)(Vt + bh * (TQK / 64) * 4096);
        bf16x8_t qf[6];
        { const bf16* qp = Qb + (bh * TQK + tq0 + wave * 32 + r32) * 96 + hi * 8;
#pragma unroll
          for (int ks = 0; ks < 6; ++ks) qf[ks] = *(const GAS bf16x8_t*)(qp + ks * 16); }
        f32x16 o0, o1;
#pragma unroll
        for (int r = 0; r < 16; ++r) { o0[r] = 0.f; o1[r] = 0.f; }
        float m_run = -1e30f, l_run = 0.f;
        __syncthreads();
        { v4u a[3], v[2];
#pragma unroll
          for (int i = 0; i < 3; ++i) a[i] = Kg[tid + 512 * i];
#pragma unroll
          for (int i = 0; i < 2; ++i) v[i] = Vg[tid + 512 * i];
#pragma unroll
          for (int i = 0; i < 3; ++i) *(LAS v4u*)(L + AT_K0 + kl[i]) = a[i];
#pragma unroll
          for (int i = 0; i < 2; ++i) *(LAS v4u*)(L + AT_V0 + vl[i]) = v[i]; }
        __syncthreads();
        for (int t = 0; t < NT; ++t) {
            const int cur = t & 1, nxt = cur ^ 1; const bool more = (t + 1 < NT);
            v4u na[3], nv[2];
#pragma unroll
            for (int i = 0; i < 3; ++i) na[i] = (v4u){0u, 0u, 0u, 0u};
#pragma unroll
            for (int i = 0; i < 2; ++i) nv[i] = (v4u){0u, 0u, 0u, 0u};
            if (more) {
#pragma unroll
                for (int i = 0; i < 3; ++i) na[i] = Kg[(size_t)(t + 1) * 1536 + tid + 512 * i];
#pragma unroll
                for (int i = 0; i < 2; ++i) nv[i] = Vg[(size_t)(t + 1) * 1024 + tid + 512 * i]; }
            const LAS unsigned char* Kl = L + AT_K0 + cur * AT_KB + r32 * AT_KP + hi * 16;
            const LAS unsigned char* Vl = L + AT_V0 + cur * AT_VB + r32 * AT_VP + hi * 16;
            f32x16 p[4];
#pragma unroll
            for (int kb = 0; kb < 4; ++kb) {
#pragma unroll
                for (int r = 0; r < 16; ++r) p[kb][r] = 0.f;
#pragma unroll
                for (int ks = 0; ks < 6; ++ks) p[kb] = __builtin_amdgcn_mfma_f32_32x32x16_bf16(*(const LAS bf16x8_t*)(Kl + kb * 32 * AT_KP + ks * 32), qf[ks], p[kb], 0, 0, 0);
            }
            float mt = fmaxf(fmaxf(p[0][0], p[1][0]), fmaxf(p[2][0], p[3][0]));
#pragma unroll
            for (int r = 1; r < 16; ++r) mt = fmaxf(mt, fmaxf(fmaxf(p[0][r], p[1][r]), fmaxf(p[2][r], p[3][r])));
            mt = fmaxf(mt, __shfl_xor(mt, 32));
            const bool need = mt > m_run + 8.0f;
            if (__any(need)) {
                const float mn = need ? mt : m_run, alpha = __builtin_amdgcn_exp2f(m_run - mn);
                l_run *= alpha; m_run = mn;
                if (hi == 0) wsf[r32] = alpha;
#pragma unroll
                for (int r = 0; r < 16; ++r) { const float a = wsf[crow(r, hi)]; o0[r] *= a; o1[r] *= a; }
            }
            float sum = 0.f;
#pragma unroll
            for (int kb = 0; kb < 4; ++kb)
#pragma unroll
                for (int r = 0; r < 16; ++r) { p[kb][r] = __builtin_amdgcn_exp2f(p[kb][r] - m_run); sum += p[kb][r]; }
            l_run += sum;
#pragma unroll
            for (int kb = 0; kb < 4; ++kb) {
                const bf16x8_t pa = pack_frag(p[kb], 0), pb = pack_frag(p[kb], 8);
                const LAS unsigned char* vp = Vl + (kb >> 1) * 128 + (kb & 1) * 64;
                o0 = __builtin_amdgcn_mfma_f32_32x32x16_bf16(pa, *(const LAS bf16x8_t*)(vp), o0, 0, 0, 0);
                o0 = __builtin_amdgcn_mfma_f32_32x32x16_bf16(pb, *(const LAS bf16x8_t*)(vp + 32), o0, 0, 0, 0);
                o1 = __builtin_amdgcn_mfma_f32_32x32x16_bf16(pa, *(const LAS bf16x8_t*)(vp + 32 * AT_VP), o1, 0, 0, 0);
                o1 = __builtin_amdgcn_mfma_f32_32x32x16_bf16(pb, *(const LAS bf16x8_t*)(vp + 32 * AT_VP + 32), o1, 0, 0, 0);
            }
            if (more) {
#pragma unroll
                for (int i = 0; i < 3; ++i) *(LAS v4u*)(L + AT_K0 + nxt * AT_KB + kl[i]) = na[i];
#pragma unroll
                for (int i = 0; i < 2; ++i) *(LAS v4u*)(L + AT_V0 + nxt * AT_VB + vl[i]) = nv[i]; }
            __syncthreads();
        }
        l_run += __shfl_xor(l_run, 32);
        if (hi == 0) wsf[r32] = 1.0f / l_run;
#pragma unroll
        for (int r = 0; r < 16; ++r) { const int q = crow(r, hi); const float inv = wsf[q];
            bf16* op = MIX + (size_t)(m0 + wave * 32 + q) * D + h * 64 + r32;
            op[0] = (bf16)f2bf(o0[r] * inv); op[32] = (bf16)f2bf(o1[r] * inv); }
    }
}

constexpr int HG_QT = 0, HG_KT = 17408, HG_KH = 34816, HG_VT = 53248, HG_ST = 71680, HG_DEC = 106496, HG_TOT = 107008;
constexpr int HG_NSC = 17;
constexpr size_t WS_SD = 231 * MiB;
constexpr size_t WS_DECS = WS_SD + 18 * MiB;
static_assert(WS_DECS + 32 * 17 * 128 * 4 <= WS_END, "hgrn ws");
template <bool OUT>
__device__ __forceinline__ void hgrn_pass(Frame& F, int b, int h, int dir, int sc, f32x16 (&st)[2], float& dsum) {
    LAS unsigned char* L = F.lds + RING_OFF;
    unsigned char* ws = ws_(F);
    const int tid = F.tid, lane = F.lane, r32 = lane & 31, hh = lane >> 5, wave = F.wave;
    const int k = tid & 127, tg = tid >> 7;
    const int nch = sc == 0 ? 4 : 8; const size_t rowbase = sc == 0 ? (size_t)TL + b * CTXL : (size_t)b * SEQ + (size_t)(sc - 1) * 512;
    const bf16* QF = (const bf16*)(ws + WS_QFFI);
    const float lb = ((const float*)(ws + WS_LBV))[dir * 1024 + h * 128 + k];
    const int colf = 1024 * (1 + dir) + h * 128 + k, colq = h * 128 + k, colv = 3072 + h * 128 + k;
    const int dvb = wave & 3, jb = wave >> 2;
    bf16 rq[16], rf[16], rv[16];
#define HG_LOAD(ci) do { const int cc_ = dir ? nch - 1 - (ci) : (ci); const int tl0_ = dir ? 63 - 16 * tg : 16 * tg; \
        const bf16* pf_ = QF + (rowbase + 64 * cc_ + tl0_) * 4096 + colf; const bf16* pv_ = pf_ + (colv - colf); const bf16* pq_ = pf_ + (colq - colf); const long stp_ = dir ? -4096 : 4096; \
        _Pragma("unroll") for (int jj = 0; jj < 16; ++jj) { rf[jj] = *pf_; rv[jj] = *pv_; if (OUT) rq[jj] = *pq_; pf_ += stp_; pv_ += stp_; pq_ += stp_; asm volatile("" : "+v"(pf_), "+v"(pv_), "+v"(pq_)); } } while (0)
    HG_LOAD(0);
    for (int ci = 0; ci < nch; ++ci) {
        const int cc = dir ? nch - 1 - ci : ci;
        float cum[16], kk[16];
        { float run = 0.f;
#pragma unroll
          for (int jj = 0; jj < 16; ++jj) { const float f = lb + (1.f - lb) * sigmoidf_(bf2f(rf[jj])); run += __log2f(f); cum[jj] = run; kk[jj] = 1.f - f; }
          ((LAS float*)(L + HG_TOT))[tg * 128 + k] = run; }
        __syncthreads();
        { const LAS float* tot = (const LAS float*)(L + HG_TOT) + k; const float t0 = tot[0], t1 = tot[128], t2 = tot[256], t3 = tot[384];
          const float pre = tg == 0 ? 0.f : (tg == 1 ? t0 : (tg == 2 ? t0 + t1 : t0 + t1 + t2)), total = (t0 + t1) + (t2 + t3);
          if (tg == 0) { ((LAS float*)(L + HG_DEC))[k] = __builtin_amdgcn_exp2f(total); dsum += total; }
#define HG_KH(jj) (kk[jj] * __builtin_amdgcn_exp2f(total - (pre + cum[jj])))
#define HG_PKV(a, b_) ((unsigned)rv[a] | ((unsigned)rv[b_] << 16))
          if (OUT) {
#pragma unroll
              for (int jj = 0; jj < 16; ++jj) { const float c = pre + cum[jj]; const int j = 16 * tg + jj;
                  *(LAS bf16*)(L + HG_QT + j * 272 + k * 2) = (bf16)f2bf(bf2f(rq[jj]) * __builtin_amdgcn_exp2f(c)); *(LAS bf16*)(L + HG_KT + j * 272 + k * 2) = (bf16)f2bf(kk[jj] * __builtin_amdgcn_exp2f(-c)); } }
          v4u w0, w1;
          w0.x = pk2(HG_KH(0), HG_KH(1)); w0.y = pk2(HG_KH(2), HG_KH(3)); w0.z = pk2(HG_KH(8), HG_KH(9)); w0.w = pk2(HG_KH(10), HG_KH(11));
          w1.x = pk2(HG_KH(4), HG_KH(5)); w1.y = pk2(HG_KH(6), HG_KH(7)); w1.z = pk2(HG_KH(12), HG_KH(13)); w1.w = pk2(HG_KH(14), HG_KH(15));
          *(LAS v4u*)(L + HG_KH + k * 144 + tg * 32) = w0; *(LAS v4u*)(L + HG_KH + k * 144 + tg * 32 + 16) = w1;
          w0.x = HG_PKV(0, 1); w0.y = HG_PKV(2, 3); w0.z = HG_PKV(8, 9); w0.w = HG_PKV(10, 11);
          w1.x = HG_PKV(4, 5); w1.y = HG_PKV(6, 7); w1.z = HG_PKV(12, 13); w1.w = HG_PKV(14, 15);
          *(LAS v4u*)(L + HG_VT + k * 144 + tg * 32) = w0; *(LAS v4u*)(L + HG_VT + k * 144 + tg * 32 + 16) = w1; }
#undef HG_KH
#undef HG_PKV
        if (ci + 1 < nch) HG_LOAD(ci + 1);
        __syncthreads();
        if (OUT) {
            f32x16 oacc;
#pragma unroll
            for (int r = 0; r < 16; ++r) oacc[r] = 0.f;
            const LAS unsigned char* qrow = L + HG_QT + (32 * jb + r32) * 272 + hh * 16;
            const LAS unsigned char* srow = L + HG_ST + (32 * dvb + r32) * 272 + hh * 16;
            const LAS unsigned char* vrow = L + HG_VT + (32 * dvb + r32) * 144 + hh * 16;
#pragma unroll
            for (int ks = 0; ks < 8; ++ks) oacc = __builtin_amdgcn_mfma_f32_32x32x16_bf16(*(const LAS bf16x8_t*)(qrow + ks * 32), *(const LAS bf16x8_t*)(srow + ks * 32), oacc, 0, 0, 0);
            {
                f32x16 at;
#pragma unroll
                for (int r = 0; r < 16; ++r) at[r] = 0.f;
                const LAS unsigned char* krow = L + HG_KT + r32 * 272 + hh * 16;
#pragma unroll
                for (int ks = 0; ks < 8; ++ks) at = __builtin_amdgcn_mfma_f32_32x32x16_bf16(*(const LAS bf16x8_t*)(krow + ks * 32), *(const LAS bf16x8_t*)(qrow + ks * 32), at, 0, 0, 0);
                if (jb == 0) {
#pragma unroll
                    for (int r = 0; r < 16; ++r) if (crow(r, hh) > r32) at[r] = 0.f; }
                oacc = __builtin_amdgcn_mfma_f32_32x32x16_bf16(pack_frag(at, 0), *(const LAS bf16x8_t*)(vrow + 0), oacc, 0, 0, 0);
                oacc = __builtin_amdgcn_mfma_f32_32x32x16_bf16(pack_frag(at, 8), *(const LAS bf16x8_t*)(vrow + 32), oacc, 0, 0, 0);
            }
            if (jb == 1) {
                f32x16 at;
#pragma unroll
                for (int r = 0; r < 16; ++r) at[r] = 0.f;
                const LAS unsigned char* krow = L + HG_KT + (32 + r32) * 272 + hh * 16;
#pragma unroll
                for (int ks = 0; ks < 8; ++ks) at = __builtin_amdgcn_mfma_f32_32x32x16_bf16(*(const LAS bf16x8_t*)(krow + ks * 32), *(const LAS bf16x8_t*)(qrow + ks * 32), at, 0, 0, 0);
#pragma unroll
                for (int r = 0; r < 16; ++r) if (crow(r, hh) > r32) at[r] = 0.f;
                oacc = __builtin_amdgcn_mfma_f32_32x32x16_bf16(pack_frag(at, 0), *(const LAS bf16x8_t*)(vrow + 64), oacc, 0, 0, 0);
                oacc = __builtin_amdgcn_mfma_f32_32x32x16_bf16(pack_frag(at, 8), *(const LAS bf16x8_t*)(vrow + 96), oacc, 0, 0, 0);
            }
            bf16* O = (bf16*)(ws + WS_O);
#pragma unroll
            for (int r = 0; r < 16; ++r) { const int j = 32 * jb + crow(r, hh), tl = dir ? 63 - j : j;
                bf16* op = O + (rowbase + 64 * cc + tl) * D + h * 128 + 32 * dvb + r32; float ov = oacc[r];
                if (dir) ov += bf2f(*op);
                *op = (bf16)f2bf(ov); }
        }
#pragma unroll
        for (int t = 0; t < 2; ++t) { const int dkb = 2 * (wave >> 2) + t;
#pragma unroll
            for (int q4 = 0; q4 < 4; ++q4) { const f32x4 dd = *(const LAS f32x4*)(L + HG_DEC + (32 * dkb + 8 * q4 + 4 * hh) * 4);
                st[t][4 * q4] *= dd[0]; st[t][4 * q4 + 1] *= dd[1]; st[t][4 * q4 + 2] *= dd[2]; st[t][4 * q4 + 3] *= dd[3]; }
            const LAS unsigned char* arow = L + HG_KH + (32 * dkb + r32) * 144 + hh * 16; const LAS unsigned char* vrow = L + HG_VT + (32 * dvb + r32) * 144 + hh * 16;
#pragma unroll
            for (int ks = 0; ks < 4; ++ks) st[t] = __builtin_amdgcn_mfma_f32_32x32x16_bf16(*(const LAS bf16x8_t*)(arow + ks * 32), *(const LAS bf16x8_t*)(vrow + ks * 32), st[t], 0, 0, 0); }
        __syncthreads();
        if (OUT && ci + 1 < nch) {
#pragma unroll
            for (int t = 0; t < 2; ++t) { const int dkb = 2 * (wave >> 2) + t;
#pragma unroll
                for (int q4 = 0; q4 < 4; ++q4) { v2u w; w.x = pk2(st[t][4 * q4], st[t][4 * q4 + 1]); w.y = pk2(st[t][4 * q4 + 2], st[t][4 * q4 + 3]);
                    *(LAS v2u*)(L + HG_ST + (32 * dvb + r32) * 272 + (32 * dkb + 8 * q4 + 4 * hh) * 2) = w; } }
        }
    }
#undef HG_LOAD
}
__device__ __forceinline__ void ph_hgrn_states(Frame& F) {
    unsigned char* ws = ws_(F);
    for (int item = blockIdx.x; item < 32 * HG_NSC; item += F.G) {
        const int chain = item / HG_NSC, sc = item % HG_NSC, b = chain >> 4, h = (chain >> 1) & 7, dir = chain & 1;
        f32x16 st[2];
#pragma unroll
        for (int t = 0; t < 2; ++t)
#pragma unroll
            for (int r = 0; r < 16; ++r) st[t][r] = 0.f;
        float dsum = 0.f;
        hgrn_pass<false>(F, b, h, dir, sc, st, dsum);
        bf16* sd = (bf16*)(ws + WS_SD) + ((size_t)(chain * HG_NSC + sc) * 8 + F.wave) * 2048 + F.lane;
#pragma unroll
        for (int t = 0; t < 2; ++t)
#pragma unroll
            for (int r = 0; r < 16; ++r) sd[(t * 16 + r) * 64] = (bf16)f2bf(st[t][r]);
        if (F.tid < 128) ((float*)(ws + WS_DECS))[(size_t)(chain * HG_NSC + sc) * 128 + F.tid] = dsum;
    }
}
__device__ __forceinline__ void ph_hgrn_out(Frame& F) {
    LAS unsigned char* L = F.lds + RING_OFF;
    unsigned char* ws = ws_(F);
    const int lane = F.lane, r32 = lane & 31, hh = lane >> 5, wave = F.wave, dvb = wave & 3;
    for (int item = blockIdx.x; item < 256; item += F.G) {
        const int b = item >> 7, h = (item >> 4) & 7, Lsc = item & 15, sc = Lsc + 1;
        for (int dir = 0; dir < 2; ++dir) {
            const int chain = (b * 8 + h) * 2 + dir;
            f32x16 st[2];
#pragma unroll
            for (int t = 0; t < 2; ++t)
#pragma unroll
                for (int r = 0; r < 16; ++r) st[t][r] = 0.f;
            const int npre = dir ? 1 + (16 - sc) : sc;
            for (int i = 0; i < npre; ++i) {
                const int sp = (i == 0) ? 0 : (dir ? 17 - i : i);
                const bf16* sd = (const bf16*)(ws + WS_SD) + ((size_t)(chain * HG_NSC + sp) * 8 + wave) * 2048 + lane;
                const float* dl = (const float*)(ws + WS_DECS) + (size_t)(chain * HG_NSC + sp) * 128;
#pragma unroll
                for (int t = 0; t < 2; ++t) { const int dkb = 2 * (wave >> 2) + t;
#pragma unroll
                    for (int q4 = 0; q4 < 4; ++q4) { const f32x4 dd = *(const GAS f32x4*)(dl + 32 * dkb + 8 * q4 + 4 * hh);
#pragma unroll
                        for (int e = 0; e < 4; ++e) st[t][4 * q4 + e] = __builtin_amdgcn_exp2f(dd[e]) * st[t][4 * q4 + e] + bf2f(sd[(t * 16 + 4 * q4 + e) * 64]); } }
            }
            __syncthreads();
#pragma unroll
            for (int t = 0; t < 2; ++t) { const int dkb = 2 * (wave >> 2) + t;
#pragma unroll
                for (int q4 = 0; q4 < 4; ++q4) { v2u w; w.x = pk2(st[t][4 * q4], st[t][4 * q4 + 1]); w.y = pk2(st[t][4 * q4 + 2], st[t][4 * q4 + 3]);
                    *(LAS v2u*)(L + HG_ST + (32 * dvb + r32) * 272 + (32 * dkb + 8 * q4 + 4 * hh) * 2) = w; } }
            float dsum = 0.f;
            hgrn_pass<true>(F, b, h, dir, sc, st, dsum);
            __syncthreads();
        }
    }
}

struct FInProj {
    bf16* cqkv; bf16* ug;
    __device__ __forceinline__ void operator()(int row, int col, f32x4 v0, f32x4 v1) const {
        v4u w; w.x = pg8::cvt_pk_bf16(v0[0], v0[1]); w.y = pg8::cvt_pk_bf16(v0[2], v0[3]); w.z = pg8::cvt_pk_bf16(v1[0], v1[1]); w.w = pg8::cvt_pk_bf16(v1[2], v1[3]);
        if (col < 672) *(GAS v4u*)(cqkv + (size_t)row * CQKV_LD + col) = w;
        else if (col < EVEN_IN) { const int c = col - 672; *(GAS v4u*)(ug + ((size_t)(c >> 4) * TT + row) * 16 + (c & 15)) = w; }
    }
};
struct FBf16 {
    bf16* o; int ld;
    __device__ __forceinline__ void operator()(int row, int col, f32x4 v0, f32x4 v1) const {
        v4u w; w.x = pg8::cvt_pk_bf16(v0[0], v0[1]); w.y = pg8::cvt_pk_bf16(v0[2], v0[3]); w.z = pg8::cvt_pk_bf16(v1[0], v1[1]); w.w = pg8::cvt_pk_bf16(v1[2], v1[3]);
        *(GAS v4u*)(o + (size_t)row * ld + col) = w;
    }
};
struct FGlu {
    const bf16* z; bf16* mix;
    __device__ __forceinline__ void operator()(int row, int col, f32x4 v0, f32x4 v1) const {
        float zz[8]; unpack8(*(const GAS v4u*)(z + (size_t)row * 512 + col), zz);
        float o[8];
#pragma unroll
        for (int j = 0; j < 4; ++j) { o[j] = zz[j] * sigmoidf_(v0[j]); o[4 + j] = zz[4 + j] * sigmoidf_(v1[j]); }
        *(GAS v4u*)(mix + (size_t)row * D + 512 + col) = pack8(o);
    }
};
struct FQ {
    bf16* qb; const float* rope;
    __device__ __forceinline__ void operator()(int row, int col, f32x4 v0, f32x4 v1) const {
        float x[8] = {v0[0], v0[1], v0[2], v0[3], v1[0], v1[1], v1[2], v1[3]}, p[8];
#pragma unroll
        for (int j = 0; j < 8; ++j) p[j] = __shfl_xor(x[j], 16);
        const bool isctx = row >= TL; const int b = isctx ? ((row - TL) >> 8) : (row >> 13), t = isctx ? ((row - TL) & 255) : (row & 8191), tq = isctx ? SEQ + t : t;
        const int h = col / 96, d = col - h * 96;
        if (d >= 64 && !isctx) { const int idx = d - 64, a = idx >> 4, half = (idx >> 3) & 1, pos = a ? (t & 63) : (t >> 6);
#pragma unroll
            for (int f = 0; f < 8; ++f) { const float cs = rope[2 * (pos * 8 + f)], sn = rope[2 * (pos * 8 + f) + 1]; x[f] = half ? x[f] * cs + p[f] * sn : x[f] * cs - p[f] * sn; } }
#pragma unroll
        for (int j = 0; j < 8; ++j) x[j] *= QSCALE;
        *(GAS v4u*)(qb + ((size_t)(b * 8 + h) * TQK + tq) * 96 + d) = pack8(x);
        asm volatile("" ::: "memory");
    }
};
struct FKV {
    bf16* kb; bf16* vb;
    __device__ __forceinline__ void operator()(int row, int col, f32x4 v0, f32x4 v1) const {
        v4u w; w.x = pg8::cvt_pk_bf16(v0[0], v0[1]); w.y = pg8::cvt_pk_bf16(v0[2], v0[3]); w.z = pg8::cvt_pk_bf16(v1[0], v1[1]); w.w = pg8::cvt_pk_bf16(v1[2], v1[3]);
        const bool isctx = row >= TL; const int b = isctx ? ((row - TL) >> 8) : (row >> 13), t = isctx ? ((row - TL) & 255) : (row & 8191), tk = isctx ? t : CTXL + t;
        const int h = col >> 7, e = col & 127;
        if (e < 64) *(GAS v4u*)(kb + ((size_t)(b * 8 + h) * TQK + tk) * 96 + e) = w;
        else { const int kk = tk & 63, pos = (kk & 48) | (kk & 3) | ((kk & 4) << 1) | ((kk & 8) >> 1);
            bf16* p = vb + (((size_t)(b * 8 + h) * (TQK / 64) + (tk >> 6)) * 64 + (e - 64)) * 64 + pos;
            p[0] = (bf16)(w.x & 0xffffu); p[64] = (bf16)(w.x >> 16); p[128] = (bf16)(w.y & 0xffffu); p[192] = (bf16)(w.y >> 16);
            p[256] = (bf16)(w.z & 0xffffu); p[320] = (bf16)(w.z >> 16); p[384] = (bf16)(w.w & 0xffffu); p[448] = (bf16)(w.w >> 16); }
    }
};
struct FResid {
    float* xl; float* xc; const float* gate;
    int first; int row_off;
    __device__ __forceinline__ void operator()(int row_, int col, f32x4 v) const {
        const int row = row_ + row_off;
        const f32x4 gv = *(const GAS f32x4*)(gate + (size_t)modrow_of(row) * 6144 + col);
        if (row < TL) { float* xp = xl + (size_t)row * D + col; const f32x4 xo = *(const GAS f32x4*)xp; *(GAS f32x4*)xp = (first ? xo * DN_ALPHA : xo) + gv * v; }
        else { float* xp = xc + (size_t)(row - TL) * D + col; *(GAS f32x4*)xp = *(const GAS f32x4*)xp + gv * v; }
    }
};
struct FHgIn {
    bf16* qffi; bf16* g;
    __device__ __forceinline__ void operator()(int row, int col, f32x4 v0, f32x4 v1) const {
        v4u w; w.x = pg8::cvt_pk_bf16(v0[0], v0[1]); w.y = pg8::cvt_pk_bf16(v0[2], v0[3]); w.z = pg8::cvt_pk_bf16(v1[0], v1[1]); w.w = pg8::cvt_pk_bf16(v1[2], v1[3]);
        if (col < 4096) *(GAS v4u*)(qffi + (size_t)row * 4096 + col) = w; else *(GAS v4u*)(g + (size_t)row * D + (col - 4096)) = w;
    }
};
struct EpiConvGate {
    static constexpr bool PERM = true, AFTER_DRAIN = false;
    bf16* hg; bf16* ab; bf16* gb; const float* cw; const float* cb;
    __device__ __forceinline__ void operator()(const pg8::f32x4 (&acc)[2][2][4][2], const pg8::Unit& u, int wr, int wc, int fr, int fq) const {
        const int hc0 = 128 * u.pn + 32 * wc + 8 * fq;
#pragma unroll
        for (int ai = 0; ai < 2; ++ai) {
            const int rowbase = u.pm * 256 + 128 * ai + 64 * wr, g64 = rowbase >> 6;
#pragma unroll
            for (int n = 0; n < 2; ++n) {
                const int hc = hc0 + 4 * n;
                const f32x4 w0 = *(const GAS f32x4*)(cw + hc), w1 = *(const GAS f32x4*)(cw + FFH + hc), w2 = *(const GAS f32x4*)(cw + 2 * FFH + hc), b0 = *(const GAS f32x4*)(cb + hc);
                float out[4][4];
#pragma unroll
                for (int e = 0; e < 4; ++e) { float a[4], up[4], dn[4], l15[4], l0[4];
#pragma unroll
                    for (int m = 0; m < 4; ++m) { a[m] = acc[ai][0][m][n][e]; up[m] = __shfl_up(a[m], 1, 16); dn[m] = __shfl_down(a[m], 1, 16); l15[m] = __shfl(a[m], 15, 16); l0[m] = __shfl(a[m], 0, 16); }
#pragma unroll
                    for (int m = 0; m < 4; ++m) { const float prev = fr > 0 ? up[m] : (m > 0 ? l15[m > 0 ? m - 1 : 0] : 0.f), next = fr < 15 ? dn[m] : (m < 3 ? l0[m < 3 ? m + 1 : 3] : 0.f);
                        const float cv = b0[e] + w0[e] * prev + w1[e] * a[m] + w2[e] * next; out[m][e] = siluf_(cv) * acc[ai][1][m][n][e]; } }
#pragma unroll
                for (int m = 0; m < 4; ++m) { const int r64 = 16 * m + fr, row = rowbase + r64;
                    if (r64 != 0 && r64 != 63) { v2u w; w.x = pk2(out[m][0], out[m][1]); w.y = pk2(out[m][2], out[m][3]); *(GAS v2u*)(hg + (size_t)row * FFH + hc) = w; }
                    if (r64 <= 1 || r64 >= 62) { const int slot = r64 <= 1 ? r64 : r64 - 60; const f32x4 ra = acc[ai][0][m][n];
                        v2u w; w.x = pk2(ra[0], ra[1]); w.y = pk2(ra[2], ra[3]); *(GAS v2u*)(ab + (size_t)(g64 * 4 + slot) * FFH + hc) = w;
                        if (r64 == 0 || r64 == 63) { const f32x4 rg = acc[ai][1][m][n]; v2u wg; wg.x = pk2(rg[0], rg[1]); wg.y = pk2(rg[2], rg[3]); *(GAS v2u*)(gb + (size_t)(g64 * 2 + (r64 == 63 ? 1 : 0)) * FFH + hc) = wg; } }
                }
                __builtin_amdgcn_sched_barrier(0);
            }
        }
    }
};
template <class E> __device__ __forceinline__ void run_gemm_off(Frame& F, const bf16* A, int lda, const bf16* Bt, int ldb, int M, int N, int K, const E& e, int boff) {
    pg8::Gemm g{A, Bt, M, N, K, lda, ldb}; pg8::StaticOrder S; S.init(M, N, F.G, (int)((blockIdx.x + F.G - boff) % F.G));
    pg8::gemm_phase<E, pg8::StaticOrder, true, true>(F.lds + RING_OFF, g, S, e);
}
template <class E> __device__ __forceinline__ void run_gemm(Frame& F, const bf16* A, int lda, const bf16* Bt, int ldb, int M, int N, int K, const E& e) {
    pg8::Gemm g{A, Bt, M, N, K, lda, ldb}; pg8::StaticOrder S; S.init(M, N, F.G, (int)blockIdx.x);
    pg8::gemm_phase<E, pg8::StaticOrder, true, true>(F.lds + RING_OFF, g, S, e);
}

constexpr int NPH = 26;
struct Args { const float* in[31]; float* out; unsigned char* ws; int ph_lo, ph_hi; };
__global__ void __launch_bounds__(NWAVES * 64, 2) mk_fwd(Args args) {
    extern __shared__ __attribute__((aligned(16))) unsigned char lds[];
    Frame F;
    F.lds = (LAS unsigned char*)lds;
    F.tid = threadIdx.x; F.lane = F.tid & 63; F.wave = __builtin_amdgcn_readfirstlane(F.tid >> 6);
    F.G = gridDim.x; { const int bx = blockIdx.x; F.vcu = (F.G % 8 == 0) ? (bx % 8) * (F.G / 8) + bx / 8 : bx; }
    for (int u = F.tid; u < (LDS_BYTES - LDSCTL_OFF) / 4; u += NWAVES * 64) ((LAS unsigned*)(F.lds + LDSCTL_OFF))[u] = 0u;
    __syncthreads();
    if (F.tid == 0) {
#pragma unroll
        for (int i = 0; i < 31; ++i) ((LAS unsigned long long*)(F.lds + PTR_OFF))[i] = (unsigned long long)args.in[i];
        ((LAS unsigned long long*)(F.lds + PTR_OFF))[31] = (unsigned long long)args.ws; ((LAS unsigned long long*)(F.lds + PTR_OFF))[32] = (unsigned long long)args.out;
    }
    __syncthreads();
    const int lo = args.ph_lo, hi = args.ph_hi;
    const bool multi = (hi - lo) > 1;
    if (multi) (void)xcd_barrier_post((unsigned*)ws_(F) + CW_BAR, (volatile LAS unsigned*)(F.lds + MISC_OFF) + 8);
#ifndef ONLY_PHASE
#define ONLY_PHASE -1
#endif
#define WSP ws_(F)
#define MODP ((const float*)(ws_(F) + WS_MOD))
#define ABUF ((bf16*)(ws_(F) + WS_A))
#ifndef SKIP_PHASE
#define SKIP_PHASE -1
#endif
#define IN(k) ((ONLY_PHASE < 0 || ONLY_PHASE == (k)) && SKIP_PHASE != (k) && lo <= (k) && (k) < hi)
#define SEAM(k) do { if (IN(k) && IN((k) + 1)) { XcdBarrier bar_; bar_.bar = (unsigned*)ws_(F) + CW_BAR; bar_.x = xb_xcc_id(); bar_.st = (volatile LAS unsigned*)(F.lds + MISC_OFF) + 8; xcd_barrier(bar_); } asm volatile("" : "+v"(F.tid), "+v"(F.lane)); } while (0)
    int pk = 0;
#ifndef REPEAT_PHASE
#define REPEAT_PHASE -1
#endif
#define PHASE(...) do { if (IN(pk)) { __VA_ARGS__ } if (REPEAT_PHASE == pk && IN(pk)) { { XcdBarrier bar_; bar_.bar = (unsigned*)ws_(F) + CW_BAR; bar_.x = xb_xcc_id(); bar_.st = (volatile LAS unsigned*)(F.lds + MISC_OFF) + 8; xcd_barrier(bar_); } asm volatile("" : "+v"(F.tid), "+v"(F.lane)); { __VA_ARGS__ } } SEAM(pk); ++pk; } while (0)
    PHASE( p0_prologue(F); p0_s5_tables(F); );
    PHASE( ph_init_rows(F); );
    PHASE( pg8::Epi8<FInProj> e{{(bf16*)(WSP + WS_CQKV), (bf16*)(WSP + WS_UG)}}; run_gemm(F, ABUF, D, (const bf16*)(WSP + WS_WIN0), D, TT, EVEN_IN_PAD, D, e); );
    PHASE( ph_s5_finals(F); );
    PHASE( ph_s5_carry(F); );
    PHASE( ph_mla_norm(F); );
    PHASE(
        { pg8::Epi8<FQ> e{{(bf16*)(WSP + WS_QB), (const float*)(WSP + WS_ROPE)}}; run_gemm(F, (const bf16*)(WSP + WS_CQKV), CQKV_LD, (const bf16*)(WSP + WS_WUQ), 384, TT, 768, 384, e); }
        { pg8::Epi8<FKV> e{{(bf16*)(WSP + WS_KB), (bf16*)(WSP + WS_VB)}}; run_gemm(F, (const bf16*)(WSP + WS_CQKV) + 384, CQKV_LD, (const bf16*)(WSP + WS_WUKV), 256, TT, 1024, 256, e); }
    );
    PHASE( ph_s5_out(F); );
    PHASE( ph_attn(F); );
    PHASE( pg8::Epi8<FGlu> e{{(const bf16*)(WSP + WS_Z), (bf16*)(WSP + WS_MIX)}}; run_gemm(F, (const bf16*)(WSP + WS_Z), 512, (const bf16*)(WSP + WS_WGLU), 512, TT, 512, 512, e); );
    PHASE( pg8::Epi4<FResid> e{{out_(F), (float*)(WSP + WS_XC), MODP + 0 * 3 * 6144 + 2 * 1024, 1, 0}}; run_gemm(F, (const bf16*)(WSP + WS_MIX), D, (const bf16*)(WSP + WS_WOUT0), D, TT, D, D, e); );
    PHASE( ph_layernorm(F, TT, 0, 0, 0, 3, nullptr, 0); );
    PHASE( EpiConvGate e{(bf16*)(WSP + WS_HG), (bf16*)(WSP + WS_AB), (bf16*)(WSP + WS_GB), inp(F, 9), inp(F, 10)}; run_gemm(F, ABUF, D, (const bf16*)(WSP + WS_F1T0), D, TT, 2 * FFH, D, e); );
    PHASE( ph_convfix(F, TT, 0); );
    PHASE( pg8::Epi4<FResid> e{{out_(F), (float*)(WSP + WS_XC), MODP + 0 * 3 * 6144 + 5 * 1024, 1, 0}}; run_gemm(F, (const bf16*)(WSP + WS_HG), FFH, (const bf16*)(WSP + WS_F2T0), FFH, TT, D, FFH, e); );
    PHASE( ph_layernorm(F, TT, 0, 1, 1, 0, nullptr, 0); );
    PHASE( pg8::Epi8<FHgIn> e{{(bf16*)(WSP + WS_QFFI), (bf16*)(WSP + WS_G)}}; run_gemm(F, ABUF, D, (const bf16*)(WSP + WS_HGINT), D, TT, 5120, D, e); );
    PHASE( ph_hgrn_states(F); );
    PHASE( ph_hgrn_out(F); );
    PHASE( ph_hg_gate(F); );
    PHASE( pg8::Epi4<FResid> e{{out_(F), (float*)(WSP + WS_XC), MODP + 1 * 3 * 6144 + 2 * 1024, 1, 0}}; run_gemm(F, (const bf16*)(WSP + WS_O), D, (const bf16*)(WSP + WS_HGOUTT), D, TL, D, D, e); );
    PHASE( ph_layernorm(F, TL, 1, 0, 1, 3); );
    PHASE( EpiConvGate e{(bf16*)(WSP + WS_HG), (bf16*)(WSP + WS_AB), (bf16*)(WSP + WS_GB), inp(F, 9) + (size_t)3 * FFH, inp(F, 10) + FFH}; run_gemm(F, ABUF, D, (const bf16*)(WSP + WS_F1T1), D, TL, 2 * FFH, D, e); );
    PHASE( ph_convfix(F, TL, 1); );
    PHASE( pg8::Epi4<FResid> e{{out_(F), (float*)(WSP + WS_XC), MODP + 1 * 3 * 6144 + 5 * 1024, 1, 0}}; run_gemm(F, (const bf16*)(WSP + WS_HG), FFH, (const bf16*)(WSP + WS_F2T1), FFH, TL, D, FFH, e); );
    PHASE( ph_layernorm(F, TL, 1, 1, -1, 0); );
#undef PHASE
#undef IN
#undef SEAM
}

extern "C" void kernel_launch(void* const* d_in, const int* in_sizes, int n_in, void* d_out, int out_size, void* d_ws, size_t ws_size, hipStream_t stream) {
    static int grid = 0;
    if (grid == 0) {
        if (n_in != 31 || out_size != TL * D || ws_size < WS_END) { fprintf(stderr, "kernel_launch: unexpected shapes n_in %d out %d ws %zu\n", n_in, out_size, ws_size); grid = -1; return; }
        int dev = 0, cus = 0;
        if (hipGetDevice(&dev) != hipSuccess || hipDeviceGetAttribute(&cus, hipDeviceAttributeMultiprocessorCount, dev) != hipSuccess) { grid = -1; return; }
        if (hipFuncSetAttribute((const void*)mk_fwd, hipFuncAttributeMaxDynamicSharedMemorySize, LDS_BYTES) != hipSuccess) { fprintf(stderr, "kernel_launch: hipFuncSetAttribute failed\n"); grid = -1; return; }
        int per_cu = 0;
        if (hipOccupancyMaxActiveBlocksPerMultiprocessor(&per_cu, (const void*)mk_fwd, NWAVES * 64, LDS_BYTES) != hipSuccess || per_cu < 1) fprintf(stderr, "kernel_launch: occupancy query says %d\n", per_cu);
        (void)hipGetLastError();
        grid = cus;
    }
    if (grid < 0) return;
    if (hipMemsetAsync((char*)d_ws + WS_CTL, 0, CTL_ZERO_BYTES, stream) != hipSuccess) return;
    Args a{};
    for (int i = 0; i < 31; ++i) a.in[i] = (const float*)d_in[i];
    a.out = (float*)d_out; a.ws = (unsigned char*)d_ws;
#ifndef MK_ONE_LAUNCH
#define MK_ONE_LAUNCH 1
#endif
    if (MK_ONE_LAUNCH) { a.ph_lo = 0; a.ph_hi = NPH; hipLaunchKernelGGL(mk_fwd, dim3(grid), dim3(NWAVES * 64), LDS_BYTES, stream, a); }
    else for (int p = 0; p < NPH; ++p) { a.ph_lo = p; a.ph_hi = p + 1; hipLaunchKernelGGL(mk_fwd, dim3(grid), dim3(NWAVES * 64), LDS_BYTES, stream, a); }
}
```

```cpp
#include <hip/hip_runtime.h>
#include <cstdio>
#include <cstdint>
#include <cmath>
namespace pg8 {
#define PG8_LAS __attribute__((address_space(3)))
typedef unsigned short bf16_t;
typedef short bf16x8 __attribute__((ext_vector_type(8)));
typedef float f32x4 __attribute__((ext_vector_type(4)));
typedef unsigned u32x4 __attribute__((ext_vector_type(4)));
constexpr int BM = 256, BK = 64, HALF = 128, HTB = HALF * BK * 2  , STAGE_BYTES = 8 * HTB, NXCD = 8, WGM = 8;

__host__ __device__ __forceinline__ int lds_byte(int r, int c) { const int st = (r >> 4) * 2 + (c >> 5), rr = r & 15, cc = c & 31, ob = rr * 64 + cc * 2; return st * 1024 + (ob ^ (((ob >> 9) & 1) << 5)); }
__host__ __device__ __forceinline__ void stage_rc(int b, int& R, int& C) { const int st = b / 1024, sb = b % 1024, swz = sb ^ (((sb >> 9) & 1) << 5); R = (st >> 1) * 16 + swz / 64; C = (st & 1) * 32 + (swz % 64) / 2; }
__host__ __device__ __forceinline__ int perm32(int rho) { const int n = rho >> 4, i = rho & 15; return 8 * (i >> 2) + 4 * n + (i & 3); }

struct Unit { int pm, pn; };
struct Gemm { const bf16_t* A; const bf16_t* Bt; int M, N, K, lda, ldb; };

struct StaticOrder {
    int nM, nN, nwg, G, c;
    __host__ __device__ void init(int M, int N, int G_, int c_) { nM = M / BM; nN = N / BM; nwg = nM * nN; G = G_; c = c_; }
    __host__ __device__ bool next(int i, Unit& u) const {
        const long L = (long)i * G + c; if (L >= nwg) return false;
        int wgid = (int)L; { const int q = nwg / NXCD, r = nwg % NXCD, xcd = wgid % NXCD, off = wgid / NXCD; wgid = (xcd < r ? xcd * (q + 1) : r * (q + 1) + (xcd - r) * q) + off; }
        const int nig = WGM * nN, gid = wgid / nig, fm = gid * WGM, gsz = (nM - fm) < WGM ? (nM - fm) : WGM;
        u.pm = fm + ((wgid % nig) % gsz); u.pn = (wgid % nig) / gsz; return true;
    }
    __device__ __forceinline__ void a_ready(const Unit&) const {}
    __device__ __forceinline__ void done(const Unit&) const {}
};

__device__ __forceinline__ unsigned cvt_pk_bf16(float lo, float hi) { unsigned r; asm volatile("v_cvt_pk_bf16_f32 %0, %1, %2" : "=v"(r) : "v"(lo), "v"(hi)); return r; }
template <class F> struct Epi8 {
    static constexpr bool PERM = true, AFTER_DRAIN = false; F f;
    __device__ __forceinline__ void operator()(const f32x4 (&acc)[2][2][4][2], const Unit& u, int wr, int wc, int fr, int fq) const {
        const int row0 = u.pm * BM + wr * 64 + fr, col0 = u.pn * BM + wc * 32 + 8 * fq;
#pragma unroll
        for (int ai = 0; ai < 2; ++ai)
#pragma unroll
            for (int m = 0; m < 4; ++m)
#pragma unroll
                for (int bj = 0; bj < 2; ++bj) { f(row0 + ai * HALF + m * 16, col0 + bj * HALF, acc[ai][bj][m][0], acc[ai][bj][m][1]); }
    }
};
template <class F> struct Epi4 {
    static constexpr bool PERM = false, AFTER_DRAIN = false; F f;
    __device__ __forceinline__ void operator()(const f32x4 (&acc)[2][2][4][2], const Unit& u, int wr, int wc, int fr, int fq) const {
        const int row0 = u.pm * BM + wr * 64 + fr, col0 = u.pn * BM + wc * 32 + 4 * fq;
#pragma unroll
        for (int ai = 0; ai < 2; ++ai)
#pragma unroll
            for (int m = 0; m < 4; ++m)
#pragma unroll
                for (int bj = 0; bj < 2; ++bj)
#pragma unroll
                    for (int n = 0; n < 2; ++n) { f(row0 + ai * HALF + m * 16, col0 + bj * HALF + n * 16, acc[ai][bj][m][n]); }
    }
};
template <class Epi, class Sched, bool ALIGN_EPI = false, bool SP2 = false>
__device__ __forceinline__ void gemm_phase(PG8_LAS unsigned char* lds, const Gemm g, const Sched& S, const Epi& E) {
    int tid_ = threadIdx.x; asm volatile("" : "+v"(tid_));
    const int tid = tid_, wid = __builtin_amdgcn_readfirstlane(tid >> 6), lane = tid & 63, wr = wid >> 2, wc = wid & 3, fr = lane & 15, fq = lane >> 4;
    const int K = g.K, nt = K / BK;
    unsigned voffA[2], voffB[2];
#pragma unroll
    for (int i = 0; i < 2; ++i) { int R, C; stage_rc(tid * 16 + i * 8192, R, C); const int Rb = Epi::PERM ? ((R & ~31) + perm32(R & 31)) : R;
        voffA[i] = (unsigned)(R * g.lda + C) * 2u; voffB[i] = (unsigned)(Rb * g.ldb + C) * 2u; }
    const size_t kstep = (size_t)(BK * 2);
    const size_t hstepA = (size_t)HALF * g.lda * 2, hstepB = (size_t)HALF * g.ldb * 2;
    const size_t tstepA = 2 * hstepA, tstepB = 2 * hstepB;
    const unsigned ldsw = (unsigned)wid * 1024u;
    const int aoff = lds_byte(wr * 64 + fr, fq * 8), boff = lds_byte(wc * 32 + fr, fq * 8);
#define PG8_SA(b, h) (((b) * 2 + (h)) * HTB)
#define PG8_SB(b, h) ((4 + (b) * 2 + (h)) * HTB)
#define PG8_STAGE(bufoff, gbase, voff) do { _Pragma("unroll") for (int _i = 0; _i < 2; ++_i) \
        __builtin_amdgcn_global_load_lds((const unsigned*)((const char*)(gbase) + (voff)[_i]), (PG8_LAS unsigned*)(lds + (bufoff) + ldsw + _i * 8192), 16, 0, 0); } while (0)
#define PG8_LDA(dst, b, h) do { _Pragma("unroll") for (int m = 0; m < 4; ++m) _Pragma("unroll") for (int k = 0; k < 2; ++k) dst[m][k] = *(const PG8_LAS bf16x8*)(lds + PG8_SA(b, h) + aoff + m * 2048 + k * 1024); } while (0)
#define PG8_LDB(dst, b, h) do { _Pragma("unroll") for (int n = 0; n < 2; ++n) _Pragma("unroll") for (int k = 0; k < 2; ++k) dst[n][k] = *(const PG8_LAS bf16x8*)(lds + PG8_SB(b, h) + boff + n * 2048 + k * 1024); } while (0)
#define PG8_MMA(ai, bj, At, Bt) do { __builtin_amdgcn_s_setprio(1); _Pragma("unroll") for (int m = 0; m < 4; ++m) _Pragma("unroll") for (int n = 0; n < 2; ++n) _Pragma("unroll") for (int k = 0; k < 2; ++k) \
        acc[ai][bj][m][n] = __builtin_amdgcn_mfma_f32_16x16x32_bf16(Bt[n][k], At[m][k], acc[ai][bj][m][n], 0, 0, 0); __builtin_amdgcn_s_setprio(0); } while (0)
#define PG8_WAIT_V(n) asm volatile("s_waitcnt vmcnt(" #n ")" ::: "memory")
#define PG8_WAIT_L(n) asm volatile("s_waitcnt lgkmcnt(" #n ")" ::: "memory")
#define PG8_BAR __builtin_amdgcn_s_barrier()
#define PG8_SCHED __builtin_amdgcn_sched_barrier(0)
    Unit cur, nxt; int ui = 0;
    if (!S.next(0, cur)) return;
    f32x4 acc[2][2][4][2];
#pragma unroll
    for (int a = 0; a < 2; ++a)
#pragma unroll
        for (int b = 0; b < 2; ++b)
#pragma unroll
            for (int m = 0; m < 4; ++m)
#pragma unroll
                for (int n = 0; n < 2; ++n) acc[a][b][m][n] = (f32x4){0.f, 0.f, 0.f, 0.f};
    bf16x8 At[4][2], B0[2][2], B1[2][2];
    const char* cA = (const char*)g.A + (size_t)cur.pm * tstepA; const char* cB = (const char*)g.Bt + (size_t)cur.pn * tstepB;
    S.a_ready(cur);
    if constexpr (SP2) {
        PG8_STAGE(PG8_SB(0, 0), cB, voffB); PG8_STAGE(PG8_SB(0, 1), cB + hstepB, voffB); PG8_STAGE(PG8_SA(0, 0), cA, voffA); PG8_STAGE(PG8_SA(0, 1), cA + hstepA, voffA);
        if (wr == 1) PG8_BAR;
        PG8_WAIT_V(2); PG8_BAR;
        PG8_STAGE(PG8_SB(1, 0), cB + kstep, voffB); PG8_STAGE(PG8_SA(1, 0), cA + kstep, voffA); PG8_STAGE(PG8_SB(1, 1), cB + hstepB + kstep, voffB);
        PG8_WAIT_V(6); PG8_BAR;
    } else {
        PG8_STAGE(PG8_SB(0, 0), cB, voffB); PG8_STAGE(PG8_SA(0, 0), cA, voffA); PG8_STAGE(PG8_SB(0, 1), cB + hstepB, voffB); PG8_STAGE(PG8_SA(0, 1), cA + hstepA, voffA);
        if (wr == 1) PG8_BAR;
        PG8_WAIT_V(4); PG8_BAR;
        PG8_STAGE(PG8_SB(1, 0), cB + kstep, voffB); PG8_STAGE(PG8_SA(1, 0), cA + kstep, voffA); PG8_STAGE(PG8_SB(1, 1), cB + hstepB + kstep, voffB);
        PG8_WAIT_V(6); PG8_BAR;
    }
    for (;;) {
        const bool has_next = S.next(ui + 1, nxt);
        const char* nA = has_next ? (const char*)g.A + (size_t)nxt.pm * tstepA : cA; const char* nB = has_next ? (const char*)g.Bt + (size_t)nxt.pn * tstepB : cB;
#pragma unroll 1
        for (int t = 0; t < nt; t += 2) {
            const bool last = (t == nt - 2);
            const char* a1 = cA + (size_t)(t + 1) * kstep;
            const char* a2 = last ? nA : cA + (size_t)(t + 2) * kstep; const char* b2 = last ? nB : cB + (size_t)(t + 2) * kstep;
            const char* a3 = a2 + kstep; const char* b3 = b2 + kstep;
            if (last && has_next) S.a_ready(nxt);
            if constexpr (SP2) {
            PG8_LDB(B0, 0, 0); PG8_LDB(B1, 0, 1); PG8_SCHED; PG8_LDA(At, 0, 0); PG8_STAGE(PG8_SA(1, 1), a1 + hstepA, voffA);
            PG8_WAIT_V(8); PG8_WAIT_L(0); PG8_BAR; PG8_MMA(0, 0, At, B0); PG8_MMA(0, 1, At, B1); PG8_BAR; PG8_SCHED;
            PG8_LDA(At, 0, 1); PG8_STAGE(PG8_SB(0, 0), b2, voffB); PG8_STAGE(PG8_SB(0, 1), b2 + hstepB, voffB); PG8_STAGE(PG8_SA(0, 0), a2, voffA);
            PG8_WAIT_V(8); PG8_WAIT_L(0); PG8_BAR; PG8_MMA(1, 0, At, B0); PG8_MMA(1, 1, At, B1); PG8_BAR; PG8_SCHED;
            PG8_LDB(B0, 1, 0); PG8_LDB(B1, 1, 1); PG8_SCHED; PG8_LDA(At, 1, 0); PG8_STAGE(PG8_SA(0, 1), a2 + hstepA, voffA);
            PG8_WAIT_V(8); PG8_WAIT_L(0); PG8_BAR; PG8_MMA(0, 0, At, B0); PG8_MMA(0, 1, At, B1); PG8_BAR; PG8_SCHED;
            PG8_LDA(At, 1, 1); PG8_STAGE(PG8_SB(1, 0), b3, voffB); PG8_STAGE(PG8_SB(1, 1), b3 + hstepB, voffB); PG8_STAGE(PG8_SA(1, 0), a3, voffA);
            PG8_WAIT_V(8); PG8_WAIT_L(0); PG8_BAR; PG8_MMA(1, 0, At, B0); PG8_MMA(1, 1, At, B1); PG8_BAR; PG8_SCHED;
            } else {
            PG8_LDB(B0, 0, 0); PG8_SCHED; PG8_LDA(At, 0, 0); PG8_STAGE(PG8_SA(1, 1), a1 + hstepA, voffA);
            PG8_WAIT_L(8); PG8_BAR; PG8_WAIT_L(0); PG8_MMA(0, 0, At, B0); PG8_BAR; PG8_SCHED;
            PG8_LDB(B1, 0, 1); PG8_STAGE(PG8_SB(0, 0), b2, voffB);
            PG8_BAR; PG8_WAIT_L(0); PG8_MMA(0, 1, At, B1); PG8_BAR;
            PG8_LDA(At, 0, 1); PG8_STAGE(PG8_SA(0, 0), a2, voffA);
            PG8_BAR; PG8_WAIT_L(0); PG8_MMA(1, 0, At, B0); PG8_BAR; PG8_SCHED;
            PG8_STAGE(PG8_SB(0, 1), b2 + hstepB, voffB);
            PG8_WAIT_V(6); PG8_BAR; PG8_MMA(1, 1, At, B1); PG8_BAR;
            PG8_LDB(B0, 1, 0); PG8_SCHED; PG8_LDA(At, 1, 0); PG8_STAGE(PG8_SA(0, 1), a2 + hstepA, voffA);
            PG8_WAIT_L(8); PG8_BAR; PG8_WAIT_L(0); PG8_MMA(0, 0, At, B0); PG8_BAR; PG8_SCHED;
            PG8_LDB(B1, 1, 1); PG8_STAGE(PG8_SB(1, 0), b3, voffB);
            PG8_BAR; PG8_WAIT_L(0); PG8_MMA(0, 1, At, B1); PG8_BAR;
            PG8_LDA(At, 1, 1); PG8_STAGE(PG8_SA(1, 0), a3, voffA);
            PG8_BAR; PG8_WAIT_L(0); PG8_MMA(1, 0, At, B0); PG8_BAR; PG8_SCHED;
            PG8_STAGE(PG8_SB(1, 1), b3 + hstepB, voffB);
            PG8_WAIT_V(6); PG8_BAR; PG8_MMA(1, 1, At, B1); PG8_BAR;
            }
        }
        if constexpr (ALIGN_EPI) { if (wr == 0) PG8_BAR; }
        if constexpr (!Epi::AFTER_DRAIN) { E(acc, cur, wr, wc, fr, fq); S.done(cur); }
        if (!has_next) break;
#pragma unroll
        for (int a = 0; a < 2; ++a)
#pragma unroll
            for (int b = 0; b < 2; ++b)
#pragma unroll
                for (int m = 0; m < 4; ++m)
#pragma unroll
                    for (int n = 0; n < 2; ++n) acc[a][b][m][n] = (f32x4){0.f, 0.f, 0.f, 0.f};
        cur = nxt; cA = nA; cB = nB; ++ui;
        if constexpr (ALIGN_EPI) { if (wr == 1) PG8_BAR; }
    }
    PG8_WAIT_V(0);
    if constexpr (!ALIGN_EPI) { if (wr == 0) PG8_BAR; }
    PG8_BAR;
    if constexpr (Epi::AFTER_DRAIN) { E.fused(acc, cur, wr, wc, fr, fq, lds, wid, lane); S.done(cur); }
#undef PG8_SA
#undef PG8_SB
#undef PG8_STAGE
#undef PG8_LDA
#undef PG8_LDB
#undef PG8_MMA
#undef PG8_WAIT_V
#undef PG8_WAIT_L
#undef PG8_BAR
#undef PG8_SCHED
}
}

constexpr int NWAVES = 8;
constexpr int D = 1024, BATCH = 2, SEQ = 8192, CTXL = 256;
constexpr int TL = BATCH * SEQ;
constexpr int TC = BATCH * CTXL;
constexpr int TT = TL + TC;
constexpr int EVEN_IN = 1184, EVEN_IN_PAD = 1280, CQKV_LD = 672;
constexpr int FFH = 2816, FFG = 1408;
constexpr int TQK = SEQ + CTXL;
constexpr float NORM_EPS = 1e-6f;
constexpr float DN_ALPHA = 1.41421356237f;
constexpr float QSCALE = 0.10206207261596577f * 1.4426950408889634f;

constexpr size_t MiB = 1u << 20;
constexpr size_t WS_CTL = 0, CTL_ZERO_BYTES = 1 * MiB;
constexpr size_t WS_MOD = 1 * MiB;
constexpr size_t WS_LBV = WS_MOD + 160 * 1024;
constexpr size_t WS_ROPE = WS_LBV + 16 * 1024;
constexpr size_t WS_HGINT = 2 * MiB, WS_HGOUTT = 12 * MiB, WS_F1T1 = 14 * MiB, WS_F2T1 = 25 * MiB;
constexpr size_t WS_A = 31 * MiB;
constexpr size_t WS_XC = 64 * MiB;
constexpr size_t WS_WIN0 = 66 * MiB, WS_WUQ = WS_WIN0 + 2560 * 1024, WS_WUKV = WS_WUQ + 768 * 1024, WS_WGLU = WS_WUKV + 512 * 1024,
                 WS_WOUT0 = WS_WGLU + 512 * 1024, WS_F1T0 = 72 * MiB + 512 * 1024, WS_F2T0 = WS_F1T0 + 11 * MiB;
constexpr size_t WS_R = 89 * MiB;
constexpr size_t WS_CQKV = WS_R;
constexpr size_t WS_UG = WS_R + 22 * MiB;
constexpr size_t WS_WF = WS_R + 39 * MiB;
constexpr size_t WS_WC = WS_R + 64 * MiB;
constexpr size_t WS_TOEP = WS_R + 80 * MiB;
constexpr size_t WS_T0 = WS_R + 82 * MiB;
constexpr size_t WS_A64 = WS_T0 + 128 * 1024;
constexpr size_t WS_FIN = WS_R + 83 * MiB;
constexpr size_t WS_SIN = WS_R + 92 * MiB;
constexpr size_t WS_Z = WS_R + 97 * MiB;
constexpr size_t WS_MIX = WS_R + 134 * MiB;
constexpr size_t WS_QB = WS_R + 39 * MiB;
constexpr size_t WS_KB = 31 * MiB;
constexpr size_t WS_VB = WS_R + 114 * MiB;
constexpr size_t WS_AB = WS_R;
constexpr size_t WS_GB = WS_R + 8 * MiB;
constexpr size_t WS_H = WS_R;
constexpr size_t WS_HG = WS_R + 16 * MiB;
constexpr size_t WS_QFFI = 66 * MiB;
constexpr size_t WS_G = 198 * MiB;
constexpr size_t WS_O = WS_A;
constexpr size_t WS_SLAB1 = WS_R;
constexpr size_t WS_SLAB2 = WS_R + 140 * MiB;
constexpr size_t WS_END = 256 * MiB;
static_assert(WS_F2T0 + 5632 * 1024 <= WS_R, "layer-0 weights");
static_assert(WS_MIX + (size_t)TT * 1024 * 2 <= WS_END && WS_G + (size_t)TT * 1024 * 2 <= WS_END && WS_HG + (size_t)TT * FFH * 2 <= WS_END, "ws map");
static_assert(WS_WF + 16 * MiB <= WS_WC && WS_QB + (size_t)16 * TQK * 96 * 2 <= WS_WC && WS_WC + 16 * MiB <= WS_TOEP && WS_TOEP + 2 * MiB <= WS_T0 && WS_T0 + MiB <= WS_FIN && WS_FIN + (size_t)32 * 264 * 256 * 4 <= WS_SIN && WS_SIN + (size_t)32 * 264 * 256 * 2 <= WS_Z && WS_Z + (size_t)TT * 512 * 2 <= WS_VB && WS_VB + (size_t)16 * TQK * 64 * 2 <= WS_MIX && WS_KB + (size_t)16 * TQK * 96 * 2 <= WS_XC, "ws map 2");

constexpr int CW_BAR = 4096;
constexpr int RING_OFF = 0, RING_BYTES = 131072;
constexpr int LDSCTL_OFF = RING_BYTES, MISC_OFF = LDSCTL_OFF + 320;
constexpr int LDS_BYTES = 147456;

#define GAS __attribute__((address_space(1)))
#define LAS __attribute__((address_space(3)))
typedef unsigned short bf16;
typedef unsigned v4u __attribute__((ext_vector_type(4)));
typedef unsigned v2u __attribute__((ext_vector_type(2)));
typedef float f32x4 __attribute__((ext_vector_type(4)));
typedef GAS unsigned gu32;
#define RLX_AGENT __ATOMIC_RELAXED, __HIP_MEMORY_SCOPE_AGENT
#define LDS_WAIT() asm volatile("s_waitcnt lgkmcnt(0)" ::: "memory")
__device__ __forceinline__ unsigned f2bf(float f) { unsigned u = __builtin_bit_cast(unsigned, f); return (u + 0x7fffu + ((u >> 16) & 1u)) >> 16; }
__device__ __forceinline__ unsigned pk2(float lo, float hi) { return f2bf(lo) | (f2bf(hi) << 16); }
__device__ __forceinline__ float bflo(unsigned w) { return __builtin_bit_cast(float, w << 16); }
__device__ __forceinline__ float bfhi(unsigned w) { return __builtin_bit_cast(float, w & 0xffff0000u); }
__device__ __forceinline__ float bf2f(bf16 h) { return __builtin_bit_cast(float, (unsigned)h << 16); }
__device__ __forceinline__ void unpack8(v4u w, float* x) { x[0] = bflo(w.x); x[1] = bfhi(w.x); x[2] = bflo(w.y); x[3] = bfhi(w.y); x[4] = bflo(w.z); x[5] = bfhi(w.z); x[6] = bflo(w.w); x[7] = bfhi(w.w); }
__device__ __forceinline__ v4u pack8(const float* x) { v4u w; w.x = pk2(x[0], x[1]); w.y = pk2(x[2], x[3]); w.z = pk2(x[4], x[5]); w.w = pk2(x[6], x[7]); return w; }
__device__ __forceinline__ float sigmoidf_(float x) { return 1.0f / (1.0f + __expf(-x)); }
__device__ __forceinline__ float siluf_(float x) { return x / (1.0f + __expf(-x)); }
__device__ __forceinline__ float gelu_tanh(float x) { const float u = 0.7978845608028654f * (x + 0.044715f * x * x * x); return 0.5f * x * (1.0f + tanhf(u)); }
__device__ __forceinline__ float wave_sum(float v) {
#pragma unroll
    for (int o = 1; o < 64; o <<= 1) v += __shfl_xor(v, o);
    return v;
}

#define XB_TMO      128
#define XB_XCNT(j)  (256  + 64 * (j))
#define XB_XSUB(j)  (1280 + 64 * (j))
#define XB_XGEN(j)  (2304 + 64 * (j))
#define XB_TOP      3328
#define XB_TOPGEN   3392
#define XCD_BAR_WORDS 3456
#define XB_SPIN_CAP (1u << 18)

__device__ __forceinline__ unsigned xb_ld(unsigned* p)              { return __hip_atomic_load(p, __ATOMIC_RELAXED, __HIP_MEMORY_SCOPE_AGENT); }
__device__ __forceinline__ unsigned xb_add(unsigned* p, unsigned v) { return __hip_atomic_fetch_add(p, v, __ATOMIC_RELAXED, __HIP_MEMORY_SCOPE_AGENT); }
__device__ __forceinline__ unsigned xb_xcc_id() { return (unsigned)__builtin_amdgcn_s_getreg((3 << 11) | 20) & 0xFu; }
#define XB_SPIN(cond, bar) do { unsigned _sp = 0; while (cond) { __builtin_amdgcn_s_sleep(1); \
    if ((++_sp & 255u) == 0u) { if (xb_ld(&(bar)[XB_TMO])) break; if (_sp > XB_SPIN_CAP) { atomicAdd(&(bar)[XB_TMO], 1u); break; } } } } while (0)

struct XcdBarrier {
    unsigned* bar; unsigned x;
    volatile LAS unsigned* st;
};

__device__ __forceinline__ XcdBarrier xcd_barrier_post(unsigned* bar, volatile LAS unsigned* st) {
    XcdBarrier b; b.bar = bar; b.x = xb_xcc_id(); b.st = st;
    if (threadIdx.x == 0) (void)xb_add(&bar[XB_XCNT(b.x)], 1u);
    return b;
}
__device__ __forceinline__ void xcd_barrier_complete(unsigned* bar, unsigned x, unsigned& nloc, unsigned& nx) {
    const unsigned G = gridDim.x * gridDim.y * gridDim.z;
    unsigned sum, cnt, mine, sp = 0u;
    for (;;) {
        sum = 0u; cnt = 0u; mine = 0u;
#pragma unroll
        for (unsigned j = 0; j < 16; ++j) { const unsigned c = xb_ld(&bar[XB_XCNT(j)]); sum += c; cnt += (c > 0u) ? 1u : 0u; mine = (j == x) ? c : mine; }
        if (sum == G) break;
        __builtin_amdgcn_s_sleep(1);
        if ((++sp & 255u) == 0u) { if (xb_ld(&bar[XB_TMO])) break; if (sp > XB_SPIN_CAP) { atomicAdd(&bar[XB_TMO], 1u); break; } }
    }
    nloc = mine > 0u ? mine : 1u; nx = cnt > 0u ? cnt : 1u;
}

__device__ __forceinline__ void xcd_barrier(const XcdBarrier& b) {
    asm volatile("s_waitcnt vmcnt(0)" ::: "memory");
    __syncthreads();
    if (threadIdx.x == 0) {
        unsigned* bar = b.bar;
        __builtin_amdgcn_s_waitcnt(0);
        unsigned nloc = b.st[0], nx = b.st[1];
        if (nloc == 0u) { xcd_barrier_complete(bar, b.x, nloc, nx); b.st[0] = nloc; b.st[1] = nx; }
        const unsigned old = xb_add(&bar[XB_XSUB(b.x)], 1u);
        const unsigned gen = old / nloc;
        if (old + 1u == (gen + 1u) * nloc) {
            __builtin_amdgcn_fence(__ATOMIC_RELEASE, "agent");
            asm volatile("s_waitcnt vmcnt(0)" ::: "memory");
            const unsigned og = xb_add(&bar[XB_TOP], 1u);
            const unsigned tg = og / nx;
            if (og + 1u == (tg + 1u) * nx) xb_add(&bar[XB_TOPGEN], 1u);
            else XB_SPIN(xb_ld(&bar[XB_TOPGEN]) == tg, bar);
            __builtin_amdgcn_fence(__ATOMIC_ACQUIRE, "agent");
            xb_add(&bar[XB_XGEN(b.x)], 1u);
            asm volatile("s_waitcnt vmcnt(0)" ::: "memory");
        } else {
            XB_SPIN(xb_ld(&bar[XB_XGEN(b.x)]) == gen, bar);
            __builtin_amdgcn_fence(__ATOMIC_ACQUIRE, "agent");
            asm volatile("s_waitcnt vmcnt(0)" ::: "memory");
        }
    }
    __syncthreads();
}


struct Frame {
    LAS unsigned char* lds;
    int tid, lane, wave, vcu, G;
};
constexpr int PTR_OFF = LDSCTL_OFF + 1024;
__device__ __forceinline__ const float* inp(const Frame& F, int i) {
    const LAS unsigned* p = (const LAS unsigned*)(F.lds + PTR_OFF) + 2 * i;
    const unsigned lo = __builtin_amdgcn_readfirstlane(p[0]), hi = __builtin_amdgcn_readfirstlane(p[1]);
    return (const float*)(const GAS float*)(((unsigned long long)hi << 32) | lo);
}
__device__ __forceinline__ unsigned char* ws_(const Frame& F) { return (unsigned char*)inp(F, 31); }
__device__ __forceinline__ float* out_(const Frame& F) { return (float*)inp(F, 32); }
__device__ __forceinline__ int modrow_of(int m) { return m < TL ? (m >> 13) : 2; }
__device__ __forceinline__ const float* xin_row(const Frame& F, int m) { return m < TL ? inp(F, 0) + (size_t)m * D : inp(F, 2) + (size_t)(m - TL) * D; }
__device__ __forceinline__ float* xres_row(const Frame& F, int m) { return m < TL ? out_(F) + (size_t)m * D : (float*)(ws_(F) + WS_XC) + (size_t)(m - TL) * D; }
__device__ __forceinline__ const float* modvec(const Frame& F, int layer, int mr, int part) { return (const float*)(ws_(F) + WS_MOD) + (size_t)(layer * 3 + mr) * 6144 + part * 1024; }

__device__ __forceinline__ void tr_item(const float* W, int ldw, int k0, int n0, bf16* dst, int dpitch, LAS float* scr, int lane) {
    { f32x4 v[8];
#pragma unroll
      for (int i = 0; i < 8; ++i) v[i] = *(const GAS f32x4*)(W + (size_t)(k0 + 8 * i + (lane >> 3)) * ldw + n0 + 4 * (lane & 7));
#pragma unroll
      for (int i = 0; i < 8; ++i) { LAS float* d = scr + (8 * i + (lane >> 3)) * 33 + 4 * (lane & 7); d[0] = v[i].x; d[1] = v[i].y; d[2] = v[i].z; d[3] = v[i].w; } }
    LDS_WAIT(); asm volatile("" ::: "memory");
    const int c = lane & 7;
#pragma unroll
    for (int j = 0; j < 4; ++j) { const int n = (lane >> 3) + 8 * j; const LAS float* s = scr + (8 * c) * 33 + n;
        v4u o; o.x = pk2(s[0 * 33], s[1 * 33]); o.y = pk2(s[2 * 33], s[3 * 33]); o.z = pk2(s[4 * 33], s[5 * 33]); o.w = pk2(s[6 * 33], s[7 * 33]);
        *(GAS v4u*)(dst + (size_t)n * dpitch + 8 * c) = o; }
    LDS_WAIT(); asm volatile("" ::: "memory");
}
__device__ __forceinline__ bool tr_plain(int& r, const float* W, int K, int N, bf16* WT, LAS float* scr, int lane) {
    const int nblk = N / 32, cnt = (K / 64) * nblk;
    if (r >= cnt) { r -= cnt; return false; }
    const int kb = r / nblk, nb = r % nblk;
    tr_item(W, N, 64 * kb, 32 * nb, WT + (size_t)(32 * nb) * K + 64 * kb, K, scr, lane); return true;
}
__device__ __forceinline__ bool tr_ffn1(int& r, const float* W, bf16* WT, LAS float* scr, int lane) {
    const int nblk = 5632 / 32, cnt = 16 * nblk;
    if (r >= cnt) { r -= cnt; return false; }
    const int kb = r / nblk, nb = r % nblk, n0 = 32 * nb, half = n0 / FFH, j = n0 % FFH, drow = (j >> 7) * 256 + half * 128 + (j & 127);
    tr_item(W, 5632, 64 * kb, n0, WT + (size_t)drow * 1024 + 64 * kb, 1024, scr, lane); return true;
}
__device__ __forceinline__ void p0_prologue(Frame& F) {
    {
        LAS float* sv = (LAS float*)(F.lds + RING_OFF);
        LAS float* red = sv + 3072;
        for (int i = F.tid; i < 3072; i += 512) { const int r = i >> 10, k = i & 1023; const float cv = (r < 2) ? inp(F, 1)[r * 1024 + k] : inp(F, 3)[k]; sv[i] = cv / (1.0f + __expf(-cv)); }
        __syncthreads();
        for (int it = blockIdx.x; it < 192; it += F.G) {
            const int layer = it / 96, cg = it % 96, col = cg * 64 + F.lane, k0 = F.wave * 128;
            const float* w = inp(F, 4) + ((size_t)layer * 1024 + k0) * 6144 + col;
            float a0 = 0.f, a1 = 0.f, a2 = 0.f;
#pragma unroll 16
            for (int k = 0; k < 128; ++k) { const float wv = w[(size_t)k * 6144]; a0 += sv[k0 + k] * wv; a1 += sv[1024 + k0 + k] * wv; a2 += sv[2048 + k0 + k] * wv; }
            red[(F.wave * 3 + 0) * 64 + F.lane] = a0; red[(F.wave * 3 + 1) * 64 + F.lane] = a1; red[(F.wave * 3 + 2) * 64 + F.lane] = a2;
            __syncthreads();
            if (F.tid < 192) { const int r = F.tid >> 6, l = F.tid & 63; float s = inp(F, 5)[layer * 6144 + cg * 64 + l];
#pragma unroll
                for (int wv = 0; wv < 8; ++wv) s += red[(wv * 3 + r) * 64 + l];
                ((float*)(ws_(F) + WS_MOD))[(size_t)(layer * 3 + r) * 6144 + cg * 64 + l] = s; }
            __syncthreads();
        }
        __syncthreads();
    }
    {
        const int gt = F.vcu * 512 + F.tid, NT = F.G * 512;
        for (int i = gt; i < 2048; i += NT) { const int dir = i >> 10, c = i & 1023; const float l0 = inp(F, 28)[(0 * 2 + dir) * 1024 + c], l1 = inp(F, 28)[(1 * 2 + dir) * 1024 + c];
            ((float*)(ws_(F) + WS_LBV))[i] = 1.0f / (1.0f + expf(l0 - l1)); }
        for (int i = gt; i < 1024; i += NT) { const int pos = i >> 3, f = i & 7; const float inv = powf(10000.0f, -(float)f / 8.0f); const float ang = (float)pos * inv;
            ((float*)(ws_(F) + WS_ROPE))[2 * i] = cosf(ang); ((float*)(ws_(F) + WS_ROPE))[2 * i + 1] = sinf(ang); }
        for (int i = gt; i < 96 * 1024 / 8; i += NT) ((GAS v4u*)(ws_(F) + WS_WIN0 + (size_t)1184 * 1024 * 2))[i] = (v4u){0u, 0u, 0u, 0u};
    }
    {
        LAS float* scr = (LAS float*)(F.lds + RING_OFF + F.wave * 16384);
        const int gw = F.vcu * NWAVES + F.wave, NGW = F.G * NWAVES;
        constexpr int NITEMS = 592 + 144 + 128 + 128 + 512 + 2 * 2816 + 2 * 1408 + 2560 + 512;
        for (int it = gw; it < NITEMS; it += NGW) {
            int r = it;
            if (tr_plain(r, inp(F, 12), 1024, 1184, (bf16*)(ws_(F) + WS_WIN0), scr, F.lane)) continue;
            if (tr_plain(r, inp(F, 14), 384, 768, (bf16*)(ws_(F) + WS_WUQ), scr, F.lane)) continue;
            if (tr_plain(r, inp(F, 16), 256, 1024, (bf16*)(ws_(F) + WS_WUKV), scr, F.lane)) continue;
            if (tr_plain(r, inp(F, 25), 512, 512, (bf16*)(ws_(F) + WS_WGLU), scr, F.lane)) continue;
            if (tr_plain(r, inp(F, 26), 1024, 1024, (bf16*)(ws_(F) + WS_WOUT0), scr, F.lane)) continue;
            if (tr_ffn1(r, inp(F, 8), (bf16*)(ws_(F) + WS_F1T0), scr, F.lane)) continue;
            if (tr_ffn1(r, inp(F, 8) + (size_t)1024 * 5632, (bf16*)(ws_(F) + WS_F1T1), scr, F.lane)) continue;
            if (tr_plain(r, inp(F, 11), 2816, 1024, (bf16*)(ws_(F) + WS_F2T0), scr, F.lane)) continue;
            if (tr_plain(r, inp(F, 11) + (size_t)2816 * 1024, 2816, 1024, (bf16*)(ws_(F) + WS_F2T1), scr, F.lane)) continue;
            if (tr_plain(r, inp(F, 27), 1024, 5120, (bf16*)(ws_(F) + WS_HGINT), scr, F.lane)) continue;
            tr_plain(r, inp(F, 30), 1024, 1024, (bf16*)(ws_(F) + WS_HGOUTT), scr, F.lane);
        }
    }
}

__device__ __forceinline__ void store_mod_bf16(const Frame& F, const f32x4 (&v)[4], int m, int layer, int part_sh) {
    const int mr = modrow_of(m);
    const GAS f32x4* sh = (const GAS f32x4*)modvec(F, layer, mr, part_sh) + F.lane;
    const GAS f32x4* sc = (const GAS f32x4*)modvec(F, layer, mr, part_sh + 1) + F.lane;
    GAS v2u* o = (GAS v2u*)((bf16*)(ws_(F) + WS_A) + (size_t)m * D) + F.lane;
#pragma unroll
    for (int j = 0; j < 4; ++j) { const f32x4 s = sc[64 * j], h = sh[64 * j]; const f32x4 y = v[j] * (s + 1.0f) + h; v2u w; w.x = pk2(y.x, y.y); w.y = pk2(y.z, y.w); o[64 * j] = w; }
}
__device__ __forceinline__ void ph_init_rows(Frame& F) {
    const int gw = F.vcu * NWAVES + F.wave, NGW = F.G * NWAVES;
    for (int m = gw; m < TT; m += NGW) {
        const GAS f32x4* xr = (const GAS f32x4*)xin_row(F, m) + F.lane; GAS f32x4* xo = (GAS f32x4*)xres_row(F, m) + F.lane;
        f32x4 v[4];
#pragma unroll
        for (int j = 0; j < 4; ++j) { v[j] = xr[64 * j]; xo[64 * j] = (m >= TL) ? v[j] * DN_ALPHA : v[j]; }
        store_mod_bf16(F, v, m, 0, 0);
    }
}
__device__ __forceinline__ void ph_layernorm(Frame& F, int nrows, int layer, int which, int next_layer, int next_part_sh, const float* slabs = nullptr, int nslabs = 0) {
    const int gw = F.vcu * NWAVES + F.wave, NGW = F.G * NWAVES;
    const GAS f32x4* gg = (const GAS f32x4*)(inp(F, 6) + (size_t)(layer * 2 + which) * D) + F.lane;
    const GAS f32x4* bb = (const GAS f32x4*)(inp(F, 7) + (size_t)(layer * 2 + which) * D) + F.lane;
    for (int m0 = gw; m0 < nrows; m0 += 2 * NGW) {
        const int m1 = m0 + NGW; const bool has1 = m1 < nrows; const int m1c = has1 ? m1 : m0;
        GAS f32x4* xr0 = (GAS f32x4*)xres_row(F, m0) + F.lane; GAS f32x4* xr1 = (GAS f32x4*)xres_row(F, m1c) + F.lane;
        f32x4 v[4], w[4]; float s0 = 0.f, s1 = 0.f;
#pragma unroll
        for (int j = 0; j < 4; ++j) { v[j] = xr0[64 * j]; w[j] = xr1[64 * j]; }
        if (nslabs > 0 && m1c >= TL) {
            for (int sl = 0; sl < nslabs; ++sl) { const GAS f32x4* p1 = (const GAS f32x4*)(slabs + ((size_t)sl * TC + (m1c - TL)) * D) + F.lane;
#pragma unroll
                for (int j = 0; j < 4; ++j) w[j] += p1[64 * j];
                if (m0 >= TL) { const GAS f32x4* p0 = (const GAS f32x4*)(slabs + ((size_t)sl * TC + (m0 - TL)) * D) + F.lane;
#pragma unroll
                    for (int j = 0; j < 4; ++j) v[j] += p0[64 * j]; } }
        }
#pragma unroll
        for (int j = 0; j < 4; ++j) { s0 += (v[j].x + v[j].y) + (v[j].z + v[j].w); s1 += (w[j].x + w[j].y) + (w[j].z + w[j].w); }
        const float mean0 = wave_sum(s0) * (1.f / D), mean1 = wave_sum(s1) * (1.f / D); float q0 = 0.f, q1 = 0.f;
#pragma unroll
        for (int j = 0; j < 4; ++j) { v[j] = v[j] - mean0; w[j] = w[j] - mean1; q0 += (v[j].x * v[j].x + v[j].y * v[j].y) + (v[j].z * v[j].z + v[j].w * v[j].w); q1 += (w[j].x * w[j].x + w[j].y * w[j].y) + (w[j].z * w[j].z + w[j].w * w[j].w); }
        const float r0 = 1.f / sqrtf(wave_sum(q0) * (1.f / D) + NORM_EPS), r1 = 1.f / sqrtf(wave_sum(q1) * (1.f / D) + NORM_EPS);
#pragma unroll
        for (int j = 0; j < 4; ++j) { const f32x4 g4 = gg[64 * j], b4 = bb[64 * j]; v[j] = v[j] * r0 * g4 + b4; w[j] = w[j] * r1 * g4 + b4; xr0[64 * j] = (m0 >= TL) ? v[j] * DN_ALPHA : v[j]; if (has1) xr1[64 * j] = (m1 >= TL) ? w[j] * DN_ALPHA : w[j]; }
        if (next_layer >= 0) { store_mod_bf16(F, v, m0, next_layer, next_part_sh); if (has1) store_mod_bf16(F, w, m1, next_layer, next_part_sh); }
    }
}
__device__ __forceinline__ void ph_mla_norm(Frame& F) {
    const int gw = F.vcu * NWAVES + F.wave, NGW = F.G * NWAVES;
    bf16* CQ = (bf16*)(ws_(F) + WS_CQKV); bf16* Kb = (bf16*)(ws_(F) + WS_KB); const float* rope = (const float*)(ws_(F) + WS_ROPE);
    for (int m = gw; m < TT; m += NGW) {
        bf16* row = CQ + (size_t)m * CQKV_LD;
        {
            float x[8]; float ss = 0.f; const bool act = F.lane < 48;
            if (act) { unpack8(*(const GAS v4u*)(row + 8 * F.lane), x);
#pragma unroll
                for (int j = 0; j < 8; ++j) ss += x[j] * x[j]; }
            const float sc = 1.f / sqrtf(wave_sum(ss) * (1.f / 384.f) + NORM_EPS);
            if (act) {
#pragma unroll
                for (int j = 0; j < 8; ++j) x[j] = x[j] * sc * inp(F, 13)[8 * F.lane + j];
                *(GAS v4u*)(row + 8 * F.lane) = pack8(x); }
        }
        {
            float x[8]; float ss = 0.f; const bool act = F.lane < 32;
            if (act) { unpack8(*(const GAS v4u*)(row + 384 + 8 * F.lane), x);
#pragma unroll
                for (int j = 0; j < 8; ++j) ss += x[j] * x[j]; }
            const float sc = 1.f / sqrtf(wave_sum(ss) * (1.f / 256.f) + NORM_EPS);
            if (act) {
#pragma unroll
                for (int j = 0; j < 8; ++j) x[j] = x[j] * sc * inp(F, 15)[8 * F.lane + j];
                *(GAS v4u*)(row + 384 + 8 * F.lane) = pack8(x); }
        }
        {
            const bool isctx = m >= TL; const int b = isctx ? ((m - TL) >> 8) : (m >> 13), t = isctx ? ((m - TL) & 255) : (m & 8191), tk = isctx ? t : CTXL + t;
            const int h = F.lane >> 3, i0 = (F.lane & 7) * 4;
            const v2u w = *(const GAS v2u*)(row + 640 + i0);
            float x[4] = {bflo(w.x), bfhi(w.x), bflo(w.y), bfhi(w.y)}, o[4];
#pragma unroll
            for (int j = 0; j < 4; ++j) { const float p = __shfl_xor(x[j], 2); const int idx = i0 + j, a = idx >> 4, half = (idx >> 3) & 1, f = idx & 7, pos = a ? (t & 63) : (t >> 6);
                const float cs = rope[2 * (pos * 8 + f)], sn = rope[2 * (pos * 8 + f) + 1];
                o[j] = isctx ? x[j] : (half ? x[j] * cs + p * sn : x[j] * cs - p * sn); }
            v2u ow; ow.x = pk2(o[0], o[1]); ow.y = pk2(o[2], o[3]);
            *(GAS v2u*)(Kb + ((size_t)(b * 8 + h) * TQK + tk) * 96 + 64 + i0) = ow;
        }
    }
}
__device__ __forceinline__ void ph_convfix(Frame& F, int nrows, int layer) {
    const int gw = F.vcu * NWAVES + F.wave, NGW = F.G * NWAVES;
    const bf16* AB = (const bf16*)(ws_(F) + WS_AB); const bf16* GB = (const bf16*)(ws_(F) + WS_GB); bf16* HG = (bf16*)(ws_(F) + WS_HG);
    const float* cw = inp(F, 9) + (size_t)layer * 3 * FFH; const float* cb = inp(F, 10) + (size_t)layer * FFH;
    const int nedge = (nrows / 64) * 2;
    for (int er = gw; er < nedge; er += NGW) {
        const int g64 = er >> 1, which = er & 1, m = 64 * g64 + (which ? 63 : 0);
        const bool isctx = m >= TL; const int t = isctx ? ((m - TL) & 255) : (m & 8191), len = isctx ? CTXL : SEQ;
        const bool hp = t > 0, hn = t < len - 1;
        const bf16* ac_ = AB + (size_t)(g64 * 4 + (which ? 3 : 0)) * FFH;
        const bf16* ap_ = which ? AB + (size_t)(g64 * 4 + 2) * FFH : AB + (size_t)((g64 - 1) * 4 + 3) * FFH;
        const bf16* an_ = which ? AB + (size_t)((g64 + 1) * 4 + 0) * FFH : AB + (size_t)(g64 * 4 + 1) * FFH;
        const bf16* gt_ = GB + (size_t)(g64 * 2 + which) * FFH;
#pragma unroll
        for (int ci = 0; ci < 6; ++ci) { const int ch = F.lane + 64 * ci; if (ch >= FFH / 8) break;
            const int j0 = 8 * ch; float ac[8], ap[8], an[8], gt[8], o[8];
            unpack8(*(const GAS v4u*)(ac_ + j0), ac); unpack8(*(const GAS v4u*)(gt_ + j0), gt);
            if (hp) unpack8(*(const GAS v4u*)(ap_ + j0), ap); else {
#pragma unroll
                for (int j = 0; j < 8; ++j) ap[j] = 0.f; }
            if (hn) unpack8(*(const GAS v4u*)(an_ + j0), an); else {
#pragma unroll
                for (int j = 0; j < 8; ++j) an[j] = 0.f; }
#pragma unroll
            for (int j = 0; j < 8; ++j) { const float cv = cb[j0 + j] + cw[j0 + j] * ap[j] + cw[FFH + j0 + j] * ac[j] + cw[2 * FFH + j0 + j] * an[j]; o[j] = siluf_(cv) * gt[j]; }
            *(GAS v4u*)(HG + (size_t)m * FFH + j0) = pack8(o);
        }
    }
}
__device__ __forceinline__ void ph_hg_gate(Frame& F) {
    const int gw = F.vcu * NWAVES + F.wave, NGW = F.G * NWAVES;
    bf16* O = (bf16*)(ws_(F) + WS_O); const bf16* G = (const bf16*)(ws_(F) + WS_G);
    const int c0 = 16 * F.lane; float ng[16];
#pragma unroll
    for (int j = 0; j < 16; ++j) ng[j] = inp(F, 29)[(c0 + j) & 127];
    for (int m = gw; m < TL; m += NGW) {
        float o[16], g[16]; unpack8(*(const GAS v4u*)(O + (size_t)m * D + c0), o); unpack8(*(const GAS v4u*)(O + (size_t)m * D + c0 + 8), o + 8);
        unpack8(*(const GAS v4u*)(G + (size_t)m * D + c0), g); unpack8(*(const GAS v4u*)(G + (size_t)m * D + c0 + 8), g + 8);
        float ss = 0.f;
#pragma unroll
        for (int j = 0; j < 16; ++j) ss += o[j] * o[j];
        ss += __shfl_xor(ss, 1); ss += __shfl_xor(ss, 2); ss += __shfl_xor(ss, 4);
        const float sc = 1.f / sqrtf(ss * (1.f / 128.f) + NORM_EPS);
#pragma unroll
        for (int j = 0; j < 16; ++j) o[j] = o[j] * sc * ng[j] * siluf_(g[j]);
        *(GAS v4u*)(O + (size_t)m * D + c0) = pack8(o); *(GAS v4u*)(O + (size_t)m * D + c0 + 8) = pack8(o + 8);
    }
}

typedef short bf16x8_t __attribute__((ext_vector_type(8)));
typedef float f32x16 __attribute__((ext_vector_type(16)));
__device__ __forceinline__ int crow(int r, int hi) { return (r & 3) + 8 * (r >> 2) + 4 * hi; }
constexpr int NCH = TT / 64;
__device__ __forceinline__ void p0_s5_tables(Frame& F) {
    LAS unsigned char* L = F.lds + RING_OFF;
    LAS double* lam = (LAS double*)L;
    LAS float* bb = (LAS float*)(L + 1024);
    LAS float* cc = (LAS float*)(L + 1024 + 8192);
    LAS float* pw = (LAS float*)(L + 1024 + 16384);
    unsigned char* ws = ws_(F);
    for (int item = (int)blockIdx.x - 192; item >= 0 && item < 64; item += F.G) {
        const int g = item >> 1, d = item & 1;
        __syncthreads();
        if (F.tid < 64) { const int n = F.tid, pi = (d * 32 + g) * 64 + n;
            const double lre = inp(F, 17)[pi], lim = inp(F, 18)[pi], dt = exp((double)inp(F, 19)[d * 32 + g]);
            const double mag = exp(lre * dt), are = mag * cos(lim * dt), aim = mag * sin(lim * dt), den = lre * lre + lim * lim, nr = are - 1.0;
            const double fr = (nr * lre + aim * lim) / den, fi = (aim * lre - nr * lim) / den;
            lam[2 * n] = lre * dt; lam[2 * n + 1] = lim * dt;
            for (int q = 0; q < 16; ++q) { const double br = inp(F, 20)[(size_t)pi * 16 + q], bi = inp(F, 21)[(size_t)pi * 16 + q];
                bb[(n * 16 + q) * 2] = (float)(fr * br - fi * bi); bb[(n * 16 + q) * 2 + 1] = (float)(fr * bi + fi * br); } }
        for (int i = F.tid; i < 1024; i += 512) { const int p = i >> 6, n = i & 63; cc[i * 2] = inp(F, 22)[((size_t)(d * 32 + g) * 16 + p) * 64 + n]; cc[i * 2 + 1] = inp(F, 23)[((size_t)(d * 32 + g) * 16 + p) * 64 + n]; }
        __syncthreads();
        if (F.tid < 64) { const int n = F.tid; const double m1 = exp(lam[2 * n]), ar = m1 * cos(lam[2 * n + 1]), ai = m1 * sin(lam[2 * n + 1]);
            double pr = 1.0, pim = 0.0;
            for (int e = 0; e <= 64; ++e) { pw[(e * 64 + n) * 2] = (float)pr; pw[(e * 64 + n) * 2 + 1] = (float)pim; const double nr = pr * ar - pim * ai, ni = pr * ai + pim * ar; pr = nr; pim = ni; } }
        __syncthreads();
        { bf16* WF = (bf16*)(ws + WS_WF) + (size_t)g * 256 * 1024;
          for (int i = F.tid; i < 128 * 128; i += 512) { const int row = i >> 7, grp = i & 127, c = row >> 6, n = row & 63, sI = grp >> 1, q0 = (grp & 1) * 8, e = d ? sI : 63 - sI;
              const float pr = pw[(e * 64 + n) * 2], pim = pw[(e * 64 + n) * 2 + 1]; float o[8];
#pragma unroll
              for (int j = 0; j < 8; ++j) { const float br = bb[(n * 16 + q0 + j) * 2], bi = bb[(n * 16 + q0 + j) * 2 + 1]; o[j] = c ? (pr * bi + pim * br) : (pr * br - pim * bi); }
              *(GAS v4u*)(WF + (size_t)(d * 128 + row) * 1024 + sI * 16 + q0) = pack8(o); } }
        { bf16* WC = (bf16*)(ws + WS_WC) + (size_t)g * 1024 * 256;
          for (int i = F.tid; i < 1024 * 16; i += 512) { const int row = i >> 4, grp = i & 15, t = row >> 4, p = row & 15, c = grp >> 3, n0 = (grp & 7) * 8, ex = d ? 64 - t : t + 1; float o[8];
#pragma unroll
              for (int j = 0; j < 8; ++j) { const int n = n0 + j; const float pr = pw[(ex * 64 + n) * 2], pim = pw[(ex * 64 + n) * 2 + 1], cr = cc[(p * 64 + n) * 2], ci = cc[(p * 64 + n) * 2 + 1];
                  o[j] = c ? -(cr * pim + ci * pr) : (cr * pr - ci * pim); }
              *(GAS v4u*)(WC + (size_t)row * 256 + d * 128 + c * 64 + n0) = pack8(o); } }
        { bf16* TP = (bf16*)(ws + WS_TOEP) + (size_t)g * 127 * 256; float* T0 = (float*)(ws + WS_T0) + (size_t)(g * 2 + d) * 256;
          for (int i = F.tid; i < 64 * 16; i += 512) { const int tau = i >> 4, p = i & 15; float acc[16];
#pragma unroll
              for (int q = 0; q < 16; ++q) acc[q] = 0.f;
              for (int n = 0; n < 64; ++n) { const float pr = pw[(tau * 64 + n) * 2], pim = pw[(tau * 64 + n) * 2 + 1], cr = cc[(p * 64 + n) * 2], ci = cc[(p * 64 + n) * 2 + 1];
                  const float tr = cr * pr - ci * pim, ti = cr * pim + ci * pr;
                  const LAS f32x4* bq = (const LAS f32x4*)(bb + n * 32);
#pragma unroll
                  for (int q4 = 0; q4 < 8; ++q4) { const f32x4 v = bq[q4]; acc[2 * q4] += tr * v.x - ti * v.y; acc[2 * q4 + 1] += tr * v.z - ti * v.w; } }
              if (tau == 0) {
#pragma unroll
                  for (int q = 0; q < 16; ++q) T0[p * 16 + q] = acc[q]; }
              else { bf16* o = TP + (size_t)(d ? 63 - tau : 63 + tau) * 256 + p * 16; *(GAS v4u*)o = pack8(acc); *(GAS v4u*)(o + 8) = pack8(acc + 8); } } }
        if (F.tid < 64) { float* A64 = (float*)(ws + WS_A64) + (size_t)((g * 2 + d) * 64 + F.tid) * 2; A64[0] = pw[(64 * 64 + F.tid) * 2]; A64[1] = pw[(64 * 64 + F.tid) * 2 + 1]; }
    }
    __syncthreads();
}
__device__ __forceinline__ void ph_s5_finals(Frame& F) {
    const int lane = F.lane, r32 = lane & 31, hh = lane >> 5, wave = F.wave;
    unsigned char* ws = ws_(F);
    for (int u = blockIdx.x; u < 288; u += F.G) {
        const int g = u / 9, nb = u % 9; int chunk = nb * 32 + r32; const bool valid = chunk < NCH; if (!valid) chunk = NCH - 1;
        const bf16* ub = (const bf16*)(ws + WS_UG) + ((size_t)g * TT + (size_t)chunk * 64) * 16 + 8 * hh;
        const bf16* wf = (const bf16*)(ws + WS_WF) + ((size_t)(g * 256 + 32 * wave + r32)) * 1024 + 8 * hh;
        f32x16 acc;
#pragma unroll
        for (int r = 0; r < 16; ++r) acc[r] = 0.f;
#pragma unroll 16
        for (int sI = 0; sI < 64; ++sI) { const bf16x8_t a = *(const GAS bf16x8_t*)(wf + 16 * sI), b = *(const GAS bf16x8_t*)(ub + 16 * sI); acc = __builtin_amdgcn_mfma_f32_32x32x16_bf16(a, b, acc, 0, 0, 0); }
        if (valid) { float* fo = (float*)(ws + WS_FIN) + ((size_t)g * NCH + chunk) * 256 + 32 * wave + 4 * hh;
#pragma unroll
            for (int k = 0; k < 4; ++k) *(GAS f32x4*)(fo + 8 * k) = (f32x4){acc[4 * k], acc[4 * k + 1], acc[4 * k + 2], acc[4 * k + 3]}; }
    }
}
__device__ __forceinline__ int s5_chunk_of(int step, int d, int b) { return step < 4 ? 256 + 4 * b + (d ? 3 - step : step) : 128 * b + (d ? 127 - (step - 4) : step - 4); }
__device__ __forceinline__ void ph_s5_carry(Frame& F) {
    if (F.wave >= 3) return;
    unsigned char* ws = ws_(F);
    for (int item = ((int)F.G - 1 - (int)blockIdx.x) * 3 + F.wave; item < 128; item += 3 * F.G) {
        const int g = item >> 2, d = (item >> 1) & 1, b = item & 1, n = F.lane;
        const float a_r = ((const float*)(ws + WS_A64))[((g * 2 + d) * 64 + n) * 2], a_i = ((const float*)(ws + WS_A64))[((g * 2 + d) * 64 + n) * 2 + 1];
        const float* Fb = (const float*)(ws + WS_FIN) + (size_t)g * NCH * 256 + d * 128 + n; bf16* Sb = (bf16*)(ws + WS_SIN) + (size_t)g * NCH * 256 + d * 128 + n;
        float sr = 0.f, si = 0.f;
        for (int s0 = 0; s0 < 132; s0 += 12) {
            float fr[12], fi[12];
#pragma unroll
            for (int j = 0; j < 12; ++j) { const int c = s5_chunk_of(s0 + j, d, b); fr[j] = Fb[(size_t)c * 256]; fi[j] = Fb[(size_t)c * 256 + 64]; }
#pragma unroll
            for (int j = 0; j < 12; ++j) { const int c = s5_chunk_of(s0 + j, d, b); Sb[(size_t)c * 256] = (bf16)f2bf(sr); Sb[(size_t)c * 256 + 64] = (bf16)f2bf(si);
                const float nr = a_r * sr - a_i * si + fr[j], ni = a_r * si + a_i * sr + fi[j]; sr = nr; si = ni; }
        }
    }
}
constexpr int TP_PITCH = 48;
__device__ __forceinline__ void ph_s5_out(Frame& F) {
    LAS unsigned char* L = F.lds + RING_OFF;
    const int lane = F.lane, r32 = lane & 31, hh = lane >> 5, wave = F.wave, tid = F.tid;
    unsigned char* ws = ws_(F);
    for (int u = blockIdx.x; u < 288; u += F.G) {
        const int g = u / 9, nb = u % 9; int chunk = nb * 32 + r32; const bool valid = chunk < NCH; if (!valid) chunk = NCH - 1;
        __syncthreads();
        { const GAS v4u* tp = (const GAS v4u*)((const bf16*)(ws + WS_TOEP) + (size_t)g * 127 * 256); const float* t0 = (const float*)(ws + WS_T0) + (size_t)g * 512;
          for (int c = tid; c < 127 * 32; c += 512) { const int di = c >> 5, p = (c >> 1) & 15, half = c & 1; v4u v;
              if (di == 63) { float o[8];
#pragma unroll
                  for (int j = 0; j < 8; ++j) o[j] = t0[p * 16 + half * 8 + j] + t0[256 + p * 16 + half * 8 + j];
                  v = pack8(o); }
              else v = tp[c];
              *(LAS v4u*)(L + (di * 16 + p) * TP_PITCH + half * 16) = v; } }
        __syncthreads();
        const bf16* ub = (const bf16*)(ws + WS_UG) + ((size_t)g * TT + (size_t)chunk * 64) * 16 + 8 * hh;
        f32x16 acc[4];
#pragma unroll
        for (int i = 0; i < 4; ++i)
#pragma unroll
            for (int r = 0; r < 16; ++r) acc[i][r] = 0.f;
        const LAS unsigned char* tl = L + ((63 + 2 * wave + (r32 >> 4)) * 16 + (r32 & 15)) * TP_PITCH + hh * 16;
#pragma unroll 1
        for (int s0 = 0; s0 < 64; s0 += 16) {
            bf16x8_t bq[16];
#pragma unroll
            for (int e = 0; e < 16; ++e) bq[e] = *(const GAS bf16x8_t*)(ub + 16 * (s0 + e));
#pragma unroll
            for (int e = 0; e < 16; ++e) { const int sI = s0 + e; const bf16x8_t b = bq[e];
#pragma unroll
            for (int i = 0; i < 4; ++i) { const bf16x8_t a = *(const LAS bf16x8_t*)(tl + (16 * i - sI) * 16 * TP_PITCH); acc[i] = __builtin_amdgcn_mfma_f32_32x32x16_bf16(a, b, acc[i], 0, 0, 0); }
            }
        }
        { const bf16* sb = (const bf16*)(ws + WS_SIN) + ((size_t)g * NCH + chunk) * 256 + 8 * hh;
          const bf16* wc = (const bf16*)(ws + WS_WC) + ((size_t)g * 1024 + 32 * wave + r32) * 256 + 8 * hh;
#pragma unroll 4
          for (int kk = 0; kk < 16; ++kk) {
              const bf16x8_t b = *(const GAS bf16x8_t*)(sb + 16 * kk);
#pragma unroll
              for (int i = 0; i < 4; ++i) { const bf16x8_t a = *(const GAS bf16x8_t*)(wc + (size_t)(256 * i) * 256 + 16 * kk); acc[i] = __builtin_amdgcn_mfma_f32_32x32x16_bf16(a, b, acc[i], 0, 0, 0); }
          } }
        if (valid) {
            const float* dsk = inp(F, 24) + 16 * g;
#pragma unroll
            for (int i = 0; i < 4; ++i)
#pragma unroll
                for (int k = 0; k < 4; ++k) { const int tloc = 2 * (wave + 8 * i) + (k >> 1), p0 = 8 * (k & 1) + 4 * hh; const size_t m = (size_t)chunk * 64 + tloc;
                    const v2u uw = *(const GAS v2u*)((const bf16*)(ws + WS_UG) + ((size_t)g * TT + m) * 16 + p0);
                    const float y0 = gelu_tanh(acc[i][4 * k] + dsk[p0] * bflo(uw.x)), y1 = gelu_tanh(acc[i][4 * k + 1] + dsk[p0 + 1] * bfhi(uw.x));
                    const float y2 = gelu_tanh(acc[i][4 * k + 2] + dsk[p0 + 2] * bflo(uw.y)), y3 = gelu_tanh(acc[i][4 * k + 3] + dsk[p0 + 3] * bfhi(uw.y));
                    v2u zw; zw.x = pk2(y0, y1); zw.y = pk2(y2, y3);
                    *(GAS v2u*)((bf16*)(ws + WS_Z) + m * 512 + 16 * g + p0) = zw; }
        }
    }
}

__device__ __forceinline__ bf16x8_t pack_frag(const f32x16& p, int base) {
    v4u w; w.x = pg8::cvt_pk_bf16(p[base + 0], p[base + 1]); w.y = pg8::cvt_pk_bf16(p[base + 2], p[base + 3]); w.z = pg8::cvt_pk_bf16(p[base + 4], p[base + 5]); w.w = pg8::cvt_pk_bf16(p[base + 6], p[base + 7]);
    return __builtin_bit_cast(bf16x8_t, w);
}
constexpr int AT_KP = 208, AT_VP = 272;
constexpr int AT_KB = 128 * AT_KP, AT_VB = 64 * AT_VP;
constexpr int AT_K0 = 0, AT_V0 = 2 * AT_KB, AT_WS = 2 * AT_KB + 2 * AT_VB;
__device__ __forceinline__ void ph_attn(Frame& F) {
    LAS unsigned char* L = F.lds + RING_OFF;
    const int lane = F.lane, r32 = lane & 31, hi = lane >> 5, wave = F.wave, tid = F.tid;
    volatile LAS float* wsf = (volatile LAS float*)(L + AT_WS) + wave * 32;
    const bf16* Qb = (const bf16*)(ws_(F) + WS_QB); const bf16* Kb = (const bf16*)(ws_(F) + WS_KB); const bf16* Vt = (const bf16*)(ws_(F) + WS_VB);
    bf16* MIX = (bf16*)(ws_(F) + WS_MIX);
    int kl[3], vl[2];
#pragma unroll
    for (int i = 0; i < 3; ++i) { const int c = tid + 512 * i; kl[i] = (c / 12) * AT_KP + (c % 12) * 16; }
#pragma unroll
    for (int i = 0; i < 2; ++i) { const int c = tid + 512 * i; vl[i] = ((c & 511) >> 3) * AT_VP + (c >> 9) * 128 + (c & 7) * 16; }
    for (int it = 0; it < 3; ++it) {
        int u; if (it < 2) u = it * 256 + F.vcu; else { if (F.vcu >= 16) break; u = 512 + F.vcu; }
        int b, h, tq0, NT, m0;
        if (u < 512) { b = u >> 8; h = (u >> 5) & 7; tq0 = (u & 31) * 256; NT = TQK / 128; m0 = b * SEQ + tq0; }
        else { const int uc = u - 512; b = uc >> 3; h = uc & 7; tq0 = SEQ; NT = CTXL / 128; m0 = TL + b * CTXL; }
        const size_t bh = (size_t)(b * 8 + h);
        const GAS v4u* Kg = (const GAS v4u*)(Kb + bh * TQK * 96);
        const GAS v4u* Vg = (const GAS v4u*)(Vt + bh * (TQK / 64) * 4096);
        bf16x8_t qf[6];
        { const bf16* qp = Qb + (bh * TQK + tq0 + wave * 32 + r32) * 96 + hi * 8;
#pragma unroll
          for (int ks = 0; ks < 6; ++ks) qf[ks] = *(const GAS bf16x8_t*)(qp + ks * 16); }
        f32x16 o0, o1;
#pragma unroll
        for (int r = 0; r < 16; ++r) { o0[r] = 0.f; o1[r] = 0.f; }
        float m_run = -1e30f, l_run = 0.f;
        __syncthreads();
        { v4u a[3], v[2];
#pragma unroll
          for (int i = 0; i < 3; ++i) a[i] = Kg[tid + 512 * i];
#pragma unroll
          for (int i = 0; i < 2; ++i) v[i] = Vg[tid + 512 * i];
#pragma unroll
          for (int i = 0; i < 3; ++i) *(LAS v4u*)(L + AT_K0 + kl[i]) = a[i];
#pragma unroll
          for (int i = 0; i < 2; ++i) *(LAS v4u*)(L + AT_V0 + vl[i]) = v[i]; }
        __syncthreads();
        for (int t = 0; t < NT; ++t) {
            const int cur = t & 1, nxt = cur ^ 1; const bool more = (t + 1 < NT);
            v4u na[3], nv[2];
#pragma unroll
            for (int i = 0; i < 3; ++i) na[i] = (v4u){0u, 0u, 0u, 0u};
#pragma unroll
            for (int i = 0; i < 2; ++i) nv[i] = (v4u){0u, 0u, 0u, 0u};
            if (more) {
#pragma unroll
                for (int i = 0; i < 3; ++i) na[i] = Kg[(size_t)(t + 1) * 1536 + tid + 512 * i];
#pragma unroll
                for (int i = 0; i < 2; ++i) nv[i] = Vg[(size_t)(t + 1) * 1024 + tid + 512 * i]; }
            const LAS unsigned char* Kl = L + AT_K0 + cur * AT_KB + r32 * AT_KP + hi * 16;
            const LAS unsigned char* Vl = L + AT_V0 + cur * AT_VB + r32 * AT_VP + hi * 16;
            f32x16 p[4];
#pragma unroll
            for (int kb = 0; kb < 4; ++kb) {
#pragma unroll
                for (int r = 0; r < 16; ++r) p[kb][r] = 0.f;
#pragma unroll
                for (int ks = 0; ks < 6; ++ks) p[kb] = __builtin_amdgcn_mfma_f32_32x32x16_bf16(*(const LAS bf16x8_t*)(Kl + kb * 32 * AT_KP + ks * 32), qf[ks], p[kb], 0, 0, 0);
            }
            float mt = fmaxf(fmaxf(p[0][0], p[1][0]), fmaxf(p[2][0], p[3][0]));
#pragma unroll
            for (int r = 1; r < 16; ++r) mt = fmaxf(mt, fmaxf(fmaxf(p[0][r], p[1][r]), fmaxf(p[2][r], p[3][r])));
            mt = fmaxf(mt, __shfl_xor(mt, 32));
            const bool need = mt > m_run + 8.0f;
            if (__any(need)) {
                const float mn = need ? mt : m_run, alpha = __builtin_amdgcn_exp2f(m_run - mn);
                l_run *= alpha; m_run = mn;
                if (hi == 0) wsf[r32] = alpha;
#pragma unroll
                for (int r = 0; r < 16; ++r) { const float a = wsf[crow(r, hi)]; o0[r] *= a; o1[r] *= a; }
            }
            float sum = 0.f;
#pragma unroll
            for (int kb = 0; kb < 4; ++kb)
#pragma unroll
                for (int r = 0; r < 16; ++r) { p[kb][r] = __builtin_amdgcn_exp2f(p[kb][r] - m_run); sum += p[kb][r]; }
            l_run += sum;
#pragma unroll
            for (int kb = 0; kb < 4; ++kb) {
                const bf16x8_t pa = pack_frag(p[kb], 0), pb = pack_frag(p[kb], 8);
                const LAS unsigned char* vp = Vl + (kb >> 1) * 128 + (kb & 1) * 64;
                o0 = __builtin_amdgcn_mfma_f32_32x32x16_bf16(pa, *(const LAS bf16x8_t*)(vp), o0, 0, 0, 0);
                o0 = __builtin_amdgcn_mfma_f32_32x32x16_bf16(pb, *(const LAS bf16x8_t*)(vp + 32), o0, 0, 0, 0);
                o1 = __builtin_amdgcn_mfma_f32_32x32x16_bf16(pa, *(const LAS bf16x8_t*)(vp + 32 * AT_VP), o1, 0, 0, 0);
                o1 = __builtin_amdgcn_mfma_f32_32x32x16_bf16(pb, *(const LAS bf16x8_t*)(vp + 32 * AT_VP + 32), o1, 0, 0, 0);
            }
            if (more) {
#pragma unroll
                for (int i = 0; i < 3; ++i) *(LAS v4u*)(L + AT_K0 + nxt * AT_KB + kl[i]) = na[i];
#pragma unroll
                for (int i = 0; i < 2; ++i) *(LAS v4u*)(L + AT_V0 + nxt * AT_VB + vl[i]) = nv[i]; }
            __syncthreads();
        }
        l_run += __shfl_xor(l_run, 32);
        if (hi == 0) wsf[r32] = 1.0f / l_run;
#pragma unroll
        for (int r = 0; r < 16; ++r) { const int q = crow(r, hi); const float inv = wsf[q];
            bf16* op = MIX + (size_t)(m0 + wave * 32 + q) * D + h * 64 + r32;
            op[0] = (bf16)f2bf(o0[r] * inv); op[32] = (bf16)f2bf(o1[r] * inv); }
    }
}

constexpr int HG_QT = 0, HG_KT = 17408, HG_KH = 34816, HG_VT = 53248, HG_ST = 71680, HG_DEC = 106496, HG_TOT = 107008;
constexpr int HG_NSC = 17;
constexpr size_t WS_SD = 231 * MiB;
constexpr size_t WS_DECS = WS_SD + 18 * MiB;
static_assert(WS_DECS + 32 * 17 * 128 * 4 <= WS_END, "hgrn ws");
template <bool OUT>
__device__ __forceinline__ void hgrn_pass(Frame& F, int b, int h, int dir, int sc, f32x16 (&st)[2], float& dsum) {
    LAS unsigned char* L = F.lds + RING_OFF;
    unsigned char* ws = ws_(F);
    const int tid = F.tid, lane = F.lane, r32 = lane & 31, hh = lane >> 5, wave = F.wave;
    const int k = tid & 127, tg = tid >> 7;
    const int nch = sc == 0 ? 4 : 8; const size_t rowbase = sc == 0 ? (size_t)TL + b * CTXL : (size_t)b * SEQ + (size_t)(sc - 1) * 512;
    const bf16* QF = (const bf16*)(ws + WS_QFFI);
    const float lb = ((const float*)(ws + WS_LBV))[dir * 1024 + h * 128 + k];
    const int colf = 1024 * (1 + dir) + h * 128 + k, colq = h * 128 + k, colv = 3072 + h * 128 + k;
    const int dvb = wave & 3, jb = wave >> 2;
    bf16 rq[16], rf[16], rv[16];
#define HG_LOAD(ci) do { const int cc_ = dir ? nch - 1 - (ci) : (ci); const int tl0_ = dir ? 63 - 16 * tg : 16 * tg; \
        const GAS bf16* pf_ = (const GAS bf16*)(QF + (rowbase + 64 * cc_ + tl0_) * 4096 + colf); const GAS bf16* pv_ = pf_ + (colv - colf); const GAS bf16* pq_ = pf_ + (colq - colf); const long stp_ = dir ? -4096 : 4096; \
        _Pragma("unroll") for (int jj = 0; jj < 16; ++jj) { rf[jj] = *pf_; rv[jj] = *pv_; if (OUT) rq[jj] = *pq_; pf_ += stp_; pv_ += stp_; pq_ += stp_; asm volatile("" : "+v"(pf_), "+v"(pv_), "+v"(pq_)); } } while (0)
    HG_LOAD(0);
    for (int ci = 0; ci < nch; ++ci) {
        const int cc = dir ? nch - 1 - ci : ci;
        float cum[16], kk[16];
        { float run = 0.f;
#pragma unroll
          for (int jj = 0; jj < 16; ++jj) { const float f = lb + (1.f - lb) * sigmoidf_(bf2f(rf[jj])); run += __log2f(f); cum[jj] = run; kk[jj] = 1.f - f; }
          ((LAS float*)(L + HG_TOT))[tg * 128 + k] = run; }
        __syncthreads();
        { const LAS float* tot = (const LAS float*)(L + HG_TOT) + k; const float t0 = tot[0], t1 = tot[128], t2 = tot[256], t3 = tot[384];
          const float pre = tg == 0 ? 0.f : (tg == 1 ? t0 : (tg == 2 ? t0 + t1 : t0 + t1 + t2)), total = (t0 + t1) + (t2 + t3);
          if (tg == 0) { ((LAS float*)(L + HG_DEC))[k] = __builtin_amdgcn_exp2f(total); dsum += total; }
#define HG_KH(jj) (kk[jj] * __builtin_amdgcn_exp2f(total - (pre + cum[jj])))
#define HG_PKV(a, b_) ((unsigned)rv[a] | ((unsigned)rv[b_] << 16))
          if (OUT) {
#pragma unroll
              for (int jj = 0; jj < 16; ++jj) { const float c = pre + cum[jj]; const int j = 16 * tg + jj;
                  *(LAS bf16*)(L + HG_QT + j * 272 + k * 2) = (bf16)f2bf(bf2f(rq[jj]) * __builtin_amdgcn_exp2f(c)); *(LAS bf16*)(L + HG_KT + j * 272 + k * 2) = (bf16)f2bf(kk[jj] * __builtin_amdgcn_exp2f(-c)); } }
          v4u w0, w1;
          w0.x = pk2(HG_KH(0), HG_KH(1)); w0.y = pk2(HG_KH(2), HG_KH(3)); w0.z = pk2(HG_KH(8), HG_KH(9)); w0.w = pk2(HG_KH(10), HG_KH(11));
          w1.x = pk2(HG_KH(4), HG_KH(5)); w1.y = pk2(HG_KH(6), HG_KH(7)); w1.z = pk2(HG_KH(12), HG_KH(13)); w1.w = pk2(HG_KH(14), HG_KH(15));
          *(LAS v4u*)(L + HG_KH + k * 144 + tg * 32) = w0; *(LAS v4u*)(L + HG_KH + k * 144 + tg * 32 + 16) = w1;
          w0.x = HG_PKV(0, 1); w0.y = HG_PKV(2, 3); w0.z = HG_PKV(8, 9); w0.w = HG_PKV(10, 11);
          w1.x = HG_PKV(4, 5); w1.y = HG_PKV(6, 7); w1.z = HG_PKV(12, 13); w1.w = HG_PKV(14, 15);
          *(LAS v4u*)(L + HG_VT + k * 144 + tg * 32) = w0; *(LAS v4u*)(L + HG_VT + k * 144 + tg * 32 + 16) = w1; }
#undef HG_KH
#undef HG_PKV
        if (ci + 1 < nch) HG_LOAD(ci + 1);
        __syncthreads();
        if (OUT) {
            f32x16 oacc;
#pragma unroll
            for (int r = 0; r < 16; ++r) oacc[r] = 0.f;
            const LAS unsigned char* qrow = L + HG_QT + (32 * jb + r32) * 272 + hh * 16;
            const LAS unsigned char* srow = L + HG_ST + (32 * dvb + r32) * 272 + hh * 16;
            const LAS unsigned char* vrow = L + HG_VT + (32 * dvb + r32) * 144 + hh * 16;
#pragma unroll
            for (int ks = 0; ks < 8; ++ks) oacc = __builtin_amdgcn_mfma_f32_32x32x16_bf16(*(const LAS bf16x8_t*)(qrow + ks * 32), *(const LAS bf16x8_t*)(srow + ks * 32), oacc, 0, 0, 0);
            {
                f32x16 at;
#pragma unroll
                for (int r = 0; r < 16; ++r) at[r] = 0.f;
                const LAS unsigned char* krow = L + HG_KT + r32 * 272 + hh * 16;
#pragma unroll
                for (int ks = 0; ks < 8; ++ks) at = __builtin_amdgcn_mfma_f32_32x32x16_bf16(*(const LAS bf16x8_t*)(krow + ks * 32), *(const LAS bf16x8_t*)(qrow + ks * 32), at, 0, 0, 0);
                if (jb == 0) {
#pragma unroll
                    for (int r = 0; r < 16; ++r) if (crow(r, hh) > r32) at[r] = 0.f; }
                oacc = __builtin_amdgcn_mfma_f32_32x32x16_bf16(pack_frag(at, 0), *(const LAS bf16x8_t*)(vrow + 0), oacc, 0, 0, 0);
                oacc = __builtin_amdgcn_mfma_f32_32x32x16_bf16(pack_frag(at, 8), *(const LAS bf16x8_t*)(vrow + 32), oacc, 0, 0, 0);
            }
            if (jb == 1) {
                f32x16 at;
#pragma unroll
                for (int r = 0; r < 16; ++r) at[r] = 0.f;
                const LAS unsigned char* krow = L + HG_KT + (32 + r32) * 272 + hh * 16;
#pragma unroll
                for (int ks = 0; ks < 8; ++ks) at = __builtin_amdgcn_mfma_f32_32x32x16_bf16(*(const LAS bf16x8_t*)(krow + ks * 32), *(const LAS bf16x8_t*)(qrow + ks * 32), at, 0, 0, 0);
#pragma unroll
                for (int r = 0; r < 16; ++r) if (crow(r, hh) > r32) at[r] = 0.f;
                oacc = __builtin_amdgcn_mfma_f32_32x32x16_bf16(pack_frag(at, 0), *(const LAS bf16x8_t*)(vrow + 64), oacc, 0, 0, 0);
                oacc = __builtin_amdgcn_mfma_f32_32x32x16_bf16(pack_frag(at, 8), *(const LAS bf16x8_t*)(vrow + 96), oacc, 0, 0, 0);
            }
            bf16* O = (bf16*)(ws + WS_O);
#pragma unroll
            for (int r = 0; r < 16; ++r) { const int j = 32 * jb + crow(r, hh), tl = dir ? 63 - j : j;
                bf16* op = O + (rowbase + 64 * cc + tl) * D + h * 128 + 32 * dvb + r32; float ov = oacc[r];
                if (dir) ov += bf2f(*op);
                *op = (bf16)f2bf(ov); }
        }
#pragma unroll
        for (int t = 0; t < 2; ++t) { const int dkb = 2 * (wave >> 2) + t;
#pragma unroll
            for (int q4 = 0; q4 < 4; ++q4) { const f32x4 dd = *(const LAS f32x4*)(L + HG_DEC + (32 * dkb + 8 * q4 + 4 * hh) * 4);
                st[t][4 * q4] *= dd[0]; st[t][4 * q4 + 1] *= dd[1]; st[t][4 * q4 + 2] *= dd[2]; st[t][4 * q4 + 3] *= dd[3]; }
            const LAS unsigned char* arow = L + HG_KH + (32 * dkb + r32) * 144 + hh * 16; const LAS unsigned char* vrow = L + HG_VT + (32 * dvb + r32) * 144 + hh * 16;
#pragma unroll
            for (int ks = 0; ks < 4; ++ks) st[t] = __builtin_amdgcn_mfma_f32_32x32x16_bf16(*(const LAS bf16x8_t*)(arow + ks * 32), *(const LAS bf16x8_t*)(vrow + ks * 32), st[t], 0, 0, 0); }
        __syncthreads();
        if (OUT && ci + 1 < nch) {
#pragma unroll
            for (int t = 0; t < 2; ++t) { const int dkb = 2 * (wave >> 2) + t;
#pragma unroll
                for (int q4 = 0; q4 < 4; ++q4) { v2u w; w.x = pk2(st[t][4 * q4], st[t][4 * q4 + 1]); w.y = pk2(st[t][4 * q4 + 2], st[t][4 * q4 + 3]);
                    *(LAS v2u*)(L + HG_ST + (32 * dvb + r32) * 272 + (32 * dkb + 8 * q4 + 4 * hh) * 2) = w; } }
        }
    }
#undef HG_LOAD
}
__device__ __forceinline__ void ph_hgrn_states(Frame& F) {
    unsigned char* ws = ws_(F);
    for (int item = blockIdx.x; item < 32 * HG_NSC; item += F.G) {
        const int chain = item / HG_NSC, sc = item % HG_NSC, b = chain >> 4, h = (chain >> 1) & 7, dir = chain & 1;
        f32x16 st[2];
#pragma unroll
        for (int t = 0; t < 2; ++t)
#pragma unroll
            for (int r = 0; r < 16; ++r) st[t][r] = 0.f;
        float dsum = 0.f;
        hgrn_pass<false>(F, b, h, dir, sc, st, dsum);
        bf16* sd = (bf16*)(ws + WS_SD) + ((size_t)(chain * HG_NSC + sc) * 8 + F.wave) * 2048 + F.lane;
#pragma unroll
        for (int t = 0; t < 2; ++t)
#pragma unroll
            for (int r = 0; r < 16; ++r) sd[(t * 16 + r) * 64] = (bf16)f2bf(st[t][r]);
        if (F.tid < 128) ((float*)(ws + WS_DECS))[(size_t)(chain * HG_NSC + sc) * 128 + F.tid] = dsum;
    }
}
__device__ __forceinline__ void ph_hgrn_out(Frame& F) {
    LAS unsigned char* L = F.lds + RING_OFF;
    unsigned char* ws = ws_(F);
    const int lane = F.lane, r32 = lane & 31, hh = lane >> 5, wave = F.wave, dvb = wave & 3;
    for (int item = blockIdx.x; item < 256; item += F.G) {
        const int b = item >> 7, h = (item >> 4) & 7, Lsc = item & 15, sc = Lsc + 1;
        for (int dir = 0; dir < 2; ++dir) {
            const int chain = (b * 8 + h) * 2 + dir;
            f32x16 st[2];
#pragma unroll
            for (int t = 0; t < 2; ++t)
#pragma unroll
                for (int r = 0; r < 16; ++r) st[t][r] = 0.f;
            const int npre = dir ? 1 + (16 - sc) : sc;
            for (int i = 0; i < npre; ++i) {
                const int sp = (i == 0) ? 0 : (dir ? 17 - i : i);
                const bf16* sd = (const bf16*)(ws + WS_SD) + ((size_t)(chain * HG_NSC + sp) * 8 + wave) * 2048 + lane;
                const float* dl = (const float*)(ws + WS_DECS) + (size_t)(chain * HG_NSC + sp) * 128;
#pragma unroll
                for (int t = 0; t < 2; ++t) { const int dkb = 2 * (wave >> 2) + t;
#pragma unroll
                    for (int q4 = 0; q4 < 4; ++q4) { const f32x4 dd = *(const GAS f32x4*)(dl + 32 * dkb + 8 * q4 + 4 * hh);
#pragma unroll
                        for (int e = 0; e < 4; ++e) st[t][4 * q4 + e] = __builtin_amdgcn_exp2f(dd[e]) * st[t][4 * q4 + e] + bf2f(sd[(t * 16 + 4 * q4 + e) * 64]); } }
            }
            __syncthreads();
#pragma unroll
            for (int t = 0; t < 2; ++t) { const int dkb = 2 * (wave >> 2) + t;
#pragma unroll
                for (int q4 = 0; q4 < 4; ++q4) { v2u w; w.x = pk2(st[t][4 * q4], st[t][4 * q4 + 1]); w.y = pk2(st[t][4 * q4 + 2], st[t][4 * q4 + 3]);
                    *(LAS v2u*)(L + HG_ST + (32 * dvb + r32) * 272 + (32 * dkb + 8 * q4 + 4 * hh) * 2) = w; } }
            float dsum = 0.f;
            hgrn_pass<true>(F, b, h, dir, sc, st, dsum);
            __syncthreads();
        }
    }
}

struct FInProj {
    bf16* cqkv; bf16* ug;
    __device__ __forceinline__ void operator()(int row, int col, f32x4 v0, f32x4 v1) const {
        v4u w; w.x = pg8::cvt_pk_bf16(v0[0], v0[1]); w.y = pg8::cvt_pk_bf16(v0[2], v0[3]); w.z = pg8::cvt_pk_bf16(v1[0], v1[1]); w.w = pg8::cvt_pk_bf16(v1[2], v1[3]);
        if (col < 672) *(GAS v4u*)(cqkv + (size_t)row * CQKV_LD + col) = w;
        else if (col < EVEN_IN) { const int c = col - 672; *(GAS v4u*)(ug + ((size_t)(c >> 4) * TT + row) * 16 + (c & 15)) = w; }
    }
};
struct FBf16 {
    bf16* o; int ld;
    __device__ __forceinline__ void operator()(int row, int col, f32x4 v0, f32x4 v1) const {
        v4u w; w.x = pg8::cvt_pk_bf16(v0[0], v0[1]); w.y = pg8::cvt_pk_bf16(v0[2], v0[3]); w.z = pg8::cvt_pk_bf16(v1[0], v1[1]); w.w = pg8::cvt_pk_bf16(v1[2], v1[3]);
        *(GAS v4u*)(o + (size_t)row * ld + col) = w;
    }
};
struct FGlu {
    const bf16* z; bf16* mix;
    __device__ __forceinline__ void operator()(int row, int col, f32x4 v0, f32x4 v1) const {
        float zz[8]; unpack8(*(const GAS v4u*)(z + (size_t)row * 512 + col), zz);
        float o[8];
#pragma unroll
        for (int j = 0; j < 4; ++j) { o[j] = zz[j] * sigmoidf_(v0[j]); o[4 + j] = zz[4 + j] * sigmoidf_(v1[j]); }
        *(GAS v4u*)(mix + (size_t)row * D + 512 + col) = pack8(o);
    }
};
struct FQ {
    bf16* qb; const float* rope;
    __device__ __forceinline__ void operator()(int row, int col, f32x4 v0, f32x4 v1) const {
        float x[8] = {v0[0], v0[1], v0[2], v0[3], v1[0], v1[1], v1[2], v1[3]}, p[8];
#pragma unroll
        for (int j = 0; j < 8; ++j) p[j] = __shfl_xor(x[j], 16);
        const bool isctx = row >= TL; const int b = isctx ? ((row - TL) >> 8) : (row >> 13), t = isctx ? ((row - TL) & 255) : (row & 8191), tq = isctx ? SEQ + t : t;
        const int h = col / 96, d = col - h * 96;
        if (d >= 64 && !isctx) { const int idx = d - 64, a = idx >> 4, half = (idx >> 3) & 1, pos = a ? (t & 63) : (t >> 6);
#pragma unroll
            for (int f = 0; f < 8; ++f) { const float cs = rope[2 * (pos * 8 + f)], sn = rope[2 * (pos * 8 + f) + 1]; x[f] = half ? x[f] * cs + p[f] * sn : x[f] * cs - p[f] * sn; } }
#pragma unroll
        for (int j = 0; j < 8; ++j) x[j] *= QSCALE;
        *(GAS v4u*)(qb + ((size_t)(b * 8 + h) * TQK + tq) * 96 + d) = pack8(x);
        asm volatile("" ::: "memory");
    }
};
struct FKV {
    bf16* kb; bf16* vb;
    __device__ __forceinline__ void operator()(int row, int col, f32x4 v0, f32x4 v1) const {
        v4u w; w.x = pg8::cvt_pk_bf16(v0[0], v0[1]); w.y = pg8::cvt_pk_bf16(v0[2], v0[3]); w.z = pg8::cvt_pk_bf16(v1[0], v1[1]); w.w = pg8::cvt_pk_bf16(v1[2], v1[3]);
        const bool isctx = row >= TL; const int b = isctx ? ((row - TL) >> 8) : (row >> 13), t = isctx ? ((row - TL) & 255) : (row & 8191), tk = isctx ? t : CTXL + t;
        const int h = col >> 7, e = col & 127;
        if (e < 64) *(GAS v4u*)(kb + ((size_t)(b * 8 + h) * TQK + tk) * 96 + e) = w;
        else { const int kk = tk & 63, pos = (kk & 48) | (kk & 3) | ((kk & 4) << 1) | ((kk & 8) >> 1);
            bf16* p = vb + (((size_t)(b * 8 + h) * (TQK / 64) + (tk >> 6)) * 64 + (e - 64)) * 64 + pos;
            p[0] = (bf16)(w.x & 0xffffu); p[64] = (bf16)(w.x >> 16); p[128] = (bf16)(w.y & 0xffffu); p[192] = (bf16)(w.y >> 16);
            p[256] = (bf16)(w.z & 0xffffu); p[320] = (bf16)(w.z >> 16); p[384] = (bf16)(w.w & 0xffffu); p[448] = (bf16)(w.w >> 16); }
    }
};
struct EpiResid {
    static constexpr bool PERM = false, AFTER_DRAIN = false;
    float* xl; float* xc; const float* gate; int first; int row_off;
    __device__ __forceinline__ void operator()(const pg8::f32x4 (&acc)[2][2][4][2], const pg8::Unit& u, int wr, int wc, int fr, int fq) const {
        const int trow = u.pm * 256 + row_off, col0 = u.pn * 256 + wc * 32 + 4 * fq;
        const bool lat = trow < TL;
        GAS float* xb = (GAS float*)(lat ? xl + (size_t)trow * D : xc + (size_t)(trow - TL) * D) + (size_t)(wr * 64 + fr) * D + col0;
        const GAS float* gp = (const GAS float*)gate + (size_t)modrow_of(trow) * 6144 + col0;
        f32x4 gv[2][2];
#pragma unroll
        for (int bj = 0; bj < 2; ++bj)
#pragma unroll
            for (int n = 0; n < 2; ++n) gv[bj][n] = *(const GAS f32x4*)(gp + bj * 128 + n * 16);
        const float a0 = (first && lat) ? DN_ALPHA : 1.0f;
#pragma unroll
        for (int ai = 0; ai < 2; ++ai) {
            f32x4 xo[4][2][2];
#pragma unroll
            for (int m = 0; m < 4; ++m)
#pragma unroll
                for (int bj = 0; bj < 2; ++bj)
#pragma unroll
                    for (int n = 0; n < 2; ++n) xo[m][bj][n] = *(const GAS f32x4*)(xb + (size_t)(ai * 128 + m * 16) * D + bj * 128 + n * 16);
#pragma unroll
            for (int m = 0; m < 4; ++m)
#pragma unroll
                for (int bj = 0; bj < 2; ++bj)
#pragma unroll
                    for (int n = 0; n < 2; ++n) *(GAS f32x4*)(xb + (size_t)(ai * 128 + m * 16) * D + bj * 128 + n * 16) = xo[m][bj][n] * a0 + gv[bj][n] * acc[ai][bj][m][n];
            __builtin_amdgcn_sched_barrier(0);
        }
    }
};
struct FHgIn {
    bf16* qffi; bf16* g;
    __device__ __forceinline__ void operator()(int row, int col, f32x4 v0, f32x4 v1) const {
        v4u w; w.x = pg8::cvt_pk_bf16(v0[0], v0[1]); w.y = pg8::cvt_pk_bf16(v0[2], v0[3]); w.z = pg8::cvt_pk_bf16(v1[0], v1[1]); w.w = pg8::cvt_pk_bf16(v1[2], v1[3]);
        if (col < 4096) *(GAS v4u*)(qffi + (size_t)row * 4096 + col) = w; else *(GAS v4u*)(g + (size_t)row * D + (col - 4096)) = w;
    }
};
struct EpiConvGate {
    static constexpr bool PERM = true, AFTER_DRAIN = false;
    bf16* hg; bf16* ab; bf16* gb; const float* cw; const float* cb;
    __device__ __forceinline__ void operator()(const pg8::f32x4 (&acc)[2][2][4][2], const pg8::Unit& u, int wr, int wc, int fr, int fq) const {
        const int hc0 = 128 * u.pn + 32 * wc + 8 * fq;
#pragma unroll
        for (int ai = 0; ai < 2; ++ai) {
            const int rowbase = u.pm * 256 + 128 * ai + 64 * wr, g64 = rowbase >> 6;
#pragma unroll
            for (int n = 0; n < 2; ++n) {
                const int hc = hc0 + 4 * n;
                const f32x4 w0 = *(const GAS f32x4*)(cw + hc), w1 = *(const GAS f32x4*)(cw + FFH + hc), w2 = *(const GAS f32x4*)(cw + 2 * FFH + hc), b0 = *(const GAS f32x4*)(cb + hc);
                float out[4][4];
#pragma unroll
                for (int e = 0; e < 4; ++e) { float a[4], up[4], dn[4], l15[4], l0[4];
#pragma unroll
                    for (int m = 0; m < 4; ++m) { a[m] = acc[ai][0][m][n][e]; up[m] = __shfl_up(a[m], 1, 16); dn[m] = __shfl_down(a[m], 1, 16); l15[m] = __shfl(a[m], 15, 16); l0[m] = __shfl(a[m], 0, 16); }
#pragma unroll
                    for (int m = 0; m < 4; ++m) { const float prev = fr > 0 ? up[m] : (m > 0 ? l15[m > 0 ? m - 1 : 0] : 0.f), next = fr < 15 ? dn[m] : (m < 3 ? l0[m < 3 ? m + 1 : 3] : 0.f);
                        const float cv = b0[e] + w0[e] * prev + w1[e] * a[m] + w2[e] * next; out[m][e] = siluf_(cv) * acc[ai][1][m][n][e]; } }
#pragma unroll
                for (int m = 0; m < 4; ++m) { const int r64 = 16 * m + fr, row = rowbase + r64;
                    if (r64 != 0 && r64 != 63) { v2u w; w.x = pk2(out[m][0], out[m][1]); w.y = pk2(out[m][2], out[m][3]); *(GAS v2u*)(hg + (size_t)row * FFH + hc) = w; }
                    if (r64 <= 1 || r64 >= 62) { const int slot = r64 <= 1 ? r64 : r64 - 60; const f32x4 ra = acc[ai][0][m][n];
                        v2u w; w.x = pk2(ra[0], ra[1]); w.y = pk2(ra[2], ra[3]); *(GAS v2u*)(ab + (size_t)(g64 * 4 + slot) * FFH + hc) = w;
                        if (r64 == 0 || r64 == 63) { const f32x4 rg = acc[ai][1][m][n]; v2u wg; wg.x = pk2(rg[0], rg[1]); wg.y = pk2(rg[2], rg[3]); *(GAS v2u*)(gb + (size_t)(g64 * 2 + (r64 == 63 ? 1 : 0)) * FFH + hc) = wg; } }
                }
                __builtin_amdgcn_sched_barrier(0);
            }
        }
    }
};
template <class E> __device__ __forceinline__ void run_gemm_off(Frame& F, const bf16* A, int lda, const bf16* Bt, int ldb, int M, int N, int K, const E& e, int boff) {
    pg8::Gemm g{A, Bt, M, N, K, lda, ldb}; pg8::StaticOrder S; S.init(M, N, F.G, (int)((blockIdx.x + F.G - boff) % F.G));
    pg8::gemm_phase<E, pg8::StaticOrder, true, true>(F.lds + RING_OFF, g, S, e);
}
template <class E> __device__ __forceinline__ void run_gemm(Frame& F, const bf16* A, int lda, const bf16* Bt, int ldb, int M, int N, int K, const E& e) {
    pg8::Gemm g{A, Bt, M, N, K, lda, ldb}; pg8::StaticOrder S; S.init(M, N, F.G, (int)blockIdx.x);
    pg8::gemm_phase<E, pg8::StaticOrder, true, true>(F.lds + RING_OFF, g, S, e);
}

constexpr int NPH = 26;
struct Args { const float* in[31]; float* out; unsigned char* ws; int ph_lo, ph_hi; };
__global__ void __launch_bounds__(NWAVES * 64, 2) mk_fwd(Args args) {
    extern __shared__ __attribute__((aligned(16))) unsigned char lds[];
    Frame F;
    F.lds = (LAS unsigned char*)lds;
    F.tid = threadIdx.x; F.lane = F.tid & 63; F.wave = __builtin_amdgcn_readfirstlane(F.tid >> 6);
    F.G = gridDim.x; { const int bx = blockIdx.x; F.vcu = (F.G % 8 == 0) ? (bx % 8) * (F.G / 8) + bx / 8 : bx; }
    for (int u = F.tid; u < (LDS_BYTES - LDSCTL_OFF) / 4; u += NWAVES * 64) ((LAS unsigned*)(F.lds + LDSCTL_OFF))[u] = 0u;
    __syncthreads();
    if (F.tid == 0) {
#pragma unroll
        for (int i = 0; i < 31; ++i) ((LAS unsigned long long*)(F.lds + PTR_OFF))[i] = (unsigned long long)args.in[i];
        ((LAS unsigned long long*)(F.lds + PTR_OFF))[31] = (unsigned long long)args.ws; ((LAS unsigned long long*)(F.lds + PTR_OFF))[32] = (unsigned long long)args.out;
    }
    __syncthreads();
    const int lo = args.ph_lo, hi = args.ph_hi;
    const bool multi = (hi - lo) > 1;
    if (multi) (void)xcd_barrier_post((unsigned*)ws_(F) + CW_BAR, (volatile LAS unsigned*)(F.lds + MISC_OFF) + 8);
#ifndef ONLY_PHASE
#define ONLY_PHASE -1
#endif
#define WSP ws_(F)
#define MODP ((const float*)(ws_(F) + WS_MOD))
#define ABUF ((bf16*)(ws_(F) + WS_A))
#ifndef SKIP_PHASE
#define SKIP_PHASE -1
#endif
#define IN(k) ((ONLY_PHASE < 0 || ONLY_PHASE == (k)) && SKIP_PHASE != (k) && lo <= (k) && (k) < hi)
#define SEAM(k) do { if (IN(k) && IN((k) + 1)) { XcdBarrier bar_; bar_.bar = (unsigned*)ws_(F) + CW_BAR; bar_.x = xb_xcc_id(); bar_.st = (volatile LAS unsigned*)(F.lds + MISC_OFF) + 8; xcd_barrier(bar_); } asm volatile("" : "+v"(F.tid), "+v"(F.lane)); } while (0)
    int pk = 0;
#ifndef REPEAT_PHASE
#define REPEAT_PHASE -1
#endif
#define PHASE(...) do { if (IN(pk)) { __VA_ARGS__ } if (REPEAT_PHASE == pk && IN(pk)) { { XcdBarrier bar_; bar_.bar = (unsigned*)ws_(F) + CW_BAR; bar_.x = xb_xcc_id(); bar_.st = (volatile LAS unsigned*)(F.lds + MISC_OFF) + 8; xcd_barrier(bar_); } asm volatile("" : "+v"(F.tid), "+v"(F.lane)); { __VA_ARGS__ } } SEAM(pk); ++pk; } while (0)
    PHASE( p0_prologue(F); p0_s5_tables(F); );
    PHASE( ph_init_rows(F); );
    PHASE( pg8::Epi8<FInProj> e{{(bf16*)(WSP + WS_CQKV), (bf16*)(WSP + WS_UG)}}; run_gemm(F, ABUF, D, (const bf16*)(WSP + WS_WIN0), D, TT, EVEN_IN_PAD, D, e); );
    PHASE( ph_s5_finals(F); );
    PHASE( ph_s5_carry(F); );
    PHASE( ph_mla_norm(F); );
    PHASE(
#ifndef DUPQ
#define DUPQ 1
#endif
#ifndef DUPKV
#define DUPKV 1
#endif
        _Pragma("unroll") for (int rep = 0; rep < DUPQ; ++rep) { pg8::Epi8<FQ> e{{(bf16*)(WSP + WS_QB), (const float*)(WSP + WS_ROPE)}}; run_gemm(F, (const bf16*)(WSP + WS_CQKV), CQKV_LD, (const bf16*)(WSP + WS_WUQ), 384, TT, 768, 384, e); }
        _Pragma("unroll") for (int rep = 0; rep < DUPKV; ++rep) { pg8::Epi8<FKV> e{{(bf16*)(WSP + WS_KB), (bf16*)(WSP + WS_VB)}}; run_gemm(F, (const bf16*)(WSP + WS_CQKV) + 384, CQKV_LD, (const bf16*)(WSP + WS_WUKV), 256, TT, 1024, 256, e); }
    );
    PHASE( ph_s5_out(F); );
    PHASE( ph_attn(F); );
    PHASE( pg8::Epi8<FGlu> e{{(const bf16*)(WSP + WS_Z), (bf16*)(WSP + WS_MIX)}}; run_gemm(F, (const bf16*)(WSP + WS_Z), 512, (const bf16*)(WSP + WS_WGLU), 512, TT, 512, 512, e); );
    PHASE( EpiResid e{out_(F), (float*)(WSP + WS_XC), MODP + 0 * 3 * 6144 + 2 * 1024, 1, 0}; run_gemm(F, (const bf16*)(WSP + WS_MIX), D, (const bf16*)(WSP + WS_WOUT0), D, TT, D, D, e); );
    PHASE( ph_layernorm(F, TT, 0, 0, 0, 3, nullptr, 0); );
    PHASE( EpiConvGate e{(bf16*)(WSP + WS_HG), (bf16*)(WSP + WS_AB), (bf16*)(WSP + WS_GB), inp(F, 9), inp(F, 10)}; run_gemm(F, ABUF, D, (const bf16*)(WSP + WS_F1T0), D, TT, 2 * FFH, D, e); );
    PHASE( ph_convfix(F, TT, 0); );
    PHASE( EpiResid e{out_(F), (float*)(WSP + WS_XC), MODP + 0 * 3 * 6144 + 5 * 1024, 1, 0}; run_gemm(F, (const bf16*)(WSP + WS_HG), FFH, (const bf16*)(WSP + WS_F2T0), FFH, TT, D, FFH, e); );
    PHASE( ph_layernorm(F, TT, 0, 1, 1, 0, nullptr, 0); );
    PHASE( pg8::Epi8<FHgIn> e{{(bf16*)(WSP + WS_QFFI), (bf16*)(WSP + WS_G)}}; run_gemm(F, ABUF, D, (const bf16*)(WSP + WS_HGINT), D, TT, 5120, D, e); );
    PHASE( ph_hgrn_states(F); );
    PHASE( ph_hgrn_out(F); );
    PHASE( ph_hg_gate(F); );
    PHASE( EpiResid e{out_(F), (float*)(WSP + WS_XC), MODP + 1 * 3 * 6144 + 2 * 1024, 1, 0}; run_gemm(F, (const bf16*)(WSP + WS_O), D, (const bf16*)(WSP + WS_HGOUTT), D, TL, D, D, e); );
    PHASE( ph_layernorm(F, TL, 1, 0, 1, 3); );
    PHASE( EpiConvGate e{(bf16*)(WSP + WS_HG), (bf16*)(WSP + WS_AB), (bf16*)(WSP + WS_GB), inp(F, 9) + (size_t)3 * FFH, inp(F, 10) + FFH}; run_gemm(F, ABUF, D, (const bf16*)(WSP + WS_F1T1), D, TL, 2 * FFH, D, e); );
    PHASE( ph_convfix(F, TL, 1); );
    PHASE( EpiResid e{out_(F), (float*)(WSP + WS_XC), MODP + 1 * 3 * 6144 + 5 * 1024, 1, 0}; run_gemm(F, (const bf16*)(WSP + WS_HG), FFH, (const bf16*)(WSP + WS_F2T1), FFH, TL, D, FFH, e); );
    PHASE( ph_layernorm(F, TL, 1, 1, -1, 0); );
#undef PHASE
#undef IN
#undef SEAM
}

extern "C" void kernel_launch(void* const* d_in, const int* in_sizes, int n_in, void* d_out, int out_size, void* d_ws, size_t ws_size, hipStream_t stream) {
    static int grid = 0;
    if (grid == 0) {
        if (n_in != 31 || out_size != TL * D || ws_size < WS_END) { fprintf(stderr, "kernel_launch: unexpected shapes n_in %d out %d ws %zu\n", n_in, out_size, ws_size); grid = -1; return; }
        int dev = 0, cus = 0;
        if (hipGetDevice(&dev) != hipSuccess || hipDeviceGetAttribute(&cus, hipDeviceAttributeMultiprocessorCount, dev) != hipSuccess) { grid = -1; return; }
        if (hipFuncSetAttribute((const void*)mk_fwd, hipFuncAttributeMaxDynamicSharedMemorySize, LDS_BYTES) != hipSuccess) { fprintf(stderr, "kernel_launch: hipFuncSetAttribute failed\n"); grid = -1; return; }
        int per_cu = 0;
        if (hipOccupancyMaxActiveBlocksPerMultiprocessor(&per_cu, (const void*)mk_fwd, NWAVES * 64, LDS_BYTES) != hipSuccess || per_cu < 1) fprintf(stderr, "kernel_launch: occupancy query says %d\n", per_cu);
        (void)hipGetLastError();
        grid = cus;
    }
    if (grid < 0) return;
    if (hipMemsetAsync((char*)d_ws + WS_CTL, 0, CTL_ZERO_BYTES, stream) != hipSuccess) return;
    Args a{};
    for (int i = 0; i < 31; ++i) a.in[i] = (const float*)d_in[i];
    a.out = (float*)d_out; a.ws = (unsigned char*)d_ws;
#ifndef MK_ONE_LAUNCH
#define MK_ONE_LAUNCH 1
#endif
    if (MK_ONE_LAUNCH) { a.ph_lo = 0; a.ph_hi = NPH; hipLaunchKernelGGL(mk_fwd, dim3(grid), dim3(NWAVES * 64), LDS_BYTES, stream, a); }
    else for (int p = 0; p < NPH; ++p) { a.ph_lo = p; a.ph_hi = p + 1; hipLaunchKernelGGL(mk_fwd, dim3(grid), dim3(NWAVES * 64), LDS_BYTES, stream, a); }
}
```

```cpp
#include <hip/hip_runtime.h>
#include <cstdio>
#include <cstdint>
#include <cmath>
namespace pg8 {
#define PG8_LAS __attribute__((address_space(3)))
typedef unsigned short bf16_t;
typedef short bf16x8 __attribute__((ext_vector_type(8)));
typedef float f32x4 __attribute__((ext_vector_type(4)));
typedef unsigned u32x4 __attribute__((ext_vector_type(4)));
constexpr int BM = 256, BK = 64, HALF = 128, HTB = HALF * BK * 2  , STAGE_BYTES = 8 * HTB, NXCD = 8, WGM = 8;

__host__ __device__ __forceinline__ int lds_byte(int r, int c) { const int st = (r >> 4) * 2 + (c >> 5), rr = r & 15, cc = c & 31, ob = rr * 64 + cc * 2; return st * 1024 + (ob ^ (((ob >> 9) & 1) << 5)); }
__host__ __device__ __forceinline__ void stage_rc(int b, int& R, int& C) { const int st = b / 1024, sb = b % 1024, swz = sb ^ (((sb >> 9) & 1) << 5); R = (st >> 1) * 16 + swz / 64; C = (st & 1) * 32 + (swz % 64) / 2; }
__host__ __device__ __forceinline__ int perm32(int rho) { const int n = rho >> 4, i = rho & 15; return 8 * (i >> 2) + 4 * n + (i & 3); }

struct Unit { int pm, pn; };
struct Gemm { const bf16_t* A; const bf16_t* Bt; int M, N, K, lda, ldb; };

struct StaticOrder {
    int nM, nN, nwg, G, c;
    __host__ __device__ void init(int M, int N, int G_, int c_) { nM = M / BM; nN = N / BM; nwg = nM * nN; G = G_; c = c_; }
    __host__ __device__ bool next(int i, Unit& u) const {
        const long L = (long)i * G + c; if (L >= nwg) return false;
        int wgid = (int)L; { const int q = nwg / NXCD, r = nwg % NXCD, xcd = wgid % NXCD, off = wgid / NXCD; wgid = (xcd < r ? xcd * (q + 1) : r * (q + 1) + (xcd - r) * q) + off; }
        const int nig = WGM * nN, gid = wgid / nig, fm = gid * WGM, gsz = (nM - fm) < WGM ? (nM - fm) : WGM;
        u.pm = fm + ((wgid % nig) % gsz); u.pn = (wgid % nig) / gsz; return true;
    }
    __device__ __forceinline__ void a_ready(const Unit&) const {}
    __device__ __forceinline__ void done(const Unit&) const {}
};

__device__ __forceinline__ unsigned cvt_pk_bf16(float lo, float hi) { unsigned r; asm volatile("v_cvt_pk_bf16_f32 %0, %1, %2" : "=v"(r) : "v"(lo), "v"(hi)); return r; }
template <class F> struct Epi8 {
    static constexpr bool PERM = true, AFTER_DRAIN = false; F f;
    __device__ __forceinline__ void operator()(const f32x4 (&acc)[2][2][4][2], const Unit& u, int wr, int wc, int fr, int fq) const {
        const int row0 = u.pm * BM + wr * 64 + fr, col0 = u.pn * BM + wc * 32 + 8 * fq;
#pragma unroll
        for (int ai = 0; ai < 2; ++ai)
#pragma unroll
            for (int m = 0; m < 4; ++m)
#pragma unroll
                for (int bj = 0; bj < 2; ++bj) { f(row0 + ai * HALF + m * 16, col0 + bj * HALF, acc[ai][bj][m][0], acc[ai][bj][m][1]); }
    }
};
template <class F> struct Epi4 {
    static constexpr bool PERM = false, AFTER_DRAIN = false; F f;
    __device__ __forceinline__ void operator()(const f32x4 (&acc)[2][2][4][2], const Unit& u, int wr, int wc, int fr, int fq) const {
        const int row0 = u.pm * BM + wr * 64 + fr, col0 = u.pn * BM + wc * 32 + 4 * fq;
#pragma unroll
        for (int ai = 0; ai < 2; ++ai)
#pragma unroll
            for (int m = 0; m < 4; ++m)
#pragma unroll
                for (int bj = 0; bj < 2; ++bj)
#pragma unroll
                    for (int n = 0; n < 2; ++n) { f(row0 + ai * HALF + m * 16, col0 + bj * HALF + n * 16, acc[ai][bj][m][n]); }
    }
};
template <class Epi, class Sched, bool ALIGN_EPI = false, bool SP2 = false>
__device__ __forceinline__ void gemm_phase(PG8_LAS unsigned char* lds, const Gemm g, const Sched& S, const Epi& E) {
    int tid_ = threadIdx.x; asm volatile("" : "+v"(tid_));
    const int tid = tid_, wid = __builtin_amdgcn_readfirstlane(tid >> 6), lane = tid & 63, wr = wid >> 2, wc = wid & 3, fr = lane & 15, fq = lane >> 4;
    const int K = g.K, nt = K / BK;
    unsigned voffA[2], voffB[2];
#pragma unroll
    for (int i = 0; i < 2; ++i) { int R, C; stage_rc(tid * 16 + i * 8192, R, C); const int Rb = Epi::PERM ? ((R & ~31) + perm32(R & 31)) : R;
        voffA[i] = (unsigned)(R * g.lda + C) * 2u; voffB[i] = (unsigned)(Rb * g.ldb + C) * 2u; }
    const size_t kstep = (size_t)(BK * 2);
    const size_t hstepA = (size_t)HALF * g.lda * 2, hstepB = (size_t)HALF * g.ldb * 2;
    const size_t tstepA = 2 * hstepA, tstepB = 2 * hstepB;
    const unsigned ldsw = (unsigned)wid * 1024u;
    const int aoff = lds_byte(wr * 64 + fr, fq * 8), boff = lds_byte(wc * 32 + fr, fq * 8);
#define PG8_SA(b, h) (((b) * 2 + (h)) * HTB)
#define PG8_SB(b, h) ((4 + (b) * 2 + (h)) * HTB)
#define PG8_STAGE(bufoff, gbase, voff) do { _Pragma("unroll") for (int _i = 0; _i < 2; ++_i) \
        __builtin_amdgcn_global_load_lds((const unsigned*)((const char*)(gbase) + (voff)[_i]), (PG8_LAS unsigned*)(lds + (bufoff) + ldsw + _i * 8192), 16, 0, 0); } while (0)
#define PG8_LDA(dst, b, h) do { _Pragma("unroll") for (int m = 0; m < 4; ++m) _Pragma("unroll") for (int k = 0; k < 2; ++k) dst[m][k] = *(const PG8_LAS bf16x8*)(lds + PG8_SA(b, h) + aoff + m * 2048 + k * 1024); } while (0)
#define PG8_LDB(dst, b, h) do { _Pragma("unroll") for (int n = 0; n < 2; ++n) _Pragma("unroll") for (int k = 0; k < 2; ++k) dst[n][k] = *(const PG8_LAS bf16x8*)(lds + PG8_SB(b, h) + boff + n * 2048 + k * 1024); } while (0)
#define PG8_MMA(ai, bj, At, Bt) do { __builtin_amdgcn_s_setprio(1); _Pragma("unroll") for (int m = 0; m < 4; ++m) _Pragma("unroll") for (int n = 0; n < 2; ++n) _Pragma("unroll") for (int k = 0; k < 2; ++k) \
        acc[ai][bj][m][n] = __builtin_amdgcn_mfma_f32_16x16x32_bf16(Bt[n][k], At[m][k], acc[ai][bj][m][n], 0, 0, 0); __builtin_amdgcn_s_setprio(0); } while (0)
#define PG8_WAIT_V(n) asm volatile("s_waitcnt vmcnt(" #n ")" ::: "memory")
#define PG8_WAIT_L(n) asm volatile("s_waitcnt lgkmcnt(" #n ")" ::: "memory")
#define PG8_BAR __builtin_amdgcn_s_barrier()
#define PG8_SCHED __builtin_amdgcn_sched_barrier(0)
    Unit cur, nxt; int ui = 0;
    if (!S.next(0, cur)) return;
    f32x4 acc[2][2][4][2];
#pragma unroll
    for (int a = 0; a < 2; ++a)
#pragma unroll
        for (int b = 0; b < 2; ++b)
#pragma unroll
            for (int m = 0; m < 4; ++m)
#pragma unroll
                for (int n = 0; n < 2; ++n) acc[a][b][m][n] = (f32x4){0.f, 0.f, 0.f, 0.f};
    bf16x8 At[4][2], B0[2][2], B1[2][2];
    const char* cA = (const char*)g.A + (size_t)cur.pm * tstepA; const char* cB = (const char*)g.Bt + (size_t)cur.pn * tstepB;
    S.a_ready(cur);
    if constexpr (SP2) {
        PG8_STAGE(PG8_SB(0, 0), cB, voffB); PG8_STAGE(PG8_SB(0, 1), cB + hstepB, voffB); PG8_STAGE(PG8_SA(0, 0), cA, voffA); PG8_STAGE(PG8_SA(0, 1), cA + hstepA, voffA);
        if (wr == 1) PG8_BAR;
        PG8_WAIT_V(2); PG8_BAR;
        PG8_STAGE(PG8_SB(1, 0), cB + kstep, voffB); PG8_STAGE(PG8_SA(1, 0), cA + kstep, voffA); PG8_STAGE(PG8_SB(1, 1), cB + hstepB + kstep, voffB);
        PG8_WAIT_V(6); PG8_BAR;
    } else {
        PG8_STAGE(PG8_SB(0, 0), cB, voffB); PG8_STAGE(PG8_SA(0, 0), cA, voffA); PG8_STAGE(PG8_SB(0, 1), cB + hstepB, voffB); PG8_STAGE(PG8_SA(0, 1), cA + hstepA, voffA);
        if (wr == 1) PG8_BAR;
        PG8_WAIT_V(4); PG8_BAR;
        PG8_STAGE(PG8_SB(1, 0), cB + kstep, voffB); PG8_STAGE(PG8_SA(1, 0), cA + kstep, voffA); PG8_STAGE(PG8_SB(1, 1), cB + hstepB + kstep, voffB);
        PG8_WAIT_V(6); PG8_BAR;
    }
    for (;;) {
        const bool has_next = S.next(ui + 1, nxt);
        const char* nA = has_next ? (const char*)g.A + (size_t)nxt.pm * tstepA : cA; const char* nB = has_next ? (const char*)g.Bt + (size_t)nxt.pn * tstepB : cB;
#pragma unroll 1
        for (int t = 0; t < nt; t += 2) {
            const bool last = (t == nt - 2);
            const char* a1 = cA + (size_t)(t + 1) * kstep;
            const char* a2 = last ? nA : cA + (size_t)(t + 2) * kstep; const char* b2 = last ? nB : cB + (size_t)(t + 2) * kstep;
            const char* a3 = a2 + kstep; const char* b3 = b2 + kstep;
            if (last && has_next) S.a_ready(nxt);
            if constexpr (SP2) {
            PG8_LDB(B0, 0, 0); PG8_LDB(B1, 0, 1); PG8_SCHED; PG8_LDA(At, 0, 0); PG8_STAGE(PG8_SA(1, 1), a1 + hstepA, voffA);
            PG8_WAIT_V(8); PG8_WAIT_L(0); PG8_BAR; PG8_MMA(0, 0, At, B0); PG8_MMA(0, 1, At, B1); PG8_BAR; PG8_SCHED;
            PG8_LDA(At, 0, 1); PG8_STAGE(PG8_SB(0, 0), b2, voffB); PG8_STAGE(PG8_SB(0, 1), b2 + hstepB, voffB); PG8_STAGE(PG8_SA(0, 0), a2, voffA);
            PG8_WAIT_V(8); PG8_WAIT_L(0); PG8_BAR; PG8_MMA(1, 0, At, B0); PG8_MMA(1, 1, At, B1); PG8_BAR; PG8_SCHED;
            PG8_LDB(B0, 1, 0); PG8_LDB(B1, 1, 1); PG8_SCHED; PG8_LDA(At, 1, 0); PG8_STAGE(PG8_SA(0, 1), a2 + hstepA, voffA);
            PG8_WAIT_V(8); PG8_WAIT_L(0); PG8_BAR; PG8_MMA(0, 0, At, B0); PG8_MMA(0, 1, At, B1); PG8_BAR; PG8_SCHED;
            PG8_LDA(At, 1, 1); PG8_STAGE(PG8_SB(1, 0), b3, voffB); PG8_STAGE(PG8_SB(1, 1), b3 + hstepB, voffB); PG8_STAGE(PG8_SA(1, 0), a3, voffA);
            PG8_WAIT_V(8); PG8_WAIT_L(0); PG8_BAR; PG8_MMA(1, 0, At, B0); PG8_MMA(1, 1, At, B1); PG8_BAR; PG8_SCHED;
            } else {
            PG8_LDB(B0, 0, 0); PG8_SCHED; PG8_LDA(At, 0, 0); PG8_STAGE(PG8_SA(1, 1), a1 + hstepA, voffA);
            PG8_WAIT_L(8); PG8_BAR; PG8_WAIT_L(0); PG8_MMA(0, 0, At, B0); PG8_BAR; PG8_SCHED;
            PG8_LDB(B1, 0, 1); PG8_STAGE(PG8_SB(0, 0), b2, voffB);
            PG8_BAR; PG8_WAIT_L(0); PG8_MMA(0, 1, At, B1); PG8_BAR;
            PG8_LDA(At, 0, 1); PG8_STAGE(PG8_SA(0, 0), a2, voffA);
            PG8_BAR; PG8_WAIT_L(0); PG8_MMA(1, 0, At, B0); PG8_BAR; PG8_SCHED;
            PG8_STAGE(PG8_SB(0, 1), b2 + hstepB, voffB);
            PG8_WAIT_V(6); PG8_BAR; PG8_MMA(1, 1, At, B1); PG8_BAR;
            PG8_LDB(B0, 1, 0); PG8_SCHED; PG8_LDA(At, 1, 0); PG8_STAGE(PG8_SA(0, 1), a2 + hstepA, voffA);
            PG8_WAIT_L(8); PG8_BAR; PG8_WAIT_L(0); PG8_MMA(0, 0, At, B0); PG8_BAR; PG8_SCHED;
            PG8_LDB(B1, 1, 1); PG8_STAGE(PG8_SB(1, 0), b3, voffB);
            PG8_BAR; PG8_WAIT_L(0); PG8_MMA(0, 1, At, B1); PG8_BAR;
            PG8_LDA(At, 1, 1); PG8_STAGE(PG8_SA(1, 0), a3, voffA);
            PG8_BAR; PG8_WAIT_L(0); PG8_MMA(1, 0, At, B0); PG8_BAR; PG8_SCHED;
            PG8_STAGE(PG8_SB(1, 1), b3 + hstepB, voffB);
            PG8_WAIT_V(6); PG8_BAR; PG8_MMA(1, 1, At, B1); PG8_BAR;
            }
        }
        if constexpr (ALIGN_EPI) { if (wr == 0) PG8_BAR; }
        if constexpr (!Epi::AFTER_DRAIN) { E(acc, cur, wr, wc, fr, fq); S.done(cur); }
        if (!has_next) break;
#pragma unroll
        for (int a = 0; a < 2; ++a)
#pragma unroll
            for (int b = 0; b < 2; ++b)
#pragma unroll
                for (int m = 0; m < 4; ++m)
#pragma unroll
                    for (int n = 0; n < 2; ++n) acc[a][b][m][n] = (f32x4){0.f, 0.f, 0.f, 0.f};
        cur = nxt; cA = nA; cB = nB; ++ui;
        if constexpr (ALIGN_EPI) { if (wr == 1) PG8_BAR; }
    }
    PG8_WAIT_V(0);
    if constexpr (!ALIGN_EPI) { if (wr == 0) PG8_BAR; }
    PG8_BAR;
    if constexpr (Epi::AFTER_DRAIN) { E.fused(acc, cur, wr, wc, fr, fq, lds, wid, lane); S.done(cur); }
#undef PG8_SA
#undef PG8_SB
#undef PG8_STAGE
#undef PG8_LDA
#undef PG8_LDB
#undef PG8_MMA
#undef PG8_WAIT_V
#undef PG8_WAIT_L
#undef PG8_BAR
#undef PG8_SCHED
}
}

constexpr int NWAVES = 8;
constexpr int D = 1024, BATCH = 2, SEQ = 8192, CTXL = 256;
constexpr int TL = BATCH * SEQ;
constexpr int TC = BATCH * CTXL;
constexpr int TT = TL + TC;
constexpr int EVEN_IN = 1184, EVEN_IN_PAD = 1280, CQKV_LD = 672;
constexpr int FFH = 2816, FFG = 1408;
constexpr int TQK = SEQ + CTXL;
constexpr float NORM_EPS = 1e-6f;
constexpr float DN_ALPHA = 1.41421356237f;
constexpr float QSCALE = 0.10206207261596577f * 1.4426950408889634f;

constexpr size_t MiB = 1u << 20;
constexpr size_t WS_CTL = 0, CTL_ZERO_BYTES = 1 * MiB;
constexpr size_t WS_MOD = 1 * MiB;
constexpr size_t WS_LBV = WS_MOD + 160 * 1024;
constexpr size_t WS_ROPE = WS_LBV + 16 * 1024;
constexpr size_t WS_CWT = WS_ROPE + 16 * 1024;
constexpr size_t WS_HGINT = 2 * MiB, WS_HGOUTT = 12 * MiB, WS_F1T1 = 14 * MiB, WS_F2T1 = 25 * MiB;
constexpr size_t WS_A = 31 * MiB;
constexpr size_t WS_XC = 64 * MiB;
constexpr size_t WS_WIN0 = 66 * MiB, WS_WUQ = WS_WIN0 + 2560 * 1024, WS_WUKV = WS_WUQ + 768 * 1024, WS_WGLU = WS_WUKV + 512 * 1024,
                 WS_WOUT0 = WS_WGLU + 512 * 1024, WS_F1T0 = 72 * MiB + 512 * 1024, WS_F2T0 = WS_F1T0 + 11 * MiB;
constexpr size_t WS_R = 89 * MiB;
constexpr size_t WS_CQKV = WS_R;
constexpr size_t WS_UG = WS_R + 22 * MiB;
constexpr size_t WS_WF = WS_R + 39 * MiB;
constexpr size_t WS_WC = WS_R + 64 * MiB;
constexpr size_t WS_TOEP = WS_R + 80 * MiB;
constexpr size_t WS_T0 = WS_R + 82 * MiB;
constexpr size_t WS_A64 = WS_T0 + 128 * 1024;
constexpr size_t WS_FIN = WS_R + 83 * MiB;
constexpr size_t WS_SIN = WS_R + 92 * MiB;
constexpr size_t WS_Z = WS_R + 97 * MiB;
constexpr size_t WS_MIX = WS_R + 134 * MiB;
constexpr size_t WS_QB = WS_R + 39 * MiB;
constexpr size_t WS_KB = 31 * MiB;
constexpr size_t WS_VB = WS_R + 114 * MiB;
constexpr size_t WS_AB = WS_R;
constexpr size_t WS_GB = WS_R + 8 * MiB;
constexpr size_t WS_H = WS_R;
constexpr size_t WS_HG = WS_R + 16 * MiB;
constexpr size_t WS_QFFI = 66 * MiB;
constexpr size_t WS_G = 198 * MiB;
constexpr size_t WS_O = WS_A;
constexpr size_t WS_SLAB1 = WS_R;
constexpr size_t WS_SLAB2 = WS_R + 140 * MiB;
constexpr size_t WS_END = 256 * MiB;
static_assert(WS_F2T0 + 5632 * 1024 <= WS_R, "layer-0 weights");
static_assert(WS_MIX + (size_t)TT * 1024 * 2 <= WS_END && WS_G + (size_t)TT * 1024 * 2 <= WS_END && WS_HG + (size_t)TT * FFH * 2 <= WS_END, "ws map");
static_assert(WS_WF + 16 * MiB <= WS_WC && WS_QB + (size_t)16 * TQK * 96 * 2 <= WS_WC && WS_WC + 16 * MiB <= WS_TOEP && WS_TOEP + 2 * MiB <= WS_T0 && WS_T0 + MiB <= WS_FIN && WS_FIN + (size_t)32 * 264 * 256 * 4 <= WS_SIN && WS_SIN + (size_t)32 * 264 * 256 * 2 <= WS_Z && WS_Z + (size_t)TT * 512 * 2 <= WS_VB && WS_VB + (size_t)16 * TQK * 64 * 2 <= WS_MIX && WS_KB + (size_t)16 * TQK * 96 * 2 <= WS_XC, "ws map 2");

constexpr int CW_BAR = 4096;
constexpr int RING_OFF = 0, RING_BYTES = 131072;
constexpr int LDSCTL_OFF = RING_BYTES, MISC_OFF = LDSCTL_OFF + 320;
constexpr int LDS_BYTES = 147456;

#define GAS __attribute__((address_space(1)))
#define LAS __attribute__((address_space(3)))
typedef unsigned short bf16;
typedef unsigned v4u __attribute__((ext_vector_type(4)));
typedef unsigned v2u __attribute__((ext_vector_type(2)));
typedef float f32x4 __attribute__((ext_vector_type(4)));
typedef GAS unsigned gu32;
#define RLX_AGENT __ATOMIC_RELAXED, __HIP_MEMORY_SCOPE_AGENT
#define LDS_WAIT() asm volatile("s_waitcnt lgkmcnt(0)" ::: "memory")
__device__ __forceinline__ unsigned f2bf(float f) { unsigned u = __builtin_bit_cast(unsigned, f); return (u + 0x7fffu + ((u >> 16) & 1u)) >> 16; }
__device__ __forceinline__ unsigned pk2(float lo, float hi) { return f2bf(lo) | (f2bf(hi) << 16); }
__device__ __forceinline__ float bflo(unsigned w) { return __builtin_bit_cast(float, w << 16); }
__device__ __forceinline__ float bfhi(unsigned w) { return __builtin_bit_cast(float, w & 0xffff0000u); }
__device__ __forceinline__ float bf2f(bf16 h) { return __builtin_bit_cast(float, (unsigned)h << 16); }
__device__ __forceinline__ void unpack8(v4u w, float* x) { x[0] = bflo(w.x); x[1] = bfhi(w.x); x[2] = bflo(w.y); x[3] = bfhi(w.y); x[4] = bflo(w.z); x[5] = bfhi(w.z); x[6] = bflo(w.w); x[7] = bfhi(w.w); }
__device__ __forceinline__ v4u pack8(const float* x) { v4u w; w.x = pk2(x[0], x[1]); w.y = pk2(x[2], x[3]); w.z = pk2(x[4], x[5]); w.w = pk2(x[6], x[7]); return w; }
__device__ __forceinline__ float sigmoidf_(float x) { return 1.0f / (1.0f + __expf(-x)); }
__device__ __forceinline__ float siluf_(float x) { return x / (1.0f + __expf(-x)); }
__device__ __forceinline__ float gelu_tanh(float x) { const float u = 0.7978845608028654f * (x + 0.044715f * x * x * x); return 0.5f * x * (1.0f + tanhf(u)); }
__device__ __forceinline__ float wave_sum(float v) {
#pragma unroll
    for (int o = 1; o < 64; o <<= 1) v += __shfl_xor(v, o);
    return v;
}

#define XB_TMO      128
#define XB_XCNT(j)  (256  + 64 * (j))
#define XB_XSUB(j)  (1280 + 64 * (j))
#define XB_XGEN(j)  (2304 + 64 * (j))
#define XB_TOP      3328
#define XB_TOPGEN   3392
#define XCD_BAR_WORDS 3456
#define XB_SPIN_CAP (1u << 18)

__device__ __forceinline__ unsigned xb_ld(unsigned* p)              { return __hip_atomic_load(p, __ATOMIC_RELAXED, __HIP_MEMORY_SCOPE_AGENT); }
__device__ __forceinline__ unsigned xb_add(unsigned* p, unsigned v) { return __hip_atomic_fetch_add(p, v, __ATOMIC_RELAXED, __HIP_MEMORY_SCOPE_AGENT); }
__device__ __forceinline__ unsigned xb_xcc_id() { return (unsigned)__builtin_amdgcn_s_getreg((3 << 11) | 20) & 0xFu; }
#define XB_SPIN(cond, bar) do { unsigned _sp = 0; while (cond) { __builtin_amdgcn_s_sleep(1); \
    if ((++_sp & 255u) == 0u) { if (xb_ld(&(bar)[XB_TMO])) break; if (_sp > XB_SPIN_CAP) { atomicAdd(&(bar)[XB_TMO], 1u); break; } } } } while (0)

struct XcdBarrier {
    unsigned* bar; unsigned x;
    volatile LAS unsigned* st;
};

__device__ __forceinline__ XcdBarrier xcd_barrier_post(unsigned* bar, volatile LAS unsigned* st) {
    XcdBarrier b; b.bar = bar; b.x = xb_xcc_id(); b.st = st;
    if (threadIdx.x == 0) (void)xb_add(&bar[XB_XCNT(b.x)], 1u);
    return b;
}
__device__ __forceinline__ void xcd_barrier_complete(unsigned* bar, unsigned x, unsigned& nloc, unsigned& nx) {
    const unsigned G = gridDim.x * gridDim.y * gridDim.z;
    unsigned sum, cnt, mine, sp = 0u;
    for (;;) {
        sum = 0u; cnt = 0u; mine = 0u;
#pragma unroll
        for (unsigned j = 0; j < 16; ++j) { const unsigned c = xb_ld(&bar[XB_XCNT(j)]); sum += c; cnt += (c > 0u) ? 1u : 0u; mine = (j == x) ? c : mine; }
        if (sum == G) break;
        __builtin_amdgcn_s_sleep(1);
        if ((++sp & 255u) == 0u) { if (xb_ld(&bar[XB_TMO])) break; if (sp > XB_SPIN_CAP) { atomicAdd(&bar[XB_TMO], 1u); break; } }
    }
    nloc = mine > 0u ? mine : 1u; nx = cnt > 0u ? cnt : 1u;
}

__device__ __forceinline__ void xcd_barrier(const XcdBarrier& b) {
    asm volatile("s_waitcnt vmcnt(0)" ::: "memory");
    __syncthreads();
    if (threadIdx.x == 0) {
        unsigned* bar = b.bar;
        __builtin_amdgcn_s_waitcnt(0);
        unsigned nloc = b.st[0], nx = b.st[1];
        if (nloc == 0u) { xcd_barrier_complete(bar, b.x, nloc, nx); b.st[0] = nloc; b.st[1] = nx; }
        const unsigned old = xb_add(&bar[XB_XSUB(b.x)], 1u);
        const unsigned gen = old / nloc;
        if (old + 1u == (gen + 1u) * nloc) {
            __builtin_amdgcn_fence(__ATOMIC_RELEASE, "agent");
            asm volatile("s_waitcnt vmcnt(0)" ::: "memory");
            const unsigned og = xb_add(&bar[XB_TOP], 1u);
            const unsigned tg = og / nx;
            if (og + 1u == (tg + 1u) * nx) xb_add(&bar[XB_TOPGEN], 1u);
            else XB_SPIN(xb_ld(&bar[XB_TOPGEN]) == tg, bar);
            __builtin_amdgcn_fence(__ATOMIC_ACQUIRE, "agent");
            xb_add(&bar[XB_XGEN(b.x)], 1u);
            asm volatile("s_waitcnt vmcnt(0)" ::: "memory");
        } else {
            XB_SPIN(xb_ld(&bar[XB_XGEN(b.x)]) == gen, bar);
            __builtin_amdgcn_fence(__ATOMIC_ACQUIRE, "agent");
            asm volatile("s_waitcnt vmcnt(0)" ::: "memory");
        }
    }
    __syncthreads();
}


struct Frame {
    LAS unsigned char* lds;
    int tid, lane, wave, vcu, G;
};
constexpr int PTR_OFF = LDSCTL_OFF + 1024;
__device__ __forceinline__ const float* inp(const Frame& F, int i) {
    const LAS unsigned* p = (const LAS unsigned*)(F.lds + PTR_OFF) + 2 * i;
    const unsigned lo = __builtin_amdgcn_readfirstlane(p[0]), hi = __builtin_amdgcn_readfirstlane(p[1]);
    return (const float*)(const GAS float*)(((unsigned long long)hi << 32) | lo);
}
__device__ __forceinline__ unsigned char* ws_(const Frame& F) { return (unsigned char*)inp(F, 31); }
__device__ __forceinline__ float* out_(const Frame& F) { return (float*)inp(F, 32); }
__device__ __forceinline__ int modrow_of(int m) { return m < TL ? (m >> 13) : 2; }
__device__ __forceinline__ const float* xin_row(const Frame& F, int m) { return m < TL ? inp(F, 0) + (size_t)m * D : inp(F, 2) + (size_t)(m - TL) * D; }
__device__ __forceinline__ float* xres_row(const Frame& F, int m) { return m < TL ? out_(F) + (size_t)m * D : (float*)(ws_(F) + WS_XC) + (size_t)(m - TL) * D; }
__device__ __forceinline__ const float* modvec(const Frame& F, int layer, int mr, int part) { return (const float*)(ws_(F) + WS_MOD) + (size_t)(layer * 3 + mr) * 6144 + part * 1024; }

__device__ __forceinline__ void tr_item(const float* W, int ldw, int k0, int n0, bf16* dst, int dpitch, LAS float* scr, int lane) {
    { f32x4 v[8];
#pragma unroll
      for (int i = 0; i < 8; ++i) v[i] = *(const GAS f32x4*)(W + (size_t)(k0 + 8 * i + (lane >> 3)) * ldw + n0 + 4 * (lane & 7));
#pragma unroll
      for (int i = 0; i < 8; ++i) { LAS float* d = scr + (8 * i + (lane >> 3)) * 33 + 4 * (lane & 7); d[0] = v[i].x; d[1] = v[i].y; d[2] = v[i].z; d[3] = v[i].w; } }
    LDS_WAIT(); asm volatile("" ::: "memory");
    const int c = lane & 7;
#pragma unroll
    for (int j = 0; j < 4; ++j) { const int n = (lane >> 3) + 8 * j; const LAS float* s = scr + (8 * c) * 33 + n;
        v4u o; o.x = pk2(s[0 * 33], s[1 * 33]); o.y = pk2(s[2 * 33], s[3 * 33]); o.z = pk2(s[4 * 33], s[5 * 33]); o.w = pk2(s[6 * 33], s[7 * 33]);
        *(GAS v4u*)(dst + (size_t)n * dpitch + 8 * c) = o; }
    LDS_WAIT(); asm volatile("" ::: "memory");
}
__device__ __forceinline__ bool tr_plain(int& r, const float* W, int K, int N, bf16* WT, LAS float* scr, int lane) {
    const int nblk = N / 32, cnt = (K / 64) * nblk;
    if (r >= cnt) { r -= cnt; return false; }
    const int kb = r / nblk, nb = r % nblk;
    tr_item(W, N, 64 * kb, 32 * nb, WT + (size_t)(32 * nb) * K + 64 * kb, K, scr, lane); return true;
}
__device__ __forceinline__ bool tr_ffn1(int& r, const float* W, bf16* WT, LAS float* scr, int lane) {
    const int nblk = 5632 / 32, cnt = 16 * nblk;
    if (r >= cnt) { r -= cnt; return false; }
    const int kb = r / nblk, nb = r % nblk, n0 = 32 * nb, half = n0 / FFH, j = n0 % FFH, drow = (j >> 7) * 256 + half * 128 + (j & 127);
    tr_item(W, 5632, 64 * kb, n0, WT + (size_t)drow * 1024 + 64 * kb, 1024, scr, lane); return true;
}
__device__ __forceinline__ void p0_prologue(Frame& F) {
    {
        LAS float* sv = (LAS float*)(F.lds + RING_OFF);
        LAS float* red = sv + 3072;
        for (int i = F.tid; i < 3072; i += 512) { const int r = i >> 10, k = i & 1023; const float cv = (r < 2) ? inp(F, 1)[r * 1024 + k] : inp(F, 3)[k]; sv[i] = cv / (1.0f + __expf(-cv)); }
        __syncthreads();
        for (int it = blockIdx.x; it < 192; it += F.G) {
            const int layer = it / 96, cg = it % 96, col = cg * 64 + F.lane, k0 = F.wave * 128;
            const float* w = inp(F, 4) + ((size_t)layer * 1024 + k0) * 6144 + col;
            float a0 = 0.f, a1 = 0.f, a2 = 0.f;
#pragma unroll 16
            for (int k = 0; k < 128; ++k) { const float wv = w[(size_t)k * 6144]; a0 += sv[k0 + k] * wv; a1 += sv[1024 + k0 + k] * wv; a2 += sv[2048 + k0 + k] * wv; }
            red[(F.wave * 3 + 0) * 64 + F.lane] = a0; red[(F.wave * 3 + 1) * 64 + F.lane] = a1; red[(F.wave * 3 + 2) * 64 + F.lane] = a2;
            __syncthreads();
            if (F.tid < 192) { const int r = F.tid >> 6, l = F.tid & 63; float s = inp(F, 5)[layer * 6144 + cg * 64 + l];
#pragma unroll
                for (int wv = 0; wv < 8; ++wv) s += red[(wv * 3 + r) * 64 + l];
                ((float*)(ws_(F) + WS_MOD))[(size_t)(layer * 3 + r) * 6144 + cg * 64 + l] = s; }
            __syncthreads();
        }
        __syncthreads();
    }
    {
        const int gt = F.vcu * 512 + F.tid, NT = F.G * 512;
        for (int i = gt; i < 2048; i += NT) { const int dir = i >> 10, c = i & 1023; const float l0 = inp(F, 28)[(0 * 2 + dir) * 1024 + c], l1 = inp(F, 28)[(1 * 2 + dir) * 1024 + c];
            ((float*)(ws_(F) + WS_LBV))[i] = 1.0f / (1.0f + expf(l0 - l1)); }
        for (int i = gt; i < 1024; i += NT) { const int pos = i >> 3, f = i & 7; const float inv = powf(10000.0f, -(float)f / 8.0f); const float ang = (float)pos * inv;
            ((float*)(ws_(F) + WS_ROPE))[2 * i] = cosf(ang); ((float*)(ws_(F) + WS_ROPE))[2 * i + 1] = sinf(ang); }
        for (int i = gt; i < 2 * FFH; i += NT) { const int layer = i / FFH, j = i % FFH; const float* cwp = inp(F, 9) + (size_t)layer * 3 * FFH + j;
            v2u w; w.x = pk2(cwp[0], cwp[FFH]); w.y = pk2(cwp[2 * FFH], inp(F, 10)[(size_t)layer * FFH + j]); *(GAS v2u*)((bf16*)(ws_(F) + WS_CWT) + (size_t)i * 4) = w; }
        for (int i = gt; i < 96 * 1024 / 8; i += NT) ((GAS v4u*)(ws_(F) + WS_WIN0 + (size_t)1184 * 1024 * 2))[i] = (v4u){0u, 0u, 0u, 0u};
    }
    {
        LAS float* scr = (LAS float*)(F.lds + RING_OFF + F.wave * 16384);
        const int gw = F.vcu * NWAVES + F.wave, NGW = F.G * NWAVES;
        constexpr int NITEMS = 592 + 144 + 128 + 128 + 512 + 2 * 2816 + 2 * 1408 + 2560 + 512;
        for (int it = gw; it < NITEMS; it += NGW) {
            int r = it;
            if (tr_plain(r, inp(F, 12), 1024, 1184, (bf16*)(ws_(F) + WS_WIN0), scr, F.lane)) continue;
            if (tr_plain(r, inp(F, 14), 384, 768, (bf16*)(ws_(F) + WS_WUQ), scr, F.lane)) continue;
            if (tr_plain(r, inp(F, 16), 256, 1024, (bf16*)(ws_(F) + WS_WUKV), scr, F.lane)) continue;
            if (tr_plain(r, inp(F, 25), 512, 512, (bf16*)(ws_(F) + WS_WGLU), scr, F.lane)) continue;
            if (tr_plain(r, inp(F, 26), 1024, 1024, (bf16*)(ws_(F) + WS_WOUT0), scr, F.lane)) continue;
            if (tr_ffn1(r, inp(F, 8), (bf16*)(ws_(F) + WS_F1T0), scr, F.lane)) continue;
            if (tr_ffn1(r, inp(F, 8) + (size_t)1024 * 5632, (bf16*)(ws_(F) + WS_F1T1), scr, F.lane)) continue;
            if (tr_plain(r, inp(F, 11), 2816, 1024, (bf16*)(ws_(F) + WS_F2T0), scr, F.lane)) continue;
            if (tr_plain(r, inp(F, 11) + (size_t)2816 * 1024, 2816, 1024, (bf16*)(ws_(F) + WS_F2T1), scr, F.lane)) continue;
            if (tr_plain(r, inp(F, 27), 1024, 5120, (bf16*)(ws_(F) + WS_HGINT), scr, F.lane)) continue;
            tr_plain(r, inp(F, 30), 1024, 1024, (bf16*)(ws_(F) + WS_HGOUTT), scr, F.lane);
        }
    }
}

__device__ __forceinline__ void store_mod_bf16(const Frame& F, const f32x4 (&v)[4], int m, int layer, int part_sh) {
    const int mr = modrow_of(m);
    const GAS f32x4* sh = (const GAS f32x4*)modvec(F, layer, mr, part_sh) + F.lane;
    const GAS f32x4* sc = (const GAS f32x4*)modvec(F, layer, mr, part_sh + 1) + F.lane;
    GAS v2u* o = (GAS v2u*)((bf16*)(ws_(F) + WS_A) + (size_t)m * D) + F.lane;
#pragma unroll
    for (int j = 0; j < 4; ++j) { const f32x4 s = sc[64 * j], h = sh[64 * j]; const f32x4 y = v[j] * (s + 1.0f) + h; v2u w; w.x = pk2(y.x, y.y); w.y = pk2(y.z, y.w); o[64 * j] = w; }
}
__device__ __forceinline__ void ph_init_rows(Frame& F) {
    const int gw = F.vcu * NWAVES + F.wave, NGW = F.G * NWAVES;
    for (int m = gw; m < TT; m += NGW) {
        const GAS f32x4* xr = (const GAS f32x4*)xin_row(F, m) + F.lane; GAS f32x4* xo = (GAS f32x4*)xres_row(F, m) + F.lane;
        f32x4 v[4];
#pragma unroll
        for (int j = 0; j < 4; ++j) { v[j] = xr[64 * j]; xo[64 * j] = (m >= TL) ? v[j] * DN_ALPHA : v[j]; }
        store_mod_bf16(F, v, m, 0, 0);
    }
}
__device__ __forceinline__ void ph_layernorm(Frame& F, int nrows, int layer, int which, int next_layer, int next_part_sh, const float* slabs = nullptr, int nslabs = 0) {
    const int gw = F.vcu * NWAVES + F.wave, NGW = F.G * NWAVES;
    const GAS f32x4* gg = (const GAS f32x4*)(inp(F, 6) + (size_t)(layer * 2 + which) * D) + F.lane;
    const GAS f32x4* bb = (const GAS f32x4*)(inp(F, 7) + (size_t)(layer * 2 + which) * D) + F.lane;
    for (int m0 = gw; m0 < nrows; m0 += 2 * NGW) {
        const int m1 = m0 + NGW; const bool has1 = m1 < nrows; const int m1c = has1 ? m1 : m0;
        GAS f32x4* xr0 = (GAS f32x4*)xres_row(F, m0) + F.lane; GAS f32x4* xr1 = (GAS f32x4*)xres_row(F, m1c) + F.lane;
        f32x4 v[4], w[4]; float s0 = 0.f, s1 = 0.f;
#pragma unroll
        for (int j = 0; j < 4; ++j) { v[j] = xr0[64 * j]; w[j] = xr1[64 * j]; }
        if (nslabs > 0 && m1c >= TL) {
            for (int sl = 0; sl < nslabs; ++sl) { const GAS f32x4* p1 = (const GAS f32x4*)(slabs + ((size_t)sl * TC + (m1c - TL)) * D) + F.lane;
#pragma unroll
                for (int j = 0; j < 4; ++j) w[j] += p1[64 * j];
                if (m0 >= TL) { const GAS f32x4* p0 = (const GAS f32x4*)(slabs + ((size_t)sl * TC + (m0 - TL)) * D) + F.lane;
#pragma unroll
                    for (int j = 0; j < 4; ++j) v[j] += p0[64 * j]; } }
        }
#pragma unroll
        for (int j = 0; j < 4; ++j) { s0 += (v[j].x + v[j].y) + (v[j].z + v[j].w); s1 += (w[j].x + w[j].y) + (w[j].z + w[j].w); }
        const float mean0 = wave_sum(s0) * (1.f / D), mean1 = wave_sum(s1) * (1.f / D); float q0 = 0.f, q1 = 0.f;
#pragma unroll
        for (int j = 0; j < 4; ++j) { v[j] = v[j] - mean0; w[j] = w[j] - mean1; q0 += (v[j].x * v[j].x + v[j].y * v[j].y) + (v[j].z * v[j].z + v[j].w * v[j].w); q1 += (w[j].x * w[j].x + w[j].y * w[j].y) + (w[j].z * w[j].z + w[j].w * w[j].w); }
        const float r0 = 1.f / sqrtf(wave_sum(q0) * (1.f / D) + NORM_EPS), r1 = 1.f / sqrtf(wave_sum(q1) * (1.f / D) + NORM_EPS);
#pragma unroll
        for (int j = 0; j < 4; ++j) { const f32x4 g4 = gg[64 * j], b4 = bb[64 * j]; v[j] = v[j] * r0 * g4 + b4; w[j] = w[j] * r1 * g4 + b4; xr0[64 * j] = (m0 >= TL) ? v[j] * DN_ALPHA : v[j]; if (has1) xr1[64 * j] = (m1 >= TL) ? w[j] * DN_ALPHA : w[j]; }
        if (next_layer >= 0) { store_mod_bf16(F, v, m0, next_layer, next_part_sh); if (has1) store_mod_bf16(F, w, m1, next_layer, next_part_sh); }
    }
}
__device__ __forceinline__ void ph_mla_norm(Frame& F) {
    const int gw = F.vcu * NWAVES + F.wave, NGW = F.G * NWAVES;
    bf16* CQ = (bf16*)(ws_(F) + WS_CQKV); bf16* Kb = (bf16*)(ws_(F) + WS_KB); const float* rope = (const float*)(ws_(F) + WS_ROPE);
    for (int m = gw; m < TT; m += NGW) {
        bf16* row = CQ + (size_t)m * CQKV_LD;
        {
            float x[8]; float ss = 0.f; const bool act = F.lane < 48;
            if (act) { unpack8(*(const GAS v4u*)(row + 8 * F.lane), x);
#pragma unroll
                for (int j = 0; j < 8; ++j) ss += x[j] * x[j]; }
            const float sc = 1.f / sqrtf(wave_sum(ss) * (1.f / 384.f) + NORM_EPS);
            if (act) {
#pragma unroll
                for (int j = 0; j < 8; ++j) x[j] = x[j] * sc * inp(F, 13)[8 * F.lane + j];
                *(GAS v4u*)(row + 8 * F.lane) = pack8(x); }
        }
        {
            float x[8]; float ss = 0.f; const bool act = F.lane < 32;
            if (act) { unpack8(*(const GAS v4u*)(row + 384 + 8 * F.lane), x);
#pragma unroll
                for (int j = 0; j < 8; ++j) ss += x[j] * x[j]; }
            const float sc = 1.f / sqrtf(wave_sum(ss) * (1.f / 256.f) + NORM_EPS);
            if (act) {
#pragma unroll
                for (int j = 0; j < 8; ++j) x[j] = x[j] * sc * inp(F, 15)[8 * F.lane + j];
                *(GAS v4u*)(row + 384 + 8 * F.lane) = pack8(x); }
        }
        {
            const bool isctx = m >= TL; const int b = isctx ? ((m - TL) >> 8) : (m >> 13), t = isctx ? ((m - TL) & 255) : (m & 8191), tk = isctx ? t : CTXL + t;
            const int h = F.lane >> 3, i0 = (F.lane & 7) * 4;
            const v2u w = *(const GAS v2u*)(row + 640 + i0);
            float x[4] = {bflo(w.x), bfhi(w.x), bflo(w.y), bfhi(w.y)}, o[4];
#pragma unroll
            for (int j = 0; j < 4; ++j) { const float p = __shfl_xor(x[j], 2); const int idx = i0 + j, a = idx >> 4, half = (idx >> 3) & 1, f = idx & 7, pos = a ? (t & 63) : (t >> 6);
                const float cs = rope[2 * (pos * 8 + f)], sn = rope[2 * (pos * 8 + f) + 1];
                o[j] = isctx ? x[j] : (half ? x[j] * cs + p * sn : x[j] * cs - p * sn); }
            v2u ow; ow.x = pk2(o[0], o[1]); ow.y = pk2(o[2], o[3]);
            *(GAS v2u*)(Kb + ((size_t)(b * 8 + h) * TQK + tk) * 96 + 64 + i0) = ow;
        }
    }
}
__device__ __forceinline__ void ph_convfix(Frame& F, int nrows, int layer) {
    const int gw = F.vcu * NWAVES + F.wave, NGW = F.G * NWAVES;
    const bf16* AB = (const bf16*)(ws_(F) + WS_AB); const bf16* GB = (const bf16*)(ws_(F) + WS_GB); bf16* HG = (bf16*)(ws_(F) + WS_HG);
    const float* cw = inp(F, 9) + (size_t)layer * 3 * FFH; const float* cb = inp(F, 10) + (size_t)layer * FFH;
    const int nedge = (nrows / 64) * 2;
    for (int er = gw; er < nedge; er += NGW) {
        const int g64 = er >> 1, which = er & 1, m = 64 * g64 + (which ? 63 : 0);
        const bool isctx = m >= TL; const int t = isctx ? ((m - TL) & 255) : (m & 8191), len = isctx ? CTXL : SEQ;
        const bool hp = t > 0, hn = t < len - 1;
        const bf16* ac_ = AB + (size_t)(g64 * 4 + (which ? 3 : 0)) * FFH;
        const bf16* ap_ = which ? AB + (size_t)(g64 * 4 + 2) * FFH : AB + (size_t)((g64 - 1) * 4 + 3) * FFH;
        const bf16* an_ = which ? AB + (size_t)((g64 + 1) * 4 + 0) * FFH : AB + (size_t)(g64 * 4 + 1) * FFH;
        const bf16* gt_ = GB + (size_t)(g64 * 2 + which) * FFH;
#pragma unroll
        for (int ci = 0; ci < 6; ++ci) { const int ch = F.lane + 64 * ci; if (ch >= FFH / 8) break;
            const int j0 = 8 * ch; float ac[8], ap[8], an[8], gt[8], o[8];
            unpack8(*(const GAS v4u*)(ac_ + j0), ac); unpack8(*(const GAS v4u*)(gt_ + j0), gt);
            if (hp) unpack8(*(const GAS v4u*)(ap_ + j0), ap); else {
#pragma unroll
                for (int j = 0; j < 8; ++j) ap[j] = 0.f; }
            if (hn) unpack8(*(const GAS v4u*)(an_ + j0), an); else {
#pragma unroll
                for (int j = 0; j < 8; ++j) an[j] = 0.f; }
#pragma unroll
            for (int j = 0; j < 8; ++j) { const float cv = cb[j0 + j] + cw[j0 + j] * ap[j] + cw[FFH + j0 + j] * ac[j] + cw[2 * FFH + j0 + j] * an[j]; o[j] = siluf_(cv) * gt[j]; }
            *(GAS v4u*)(HG + (size_t)m * FFH + j0) = pack8(o);
        }
    }
}
__device__ __forceinline__ void ph_hg_gate(Frame& F) {
    const int gw = F.vcu * NWAVES + F.wave, NGW = F.G * NWAVES;
    bf16* O = (bf16*)(ws_(F) + WS_O); const bf16* G = (const bf16*)(ws_(F) + WS_G);
    const int c0 = 16 * F.lane; float ng[16];
#pragma unroll
    for (int j = 0; j < 16; ++j) ng[j] = inp(F, 29)[(c0 + j) & 127];
    for (int m = gw; m < TL; m += NGW) {
        float o[16], g[16]; unpack8(*(const GAS v4u*)(O + (size_t)m * D + c0), o); unpack8(*(const GAS v4u*)(O + (size_t)m * D + c0 + 8), o + 8);
        unpack8(*(const GAS v4u*)(G + (size_t)m * D + c0), g); unpack8(*(const GAS v4u*)(G + (size_t)m * D + c0 + 8), g + 8);
        float ss = 0.f;
#pragma unroll
        for (int j = 0; j < 16; ++j) ss += o[j] * o[j];
        ss += __shfl_xor(ss, 1); ss += __shfl_xor(ss, 2); ss += __shfl_xor(ss, 4);
        const float sc = 1.f / sqrtf(ss * (1.f / 128.f) + NORM_EPS);
#pragma unroll
        for (int j = 0; j < 16; ++j) o[j] = o[j] * sc * ng[j] * siluf_(g[j]);
        *(GAS v4u*)(O + (size_t)m * D + c0) = pack8(o); *(GAS v4u*)(O + (size_t)m * D + c0 + 8) = pack8(o + 8);
    }
}

typedef short bf16x8_t __attribute__((ext_vector_type(8)));
typedef float f32x16 __attribute__((ext_vector_type(16)));
__device__ __forceinline__ int crow(int r, int hi) { return (r & 3) + 8 * (r >> 2) + 4 * hi; }
constexpr int NCH = TT / 64;
__device__ __forceinline__ void p0_s5_tables(Frame& F) {
    LAS unsigned char* L = F.lds + RING_OFF;
    LAS double* lam = (LAS double*)L;
    LAS float* bb = (LAS float*)(L + 1024);
    LAS float* cc = (LAS float*)(L + 1024 + 8192);
    LAS float* pw = (LAS float*)(L + 1024 + 16384);
    unsigned char* ws = ws_(F);
    for (int item = (int)blockIdx.x - 192; item >= 0 && item < 64; item += F.G) {
        const int g = item >> 1, d = item & 1;
        __syncthreads();
        if (F.tid < 64) { const int n = F.tid, pi = (d * 32 + g) * 64 + n;
            const double lre = inp(F, 17)[pi], lim = inp(F, 18)[pi], dt = exp((double)inp(F, 19)[d * 32 + g]);
            const double mag = exp(lre * dt), are = mag * cos(lim * dt), aim = mag * sin(lim * dt), den = lre * lre + lim * lim, nr = are - 1.0;
            const double fr = (nr * lre + aim * lim) / den, fi = (aim * lre - nr * lim) / den;
            lam[2 * n] = lre * dt; lam[2 * n + 1] = lim * dt;
            for (int q = 0; q < 16; ++q) { const double br = inp(F, 20)[(size_t)pi * 16 + q], bi = inp(F, 21)[(size_t)pi * 16 + q];
                bb[(n * 16 + q) * 2] = (float)(fr * br - fi * bi); bb[(n * 16 + q) * 2 + 1] = (float)(fr * bi + fi * br); } }
        for (int i = F.tid; i < 1024; i += 512) { const int p = i >> 6, n = i & 63; cc[i * 2] = inp(F, 22)[((size_t)(d * 32 + g) * 16 + p) * 64 + n]; cc[i * 2 + 1] = inp(F, 23)[((size_t)(d * 32 + g) * 16 + p) * 64 + n]; }
        __syncthreads();
        if (F.tid < 64) { const int n = F.tid; const double m1 = exp(lam[2 * n]), ar = m1 * cos(lam[2 * n + 1]), ai = m1 * sin(lam[2 * n + 1]);
            double pr = 1.0, pim = 0.0;
            for (int e = 0; e <= 64; ++e) { pw[(e * 64 + n) * 2] = (float)pr; pw[(e * 64 + n) * 2 + 1] = (float)pim; const double nr = pr * ar - pim * ai, ni = pr * ai + pim * ar; pr = nr; pim = ni; } }
        __syncthreads();
        { bf16* WF = (bf16*)(ws + WS_WF) + (size_t)g * 256 * 1024;
          for (int i = F.tid; i < 128 * 128; i += 512) { const int row = i >> 7, grp = i & 127, c = row >> 6, n = row & 63, sI = grp >> 1, q0 = (grp & 1) * 8, e = d ? sI : 63 - sI;
              const float pr = pw[(e * 64 + n) * 2], pim = pw[(e * 64 + n) * 2 + 1]; float o[8];
#pragma unroll
              for (int j = 0; j < 8; ++j) { const float br = bb[(n * 16 + q0 + j) * 2], bi = bb[(n * 16 + q0 + j) * 2 + 1]; o[j] = c ? (pr * bi + pim * br) : (pr * br - pim * bi); }
              *(GAS v4u*)(WF + (size_t)(d * 128 + row) * 1024 + sI * 16 + q0) = pack8(o); } }
        { bf16* WC = (bf16*)(ws + WS_WC) + (size_t)g * 1024 * 256;
          for (int i = F.tid; i < 1024 * 16; i += 512) { const int row = i >> 4, grp = i & 15, t = row >> 4, p = row & 15, c = grp >> 3, n0 = (grp & 7) * 8, ex = d ? 64 - t : t + 1; float o[8];
#pragma unroll
              for (int j = 0; j < 8; ++j) { const int n = n0 + j; const float pr = pw[(ex * 64 + n) * 2], pim = pw[(ex * 64 + n) * 2 + 1], cr = cc[(p * 64 + n) * 2], ci = cc[(p * 64 + n) * 2 + 1];
                  o[j] = c ? -(cr * pim + ci * pr) : (cr * pr - ci * pim); }
              *(GAS v4u*)(WC + (size_t)row * 256 + d * 128 + c * 64 + n0) = pack8(o); } }
        { bf16* TP = (bf16*)(ws + WS_TOEP) + (size_t)g * 127 * 256; float* T0 = (float*)(ws + WS_T0) + (size_t)(g * 2 + d) * 256;
          for (int i = F.tid; i < 64 * 16; i += 512) { const int tau = i >> 4, p = i & 15; float acc[16];
#pragma unroll
              for (int q = 0; q < 16; ++q) acc[q] = 0.f;
              for (int n = 0; n < 64; ++n) { const float pr = pw[(tau * 64 + n) * 2], pim = pw[(tau * 64 + n) * 2 + 1], cr = cc[(p * 64 + n) * 2], ci = cc[(p * 64 + n) * 2 + 1];
                  const float tr = cr * pr - ci * pim, ti = cr * pim + ci * pr;
                  const LAS f32x4* bq = (const LAS f32x4*)(bb + n * 32);
#pragma unroll
                  for (int q4 = 0; q4 < 8; ++q4) { const f32x4 v = bq[q4]; acc[2 * q4] += tr * v.x - ti * v.y; acc[2 * q4 + 1] += tr * v.z - ti * v.w; } }
              if (tau == 0) {
#pragma unroll
                  for (int q = 0; q < 16; ++q) T0[p * 16 + q] = acc[q]; }
              else { bf16* o = TP + (size_t)(d ? 63 - tau : 63 + tau) * 256 + p * 16; *(GAS v4u*)o = pack8(acc); *(GAS v4u*)(o + 8) = pack8(acc + 8); } } }
        if (F.tid < 64) { float* A64 = (float*)(ws + WS_A64) + (size_t)((g * 2 + d) * 64 + F.tid) * 2; A64[0] = pw[(64 * 64 + F.tid) * 2]; A64[1] = pw[(64 * 64 + F.tid) * 2 + 1]; }
    }
    __syncthreads();
}
__device__ __forceinline__ void ph_s5_finals(Frame& F) {
    const int lane = F.lane, r32 = lane & 31, hh = lane >> 5, wave = F.wave;
    unsigned char* ws = ws_(F);
    for (int u = blockIdx.x; u < 288; u += F.G) {
        const int g = u / 9, nb = u % 9; int chunk = nb * 32 + r32; const bool valid = chunk < NCH; if (!valid) chunk = NCH - 1;
        const bf16* ub = (const bf16*)(ws + WS_UG) + ((size_t)g * TT + (size_t)chunk * 64) * 16 + 8 * hh;
        const bf16* wf = (const bf16*)(ws + WS_WF) + ((size_t)(g * 256 + 32 * wave + r32)) * 1024 + 8 * hh;
        f32x16 acc;
#pragma unroll
        for (int r = 0; r < 16; ++r) acc[r] = 0.f;
#pragma unroll 16
        for (int sI = 0; sI < 64; ++sI) { const bf16x8_t a = *(const GAS bf16x8_t*)(wf + 16 * sI), b = *(const GAS bf16x8_t*)(ub + 16 * sI); acc = __builtin_amdgcn_mfma_f32_32x32x16_bf16(a, b, acc, 0, 0, 0); }
        if (valid) { float* fo = (float*)(ws + WS_FIN) + ((size_t)g * NCH + chunk) * 256 + 32 * wave + 4 * hh;
#pragma unroll
            for (int k = 0; k < 4; ++k) *(GAS f32x4*)(fo + 8 * k) = (f32x4){acc[4 * k], acc[4 * k + 1], acc[4 * k + 2], acc[4 * k + 3]}; }
    }
}
__device__ __forceinline__ int s5_chunk_of(int step, int d, int b) { return step < 4 ? 256 + 4 * b + (d ? 3 - step : step) : 128 * b + (d ? 127 - (step - 4) : step - 4); }
__device__ __forceinline__ void ph_s5_carry(Frame& F) {
    if (F.wave >= 3) return;
    unsigned char* ws = ws_(F);
    for (int item = ((int)F.G - 1 - (int)blockIdx.x) * 3 + F.wave; item < 128; item += 3 * F.G) {
        const int g = item >> 2, d = (item >> 1) & 1, b = item & 1, n = F.lane;
        const float a_r = ((const float*)(ws + WS_A64))[((g * 2 + d) * 64 + n) * 2], a_i = ((const float*)(ws + WS_A64))[((g * 2 + d) * 64 + n) * 2 + 1];
        const float* Fb = (const float*)(ws + WS_FIN) + (size_t)g * NCH * 256 + d * 128 + n; bf16* Sb = (bf16*)(ws + WS_SIN) + (size_t)g * NCH * 256 + d * 128 + n;
        float sr = 0.f, si = 0.f;
        for (int s0 = 0; s0 < 132; s0 += 12) {
            float fr[12], fi[12];
#pragma unroll
            for (int j = 0; j < 12; ++j) { const int c = s5_chunk_of(s0 + j, d, b); fr[j] = Fb[(size_t)c * 256]; fi[j] = Fb[(size_t)c * 256 + 64]; }
#pragma unroll
            for (int j = 0; j < 12; ++j) { const int c = s5_chunk_of(s0 + j, d, b); Sb[(size_t)c * 256] = (bf16)f2bf(sr); Sb[(size_t)c * 256 + 64] = (bf16)f2bf(si);
                const float nr = a_r * sr - a_i * si + fr[j], ni = a_r * si + a_i * sr + fi[j]; sr = nr; si = ni; }
        }
    }
}
constexpr int TP_PITCH = 48;
__device__ __forceinline__ void ph_s5_out(Frame& F) {
    LAS unsigned char* L = F.lds + RING_OFF;
    const int lane = F.lane, r32 = lane & 31, hh = lane >> 5, wave = F.wave, tid = F.tid;
    unsigned char* ws = ws_(F);
    for (int u = blockIdx.x; u < 288; u += F.G) {
        const int g = u / 9, nb = u % 9; int chunk = nb * 32 + r32; const bool valid = chunk < NCH; if (!valid) chunk = NCH - 1;
        __syncthreads();
        { const GAS v4u* tp = (const GAS v4u*)((const bf16*)(ws + WS_TOEP) + (size_t)g * 127 * 256); const float* t0 = (const float*)(ws + WS_T0) + (size_t)g * 512;
          for (int c = tid; c < 127 * 32; c += 512) { const int di = c >> 5, p = (c >> 1) & 15, half = c & 1; v4u v;
              if (di == 63) { float o[8];
#pragma unroll
                  for (int j = 0; j < 8; ++j) o[j] = t0[p * 16 + half * 8 + j] + t0[256 + p * 16 + half * 8 + j];
                  v = pack8(o); }
              else v = tp[c];
              *(LAS v4u*)(L + (di * 16 + p) * TP_PITCH + half * 16) = v; } }
        __syncthreads();
        const bf16* ub = (const bf16*)(ws + WS_UG) + ((size_t)g * TT + (size_t)chunk * 64) * 16 + 8 * hh;
        f32x16 acc[4];
#pragma unroll
        for (int i = 0; i < 4; ++i)
#pragma unroll
            for (int r = 0; r < 16; ++r) acc[i][r] = 0.f;
        const LAS unsigned char* tl = L + ((63 + 2 * wave + (r32 >> 4)) * 16 + (r32 & 15)) * TP_PITCH + hh * 16;
#pragma unroll 1
        for (int s0 = 0; s0 < 64; s0 += 16) {
            bf16x8_t bq[16];
#pragma unroll
            for (int e = 0; e < 16; ++e) bq[e] = *(const GAS bf16x8_t*)(ub + 16 * (s0 + e));
#pragma unroll
            for (int e = 0; e < 16; ++e) { const int sI = s0 + e; const bf16x8_t b = bq[e];
#pragma unroll
            for (int i = 0; i < 4; ++i) { const bf16x8_t a = *(const LAS bf16x8_t*)(tl + (16 * i - sI) * 16 * TP_PITCH); acc[i] = __builtin_amdgcn_mfma_f32_32x32x16_bf16(a, b, acc[i], 0, 0, 0); }
            }
        }
        { const bf16* sb = (const bf16*)(ws + WS_SIN) + ((size_t)g * NCH + chunk) * 256 + 8 * hh;
          const bf16* wc = (const bf16*)(ws + WS_WC) + ((size_t)g * 1024 + 32 * wave + r32) * 256 + 8 * hh;
#pragma unroll 4
          for (int kk = 0; kk < 16; ++kk) {
              const bf16x8_t b = *(const GAS bf16x8_t*)(sb + 16 * kk);
#pragma unroll
              for (int i = 0; i < 4; ++i) { const bf16x8_t a = *(const GAS bf16x8_t*)(wc + (size_t)(256 * i) * 256 + 16 * kk); acc[i] = __builtin_amdgcn_mfma_f32_32x32x16_bf16(a, b, acc[i], 0, 0, 0); }
          } }
        if (valid) {
            const float* dsk = inp(F, 24) + 16 * g;
#pragma unroll
            for (int i = 0; i < 4; ++i)
#pragma unroll
                for (int k = 0; k < 4; ++k) { const int tloc = 2 * (wave + 8 * i) + (k >> 1), p0 = 8 * (k & 1) + 4 * hh; const size_t m = (size_t)chunk * 64 + tloc;
                    const v2u uw = *(const GAS v2u*)((const bf16*)(ws + WS_UG) + ((size_t)g * TT + m) * 16 + p0);
                    const float y0 = gelu_tanh(acc[i][4 * k] + dsk[p0] * bflo(uw.x)), y1 = gelu_tanh(acc[i][4 * k + 1] + dsk[p0 + 1] * bfhi(uw.x));
                    const float y2 = gelu_tanh(acc[i][4 * k + 2] + dsk[p0 + 2] * bflo(uw.y)), y3 = gelu_tanh(acc[i][4 * k + 3] + dsk[p0 + 3] * bfhi(uw.y));
                    v2u zw; zw.x = pk2(y0, y1); zw.y = pk2(y2, y3);
                    *(GAS v2u*)((bf16*)(ws + WS_Z) + m * 512 + 16 * g + p0) = zw; }
        }
    }
}

__device__ __forceinline__ bf16x8_t pack_frag(const f32x16& p, int base) {
    v4u w; w.x = pg8::cvt_pk_bf16(p[base + 0], p[base + 1]); w.y = pg8::cvt_pk_bf16(p[base + 2], p[base + 3]); w.z = pg8::cvt_pk_bf16(p[base + 4], p[base + 5]); w.w = pg8::cvt_pk_bf16(p[base + 6], p[base + 7]);
    return __builtin_bit_cast(bf16x8_t, w);
}
constexpr int AT_KP = 208, AT_VP = 272;
constexpr int AT_KB = 128 * AT_KP, AT_VB = 64 * AT_VP;
constexpr int AT_K0 = 0, AT_V0 = 2 * AT_KB, AT_WS = 2 * AT_KB + 2 * AT_VB;
__device__ __forceinline__ void ph_attn(Frame& F) {
    LAS unsigned char* L = F.lds + RING_OFF;
    const int lane = F.lane, r32 = lane & 31, hi = lane >> 5, wave = F.wave, tid = F.tid;
    volatile LAS float* wsf = (volatile LAS float*)(L + AT_WS) + wave * 32;
    const bf16* Qb = (const bf16*)(ws_(F) + WS_QB); const bf16* Kb = (const bf16*)(ws_(F) + WS_KB); const bf16* Vt = (const bf16*)(ws_(F) + WS_VB);
    bf16* MIX = (bf16*)(ws_(F) + WS_MIX);
    int kl[3], vl[2];
#pragma unroll
    for (int i = 0; i < 3; ++i) { const int c = tid + 512 * i; kl[i] = (c / 12) * AT_KP + (c % 12) * 16; }
#pragma unroll
    for (int i = 0; i < 2; ++i) { const int c = tid + 512 * i; vl[i] = ((c & 511) >> 3) * AT_VP + (c >> 9) * 128 + (c & 7) * 16; }
    for (int it = 0; it < 3; ++it) {
        int u; if (it < 2) u = it * 256 + F.vcu; else { if (F.vcu >= 16) break; u = 512 + F.vcu; }
        int b, h, tq0, NT, m0;
        if (u < 512) { b = u >> 8; h = (u >> 5) & 7; tq0 = (u & 31) * 256; NT = TQK / 128; m0 = b * SEQ + tq0; }
        else { const int uc = u - 512; b = uc >> 3; h = uc & 7; tq0 = SEQ; NT = CTXL / 128; m0 = TL + b * CTXL; }
        const size_t bh = (size_t)(b * 8 + h);
        const GAS v4u* Kg = (const GAS v4u*)(Kb + bh * TQK * 96);
        const GAS v4u* Vg = (const GAS v4u*)(Vt + bh * (TQK / 64) * 4096);
        bf16x8_t qf[6];
        { const bf16* qp = Qb + (bh * TQK + tq0 + wave * 32 + r32) * 96 + hi * 8;
#pragma unroll
          for (int ks = 0; ks < 6; ++ks) qf[ks] = *(const GAS bf16x8_t*)(qp + ks * 16); }
        f32x16 o0, o1;
#pragma unroll
        for (int r = 0; r < 16; ++r) { o0[r] = 0.f; o1[r] = 0.f; }
        float m_run = -1e30f, l_run = 0.f;
        __syncthreads();
        { v4u a[3], v[2];
#pragma unroll
          for (int i = 0; i < 3; ++i) a[i] = Kg[tid + 512 * i];
#pragma unroll
          for (int i = 0; i < 2; ++i) v[i] = Vg[tid + 512 * i];
#pragma unroll
          for (int i = 0; i < 3; ++i) *(LAS v4u*)(L + AT_K0 + kl[i]) = a[i];
#pragma unroll
          for (int i = 0; i < 2; ++i) *(LAS v4u*)(L + AT_V0 + vl[i]) = v[i]; }
        __syncthreads();
        for (int t = 0; t < NT; ++t) {
            const int cur = t & 1, nxt = cur ^ 1; const bool more = (t + 1 < NT);
            v4u na[3], nv[2];
#pragma unroll
            for (int i = 0; i < 3; ++i) na[i] = (v4u){0u, 0u, 0u, 0u};
#pragma unroll
            for (int i = 0; i < 2; ++i) nv[i] = (v4u){0u, 0u, 0u, 0u};
            if (more) {
#pragma unroll
                for (int i = 0; i < 3; ++i) na[i] = Kg[(size_t)(t + 1) * 1536 + tid + 512 * i];
#pragma unroll
                for (int i = 0; i < 2; ++i) nv[i] = Vg[(size_t)(t + 1) * 1024 + tid + 512 * i]; }
            const LAS unsigned char* Kl = L + AT_K0 + cur * AT_KB + r32 * AT_KP + hi * 16;
            const LAS unsigned char* Vl = L + AT_V0 + cur * AT_VB + r32 * AT_VP + hi * 16;
            f32x16 p[4];
#pragma unroll
            for (int kb = 0; kb < 4; ++kb) {
#pragma unroll
                for (int r = 0; r < 16; ++r) p[kb][r] = 0.f;
#pragma unroll
                for (int ks = 0; ks < 6; ++ks) p[kb] = __builtin_amdgcn_mfma_f32_32x32x16_bf16(*(const LAS bf16x8_t*)(Kl + kb * 32 * AT_KP + ks * 32), qf[ks], p[kb], 0, 0, 0);
            }
            float mt = fmaxf(fmaxf(p[0][0], p[1][0]), fmaxf(p[2][0], p[3][0]));
#pragma unroll
            for (int r = 1; r < 16; ++r) mt = fmaxf(mt, fmaxf(fmaxf(p[0][r], p[1][r]), fmaxf(p[2][r], p[3][r])));
            mt = fmaxf(mt, __shfl_xor(mt, 32));
            const bool need = mt > m_run + 8.0f;
            if (__any(need)) {
                const float mn = need ? mt : m_run, alpha = __builtin_amdgcn_exp2f(m_run - mn);
                l_run *= alpha; m_run = mn;
                if (hi == 0) wsf[r32] = alpha;
#pragma unroll
                for (int r = 0; r < 16; ++r) { const float a = wsf[crow(r, hi)]; o0[r] *= a; o1[r] *= a; }
            }
            float sum = 0.f;
#pragma unroll
            for (int kb = 0; kb < 4; ++kb)
#pragma unroll
                for (int r = 0; r < 16; ++r) { p[kb][r] = __builtin_amdgcn_exp2f(p[kb][r] - m_run); sum += p[kb][r]; }
            l_run += sum;
#pragma unroll
            for (int kb = 0; kb < 4; ++kb) {
                const bf16x8_t pa = pack_frag(p[kb], 0), pb = pack_frag(p[kb], 8);
                const LAS unsigned char* vp = Vl + (kb >> 1) * 128 + (kb & 1) * 64;
                o0 = __builtin_amdgcn_mfma_f32_32x32x16_bf16(pa, *(const LAS bf16x8_t*)(vp), o0, 0, 0, 0);
                o0 = __builtin_amdgcn_mfma_f32_32x32x16_bf16(pb, *(const LAS bf16x8_t*)(vp + 32), o0, 0, 0, 0);
                o1 = __builtin_amdgcn_mfma_f32_32x32x16_bf16(pa, *(const LAS bf16x8_t*)(vp + 32 * AT_VP), o1, 0, 0, 0);
                o1 = __builtin_amdgcn_mfma_f32_32x32x16_bf16(pb, *(const LAS bf16x8_t*)(vp + 32 * AT_VP + 32), o1, 0, 0, 0);
            }
            if (more) {
#pragma unroll
                for (int i = 0; i < 3; ++i) *(LAS v4u*)(L + AT_K0 + nxt * AT_KB + kl[i]) = na[i];
#pragma unroll
                for (int i = 0; i < 2; ++i) *(LAS v4u*)(L + AT_V0 + nxt * AT_VB + vl[i]) = nv[i]; }
            __syncthreads();
        }
        l_run += __shfl_xor(l_run, 32);
        if (hi == 0) wsf[r32] = 1.0f / l_run;
#pragma unroll
        for (int r = 0; r < 16; ++r) { const int q = crow(r, hi); const float inv = wsf[q];
            bf16* op = MIX + (size_t)(m0 + wave * 32 + q) * D + h * 64 + r32;
            op[0] = (bf16)f2bf(o0[r] * inv); op[32] = (bf16)f2bf(o1[r] * inv); }
    }
}

constexpr int HG_QT = 0, HG_KT = 17408, HG_KH = 34816, HG_VT = 53248, HG_ST = 71680, HG_DEC = 106496, HG_TOT = 107008;
constexpr int HG_NSC = 17;
constexpr size_t WS_SD = 231 * MiB;
constexpr size_t WS_DECS = WS_SD + 18 * MiB;
static_assert(WS_DECS + 32 * 17 * 128 * 4 <= WS_END, "hgrn ws");
template <bool OUT>
__device__ __forceinline__ void hgrn_pass(Frame& F, int b, int h, int dir, int sc, f32x16 (&st)[2], float& dsum) {
    LAS unsigned char* L = F.lds + RING_OFF;
    unsigned char* ws = ws_(F);
    const int tid = F.tid, lane = F.lane, r32 = lane & 31, hh = lane >> 5, wave = F.wave;
    const int k = tid & 127, tg = tid >> 7;
    const int nch = sc == 0 ? 4 : 8; const size_t rowbase = sc == 0 ? (size_t)TL + b * CTXL : (size_t)b * SEQ + (size_t)(sc - 1) * 512;
    const bf16* QF = (const bf16*)(ws + WS_QFFI);
    const float lb = ((const float*)(ws + WS_LBV))[dir * 1024 + h * 128 + k];
    const int colf = 1024 * (1 + dir) + h * 128 + k, colq = h * 128 + k, colv = 3072 + h * 128 + k;
    const int dvb = wave & 3, jb = wave >> 2;
    bf16 rq[16], rf[16], rv[16];
#define HG_LOAD(ci) do { const int cc_ = dir ? nch - 1 - (ci) : (ci); const int tl0_ = dir ? 63 - 16 * tg : 16 * tg; \
        const GAS bf16* pf_ = (const GAS bf16*)(QF + (rowbase + 64 * cc_ + tl0_) * 4096 + colf); const GAS bf16* pv_ = pf_ + (colv - colf); const GAS bf16* pq_ = pf_ + (colq - colf); const long stp_ = dir ? -4096 : 4096; \
        _Pragma("unroll") for (int jj = 0; jj < 16; ++jj) { rf[jj] = *pf_; rv[jj] = *pv_; if (OUT) rq[jj] = *pq_; pf_ += stp_; pv_ += stp_; pq_ += stp_; asm volatile("" : "+v"(pf_), "+v"(pv_), "+v"(pq_)); } } while (0)
    HG_LOAD(0);
    for (int ci = 0; ci < nch; ++ci) {
        const int cc = dir ? nch - 1 - ci : ci;
        float cum[16], kk[16];
        { float run = 0.f;
#pragma unroll
          for (int jj = 0; jj < 16; ++jj) { const float f = lb + (1.f - lb) * sigmoidf_(bf2f(rf[jj])); run += __log2f(f); cum[jj] = run; kk[jj] = 1.f - f; }
          ((LAS float*)(L + HG_TOT))[tg * 128 + k] = run; }
        __syncthreads();
        { const LAS float* tot = (const LAS float*)(L + HG_TOT) + k; const float t0 = tot[0], t1 = tot[128], t2 = tot[256], t3 = tot[384];
          const float pre = tg == 0 ? 0.f : (tg == 1 ? t0 : (tg == 2 ? t0 + t1 : t0 + t1 + t2)), total = (t0 + t1) + (t2 + t3);
          if (tg == 0) { ((LAS float*)(L + HG_DEC))[k] = __builtin_amdgcn_exp2f(total); dsum += total; }
#define HG_KH(jj) (kk[jj] * __builtin_amdgcn_exp2f(total - (pre + cum[jj])))
#define HG_PKV(a, b_) ((unsigned)rv[a] | ((unsigned)rv[b_] << 16))
          if (OUT) {
#pragma unroll
              for (int jj = 0; jj < 16; ++jj) { const float c = pre + cum[jj]; const int j = 16 * tg + jj;
                  *(LAS bf16*)(L + HG_QT + j * 272 + k * 2) = (bf16)f2bf(bf2f(rq[jj]) * __builtin_amdgcn_exp2f(c)); *(LAS bf16*)(L + HG_KT + j * 272 + k * 2) = (bf16)f2bf(kk[jj] * __builtin_amdgcn_exp2f(-c)); } }
          v4u w0, w1;
          w0.x = pk2(HG_KH(0), HG_KH(1)); w0.y = pk2(HG_KH(2), HG_KH(3)); w0.z = pk2(HG_KH(8), HG_KH(9)); w0.w = pk2(HG_KH(10), HG_KH(11));
          w1.x = pk2(HG_KH(4), HG_KH(5)); w1.y = pk2(HG_KH(6), HG_KH(7)); w1.z = pk2(HG_KH(12), HG_KH(13)); w1.w = pk2(HG_KH(14), HG_KH(15));
          *(LAS v4u*)(L + HG_KH + k * 144 + tg * 32) = w0; *(LAS v4u*)(L + HG_KH + k * 144 + tg * 32 + 16) = w1;
          w0.x = HG_PKV(0, 1); w0.y = HG_PKV(2, 3); w0.z = HG_PKV(8, 9); w0.w = HG_PKV(10, 11);
          w1.x = HG_PKV(4, 5); w1.y = HG_PKV(6, 7); w1.z = HG_PKV(12, 13); w1.w = HG_PKV(14, 15);
          *(LAS v4u*)(L + HG_VT + k * 144 + tg * 32) = w0; *(LAS v4u*)(L + HG_VT + k * 144 + tg * 32 + 16) = w1; }
#undef HG_KH
#undef HG_PKV
        if (ci + 1 < nch) HG_LOAD(ci + 1);
        __syncthreads();
        if (OUT) {
            f32x16 oacc;
#pragma unroll
            for (int r = 0; r < 16; ++r) oacc[r] = 0.f;
            const LAS unsigned char* qrow = L + HG_QT + (32 * jb + r32) * 272 + hh * 16;
            const LAS unsigned char* srow = L + HG_ST + (32 * dvb + r32) * 272 + hh * 16;
            const LAS unsigned char* vrow = L + HG_VT + (32 * dvb + r32) * 144 + hh * 16;
#pragma unroll
            for (int ks = 0; ks < 8; ++ks) oacc = __builtin_amdgcn_mfma_f32_32x32x16_bf16(*(const LAS bf16x8_t*)(qrow + ks * 32), *(const LAS bf16x8_t*)(srow + ks * 32), oacc, 0, 0, 0);
            {
                f32x16 at;
#pragma unroll
                for (int r = 0; r < 16; ++r) at[r] = 0.f;
                const LAS unsigned char* krow = L + HG_KT + r32 * 272 + hh * 16;
#pragma unroll
                for (int ks = 0; ks < 8; ++ks) at = __builtin_amdgcn_mfma_f32_32x32x16_bf16(*(const LAS bf16x8_t*)(krow + ks * 32), *(const LAS bf16x8_t*)(qrow + ks * 32), at, 0, 0, 0);
                if (jb == 0) {
#pragma unroll
                    for (int r = 0; r < 16; ++r) if (crow(r, hh) > r32) at[r] = 0.f; }
                oacc = __builtin_amdgcn_mfma_f32_32x32x16_bf16(pack_frag(at, 0), *(const LAS bf16x8_t*)(vrow + 0), oacc, 0, 0, 0);
                oacc = __builtin_amdgcn_mfma_f32_32x32x16_bf16(pack_frag(at, 8), *(const LAS bf16x8_t*)(vrow + 32), oacc, 0, 0, 0);
            }
            if (jb == 1) {
                f32x16 at;
#pragma unroll
                for (int r = 0; r < 16; ++r) at[r] = 0.f;
                const LAS unsigned char* krow = L + HG_KT + (32 + r32) * 272 + hh * 16;
#pragma unroll
                for (int ks = 0; ks < 8; ++ks) at = __builtin_amdgcn_mfma_f32_32x32x16_bf16(*(const LAS bf16x8_t*)(krow + ks * 32), *(const LAS bf16x8_t*)(qrow + ks * 32), at, 0, 0, 0);
#pragma unroll
                for (int r = 0; r < 16; ++r) if (crow(r, hh) > r32) at[r] = 0.f;
                oacc = __builtin_amdgcn_mfma_f32_32x32x16_bf16(pack_frag(at, 0), *(const LAS bf16x8_t*)(vrow + 64), oacc, 0, 0, 0);
                oacc = __builtin_amdgcn_mfma_f32_32x32x16_bf16(pack_frag(at, 8), *(const LAS bf16x8_t*)(vrow + 96), oacc, 0, 0, 0);
            }
            bf16* O = (bf16*)(ws + WS_O);
#pragma unroll
            for (int r = 0; r < 16; ++r) { const int j = 32 * jb + crow(r, hh), tl = dir ? 63 - j : j;
                bf16* op = O + (rowbase + 64 * cc + tl) * D + h * 128 + 32 * dvb + r32; float ov = oacc[r];
                if (dir) ov += bf2f(*op);
                *op = (bf16)f2bf(ov); }
        }
#pragma unroll
        for (int t = 0; t < 2; ++t) { const int dkb = 2 * (wave >> 2) + t;
#pragma unroll
            for (int q4 = 0; q4 < 4; ++q4) { const f32x4 dd = *(const LAS f32x4*)(L + HG_DEC + (32 * dkb + 8 * q4 + 4 * hh) * 4);
                st[t][4 * q4] *= dd[0]; st[t][4 * q4 + 1] *= dd[1]; st[t][4 * q4 + 2] *= dd[2]; st[t][4 * q4 + 3] *= dd[3]; }
            const LAS unsigned char* arow = L + HG_KH + (32 * dkb + r32) * 144 + hh * 16; const LAS unsigned char* vrow = L + HG_VT + (32 * dvb + r32) * 144 + hh * 16;
#pragma unroll
            for (int ks = 0; ks < 4; ++ks) st[t] = __builtin_amdgcn_mfma_f32_32x32x16_bf16(*(const LAS bf16x8_t*)(arow + ks * 32), *(const LAS bf16x8_t*)(vrow + ks * 32), st[t], 0, 0, 0); }
        __syncthreads();
        if (OUT && ci + 1 < nch) {
#pragma unroll
            for (int t = 0; t < 2; ++t) { const int dkb = 2 * (wave >> 2) + t;
#pragma unroll
                for (int q4 = 0; q4 < 4; ++q4) { v2u w; w.x = pk2(st[t][4 * q4], st[t][4 * q4 + 1]); w.y = pk2(st[t][4 * q4 + 2], st[t][4 * q4 + 3]);
                    *(LAS v2u*)(L + HG_ST + (32 * dvb + r32) * 272 + (32 * dkb + 8 * q4 + 4 * hh) * 2) = w; } }
        }
    }
#undef HG_LOAD
}
__device__ __forceinline__ void ph_hgrn_states(Frame& F) {
    unsigned char* ws = ws_(F);
    for (int item = blockIdx.x; item < 32 * HG_NSC; item += F.G) {
        const int chain = item / HG_NSC, sc = item % HG_NSC, b = chain >> 4, h = (chain >> 1) & 7, dir = chain & 1;
        f32x16 st[2];
#pragma unroll
        for (int t = 0; t < 2; ++t)
#pragma unroll
            for (int r = 0; r < 16; ++r) st[t][r] = 0.f;
        float dsum = 0.f;
        hgrn_pass<false>(F, b, h, dir, sc, st, dsum);
        bf16* sd = (bf16*)(ws + WS_SD) + ((size_t)(chain * HG_NSC + sc) * 8 + F.wave) * 2048 + F.lane;
#pragma unroll
        for (int t = 0; t < 2; ++t)
#pragma unroll
            for (int r = 0; r < 16; ++r) sd[(t * 16 + r) * 64] = (bf16)f2bf(st[t][r]);
        if (F.tid < 128) ((float*)(ws + WS_DECS))[(size_t)(chain * HG_NSC + sc) * 128 + F.tid] = dsum;
    }
}
__device__ __forceinline__ void ph_hgrn_out(Frame& F) {
    LAS unsigned char* L = F.lds + RING_OFF;
    unsigned char* ws = ws_(F);
    const int lane = F.lane, r32 = lane & 31, hh = lane >> 5, wave = F.wave, dvb = wave & 3;
    for (int item = blockIdx.x; item < 256; item += F.G) {
        const int b = item >> 7, h = (item >> 4) & 7, Lsc = item & 15, sc = Lsc + 1;
        for (int dir = 0; dir < 2; ++dir) {
            const int chain = (b * 8 + h) * 2 + dir;
            f32x16 st[2];
#pragma unroll
            for (int t = 0; t < 2; ++t)
#pragma unroll
                for (int r = 0; r < 16; ++r) st[t][r] = 0.f;
            const int npre = dir ? 1 + (16 - sc) : sc;
            for (int i = 0; i < npre; ++i) {
                const int sp = (i == 0) ? 0 : (dir ? 17 - i : i);
                const bf16* sd = (const bf16*)(ws + WS_SD) + ((size_t)(chain * HG_NSC + sp) * 8 + wave) * 2048 + lane;
                const float* dl = (const float*)(ws + WS_DECS) + (size_t)(chain * HG_NSC + sp) * 128;
#pragma unroll
                for (int t = 0; t < 2; ++t) { const int dkb = 2 * (wave >> 2) + t;
#pragma unroll
                    for (int q4 = 0; q4 < 4; ++q4) { const f32x4 dd = *(const GAS f32x4*)(dl + 32 * dkb + 8 * q4 + 4 * hh);
#pragma unroll
                        for (int e = 0; e < 4; ++e) st[t][4 * q4 + e] = __builtin_amdgcn_exp2f(dd[e]) * st[t][4 * q4 + e] + bf2f(sd[(t * 16 + 4 * q4 + e) * 64]); } }
            }
            __syncthreads();
#pragma unroll
            for (int t = 0; t < 2; ++t) { const int dkb = 2 * (wave >> 2) + t;
#pragma unroll
                for (int q4 = 0; q4 < 4; ++q4) { v2u w; w.x = pk2(st[t][4 * q4], st[t][4 * q4 + 1]); w.y = pk2(st[t][4 * q4 + 2], st[t][4 * q4 + 3]);
                    *(LAS v2u*)(L + HG_ST + (32 * dvb + r32) * 272 + (32 * dkb + 8 * q4 + 4 * hh) * 2) = w; } }
            float dsum = 0.f;
            hgrn_pass<true>(F, b, h, dir, sc, st, dsum);
            __syncthreads();
        }
    }
}

struct FInProj {
    bf16* cqkv; bf16* ug;
    __device__ __forceinline__ void operator()(int row, int col, f32x4 v0, f32x4 v1) const {
        v4u w; w.x = pg8::cvt_pk_bf16(v0[0], v0[1]); w.y = pg8::cvt_pk_bf16(v0[2], v0[3]); w.z = pg8::cvt_pk_bf16(v1[0], v1[1]); w.w = pg8::cvt_pk_bf16(v1[2], v1[3]);
        if (col < 672) *(GAS v4u*)(cqkv + (size_t)row * CQKV_LD + col) = w;
        else if (col < EVEN_IN) { const int c = col - 672; *(GAS v4u*)(ug + ((size_t)(c >> 4) * TT + row) * 16 + (c & 15)) = w; }
    }
};
struct FBf16 {
    bf16* o; int ld;
    __device__ __forceinline__ void operator()(int row, int col, f32x4 v0, f32x4 v1) const {
        v4u w; w.x = pg8::cvt_pk_bf16(v0[0], v0[1]); w.y = pg8::cvt_pk_bf16(v0[2], v0[3]); w.z = pg8::cvt_pk_bf16(v1[0], v1[1]); w.w = pg8::cvt_pk_bf16(v1[2], v1[3]);
        *(GAS v4u*)(o + (size_t)row * ld + col) = w;
    }
};
struct EpiGlu {
    static constexpr bool PERM = true, AFTER_DRAIN = false;
    const bf16* z; bf16* mix;
    __device__ __forceinline__ void operator()(const pg8::f32x4 (&acc)[2][2][4][2], const pg8::Unit& u, int wr, int wc, int fr, int fq) const {
        const int row0 = u.pm * 256 + wr * 64 + fr, col0 = u.pn * 256 + wc * 32 + 8 * fq;
#pragma unroll
        for (int ai = 0; ai < 2; ++ai) {
            v4u zz[4][2];
#pragma unroll
            for (int m = 0; m < 4; ++m)
#pragma unroll
                for (int bj = 0; bj < 2; ++bj) zz[m][bj] = *(const GAS v4u*)(z + (size_t)(row0 + ai * 128 + m * 16) * 512 + col0 + bj * 128);
#pragma unroll
            for (int m = 0; m < 4; ++m)
#pragma unroll
                for (int bj = 0; bj < 2; ++bj) { float zf[8], o[8]; unpack8(zz[m][bj], zf);
#pragma unroll
                    for (int j = 0; j < 4; ++j) { o[j] = zf[j] * sigmoidf_(acc[ai][bj][m][0][j]); o[4 + j] = zf[4 + j] * sigmoidf_(acc[ai][bj][m][1][j]); }
                    *(GAS v4u*)(mix + (size_t)(row0 + ai * 128 + m * 16) * D + 512 + col0 + bj * 128) = pack8(o); }
        }
    }
};
struct FQ {
    bf16* qb; const float* rope;
    __device__ __forceinline__ void operator()(int row, int col, f32x4 v0, f32x4 v1) const {
        float x[8] = {v0[0], v0[1], v0[2], v0[3], v1[0], v1[1], v1[2], v1[3]}, p[8];
#pragma unroll
        for (int j = 0; j < 8; ++j) p[j] = __shfl_xor(x[j], 16);
        const bool isctx = row >= TL; const int b = isctx ? ((row - TL) >> 8) : (row >> 13), t = isctx ? ((row - TL) & 255) : (row & 8191), tq = isctx ? SEQ + t : t;
        const int h = col / 96, d = col - h * 96;
        if (d >= 64 && !isctx) { const int idx = d - 64, a = idx >> 4, half = (idx >> 3) & 1, pos = a ? (t & 63) : (t >> 6);
#pragma unroll
            for (int f = 0; f < 8; ++f) { const float cs = rope[2 * (pos * 8 + f)], sn = rope[2 * (pos * 8 + f) + 1]; x[f] = half ? x[f] * cs + p[f] * sn : x[f] * cs - p[f] * sn; } }
#pragma unroll
        for (int j = 0; j < 8; ++j) x[j] *= QSCALE;
        *(GAS v4u*)(qb + ((size_t)(b * 8 + h) * TQK + tq) * 96 + d) = pack8(x);
        asm volatile("" ::: "memory");
    }
};
struct FKV {
    bf16* kb; bf16* vb;
    __device__ __forceinline__ void operator()(int row, int col, f32x4 v0, f32x4 v1) const {
        v4u w; w.x = pg8::cvt_pk_bf16(v0[0], v0[1]); w.y = pg8::cvt_pk_bf16(v0[2], v0[3]); w.z = pg8::cvt_pk_bf16(v1[0], v1[1]); w.w = pg8::cvt_pk_bf16(v1[2], v1[3]);
        const bool isctx = row >= TL; const int b = isctx ? ((row - TL) >> 8) : (row >> 13), t = isctx ? ((row - TL) & 255) : (row & 8191), tk = isctx ? t : CTXL + t;
        const int h = col >> 7, e = col & 127;
        if (e < 64) *(GAS v4u*)(kb + ((size_t)(b * 8 + h) * TQK + tk) * 96 + e) = w;
        else { const int kk = tk & 63, pos = (kk & 48) | (kk & 3) | ((kk & 4) << 1) | ((kk & 8) >> 1);
            bf16* p = vb + (((size_t)(b * 8 + h) * (TQK / 64) + (tk >> 6)) * 64 + (e - 64)) * 64 + pos;
            p[0] = (bf16)(w.x & 0xffffu); p[64] = (bf16)(w.x >> 16); p[128] = (bf16)(w.y & 0xffffu); p[192] = (bf16)(w.y >> 16);
            p[256] = (bf16)(w.z & 0xffffu); p[320] = (bf16)(w.z >> 16); p[384] = (bf16)(w.w & 0xffffu); p[448] = (bf16)(w.w >> 16); }
    }
};
struct EpiResid {
    static constexpr bool PERM = false, AFTER_DRAIN = false;
    float* xl; float* xc; const float* gate; int first; int row_off;
    __device__ __forceinline__ void operator()(const pg8::f32x4 (&acc)[2][2][4][2], const pg8::Unit& u, int wr, int wc, int fr, int fq) const {
        const int trow = u.pm * 256 + row_off, col0 = u.pn * 256 + wc * 32 + 4 * fq;
        const bool lat = trow < TL;
        GAS float* xb = (GAS float*)(lat ? xl + (size_t)trow * D : xc + (size_t)(trow - TL) * D) + (size_t)(wr * 64 + fr) * D + col0;
        const GAS float* gp = (const GAS float*)gate + (size_t)modrow_of(trow) * 6144 + col0;
        f32x4 gv[2][2];
#pragma unroll
        for (int bj = 0; bj < 2; ++bj)
#pragma unroll
            for (int n = 0; n < 2; ++n) gv[bj][n] = *(const GAS f32x4*)(gp + bj * 128 + n * 16);
        const float a0 = (first && lat) ? DN_ALPHA : 1.0f;
#pragma unroll
        for (int ai = 0; ai < 2; ++ai) {
            f32x4 xo[4][2][2];
#pragma unroll
            for (int m = 0; m < 4; ++m)
#pragma unroll
                for (int bj = 0; bj < 2; ++bj)
#pragma unroll
                    for (int n = 0; n < 2; ++n) xo[m][bj][n] = *(const GAS f32x4*)(xb + (size_t)(ai * 128 + m * 16) * D + bj * 128 + n * 16);
#pragma unroll
            for (int m = 0; m < 4; ++m)
#pragma unroll
                for (int bj = 0; bj < 2; ++bj)
#pragma unroll
                    for (int n = 0; n < 2; ++n) *(GAS f32x4*)(xb + (size_t)(ai * 128 + m * 16) * D + bj * 128 + n * 16) = xo[m][bj][n] * a0 + gv[bj][n] * acc[ai][bj][m][n];
            __builtin_amdgcn_sched_barrier(0);
        }
    }
};
struct FHgIn {
    bf16* qffi; bf16* g;
    __device__ __forceinline__ void operator()(int row, int col, f32x4 v0, f32x4 v1) const {
        v4u w; w.x = pg8::cvt_pk_bf16(v0[0], v0[1]); w.y = pg8::cvt_pk_bf16(v0[2], v0[3]); w.z = pg8::cvt_pk_bf16(v1[0], v1[1]); w.w = pg8::cvt_pk_bf16(v1[2], v1[3]);
        if (col < 4096) *(GAS v4u*)(qffi + (size_t)row * 4096 + col) = w; else *(GAS v4u*)(g + (size_t)row * D + (col - 4096)) = w;
    }
};
struct EpiConvGate {
    static constexpr bool PERM = true, AFTER_DRAIN = false;
    bf16* hg; bf16* ab; bf16* gb; const bf16* cwt;
    __device__ __forceinline__ void operator()(const pg8::f32x4 (&acc)[2][2][4][2], const pg8::Unit& u, int wr, int wc, int fr, int fq) const {
        const int hc0 = 128 * u.pn + 32 * wc + 8 * fq;
        v4u wq[4];
#pragma unroll
        for (int i = 0; i < 4; ++i) wq[i] = *(const GAS v4u*)(cwt + (size_t)(hc0 + 2 * i) * 4);
#pragma unroll
        for (int ai = 0; ai < 2; ++ai) {
            const int rowbase = u.pm * 256 + 128 * ai + 64 * wr, g64 = rowbase >> 6;
#pragma unroll
            for (int n = 0; n < 2; ++n) {
                const int hc = hc0 + 4 * n;
                float out[4][4];
#pragma unroll
                for (int e = 0; e < 4; ++e) { const int c = 4 * n + e; const unsigned pw0 = (c & 1) ? wq[c >> 1].z : wq[c >> 1].x, pw1 = (c & 1) ? wq[c >> 1].w : wq[c >> 1].y;
                    const float w0 = bflo(pw0), w1 = bfhi(pw0), w2 = bflo(pw1), b0 = bfhi(pw1);
                    float a[4], up[4], dn[4];
#pragma unroll
                    for (int m = 0; m < 4; ++m) { a[m] = acc[ai][0][m][n][e];
                        up[m] = __builtin_bit_cast(float, __builtin_amdgcn_mov_dpp(__builtin_bit_cast(int, a[m]), 0x121, 0xf, 0xf, false));
                        dn[m] = __builtin_bit_cast(float, __builtin_amdgcn_mov_dpp(__builtin_bit_cast(int, a[m]), 0x12f, 0xf, 0xf, false)); }
#pragma unroll
                    for (int m = 0; m < 4; ++m) { const float prev = fr > 0 ? up[m] : (m > 0 ? up[m > 0 ? m - 1 : 0] : 0.f), next = fr < 15 ? dn[m] : (m < 3 ? dn[m < 3 ? m + 1 : 3] : 0.f);
                        const float cv = b0 + w0 * prev + w1 * a[m] + w2 * next; out[m][e] = siluf_(cv) * acc[ai][1][m][n][e]; } }
#pragma unroll
                for (int m = 0; m < 4; ++m) { const int r64 = 16 * m + fr, row = rowbase + r64;
                    if (r64 != 0 && r64 != 63) { v2u w; w.x = pk2(out[m][0], out[m][1]); w.y = pk2(out[m][2], out[m][3]); *(GAS v2u*)(hg + (size_t)row * FFH + hc) = w; }
                    if (r64 <= 1 || r64 >= 62) { const int slot = r64 <= 1 ? r64 : r64 - 60; const f32x4 ra = acc[ai][0][m][n];
                        v2u w; w.x = pk2(ra[0], ra[1]); w.y = pk2(ra[2], ra[3]); *(GAS v2u*)(ab + (size_t)(g64 * 4 + slot) * FFH + hc) = w;
                        if (r64 == 0 || r64 == 63) { const f32x4 rg = acc[ai][1][m][n]; v2u wg; wg.x = pk2(rg[0], rg[1]); wg.y = pk2(rg[2], rg[3]); *(GAS v2u*)(gb + (size_t)(g64 * 2 + (r64 == 63 ? 1 : 0)) * FFH + hc) = wg; } }
                }
                __builtin_amdgcn_sched_barrier(0);
            }
        }
    }
};
template <class E> __device__ __forceinline__ void run_gemm_off(Frame& F, const bf16* A, int lda, const bf16* Bt, int ldb, int M, int N, int K, const E& e, int boff) {
    pg8::Gemm g{A, Bt, M, N, K, lda, ldb}; pg8::StaticOrder S; S.init(M, N, F.G, (int)((blockIdx.x + F.G - boff) % F.G));
    pg8::gemm_phase<E, pg8::StaticOrder, true, true>(F.lds + RING_OFF, g, S, e);
}
template <class E> __device__ __forceinline__ void run_gemm(Frame& F, const bf16* A, int lda, const bf16* Bt, int ldb, int M, int N, int K, const E& e) {
    pg8::Gemm g{A, Bt, M, N, K, lda, ldb}; pg8::StaticOrder S; S.init(M, N, F.G, (int)blockIdx.x);
    pg8::gemm_phase<E, pg8::StaticOrder, true, true>(F.lds + RING_OFF, g, S, e);
}

constexpr int NPH = 26;
struct Args { const float* in[31]; float* out; unsigned char* ws; int ph_lo, ph_hi; };
__global__ void __launch_bounds__(NWAVES * 64, 2) mk_fwd(Args args) {
    extern __shared__ __attribute__((aligned(16))) unsigned char lds[];
    Frame F;
    F.lds = (LAS unsigned char*)lds;
    F.tid = threadIdx.x; F.lane = F.tid & 63; F.wave = __builtin_amdgcn_readfirstlane(F.tid >> 6);
    F.G = gridDim.x; { const int bx = blockIdx.x; F.vcu = (F.G % 8 == 0) ? (bx % 8) * (F.G / 8) + bx / 8 : bx; }
    for (int u = F.tid; u < (LDS_BYTES - LDSCTL_OFF) / 4; u += NWAVES * 64) ((LAS unsigned*)(F.lds + LDSCTL_OFF))[u] = 0u;
    __syncthreads();
    if (F.tid == 0) {
#pragma unroll
        for (int i = 0; i < 31; ++i) ((LAS unsigned long long*)(F.lds + PTR_OFF))[i] = (unsigned long long)args.in[i];
        ((LAS unsigned long long*)(F.lds + PTR_OFF))[31] = (unsigned long long)args.ws; ((LAS unsigned long long*)(F.lds + PTR_OFF))[32] = (unsigned long long)args.out;
    }
    __syncthreads();
    const int lo = args.ph_lo, hi = args.ph_hi;
    const bool multi = (hi - lo) > 1;
    if (multi) (void)xcd_barrier_post((unsigned*)ws_(F) + CW_BAR, (volatile LAS unsigned*)(F.lds + MISC_OFF) + 8);
#ifndef ONLY_PHASE
#define ONLY_PHASE -1
#endif
#define WSP ws_(F)
#define MODP ((const float*)(ws_(F) + WS_MOD))
#define ABUF ((bf16*)(ws_(F) + WS_A))
#ifndef SKIP_PHASE
#define SKIP_PHASE -1
#endif
#define IN(k) ((ONLY_PHASE < 0 || ONLY_PHASE == (k)) && SKIP_PHASE != (k) && lo <= (k) && (k) < hi)
#define SEAM(k) do { if (IN(k) && IN((k) + 1)) { XcdBarrier bar_; bar_.bar = (unsigned*)ws_(F) + CW_BAR; bar_.x = xb_xcc_id(); bar_.st = (volatile LAS unsigned*)(F.lds + MISC_OFF) + 8; xcd_barrier(bar_); } asm volatile("" : "+v"(F.tid), "+v"(F.lane)); } while (0)
    int pk = 0;
#ifndef REPEAT_PHASE
#define REPEAT_PHASE -1
#endif
#define PHASE(...) do { if (IN(pk)) { __VA_ARGS__ } if (REPEAT_PHASE == pk && IN(pk)) { { XcdBarrier bar_; bar_.bar = (unsigned*)ws_(F) + CW_BAR; bar_.x = xb_xcc_id(); bar_.st = (volatile LAS unsigned*)(F.lds + MISC_OFF) + 8; xcd_barrier(bar_); } asm volatile("" : "+v"(F.tid), "+v"(F.lane)); { __VA_ARGS__ } } SEAM(pk); ++pk; } while (0)
    PHASE( p0_prologue(F); p0_s5_tables(F); );
    PHASE( ph_init_rows(F); );
    PHASE( pg8::Epi8<FInProj> e{{(bf16*)(WSP + WS_CQKV), (bf16*)(WSP + WS_UG)}}; run_gemm(F, ABUF, D, (const bf16*)(WSP + WS_WIN0), D, TT, EVEN_IN_PAD, D, e); );
    PHASE( ph_s5_finals(F); );
    PHASE( ph_s5_carry(F); );
    PHASE( ph_mla_norm(F); );
    PHASE(
#ifndef DUPQ
#define DUPQ 1
#endif
#ifndef DUPKV
#define DUPKV 1
#endif
        _Pragma("unroll") for (int rep = 0; rep < DUPQ; ++rep) { pg8::Epi8<FQ> e{{(bf16*)(WSP + WS_QB), (const float*)(WSP + WS_ROPE)}}; run_gemm(F, (const bf16*)(WSP + WS_CQKV), CQKV_LD, (const bf16*)(WSP + WS_WUQ), 384, TT, 768, 384, e); }
        _Pragma("unroll") for (int rep = 0; rep < DUPKV; ++rep) { pg8::Epi8<FKV> e{{(bf16*)(WSP + WS_KB), (bf16*)(WSP + WS_VB)}}; run_gemm(F, (const bf16*)(WSP + WS_CQKV) + 384, CQKV_LD, (const bf16*)(WSP + WS_WUKV), 256, TT, 1024, 256, e); }
    );
    PHASE( ph_s5_out(F); );
    PHASE( ph_attn(F); );
    PHASE( EpiGlu e{(const bf16*)(WSP + WS_Z), (bf16*)(WSP + WS_MIX)}; run_gemm(F, (const bf16*)(WSP + WS_Z), 512, (const bf16*)(WSP + WS_WGLU), 512, TT, 512, 512, e); );
    PHASE( EpiResid e{out_(F), (float*)(WSP + WS_XC), MODP + 0 * 3 * 6144 + 2 * 1024, 1, 0}; run_gemm(F, (const bf16*)(WSP + WS_MIX), D, (const bf16*)(WSP + WS_WOUT0), D, TT, D, D, e); );
    PHASE( ph_layernorm(F, TT, 0, 0, 0, 3, nullptr, 0); );
    PHASE( EpiConvGate e{(bf16*)(WSP + WS_HG), (bf16*)(WSP + WS_AB), (bf16*)(WSP + WS_GB), (const bf16*)(WSP + WS_CWT)}; run_gemm(F, ABUF, D, (const bf16*)(WSP + WS_F1T0), D, TT, 2 * FFH, D, e); );
    PHASE( ph_convfix(F, TT, 0); );
    PHASE( EpiResid e{out_(F), (float*)(WSP + WS_XC), MODP + 0 * 3 * 6144 + 5 * 1024, 1, 0}; run_gemm(F, (const bf16*)(WSP + WS_HG), FFH, (const bf16*)(WSP + WS_F2T0), FFH, TT, D, FFH, e); );
    PHASE( ph_layernorm(F, TT, 0, 1, 1, 0, nullptr, 0); );
    PHASE( pg8::Epi8<FHgIn> e{{(bf16*)(WSP + WS_QFFI), (bf16*)(WSP + WS_G)}}; run_gemm(F, ABUF, D, (const bf16*)(WSP + WS_HGINT), D, TT, 5120, D, e); );
    PHASE( ph_hgrn_states(F); );
    PHASE( ph_hgrn_out(F); );
    PHASE( ph_hg_gate(F); );
    PHASE( EpiResid e{out_(F), (float*)(WSP + WS_XC), MODP + 1 * 3 * 6144 + 2 * 1024, 1, 0}; run_gemm(F, (const bf16*)(WSP + WS_O), D, (const bf16*)(WSP + WS_HGOUTT), D, TL, D, D, e); );
    PHASE( ph_layernorm(F, TL, 1, 0, 1, 3); );
    PHASE( EpiConvGate e{(bf16*)(WSP + WS_HG), (bf16*)(WSP + WS_AB), (bf16*)(WSP + WS_GB), (const bf16*)(WSP + WS_CWT) + (size_t)FFH * 4}; run_gemm(F, ABUF, D, (const bf16*)(WSP + WS_F1T1), D, TL, 2 * FFH, D, e); );
    PHASE( ph_convfix(F, TL, 1); );
    PHASE( EpiResid e{out_(F), (float*)(WSP + WS_XC), MODP + 1 * 3 * 6144 + 5 * 1024, 1, 0}; run_gemm(F, (const bf16*)(WSP + WS_HG), FFH, (const bf16*)(WSP + WS_F2T1), FFH, TL, D, FFH, e); );
    PHASE( ph_layernorm(F, TL, 1, 1, -1, 0); );
#undef PHASE
#undef IN
#undef SEAM
}

extern "C" void kernel_launch(void* const* d_in, const int* in_sizes, int n_in, void* d_out, int out_size, void* d_ws, size_t ws_size, hipStream_t stream) {
    static int grid = 0;
    if (grid == 0) {
        if (n_in != 31 || out_size != TL * D || ws_size < WS_END) { fprintf(stderr, "kernel_launch: unexpected shapes n_in %d out %d ws %zu\n", n_in, out_size, ws_size); grid = -1; return; }
        int dev = 0, cus = 0;
        if (hipGetDevice(&dev) != hipSuccess || hipDeviceGetAttribute(&cus, hipDeviceAttributeMultiprocessorCount, dev) != hipSuccess) { grid = -1; return; }
        if (hipFuncSetAttribute((const void*)mk_fwd, hipFuncAttributeMaxDynamicSharedMemorySize, LDS_BYTES) != hipSuccess) { fprintf(stderr, "kernel_launch: hipFuncSetAttribute failed\n"); grid = -1; return; }
        int per_cu = 0;
        if (hipOccupancyMaxActiveBlocksPerMultiprocessor(&per_cu, (const void*)mk_fwd, NWAVES * 64, LDS_BYTES) != hipSuccess || per_cu < 1) fprintf(stderr, "kernel_launch: occupancy query says %d\n", per_cu);
        (void)hipGetLastError();
        grid = cus;
    }
    if (grid < 0) return;
    if (hipMemsetAsync((char*)d_ws + WS_CTL, 0, CTL_ZERO_BYTES, stream) != hipSuccess) return;
    Args a{};
    for (int i = 0; i < 31; ++i) a.in[i] = (const float*)d_in[i];
    a.out = (float*)d_out; a.ws = (unsigned char*)d_ws;
#ifndef MK_ONE_LAUNCH
#define MK_ONE_LAUNCH 1
#endif
    if (MK_ONE_LAUNCH) { a.ph_lo = 0; a.ph_hi = NPH; hipLaunchKernelGGL(mk_fwd, dim3(grid), dim3(NWAVES * 64), LDS_BYTES, stream, a); }
    else for (int p = 0; p < NPH; ++p) { a.ph_lo = p; a.ph_hi = p + 1; hipLaunchKernelGGL(mk_fwd, dim3(grid), dim3(NWAVES * 64), LDS_BYTES, stream, a); }
}
```

```cpp
#include <hip/hip_runtime.h>
#include <cstdio>
#include <cstdint>
#include <cmath>
namespace pg8 {
#define PG8_LAS __attribute__((address_space(3)))
typedef unsigned short bf16_t;
typedef short bf16x8 __attribute__((ext_vector_type(8)));
typedef float f32x4 __attribute__((ext_vector_type(4)));
typedef unsigned u32x4 __attribute__((ext_vector_type(4)));
constexpr int BM = 256, BK = 64, HALF = 128, HTB = HALF * BK * 2  , STAGE_BYTES = 8 * HTB, NXCD = 8, WGM = 8;

__host__ __device__ __forceinline__ int lds_byte(int r, int c) { const int st = (r >> 4) * 2 + (c >> 5), rr = r & 15, cc = c & 31, ob = rr * 64 + cc * 2; return st * 1024 + (ob ^ (((ob >> 9) & 1) << 5)); }
__host__ __device__ __forceinline__ void stage_rc(int b, int& R, int& C) { const int st = b / 1024, sb = b % 1024, swz = sb ^ (((sb >> 9) & 1) << 5); R = (st >> 1) * 16 + swz / 64; C = (st & 1) * 32 + (swz % 64) / 2; }
__host__ __device__ __forceinline__ int perm32(int rho) { const int n = rho >> 4, i = rho & 15; return 8 * (i >> 2) + 4 * n + (i & 3); }

struct Unit { int pm, pn; };
struct Gemm { const bf16_t* A; const bf16_t* Bt; int M, N, K, lda, ldb; };

struct StaticOrder {
    int nM, nN, nwg, G, c;
    __host__ __device__ void init(int M, int N, int G_, int c_) { nM = M / BM; nN = N / BM; nwg = nM * nN; G = G_; c = c_; }
    __host__ __device__ bool next(int i, Unit& u) const {
        const long L = (long)i * G + c; if (L >= nwg) return false;
        int wgid = (int)L; { const int q = nwg / NXCD, r = nwg % NXCD, xcd = wgid % NXCD, off = wgid / NXCD; wgid = (xcd < r ? xcd * (q + 1) : r * (q + 1) + (xcd - r) * q) + off; }
        const int nig = WGM * nN, gid = wgid / nig, fm = gid * WGM, gsz = (nM - fm) < WGM ? (nM - fm) : WGM;
        u.pm = fm + ((wgid % nig) % gsz); u.pn = (wgid % nig) / gsz; return true;
    }
    __device__ __forceinline__ void a_ready(const Unit&) const {}
    __device__ __forceinline__ void done(const Unit&) const {}
};

__device__ __forceinline__ unsigned cvt_pk_bf16(float lo, float hi) { unsigned r; asm volatile("v_cvt_pk_bf16_f32 %0, %1, %2" : "=v"(r) : "v"(lo), "v"(hi)); return r; }
template <class F> struct Epi8 {
    static constexpr bool PERM = true, AFTER_DRAIN = false; F f;
    __device__ __forceinline__ void operator()(const f32x4 (&acc)[2][2][4][2], const Unit& u, int wr, int wc, int fr, int fq) const {
        const int row0 = u.pm * BM + wr * 64 + fr, col0 = u.pn * BM + wc * 32 + 8 * fq;
#pragma unroll
        for (int ai = 0; ai < 2; ++ai)
#pragma unroll
            for (int m = 0; m < 4; ++m)
#pragma unroll
                for (int bj = 0; bj < 2; ++bj) { f(row0 + ai * HALF + m * 16, col0 + bj * HALF, acc[ai][bj][m][0], acc[ai][bj][m][1]); }
    }
};
template <class F> struct Epi4 {
    static constexpr bool PERM = false, AFTER_DRAIN = false; F f;
    __device__ __forceinline__ void operator()(const f32x4 (&acc)[2][2][4][2], const Unit& u, int wr, int wc, int fr, int fq) const {
        const int row0 = u.pm * BM + wr * 64 + fr, col0 = u.pn * BM + wc * 32 + 4 * fq;
#pragma unroll
        for (int ai = 0; ai < 2; ++ai)
#pragma unroll
            for (int m = 0; m < 4; ++m)
#pragma unroll
                for (int bj = 0; bj < 2; ++bj)
#pragma unroll
                    for (int n = 0; n < 2; ++n) { f(row0 + ai * HALF + m * 16, col0 + bj * HALF + n * 16, acc[ai][bj][m][n]); }
    }
};
template <class Epi, class Sched, bool ALIGN_EPI = false, bool SP2 = false>
__device__ __forceinline__ void gemm_phase(PG8_LAS unsigned char* lds, const Gemm g, const Sched& S, const Epi& E) {
    int tid_ = threadIdx.x; asm volatile("" : "+v"(tid_));
    const int tid = tid_, wid = __builtin_amdgcn_readfirstlane(tid >> 6), lane = tid & 63, wr = wid >> 2, wc = wid & 3, fr = lane & 15, fq = lane >> 4;
    const int K = g.K, nt = K / BK;
    unsigned voffA[2], voffB[2];
#pragma unroll
    for (int i = 0; i < 2; ++i) { int R, C; stage_rc(tid * 16 + i * 8192, R, C); const int Rb = Epi::PERM ? ((R & ~31) + perm32(R & 31)) : R;
        voffA[i] = (unsigned)(R * g.lda + C) * 2u; voffB[i] = (unsigned)(Rb * g.ldb + C) * 2u; }
    const size_t kstep = (size_t)(BK * 2);
    const size_t hstepA = (size_t)HALF * g.lda * 2, hstepB = (size_t)HALF * g.ldb * 2;
    const size_t tstepA = 2 * hstepA, tstepB = 2 * hstepB;
    const unsigned ldsw = (unsigned)wid * 1024u;
    const int aoff = lds_byte(wr * 64 + fr, fq * 8), boff = lds_byte(wc * 32 + fr, fq * 8);
#define PG8_SA(b, h) (((b) * 2 + (h)) * HTB)
#define PG8_SB(b, h) ((4 + (b) * 2 + (h)) * HTB)
#define PG8_STAGE(bufoff, gbase, voff) do { _Pragma("unroll") for (int _i = 0; _i < 2; ++_i) \
        __builtin_amdgcn_global_load_lds((const unsigned*)((const char*)(gbase) + (voff)[_i]), (PG8_LAS unsigned*)(lds + (bufoff) + ldsw + _i * 8192), 16, 0, 0); } while (0)
#define PG8_LDA(dst, b, h) do { _Pragma("unroll") for (int m = 0; m < 4; ++m) _Pragma("unroll") for (int k = 0; k < 2; ++k) dst[m][k] = *(const PG8_LAS bf16x8*)(lds + PG8_SA(b, h) + aoff + m * 2048 + k * 1024); } while (0)
#define PG8_LDB(dst, b, h) do { _Pragma("unroll") for (int n = 0; n < 2; ++n) _Pragma("unroll") for (int k = 0; k < 2; ++k) dst[n][k] = *(const PG8_LAS bf16x8*)(lds + PG8_SB(b, h) + boff + n * 2048 + k * 1024); } while (0)
#define PG8_MMA(ai, bj, At, Bt) do { __builtin_amdgcn_s_setprio(1); _Pragma("unroll") for (int m = 0; m < 4; ++m) _Pragma("unroll") for (int n = 0; n < 2; ++n) _Pragma("unroll") for (int k = 0; k < 2; ++k) \
        acc[ai][bj][m][n] = __builtin_amdgcn_mfma_f32_16x16x32_bf16(Bt[n][k], At[m][k], acc[ai][bj][m][n], 0, 0, 0); __builtin_amdgcn_s_setprio(0); } while (0)
#define PG8_WAIT_V(n) asm volatile("s_waitcnt vmcnt(" #n ")" ::: "memory")
#define PG8_WAIT_L(n) asm volatile("s_waitcnt lgkmcnt(" #n ")" ::: "memory")
#define PG8_BAR __builtin_amdgcn_s_barrier()
#define PG8_SCHED __builtin_amdgcn_sched_barrier(0)
    Unit cur, nxt; int ui = 0;
    if (!S.next(0, cur)) return;
    f32x4 acc[2][2][4][2];
#pragma unroll
    for (int a = 0; a < 2; ++a)
#pragma unroll
        for (int b = 0; b < 2; ++b)
#pragma unroll
            for (int m = 0; m < 4; ++m)
#pragma unroll
                for (int n = 0; n < 2; ++n) acc[a][b][m][n] = (f32x4){0.f, 0.f, 0.f, 0.f};
    bf16x8 At[4][2], B0[2][2], B1[2][2];
    const char* cA = (const char*)g.A + (size_t)cur.pm * tstepA; const char* cB = (const char*)g.Bt + (size_t)cur.pn * tstepB;
    S.a_ready(cur);
    if constexpr (SP2) {
        PG8_STAGE(PG8_SB(0, 0), cB, voffB); PG8_STAGE(PG8_SB(0, 1), cB + hstepB, voffB); PG8_STAGE(PG8_SA(0, 0), cA, voffA); PG8_STAGE(PG8_SA(0, 1), cA + hstepA, voffA);
        if (wr == 1) PG8_BAR;
        PG8_WAIT_V(2); PG8_BAR;
        PG8_STAGE(PG8_SB(1, 0), cB + kstep, voffB); PG8_STAGE(PG8_SA(1, 0), cA + kstep, voffA); PG8_STAGE(PG8_SB(1, 1), cB + hstepB + kstep, voffB);
        PG8_WAIT_V(6); PG8_BAR;
    } else {
        PG8_STAGE(PG8_SB(0, 0), cB, voffB); PG8_STAGE(PG8_SA(0, 0), cA, voffA); PG8_STAGE(PG8_SB(0, 1), cB + hstepB, voffB); PG8_STAGE(PG8_SA(0, 1), cA + hstepA, voffA);
        if (wr == 1) PG8_BAR;
        PG8_WAIT_V(4); PG8_BAR;
        PG8_STAGE(PG8_SB(1, 0), cB + kstep, voffB); PG8_STAGE(PG8_SA(1, 0), cA + kstep, voffA); PG8_STAGE(PG8_SB(1, 1), cB + hstepB + kstep, voffB);
        PG8_WAIT_V(6); PG8_BAR;
    }
    for (;;) {
        const bool has_next = S.next(ui + 1, nxt);
        const char* nA = has_next ? (const char*)g.A + (size_t)nxt.pm * tstepA : cA; const char* nB = has_next ? (const char*)g.Bt + (size_t)nxt.pn * tstepB : cB;
#pragma unroll 1
        for (int t = 0; t < nt; t += 2) {
            const bool last = (t == nt - 2);
            const char* a1 = cA + (size_t)(t + 1) * kstep;
            const char* a2 = last ? nA : cA + (size_t)(t + 2) * kstep; const char* b2 = last ? nB : cB + (size_t)(t + 2) * kstep;
            const char* a3 = a2 + kstep; const char* b3 = b2 + kstep;
            if (last && has_next) S.a_ready(nxt);
            if constexpr (SP2) {
            PG8_LDB(B0, 0, 0); PG8_LDB(B1, 0, 1); PG8_SCHED; PG8_LDA(At, 0, 0); PG8_STAGE(PG8_SA(1, 1), a1 + hstepA, voffA);
            PG8_WAIT_V(8); PG8_WAIT_L(0); PG8_BAR; PG8_MMA(0, 0, At, B0); PG8_MMA(0, 1, At, B1); PG8_BAR; PG8_SCHED;
            PG8_LDA(At, 0, 1); PG8_STAGE(PG8_SB(0, 0), b2, voffB); PG8_STAGE(PG8_SB(0, 1), b2 + hstepB, voffB); PG8_STAGE(PG8_SA(0, 0), a2, voffA);
            PG8_WAIT_V(8); PG8_WAIT_L(0); PG8_BAR; PG8_MMA(1, 0, At, B0); PG8_MMA(1, 1, At, B1); PG8_BAR; PG8_SCHED;
            PG8_LDB(B0, 1, 0); PG8_LDB(B1, 1, 1); PG8_SCHED; PG8_LDA(At, 1, 0); PG8_STAGE(PG8_SA(0, 1), a2 + hstepA, voffA);
            PG8_WAIT_V(8); PG8_WAIT_L(0); PG8_BAR; PG8_MMA(0, 0, At, B0); PG8_MMA(0, 1, At, B1); PG8_BAR; PG8_SCHED;
            PG8_LDA(At, 1, 1); PG8_STAGE(PG8_SB(1, 0), b3, voffB); PG8_STAGE(PG8_SB(1, 1), b3 + hstepB, voffB); PG8_STAGE(PG8_SA(1, 0), a3, voffA);
            PG8_WAIT_V(8); PG8_WAIT_L(0); PG8_BAR; PG8_MMA(1, 0, At, B0); PG8_MMA(1, 1, At, B1); PG8_BAR; PG8_SCHED;
            } else {
            PG8_LDB(B0, 0, 0); PG8_SCHED; PG8_LDA(At, 0, 0); PG8_STAGE(PG8_SA(1, 1), a1 + hstepA, voffA);
            PG8_WAIT_L(8); PG8_BAR; PG8_WAIT_L(0); PG8_MMA(0, 0, At, B0); PG8_BAR; PG8_SCHED;
            PG8_LDB(B1, 0, 1); PG8_STAGE(PG8_SB(0, 0), b2, voffB);
            PG8_BAR; PG8_WAIT_L(0); PG8_MMA(0, 1, At, B1); PG8_BAR;
            PG8_LDA(At, 0, 1); PG8_STAGE(PG8_SA(0, 0), a2, voffA);
            PG8_BAR; PG8_WAIT_L(0); PG8_MMA(1, 0, At, B0); PG8_BAR; PG8_SCHED;
            PG8_STAGE(PG8_SB(0, 1), b2 + hstepB, voffB);
            PG8_WAIT_V(6); PG8_BAR; PG8_MMA(1, 1, At, B1); PG8_BAR;
            PG8_LDB(B0, 1, 0); PG8_SCHED; PG8_LDA(At, 1, 0); PG8_STAGE(PG8_SA(0, 1), a2 + hstepA, voffA);
            PG8_WAIT_L(8); PG8_BAR; PG8_WAIT_L(0); PG8_MMA(0, 0, At, B0); PG8_BAR; PG8_SCHED;
            PG8_LDB(B1, 1, 1); PG8_STAGE(PG8_SB(1, 0), b3, voffB);
            PG8_BAR; PG8_WAIT_L(0); PG8_MMA(0, 1, At, B1); PG8_BAR;
            PG8_LDA(At, 1, 1); PG8_STAGE(PG8_SA(1, 0), a3, voffA);
            PG8_BAR; PG8_WAIT_L(0); PG8_MMA(1, 0, At, B0); PG8_BAR; PG8_SCHED;
            PG8_STAGE(PG8_SB(1, 1), b3 + hstepB, voffB);
            PG8_WAIT_V(6); PG8_BAR; PG8_MMA(1, 1, At, B1); PG8_BAR;
            }
        }
        if constexpr (ALIGN_EPI) { if (wr == 0) PG8_BAR; }
        if constexpr (!Epi::AFTER_DRAIN) { E(acc, cur, wr, wc, fr, fq); S.done(cur); }
        if (!has_next) break;
#pragma unroll
        for (int a = 0; a < 2; ++a)
#pragma unroll
            for (int b = 0; b < 2; ++b)
#pragma unroll
                for (int m = 0; m < 4; ++m)
#pragma unroll
                    for (int n = 0; n < 2; ++n) acc[a][b][m][n] = (f32x4){0.f, 0.f, 0.f, 0.f};
        cur = nxt; cA = nA; cB = nB; ++ui;
        if constexpr (ALIGN_EPI) { if (wr == 1) PG8_BAR; }
    }
    PG8_WAIT_V(0);
    if constexpr (!ALIGN_EPI) { if (wr == 0) PG8_BAR; }
    PG8_BAR;
    if constexpr (Epi::AFTER_DRAIN) { E.fused(acc, cur, wr, wc, fr, fq, lds, wid, lane); S.done(cur); }
#undef PG8_SA
#undef PG8_SB
#undef PG8_STAGE
#undef PG8_LDA
#undef PG8_LDB
#undef PG8_MMA
#undef PG8_WAIT_V
#undef PG8_WAIT_L
#undef PG8_BAR
#undef PG8_SCHED
}
}

constexpr int NWAVES = 8;
constexpr int D = 1024, BATCH = 2, SEQ = 8192, CTXL = 256;
constexpr int TL = BATCH * SEQ;
constexpr int TC = BATCH * CTXL;
constexpr int TT = TL + TC;
constexpr int EVEN_IN = 1184, EVEN_IN_PAD = 1280, CQKV_LD = 672;
constexpr int FFH = 2816, FFG = 1408;
constexpr int TQK = SEQ + CTXL;
constexpr float NORM_EPS = 1e-6f;
constexpr float DN_ALPHA = 1.41421356237f;
constexpr float QSCALE = 0.10206207261596577f * 1.4426950408889634f;

constexpr size_t MiB = 1u << 20;
constexpr size_t WS_CTL = 0, CTL_ZERO_BYTES = 1 * MiB;
constexpr size_t WS_MOD = 1 * MiB;
constexpr size_t WS_LBV = WS_MOD + 160 * 1024;
constexpr size_t WS_ROPE = WS_LBV + 16 * 1024;
constexpr size_t WS_CWT = WS_ROPE + 16 * 1024;
constexpr size_t WS_HGINT = 2 * MiB, WS_HGOUTT = 12 * MiB, WS_F1T1 = 14 * MiB, WS_F2T1 = 25 * MiB;
constexpr size_t WS_A = 31 * MiB;
constexpr size_t WS_XC = 64 * MiB;
constexpr size_t WS_WIN0 = 66 * MiB, WS_WUQ = WS_WIN0 + 2560 * 1024, WS_WUKV = WS_WUQ + 768 * 1024, WS_WGLU = WS_WUKV + 512 * 1024,
                 WS_WOUT0 = WS_WGLU + 512 * 1024, WS_F1T0 = 72 * MiB + 512 * 1024, WS_F2T0 = WS_F1T0 + 11 * MiB;
constexpr size_t WS_R = 89 * MiB;
constexpr size_t WS_CQKV = WS_R;
constexpr size_t WS_UG = WS_R + 22 * MiB;
constexpr size_t WS_WF = WS_R + 39 * MiB;
constexpr size_t WS_WC = WS_R + 64 * MiB;
constexpr size_t WS_TOEP = WS_R + 80 * MiB;
constexpr size_t WS_T0 = WS_R + 82 * MiB;
constexpr size_t WS_A64 = WS_T0 + 128 * 1024;
constexpr size_t WS_FIN = WS_R + 83 * MiB;
constexpr size_t WS_SIN = WS_R + 92 * MiB;
constexpr size_t WS_Z = WS_R + 97 * MiB;
constexpr size_t WS_MIX = WS_R + 134 * MiB;
constexpr size_t WS_QB = WS_R + 39 * MiB;
constexpr size_t WS_KB = 31 * MiB;
constexpr size_t WS_VB = WS_R + 114 * MiB;
constexpr size_t WS_AB = WS_R;
constexpr size_t WS_GB = WS_R + 8 * MiB;
constexpr size_t WS_H = WS_R;
constexpr size_t WS_HG = WS_R + 16 * MiB;
constexpr size_t WS_QFFI = 66 * MiB;
constexpr size_t WS_G = 198 * MiB;
constexpr size_t WS_O = WS_A;
constexpr size_t WS_SLAB1 = WS_R;
constexpr size_t WS_SLAB2 = WS_R + 140 * MiB;
constexpr size_t WS_END = 256 * MiB;
static_assert(WS_F2T0 + 5632 * 1024 <= WS_R, "layer-0 weights");
static_assert(WS_MIX + (size_t)TT * 1024 * 2 <= WS_END && WS_G + (size_t)TT * 1024 * 2 <= WS_END && WS_HG + (size_t)TT * FFH * 2 <= WS_END, "ws map");
static_assert(WS_WF + 16 * MiB <= WS_WC && WS_QB + (size_t)16 * TQK * 96 * 2 <= WS_WC && WS_WC + 16 * MiB <= WS_TOEP && WS_TOEP + 2 * MiB <= WS_T0 && WS_T0 + MiB <= WS_FIN && WS_FIN + (size_t)32 * 264 * 256 * 4 <= WS_SIN && WS_SIN + (size_t)32 * 264 * 256 * 2 <= WS_Z && WS_Z + (size_t)TT * 512 * 2 <= WS_VB && WS_VB + (size_t)16 * TQK * 64 * 2 <= WS_MIX && WS_KB + (size_t)16 * TQK * 96 * 2 <= WS_XC, "ws map 2");

constexpr int CW_BAR = 4096;
constexpr int RING_OFF = 0, RING_BYTES = 131072;
constexpr int LDSCTL_OFF = RING_BYTES, MISC_OFF = LDSCTL_OFF + 320;
constexpr int LDS_BYTES = 147456;

#define GAS __attribute__((address_space(1)))
#define LAS __attribute__((address_space(3)))
typedef unsigned short bf16;
typedef unsigned v4u __attribute__((ext_vector_type(4)));
typedef unsigned v2u __attribute__((ext_vector_type(2)));
typedef float f32x4 __attribute__((ext_vector_type(4)));
typedef GAS unsigned gu32;
#define RLX_AGENT __ATOMIC_RELAXED, __HIP_MEMORY_SCOPE_AGENT
#define LDS_WAIT() asm volatile("s_waitcnt lgkmcnt(0)" ::: "memory")
__device__ __forceinline__ unsigned f2bf(float f) { unsigned u = __builtin_bit_cast(unsigned, f); return (u + 0x7fffu + ((u >> 16) & 1u)) >> 16; }
__device__ __forceinline__ unsigned pk2(float lo, float hi) { return f2bf(lo) | (f2bf(hi) << 16); }
__device__ __forceinline__ float bflo(unsigned w) { return __builtin_bit_cast(float, w << 16); }
__device__ __forceinline__ float bfhi(unsigned w) { return __builtin_bit_cast(float, w & 0xffff0000u); }
__device__ __forceinline__ float bf2f(bf16 h) { return __builtin_bit_cast(float, (unsigned)h << 16); }
__device__ __forceinline__ void unpack8(v4u w, float* x) { x[0] = bflo(w.x); x[1] = bfhi(w.x); x[2] = bflo(w.y); x[3] = bfhi(w.y); x[4] = bflo(w.z); x[5] = bfhi(w.z); x[6] = bflo(w.w); x[7] = bfhi(w.w); }
__device__ __forceinline__ v4u pack8(const float* x) { v4u w; w.x = pk2(x[0], x[1]); w.y = pk2(x[2], x[3]); w.z = pk2(x[4], x[5]); w.w = pk2(x[6], x[7]); return w; }
__device__ __forceinline__ float sigmoidf_(float x) { return 1.0f / (1.0f + __expf(-x)); }
__device__ __forceinline__ float siluf_(float x) { return x / (1.0f + __expf(-x)); }
__device__ __forceinline__ float gelu_tanh(float x) { const float u = 0.7978845608028654f * (x + 0.044715f * x * x * x); return 0.5f * x * (1.0f + tanhf(u)); }
__device__ __forceinline__ float wave_sum(float v) {
#pragma unroll
    for (int o = 1; o < 64; o <<= 1) v += __shfl_xor(v, o);
    return v;
}

#define XB_TMO      128
#define XB_XCNT(j)  (256  + 64 * (j))
#define XB_XSUB(j)  (1280 + 64 * (j))
#define XB_XGEN(j)  (2304 + 64 * (j))
#define XB_TOP      3328
#define XB_TOPGEN   3392
#define XCD_BAR_WORDS 3456
#define XB_SPIN_CAP (1u << 18)

__device__ __forceinline__ unsigned xb_ld(unsigned* p)              { return __hip_atomic_load(p, __ATOMIC_RELAXED, __HIP_MEMORY_SCOPE_AGENT); }
__device__ __forceinline__ unsigned xb_add(unsigned* p, unsigned v) { return __hip_atomic_fetch_add(p, v, __ATOMIC_RELAXED, __HIP_MEMORY_SCOPE_AGENT); }
__device__ __forceinline__ unsigned xb_xcc_id() { return (unsigned)__builtin_amdgcn_s_getreg((3 << 11) | 20) & 0xFu; }
#define XB_SPIN(cond, bar) do { unsigned _sp = 0; while (cond) { __builtin_amdgcn_s_sleep(1); \
    if ((++_sp & 255u) == 0u) { if (xb_ld(&(bar)[XB_TMO])) break; if (_sp > XB_SPIN_CAP) { atomicAdd(&(bar)[XB_TMO], 1u); break; } } } } while (0)

struct XcdBarrier {
    unsigned* bar; unsigned x;
    volatile LAS unsigned* st;
};

__device__ __forceinline__ XcdBarrier xcd_barrier_post(unsigned* bar, volatile LAS unsigned* st) {
    XcdBarrier b; b.bar = bar; b.x = xb_xcc_id(); b.st = st;
    if (threadIdx.x == 0) (void)xb_add(&bar[XB_XCNT(b.x)], 1u);
    return b;
}
__device__ __forceinline__ void xcd_barrier_complete(unsigned* bar, unsigned x, unsigned& nloc, unsigned& nx) {
    const unsigned G = gridDim.x * gridDim.y * gridDim.z;
    unsigned sum, cnt, mine, sp = 0u;
    for (;;) {
        sum = 0u; cnt = 0u; mine = 0u;
#pragma unroll
        for (unsigned j = 0; j < 16; ++j) { const unsigned c = xb_ld(&bar[XB_XCNT(j)]); sum += c; cnt += (c > 0u) ? 1u : 0u; mine = (j == x) ? c : mine; }
        if (sum == G) break;
        __builtin_amdgcn_s_sleep(1);
        if ((++sp & 255u) == 0u) { if (xb_ld(&bar[XB_TMO])) break; if (sp > XB_SPIN_CAP) { atomicAdd(&bar[XB_TMO], 1u); break; } }
    }
    nloc = mine > 0u ? mine : 1u; nx = cnt > 0u ? cnt : 1u;
}

__device__ __forceinline__ void xcd_barrier(const XcdBarrier& b) {
    asm volatile("s_waitcnt vmcnt(0)" ::: "memory");
    __syncthreads();
    if (threadIdx.x == 0) {
        unsigned* bar = b.bar;
        __builtin_amdgcn_s_waitcnt(0);
        unsigned nloc = b.st[0], nx = b.st[1];
        if (nloc == 0u) { xcd_barrier_complete(bar, b.x, nloc, nx); b.st[0] = nloc; b.st[1] = nx; }
        const unsigned old = xb_add(&bar[XB_XSUB(b.x)], 1u);
        const unsigned gen = old / nloc;
        if (old + 1u == (gen + 1u) * nloc) {
            __builtin_amdgcn_fence(__ATOMIC_RELEASE, "agent");
            asm volatile("s_waitcnt vmcnt(0)" ::: "memory");
            const unsigned og = xb_add(&bar[XB_TOP], 1u);
            const unsigned tg = og / nx;
            if (og + 1u == (tg + 1u) * nx) xb_add(&bar[XB_TOPGEN], 1u);
            else XB_SPIN(xb_ld(&bar[XB_TOPGEN]) == tg, bar);
            __builtin_amdgcn_fence(__ATOMIC_ACQUIRE, "agent");
            xb_add(&bar[XB_XGEN(b.x)], 1u);
            asm volatile("s_waitcnt vmcnt(0)" ::: "memory");
        } else {
            XB_SPIN(xb_ld(&bar[XB_XGEN(b.x)]) == gen, bar);
            __builtin_amdgcn_fence(__ATOMIC_ACQUIRE, "agent");
            asm volatile("s_waitcnt vmcnt(0)" ::: "memory");
        }
    }
    __syncthreads();
}


struct Frame {
    LAS unsigned char* lds;
    int tid, lane, wave, vcu, G;
};
constexpr int PTR_OFF = LDSCTL_OFF + 1024;
__device__ __forceinline__ const float* inp(const Frame& F, int i) {
    const LAS unsigned* p = (const LAS unsigned*)(F.lds + PTR_OFF) + 2 * i;
    const unsigned lo = __builtin_amdgcn_readfirstlane(p[0]), hi = __builtin_amdgcn_readfirstlane(p[1]);
    return (const float*)(const GAS float*)(((unsigned long long)hi << 32) | lo);
}
__device__ __forceinline__ unsigned char* ws_(const Frame& F) { return (unsigned char*)inp(F, 31); }
__device__ __forceinline__ float* out_(const Frame& F) { return (float*)inp(F, 32); }
__device__ __forceinline__ int modrow_of(int m) { return m < TL ? (m >> 13) : 2; }
__device__ __forceinline__ const float* xin_row(const Frame& F, int m) { return m < TL ? inp(F, 0) + (size_t)m * D : inp(F, 2) + (size_t)(m - TL) * D; }
__device__ __forceinline__ float* xres_row(const Frame& F, int m) { return m < TL ? out_(F) + (size_t)m * D : (float*)(ws_(F) + WS_XC) + (size_t)(m - TL) * D; }
__device__ __forceinline__ const float* modvec(const Frame& F, int layer, int mr, int part) { return (const float*)(ws_(F) + WS_MOD) + (size_t)(layer * 3 + mr) * 6144 + part * 1024; }

__device__ __forceinline__ void tr_item(const float* W, int ldw, int k0, int n0, bf16* dst, int dpitch, LAS float* scr, int lane) {
    { f32x4 v[8];
#pragma unroll
      for (int i = 0; i < 8; ++i) v[i] = *(const GAS f32x4*)(W + (size_t)(k0 + 8 * i + (lane >> 3)) * ldw + n0 + 4 * (lane & 7));
#pragma unroll
      for (int i = 0; i < 8; ++i) { LAS float* d = scr + (8 * i + (lane >> 3)) * 33 + 4 * (lane & 7); d[0] = v[i].x; d[1] = v[i].y; d[2] = v[i].z; d[3] = v[i].w; } }
    LDS_WAIT(); asm volatile("" ::: "memory");
    const int c = lane & 7;
#pragma unroll
    for (int j = 0; j < 4; ++j) { const int n = (lane >> 3) + 8 * j; const LAS float* s = scr + (8 * c) * 33 + n;
        v4u o; o.x = pk2(s[0 * 33], s[1 * 33]); o.y = pk2(s[2 * 33], s[3 * 33]); o.z = pk2(s[4 * 33], s[5 * 33]); o.w = pk2(s[6 * 33], s[7 * 33]);
        *(GAS v4u*)(dst + (size_t)n * dpitch + 8 * c) = o; }
    LDS_WAIT(); asm volatile("" ::: "memory");
}
__device__ __forceinline__ bool tr_plain(int& r, const float* W, int K, int N, bf16* WT, LAS float* scr, int lane) {
    const int nblk = N / 32, cnt = (K / 64) * nblk;
    if (r >= cnt) { r -= cnt; return false; }
    const int kb = r / nblk, nb = r % nblk;
    tr_item(W, N, 64 * kb, 32 * nb, WT + (size_t)(32 * nb) * K + 64 * kb, K, scr, lane); return true;
}
__device__ __forceinline__ bool tr_ffn1(int& r, const float* W, bf16* WT, LAS float* scr, int lane) {
    const int nblk = 5632 / 32, cnt = 16 * nblk;
    if (r >= cnt) { r -= cnt; return false; }
    const int kb = r / nblk, nb = r % nblk, n0 = 32 * nb, half = n0 / FFH, j = n0 % FFH, drow = (j >> 7) * 256 + half * 128 + (j & 127);
    tr_item(W, 5632, 64 * kb, n0, WT + (size_t)drow * 1024 + 64 * kb, 1024, scr, lane); return true;
}
#ifndef DUP_GEMV
#define DUP_GEMV 1
#endif
#ifndef DUP_TR
#define DUP_TR 1
#endif
#ifndef DUP_S5T
#define DUP_S5T 1
#endif
__device__ __forceinline__ void p0_prologue(Frame& F) {
    {
        LAS float* sv = (LAS float*)(F.lds + RING_OFF);
        LAS float* red = sv + 3072;
        for (int i = F.tid; i < 3072; i += 512) { const int r = i >> 10, k = i & 1023; const float cv = (r < 2) ? inp(F, 1)[r * 1024 + k] : inp(F, 3)[k]; sv[i] = cv / (1.0f + __expf(-cv)); }
        __syncthreads();
        for (int rep_ = 0; rep_ < DUP_GEMV; ++rep_)
        for (int it = blockIdx.x; it < 192; it += F.G) {
            const int layer = it / 96, cg = it % 96, col = cg * 64 + F.lane, k0 = F.wave * 128;
            const float* w = inp(F, 4) + ((size_t)layer * 1024 + k0) * 6144 + col;
            float a0 = 0.f, a1 = 0.f, a2 = 0.f;
#pragma unroll 16
            for (int k = 0; k < 128; ++k) { const float wv = w[(size_t)k * 6144]; a0 += sv[k0 + k] * wv; a1 += sv[1024 + k0 + k] * wv; a2 += sv[2048 + k0 + k] * wv; }
            red[(F.wave * 3 + 0) * 64 + F.lane] = a0; red[(F.wave * 3 + 1) * 64 + F.lane] = a1; red[(F.wave * 3 + 2) * 64 + F.lane] = a2;
            __syncthreads();
            if (F.tid < 192) { const int r = F.tid >> 6, l = F.tid & 63; float s = inp(F, 5)[layer * 6144 + cg * 64 + l];
#pragma unroll
                for (int wv = 0; wv < 8; ++wv) s += red[(wv * 3 + r) * 64 + l];
                ((float*)(ws_(F) + WS_MOD))[(size_t)(layer * 3 + r) * 6144 + cg * 64 + l] = s; }
            __syncthreads();
        }
        __syncthreads();
    }
    {
        const int gt = F.vcu * 512 + F.tid, NT = F.G * 512;
        for (int i = gt; i < 2048; i += NT) { const int dir = i >> 10, c = i & 1023; const float l0 = inp(F, 28)[(0 * 2 + dir) * 1024 + c], l1 = inp(F, 28)[(1 * 2 + dir) * 1024 + c];
            ((float*)(ws_(F) + WS_LBV))[i] = 1.0f / (1.0f + expf(l0 - l1)); }
        for (int i = gt; i < 1024; i += NT) { const int pos = i >> 3, f = i & 7; const float inv = powf(10000.0f, -(float)f / 8.0f); const float ang = (float)pos * inv;
            ((float*)(ws_(F) + WS_ROPE))[2 * i] = cosf(ang); ((float*)(ws_(F) + WS_ROPE))[2 * i + 1] = sinf(ang); }
        for (int i = gt; i < 2 * FFH; i += NT) { const int layer = i / FFH, j = i % FFH; const float* cwp = inp(F, 9) + (size_t)layer * 3 * FFH + j;
            v2u w; w.x = pk2(cwp[0], cwp[FFH]); w.y = pk2(cwp[2 * FFH], inp(F, 10)[(size_t)layer * FFH + j]); *(GAS v2u*)((bf16*)(ws_(F) + WS_CWT) + (size_t)i * 4) = w; }
        for (int i = gt; i < 96 * 1024 / 8; i += NT) ((GAS v4u*)(ws_(F) + WS_WIN0 + (size_t)1184 * 1024 * 2))[i] = (v4u){0u, 0u, 0u, 0u};
    }
    {
        LAS float* scr = (LAS float*)(F.lds + RING_OFF + F.wave * 16384);
        const int gw = F.vcu * NWAVES + F.wave, NGW = F.G * NWAVES;
        constexpr int NITEMS = 592 + 144 + 128 + 128 + 512 + 2 * 2816 + 2 * 1408 + 2560 + 512;
        for (int rep_ = 0; rep_ < DUP_TR; ++rep_)
        for (int it = gw; it < NITEMS; it += NGW) {
            int r = it;
            if (tr_plain(r, inp(F, 12), 1024, 1184, (bf16*)(ws_(F) + WS_WIN0), scr, F.lane)) continue;
            if (tr_plain(r, inp(F, 14), 384, 768, (bf16*)(ws_(F) + WS_WUQ), scr, F.lane)) continue;
            if (tr_plain(r, inp(F, 16), 256, 1024, (bf16*)(ws_(F) + WS_WUKV), scr, F.lane)) continue;
            if (tr_plain(r, inp(F, 25), 512, 512, (bf16*)(ws_(F) + WS_WGLU), scr, F.lane)) continue;
            if (tr_plain(r, inp(F, 26), 1024, 1024, (bf16*)(ws_(F) + WS_WOUT0), scr, F.lane)) continue;
            if (tr_ffn1(r, inp(F, 8), (bf16*)(ws_(F) + WS_F1T0), scr, F.lane)) continue;
            if (tr_ffn1(r, inp(F, 8) + (size_t)1024 * 5632, (bf16*)(ws_(F) + WS_F1T1), scr, F.lane)) continue;
            if (tr_plain(r, inp(F, 11), 2816, 1024, (bf16*)(ws_(F) + WS_F2T0), scr, F.lane)) continue;
            if (tr_plain(r, inp(F, 11) + (size_t)2816 * 1024, 2816, 1024, (bf16*)(ws_(F) + WS_F2T1), scr, F.lane)) continue;
            if (tr_plain(r, inp(F, 27), 1024, 5120, (bf16*)(ws_(F) + WS_HGINT), scr, F.lane)) continue;
            tr_plain(r, inp(F, 30), 1024, 1024, (bf16*)(ws_(F) + WS_HGOUTT), scr, F.lane);
        }
    }
}

__device__ __forceinline__ void store_mod_bf16(const Frame& F, const f32x4 (&v)[4], int m, int layer, int part_sh) {
    const int mr = modrow_of(m);
    const GAS f32x4* sh = (const GAS f32x4*)modvec(F, layer, mr, part_sh) + F.lane;
    const GAS f32x4* sc = (const GAS f32x4*)modvec(F, layer, mr, part_sh + 1) + F.lane;
    GAS v2u* o = (GAS v2u*)((bf16*)(ws_(F) + WS_A) + (size_t)m * D) + F.lane;
#pragma unroll
    for (int j = 0; j < 4; ++j) { const f32x4 s = sc[64 * j], h = sh[64 * j]; const f32x4 y = v[j] * (s + 1.0f) + h; v2u w; w.x = pk2(y.x, y.y); w.y = pk2(y.z, y.w); o[64 * j] = w; }
}
__device__ __forceinline__ void ph_init_rows(Frame& F) {
    const int gw = F.vcu * NWAVES + F.wave, NGW = F.G * NWAVES;
    for (int m = gw; m < TT; m += NGW) {
        const GAS f32x4* xr = (const GAS f32x4*)xin_row(F, m) + F.lane; GAS f32x4* xo = (GAS f32x4*)xres_row(F, m) + F.lane;
        f32x4 v[4];
#pragma unroll
        for (int j = 0; j < 4; ++j) { v[j] = xr[64 * j]; xo[64 * j] = (m >= TL) ? v[j] * DN_ALPHA : v[j]; }
        store_mod_bf16(F, v, m, 0, 0);
    }
}
__device__ __forceinline__ void ph_layernorm(Frame& F, int nrows, int layer, int which, int next_layer, int next_part_sh, const float* slabs = nullptr, int nslabs = 0) {
    const int gw = F.vcu * NWAVES + F.wave, NGW = F.G * NWAVES;
    const GAS f32x4* gg = (const GAS f32x4*)(inp(F, 6) + (size_t)(layer * 2 + which) * D) + F.lane;
    const GAS f32x4* bb = (const GAS f32x4*)(inp(F, 7) + (size_t)(layer * 2 + which) * D) + F.lane;
    for (int m0 = gw; m0 < nrows; m0 += 2 * NGW) {
        const int m1 = m0 + NGW; const bool has1 = m1 < nrows; const int m1c = has1 ? m1 : m0;
        GAS f32x4* xr0 = (GAS f32x4*)xres_row(F, m0) + F.lane; GAS f32x4* xr1 = (GAS f32x4*)xres_row(F, m1c) + F.lane;
        f32x4 v[4], w[4]; float s0 = 0.f, s1 = 0.f;
#pragma unroll
        for (int j = 0; j < 4; ++j) { v[j] = xr0[64 * j]; w[j] = xr1[64 * j]; }
        if (nslabs > 0 && m1c >= TL) {
            for (int sl = 0; sl < nslabs; ++sl) { const GAS f32x4* p1 = (const GAS f32x4*)(slabs + ((size_t)sl * TC + (m1c - TL)) * D) + F.lane;
#pragma unroll
                for (int j = 0; j < 4; ++j) w[j] += p1[64 * j];
                if (m0 >= TL) { const GAS f32x4* p0 = (const GAS f32x4*)(slabs + ((size_t)sl * TC + (m0 - TL)) * D) + F.lane;
#pragma unroll
                    for (int j = 0; j < 4; ++j) v[j] += p0[64 * j]; } }
        }
#pragma unroll
        for (int j = 0; j < 4; ++j) { s0 += (v[j].x + v[j].y) + (v[j].z + v[j].w); s1 += (w[j].x + w[j].y) + (w[j].z + w[j].w); }
        const float mean0 = wave_sum(s0) * (1.f / D), mean1 = wave_sum(s1) * (1.f / D); float q0 = 0.f, q1 = 0.f;
#pragma unroll
        for (int j = 0; j < 4; ++j) { v[j] = v[j] - mean0; w[j] = w[j] - mean1; q0 += (v[j].x * v[j].x + v[j].y * v[j].y) + (v[j].z * v[j].z + v[j].w * v[j].w); q1 += (w[j].x * w[j].x + w[j].y * w[j].y) + (w[j].z * w[j].z + w[j].w * w[j].w); }
        const float r0 = 1.f / sqrtf(wave_sum(q0) * (1.f / D) + NORM_EPS), r1 = 1.f / sqrtf(wave_sum(q1) * (1.f / D) + NORM_EPS);
#pragma unroll
        for (int j = 0; j < 4; ++j) { const f32x4 g4 = gg[64 * j], b4 = bb[64 * j]; v[j] = v[j] * r0 * g4 + b4; w[j] = w[j] * r1 * g4 + b4; xr0[64 * j] = (m0 >= TL) ? v[j] * DN_ALPHA : v[j]; if (has1) xr1[64 * j] = (m1 >= TL) ? w[j] * DN_ALPHA : w[j]; }
        if (next_layer >= 0) { store_mod_bf16(F, v, m0, next_layer, next_part_sh); if (has1) store_mod_bf16(F, w, m1, next_layer, next_part_sh); }
    }
}
__device__ __forceinline__ void ph_mla_norm(Frame& F) {
    const int gw = F.vcu * NWAVES + F.wave, NGW = F.G * NWAVES;
    bf16* CQ = (bf16*)(ws_(F) + WS_CQKV); bf16* Kb = (bf16*)(ws_(F) + WS_KB); const float* rope = (const float*)(ws_(F) + WS_ROPE);
    for (int m = gw; m < TT; m += NGW) {
        bf16* row = CQ + (size_t)m * CQKV_LD;
        {
            float x[8]; float ss = 0.f; const bool act = F.lane < 48;
            if (act) { unpack8(*(const GAS v4u*)(row + 8 * F.lane), x);
#pragma unroll
                for (int j = 0; j < 8; ++j) ss += x[j] * x[j]; }
            const float sc = 1.f / sqrtf(wave_sum(ss) * (1.f / 384.f) + NORM_EPS);
            if (act) {
#pragma unroll
                for (int j = 0; j < 8; ++j) x[j] = x[j] * sc * inp(F, 13)[8 * F.lane + j];
                *(GAS v4u*)(row + 8 * F.lane) = pack8(x); }
        }
        {
            float x[8]; float ss = 0.f; const bool act = F.lane < 32;
            if (act) { unpack8(*(const GAS v4u*)(row + 384 + 8 * F.lane), x);
#pragma unroll
                for (int j = 0; j < 8; ++j) ss += x[j] * x[j]; }
            const float sc = 1.f / sqrtf(wave_sum(ss) * (1.f / 256.f) + NORM_EPS);
            if (act) {
#pragma unroll
                for (int j = 0; j < 8; ++j) x[j] = x[j] * sc * inp(F, 15)[8 * F.lane + j];
                *(GAS v4u*)(row + 384 + 8 * F.lane) = pack8(x); }
        }
        {
            const bool isctx = m >= TL; const int b = isctx ? ((m - TL) >> 8) : (m >> 13), t = isctx ? ((m - TL) & 255) : (m & 8191), tk = isctx ? t : CTXL + t;
            const int h = F.lane >> 3, i0 = (F.lane & 7) * 4;
            const v2u w = *(const GAS v2u*)(row + 640 + i0);
            float x[4] = {bflo(w.x), bfhi(w.x), bflo(w.y), bfhi(w.y)}, o[4];
#pragma unroll
            for (int j = 0; j < 4; ++j) { const float p = __shfl_xor(x[j], 2); const int idx = i0 + j, a = idx >> 4, half = (idx >> 3) & 1, f = idx & 7, pos = a ? (t & 63) : (t >> 6);
                const float cs = rope[2 * (pos * 8 + f)], sn = rope[2 * (pos * 8 + f) + 1];
                o[j] = isctx ? x[j] : (half ? x[j] * cs + p * sn : x[j] * cs - p * sn); }
            v2u ow; ow.x = pk2(o[0], o[1]); ow.y = pk2(o[2], o[3]);
            *(GAS v2u*)(Kb + ((size_t)(b * 8 + h) * TQK + tk) * 96 + 64 + i0) = ow;
        }
    }
}
__device__ __forceinline__ void ph_convfix(Frame& F, int nrows, int layer) {
    const int gw = F.vcu * NWAVES + F.wave, NGW = F.G * NWAVES;
    const bf16* AB = (const bf16*)(ws_(F) + WS_AB); const bf16* GB = (const bf16*)(ws_(F) + WS_GB); bf16* HG = (bf16*)(ws_(F) + WS_HG);
    const float* cw = inp(F, 9) + (size_t)layer * 3 * FFH; const float* cb = inp(F, 10) + (size_t)layer * FFH;
    const int nedge = (nrows / 64) * 2;
    for (int er = gw; er < nedge; er += NGW) {
        const int g64 = er >> 1, which = er & 1, m = 64 * g64 + (which ? 63 : 0);
        const bool isctx = m >= TL; const int t = isctx ? ((m - TL) & 255) : (m & 8191), len = isctx ? CTXL : SEQ;
        const bool hp = t > 0, hn = t < len - 1;
        const bf16* ac_ = AB + (size_t)(g64 * 4 + (which ? 3 : 0)) * FFH;
        const bf16* ap_ = which ? AB + (size_t)(g64 * 4 + 2) * FFH : AB + (size_t)((g64 - 1) * 4 + 3) * FFH;
        const bf16* an_ = which ? AB + (size_t)((g64 + 1) * 4 + 0) * FFH : AB + (size_t)(g64 * 4 + 1) * FFH;
        const bf16* gt_ = GB + (size_t)(g64 * 2 + which) * FFH;
#pragma unroll
        for (int ci = 0; ci < 6; ++ci) { const int ch = F.lane + 64 * ci; if (ch >= FFH / 8) break;
            const int j0 = 8 * ch; float ac[8], ap[8], an[8], gt[8], o[8];
            unpack8(*(const GAS v4u*)(ac_ + j0), ac); unpack8(*(const GAS v4u*)(gt_ + j0), gt);
            if (hp) unpack8(*(const GAS v4u*)(ap_ + j0), ap); else {
#pragma unroll
                for (int j = 0; j < 8; ++j) ap[j] = 0.f; }
            if (hn) unpack8(*(const GAS v4u*)(an_ + j0), an); else {
#pragma unroll
                for (int j = 0; j < 8; ++j) an[j] = 0.f; }
#pragma unroll
            for (int j = 0; j < 8; ++j) { const float cv = cb[j0 + j] + cw[j0 + j] * ap[j] + cw[FFH + j0 + j] * ac[j] + cw[2 * FFH + j0 + j] * an[j]; o[j] = siluf_(cv) * gt[j]; }
            *(GAS v4u*)(HG + (size_t)m * FFH + j0) = pack8(o);
        }
    }
}
__device__ __forceinline__ void ph_hg_gate(Frame& F) {
    const int gw = F.vcu * NWAVES + F.wave, NGW = F.G * NWAVES;
    bf16* O = (bf16*)(ws_(F) + WS_O); const bf16* G = (const bf16*)(ws_(F) + WS_G);
    const int c0 = 16 * F.lane; float ng[16];
#pragma unroll
    for (int j = 0; j < 16; ++j) ng[j] = inp(F, 29)[(c0 + j) & 127];
    for (int m = gw; m < TL; m += NGW) {
        float o[16], g[16]; unpack8(*(const GAS v4u*)(O + (size_t)m * D + c0), o); unpack8(*(const GAS v4u*)(O + (size_t)m * D + c0 + 8), o + 8);
        unpack8(*(const GAS v4u*)(G + (size_t)m * D + c0), g); unpack8(*(const GAS v4u*)(G + (size_t)m * D + c0 + 8), g + 8);
        float ss = 0.f;
#pragma unroll
        for (int j = 0; j < 16; ++j) ss += o[j] * o[j];
        ss += __shfl_xor(ss, 1); ss += __shfl_xor(ss, 2); ss += __shfl_xor(ss, 4);
        const float sc = 1.f / sqrtf(ss * (1.f / 128.f) + NORM_EPS);
#pragma unroll
        for (int j = 0; j < 16; ++j) o[j] = o[j] * sc * ng[j] * siluf_(g[j]);
        *(GAS v4u*)(O + (size_t)m * D + c0) = pack8(o); *(GAS v4u*)(O + (size_t)m * D + c0 + 8) = pack8(o + 8);
    }
}

typedef short bf16x8_t __attribute__((ext_vector_type(8)));
typedef float f32x16 __attribute__((ext_vector_type(16)));
__device__ __forceinline__ int crow(int r, int hi) { return (r & 3) + 8 * (r >> 2) + 4 * hi; }
constexpr int NCH = TT / 64;
__device__ __forceinline__ void p0_s5_tables(Frame& F) {
    LAS unsigned char* L = F.lds + RING_OFF;
    LAS double* lam = (LAS double*)L;
    LAS float* bb = (LAS float*)(L + 1024);
    LAS float* cc = (LAS float*)(L + 1024 + 8192);
    LAS float* pw = (LAS float*)(L + 1024 + 16384);
    unsigned char* ws = ws_(F);
    for (int item4 = blockIdx.x; item4 < 256; item4 += F.G) {
        const int item = item4 >> 2, part = item4 & 3;
        const int g = item >> 1, d = item & 1;
        __syncthreads();
        if (F.tid < 64) { const int n = F.tid, pi = (d * 32 + g) * 64 + n;
            const double lre = inp(F, 17)[pi], lim = inp(F, 18)[pi], dt = exp((double)inp(F, 19)[d * 32 + g]);
            const double mag = exp(lre * dt), are = mag * cos(lim * dt), aim = mag * sin(lim * dt), den = lre * lre + lim * lim, nr = are - 1.0;
            const double fr = (nr * lre + aim * lim) / den, fi = (aim * lre - nr * lim) / den;
            for (int q = 0; q < 16; ++q) { const double br = inp(F, 20)[(size_t)pi * 16 + q], bi = inp(F, 21)[(size_t)pi * 16 + q];
                bb[(n * 16 + q) * 2] = (float)(fr * br - fi * bi); bb[(n * 16 + q) * 2 + 1] = (float)(fr * bi + fi * br); }
            double pr = 1.0, pim = 0.0;
            for (int e = 0; e <= 64; ++e) { pw[(e * 64 + n) * 2] = (float)pr; pw[(e * 64 + n) * 2 + 1] = (float)pim; const double n_r = pr * are - pim * aim, n_i = pr * aim + pim * are; pr = n_r; pim = n_i; } }
        for (int i = F.tid; i < 1024; i += 512) { const int p = i >> 6, n = i & 63; cc[i * 2] = inp(F, 22)[((size_t)(d * 32 + g) * 16 + p) * 64 + n]; cc[i * 2 + 1] = inp(F, 23)[((size_t)(d * 32 + g) * 16 + p) * 64 + n]; }
        __syncthreads();
        { bf16* WF = (bf16*)(ws + WS_WF) + (size_t)g * 256 * 1024;
          for (int i = part * 4096 + F.tid; i < (part + 1) * 4096; i += 512) { const int row = i >> 7, grp = i & 127, c = row >> 6, n = row & 63, sI = grp >> 1, q0 = (grp & 1) * 8, e = d ? sI : 63 - sI;
              const float pr = pw[(e * 64 + n) * 2], pim = pw[(e * 64 + n) * 2 + 1]; float o[8];
              const LAS f32x4* bq = (const LAS f32x4*)(bb + (n * 16 + q0) * 2);
#pragma unroll
              for (int j4 = 0; j4 < 4; ++j4) { const f32x4 v = bq[j4]; o[2 * j4] = c ? (pr * v.y + pim * v.x) : (pr * v.x - pim * v.y); o[2 * j4 + 1] = c ? (pr * v.w + pim * v.z) : (pr * v.z - pim * v.w); }
              *(GAS v4u*)(WF + (size_t)(d * 128 + row) * 1024 + sI * 16 + q0) = pack8(o); } }
        { bf16* WC = (bf16*)(ws + WS_WC) + (size_t)g * 1024 * 256;
          for (int i = part * 4096 + F.tid; i < (part + 1) * 4096; i += 512) { const int row = i >> 4, grp = i & 15, t = row >> 4, p = row & 15, c = grp >> 3, n0 = (grp & 7) * 8, ex = d ? 64 - t : t + 1; float o[8];
              const LAS f32x4* pq = (const LAS f32x4*)(pw + (ex * 64 + n0) * 2); const LAS f32x4* cq = (const LAS f32x4*)(cc + (p * 64 + n0) * 2);
#pragma unroll
              for (int j4 = 0; j4 < 4; ++j4) { const f32x4 pv = pq[j4], cv = cq[j4];
                  o[2 * j4] = c ? -(cv.x * pv.y + cv.y * pv.x) : (cv.x * pv.x - cv.y * pv.y); o[2 * j4 + 1] = c ? -(cv.z * pv.w + cv.w * pv.z) : (cv.z * pv.z - cv.w * pv.w); }
              *(GAS v4u*)(WC + (size_t)row * 256 + d * 128 + c * 64 + n0) = pack8(o); } }
        { bf16* TP = (bf16*)(ws + WS_TOEP) + (size_t)g * 127 * 256; float* T0 = (float*)(ws + WS_T0) + (size_t)(g * 2 + d) * 256;
          for (int i = part * 256 + F.tid; i < (part + 1) * 256; i += 512) { const int tau = i >> 4, p = i & 15; float acc[16];
#pragma unroll
              for (int q = 0; q < 16; ++q) acc[q] = 0.f;
              for (int n = 0; n < 64; ++n) { const float pr = pw[(tau * 64 + n) * 2], pim = pw[(tau * 64 + n) * 2 + 1], cr = cc[(p * 64 + n) * 2], ci = cc[(p * 64 + n) * 2 + 1];
                  const float tr = cr * pr - ci * pim, ti = cr * pim + ci * pr;
                  const LAS f32x4* bq = (const LAS f32x4*)(bb + n * 32);
#pragma unroll
                  for (int q4 = 0; q4 < 8; ++q4) { const f32x4 v = bq[q4]; acc[2 * q4] += tr * v.x - ti * v.y; acc[2 * q4 + 1] += tr * v.z - ti * v.w; } }
              if (tau == 0) {
#pragma unroll
                  for (int q = 0; q < 16; ++q) T0[p * 16 + q] = acc[q]; }
              else { bf16* o = TP + (size_t)(d ? 63 - tau : 63 + tau) * 256 + p * 16; *(GAS v4u*)o = pack8(acc); *(GAS v4u*)(o + 8) = pack8(acc + 8); } } }
        if (part == 0 && F.tid < 64) { float* A64 = (float*)(ws + WS_A64) + (size_t)((g * 2 + d) * 64 + F.tid) * 2; A64[0] = pw[(64 * 64 + F.tid) * 2]; A64[1] = pw[(64 * 64 + F.tid) * 2 + 1]; }
    }
    __syncthreads();
}
__device__ __forceinline__ void ph_s5_finals(Frame& F) {
    const int lane = F.lane, r32 = lane & 31, hh = lane >> 5, wave = F.wave;
    unsigned char* ws = ws_(F);
    for (int u = blockIdx.x; u < 288; u += F.G) {
        const int g = u / 9, nb = u % 9; int chunk = nb * 32 + r32; const bool valid = chunk < NCH; if (!valid) chunk = NCH - 1;
        const bf16* ub = (const bf16*)(ws + WS_UG) + ((size_t)g * TT + (size_t)chunk * 64) * 16 + 8 * hh;
        const bf16* wf = (const bf16*)(ws + WS_WF) + ((size_t)(g * 256 + 32 * wave + r32)) * 1024 + 8 * hh;
        f32x16 acc;
#pragma unroll
        for (int r = 0; r < 16; ++r) acc[r] = 0.f;
#pragma unroll 16
        for (int sI = 0; sI < 64; ++sI) { const bf16x8_t a = *(const GAS bf16x8_t*)(wf + 16 * sI), b = *(const GAS bf16x8_t*)(ub + 16 * sI); acc = __builtin_amdgcn_mfma_f32_32x32x16_bf16(a, b, acc, 0, 0, 0); }
        if (valid) { float* fo = (float*)(ws + WS_FIN) + ((size_t)g * NCH + chunk) * 256 + 32 * wave + 4 * hh;
#pragma unroll
            for (int k = 0; k < 4; ++k) *(GAS f32x4*)(fo + 8 * k) = (f32x4){acc[4 * k], acc[4 * k + 1], acc[4 * k + 2], acc[4 * k + 3]}; }
    }
}
__device__ __forceinline__ int s5_chunk_of(int step, int d, int b) { return step < 4 ? 256 + 4 * b + (d ? 3 - step : step) : 128 * b + (d ? 127 - (step - 4) : step - 4); }
__device__ __forceinline__ void ph_s5_carry(Frame& F) {
    if (F.wave >= 3) return;
    unsigned char* ws = ws_(F);
    for (int item = ((int)F.G - 1 - (int)blockIdx.x) * 3 + F.wave; item < 128; item += 3 * F.G) {
        const int g = item >> 2, d = (item >> 1) & 1, b = item & 1, n = F.lane;
        const float a_r = ((const float*)(ws + WS_A64))[((g * 2 + d) * 64 + n) * 2], a_i = ((const float*)(ws + WS_A64))[((g * 2 + d) * 64 + n) * 2 + 1];
        const float* Fb = (const float*)(ws + WS_FIN) + (size_t)g * NCH * 256 + d * 128 + n; bf16* Sb = (bf16*)(ws + WS_SIN) + (size_t)g * NCH * 256 + d * 128 + n;
        float sr = 0.f, si = 0.f;
        for (int s0 = 0; s0 < 132; s0 += 12) {
            float fr[12], fi[12];
#pragma unroll
            for (int j = 0; j < 12; ++j) { const int c = s5_chunk_of(s0 + j, d, b); fr[j] = Fb[(size_t)c * 256]; fi[j] = Fb[(size_t)c * 256 + 64]; }
#pragma unroll
            for (int j = 0; j < 12; ++j) { const int c = s5_chunk_of(s0 + j, d, b); Sb[(size_t)c * 256] = (bf16)f2bf(sr); Sb[(size_t)c * 256 + 64] = (bf16)f2bf(si);
                const float nr = a_r * sr - a_i * si + fr[j], ni = a_r * si + a_i * sr + fi[j]; sr = nr; si = ni; }
        }
    }
}
constexpr int TP_PITCH = 48;
__device__ __forceinline__ void ph_s5_out(Frame& F) {
    LAS unsigned char* L = F.lds + RING_OFF;
    const int lane = F.lane, r32 = lane & 31, hh = lane >> 5, wave = F.wave, tid = F.tid;
    unsigned char* ws = ws_(F);
    for (int u = blockIdx.x; u < 288; u += F.G) {
        const int g = u / 9, nb = u % 9; int chunk = nb * 32 + r32; const bool valid = chunk < NCH; if (!valid) chunk = NCH - 1;
        __syncthreads();
        { const GAS v4u* tp = (const GAS v4u*)((const bf16*)(ws + WS_TOEP) + (size_t)g * 127 * 256); const float* t0 = (const float*)(ws + WS_T0) + (size_t)g * 512;
          for (int c = tid; c < 127 * 32; c += 512) { const int di = c >> 5, p = (c >> 1) & 15, half = c & 1; v4u v;
              if (di == 63) { float o[8];
#pragma unroll
                  for (int j = 0; j < 8; ++j) o[j] = t0[p * 16 + half * 8 + j] + t0[256 + p * 16 + half * 8 + j];
                  v = pack8(o); }
              else v = tp[c];
              *(LAS v4u*)(L + (di * 16 + p) * TP_PITCH + half * 16) = v; } }
        __syncthreads();
        const bf16* ub = (const bf16*)(ws + WS_UG) + ((size_t)g * TT + (size_t)chunk * 64) * 16 + 8 * hh;
        f32x16 acc[4];
#pragma unroll
        for (int i = 0; i < 4; ++i)
#pragma unroll
            for (int r = 0; r < 16; ++r) acc[i][r] = 0.f;
        const LAS unsigned char* tl = L + ((63 + 2 * wave + (r32 >> 4)) * 16 + (r32 & 15)) * TP_PITCH + hh * 16;
#pragma unroll 1
        for (int s0 = 0; s0 < 64; s0 += 16) {
            bf16x8_t bq[16];
#pragma unroll
            for (int e = 0; e < 16; ++e) bq[e] = *(const GAS bf16x8_t*)(ub + 16 * (s0 + e));
#pragma unroll
            for (int e = 0; e < 16; ++e) { const int sI = s0 + e; const bf16x8_t b = bq[e];
#pragma unroll
            for (int i = 0; i < 4; ++i) { const bf16x8_t a = *(const LAS bf16x8_t*)(tl + (16 * i - sI) * 16 * TP_PITCH); acc[i] = __builtin_amdgcn_mfma_f32_32x32x16_bf16(a, b, acc[i], 0, 0, 0); }
            }
        }
        { const bf16* sb = (const bf16*)(ws + WS_SIN) + ((size_t)g * NCH + chunk) * 256 + 8 * hh;
          const bf16* wc = (const bf16*)(ws + WS_WC) + ((size_t)g * 1024 + 32 * wave + r32) * 256 + 8 * hh;
#pragma unroll 4
          for (int kk = 0; kk < 16; ++kk) {
              const bf16x8_t b = *(const GAS bf16x8_t*)(sb + 16 * kk);
#pragma unroll
              for (int i = 0; i < 4; ++i) { const bf16x8_t a = *(const GAS bf16x8_t*)(wc + (size_t)(256 * i) * 256 + 16 * kk); acc[i] = __builtin_amdgcn_mfma_f32_32x32x16_bf16(a, b, acc[i], 0, 0, 0); }
          } }
        if (valid) {
            const float* dsk = inp(F, 24) + 16 * g;
#pragma unroll
            for (int i = 0; i < 4; ++i)
#pragma unroll
                for (int k = 0; k < 4; ++k) { const int tloc = 2 * (wave + 8 * i) + (k >> 1), p0 = 8 * (k & 1) + 4 * hh; const size_t m = (size_t)chunk * 64 + tloc;
                    const v2u uw = *(const GAS v2u*)((const bf16*)(ws + WS_UG) + ((size_t)g * TT + m) * 16 + p0);
                    const float y0 = gelu_tanh(acc[i][4 * k] + dsk[p0] * bflo(uw.x)), y1 = gelu_tanh(acc[i][4 * k + 1] + dsk[p0 + 1] * bfhi(uw.x));
                    const float y2 = gelu_tanh(acc[i][4 * k + 2] + dsk[p0 + 2] * bflo(uw.y)), y3 = gelu_tanh(acc[i][4 * k + 3] + dsk[p0 + 3] * bfhi(uw.y));
                    v2u zw; zw.x = pk2(y0, y1); zw.y = pk2(y2, y3);
                    *(GAS v2u*)((bf16*)(ws + WS_Z) + m * 512 + 16 * g + p0) = zw; }
        }
    }
}

__device__ __forceinline__ bf16x8_t pack_frag(const f32x16& p, int base) {
    v4u w; w.x = pg8::cvt_pk_bf16(p[base + 0], p[base + 1]); w.y = pg8::cvt_pk_bf16(p[base + 2], p[base + 3]); w.z = pg8::cvt_pk_bf16(p[base + 4], p[base + 5]); w.w = pg8::cvt_pk_bf16(p[base + 6], p[base + 7]);
    return __builtin_bit_cast(bf16x8_t, w);
}
constexpr int AT_KP = 208, AT_VP = 272;
constexpr int AT_KB = 128 * AT_KP, AT_VB = 64 * AT_VP;
constexpr int AT_K0 = 0, AT_V0 = 2 * AT_KB, AT_WS = 2 * AT_KB + 2 * AT_VB;
__device__ __forceinline__ void ph_attn(Frame& F) {
    LAS unsigned char* L = F.lds + RING_OFF;
    const int lane = F.lane, r32 = lane & 31, hi = lane >> 5, wave = F.wave, tid = F.tid;
    volatile LAS float* wsf = (volatile LAS float*)(L + AT_WS) + wave * 32;
    const bf16* Qb = (const bf16*)(ws_(F) + WS_QB); const bf16* Kb = (const bf16*)(ws_(F) + WS_KB); const bf16* Vt = (const bf16*)(ws_(F) + WS_VB);
    bf16* MIX = (bf16*)(ws_(F) + WS_MIX);
    int kl[3], vl[2];
#pragma unroll
    for (int i = 0; i < 3; ++i) { const int c = tid + 512 * i; kl[i] = (c / 12) * AT_KP + (c % 12) * 16; }
#pragma unroll
    for (int i = 0; i < 2; ++i) { const int c = tid + 512 * i; vl[i] = ((c & 511) >> 3) * AT_VP + (c >> 9) * 128 + (c & 7) * 16; }
    for (int it = 0; it < 3; ++it) {
        int u; if (it < 2) u = it * 256 + F.vcu; else { if (F.vcu >= 16) break; u = 512 + F.vcu; }
        int b, h, tq0, NT, m0;
        if (u < 512) { b = u >> 8; h = (u >> 5) & 7; tq0 = (u & 31) * 256; NT = TQK / 128; m0 = b * SEQ + tq0; }
        else { const int uc = u - 512; b = uc >> 3; h = uc & 7; tq0 = SEQ; NT = CTXL / 128; m0 = TL + b * CTXL; }
        const size_t bh = (size_t)(b * 8 + h);
        const GAS v4u* Kg = (const GAS v4u*)(Kb + bh * TQK * 96);
        const GAS v4u* Vg = (const GAS v4u*)(Vt + bh * (TQK / 64) * 4096);
        bf16x8_t qf[6];
        { const bf16* qp = Qb + (bh * TQK + tq0 + wave * 32 + r32) * 96 + hi * 8;
#pragma unroll
          for (int ks = 0; ks < 6; ++ks) qf[ks] = *(const GAS bf16x8_t*)(qp + ks * 16); }
        f32x16 o0, o1;
#pragma unroll
        for (int r = 0; r < 16; ++r) { o0[r] = 0.f; o1[r] = 0.f; }
        float m_run = -1e30f, l_run = 0.f;
        __syncthreads();
        { v4u a[3], v[2];
#pragma unroll
          for (int i = 0; i < 3; ++i) a[i] = Kg[tid + 512 * i];
#pragma unroll
          for (int i = 0; i < 2; ++i) v[i] = Vg[tid + 512 * i];
#pragma unroll
          for (int i = 0; i < 3; ++i) *(LAS v4u*)(L + AT_K0 + kl[i]) = a[i];
#pragma unroll
          for (int i = 0; i < 2; ++i) *(LAS v4u*)(L + AT_V0 + vl[i]) = v[i]; }
        __syncthreads();
        for (int t = 0; t < NT; ++t) {
            const int cur = t & 1, nxt = cur ^ 1; const bool more = (t + 1 < NT);
            v4u na[3], nv[2];
#pragma unroll
            for (int i = 0; i < 3; ++i) na[i] = (v4u){0u, 0u, 0u, 0u};
#pragma unroll
            for (int i = 0; i < 2; ++i) nv[i] = (v4u){0u, 0u, 0u, 0u};
            if (more) {
#pragma unroll
                for (int i = 0; i < 3; ++i) na[i] = Kg[(size_t)(t + 1) * 1536 + tid + 512 * i];
#pragma unroll
                for (int i = 0; i < 2; ++i) nv[i] = Vg[(size_t)(t + 1) * 1024 + tid + 512 * i]; }
            const LAS unsigned char* Kl = L + AT_K0 + cur * AT_KB + r32 * AT_KP + hi * 16;
            const LAS unsigned char* Vl = L + AT_V0 + cur * AT_VB + r32 * AT_VP + hi * 16;
            f32x16 p[4];
#pragma unroll
            for (int kb = 0; kb < 4; ++kb) {
#pragma unroll
                for (int r = 0; r < 16; ++r) p[kb][r] = 0.f;
#pragma unroll
                for (int ks = 0; ks < 6; ++ks) p[kb] = __builtin_amdgcn_mfma_f32_32x32x16_bf16(*(const LAS bf16x8_t*)(Kl + kb * 32 * AT_KP + ks * 32), qf[ks], p[kb], 0, 0, 0);
            }
            float mt = fmaxf(fmaxf(p[0][0], p[1][0]), fmaxf(p[2][0], p[3][0]));
#pragma unroll
            for (int r = 1; r < 16; ++r) mt = fmaxf(mt, fmaxf(fmaxf(p[0][r], p[1][r]), fmaxf(p[2][r], p[3][r])));
            mt = fmaxf(mt, __shfl_xor(mt, 32));
            const bool need = mt > m_run + 8.0f;
            if (__any(need)) {
                const float mn = need ? mt : m_run, alpha = __builtin_amdgcn_exp2f(m_run - mn);
                l_run *= alpha; m_run = mn;
                if (hi == 0) wsf[r32] = alpha;
#pragma unroll
                for (int r = 0; r < 16; ++r) { const float a = wsf[crow(r, hi)]; o0[r] *= a; o1[r] *= a; }
            }
            float sum = 0.f;
#pragma unroll
            for (int kb = 0; kb < 4; ++kb)
#pragma unroll
                for (int r = 0; r < 16; ++r) { p[kb][r] = __builtin_amdgcn_exp2f(p[kb][r] - m_run); sum += p[kb][r]; }
            l_run += sum;
#pragma unroll
            for (int kb = 0; kb < 4; ++kb) {
                const bf16x8_t pa = pack_frag(p[kb], 0), pb = pack_frag(p[kb], 8);
                const LAS unsigned char* vp = Vl + (kb >> 1) * 128 + (kb & 1) * 64;
                o0 = __builtin_amdgcn_mfma_f32_32x32x16_bf16(pa, *(const LAS bf16x8_t*)(vp), o0, 0, 0, 0);
                o0 = __builtin_amdgcn_mfma_f32_32x32x16_bf16(pb, *(const LAS bf16x8_t*)(vp + 32), o0, 0, 0, 0);
                o1 = __builtin_amdgcn_mfma_f32_32x32x16_bf16(pa, *(const LAS bf16x8_t*)(vp + 32 * AT_VP), o1, 0, 0, 0);
                o1 = __builtin_amdgcn_mfma_f32_32x32x16_bf16(pb, *(const LAS bf16x8_t*)(vp + 32 * AT_VP + 32), o1, 0, 0, 0);
            }
            if (more) {
#pragma unroll
                for (int i = 0; i < 3; ++i) *(LAS v4u*)(L + AT_K0 + nxt * AT_KB + kl[i]) = na[i];
#pragma unroll
                for (int i = 0; i < 2; ++i) *(LAS v4u*)(L + AT_V0 + nxt * AT_VB + vl[i]) = nv[i]; }
            __syncthreads();
        }
        l_run += __shfl_xor(l_run, 32);
        if (hi == 0) wsf[r32] = 1.0f / l_run;
#pragma unroll
        for (int r = 0; r < 16; ++r) { const int q = crow(r, hi); const float inv = wsf[q];
            bf16* op = MIX + (size_t)(m0 + wave * 32 + q) * D + h * 64 + r32;
            op[0] = (bf16)f2bf(o0[r] * inv); op[32] = (bf16)f2bf(o1[r] * inv); }
    }
}

constexpr int HG_QT = 0, HG_KT = 17408, HG_KH = 34816, HG_VT = 53248, HG_ST = 71680, HG_DEC = 106496, HG_TOT = 107008;
constexpr int HG_NSC = 17;
constexpr size_t WS_SD = 231 * MiB;
constexpr size_t WS_DECS = WS_SD + 18 * MiB;
static_assert(WS_DECS + 32 * 17 * 128 * 4 <= WS_END, "hgrn ws");
template <bool OUT>
__device__ __forceinline__ void hgrn_pass(Frame& F, int b, int h, int dir, int sc, f32x16 (&st)[2], float& dsum) {
    LAS unsigned char* L = F.lds + RING_OFF;
    unsigned char* ws = ws_(F);
    const int tid = F.tid, lane = F.lane, r32 = lane & 31, hh = lane >> 5, wave = F.wave;
    const int k = tid & 127, tg = tid >> 7;
    const int nch = sc == 0 ? 4 : 8; const size_t rowbase = sc == 0 ? (size_t)TL + b * CTXL : (size_t)b * SEQ + (size_t)(sc - 1) * 512;
    const bf16* QF = (const bf16*)(ws + WS_QFFI);
    const float lb = ((const float*)(ws + WS_LBV))[dir * 1024 + h * 128 + k];
    const int colf = 1024 * (1 + dir) + h * 128 + k, colq = h * 128 + k, colv = 3072 + h * 128 + k;
    const int dvb = wave & 3, jb = wave >> 2;
    bf16 rq[16], rf[16], rv[16];
#define HG_LOAD(ci) do { const int cc_ = dir ? nch - 1 - (ci) : (ci); const int tl0_ = dir ? 63 - 16 * tg : 16 * tg; \
        const GAS bf16* pf_ = (const GAS bf16*)(QF + (rowbase + 64 * cc_ + tl0_) * 4096 + colf); const GAS bf16* pv_ = pf_ + (colv - colf); const GAS bf16* pq_ = pf_ + (colq - colf); const long stp_ = dir ? -4096 : 4096; \
        _Pragma("unroll") for (int jj = 0; jj < 16; ++jj) { rf[jj] = *pf_; rv[jj] = *pv_; if (OUT) rq[jj] = *pq_; pf_ += stp_; pv_ += stp_; pq_ += stp_; asm volatile("" : "+v"(pf_), "+v"(pv_), "+v"(pq_)); } } while (0)
    HG_LOAD(0);
    for (int ci = 0; ci < nch; ++ci) {
        const int cc = dir ? nch - 1 - ci : ci;
        float cum[16], kk[16];
        { float run = 0.f;
#pragma unroll
          for (int jj = 0; jj < 16; ++jj) { const float f = lb + (1.f - lb) * sigmoidf_(bf2f(rf[jj])); run += __log2f(f); cum[jj] = run; kk[jj] = 1.f - f; }
          ((LAS float*)(L + HG_TOT))[tg * 128 + k] = run; }
        __syncthreads();
        { const LAS float* tot = (const LAS float*)(L + HG_TOT) + k; const float t0 = tot[0], t1 = tot[128], t2 = tot[256], t3 = tot[384];
          const float pre = tg == 0 ? 0.f : (tg == 1 ? t0 : (tg == 2 ? t0 + t1 : t0 + t1 + t2)), total = (t0 + t1) + (t2 + t3);
          if (tg == 0) { ((LAS float*)(L + HG_DEC))[k] = __builtin_amdgcn_exp2f(total); dsum += total; }
#define HG_KH(jj) (kk[jj] * __builtin_amdgcn_exp2f(total - (pre + cum[jj])))
#define HG_PKV(a, b_) ((unsigned)rv[a] | ((unsigned)rv[b_] << 16))
          if (OUT) {
#pragma unroll
              for (int jj = 0; jj < 16; ++jj) { const float c = pre + cum[jj]; const int j = 16 * tg + jj;
                  *(LAS bf16*)(L + HG_QT + j * 272 + k * 2) = (bf16)f2bf(bf2f(rq[jj]) * __builtin_amdgcn_exp2f(c)); *(LAS bf16*)(L + HG_KT + j * 272 + k * 2) = (bf16)f2bf(kk[jj] * __builtin_amdgcn_exp2f(-c)); } }
          v4u w0, w1;
          w0.x = pk2(HG_KH(0), HG_KH(1)); w0.y = pk2(HG_KH(2), HG_KH(3)); w0.z = pk2(HG_KH(8), HG_KH(9)); w0.w = pk2(HG_KH(10), HG_KH(11));
          w1.x = pk2(HG_KH(4), HG_KH(5)); w1.y = pk2(HG_KH(6), HG_KH(7)); w1.z = pk2(HG_KH(12), HG_KH(13)); w1.w = pk2(HG_KH(14), HG_KH(15));
          *(LAS v4u*)(L + HG_KH + k * 144 + tg * 32) = w0; *(LAS v4u*)(L + HG_KH + k * 144 + tg * 32 + 16) = w1;
          w0.x = HG_PKV(0, 1); w0.y = HG_PKV(2, 3); w0.z = HG_PKV(8, 9); w0.w = HG_PKV(10, 11);
          w1.x = HG_PKV(4, 5); w1.y = HG_PKV(6, 7); w1.z = HG_PKV(12, 13); w1.w = HG_PKV(14, 15);
          *(LAS v4u*)(L + HG_VT + k * 144 + tg * 32) = w0; *(LAS v4u*)(L + HG_VT + k * 144 + tg * 32 + 16) = w1; }
#undef HG_KH
#undef HG_PKV
        if (ci + 1 < nch) HG_LOAD(ci + 1);
        __syncthreads();
        if (OUT) {
            f32x16 oacc;
#pragma unroll
            for (int r = 0; r < 16; ++r) oacc[r] = 0.f;
            const LAS unsigned char* qrow = L + HG_QT + (32 * jb + r32) * 272 + hh * 16;
            const LAS unsigned char* srow = L + HG_ST + (32 * dvb + r32) * 272 + hh * 16;
            const LAS unsigned char* vrow = L + HG_VT + (32 * dvb + r32) * 144 + hh * 16;
#pragma unroll
            for (int ks = 0; ks < 8; ++ks) oacc = __builtin_amdgcn_mfma_f32_32x32x16_bf16(*(const LAS bf16x8_t*)(qrow + ks * 32), *(const LAS bf16x8_t*)(srow + ks * 32), oacc, 0, 0, 0);
            {
                f32x16 at;
#pragma unroll
                for (int r = 0; r < 16; ++r) at[r] = 0.f;
                const LAS unsigned char* krow = L + HG_KT + r32 * 272 + hh * 16;
#pragma unroll
                for (int ks = 0; ks < 8; ++ks) at = __builtin_amdgcn_mfma_f32_32x32x16_bf16(*(const LAS bf16x8_t*)(krow + ks * 32), *(const LAS bf16x8_t*)(qrow + ks * 32), at, 0, 0, 0);
                if (jb == 0) {
#pragma unroll
                    for (int r = 0; r < 16; ++r) if (crow(r, hh) > r32) at[r] = 0.f; }
                oacc = __builtin_amdgcn_mfma_f32_32x32x16_bf16(pack_frag(at, 0), *(const LAS bf16x8_t*)(vrow + 0), oacc, 0, 0, 0);
                oacc = __builtin_amdgcn_mfma_f32_32x32x16_bf16(pack_frag(at, 8), *(const LAS bf16x8_t*)(vrow + 32), oacc, 0, 0, 0);
            }
            if (jb == 1) {
                f32x16 at;
#pragma unroll
                for (int r = 0; r < 16; ++r) at[r] = 0.f;
                const LAS unsigned char* krow = L + HG_KT + (32 + r32) * 272 + hh * 16;
#pragma unroll
                for (int ks = 0; ks < 8; ++ks) at = __builtin_amdgcn_mfma_f32_32x32x16_bf16(*(const LAS bf16x8_t*)(krow + ks * 32), *(const LAS bf16x8_t*)(qrow + ks * 32), at, 0, 0, 0);
#pragma unroll
                for (int r = 0; r < 16; ++r) if (crow(r, hh) > r32) at[r] = 0.f;
                oacc = __builtin_amdgcn_mfma_f32_32x32x16_bf16(pack_frag(at, 0), *(const LAS bf16x8_t*)(vrow + 64), oacc, 0, 0, 0);
                oacc = __builtin_amdgcn_mfma_f32_32x32x16_bf16(pack_frag(at, 8), *(const LAS bf16x8_t*)(vrow + 96), oacc, 0, 0, 0);
            }
            bf16* O = (bf16*)(ws + WS_O);
#pragma unroll
            for (int r = 0; r < 16; ++r) { const int j = 32 * jb + crow(r, hh), tl = dir ? 63 - j : j;
                bf16* op = O + (rowbase + 64 * cc + tl) * D + h * 128 + 32 * dvb + r32; float ov = oacc[r];
                if (dir) ov += bf2f(*op);
                *op = (bf16)f2bf(ov); }
        }
#pragma unroll
        for (int t = 0; t < 2; ++t) { const int dkb = 2 * (wave >> 2) + t;
#pragma unroll
            for (int q4 = 0; q4 < 4; ++q4) { const f32x4 dd = *(const LAS f32x4*)(L + HG_DEC + (32 * dkb + 8 * q4 + 4 * hh) * 4);
                st[t][4 * q4] *= dd[0]; st[t][4 * q4 + 1] *= dd[1]; st[t][4 * q4 + 2] *= dd[2]; st[t][4 * q4 + 3] *= dd[3]; }
            const LAS unsigned char* arow = L + HG_KH + (32 * dkb + r32) * 144 + hh * 16; const LAS unsigned char* vrow = L + HG_VT + (32 * dvb + r32) * 144 + hh * 16;
#pragma unroll
            for (int ks = 0; ks < 4; ++ks) st[t] = __builtin_amdgcn_mfma_f32_32x32x16_bf16(*(const LAS bf16x8_t*)(arow + ks * 32), *(const LAS bf16x8_t*)(vrow + ks * 32), st[t], 0, 0, 0); }
        __syncthreads();
        if (OUT && ci + 1 < nch) {
#pragma unroll
            for (int t = 0; t < 2; ++t) { const int dkb = 2 * (wave >> 2) + t;
#pragma unroll
                for (int q4 = 0; q4 < 4; ++q4) { v2u w; w.x = pk2(st[t][4 * q4], st[t][4 * q4 + 1]); w.y = pk2(st[t][4 * q4 + 2], st[t][4 * q4 + 3]);
                    *(LAS v2u*)(L + HG_ST + (32 * dvb + r32) * 272 + (32 * dkb + 8 * q4 + 4 * hh) * 2) = w; } }
        }
    }
#undef HG_LOAD
}
__device__ __forceinline__ void ph_hgrn_states(Frame& F) {
    unsigned char* ws = ws_(F);
    for (int item = blockIdx.x; item < 32 * HG_NSC; item += F.G) {
        const int chain = item / HG_NSC, sc = item % HG_NSC, b = chain >> 4, h = (chain >> 1) & 7, dir = chain & 1;
        f32x16 st[2];
#pragma unroll
        for (int t = 0; t < 2; ++t)
#pragma unroll
            for (int r = 0; r < 16; ++r) st[t][r] = 0.f;
        float dsum = 0.f;
        hgrn_pass<false>(F, b, h, dir, sc, st, dsum);
        bf16* sd = (bf16*)(ws + WS_SD) + ((size_t)(chain * HG_NSC + sc) * 8 + F.wave) * 2048 + F.lane;
#pragma unroll
        for (int t = 0; t < 2; ++t)
#pragma unroll
            for (int r = 0; r < 16; ++r) sd[(t * 16 + r) * 64] = (bf16)f2bf(st[t][r]);
        if (F.tid < 128) ((float*)(ws + WS_DECS))[(size_t)(chain * HG_NSC + sc) * 128 + F.tid] = dsum;
    }
}
__device__ __forceinline__ void ph_hgrn_out(Frame& F) {
    LAS unsigned char* L = F.lds + RING_OFF;
    unsigned char* ws = ws_(F);
    const int lane = F.lane, r32 = lane & 31, hh = lane >> 5, wave = F.wave, dvb = wave & 3;
    for (int item = blockIdx.x; item < 256; item += F.G) {
        const int b = item >> 7, h = (item >> 4) & 7, Lsc = item & 15, sc = Lsc + 1;
        for (int dir = 0; dir < 2; ++dir) {
            const int chain = (b * 8 + h) * 2 + dir;
            f32x16 st[2];
#pragma unroll
            for (int t = 0; t < 2; ++t)
#pragma unroll
                for (int r = 0; r < 16; ++r) st[t][r] = 0.f;
            const int npre = dir ? 1 + (16 - sc) : sc;
            for (int i = 0; i < npre; ++i) {
                const int sp = (i == 0) ? 0 : (dir ? 17 - i : i);
                const bf16* sd = (const bf16*)(ws + WS_SD) + ((size_t)(chain * HG_NSC + sp) * 8 + wave) * 2048 + lane;
                const float* dl = (const float*)(ws + WS_DECS) + (size_t)(chain * HG_NSC + sp) * 128;
#pragma unroll
                for (int t = 0; t < 2; ++t) { const int dkb = 2 * (wave >> 2) + t;
#pragma unroll
                    for (int q4 = 0; q4 < 4; ++q4) { const f32x4 dd = *(const GAS f32x4*)(dl + 32 * dkb + 8 * q4 + 4 * hh);
#pragma unroll
                        for (int e = 0; e < 4; ++e) st[t][4 * q4 + e] = __builtin_amdgcn_exp2f(dd[e]) * st[t][4 * q4 + e] + bf2f(sd[(t * 16 + 4 * q4 + e) * 64]); } }
            }
            __syncthreads();
#pragma unroll
            for (int t = 0; t < 2; ++t) { const int dkb = 2 * (wave >> 2) + t;
#pragma unroll
                for (int q4 = 0; q4 < 4; ++q4) { v2u w; w.x = pk2(st[t][4 * q4], st[t][4 * q4 + 1]); w.y = pk2(st[t][4 * q4 + 2], st[t][4 * q4 + 3]);
                    *(LAS v2u*)(L + HG_ST + (32 * dvb + r32) * 272 + (32 * dkb + 8 * q4 + 4 * hh) * 2) = w; } }
            float dsum = 0.f;
            hgrn_pass<true>(F, b, h, dir, sc, st, dsum);
            __syncthreads();
        }
    }
}

struct FInProj {
    bf16* cqkv; bf16* ug;
    __device__ __forceinline__ void operator()(int row, int col, f32x4 v0, f32x4 v1) const {
        v4u w; w.x = pg8::cvt_pk_bf16(v0[0], v0[1]); w.y = pg8::cvt_pk_bf16(v0[2], v0[3]); w.z = pg8::cvt_pk_bf16(v1[0], v1[1]); w.w = pg8::cvt_pk_bf16(v1[2], v1[3]);
        if (col < 672) *(GAS v4u*)(cqkv + (size_t)row * CQKV_LD + col) = w;
        else if (col < EVEN_IN) { const int c = col - 672; *(GAS v4u*)(ug + ((size_t)(c >> 4) * TT + row) * 16 + (c & 15)) = w; }
    }
};
struct FBf16 {
    bf16* o; int ld;
    __device__ __forceinline__ void operator()(int row, int col, f32x4 v0, f32x4 v1) const {
        v4u w; w.x = pg8::cvt_pk_bf16(v0[0], v0[1]); w.y = pg8::cvt_pk_bf16(v0[2], v0[3]); w.z = pg8::cvt_pk_bf16(v1[0], v1[1]); w.w = pg8::cvt_pk_bf16(v1[2], v1[3]);
        *(GAS v4u*)(o + (size_t)row * ld + col) = w;
    }
};
struct EpiGlu {
    static constexpr bool PERM = true, AFTER_DRAIN = false;
    const bf16* z; bf16* mix;
    __device__ __forceinline__ void operator()(const pg8::f32x4 (&acc)[2][2][4][2], const pg8::Unit& u, int wr, int wc, int fr, int fq) const {
        const int row0 = u.pm * 256 + wr * 64 + fr, col0 = u.pn * 256 + wc * 32 + 8 * fq;
#pragma unroll
        for (int ai = 0; ai < 2; ++ai) {
            v4u zz[4][2];
#pragma unroll
            for (int m = 0; m < 4; ++m)
#pragma unroll
                for (int bj = 0; bj < 2; ++bj) zz[m][bj] = *(const GAS v4u*)(z + (size_t)(row0 + ai * 128 + m * 16) * 512 + col0 + bj * 128);
#pragma unroll
            for (int m = 0; m < 4; ++m)
#pragma unroll
                for (int bj = 0; bj < 2; ++bj) { float zf[8], o[8]; unpack8(zz[m][bj], zf);
#pragma unroll
                    for (int j = 0; j < 4; ++j) { o[j] = zf[j] * sigmoidf_(acc[ai][bj][m][0][j]); o[4 + j] = zf[4 + j] * sigmoidf_(acc[ai][bj][m][1][j]); }
                    *(GAS v4u*)(mix + (size_t)(row0 + ai * 128 + m * 16) * D + 512 + col0 + bj * 128) = pack8(o); }
        }
    }
};
struct FQ {
    bf16* qb; const float* rope;
    __device__ __forceinline__ void operator()(int row, int col, f32x4 v0, f32x4 v1) const {
        float x[8] = {v0[0], v0[1], v0[2], v0[3], v1[0], v1[1], v1[2], v1[3]}, p[8];
#pragma unroll
        for (int j = 0; j < 8; ++j) p[j] = __shfl_xor(x[j], 16);
        const bool isctx = row >= TL; const int b = isctx ? ((row - TL) >> 8) : (row >> 13), t = isctx ? ((row - TL) & 255) : (row & 8191), tq = isctx ? SEQ + t : t;
        const int h = col / 96, d = col - h * 96;
        if (d >= 64 && !isctx) { const int idx = d - 64, a = idx >> 4, half = (idx >> 3) & 1, pos = a ? (t & 63) : (t >> 6);
#pragma unroll
            for (int f = 0; f < 8; ++f) { const float cs = rope[2 * (pos * 8 + f)], sn = rope[2 * (pos * 8 + f) + 1]; x[f] = half ? x[f] * cs + p[f] * sn : x[f] * cs - p[f] * sn; } }
#pragma unroll
        for (int j = 0; j < 8; ++j) x[j] *= QSCALE;
        *(GAS v4u*)(qb + ((size_t)(b * 8 + h) * TQK + tq) * 96 + d) = pack8(x);
        asm volatile("" ::: "memory");
    }
};
struct FKV {
    bf16* kb; bf16* vb;
    __device__ __forceinline__ void operator()(int row, int col, f32x4 v0, f32x4 v1) const {
        v4u w; w.x = pg8::cvt_pk_bf16(v0[0], v0[1]); w.y = pg8::cvt_pk_bf16(v0[2], v0[3]); w.z = pg8::cvt_pk_bf16(v1[0], v1[1]); w.w = pg8::cvt_pk_bf16(v1[2], v1[3]);
        const bool isctx = row >= TL; const int b = isctx ? ((row - TL) >> 8) : (row >> 13), t = isctx ? ((row - TL) & 255) : (row & 8191), tk = isctx ? t : CTXL + t;
        const int h = col >> 7, e = col & 127;
        if (e < 64) *(GAS v4u*)(kb + ((size_t)(b * 8 + h) * TQK + tk) * 96 + e) = w;
        else { const int kk = tk & 63, pos = (kk & 48) | (kk & 3) | ((kk & 4) << 1) | ((kk & 8) >> 1);
            bf16* p = vb + (((size_t)(b * 8 + h) * (TQK / 64) + (tk >> 6)) * 64 + (e - 64)) * 64 + pos;
            p[0] = (bf16)(w.x & 0xffffu); p[64] = (bf16)(w.x >> 16); p[128] = (bf16)(w.y & 0xffffu); p[192] = (bf16)(w.y >> 16);
            p[256] = (bf16)(w.z & 0xffffu); p[320] = (bf16)(w.z >> 16); p[384] = (bf16)(w.w & 0xffffu); p[448] = (bf16)(w.w >> 16); }
    }
};
struct EpiResid {
    static constexpr bool PERM = false, AFTER_DRAIN = false;
    float* xl; float* xc; const float* gate; int first; int row_off;
    __device__ __forceinline__ void operator()(const pg8::f32x4 (&acc)[2][2][4][2], const pg8::Unit& u, int wr, int wc, int fr, int fq) const {
        const int trow = u.pm * 256 + row_off, col0 = u.pn * 256 + wc * 32 + 4 * fq;
        const bool lat = trow < TL;
        GAS float* xb = (GAS float*)(lat ? xl + (size_t)trow * D : xc + (size_t)(trow - TL) * D) + (size_t)(wr * 64 + fr) * D + col0;
        const GAS float* gp = (const GAS float*)gate + (size_t)modrow_of(trow) * 6144 + col0;
        f32x4 gv[2][2];
#pragma unroll
        for (int bj = 0; bj < 2; ++bj)
#pragma unroll
            for (int n = 0; n < 2; ++n) gv[bj][n] = *(const GAS f32x4*)(gp + bj * 128 + n * 16);
        const float a0 = (first && lat) ? DN_ALPHA : 1.0f;
#pragma unroll
        for (int ai = 0; ai < 2; ++ai) {
            f32x4 xo[4][2][2];
#pragma unroll
            for (int m = 0; m < 4; ++m)
#pragma unroll
                for (int bj = 0; bj < 2; ++bj)
#pragma unroll
                    for (int n = 0; n < 2; ++n) xo[m][bj][n] = *(const GAS f32x4*)(xb + (size_t)(ai * 128 + m * 16) * D + bj * 128 + n * 16);
#pragma unroll
            for (int m = 0; m < 4; ++m)
#pragma unroll
                for (int bj = 0; bj < 2; ++bj)
#pragma unroll
                    for (int n = 0; n < 2; ++n) *(GAS f32x4*)(xb + (size_t)(ai * 128 + m * 16) * D + bj * 128 + n * 16) = xo[m][bj][n] * a0 + gv[bj][n] * acc[ai][bj][m][n];
            __builtin_amdgcn_sched_barrier(0);
        }
    }
};
struct FHgIn {
    bf16* qffi; bf16* g;
    __device__ __forceinline__ void operator()(int row, int col, f32x4 v0, f32x4 v1) const {
        v4u w; w.x = pg8::cvt_pk_bf16(v0[0], v0[1]); w.y = pg8::cvt_pk_bf16(v0[2], v0[3]); w.z = pg8::cvt_pk_bf16(v1[0], v1[1]); w.w = pg8::cvt_pk_bf16(v1[2], v1[3]);
        if (col < 4096) *(GAS v4u*)(qffi + (size_t)row * 4096 + col) = w; else *(GAS v4u*)(g + (size_t)row * D + (col - 4096)) = w;
    }
};
struct EpiConvGate {
    static constexpr bool PERM = true, AFTER_DRAIN = false;
    bf16* hg; bf16* ab; bf16* gb; const bf16* cwt;
    __device__ __forceinline__ void operator()(const pg8::f32x4 (&acc)[2][2][4][2], const pg8::Unit& u, int wr, int wc, int fr, int fq) const {
        const int hc0 = 128 * u.pn + 32 * wc + 8 * fq;
        v4u wq[4];
#pragma unroll
        for (int i = 0; i < 4; ++i) wq[i] = *(const GAS v4u*)(cwt + (size_t)(hc0 + 2 * i) * 4);
#pragma unroll
        for (int ai = 0; ai < 2; ++ai) {
            const int rowbase = u.pm * 256 + 128 * ai + 64 * wr, g64 = rowbase >> 6;
#pragma unroll
            for (int n = 0; n < 2; ++n) {
                const int hc = hc0 + 4 * n;
                float out[4][4];
#pragma unroll
                for (int e = 0; e < 4; ++e) { const int c = 4 * n + e; const unsigned pw0 = (c & 1) ? wq[c >> 1].z : wq[c >> 1].x, pw1 = (c & 1) ? wq[c >> 1].w : wq[c >> 1].y;
                    const float w0 = bflo(pw0), w1 = bfhi(pw0), w2 = bflo(pw1), b0 = bfhi(pw1);
                    float a[4], up[4], dn[4];
#pragma unroll
                    for (int m = 0; m < 4; ++m) { a[m] = acc[ai][0][m][n][e];
                        up[m] = __builtin_bit_cast(float, __builtin_amdgcn_mov_dpp(__builtin_bit_cast(int, a[m]), 0x121, 0xf, 0xf, false));
                        dn[m] = __builtin_bit_cast(float, __builtin_amdgcn_mov_dpp(__builtin_bit_cast(int, a[m]), 0x12f, 0xf, 0xf, false)); }
#pragma unroll
                    for (int m = 0; m < 4; ++m) { const float prev = fr > 0 ? up[m] : (m > 0 ? up[m > 0 ? m - 1 : 0] : 0.f), next = fr < 15 ? dn[m] : (m < 3 ? dn[m < 3 ? m + 1 : 3] : 0.f);
                        const float cv = b0 + w0 * prev + w1 * a[m] + w2 * next; out[m][e] = siluf_(cv) * acc[ai][1][m][n][e]; } }
#pragma unroll
                for (int m = 0; m < 4; ++m) { const int r64 = 16 * m + fr, row = rowbase + r64;
                    if (r64 != 0 && r64 != 63) { v2u w; w.x = pk2(out[m][0], out[m][1]); w.y = pk2(out[m][2], out[m][3]); *(GAS v2u*)(hg + (size_t)row * FFH + hc) = w; }
                    if (r64 <= 1 || r64 >= 62) { const int slot = r64 <= 1 ? r64 : r64 - 60; const f32x4 ra = acc[ai][0][m][n];
                        v2u w; w.x = pk2(ra[0], ra[1]); w.y = pk2(ra[2], ra[3]); *(GAS v2u*)(ab + (size_t)(g64 * 4 + slot) * FFH + hc) = w;
                        if (r64 == 0 || r64 == 63) { const f32x4 rg = acc[ai][1][m][n]; v2u wg; wg.x = pk2(rg[0], rg[1]); wg.y = pk2(rg[2], rg[3]); *(GAS v2u*)(gb + (size_t)(g64 * 2 + (r64 == 63 ? 1 : 0)) * FFH + hc) = wg; } }
                }
                __builtin_amdgcn_sched_barrier(0);
            }
        }
    }
};
template <class E> __device__ __forceinline__ void run_gemm_off(Frame& F, const bf16* A, int lda, const bf16* Bt, int ldb, int M, int N, int K, const E& e, int boff) {
    pg8::Gemm g{A, Bt, M, N, K, lda, ldb}; pg8::StaticOrder S; S.init(M, N, F.G, (int)((blockIdx.x + F.G - boff) % F.G));
    pg8::gemm_phase<E, pg8::StaticOrder, true, true>(F.lds + RING_OFF, g, S, e);
}
template <class E> __device__ __forceinline__ void run_gemm(Frame& F, const bf16* A, int lda, const bf16* Bt, int ldb, int M, int N, int K, const E& e) {
    pg8::Gemm g{A, Bt, M, N, K, lda, ldb}; pg8::StaticOrder S; S.init(M, N, F.G, (int)blockIdx.x);
    pg8::gemm_phase<E, pg8::StaticOrder, true, true>(F.lds + RING_OFF, g, S, e);
}

constexpr int NPH = 26;
struct Args { const float* in[31]; float* out; unsigned char* ws; int ph_lo, ph_hi; };
__global__ void __launch_bounds__(NWAVES * 64, 2) mk_fwd(Args args) {
    extern __shared__ __attribute__((aligned(16))) unsigned char lds[];
    Frame F;
    F.lds = (LAS unsigned char*)lds;
    F.tid = threadIdx.x; F.lane = F.tid & 63; F.wave = __builtin_amdgcn_readfirstlane(F.tid >> 6);
    F.G = gridDim.x; { const int bx = blockIdx.x; F.vcu = (F.G % 8 == 0) ? (bx % 8) * (F.G / 8) + bx / 8 : bx; }
    for (int u = F.tid; u < (LDS_BYTES - LDSCTL_OFF) / 4; u += NWAVES * 64) ((LAS unsigned*)(F.lds + LDSCTL_OFF))[u] = 0u;
    __syncthreads();
    if (F.tid == 0) {
#pragma unroll
        for (int i = 0; i < 31; ++i) ((LAS unsigned long long*)(F.lds + PTR_OFF))[i] = (unsigned long long)args.in[i];
        ((LAS unsigned long long*)(F.lds + PTR_OFF))[31] = (unsigned long long)args.ws; ((LAS unsigned long long*)(F.lds + PTR_OFF))[32] = (unsigned long long)args.out;
    }
    __syncthreads();
    const int lo = args.ph_lo, hi = args.ph_hi;
    const bool multi = (hi - lo) > 1;
    if (multi) (void)xcd_barrier_post((unsigned*)ws_(F) + CW_BAR, (volatile LAS unsigned*)(F.lds + MISC_OFF) + 8);
#ifndef ONLY_PHASE
#define ONLY_PHASE -1
#endif
#define WSP ws_(F)
#define MODP ((const float*)(ws_(F) + WS_MOD))
#define ABUF ((bf16*)(ws_(F) + WS_A))
#ifndef SKIP_PHASE
#define SKIP_PHASE -1
#endif
#define IN(k) ((ONLY_PHASE < 0 || ONLY_PHASE == (k)) && SKIP_PHASE != (k) && lo <= (k) && (k) < hi)
#define SEAM(k) do { if (IN(k) && IN((k) + 1)) { XcdBarrier bar_; bar_.bar = (unsigned*)ws_(F) + CW_BAR; bar_.x = xb_xcc_id(); bar_.st = (volatile LAS unsigned*)(F.lds + MISC_OFF) + 8; xcd_barrier(bar_); } asm volatile("" : "+v"(F.tid), "+v"(F.lane)); } while (0)
    int pk = 0;
#ifndef REPEAT_PHASE
#define REPEAT_PHASE -1
#endif
#define PHASE(...) do { if (IN(pk)) { __VA_ARGS__ } if (REPEAT_PHASE == pk && IN(pk)) { { XcdBarrier bar_; bar_.bar = (unsigned*)ws_(F) + CW_BAR; bar_.x = xb_xcc_id(); bar_.st = (volatile LAS unsigned*)(F.lds + MISC_OFF) + 8; xcd_barrier(bar_); } asm volatile("" : "+v"(F.tid), "+v"(F.lane)); { __VA_ARGS__ } } SEAM(pk); ++pk; } while (0)
    PHASE( p0_prologue(F); for (int rep_ = 0; rep_ < DUP_S5T; ++rep_) p0_s5_tables(F); );
    PHASE( ph_init_rows(F); );
    PHASE( pg8::Epi8<FInProj> e{{(bf16*)(WSP + WS_CQKV), (bf16*)(WSP + WS_UG)}}; run_gemm(F, ABUF, D, (const bf16*)(WSP + WS_WIN0), D, TT, EVEN_IN_PAD, D, e); );
    PHASE( ph_s5_finals(F); );
    PHASE( ph_s5_carry(F); );
    PHASE( ph_mla_norm(F); );
    PHASE(
#ifndef DUPQ
#define DUPQ 1
#endif
#ifndef DUPKV
#define DUPKV 1
#endif
        _Pragma("unroll") for (int rep = 0; rep < DUPQ; ++rep) { pg8::Epi8<FQ> e{{(bf16*)(WSP + WS_QB), (const float*)(WSP + WS_ROPE)}}; run_gemm(F, (const bf16*)(WSP + WS_CQKV), CQKV_LD, (const bf16*)(WSP + WS_WUQ), 384, TT, 768, 384, e); }
        _Pragma("unroll") for (int rep = 0; rep < DUPKV; ++rep) { pg8::Epi8<FKV> e{{(bf16*)(WSP + WS_KB), (bf16*)(WSP + WS_VB)}}; run_gemm(F, (const bf16*)(WSP + WS_CQKV) + 384, CQKV_LD, (const bf16*)(WSP + WS_WUKV), 256, TT, 1024, 256, e); }
    );
    PHASE( ph_s5_out(F); );
    PHASE( ph_attn(F); );
    PHASE( EpiGlu e{(const bf16*)(WSP + WS_Z), (bf16*)(WSP + WS_MIX)}; run_gemm(F, (const bf16*)(WSP + WS_Z), 512, (const bf16*)(WSP + WS_WGLU), 512, TT, 512, 512, e); );
    PHASE( EpiResid e{out_(F), (float*)(WSP + WS_XC), MODP + 0 * 3 * 6144 + 2 * 1024, 1, 0}; run_gemm(F, (const bf16*)(WSP + WS_MIX), D, (const bf16*)(WSP + WS_WOUT0), D, TT, D, D, e); );
    PHASE( ph_layernorm(F, TT, 0, 0, 0, 3, nullptr, 0); );
    PHASE( EpiConvGate e{(bf16*)(WSP + WS_HG), (bf16*)(WSP + WS_AB), (bf16*)(WSP + WS_GB), (const bf16*)(WSP + WS_CWT)}; run_gemm(F, ABUF, D, (const bf16*)(WSP + WS_F1T0), D, TT, 2 * FFH, D, e); );
    PHASE( ph_convfix(F, TT, 0); );
    PHASE( EpiResid e{out_(F), (float*)(WSP + WS_XC), MODP + 0 * 3 * 6144 + 5 * 1024, 1, 0}; run_gemm(F, (const bf16*)(WSP + WS_HG), FFH, (const bf16*)(WSP + WS_F2T0), FFH, TT, D, FFH, e); );
    PHASE( ph_layernorm(F, TT, 0, 1, 1, 0, nullptr, 0); );
    PHASE( pg8::Epi8<FHgIn> e{{(bf16*)(WSP + WS_QFFI), (bf16*)(WSP + WS_G)}}; run_gemm(F, ABUF, D, (const bf16*)(WSP + WS_HGINT), D, TT, 5120, D, e); );
    PHASE( ph_hgrn_states(F); );
    PHASE( ph_hgrn_out(F); );
    PHASE( ph_hg_gate(F); );
    PHASE( EpiResid e{out_(F), (float*)(WSP + WS_XC), MODP + 1 * 3 * 6144 + 2 * 1024, 1, 0}; run_gemm(F, (const bf16*)(WSP + WS_O), D, (const bf16*)(WSP + WS_HGOUTT), D, TL, D, D, e); );
    PHASE( ph_layernorm(F, TL, 1, 0, 1, 3); );
    PHASE( EpiConvGate e{(bf16*)(WSP + WS_HG), (bf16*)(WSP + WS_AB), (bf16*)(WSP + WS_GB), (const bf16*)(WSP + WS_CWT) + (size_t)FFH * 4}; run_gemm(F, ABUF, D, (const bf16*)(WSP + WS_F1T1), D, TL, 2 * FFH, D, e); );
    PHASE( ph_convfix(F, TL, 1); );
    PHASE( EpiResid e{out_(F), (float*)(WSP + WS_XC), MODP + 1 * 3 * 6144 + 5 * 1024, 1, 0}; run_gemm(F, (const bf16*)(WSP + WS_HG), FFH, (const bf16*)(WSP + WS_F2T1), FFH, TL, D, FFH, e); );
    PHASE( ph_layernorm(F, TL, 1, 1, -1, 0); );
#undef PHASE
#undef IN
#undef SEAM
}

extern "C" void kernel_launch(void* const* d_in, const int* in_sizes, int n_in, void* d_out, int out_size, void* d_ws, size_t ws_size, hipStream_t stream) {
    static int grid = 0;
    if (grid == 0) {
        if (n_in != 31 || out_size != TL * D || ws_size < WS_END) { fprintf(stderr, "kernel_launch: unexpected shapes n_in %d out %d ws %zu\n", n_in, out_size, ws_size); grid = -1; return; }
        int dev = 0, cus = 0;
        if (hipGetDevice(&dev) != hipSuccess || hipDeviceGetAttribute(&cus, hipDeviceAttributeMultiprocessorCount, dev) != hipSuccess) { grid = -1; return; }
        if (hipFuncSetAttribute((const void*)mk_fwd, hipFuncAttributeMaxDynamicSharedMemorySize, LDS_BYTES) != hipSuccess) { fprintf(stderr, "kernel_launch: hipFuncSetAttribute failed\n"); grid = -1; return; }
        int per_cu = 0;
        if (hipOccupancyMaxActiveBlocksPerMultiprocessor(&per_cu, (const void*)mk_fwd, NWAVES * 64, LDS_BYTES) != hipSuccess || per_cu < 1) fprintf(stderr, "kernel_launch: occupancy query says %d\n", per_cu);
        (void)hipGetLastError();
        grid = cus;
    }
    if (grid < 0) return;
    if (hipMemsetAsync((char*)d_ws + WS_CTL, 0, CTL_ZERO_BYTES, stream) != hipSuccess) return;
    Args a{};
    for (int i = 0; i < 31; ++i) a.in[i] = (const float*)d_in[i];
    a.out = (float*)d_out; a.ws = (unsigned char*)d_ws;
#ifndef MK_ONE_LAUNCH
#define MK_ONE_LAUNCH 1
#endif
    if (MK_ONE_LAUNCH) { a.ph_lo = 0; a.ph_hi = NPH; hipLaunchKernelGGL(mk_fwd, dim3(grid), dim3(NWAVES * 64), LDS_BYTES, stream, a); }
    else for (int p = 0; p < NPH; ++p) { a.ph_lo = p; a.ph_hi = p + 1; hipLaunchKernelGGL(mk_fwd, dim3(grid), dim3(NWAVES * 64), LDS_BYTES, stream, a); }
}
```

```cpp
#include <hip/hip_runtime.h>
#include <cstdio>
#include <cstdint>
#include <cmath>
namespace pg8 {
#define PG8_LAS __attribute__((address_space(3)))
typedef unsigned short bf16_t;
typedef short bf16x8 __attribute__((ext_vector_type(8)));
typedef float f32x4 __attribute__((ext_vector_type(4)));
typedef unsigned u32x4 __attribute__((ext_vector_type(4)));
constexpr int BM = 256, BK = 64, HALF = 128, HTB = HALF * BK * 2  , STAGE_BYTES = 8 * HTB, NXCD = 8, WGM = 8;

__host__ __device__ __forceinline__ int lds_byte(int r, int c) { const int st = (r >> 4) * 2 + (c >> 5), rr = r & 15, cc = c & 31, ob = rr * 64 + cc * 2; return st * 1024 + (ob ^ (((ob >> 9) & 1) << 5)); }
__host__ __device__ __forceinline__ void stage_rc(int b, int& R, int& C) { const int st = b / 1024, sb = b % 1024, swz = sb ^ (((sb >> 9) & 1) << 5); R = (st >> 1) * 16 + swz / 64; C = (st & 1) * 32 + (swz % 64) / 2; }
__host__ __device__ __forceinline__ int perm32(int rho) { const int n = rho >> 4, i = rho & 15; return 8 * (i >> 2) + 4 * n + (i & 3); }

struct Unit { int pm, pn; };
struct Gemm { const bf16_t* A; const bf16_t* Bt; int M, N, K, lda, ldb; };

struct StaticOrder {
    int nM, nN, nwg, G, c;
    __host__ __device__ void init(int M, int N, int G_, int c_) { nM = M / BM; nN = N / BM; nwg = nM * nN; G = G_; c = c_; }
    __host__ __device__ bool next(int i, Unit& u) const {
        const long L = (long)i * G + c; if (L >= nwg) return false;
        int wgid = (int)L; { const int q = nwg / NXCD, r = nwg % NXCD, xcd = wgid % NXCD, off = wgid / NXCD; wgid = (xcd < r ? xcd * (q + 1) : r * (q + 1) + (xcd - r) * q) + off; }
        const int nig = WGM * nN, gid = wgid / nig, fm = gid * WGM, gsz = (nM - fm) < WGM ? (nM - fm) : WGM;
        u.pm = fm + ((wgid % nig) % gsz); u.pn = (wgid % nig) / gsz; return true;
    }
    __device__ __forceinline__ void a_ready(const Unit&) const {}
    __device__ __forceinline__ void done(const Unit&) const {}
};

__device__ __forceinline__ unsigned cvt_pk_bf16(float lo, float hi) { unsigned r; asm volatile("v_cvt_pk_bf16_f32 %0, %1, %2" : "=v"(r) : "v"(lo), "v"(hi)); return r; }
template <class F> struct Epi8 {
    static constexpr bool PERM = true, AFTER_DRAIN = false; F f;
    __device__ __forceinline__ void operator()(const f32x4 (&acc)[2][2][4][2], const Unit& u, int wr, int wc, int fr, int fq) const {
        const int row0 = u.pm * BM + wr * 64 + fr, col0 = u.pn * BM + wc * 32 + 8 * fq;
#pragma unroll
        for (int ai = 0; ai < 2; ++ai)
#pragma unroll
            for (int m = 0; m < 4; ++m)
#pragma unroll
                for (int bj = 0; bj < 2; ++bj) { f(row0 + ai * HALF + m * 16, col0 + bj * HALF, acc[ai][bj][m][0], acc[ai][bj][m][1]); }
    }
};
template <class F> struct Epi4 {
    static constexpr bool PERM = false, AFTER_DRAIN = false; F f;
    __device__ __forceinline__ void operator()(const f32x4 (&acc)[2][2][4][2], const Unit& u, int wr, int wc, int fr, int fq) const {
        const int row0 = u.pm * BM + wr * 64 + fr, col0 = u.pn * BM + wc * 32 + 4 * fq;
#pragma unroll
        for (int ai = 0; ai < 2; ++ai)
#pragma unroll
            for (int m = 0; m < 4; ++m)
#pragma unroll
                for (int bj = 0; bj < 2; ++bj)
#pragma unroll
                    for (int n = 0; n < 2; ++n) { f(row0 + ai * HALF + m * 16, col0 + bj * HALF + n * 16, acc[ai][bj][m][n]); }
    }
};
template <class Epi, class Sched, bool ALIGN_EPI = false, bool SP2 = false>
__device__ __forceinline__ void gemm_phase(PG8_LAS unsigned char* lds, const Gemm g, const Sched& S, const Epi& E) {
    int tid_ = threadIdx.x; asm volatile("" : "+v"(tid_));
    const int tid = tid_, wid = __builtin_amdgcn_readfirstlane(tid >> 6), lane = tid & 63, wr = wid >> 2, wc = wid & 3, fr = lane & 15, fq = lane >> 4;
    const int K = g.K, nt = K / BK;
    unsigned voffA[2], voffB[2];
#pragma unroll
    for (int i = 0; i < 2; ++i) { int R, C; stage_rc(tid * 16 + i * 8192, R, C); const int Rb = Epi::PERM ? ((R & ~31) + perm32(R & 31)) : R;
        voffA[i] = (unsigned)(R * g.lda + C) * 2u; voffB[i] = (unsigned)(Rb * g.ldb + C) * 2u; }
    const size_t kstep = (size_t)(BK * 2);
    const size_t hstepA = (size_t)HALF * g.lda * 2, hstepB = (size_t)HALF * g.ldb * 2;
    const size_t tstepA = 2 * hstepA, tstepB = 2 * hstepB;
    const unsigned ldsw = (unsigned)wid * 1024u;
    const int aoff = lds_byte(wr * 64 + fr, fq * 8), boff = lds_byte(wc * 32 + fr, fq * 8);
#define PG8_SA(b, h) (((b) * 2 + (h)) * HTB)
#define PG8_SB(b, h) ((4 + (b) * 2 + (h)) * HTB)
#define PG8_STAGE(bufoff, gbase, voff) do { _Pragma("unroll") for (int _i = 0; _i < 2; ++_i) \
        __builtin_amdgcn_global_load_lds((const unsigned*)((const char*)(gbase) + (voff)[_i]), (PG8_LAS unsigned*)(lds + (bufoff) + ldsw + _i * 8192), 16, 0, 0); } while (0)
#define PG8_LDA(dst, b, h) do { _Pragma("unroll") for (int m = 0; m < 4; ++m) _Pragma("unroll") for (int k = 0; k < 2; ++k) dst[m][k] = *(const PG8_LAS bf16x8*)(lds + PG8_SA(b, h) + aoff + m * 2048 + k * 1024); } while (0)
#define PG8_LDB(dst, b, h) do { _Pragma("unroll") for (int n = 0; n < 2; ++n) _Pragma("unroll") for (int k = 0; k < 2; ++k) dst[n][k] = *(const PG8_LAS bf16x8*)(lds + PG8_SB(b, h) + boff + n * 2048 + k * 1024); } while (0)
#define PG8_MMA(ai, bj, At, Bt) do { __builtin_amdgcn_s_setprio(1); _Pragma("unroll") for (int m = 0; m < 4; ++m) _Pragma("unroll") for (int n = 0; n < 2; ++n) _Pragma("unroll") for (int k = 0; k < 2; ++k) \
        acc[ai][bj][m][n] = __builtin_amdgcn_mfma_f32_16x16x32_bf16(Bt[n][k], At[m][k], acc[ai][bj][m][n], 0, 0, 0); __builtin_amdgcn_s_setprio(0); } while (0)
#define PG8_WAIT_V(n) asm volatile("s_waitcnt vmcnt(" #n ")" ::: "memory")
#define PG8_WAIT_L(n) asm volatile("s_waitcnt lgkmcnt(" #n ")" ::: "memory")
#define PG8_BAR __builtin_amdgcn_s_barrier()
#define PG8_SCHED __builtin_amdgcn_sched_barrier(0)
    Unit cur, nxt; int ui = 0;
    if (!S.next(0, cur)) return;
    f32x4 acc[2][2][4][2];
#pragma unroll
    for (int a = 0; a < 2; ++a)
#pragma unroll
        for (int b = 0; b < 2; ++b)
#pragma unroll
            for (int m = 0; m < 4; ++m)
#pragma unroll
                for (int n = 0; n < 2; ++n) acc[a][b][m][n] = (f32x4){0.f, 0.f, 0.f, 0.f};
    bf16x8 At[4][2], B0[2][2], B1[2][2];
    const char* cA = (const char*)g.A + (size_t)cur.pm * tstepA; const char* cB = (const char*)g.Bt + (size_t)cur.pn * tstepB;
    S.a_ready(cur);
    if constexpr (SP2) {
        PG8_STAGE(PG8_SB(0, 0), cB, voffB); PG8_STAGE(PG8_SB(0, 1), cB + hstepB, voffB); PG8_STAGE(PG8_SA(0, 0), cA, voffA); PG8_STAGE(PG8_SA(0, 1), cA + hstepA, voffA);
        if (wr == 1) PG8_BAR;
        PG8_WAIT_V(2); PG8_BAR;
        PG8_STAGE(PG8_SB(1, 0), cB + kstep, voffB); PG8_STAGE(PG8_SA(1, 0), cA + kstep, voffA); PG8_STAGE(PG8_SB(1, 1), cB + hstepB + kstep, voffB);
        PG8_WAIT_V(6); PG8_BAR;
    } else {
        PG8_STAGE(PG8_SB(0, 0), cB, voffB); PG8_STAGE(PG8_SA(0, 0), cA, voffA); PG8_STAGE(PG8_SB(0, 1), cB + hstepB, voffB); PG8_STAGE(PG8_SA(0, 1), cA + hstepA, voffA);
        if (wr == 1) PG8_BAR;
        PG8_WAIT_V(4); PG8_BAR;
        PG8_STAGE(PG8_SB(1, 0), cB + kstep, voffB); PG8_STAGE(PG8_SA(1, 0), cA + kstep, voffA); PG8_STAGE(PG8_SB(1, 1), cB + hstepB + kstep, voffB);
        PG8_WAIT_V(6); PG8_BAR;
    }
    for (;;) {
        const bool has_next = S.next(ui + 1, nxt);
        const char* nA = has_next ? (const char*)g.A + (size_t)nxt.pm * tstepA : cA; const char* nB = has_next ? (const char*)g.Bt + (size_t)nxt.pn * tstepB : cB;
#pragma unroll 1
        for (int t = 0; t < nt; t += 2) {
            const bool last = (t == nt - 2);
            const char* a1 = cA + (size_t)(t + 1) * kstep;
            const char* a2 = last ? nA : cA + (size_t)(t + 2) * kstep; const char* b2 = last ? nB : cB + (size_t)(t + 2) * kstep;
            const char* a3 = a2 + kstep; const char* b3 = b2 + kstep;
            if (last && has_next) S.a_ready(nxt);
            if constexpr (SP2) {
            PG8_LDB(B0, 0, 0); PG8_LDB(B1, 0, 1); PG8_SCHED; PG8_LDA(At, 0, 0); PG8_STAGE(PG8_SA(1, 1), a1 + hstepA, voffA);
            PG8_WAIT_V(8); PG8_WAIT_L(0); PG8_BAR; PG8_MMA(0, 0, At, B0); PG8_MMA(0, 1, At, B1); PG8_BAR; PG8_SCHED;
            PG8_LDA(At, 0, 1); PG8_STAGE(PG8_SB(0, 0), b2, voffB); PG8_STAGE(PG8_SB(0, 1), b2 + hstepB, voffB); PG8_STAGE(PG8_SA(0, 0), a2, voffA);
            PG8_WAIT_V(8); PG8_WAIT_L(0); PG8_BAR; PG8_MMA(1, 0, At, B0); PG8_MMA(1, 1, At, B1); PG8_BAR; PG8_SCHED;
            PG8_LDB(B0, 1, 0); PG8_LDB(B1, 1, 1); PG8_SCHED; PG8_LDA(At, 1, 0); PG8_STAGE(PG8_SA(0, 1), a2 + hstepA, voffA);
            PG8_WAIT_V(8); PG8_WAIT_L(0); PG8_BAR; PG8_MMA(0, 0, At, B0); PG8_MMA(0, 1, At, B1); PG8_BAR; PG8_SCHED;
            PG8_LDA(At, 1, 1); PG8_STAGE(PG8_SB(1, 0), b3, voffB); PG8_STAGE(PG8_SB(1, 1), b3 + hstepB, voffB); PG8_STAGE(PG8_SA(1, 0), a3, voffA);
            PG8_WAIT_V(8); PG8_WAIT_L(0); PG8_BAR; PG8_MMA(1, 0, At, B0); PG8_MMA(1, 1, At, B1); PG8_BAR; PG8_SCHED;
            } else {
            PG8_LDB(B0, 0, 0); PG8_SCHED; PG8_LDA(At, 0, 0); PG8_STAGE(PG8_SA(1, 1), a1 + hstepA, voffA);
            PG8_WAIT_L(8); PG8_BAR; PG8_WAIT_L(0); PG8_MMA(0, 0, At, B0); PG8_BAR; PG8_SCHED;
            PG8_LDB(B1, 0, 1); PG8_STAGE(PG8_SB(0, 0), b2, voffB);
            PG8_BAR; PG8_WAIT_L(0); PG8_MMA(0, 1, At, B1); PG8_BAR;
            PG8_LDA(At, 0, 1); PG8_STAGE(PG8_SA(0, 0), a2, voffA);
            PG8_BAR; PG8_WAIT_L(0); PG8_MMA(1, 0, At, B0); PG8_BAR; PG8_SCHED;
            PG8_STAGE(PG8_SB(0, 1), b2 + hstepB, voffB);
            PG8_WAIT_V(6); PG8_BAR; PG8_MMA(1, 1, At, B1); PG8_BAR;
            PG8_LDB(B0, 1, 0); PG8_SCHED; PG8_LDA(At, 1, 0); PG8_STAGE(PG8_SA(0, 1), a2 + hstepA, voffA);
            PG8_WAIT_L(8); PG8_BAR; PG8_WAIT_L(0); PG8_MMA(0, 0, At, B0); PG8_BAR; PG8_SCHED;
            PG8_LDB(B1, 1, 1); PG8_STAGE(PG8_SB(1, 0), b3, voffB);
            PG8_BAR; PG8_WAIT_L(0); PG8_MMA(0, 1, At, B1); PG8_BAR;
            PG8_LDA(At, 1, 1); PG8_STAGE(PG8_SA(1, 0), a3, voffA);
            PG8_BAR; PG8_WAIT_L(0); PG8_MMA(1, 0, At, B0); PG8_BAR; PG8_SCHED;
            PG8_STAGE(PG8_SB(1, 1), b3 + hstepB, voffB);
            PG8_WAIT_V(6); PG8_BAR; PG8_MMA(1, 1, At, B1); PG8_BAR;
            }
        }
        if constexpr (ALIGN_EPI) { if (wr == 0) PG8_BAR; }
        if constexpr (!Epi::AFTER_DRAIN) { E(acc, cur, wr, wc, fr, fq); S.done(cur); }
        if (!has_next) break;
#pragma unroll
        for (int a = 0; a < 2; ++a)
#pragma unroll
            for (int b = 0; b < 2; ++b)
#pragma unroll
                for (int m = 0; m < 4; ++m)
#pragma unroll
                    for (int n = 0; n < 2; ++n) acc[a][b][m][n] = (f32x4){0.f, 0.f, 0.f, 0.f};
        cur = nxt; cA = nA; cB = nB; ++ui;
        if constexpr (ALIGN_EPI) { if (wr == 1) PG8_BAR; }
    }
    PG8_WAIT_V(0);
    if constexpr (!ALIGN_EPI) { if (wr == 0) PG8_BAR; }
    PG8_BAR;
    if constexpr (Epi::AFTER_DRAIN) { E.fused(acc, cur, wr, wc, fr, fq, lds, wid, lane); S.done(cur); }
#undef PG8_SA
#undef PG8_SB
#undef PG8_STAGE
#undef PG8_LDA
#undef PG8_LDB
#undef PG8_MMA
#undef PG8_WAIT_V
#undef PG8_WAIT_L
#undef PG8_BAR
#undef PG8_SCHED
}
}

constexpr int NWAVES = 8;
constexpr int D = 1024, BATCH = 2, SEQ = 8192, CTXL = 256;
constexpr int TL = BATCH * SEQ;
constexpr int TC = BATCH * CTXL;
constexpr int TT = TL + TC;
constexpr int EVEN_IN = 1184, EVEN_IN_PAD = 1280, CQKV_LD = 672;
constexpr int FFH = 2816, FFG = 1408;
constexpr int TQK = SEQ + CTXL;
constexpr float NORM_EPS = 1e-6f;
constexpr float DN_ALPHA = 1.41421356237f;
constexpr float QSCALE = 0.10206207261596577f * 1.4426950408889634f;

constexpr size_t MiB = 1u << 20;
constexpr size_t WS_CTL = 0, CTL_ZERO_BYTES = 1 * MiB;
constexpr size_t WS_MOD = 1 * MiB;
constexpr size_t WS_LBV = WS_MOD + 160 * 1024;
constexpr size_t WS_ROPE = WS_LBV + 16 * 1024;
constexpr size_t WS_CWT = WS_ROPE + 16 * 1024;
constexpr size_t WS_HGINT = 2 * MiB, WS_HGOUTT = 12 * MiB, WS_F1T1 = 14 * MiB, WS_F2T1 = 25 * MiB;
constexpr size_t WS_A = 31 * MiB;
constexpr size_t WS_XC = 64 * MiB;
constexpr size_t WS_WIN0 = 66 * MiB, WS_WUQ = WS_WIN0 + 2560 * 1024, WS_WUKV = WS_WUQ + 768 * 1024, WS_WGLU = WS_WUKV + 512 * 1024,
                 WS_WOUT0 = WS_WGLU + 512 * 1024, WS_F1T0 = 72 * MiB + 512 * 1024, WS_F2T0 = WS_F1T0 + 11 * MiB;
constexpr size_t WS_R = 89 * MiB;
constexpr size_t WS_CQKV = WS_R;
constexpr size_t WS_UG = WS_R + 22 * MiB;
constexpr size_t WS_WF = WS_R + 39 * MiB;
constexpr size_t WS_WC = WS_R + 64 * MiB;
constexpr size_t WS_TOEP = WS_R + 80 * MiB;
constexpr size_t WS_T0 = WS_R + 82 * MiB;
constexpr size_t WS_A64 = WS_T0 + 128 * 1024;
constexpr size_t WS_FIN = WS_R + 83 * MiB;
constexpr size_t WS_SIN = WS_R + 92 * MiB;
constexpr size_t WS_Z = WS_R + 97 * MiB;
constexpr size_t WS_MIX = WS_R + 134 * MiB;
constexpr size_t WS_QB = WS_R + 39 * MiB;
constexpr size_t WS_KB = 31 * MiB;
constexpr size_t WS_VB = WS_R + 114 * MiB;
constexpr size_t WS_AB = WS_R;
constexpr size_t WS_GB = WS_R + 8 * MiB;
constexpr size_t WS_H = WS_R;
constexpr size_t WS_HG = WS_R + 16 * MiB;
constexpr size_t WS_QFFI = 66 * MiB;
constexpr size_t WS_G = 198 * MiB;
constexpr size_t WS_O = WS_A;
constexpr size_t WS_SLAB1 = WS_R;
constexpr size_t WS_SLAB2 = WS_R + 110 * MiB;
constexpr size_t WS_END = 256 * MiB;
static_assert(WS_F2T0 + 5632 * 1024 <= WS_R, "layer-0 weights");
static_assert(WS_MIX + (size_t)TT * 1024 * 2 <= WS_END && WS_G + (size_t)TT * 1024 * 2 <= WS_END && WS_HG + (size_t)TT * FFH * 2 <= WS_END, "ws map");
static_assert(WS_WF + 16 * MiB <= WS_WC && WS_QB + (size_t)16 * TQK * 96 * 2 <= WS_WC && WS_WC + 16 * MiB <= WS_TOEP && WS_TOEP + 2 * MiB <= WS_T0 && WS_T0 + MiB <= WS_FIN && WS_FIN + (size_t)32 * 264 * 256 * 4 <= WS_SIN && WS_SIN + (size_t)32 * 264 * 256 * 2 <= WS_Z && WS_Z + (size_t)TT * 512 * 2 <= WS_VB && WS_VB + (size_t)16 * TQK * 64 * 2 <= WS_MIX && WS_KB + (size_t)16 * TQK * 96 * 2 <= WS_XC, "ws map 2");

constexpr int CW_BAR = 4096;
constexpr int RING_OFF = 0, RING_BYTES = 131072;
constexpr int LDSCTL_OFF = RING_BYTES, MISC_OFF = LDSCTL_OFF + 320;
constexpr int LDS_BYTES = 147456;

#define GAS __attribute__((address_space(1)))
#define LAS __attribute__((address_space(3)))
typedef unsigned short bf16;
typedef unsigned v4u __attribute__((ext_vector_type(4)));
typedef unsigned v2u __attribute__((ext_vector_type(2)));
typedef float f32x4 __attribute__((ext_vector_type(4)));
typedef GAS unsigned gu32;
#define RLX_AGENT __ATOMIC_RELAXED, __HIP_MEMORY_SCOPE_AGENT
#define LDS_WAIT() asm volatile("s_waitcnt lgkmcnt(0)" ::: "memory")
__device__ __forceinline__ unsigned f2bf(float f) { unsigned u = __builtin_bit_cast(unsigned, f); return (u + 0x7fffu + ((u >> 16) & 1u)) >> 16; }
__device__ __forceinline__ unsigned pk2(float lo, float hi) { return f2bf(lo) | (f2bf(hi) << 16); }
__device__ __forceinline__ float bflo(unsigned w) { return __builtin_bit_cast(float, w << 16); }
__device__ __forceinline__ float bfhi(unsigned w) { return __builtin_bit_cast(float, w & 0xffff0000u); }
__device__ __forceinline__ float bf2f(bf16 h) { return __builtin_bit_cast(float, (unsigned)h << 16); }
__device__ __forceinline__ void unpack8(v4u w, float* x) { x[0] = bflo(w.x); x[1] = bfhi(w.x); x[2] = bflo(w.y); x[3] = bfhi(w.y); x[4] = bflo(w.z); x[5] = bfhi(w.z); x[6] = bflo(w.w); x[7] = bfhi(w.w); }
__device__ __forceinline__ v4u pack8(const float* x) { v4u w; w.x = pk2(x[0], x[1]); w.y = pk2(x[2], x[3]); w.z = pk2(x[4], x[5]); w.w = pk2(x[6], x[7]); return w; }
__device__ __forceinline__ float sigmoidf_(float x) { return 1.0f / (1.0f + __expf(-x)); }
__device__ __forceinline__ float siluf_(float x) { return x / (1.0f + __expf(-x)); }
__device__ __forceinline__ float gelu_tanh(float x) { const float u = 0.7978845608028654f * (x + 0.044715f * x * x * x); return 0.5f * x * (1.0f + tanhf(u)); }
__device__ __forceinline__ float wave_sum(float v) {
#pragma unroll
    for (int o = 1; o < 64; o <<= 1) v += __shfl_xor(v, o);
    return v;
}

#define XB_TMO      128
#define XB_XCNT(j)  (256  + 64 * (j))
#define XB_XSUB(j)  (1280 + 64 * (j))
#define XB_XGEN(j)  (2304 + 64 * (j))
#define XB_TOP      3328
#define XB_TOPGEN   3392
#define XCD_BAR_WORDS 3456
#define XB_SPIN_CAP (1u << 18)

__device__ __forceinline__ unsigned xb_ld(unsigned* p)              { return __hip_atomic_load(p, __ATOMIC_RELAXED, __HIP_MEMORY_SCOPE_AGENT); }
__device__ __forceinline__ unsigned xb_add(unsigned* p, unsigned v) { return __hip_atomic_fetch_add(p, v, __ATOMIC_RELAXED, __HIP_MEMORY_SCOPE_AGENT); }
__device__ __forceinline__ unsigned xb_xcc_id() { return (unsigned)__builtin_amdgcn_s_getreg((3 << 11) | 20) & 0xFu; }
#define XB_SPIN(cond, bar) do { unsigned _sp = 0; while (cond) { __builtin_amdgcn_s_sleep(1); \
    if ((++_sp & 255u) == 0u) { if (xb_ld(&(bar)[XB_TMO])) break; if (_sp > XB_SPIN_CAP) { atomicAdd(&(bar)[XB_TMO], 1u); break; } } } } while (0)

struct XcdBarrier {
    unsigned* bar; unsigned x;
    volatile LAS unsigned* st;
};

__device__ __forceinline__ XcdBarrier xcd_barrier_post(unsigned* bar, volatile LAS unsigned* st) {
    XcdBarrier b; b.bar = bar; b.x = xb_xcc_id(); b.st = st;
    if (threadIdx.x == 0) (void)xb_add(&bar[XB_XCNT(b.x)], 1u);
    return b;
}
__device__ __forceinline__ void xcd_barrier_complete(unsigned* bar, unsigned x, unsigned& nloc, unsigned& nx) {
    const unsigned G = gridDim.x * gridDim.y * gridDim.z;
    unsigned sum, cnt, mine, sp = 0u;
    for (;;) {
        sum = 0u; cnt = 0u; mine = 0u;
#pragma unroll
        for (unsigned j = 0; j < 16; ++j) { const unsigned c = xb_ld(&bar[XB_XCNT(j)]); sum += c; cnt += (c > 0u) ? 1u : 0u; mine = (j == x) ? c : mine; }
        if (sum == G) break;
        __builtin_amdgcn_s_sleep(1);
        if ((++sp & 255u) == 0u) { if (xb_ld(&bar[XB_TMO])) break; if (sp > XB_SPIN_CAP) { atomicAdd(&bar[XB_TMO], 1u); break; } }
    }
    nloc = mine > 0u ? mine : 1u; nx = cnt > 0u ? cnt : 1u;
}

__device__ __forceinline__ void xcd_barrier(const XcdBarrier& b) {
    asm volatile("s_waitcnt vmcnt(0)" ::: "memory");
    __syncthreads();
    if (threadIdx.x == 0) {
        unsigned* bar = b.bar;
        __builtin_amdgcn_s_waitcnt(0);
        unsigned nloc = b.st[0], nx = b.st[1];
        if (nloc == 0u) { xcd_barrier_complete(bar, b.x, nloc, nx); b.st[0] = nloc; b.st[1] = nx; }
        const unsigned old = xb_add(&bar[XB_XSUB(b.x)], 1u);
        const unsigned gen = old / nloc;
        if (old + 1u == (gen + 1u) * nloc) {
            __builtin_amdgcn_fence(__ATOMIC_RELEASE, "agent");
            asm volatile("s_waitcnt vmcnt(0)" ::: "memory");
            const unsigned og = xb_add(&bar[XB_TOP], 1u);
            const unsigned tg = og / nx;
            if (og + 1u == (tg + 1u) * nx) xb_add(&bar[XB_TOPGEN], 1u);
            else XB_SPIN(xb_ld(&bar[XB_TOPGEN]) == tg, bar);
            __builtin_amdgcn_fence(__ATOMIC_ACQUIRE, "agent");
            xb_add(&bar[XB_XGEN(b.x)], 1u);
            asm volatile("s_waitcnt vmcnt(0)" ::: "memory");
        } else {
            XB_SPIN(xb_ld(&bar[XB_XGEN(b.x)]) == gen, bar);
            __builtin_amdgcn_fence(__ATOMIC_ACQUIRE, "agent");
            asm volatile("s_waitcnt vmcnt(0)" ::: "memory");
        }
    }
    __syncthreads();
}


struct Frame {
    LAS unsigned char* lds;
    int tid, lane, wave, vcu, G;
};
constexpr int PTR_OFF = LDSCTL_OFF + 1024;
__device__ __forceinline__ const float* inp(const Frame& F, int i) {
    const LAS unsigned* p = (const LAS unsigned*)(F.lds + PTR_OFF) + 2 * i;
    const unsigned lo = __builtin_amdgcn_readfirstlane(p[0]), hi = __builtin_amdgcn_readfirstlane(p[1]);
    return (const float*)(const GAS float*)(((unsigned long long)hi << 32) | lo);
}
__device__ __forceinline__ unsigned char* ws_(const Frame& F) { return (unsigned char*)inp(F, 31); }
__device__ __forceinline__ float* out_(const Frame& F) { return (float*)inp(F, 32); }
__device__ __forceinline__ int modrow_of(int m) { return m < TL ? (m >> 13) : 2; }
__device__ __forceinline__ const float* xin_row(const Frame& F, int m) { return m < TL ? inp(F, 0) + (size_t)m * D : inp(F, 2) + (size_t)(m - TL) * D; }
__device__ __forceinline__ float* xres_row(const Frame& F, int m) { return m < TL ? out_(F) + (size_t)m * D : (float*)(ws_(F) + WS_XC) + (size_t)(m - TL) * D; }
__device__ __forceinline__ const float* modvec(const Frame& F, int layer, int mr, int part) { return (const float*)(ws_(F) + WS_MOD) + (size_t)(layer * 3 + mr) * 6144 + part * 1024; }

__device__ __forceinline__ void tr_item(const float* W, int ldw, int k0, int n0, bf16* dst, int dpitch, LAS float* scr, int lane) {
    { f32x4 v[8];
#pragma unroll
      for (int i = 0; i < 8; ++i) v[i] = *(const GAS f32x4*)(W + (size_t)(k0 + 8 * i + (lane >> 3)) * ldw + n0 + 4 * (lane & 7));
#pragma unroll
      for (int i = 0; i < 8; ++i) { LAS float* d = scr + (8 * i + (lane >> 3)) * 33 + 4 * (lane & 7); d[0] = v[i].x; d[1] = v[i].y; d[2] = v[i].z; d[3] = v[i].w; } }
    LDS_WAIT(); asm volatile("" ::: "memory");
    const int c = lane & 7;
#pragma unroll
    for (int j = 0; j < 4; ++j) { const int n = (lane >> 3) + 8 * j; const LAS float* s = scr + (8 * c) * 33 + n;
        v4u o; o.x = pk2(s[0 * 33], s[1 * 33]); o.y = pk2(s[2 * 33], s[3 * 33]); o.z = pk2(s[4 * 33], s[5 * 33]); o.w = pk2(s[6 * 33], s[7 * 33]);
        *(GAS v4u*)(dst + (size_t)n * dpitch + 8 * c) = o; }
    LDS_WAIT(); asm volatile("" ::: "memory");
}
__device__ __forceinline__ bool tr_plain(int& r, const float* W, int K, int N, bf16* WT, LAS float* scr, int lane) {
    const int nblk = N / 32, cnt = (K / 64) * nblk;
    if (r >= cnt) { r -= cnt; return false; }
    const int kb = r / nblk, nb = r % nblk;
    tr_item(W, N, 64 * kb, 32 * nb, WT + (size_t)(32 * nb) * K + 64 * kb, K, scr, lane); return true;
}
__device__ __forceinline__ bool tr_ffn1(int& r, const float* W, bf16* WT, LAS float* scr, int lane) {
    const int nblk = 5632 / 32, cnt = 16 * nblk;
    if (r >= cnt) { r -= cnt; return false; }
    const int kb = r / nblk, nb = r % nblk, n0 = 32 * nb, half = n0 / FFH, j = n0 % FFH, drow = (j >> 7) * 256 + half * 128 + (j & 127);
    tr_item(W, 5632, 64 * kb, n0, WT + (size_t)drow * 1024 + 64 * kb, 1024, scr, lane); return true;
}
#ifndef DUP_GEMV
#define DUP_GEMV 1
#endif
#ifndef DUP_TR
#define DUP_TR 1
#endif
#ifndef DUP_S5T
#define DUP_S5T 1
#endif
__device__ __forceinline__ void p0_prologue(Frame& F) {
    {
        LAS float* sv = (LAS float*)(F.lds + RING_OFF);
        LAS float* red = sv + 3072;
        for (int i = F.tid; i < 3072; i += 512) { const int r = i >> 10, k = i & 1023; const float cv = (r < 2) ? inp(F, 1)[r * 1024 + k] : inp(F, 3)[k]; sv[i] = cv / (1.0f + __expf(-cv)); }
        __syncthreads();
        for (int rep_ = 0; rep_ < DUP_GEMV; ++rep_)
        for (int it = blockIdx.x; it < 192; it += F.G) {
            const int layer = it / 96, cg = it % 96, col = cg * 64 + F.lane, k0 = F.wave * 128;
            const float* w = inp(F, 4) + ((size_t)layer * 1024 + k0) * 6144 + col;
            float a0 = 0.f, a1 = 0.f, a2 = 0.f;
#pragma unroll 16
            for (int k = 0; k < 128; ++k) { const float wv = w[(size_t)k * 6144]; a0 += sv[k0 + k] * wv; a1 += sv[1024 + k0 + k] * wv; a2 += sv[2048 + k0 + k] * wv; }
            red[(F.wave * 3 + 0) * 64 + F.lane] = a0; red[(F.wave * 3 + 1) * 64 + F.lane] = a1; red[(F.wave * 3 + 2) * 64 + F.lane] = a2;
            __syncthreads();
            if (F.tid < 192) { const int r = F.tid >> 6, l = F.tid & 63; float s = inp(F, 5)[layer * 6144 + cg * 64 + l];
#pragma unroll
                for (int wv = 0; wv < 8; ++wv) s += red[(wv * 3 + r) * 64 + l];
                ((float*)(ws_(F) + WS_MOD))[(size_t)(layer * 3 + r) * 6144 + cg * 64 + l] = s; }
            __syncthreads();
        }
        __syncthreads();
    }
    {
        const int gt = F.vcu * 512 + F.tid, NT = F.G * 512;
        for (int i = gt; i < 2048; i += NT) { const int dir = i >> 10, c = i & 1023; const float l0 = inp(F, 28)[(0 * 2 + dir) * 1024 + c], l1 = inp(F, 28)[(1 * 2 + dir) * 1024 + c];
            ((float*)(ws_(F) + WS_LBV))[i] = 1.0f / (1.0f + expf(l0 - l1)); }
        for (int i = gt; i < 1024; i += NT) { const int pos = i >> 3, f = i & 7; const float inv = powf(10000.0f, -(float)f / 8.0f); const float ang = (float)pos * inv;
            ((float*)(ws_(F) + WS_ROPE))[2 * i] = cosf(ang); ((float*)(ws_(F) + WS_ROPE))[2 * i + 1] = sinf(ang); }
        for (int i = gt; i < 2 * FFH; i += NT) { const int layer = i / FFH, j = i % FFH; const float* cwp = inp(F, 9) + (size_t)layer * 3 * FFH + j;
            v2u w; w.x = pk2(cwp[0], cwp[FFH]); w.y = pk2(cwp[2 * FFH], inp(F, 10)[(size_t)layer * FFH + j]); *(GAS v2u*)((bf16*)(ws_(F) + WS_CWT) + (size_t)i * 4) = w; }
        for (int i = gt; i < 96 * 1024 / 8; i += NT) ((GAS v4u*)(ws_(F) + WS_WIN0 + (size_t)1184 * 1024 * 2))[i] = (v4u){0u, 0u, 0u, 0u};
    }
    {
        LAS float* scr = (LAS float*)(F.lds + RING_OFF + F.wave * 16384);
        const int gw = F.vcu * NWAVES + F.wave, NGW = F.G * NWAVES;
        constexpr int NITEMS = 592 + 144 + 128 + 128 + 512 + 2 * 2816 + 2 * 1408 + 2560 + 512;
        for (int rep_ = 0; rep_ < DUP_TR; ++rep_)
        for (int it = gw; it < NITEMS; it += NGW) {
            int r = it;
            if (tr_plain(r, inp(F, 12), 1024, 1184, (bf16*)(ws_(F) + WS_WIN0), scr, F.lane)) continue;
            if (tr_plain(r, inp(F, 14), 384, 768, (bf16*)(ws_(F) + WS_WUQ), scr, F.lane)) continue;
            if (tr_plain(r, inp(F, 16), 256, 1024, (bf16*)(ws_(F) + WS_WUKV), scr, F.lane)) continue;
            if (tr_plain(r, inp(F, 25), 512, 512, (bf16*)(ws_(F) + WS_WGLU), scr, F.lane)) continue;
            if (tr_plain(r, inp(F, 26), 1024, 1024, (bf16*)(ws_(F) + WS_WOUT0), scr, F.lane)) continue;
            if (tr_ffn1(r, inp(F, 8), (bf16*)(ws_(F) + WS_F1T0), scr, F.lane)) continue;
            if (tr_ffn1(r, inp(F, 8) + (size_t)1024 * 5632, (bf16*)(ws_(F) + WS_F1T1), scr, F.lane)) continue;
            if (tr_plain(r, inp(F, 11), 2816, 1024, (bf16*)(ws_(F) + WS_F2T0), scr, F.lane)) continue;
            if (tr_plain(r, inp(F, 11) + (size_t)2816 * 1024, 2816, 1024, (bf16*)(ws_(F) + WS_F2T1), scr, F.lane)) continue;
            if (tr_plain(r, inp(F, 27), 1024, 5120, (bf16*)(ws_(F) + WS_HGINT), scr, F.lane)) continue;
            tr_plain(r, inp(F, 30), 1024, 1024, (bf16*)(ws_(F) + WS_HGOUTT), scr, F.lane);
        }
    }
}

__device__ __forceinline__ void store_mod_bf16(const Frame& F, const f32x4 (&v)[4], int m, int layer, int part_sh) {
    const int mr = modrow_of(m);
    const GAS f32x4* sh = (const GAS f32x4*)modvec(F, layer, mr, part_sh) + F.lane;
    const GAS f32x4* sc = (const GAS f32x4*)modvec(F, layer, mr, part_sh + 1) + F.lane;
    GAS v2u* o = (GAS v2u*)((bf16*)(ws_(F) + WS_A) + (size_t)m * D) + F.lane;
#pragma unroll
    for (int j = 0; j < 4; ++j) { const f32x4 s = sc[64 * j], h = sh[64 * j]; const f32x4 y = v[j] * (s + 1.0f) + h; v2u w; w.x = pk2(y.x, y.y); w.y = pk2(y.z, y.w); o[64 * j] = w; }
}
__device__ __forceinline__ void ph_init_rows(Frame& F) {
    const int gw = F.vcu * NWAVES + F.wave, NGW = F.G * NWAVES;
    for (int m = gw; m < TT; m += NGW) {
        const GAS f32x4* xr = (const GAS f32x4*)xin_row(F, m) + F.lane; GAS f32x4* xo = (GAS f32x4*)xres_row(F, m) + F.lane;
        f32x4 v[4];
#pragma unroll
        for (int j = 0; j < 4; ++j) { v[j] = xr[64 * j]; xo[64 * j] = (m >= TL) ? v[j] * DN_ALPHA : v[j]; }
        store_mod_bf16(F, v, m, 0, 0);
    }
}
__device__ __forceinline__ void ph_layernorm(Frame& F, int nrows, int layer, int which, int next_layer, int next_part_sh, const float* slabs = nullptr, int nslabs = 0) {
    const int gw = F.vcu * NWAVES + F.wave, NGW = F.G * NWAVES;
    const GAS f32x4* gg = (const GAS f32x4*)(inp(F, 6) + (size_t)(layer * 2 + which) * D) + F.lane;
    const GAS f32x4* bb = (const GAS f32x4*)(inp(F, 7) + (size_t)(layer * 2 + which) * D) + F.lane;
    for (int m0 = gw; m0 < nrows; m0 += 2 * NGW) {
        const int m1 = m0 + NGW; const bool has1 = m1 < nrows; const int m1c = has1 ? m1 : m0;
        GAS f32x4* xr0 = (GAS f32x4*)xres_row(F, m0) + F.lane; GAS f32x4* xr1 = (GAS f32x4*)xres_row(F, m1c) + F.lane;
        f32x4 v[4], w[4]; float s0 = 0.f, s1 = 0.f;
#pragma unroll
        for (int j = 0; j < 4; ++j) { v[j] = xr0[64 * j]; w[j] = xr1[64 * j]; }
        if (nslabs > 0 && m1c >= TL) {
            for (int sl = 0; sl < nslabs; ++sl) { const GAS f32x4* p1 = (const GAS f32x4*)(slabs + ((size_t)sl * TC + (m1c - TL)) * D) + F.lane;
#pragma unroll
                for (int j = 0; j < 4; ++j) w[j] += p1[64 * j];
                if (m0 >= TL) { const GAS f32x4* p0 = (const GAS f32x4*)(slabs + ((size_t)sl * TC + (m0 - TL)) * D) + F.lane;
#pragma unroll
                    for (int j = 0; j < 4; ++j) v[j] += p0[64 * j]; } }
        }
#pragma unroll
        for (int j = 0; j < 4; ++j) { s0 += (v[j].x + v[j].y) + (v[j].z + v[j].w); s1 += (w[j].x + w[j].y) + (w[j].z + w[j].w); }
        const float mean0 = wave_sum(s0) * (1.f / D), mean1 = wave_sum(s1) * (1.f / D); float q0 = 0.f, q1 = 0.f;
#pragma unroll
        for (int j = 0; j < 4; ++j) { v[j] = v[j] - mean0; w[j] = w[j] - mean1; q0 += (v[j].x * v[j].x + v[j].y * v[j].y) + (v[j].z * v[j].z + v[j].w * v[j].w); q1 += (w[j].x * w[j].x + w[j].y * w[j].y) + (w[j].z * w[j].z + w[j].w * w[j].w); }
        const float r0 = 1.f / sqrtf(wave_sum(q0) * (1.f / D) + NORM_EPS), r1 = 1.f / sqrtf(wave_sum(q1) * (1.f / D) + NORM_EPS);
#pragma unroll
        for (int j = 0; j < 4; ++j) { const f32x4 g4 = gg[64 * j], b4 = bb[64 * j]; v[j] = v[j] * r0 * g4 + b4; w[j] = w[j] * r1 * g4 + b4; xr0[64 * j] = (m0 >= TL) ? v[j] * DN_ALPHA : v[j]; if (has1) xr1[64 * j] = (m1 >= TL) ? w[j] * DN_ALPHA : w[j]; }
        if (next_layer >= 0) { store_mod_bf16(F, v, m0, next_layer, next_part_sh); if (has1) store_mod_bf16(F, w, m1, next_layer, next_part_sh); }
    }
}
__device__ __forceinline__ void ph_mla_norm(Frame& F) {
    const int gw = F.vcu * NWAVES + F.wave, NGW = F.G * NWAVES;
    bf16* CQ = (bf16*)(ws_(F) + WS_CQKV); bf16* Kb = (bf16*)(ws_(F) + WS_KB); const float* rope = (const float*)(ws_(F) + WS_ROPE);
    for (int m = gw; m < TT; m += NGW) {
        bf16* row = CQ + (size_t)m * CQKV_LD;
        {
            float x[8]; float ss = 0.f; const bool act = F.lane < 48;
            if (act) { unpack8(*(const GAS v4u*)(row + 8 * F.lane), x);
#pragma unroll
                for (int j = 0; j < 8; ++j) ss += x[j] * x[j]; }
            const float sc = 1.f / sqrtf(wave_sum(ss) * (1.f / 384.f) + NORM_EPS);
            if (act) {
#pragma unroll
                for (int j = 0; j < 8; ++j) x[j] = x[j] * sc * inp(F, 13)[8 * F.lane + j];
                *(GAS v4u*)(row + 8 * F.lane) = pack8(x); }
        }
        {
            float x[8]; float ss = 0.f; const bool act = F.lane < 32;
            if (act) { unpack8(*(const GAS v4u*)(row + 384 + 8 * F.lane), x);
#pragma unroll
                for (int j = 0; j < 8; ++j) ss += x[j] * x[j]; }
            const float sc = 1.f / sqrtf(wave_sum(ss) * (1.f / 256.f) + NORM_EPS);
            if (act) {
#pragma unroll
                for (int j = 0; j < 8; ++j) x[j] = x[j] * sc * inp(F, 15)[8 * F.lane + j];
                *(GAS v4u*)(row + 384 + 8 * F.lane) = pack8(x); }
        }
        {
            const bool isctx = m >= TL; const int b = isctx ? ((m - TL) >> 8) : (m >> 13), t = isctx ? ((m - TL) & 255) : (m & 8191), tk = isctx ? t : CTXL + t;
            const int h = F.lane >> 3, i0 = (F.lane & 7) * 4;
            const v2u w = *(const GAS v2u*)(row + 640 + i0);
            float x[4] = {bflo(w.x), bfhi(w.x), bflo(w.y), bfhi(w.y)}, o[4];
#pragma unroll
            for (int j = 0; j < 4; ++j) { const float p = __shfl_xor(x[j], 2); const int idx = i0 + j, a = idx >> 4, half = (idx >> 3) & 1, f = idx & 7, pos = a ? (t & 63) : (t >> 6);
                const float cs = rope[2 * (pos * 8 + f)], sn = rope[2 * (pos * 8 + f) + 1];
                o[j] = isctx ? x[j] : (half ? x[j] * cs + p * sn : x[j] * cs - p * sn); }
            v2u ow; ow.x = pk2(o[0], o[1]); ow.y = pk2(o[2], o[3]);
            *(GAS v2u*)(Kb + ((size_t)(b * 8 + h) * TQK + tk) * 96 + 64 + i0) = ow;
        }
    }
}
__device__ __forceinline__ void ph_convfix(Frame& F, int nrows, int layer) {
    const int gw = F.vcu * NWAVES + F.wave, NGW = F.G * NWAVES;
    const bf16* AB = (const bf16*)(ws_(F) + WS_AB); const bf16* GB = (const bf16*)(ws_(F) + WS_GB); bf16* HG = (bf16*)(ws_(F) + WS_HG);
    const float* cw = inp(F, 9) + (size_t)layer * 3 * FFH; const float* cb = inp(F, 10) + (size_t)layer * FFH;
    const int nedge = (nrows / 64) * 2;
    for (int er = gw; er < nedge; er += NGW) {
        const int g64 = er >> 1, which = er & 1, m = 64 * g64 + (which ? 63 : 0);
        const bool isctx = m >= TL; const int t = isctx ? ((m - TL) & 255) : (m & 8191), len = isctx ? CTXL : SEQ;
        const bool hp = t > 0, hn = t < len - 1;
        const bf16* ac_ = AB + (size_t)(g64 * 4 + (which ? 3 : 0)) * FFH;
        const bf16* ap_ = which ? AB + (size_t)(g64 * 4 + 2) * FFH : AB + (size_t)((g64 - 1) * 4 + 3) * FFH;
        const bf16* an_ = which ? AB + (size_t)((g64 + 1) * 4 + 0) * FFH : AB + (size_t)(g64 * 4 + 1) * FFH;
        const bf16* gt_ = GB + (size_t)(g64 * 2 + which) * FFH;
#pragma unroll
        for (int ci = 0; ci < 6; ++ci) { const int ch = F.lane + 64 * ci; if (ch >= FFH / 8) break;
            const int j0 = 8 * ch; float ac[8], ap[8], an[8], gt[8], o[8];
            unpack8(*(const GAS v4u*)(ac_ + j0), ac); unpack8(*(const GAS v4u*)(gt_ + j0), gt);
            if (hp) unpack8(*(const GAS v4u*)(ap_ + j0), ap); else {
#pragma unroll
                for (int j = 0; j < 8; ++j) ap[j] = 0.f; }
            if (hn) unpack8(*(const GAS v4u*)(an_ + j0), an); else {
#pragma unroll
                for (int j = 0; j < 8; ++j) an[j] = 0.f; }
#pragma unroll
            for (int j = 0; j < 8; ++j) { const float cv = cb[j0 + j] + cw[j0 + j] * ap[j] + cw[FFH + j0 + j] * ac[j] + cw[2 * FFH + j0 + j] * an[j]; o[j] = siluf_(cv) * gt[j]; }
            *(GAS v4u*)(HG + (size_t)m * FFH + j0) = pack8(o);
        }
    }
}
__device__ __forceinline__ void ph_hg_gate(Frame& F) {
    const int gw = F.vcu * NWAVES + F.wave, NGW = F.G * NWAVES;
    bf16* O = (bf16*)(ws_(F) + WS_O); const bf16* G = (const bf16*)(ws_(F) + WS_G);
    const int c0 = 16 * F.lane; float ng[16];
#pragma unroll
    for (int j = 0; j < 16; ++j) ng[j] = inp(F, 29)[(c0 + j) & 127];
    for (int m = gw; m < TL; m += NGW) {
        float o[16], g[16]; unpack8(*(const GAS v4u*)(O + (size_t)m * D + c0), o); unpack8(*(const GAS v4u*)(O + (size_t)m * D + c0 + 8), o + 8);
        unpack8(*(const GAS v4u*)(G + (size_t)m * D + c0), g); unpack8(*(const GAS v4u*)(G + (size_t)m * D + c0 + 8), g + 8);
        float ss = 0.f;
#pragma unroll
        for (int j = 0; j < 16; ++j) ss += o[j] * o[j];
        ss += __shfl_xor(ss, 1); ss += __shfl_xor(ss, 2); ss += __shfl_xor(ss, 4);
        const float sc = 1.f / sqrtf(ss * (1.f / 128.f) + NORM_EPS);
#pragma unroll
        for (int j = 0; j < 16; ++j) o[j] = o[j] * sc * ng[j] * siluf_(g[j]);
        *(GAS v4u*)(O + (size_t)m * D + c0) = pack8(o); *(GAS v4u*)(O + (size_t)m * D + c0 + 8) = pack8(o + 8);
    }
}

typedef short bf16x8_t __attribute__((ext_vector_type(8)));
typedef float f32x16 __attribute__((ext_vector_type(16)));
__device__ __forceinline__ int crow(int r, int hi) { return (r & 3) + 8 * (r >> 2) + 4 * hi; }
constexpr int NCH = TT / 64;
__device__ __forceinline__ void p0_s5_tables(Frame& F) {
    LAS unsigned char* L = F.lds + RING_OFF;
    LAS double* lam = (LAS double*)L;
    LAS float* bb = (LAS float*)(L + 1024);
    LAS float* cc = (LAS float*)(L + 1024 + 8192);
    LAS float* pw = (LAS float*)(L + 1024 + 16384);
    unsigned char* ws = ws_(F);
    for (int item4 = blockIdx.x; item4 < 256; item4 += F.G) {
        const int item = item4 >> 2, part = item4 & 3;
        const int g = item >> 1, d = item & 1;
        __syncthreads();
        if (F.tid < 64) { const int n = F.tid, pi = (d * 32 + g) * 64 + n;
            const double lre = inp(F, 17)[pi], lim = inp(F, 18)[pi], dt = exp((double)inp(F, 19)[d * 32 + g]);
            const double mag = exp(lre * dt), are = mag * cos(lim * dt), aim = mag * sin(lim * dt), den = lre * lre + lim * lim, nr = are - 1.0;
            const double fr = (nr * lre + aim * lim) / den, fi = (aim * lre - nr * lim) / den;
            for (int q = 0; q < 16; ++q) { const double br = inp(F, 20)[(size_t)pi * 16 + q], bi = inp(F, 21)[(size_t)pi * 16 + q];
                bb[(n * 16 + q) * 2] = (float)(fr * br - fi * bi); bb[(n * 16 + q) * 2 + 1] = (float)(fr * bi + fi * br); }
            double pr = 1.0, pim = 0.0;
            for (int e = 0; e <= 64; ++e) { pw[(e * 64 + n) * 2] = (float)pr; pw[(e * 64 + n) * 2 + 1] = (float)pim; const double n_r = pr * are - pim * aim, n_i = pr * aim + pim * are; pr = n_r; pim = n_i; } }
        for (int i = F.tid; i < 1024; i += 512) { const int p = i >> 6, n = i & 63; cc[i * 2] = inp(F, 22)[((size_t)(d * 32 + g) * 16 + p) * 64 + n]; cc[i * 2 + 1] = inp(F, 23)[((size_t)(d * 32 + g) * 16 + p) * 64 + n]; }
        __syncthreads();
        { bf16* WF = (bf16*)(ws + WS_WF) + (size_t)g * 256 * 1024;
          for (int i = part * 4096 + F.tid; i < (part + 1) * 4096; i += 512) { const int row = i >> 7, grp = i & 127, c = row >> 6, n = row & 63, sI = grp >> 1, q0 = (grp & 1) * 8, e = d ? sI : 63 - sI;
              const float pr = pw[(e * 64 + n) * 2], pim = pw[(e * 64 + n) * 2 + 1]; float o[8];
              const LAS f32x4* bq = (const LAS f32x4*)(bb + (n * 16 + q0) * 2);
#pragma unroll
              for (int j4 = 0; j4 < 4; ++j4) { const f32x4 v = bq[j4]; o[2 * j4] = c ? (pr * v.y + pim * v.x) : (pr * v.x - pim * v.y); o[2 * j4 + 1] = c ? (pr * v.w + pim * v.z) : (pr * v.z - pim * v.w); }
              *(GAS v4u*)(WF + (size_t)(d * 128 + row) * 1024 + sI * 16 + q0) = pack8(o); } }
        { bf16* WC = (bf16*)(ws + WS_WC) + (size_t)g * 1024 * 256;
          for (int i = part * 4096 + F.tid; i < (part + 1) * 4096; i += 512) { const int row = i >> 4, grp = i & 15, t = row >> 4, p = row & 15, c = grp >> 3, n0 = (grp & 7) * 8, ex = d ? 64 - t : t + 1; float o[8];
              const LAS f32x4* pq = (const LAS f32x4*)(pw + (ex * 64 + n0) * 2); const LAS f32x4* cq = (const LAS f32x4*)(cc + (p * 64 + n0) * 2);
#pragma unroll
              for (int j4 = 0; j4 < 4; ++j4) { const f32x4 pv = pq[j4], cv = cq[j4];
                  o[2 * j4] = c ? -(cv.x * pv.y + cv.y * pv.x) : (cv.x * pv.x - cv.y * pv.y); o[2 * j4 + 1] = c ? -(cv.z * pv.w + cv.w * pv.z) : (cv.z * pv.z - cv.w * pv.w); }
              *(GAS v4u*)(WC + (size_t)row * 256 + d * 128 + c * 64 + n0) = pack8(o); } }
        { bf16* TP = (bf16*)(ws + WS_TOEP) + (size_t)g * 127 * 256; float* T0 = (float*)(ws + WS_T0) + (size_t)(g * 2 + d) * 256;
          for (int i = part * 256 + F.tid; i < (part + 1) * 256; i += 512) { const int tau = i >> 4, p = i & 15; float acc[16];
#pragma unroll
              for (int q = 0; q < 16; ++q) acc[q] = 0.f;
              for (int n = 0; n < 64; ++n) { const float pr = pw[(tau * 64 + n) * 2], pim = pw[(tau * 64 + n) * 2 + 1], cr = cc[(p * 64 + n) * 2], ci = cc[(p * 64 + n) * 2 + 1];
                  const float tr = cr * pr - ci * pim, ti = cr * pim + ci * pr;
                  const LAS f32x4* bq = (const LAS f32x4*)(bb + n * 32);
#pragma unroll
                  for (int q4 = 0; q4 < 8; ++q4) { const f32x4 v = bq[q4]; acc[2 * q4] += tr * v.x - ti * v.y; acc[2 * q4 + 1] += tr * v.z - ti * v.w; } }
              if (tau == 0) {
#pragma unroll
                  for (int q = 0; q < 16; ++q) T0[p * 16 + q] = acc[q]; }
              else { bf16* o = TP + (size_t)(d ? 63 - tau : 63 + tau) * 256 + p * 16; *(GAS v4u*)o = pack8(acc); *(GAS v4u*)(o + 8) = pack8(acc + 8); } } }
        if (part == 0 && F.tid < 64) { float* A64 = (float*)(ws + WS_A64) + (size_t)((g * 2 + d) * 64 + F.tid) * 2; A64[0] = pw[(64 * 64 + F.tid) * 2]; A64[1] = pw[(64 * 64 + F.tid) * 2 + 1]; }
    }
    __syncthreads();
}
__device__ __forceinline__ void ph_s5_finals(Frame& F) {
    const int lane = F.lane, r32 = lane & 31, hh = lane >> 5, wave = F.wave;
    unsigned char* ws = ws_(F);
    for (int u = blockIdx.x; u < 288; u += F.G) {
        const int g = u / 9, nb = u % 9; int chunk = nb * 32 + r32; const bool valid = chunk < NCH; if (!valid) chunk = NCH - 1;
        const bf16* ub = (const bf16*)(ws + WS_UG) + ((size_t)g * TT + (size_t)chunk * 64) * 16 + 8 * hh;
        const bf16* wf = (const bf16*)(ws + WS_WF) + ((size_t)(g * 256 + 32 * wave + r32)) * 1024 + 8 * hh;
        f32x16 acc;
#pragma unroll
        for (int r = 0; r < 16; ++r) acc[r] = 0.f;
#pragma unroll 16
        for (int sI = 0; sI < 64; ++sI) { const bf16x8_t a = *(const GAS bf16x8_t*)(wf + 16 * sI), b = *(const GAS bf16x8_t*)(ub + 16 * sI); acc = __builtin_amdgcn_mfma_f32_32x32x16_bf16(a, b, acc, 0, 0, 0); }
        if (valid) { float* fo = (float*)(ws + WS_FIN) + ((size_t)g * NCH + chunk) * 256 + 32 * wave + 4 * hh;
#pragma unroll
            for (int k = 0; k < 4; ++k) *(GAS f32x4*)(fo + 8 * k) = (f32x4){acc[4 * k], acc[4 * k + 1], acc[4 * k + 2], acc[4 * k + 3]}; }
    }
}
__device__ __forceinline__ int s5_chunk_of(int step, int d, int b) { return step < 4 ? 256 + 4 * b + (d ? 3 - step : step) : 128 * b + (d ? 127 - (step - 4) : step - 4); }
__device__ __forceinline__ void ph_s5_carry(Frame& F) {
    if (F.wave >= 3) return;
    unsigned char* ws = ws_(F);
    for (int item = ((int)F.G - 1 - (int)blockIdx.x) * 3 + F.wave; item < 128; item += 3 * F.G) {
        const int g = item >> 2, d = (item >> 1) & 1, b = item & 1, n = F.lane;
        const float a_r = ((const float*)(ws + WS_A64))[((g * 2 + d) * 64 + n) * 2], a_i = ((const float*)(ws + WS_A64))[((g * 2 + d) * 64 + n) * 2 + 1];
        const float* Fb = (const float*)(ws + WS_FIN) + (size_t)g * NCH * 256 + d * 128 + n; bf16* Sb = (bf16*)(ws + WS_SIN) + (size_t)g * NCH * 256 + d * 128 + n;
        float sr = 0.f, si = 0.f;
        for (int s0 = 0; s0 < 132; s0 += 12) {
            float fr[12], fi[12];
#pragma unroll
            for (int j = 0; j < 12; ++j) { const int c = s5_chunk_of(s0 + j, d, b); fr[j] = Fb[(size_t)c * 256]; fi[j] = Fb[(size_t)c * 256 + 64]; }
#pragma unroll
            for (int j = 0; j < 12; ++j) { const int c = s5_chunk_of(s0 + j, d, b); Sb[(size_t)c * 256] = (bf16)f2bf(sr); Sb[(size_t)c * 256 + 64] = (bf16)f2bf(si);
                const float nr = a_r * sr - a_i * si + fr[j], ni = a_r * si + a_i * sr + fi[j]; sr = nr; si = ni; }
        }
    }
}
constexpr int TP_PITCH = 48;
__device__ __forceinline__ void ph_s5_out(Frame& F) {
    LAS unsigned char* L = F.lds + RING_OFF;
    const int lane = F.lane, r32 = lane & 31, hh = lane >> 5, wave = F.wave, tid = F.tid;
    unsigned char* ws = ws_(F);
    for (int u = blockIdx.x; u < 288; u += F.G) {
        const int g = u / 9, nb = u % 9; int chunk = nb * 32 + r32; const bool valid = chunk < NCH; if (!valid) chunk = NCH - 1;
        __syncthreads();
        { const GAS v4u* tp = (const GAS v4u*)((const bf16*)(ws + WS_TOEP) + (size_t)g * 127 * 256); const float* t0 = (const float*)(ws + WS_T0) + (size_t)g * 512;
          for (int c = tid; c < 127 * 32; c += 512) { const int di = c >> 5, p = (c >> 1) & 15, half = c & 1; v4u v;
              if (di == 63) { float o[8];
#pragma unroll
                  for (int j = 0; j < 8; ++j) o[j] = t0[p * 16 + half * 8 + j] + t0[256 + p * 16 + half * 8 + j];
                  v = pack8(o); }
              else v = tp[c];
              *(LAS v4u*)(L + (di * 16 + p) * TP_PITCH + half * 16) = v; } }
        __syncthreads();
        const bf16* ub = (const bf16*)(ws + WS_UG) + ((size_t)g * TT + (size_t)chunk * 64) * 16 + 8 * hh;
        f32x16 acc[4];
#pragma unroll
        for (int i = 0; i < 4; ++i)
#pragma unroll
            for (int r = 0; r < 16; ++r) acc[i][r] = 0.f;
        const LAS unsigned char* tl = L + ((63 + 2 * wave + (r32 >> 4)) * 16 + (r32 & 15)) * TP_PITCH + hh * 16;
#pragma unroll 1
        for (int s0 = 0; s0 < 64; s0 += 16) {
            bf16x8_t bq[16];
#pragma unroll
            for (int e = 0; e < 16; ++e) bq[e] = *(const GAS bf16x8_t*)(ub + 16 * (s0 + e));
#pragma unroll
            for (int e = 0; e < 16; ++e) { const int sI = s0 + e; const bf16x8_t b = bq[e];
#pragma unroll
            for (int i = 0; i < 4; ++i) { const bf16x8_t a = *(const LAS bf16x8_t*)(tl + (16 * i - sI) * 16 * TP_PITCH); acc[i] = __builtin_amdgcn_mfma_f32_32x32x16_bf16(a, b, acc[i], 0, 0, 0); }
            }
        }
        { const bf16* sb = (const bf16*)(ws + WS_SIN) + ((size_t)g * NCH + chunk) * 256 + 8 * hh;
          const bf16* wc = (const bf16*)(ws + WS_WC) + ((size_t)g * 1024 + 32 * wave + r32) * 256 + 8 * hh;
#pragma unroll 4
          for (int kk = 0; kk < 16; ++kk) {
              const bf16x8_t b = *(const GAS bf16x8_t*)(sb + 16 * kk);
#pragma unroll
              for (int i = 0; i < 4; ++i) { const bf16x8_t a = *(const GAS bf16x8_t*)(wc + (size_t)(256 * i) * 256 + 16 * kk); acc[i] = __builtin_amdgcn_mfma_f32_32x32x16_bf16(a, b, acc[i], 0, 0, 0); }
          } }
        if (valid) {
            const float* dsk = inp(F, 24) + 16 * g;
#pragma unroll
            for (int i = 0; i < 4; ++i)
#pragma unroll
                for (int k = 0; k < 4; ++k) { const int tloc = 2 * (wave + 8 * i) + (k >> 1), p0 = 8 * (k & 1) + 4 * hh; const size_t m = (size_t)chunk * 64 + tloc;
                    const v2u uw = *(const GAS v2u*)((const bf16*)(ws + WS_UG) + ((size_t)g * TT + m) * 16 + p0);
                    const float y0 = gelu_tanh(acc[i][4 * k] + dsk[p0] * bflo(uw.x)), y1 = gelu_tanh(acc[i][4 * k + 1] + dsk[p0 + 1] * bfhi(uw.x));
                    const float y2 = gelu_tanh(acc[i][4 * k + 2] + dsk[p0 + 2] * bflo(uw.y)), y3 = gelu_tanh(acc[i][4 * k + 3] + dsk[p0 + 3] * bfhi(uw.y));
                    v2u zw; zw.x = pk2(y0, y1); zw.y = pk2(y2, y3);
                    *(GAS v2u*)((bf16*)(ws + WS_Z) + m * 512 + 16 * g + p0) = zw; }
        }
    }
}

__device__ __forceinline__ bf16x8_t pack_frag(const f32x16& p, int base) {
    v4u w; w.x = pg8::cvt_pk_bf16(p[base + 0], p[base + 1]); w.y = pg8::cvt_pk_bf16(p[base + 2], p[base + 3]); w.z = pg8::cvt_pk_bf16(p[base + 4], p[base + 5]); w.w = pg8::cvt_pk_bf16(p[base + 6], p[base + 7]);
    return __builtin_bit_cast(bf16x8_t, w);
}
constexpr int AT_KP = 208, AT_VP = 272;
constexpr int AT_KB = 128 * AT_KP, AT_VB = 64 * AT_VP;
constexpr int AT_K0 = 0, AT_V0 = 2 * AT_KB, AT_WS = 2 * AT_KB + 2 * AT_VB;
__device__ __forceinline__ void ph_attn(Frame& F) {
    LAS unsigned char* L = F.lds + RING_OFF;
    const int lane = F.lane, r32 = lane & 31, hi = lane >> 5, wave = F.wave, tid = F.tid;
    volatile LAS float* wsf = (volatile LAS float*)(L + AT_WS) + wave * 32;
    const bf16* Qb = (const bf16*)(ws_(F) + WS_QB); const bf16* Kb = (const bf16*)(ws_(F) + WS_KB); const bf16* Vt = (const bf16*)(ws_(F) + WS_VB);
    bf16* MIX = (bf16*)(ws_(F) + WS_MIX);
    int kl[3], vl[2];
#pragma unroll
    for (int i = 0; i < 3; ++i) { const int c = tid + 512 * i; kl[i] = (c / 12) * AT_KP + (c % 12) * 16; }
#pragma unroll
    for (int i = 0; i < 2; ++i) { const int c = tid + 512 * i; vl[i] = ((c & 511) >> 3) * AT_VP + (c >> 9) * 128 + (c & 7) * 16; }
    for (int it = 0; it < 3; ++it) {
        int u; if (it < 2) u = it * 256 + F.vcu; else { if (F.vcu >= 16) break; u = 512 + F.vcu; }
        int b, h, tq0, NT, m0;
        if (u < 512) { b = u >> 8; h = (u >> 5) & 7; tq0 = (u & 31) * 256; NT = TQK / 128; m0 = b * SEQ + tq0; }
        else { const int uc = u - 512; b = uc >> 3; h = uc & 7; tq0 = SEQ; NT = CTXL / 128; m0 = TL + b * CTXL; }
        const size_t bh = (size_t)(b * 8 + h);
        const GAS v4u* Kg = (const GAS v4u*)(Kb + bh * TQK * 96);
        const GAS v4u* Vg = (const GAS v4u*)(Vt + bh * (TQK / 64) * 4096);
        bf16x8_t qf[6];
        { const bf16* qp = Qb + (bh * TQK + tq0 + wave * 32 + r32) * 96 + hi * 8;
#pragma unroll
          for (int ks = 0; ks < 6; ++ks) qf[ks] = *(const GAS bf16x8_t*)(qp + ks * 16); }
        f32x16 o0, o1;
#pragma unroll
        for (int r = 0; r < 16; ++r) { o0[r] = 0.f; o1[r] = 0.f; }
        float m_run = -1e30f, l_run = 0.f;
        __syncthreads();
        { v4u a[3], v[2];
#pragma unroll
          for (int i = 0; i < 3; ++i) a[i] = Kg[tid + 512 * i];
#pragma unroll
          for (int i = 0; i < 2; ++i) v[i] = Vg[tid + 512 * i];
#pragma unroll
          for (int i = 0; i < 3; ++i) *(LAS v4u*)(L + AT_K0 + kl[i]) = a[i];
#pragma unroll
          for (int i = 0; i < 2; ++i) *(LAS v4u*)(L + AT_V0 + vl[i]) = v[i]; }
        __syncthreads();
        for (int t = 0; t < NT; ++t) {
            const int cur = t & 1, nxt = cur ^ 1; const bool more = (t + 1 < NT);
            v4u na[3], nv[2];
#pragma unroll
            for (int i = 0; i < 3; ++i) na[i] = (v4u){0u, 0u, 0u, 0u};
#pragma unroll
            for (int i = 0; i < 2; ++i) nv[i] = (v4u){0u, 0u, 0u, 0u};
            if (more) {
#pragma unroll
                for (int i = 0; i < 3; ++i) na[i] = Kg[(size_t)(t + 1) * 1536 + tid + 512 * i];
#pragma unroll
                for (int i = 0; i < 2; ++i) nv[i] = Vg[(size_t)(t + 1) * 1024 + tid + 512 * i]; }
            const LAS unsigned char* Kl = L + AT_K0 + cur * AT_KB + r32 * AT_KP + hi * 16;
            const LAS unsigned char* Vl = L + AT_V0 + cur * AT_VB + r32 * AT_VP + hi * 16;
            f32x16 p[4];
#pragma unroll
            for (int kb = 0; kb < 4; ++kb) {
#pragma unroll
                for (int r = 0; r < 16; ++r) p[kb][r] = 0.f;
#pragma unroll
                for (int ks = 0; ks < 6; ++ks) p[kb] = __builtin_amdgcn_mfma_f32_32x32x16_bf16(*(const LAS bf16x8_t*)(Kl + kb * 32 * AT_KP + ks * 32), qf[ks], p[kb], 0, 0, 0);
            }
            float mt = fmaxf(fmaxf(p[0][0], p[1][0]), fmaxf(p[2][0], p[3][0]));
#pragma unroll
            for (int r = 1; r < 16; ++r) mt = fmaxf(mt, fmaxf(fmaxf(p[0][r], p[1][r]), fmaxf(p[2][r], p[3][r])));
            mt = fmaxf(mt, __shfl_xor(mt, 32));
            const bool need = mt > m_run + 8.0f;
            if (__any(need)) {
                const float mn = need ? mt : m_run, alpha = __builtin_amdgcn_exp2f(m_run - mn);
                l_run *= alpha; m_run = mn;
                if (hi == 0) wsf[r32] = alpha;
#pragma unroll
                for (int r = 0; r < 16; ++r) { const float a = wsf[crow(r, hi)]; o0[r] *= a; o1[r] *= a; }
            }
            float sum = 0.f;
#pragma unroll
            for (int kb = 0; kb < 4; ++kb)
#pragma unroll
                for (int r = 0; r < 16; ++r) { p[kb][r] = __builtin_amdgcn_exp2f(p[kb][r] - m_run); sum += p[kb][r]; }
            l_run += sum;
#pragma unroll
            for (int kb = 0; kb < 4; ++kb) {
                const bf16x8_t pa = pack_frag(p[kb], 0), pb = pack_frag(p[kb], 8);
                const LAS unsigned char* vp = Vl + (kb >> 1) * 128 + (kb & 1) * 64;
                o0 = __builtin_amdgcn_mfma_f32_32x32x16_bf16(pa, *(const LAS bf16x8_t*)(vp), o0, 0, 0, 0);
                o0 = __builtin_amdgcn_mfma_f32_32x32x16_bf16(pb, *(const LAS bf16x8_t*)(vp + 32), o0, 0, 0, 0);
                o1 = __builtin_amdgcn_mfma_f32_32x32x16_bf16(pa, *(const LAS bf16x8_t*)(vp + 32 * AT_VP), o1, 0, 0, 0);
                o1 = __builtin_amdgcn_mfma_f32_32x32x16_bf16(pb, *(const LAS bf16x8_t*)(vp + 32 * AT_VP + 32), o1, 0, 0, 0);
            }
            if (more) {
#pragma unroll
                for (int i = 0; i < 3; ++i) *(LAS v4u*)(L + AT_K0 + nxt * AT_KB + kl[i]) = na[i];
#pragma unroll
                for (int i = 0; i < 2; ++i) *(LAS v4u*)(L + AT_V0 + nxt * AT_VB + vl[i]) = nv[i]; }
            __syncthreads();
        }
        l_run += __shfl_xor(l_run, 32);
        if (hi == 0) wsf[r32] = 1.0f / l_run;
#pragma unroll
        for (int r = 0; r < 16; ++r) { const int q = crow(r, hi); const float inv = wsf[q];
            bf16* op = MIX + (size_t)(m0 + wave * 32 + q) * D + h * 64 + r32;
            op[0] = (bf16)f2bf(o0[r] * inv); op[32] = (bf16)f2bf(o1[r] * inv); }
    }
}

constexpr int HG_QT = 0, HG_KT = 17408, HG_KH = 34816, HG_VT = 53248, HG_ST = 71680, HG_DEC = 106496, HG_TOT = 107008;
constexpr int HG_NSC = 17;
constexpr size_t WS_SD = 231 * MiB;
constexpr size_t WS_DECS = WS_SD + 18 * MiB;
static_assert(WS_DECS + 32 * 17 * 128 * 4 <= WS_END, "hgrn ws");
template <bool OUT>
__device__ __forceinline__ void hgrn_pass(Frame& F, int b, int h, int dir, int sc, f32x16 (&st)[2], float& dsum) {
    LAS unsigned char* L = F.lds + RING_OFF;
    unsigned char* ws = ws_(F);
    const int tid = F.tid, lane = F.lane, r32 = lane & 31, hh = lane >> 5, wave = F.wave;
    const int k = tid & 127, tg = tid >> 7;
    const int nch = sc == 0 ? 4 : 8; const size_t rowbase = sc == 0 ? (size_t)TL + b * CTXL : (size_t)b * SEQ + (size_t)(sc - 1) * 512;
    const bf16* QF = (const bf16*)(ws + WS_QFFI);
    const float lb = ((const float*)(ws + WS_LBV))[dir * 1024 + h * 128 + k];
    const int colf = 1024 * (1 + dir) + h * 128 + k, colq = h * 128 + k, colv = 3072 + h * 128 + k;
    const int dvb = wave & 3, jb = wave >> 2;
    bf16 rq[16], rf[16], rv[16];
#define HG_LOAD(ci) do { const int cc_ = dir ? nch - 1 - (ci) : (ci); const int tl0_ = dir ? 63 - 16 * tg : 16 * tg; \
        const GAS bf16* pf_ = (const GAS bf16*)(QF + (rowbase + 64 * cc_ + tl0_) * 4096 + colf); const GAS bf16* pv_ = pf_ + (colv - colf); const GAS bf16* pq_ = pf_ + (colq - colf); const long stp_ = dir ? -4096 : 4096; \
        _Pragma("unroll") for (int jj = 0; jj < 16; ++jj) { rf[jj] = *pf_; rv[jj] = *pv_; if (OUT) rq[jj] = *pq_; pf_ += stp_; pv_ += stp_; pq_ += stp_; asm volatile("" : "+v"(pf_), "+v"(pv_), "+v"(pq_)); } } while (0)
    HG_LOAD(0);
    for (int ci = 0; ci < nch; ++ci) {
        const int cc = dir ? nch - 1 - ci : ci;
        float cum[16], kk[16];
        { float run = 0.f;
#pragma unroll
          for (int jj = 0; jj < 16; ++jj) { const float f = lb + (1.f - lb) * sigmoidf_(bf2f(rf[jj])); run += __log2f(f); cum[jj] = run; kk[jj] = 1.f - f; }
          ((LAS float*)(L + HG_TOT))[tg * 128 + k] = run; }
        __syncthreads();
        { const LAS float* tot = (const LAS float*)(L + HG_TOT) + k; const float t0 = tot[0], t1 = tot[128], t2 = tot[256], t3 = tot[384];
          const float pre = tg == 0 ? 0.f : (tg == 1 ? t0 : (tg == 2 ? t0 + t1 : t0 + t1 + t2)), total = (t0 + t1) + (t2 + t3);
          if (tg == 0) { ((LAS float*)(L + HG_DEC))[k] = __builtin_amdgcn_exp2f(total); dsum += total; }
#define HG_KH(jj) (kk[jj] * __builtin_amdgcn_exp2f(total - (pre + cum[jj])))
#define HG_PKV(a, b_) ((unsigned)rv[a] | ((unsigned)rv[b_] << 16))
          if (OUT) {
#pragma unroll
              for (int jj = 0; jj < 16; ++jj) { const float c = pre + cum[jj]; const int j = 16 * tg + jj;
                  *(LAS bf16*)(L + HG_QT + j * 272 + k * 2) = (bf16)f2bf(bf2f(rq[jj]) * __builtin_amdgcn_exp2f(c)); *(LAS bf16*)(L + HG_KT + j * 272 + k * 2) = (bf16)f2bf(kk[jj] * __builtin_amdgcn_exp2f(-c)); } }
          v4u w0, w1;
          w0.x = pk2(HG_KH(0), HG_KH(1)); w0.y = pk2(HG_KH(2), HG_KH(3)); w0.z = pk2(HG_KH(8), HG_KH(9)); w0.w = pk2(HG_KH(10), HG_KH(11));
          w1.x = pk2(HG_KH(4), HG_KH(5)); w1.y = pk2(HG_KH(6), HG_KH(7)); w1.z = pk2(HG_KH(12), HG_KH(13)); w1.w = pk2(HG_KH(14), HG_KH(15));
          *(LAS v4u*)(L + HG_KH + k * 144 + tg * 32) = w0; *(LAS v4u*)(L + HG_KH + k * 144 + tg * 32 + 16) = w1;
          w0.x = HG_PKV(0, 1); w0.y = HG_PKV(2, 3); w0.z = HG_PKV(8, 9); w0.w = HG_PKV(10, 11);
          w1.x = HG_PKV(4, 5); w1.y = HG_PKV(6, 7); w1.z = HG_PKV(12, 13); w1.w = HG_PKV(14, 15);
          *(LAS v4u*)(L + HG_VT + k * 144 + tg * 32) = w0; *(LAS v4u*)(L + HG_VT + k * 144 + tg * 32 + 16) = w1; }
#undef HG_KH
#undef HG_PKV
        if (ci + 1 < nch) HG_LOAD(ci + 1);
        __syncthreads();
        if (OUT) {
            f32x16 oacc;
#pragma unroll
            for (int r = 0; r < 16; ++r) oacc[r] = 0.f;
            const LAS unsigned char* qrow = L + HG_QT + (32 * jb + r32) * 272 + hh * 16;
            const LAS unsigned char* srow = L + HG_ST + (32 * dvb + r32) * 272 + hh * 16;
            const LAS unsigned char* vrow = L + HG_VT + (32 * dvb + r32) * 144 + hh * 16;
#pragma unroll
            for (int ks = 0; ks < 8; ++ks) oacc = __builtin_amdgcn_mfma_f32_32x32x16_bf16(*(const LAS bf16x8_t*)(qrow + ks * 32), *(const LAS bf16x8_t*)(srow + ks * 32), oacc, 0, 0, 0);
            {
                f32x16 at;
#pragma unroll
                for (int r = 0; r < 16; ++r) at[r] = 0.f;
                const LAS unsigned char* krow = L + HG_KT + r32 * 272 + hh * 16;
#pragma unroll
                for (int ks = 0; ks < 8; ++ks) at = __builtin_amdgcn_mfma_f32_32x32x16_bf16(*(const LAS bf16x8_t*)(krow + ks * 32), *(const LAS bf16x8_t*)(qrow + ks * 32), at, 0, 0, 0);
                if (jb == 0) {
#pragma unroll
                    for (int r = 0; r < 16; ++r) if (crow(r, hh) > r32) at[r] = 0.f; }
                oacc = __builtin_amdgcn_mfma_f32_32x32x16_bf16(pack_frag(at, 0), *(const LAS bf16x8_t*)(vrow + 0), oacc, 0, 0, 0);
                oacc = __builtin_amdgcn_mfma_f32_32x32x16_bf16(pack_frag(at, 8), *(const LAS bf16x8_t*)(vrow + 32), oacc, 0, 0, 0);
            }
            if (jb == 1) {
                f32x16 at;
#pragma unroll
                for (int r = 0; r < 16; ++r) at[r] = 0.f;
                const LAS unsigned char* krow = L + HG_KT + (32 + r32) * 272 + hh * 16;
#pragma unroll
                for (int ks = 0; ks < 8; ++ks) at = __builtin_amdgcn_mfma_f32_32x32x16_bf16(*(const LAS bf16x8_t*)(krow + ks * 32), *(const LAS bf16x8_t*)(qrow + ks * 32), at, 0, 0, 0);
#pragma unroll
                for (int r = 0; r < 16; ++r) if (crow(r, hh) > r32) at[r] = 0.f;
                oacc = __builtin_amdgcn_mfma_f32_32x32x16_bf16(pack_frag(at, 0), *(const LAS bf16x8_t*)(vrow + 64), oacc, 0, 0, 0);
                oacc = __builtin_amdgcn_mfma_f32_32x32x16_bf16(pack_frag(at, 8), *(const LAS bf16x8_t*)(vrow + 96), oacc, 0, 0, 0);
            }
            bf16* O = (bf16*)(ws + WS_O);
#pragma unroll
            for (int r = 0; r < 16; ++r) { const int j = 32 * jb + crow(r, hh), tl = dir ? 63 - j : j;
                bf16* op = O + (rowbase + 64 * cc + tl) * D + h * 128 + 32 * dvb + r32; float ov = oacc[r];
                if (dir) ov += bf2f(*op);
                *op = (bf16)f2bf(ov); }
        }
#pragma unroll
        for (int t = 0; t < 2; ++t) { const int dkb = 2 * (wave >> 2) + t;
#pragma unroll
            for (int q4 = 0; q4 < 4; ++q4) { const f32x4 dd = *(const LAS f32x4*)(L + HG_DEC + (32 * dkb + 8 * q4 + 4 * hh) * 4);
                st[t][4 * q4] *= dd[0]; st[t][4 * q4 + 1] *= dd[1]; st[t][4 * q4 + 2] *= dd[2]; st[t][4 * q4 + 3] *= dd[3]; }
            const LAS unsigned char* arow = L + HG_KH + (32 * dkb + r32) * 144 + hh * 16; const LAS unsigned char* vrow = L + HG_VT + (32 * dvb + r32) * 144 + hh * 16;
#pragma unroll
            for (int ks = 0; ks < 4; ++ks) st[t] = __builtin_amdgcn_mfma_f32_32x32x16_bf16(*(const LAS bf16x8_t*)(arow + ks * 32), *(const LAS bf16x8_t*)(vrow + ks * 32), st[t], 0, 0, 0); }
        __syncthreads();
        if (OUT && ci + 1 < nch) {
#pragma unroll
            for (int t = 0; t < 2; ++t) { const int dkb = 2 * (wave >> 2) + t;
#pragma unroll
                for (int q4 = 0; q4 < 4; ++q4) { v2u w; w.x = pk2(st[t][4 * q4], st[t][4 * q4 + 1]); w.y = pk2(st[t][4 * q4 + 2], st[t][4 * q4 + 3]);
                    *(LAS v2u*)(L + HG_ST + (32 * dvb + r32) * 272 + (32 * dkb + 8 * q4 + 4 * hh) * 2) = w; } }
        }
    }
#undef HG_LOAD
}
__device__ __forceinline__ void ph_hgrn_states(Frame& F) {
    unsigned char* ws = ws_(F);
    for (int item = blockIdx.x; item < 32 * HG_NSC; item += F.G) {
        const int chain = item / HG_NSC, sc = item % HG_NSC, b = chain >> 4, h = (chain >> 1) & 7, dir = chain & 1;
        f32x16 st[2];
#pragma unroll
        for (int t = 0; t < 2; ++t)
#pragma unroll
            for (int r = 0; r < 16; ++r) st[t][r] = 0.f;
        float dsum = 0.f;
        hgrn_pass<false>(F, b, h, dir, sc, st, dsum);
        bf16* sd = (bf16*)(ws + WS_SD) + ((size_t)(chain * HG_NSC + sc) * 8 + F.wave) * 2048 + F.lane;
#pragma unroll
        for (int t = 0; t < 2; ++t)
#pragma unroll
            for (int r = 0; r < 16; ++r) sd[(t * 16 + r) * 64] = (bf16)f2bf(st[t][r]);
        if (F.tid < 128) ((float*)(ws + WS_DECS))[(size_t)(chain * HG_NSC + sc) * 128 + F.tid] = dsum;
    }
}
__device__ __forceinline__ void ph_hgrn_out(Frame& F) {
    LAS unsigned char* L = F.lds + RING_OFF;
    unsigned char* ws = ws_(F);
    const int lane = F.lane, r32 = lane & 31, hh = lane >> 5, wave = F.wave, dvb = wave & 3;
    for (int item = blockIdx.x; item < 256; item += F.G) {
        const int b = item >> 7, h = (item >> 4) & 7, Lsc = item & 15, sc = Lsc + 1;
        for (int dir = 0; dir < 2; ++dir) {
            const int chain = (b * 8 + h) * 2 + dir;
            f32x16 st[2];
#pragma unroll
            for (int t = 0; t < 2; ++t)
#pragma unroll
                for (int r = 0; r < 16; ++r) st[t][r] = 0.f;
            const int npre = dir ? 1 + (16 - sc) : sc;
            for (int i = 0; i < npre; ++i) {
                const int sp = (i == 0) ? 0 : (dir ? 17 - i : i);
                const bf16* sd = (const bf16*)(ws + WS_SD) + ((size_t)(chain * HG_NSC + sp) * 8 + wave) * 2048 + lane;
                const float* dl = (const float*)(ws + WS_DECS) + (size_t)(chain * HG_NSC + sp) * 128;
#pragma unroll
                for (int t = 0; t < 2; ++t) { const int dkb = 2 * (wave >> 2) + t;
#pragma unroll
                    for (int q4 = 0; q4 < 4; ++q4) { const f32x4 dd = *(const GAS f32x4*)(dl + 32 * dkb + 8 * q4 + 4 * hh);
#pragma unroll
                        for (int e = 0; e < 4; ++e) st[t][4 * q4 + e] = __builtin_amdgcn_exp2f(dd[e]) * st[t][4 * q4 + e] + bf2f(sd[(t * 16 + 4 * q4 + e) * 64]); } }
            }
            __syncthreads();
#pragma unroll
            for (int t = 0; t < 2; ++t) { const int dkb = 2 * (wave >> 2) + t;
#pragma unroll
                for (int q4 = 0; q4 < 4; ++q4) { v2u w; w.x = pk2(st[t][4 * q4], st[t][4 * q4 + 1]); w.y = pk2(st[t][4 * q4 + 2], st[t][4 * q4 + 3]);
                    *(LAS v2u*)(L + HG_ST + (32 * dvb + r32) * 272 + (32 * dkb + 8 * q4 + 4 * hh) * 2) = w; } }
            float dsum = 0.f;
            hgrn_pass<true>(F, b, h, dir, sc, st, dsum);
            __syncthreads();
        }
    }
}

struct FInProj {
    bf16* cqkv; bf16* ug;
    __device__ __forceinline__ void operator()(int row, int col, f32x4 v0, f32x4 v1) const {
        v4u w; w.x = pg8::cvt_pk_bf16(v0[0], v0[1]); w.y = pg8::cvt_pk_bf16(v0[2], v0[3]); w.z = pg8::cvt_pk_bf16(v1[0], v1[1]); w.w = pg8::cvt_pk_bf16(v1[2], v1[3]);
        if (col < 672) *(GAS v4u*)(cqkv + (size_t)row * CQKV_LD + col) = w;
        else if (col < EVEN_IN) { const int c = col - 672; *(GAS v4u*)(ug + ((size_t)(c >> 4) * TT + row) * 16 + (c & 15)) = w; }
    }
};
struct FBf16 {
    bf16* o; int ld;
    __device__ __forceinline__ void operator()(int row, int col, f32x4 v0, f32x4 v1) const {
        v4u w; w.x = pg8::cvt_pk_bf16(v0[0], v0[1]); w.y = pg8::cvt_pk_bf16(v0[2], v0[3]); w.z = pg8::cvt_pk_bf16(v1[0], v1[1]); w.w = pg8::cvt_pk_bf16(v1[2], v1[3]);
        *(GAS v4u*)(o + (size_t)row * ld + col) = w;
    }
};
struct EpiGlu {
    static constexpr bool PERM = true, AFTER_DRAIN = false;
    const bf16* z; bf16* mix;
    __device__ __forceinline__ void operator()(const pg8::f32x4 (&acc)[2][2][4][2], const pg8::Unit& u, int wr, int wc, int fr, int fq) const {
        const int row0 = u.pm * 256 + wr * 64 + fr, col0 = u.pn * 256 + wc * 32 + 8 * fq;
#pragma unroll
        for (int ai = 0; ai < 2; ++ai) {
            v4u zz[4][2];
#pragma unroll
            for (int m = 0; m < 4; ++m)
#pragma unroll
                for (int bj = 0; bj < 2; ++bj) zz[m][bj] = *(const GAS v4u*)(z + (size_t)(row0 + ai * 128 + m * 16) * 512 + col0 + bj * 128);
#pragma unroll
            for (int m = 0; m < 4; ++m)
#pragma unroll
                for (int bj = 0; bj < 2; ++bj) { float zf[8], o[8]; unpack8(zz[m][bj], zf);
#pragma unroll
                    for (int j = 0; j < 4; ++j) { o[j] = zf[j] * sigmoidf_(acc[ai][bj][m][0][j]); o[4 + j] = zf[4 + j] * sigmoidf_(acc[ai][bj][m][1][j]); }
                    *(GAS v4u*)(mix + (size_t)(row0 + ai * 128 + m * 16) * D + 512 + col0 + bj * 128) = pack8(o); }
        }
    }
};
struct FQ {
    bf16* qb; const float* rope;
    __device__ __forceinline__ void operator()(int row, int col, f32x4 v0, f32x4 v1) const {
        float x[8] = {v0[0], v0[1], v0[2], v0[3], v1[0], v1[1], v1[2], v1[3]}, p[8];
#pragma unroll
        for (int j = 0; j < 8; ++j) p[j] = __shfl_xor(x[j], 16);
        const bool isctx = row >= TL; const int b = isctx ? ((row - TL) >> 8) : (row >> 13), t = isctx ? ((row - TL) & 255) : (row & 8191), tq = isctx ? SEQ + t : t;
        const int h = col / 96, d = col - h * 96;
        if (d >= 64 && !isctx) { const int idx = d - 64, a = idx >> 4, half = (idx >> 3) & 1, pos = a ? (t & 63) : (t >> 6);
#pragma unroll
            for (int f = 0; f < 8; ++f) { const float cs = rope[2 * (pos * 8 + f)], sn = rope[2 * (pos * 8 + f) + 1]; x[f] = half ? x[f] * cs + p[f] * sn : x[f] * cs - p[f] * sn; } }
#pragma unroll
        for (int j = 0; j < 8; ++j) x[j] *= QSCALE;
        *(GAS v4u*)(qb + ((size_t)(b * 8 + h) * TQK + tq) * 96 + d) = pack8(x);
        asm volatile("" ::: "memory");
    }
};
struct FKV {
    bf16* kb; bf16* vb;
    __device__ __forceinline__ void operator()(int row, int col, f32x4 v0, f32x4 v1) const {
        v4u w; w.x = pg8::cvt_pk_bf16(v0[0], v0[1]); w.y = pg8::cvt_pk_bf16(v0[2], v0[3]); w.z = pg8::cvt_pk_bf16(v1[0], v1[1]); w.w = pg8::cvt_pk_bf16(v1[2], v1[3]);
        const bool isctx = row >= TL; const int b = isctx ? ((row - TL) >> 8) : (row >> 13), t = isctx ? ((row - TL) & 255) : (row & 8191), tk = isctx ? t : CTXL + t;
        const int h = col >> 7, e = col & 127;
        if (e < 64) *(GAS v4u*)(kb + ((size_t)(b * 8 + h) * TQK + tk) * 96 + e) = w;
        else { const int kk = tk & 63, pos = (kk & 48) | (kk & 3) | ((kk & 4) << 1) | ((kk & 8) >> 1);
            bf16* p = vb + (((size_t)(b * 8 + h) * (TQK / 64) + (tk >> 6)) * 64 + (e - 64)) * 64 + pos;
            p[0] = (bf16)(w.x & 0xffffu); p[64] = (bf16)(w.x >> 16); p[128] = (bf16)(w.y & 0xffffu); p[192] = (bf16)(w.y >> 16);
            p[256] = (bf16)(w.z & 0xffffu); p[320] = (bf16)(w.z >> 16); p[384] = (bf16)(w.w & 0xffffu); p[448] = (bf16)(w.w >> 16); }
    }
};
struct EpiResid {
    static constexpr bool PERM = false, AFTER_DRAIN = false;
    float* xl; float* xc; const float* gate; int first; int row_off; float* slab;
    __device__ __forceinline__ void operator()(const pg8::f32x4 (&acc)[2][2][4][2], const pg8::Unit& u, int wr, int wc, int fr, int fq) const {
        const int trow = u.pm * 256 + row_off, col0 = u.pn * 256 + wc * 32 + 4 * fq;
        if (slab) {
            GAS float* sb = (GAS float*)slab + (size_t)(trow - TL + wr * 64 + fr) * D + col0; const GAS float* gq = (const GAS float*)gate + (size_t)2 * 6144 + col0;
            f32x4 g2[2][2];
#pragma unroll
            for (int bj = 0; bj < 2; ++bj)
#pragma unroll
                for (int n = 0; n < 2; ++n) g2[bj][n] = *(const GAS f32x4*)(gq + bj * 128 + n * 16);
#pragma unroll
            for (int ai = 0; ai < 2; ++ai)
#pragma unroll
                for (int m = 0; m < 4; ++m)
#pragma unroll
                    for (int bj = 0; bj < 2; ++bj)
#pragma unroll
                        for (int n = 0; n < 2; ++n) *(GAS f32x4*)(sb + (size_t)(ai * 128 + m * 16) * D + bj * 128 + n * 16) = g2[bj][n] * acc[ai][bj][m][n];
            return;
        }
        const bool lat = trow < TL;
        GAS float* xb = (GAS float*)(lat ? xl + (size_t)trow * D : xc + (size_t)(trow - TL) * D) + (size_t)(wr * 64 + fr) * D + col0;
        const GAS float* gp = (const GAS float*)gate + (size_t)modrow_of(trow) * 6144 + col0;
        f32x4 gv[2][2];
#pragma unroll
        for (int bj = 0; bj < 2; ++bj)
#pragma unroll
            for (int n = 0; n < 2; ++n) gv[bj][n] = *(const GAS f32x4*)(gp + bj * 128 + n * 16);
        const float a0 = (first && lat) ? DN_ALPHA : 1.0f;
#pragma unroll
        for (int ai = 0; ai < 2; ++ai) {
            f32x4 xo[4][2][2];
#pragma unroll
            for (int m = 0; m < 4; ++m)
#pragma unroll
                for (int bj = 0; bj < 2; ++bj)
#pragma unroll
                    for (int n = 0; n < 2; ++n) xo[m][bj][n] = *(const GAS f32x4*)(xb + (size_t)(ai * 128 + m * 16) * D + bj * 128 + n * 16);
#pragma unroll
            for (int m = 0; m < 4; ++m)
#pragma unroll
                for (int bj = 0; bj < 2; ++bj)
#pragma unroll
                    for (int n = 0; n < 2; ++n) *(GAS f32x4*)(xb + (size_t)(ai * 128 + m * 16) * D + bj * 128 + n * 16) = xo[m][bj][n] * a0 + gv[bj][n] * acc[ai][bj][m][n];
            __builtin_amdgcn_sched_barrier(0);
        }
    }
};
struct FHgIn {
    bf16* qffi; bf16* g;
    __device__ __forceinline__ void operator()(int row, int col, f32x4 v0, f32x4 v1) const {
        v4u w; w.x = pg8::cvt_pk_bf16(v0[0], v0[1]); w.y = pg8::cvt_pk_bf16(v0[2], v0[3]); w.z = pg8::cvt_pk_bf16(v1[0], v1[1]); w.w = pg8::cvt_pk_bf16(v1[2], v1[3]);
        if (col < 4096) *(GAS v4u*)(qffi + (size_t)row * 4096 + col) = w; else *(GAS v4u*)(g + (size_t)row * D + (col - 4096)) = w;
    }
};
struct EpiConvGate {
    static constexpr bool PERM = true, AFTER_DRAIN = false;
    bf16* hg; bf16* ab; bf16* gb; const bf16* cwt;
    __device__ __forceinline__ void operator()(const pg8::f32x4 (&acc)[2][2][4][2], const pg8::Unit& u, int wr, int wc, int fr, int fq) const {
        const int hc0 = 128 * u.pn + 32 * wc + 8 * fq;
        v4u wq[4];
#pragma unroll
        for (int i = 0; i < 4; ++i) wq[i] = *(const GAS v4u*)(cwt + (size_t)(hc0 + 2 * i) * 4);
#pragma unroll
        for (int ai = 0; ai < 2; ++ai) {
            const int rowbase = u.pm * 256 + 128 * ai + 64 * wr, g64 = rowbase >> 6;
#pragma unroll
            for (int n = 0; n < 2; ++n) {
                const int hc = hc0 + 4 * n;
                float out[4][4];
#pragma unroll
                for (int e = 0; e < 4; ++e) { const int c = 4 * n + e; const unsigned pw0 = (c & 1) ? wq[c >> 1].z : wq[c >> 1].x, pw1 = (c & 1) ? wq[c >> 1].w : wq[c >> 1].y;
                    const float w0 = bflo(pw0), w1 = bfhi(pw0), w2 = bflo(pw1), b0 = bfhi(pw1);
                    float a[4], up[4], dn[4];
#pragma unroll
                    for (int m = 0; m < 4; ++m) { a[m] = acc[ai][0][m][n][e];
                        up[m] = __builtin_bit_cast(float, __builtin_amdgcn_mov_dpp(__builtin_bit_cast(int, a[m]), 0x121, 0xf, 0xf, false));
                        dn[m] = __builtin_bit_cast(float, __builtin_amdgcn_mov_dpp(__builtin_bit_cast(int, a[m]), 0x12f, 0xf, 0xf, false)); }
#pragma unroll
                    for (int m = 0; m < 4; ++m) { const float prev = fr > 0 ? up[m] : (m > 0 ? up[m > 0 ? m - 1 : 0] : 0.f), next = fr < 15 ? dn[m] : (m < 3 ? dn[m < 3 ? m + 1 : 3] : 0.f);
                        const float cv = b0 + w0 * prev + w1 * a[m] + w2 * next; out[m][e] = siluf_(cv) * acc[ai][1][m][n][e]; } }
#pragma unroll
                for (int m = 0; m < 4; ++m) { const int r64 = 16 * m + fr, row = rowbase + r64;
                    if (r64 != 0 && r64 != 63) { v2u w; w.x = pk2(out[m][0], out[m][1]); w.y = pk2(out[m][2], out[m][3]); *(GAS v2u*)(hg + (size_t)row * FFH + hc) = w; }
                    if (r64 <= 1 || r64 >= 62) { const int slot = r64 <= 1 ? r64 : r64 - 60; const f32x4 ra = acc[ai][0][m][n];
                        v2u w; w.x = pk2(ra[0], ra[1]); w.y = pk2(ra[2], ra[3]); *(GAS v2u*)(ab + (size_t)(g64 * 4 + slot) * FFH + hc) = w;
                        if (r64 == 0 || r64 == 63) { const f32x4 rg = acc[ai][1][m][n]; v2u wg; wg.x = pk2(rg[0], rg[1]); wg.y = pk2(rg[2], rg[3]); *(GAS v2u*)(gb + (size_t)(g64 * 2 + (r64 == 63 ? 1 : 0)) * FFH + hc) = wg; } }
                }
                __builtin_amdgcn_sched_barrier(0);
            }
        }
    }
};
template <class E> __device__ __forceinline__ void run_gemm_off(Frame& F, const bf16* A, int lda, const bf16* Bt, int ldb, int M, int N, int K, const E& e, int boff) {
    pg8::Gemm g{A, Bt, M, N, K, lda, ldb}; pg8::StaticOrder S; S.init(M, N, F.G, (int)((blockIdx.x + F.G - boff) % F.G));
    pg8::gemm_phase<E, pg8::StaticOrder, true, true>(F.lds + RING_OFF, g, S, e);
}
template <class E> __device__ __forceinline__ void run_gemm(Frame& F, const bf16* A, int lda, const bf16* Bt, int ldb, int M, int N, int K, const E& e) {
    pg8::Gemm g{A, Bt, M, N, K, lda, ldb}; pg8::StaticOrder S; S.init(M, N, F.G, (int)blockIdx.x);
    pg8::gemm_phase<E, pg8::StaticOrder, true, true>(F.lds + RING_OFF, g, S, e);
}

constexpr int NPH = 26;
struct Args { const float* in[31]; float* out; unsigned char* ws; int ph_lo, ph_hi; };
__global__ void __launch_bounds__(NWAVES * 64, 2) mk_fwd(Args args) {
    extern __shared__ __attribute__((aligned(16))) unsigned char lds[];
    Frame F;
    F.lds = (LAS unsigned char*)lds;
    F.tid = threadIdx.x; F.lane = F.tid & 63; F.wave = __builtin_amdgcn_readfirstlane(F.tid >> 6);
    F.G = gridDim.x; { const int bx = blockIdx.x; F.vcu = (F.G % 8 == 0) ? (bx % 8) * (F.G / 8) + bx / 8 : bx; }
    for (int u = F.tid; u < (LDS_BYTES - LDSCTL_OFF) / 4; u += NWAVES * 64) ((LAS unsigned*)(F.lds + LDSCTL_OFF))[u] = 0u;
    __syncthreads();
    if (F.tid == 0) {
#pragma unroll
        for (int i = 0; i < 31; ++i) ((LAS unsigned long long*)(F.lds + PTR_OFF))[i] = (unsigned long long)args.in[i];
        ((LAS unsigned long long*)(F.lds + PTR_OFF))[31] = (unsigned long long)args.ws; ((LAS unsigned long long*)(F.lds + PTR_OFF))[32] = (unsigned long long)args.out;
    }
    __syncthreads();
    const int lo = args.ph_lo, hi = args.ph_hi;
    const bool multi = (hi - lo) > 1;
    if (multi) (void)xcd_barrier_post((unsigned*)ws_(F) + CW_BAR, (volatile LAS unsigned*)(F.lds + MISC_OFF) + 8);
#ifndef ONLY_PHASE
#define ONLY_PHASE -1
#endif
#define WSP ws_(F)
#define MODP ((const float*)(ws_(F) + WS_MOD))
#define ABUF ((bf16*)(ws_(F) + WS_A))
#ifndef SKIP_PHASE
#define SKIP_PHASE -1
#endif
#define IN(k) ((ONLY_PHASE < 0 || ONLY_PHASE == (k)) && SKIP_PHASE != (k) && lo <= (k) && (k) < hi)
#define SEAM(k) do { if (IN(k) && IN((k) + 1)) { XcdBarrier bar_; bar_.bar = (unsigned*)ws_(F) + CW_BAR; bar_.x = xb_xcc_id(); bar_.st = (volatile LAS unsigned*)(F.lds + MISC_OFF) + 8; xcd_barrier(bar_); } asm volatile("" : "+v"(F.tid), "+v"(F.lane)); } while (0)
    int pk = 0;
#ifndef REPEAT_PHASE
#define REPEAT_PHASE -1
#endif
#define PHASE(...) do { if (IN(pk)) { __VA_ARGS__ } if (REPEAT_PHASE == pk && IN(pk)) { { XcdBarrier bar_; bar_.bar = (unsigned*)ws_(F) + CW_BAR; bar_.x = xb_xcc_id(); bar_.st = (volatile LAS unsigned*)(F.lds + MISC_OFF) + 8; xcd_barrier(bar_); } asm volatile("" : "+v"(F.tid), "+v"(F.lane)); { __VA_ARGS__ } } SEAM(pk); ++pk; } while (0)
    PHASE( p0_prologue(F); for (int rep_ = 0; rep_ < DUP_S5T; ++rep_) p0_s5_tables(F); );
    PHASE( ph_init_rows(F); );
    PHASE( pg8::Epi8<FInProj> e{{(bf16*)(WSP + WS_CQKV), (bf16*)(WSP + WS_UG)}}; run_gemm(F, ABUF, D, (const bf16*)(WSP + WS_WIN0), D, TT, EVEN_IN_PAD, D, e); );
    PHASE( ph_s5_finals(F); );
    PHASE( ph_s5_carry(F); );
    PHASE( ph_mla_norm(F); );
    PHASE(
#ifndef DUPQ
#define DUPQ 1
#endif
#ifndef DUPKV
#define DUPKV 1
#endif
        _Pragma("unroll") for (int rep = 0; rep < DUPQ; ++rep) { pg8::Epi8<FQ> e{{(bf16*)(WSP + WS_QB), (const float*)(WSP + WS_ROPE)}}; run_gemm(F, (const bf16*)(WSP + WS_CQKV), CQKV_LD, (const bf16*)(WSP + WS_WUQ), 384, TT, 768, 384, e); }
        _Pragma("unroll") for (int rep = 0; rep < DUPKV; ++rep) { pg8::Epi8<FKV> e{{(bf16*)(WSP + WS_KB), (bf16*)(WSP + WS_VB)}}; run_gemm(F, (const bf16*)(WSP + WS_CQKV) + 384, CQKV_LD, (const bf16*)(WSP + WS_WUKV), 256, TT, 1024, 256, e); }
    );
    PHASE( ph_s5_out(F); );
    PHASE( ph_attn(F); );
    PHASE( EpiGlu e{(const bf16*)(WSP + WS_Z), (bf16*)(WSP + WS_MIX)}; run_gemm(F, (const bf16*)(WSP + WS_Z), 512, (const bf16*)(WSP + WS_WGLU), 512, TT, 512, 512, e); );
    PHASE(
        { EpiResid e{out_(F), (float*)(WSP + WS_XC), MODP + 0 * 3 * 6144 + 2 * 1024, 1, 0, nullptr}; run_gemm(F, (const bf16*)(WSP + WS_MIX), D, (const bf16*)(WSP + WS_WOUT0), D, TL, D, D, e); }
        _Pragma("unroll") for (int sp = 0; sp < 4; ++sp) { EpiResid e{out_(F), (float*)(WSP + WS_XC), MODP + 0 * 3 * 6144 + 2 * 1024, 1, TL, (float*)(WSP + WS_SLAB1) + (size_t)sp * TC * D};
            run_gemm_off(F, (const bf16*)(WSP + WS_MIX) + (size_t)TL * D + 256 * sp, D, (const bf16*)(WSP + WS_WOUT0) + 256 * sp, D, TC, D, 256, e, 8 * sp); }
    );
    PHASE( ph_layernorm(F, TT, 0, 0, 0, 3, (const float*)(WSP + WS_SLAB1), 4); );
    PHASE( EpiConvGate e{(bf16*)(WSP + WS_HG), (bf16*)(WSP + WS_AB), (bf16*)(WSP + WS_GB), (const bf16*)(WSP + WS_CWT)}; run_gemm(F, ABUF, D, (const bf16*)(WSP + WS_F1T0), D, TT, 2 * FFH, D, e); );
    PHASE( ph_convfix(F, TT, 0); );
    PHASE(
        { EpiResid e{out_(F), (float*)(WSP + WS_XC), MODP + 0 * 3 * 6144 + 5 * 1024, 1, 0, nullptr}; run_gemm(F, (const bf16*)(WSP + WS_HG), FFH, (const bf16*)(WSP + WS_F2T0), FFH, TL, D, FFH, e); }
        _Pragma("unroll") for (int sp = 0; sp < 6; ++sp) { EpiResid e{out_(F), (float*)(WSP + WS_XC), MODP + 0 * 3 * 6144 + 5 * 1024, 1, TL, (float*)(WSP + WS_SLAB2) + (size_t)sp * TC * D};
            run_gemm_off(F, (const bf16*)(WSP + WS_HG) + (size_t)TL * FFH + 512 * sp, FFH, (const bf16*)(WSP + WS_F2T0) + 512 * sp, FFH, TC, D, sp == 5 ? 256 : 512, e, 8 * sp); }
    );
    PHASE( ph_layernorm(F, TT, 0, 1, 1, 0, (const float*)(WSP + WS_SLAB2), 6); );
    PHASE( pg8::Epi8<FHgIn> e{{(bf16*)(WSP + WS_QFFI), (bf16*)(WSP + WS_G)}}; run_gemm(F, ABUF, D, (const bf16*)(WSP + WS_HGINT), D, TT, 5120, D, e); );
    PHASE( ph_hgrn_states(F); );
    PHASE( ph_hgrn_out(F); );
    PHASE( ph_hg_gate(F); );
    PHASE( EpiResid e{out_(F), (float*)(WSP + WS_XC), MODP + 1 * 3 * 6144 + 2 * 1024, 1, 0, nullptr}; run_gemm(F, (const bf16*)(WSP + WS_O), D, (const bf16*)(WSP + WS_HGOUTT), D, TL, D, D, e); );
    PHASE( ph_layernorm(F, TL, 1, 0, 1, 3); );
    PHASE( EpiConvGate e{(bf16*)(WSP + WS_HG), (bf16*)(WSP + WS_AB), (bf16*)(WSP + WS_GB), (const bf16*)(WSP + WS_CWT) + (size_t)FFH * 4}; run_gemm(F, ABUF, D, (const bf16*)(WSP + WS_F1T1), D, TL, 2 * FFH, D, e); );
    PHASE( ph_convfix(F, TL, 1); );
    PHASE( EpiResid e{out_(F), (float*)(WSP + WS_XC), MODP + 1 * 3 * 6144 + 5 * 1024, 1, 0, nullptr}; run_gemm(F, (const bf16*)(WSP + WS_HG), FFH, (const bf16*)(WSP + WS_F2T1), FFH, TL, D, FFH, e); );
    PHASE( ph_layernorm(F, TL, 1, 1, -1, 0); );
#undef PHASE
#undef IN
#undef SEAM
}

extern "C" void kernel_launch(void* const* d_in, const int* in_sizes, int n_in, void* d_out, int out_size, void* d_ws, size_t ws_size, hipStream_t stream) {
    static int grid = 0;
    if (grid == 0) {
        if (n_in != 31 || out_size != TL * D || ws_size < WS_END) { fprintf(stderr, "kernel_launch: unexpected shapes n_in %d out %d ws %zu\n", n_in, out_size, ws_size); grid = -1; return; }
        int dev = 0, cus = 0;
        if (hipGetDevice(&dev) != hipSuccess || hipDeviceGetAttribute(&cus, hipDeviceAttributeMultiprocessorCount, dev) != hipSuccess) { grid = -1; return; }
        if (hipFuncSetAttribute((const void*)mk_fwd, hipFuncAttributeMaxDynamicSharedMemorySize, LDS_BYTES) != hipSuccess) { fprintf(stderr, "kernel_launch: hipFuncSetAttribute failed\n"); grid = -1; return; }
        int per_cu = 0;
        if (hipOccupancyMaxActiveBlocksPerMultiprocessor(&per_cu, (const void*)mk_fwd, NWAVES * 64, LDS_BYTES) != hipSuccess || per_cu < 1) fprintf(stderr, "kernel_launch: occupancy query says %d\n", per_cu);
        (void)hipGetLastError();
        grid = cus;
    }
    if (grid < 0) return;
    if (hipMemsetAsync((char*)d_ws + WS_CTL, 0, CTL_ZERO_BYTES, stream) != hipSuccess) return;
    Args a{};
    for (int i = 0; i < 31; ++i) a.in[i] = (const float*)d_in[i];
    a.out = (float*)d_out; a.ws = (unsigned char*)d_ws;
#ifndef MK_ONE_LAUNCH
#define MK_ONE_LAUNCH 1
#endif
    if (MK_ONE_LAUNCH) { a.ph_lo = 0; a.ph_hi = NPH; hipLaunchKernelGGL(mk_fwd, dim3(grid), dim3(NWAVES * 64), LDS_BYTES, stream, a); }
    else for (int p = 0; p < NPH; ++p) { a.ph_lo = p; a.ph_hi = p + 1; hipLaunchKernelGGL(mk_fwd, dim3(grid), dim3(NWAVES * 64), LDS_BYTES, stream, a); }
}
```

```cpp
#include <hip/hip_runtime.h>
#include <cstdio>
#include <cstdint>
#include <cmath>
namespace pg8 {
#define PG8_LAS __attribute__((address_space(3)))
typedef unsigned short bf16_t;
typedef short bf16x8 __attribute__((ext_vector_type(8)));
typedef float f32x4 __attribute__((ext_vector_type(4)));
typedef unsigned u32x4 __attribute__((ext_vector_type(4)));
constexpr int BM = 256, BK = 64, HALF = 128, HTB = HALF * BK * 2  , STAGE_BYTES = 8 * HTB, NXCD = 8, WGM = 8;

__host__ __device__ __forceinline__ int lds_byte(int r, int c) { const int st = (r >> 4) * 2 + (c >> 5), rr = r & 15, cc = c & 31, ob = rr * 64 + cc * 2; return st * 1024 + (ob ^ (((ob >> 9) & 1) << 5)); }
__host__ __device__ __forceinline__ void stage_rc(int b, int& R, int& C) { const int st = b / 1024, sb = b % 1024, swz = sb ^ (((sb >> 9) & 1) << 5); R = (st >> 1) * 16 + swz / 64; C = (st & 1) * 32 + (swz % 64) / 2; }
__host__ __device__ __forceinline__ int perm32(int rho) { const int n = rho >> 4, i = rho & 15; return 8 * (i >> 2) + 4 * n + (i & 3); }

struct Unit { int pm, pn; };
struct Gemm { const bf16_t* A; const bf16_t* Bt; int M, N, K, lda, ldb; };

struct StaticOrder {
    int nM, nN, nwg, G, c;
    __host__ __device__ void init(int M, int N, int G_, int c_) { nM = M / BM; nN = N / BM; nwg = nM * nN; G = G_; c = c_; }
    __host__ __device__ bool next(int i, Unit& u) const {
        const long L = (long)i * G + c; if (L >= nwg) return false;
        int wgid = (int)L; { const int q = nwg / NXCD, r = nwg % NXCD, xcd = wgid % NXCD, off = wgid / NXCD; wgid = (xcd < r ? xcd * (q + 1) : r * (q + 1) + (xcd - r) * q) + off; }
        const int nig = WGM * nN, gid = wgid / nig, fm = gid * WGM, gsz = (nM - fm) < WGM ? (nM - fm) : WGM;
        u.pm = fm + ((wgid % nig) % gsz); u.pn = (wgid % nig) / gsz; return true;
    }
    __device__ __forceinline__ void a_ready(const Unit&) const {}
    __device__ __forceinline__ void done(const Unit&) const {}
};

__device__ __forceinline__ unsigned cvt_pk_bf16(float lo, float hi) { unsigned r; asm volatile("v_cvt_pk_bf16_f32 %0, %1, %2" : "=v"(r) : "v"(lo), "v"(hi)); return r; }
template <class F> struct Epi8 {
    static constexpr bool PERM = true, AFTER_DRAIN = false; F f;
    __device__ __forceinline__ void operator()(const f32x4 (&acc)[2][2][4][2], const Unit& u, int wr, int wc, int fr, int fq) const {
        const int row0 = u.pm * BM + wr * 64 + fr, col0 = u.pn * BM + wc * 32 + 8 * fq;
#pragma unroll
        for (int ai = 0; ai < 2; ++ai)
#pragma unroll
            for (int m = 0; m < 4; ++m)
#pragma unroll
                for (int bj = 0; bj < 2; ++bj) { f(row0 + ai * HALF + m * 16, col0 + bj * HALF, acc[ai][bj][m][0], acc[ai][bj][m][1]); }
    }
};
template <class F> struct Epi4 {
    static constexpr bool PERM = false, AFTER_DRAIN = false; F f;
    __device__ __forceinline__ void operator()(const f32x4 (&acc)[2][2][4][2], const Unit& u, int wr, int wc, int fr, int fq) const {
        const int row0 = u.pm * BM + wr * 64 + fr, col0 = u.pn * BM + wc * 32 + 4 * fq;
#pragma unroll
        for (int ai = 0; ai < 2; ++ai)
#pragma unroll
            for (int m = 0; m < 4; ++m)
#pragma unroll
                for (int bj = 0; bj < 2; ++bj)
#pragma unroll
                    for (int n = 0; n < 2; ++n) { f(row0 + ai * HALF + m * 16, col0 + bj * HALF + n * 16, acc[ai][bj][m][n]); }
    }
};
template <class Epi, class Sched, bool ALIGN_EPI = false, bool SP2 = false>
__device__ __forceinline__ void gemm_phase(PG8_LAS unsigned char* lds, const Gemm g, const Sched& S, const Epi& E) {
    int tid_ = threadIdx.x; asm volatile("" : "+v"(tid_));
    const int tid = tid_, wid = __builtin_amdgcn_readfirstlane(tid >> 6), lane = tid & 63, wr = wid >> 2, wc = wid & 3, fr = lane & 15, fq = lane >> 4;
    const int K = g.K, nt = K / BK;
    unsigned voffA[2], voffB[2];
#pragma unroll
    for (int i = 0; i < 2; ++i) { int R, C; stage_rc(tid * 16 + i * 8192, R, C); const int Rb = Epi::PERM ? ((R & ~31) + perm32(R & 31)) : R;
        voffA[i] = (unsigned)(R * g.lda + C) * 2u; voffB[i] = (unsigned)(Rb * g.ldb + C) * 2u; }
    const size_t kstep = (size_t)(BK * 2);
    const size_t hstepA = (size_t)HALF * g.lda * 2, hstepB = (size_t)HALF * g.ldb * 2;
    const size_t tstepA = 2 * hstepA, tstepB = 2 * hstepB;
    const unsigned ldsw = (unsigned)wid * 1024u;
    const int aoff = lds_byte(wr * 64 + fr, fq * 8), boff = lds_byte(wc * 32 + fr, fq * 8);
#define PG8_SA(b, h) (((b) * 2 + (h)) * HTB)
#define PG8_SB(b, h) ((4 + (b) * 2 + (h)) * HTB)
#define PG8_STAGE(bufoff, gbase, voff) do { _Pragma("unroll") for (int _i = 0; _i < 2; ++_i) \
        __builtin_amdgcn_global_load_lds((const unsigned*)((const char*)(gbase) + (voff)[_i]), (PG8_LAS unsigned*)(lds + (bufoff) + ldsw + _i * 8192), 16, 0, 0); } while (0)
#define PG8_LDA(dst, b, h) do { _Pragma("unroll") for (int m = 0; m < 4; ++m) _Pragma("unroll") for (int k = 0; k < 2; ++k) dst[m][k] = *(const PG8_LAS bf16x8*)(lds + PG8_SA(b, h) + aoff + m * 2048 + k * 1024); } while (0)
#define PG8_LDB(dst, b, h) do { _Pragma("unroll") for (int n = 0; n < 2; ++n) _Pragma("unroll") for (int k = 0; k < 2; ++k) dst[n][k] = *(const PG8_LAS bf16x8*)(lds + PG8_SB(b, h) + boff + n * 2048 + k * 1024); } while (0)
#define PG8_MMA(ai, bj, At, Bt) do { __builtin_amdgcn_s_setprio(1); _Pragma("unroll") for (int m = 0; m < 4; ++m) _Pragma("unroll") for (int n = 0; n < 2; ++n) _Pragma("unroll") for (int k = 0; k < 2; ++k) \
        acc[ai][bj][m][n] = __builtin_amdgcn_mfma_f32_16x16x32_bf16(Bt[n][k], At[m][k], acc[ai][bj][m][n], 0, 0, 0); __builtin_amdgcn_s_setprio(0); } while (0)
#define PG8_WAIT_V(n) asm volatile("s_waitcnt vmcnt(" #n ")" ::: "memory")
#define PG8_WAIT_L(n) asm volatile("s_waitcnt lgkmcnt(" #n ")" ::: "memory")
#define PG8_BAR __builtin_amdgcn_s_barrier()
#define PG8_SCHED __builtin_amdgcn_sched_barrier(0)
    Unit cur, nxt; int ui = 0;
    if (!S.next(0, cur)) return;
    f32x4 acc[2][2][4][2];
#pragma unroll
    for (int a = 0; a < 2; ++a)
#pragma unroll
        for (int b = 0; b < 2; ++b)
#pragma unroll
            for (int m = 0; m < 4; ++m)
#pragma unroll
                for (int n = 0; n < 2; ++n) acc[a][b][m][n] = (f32x4){0.f, 0.f, 0.f, 0.f};
    bf16x8 At[4][2], B0[2][2], B1[2][2];
    const char* cA = (const char*)g.A + (size_t)cur.pm * tstepA; const char* cB = (const char*)g.Bt + (size_t)cur.pn * tstepB;
    S.a_ready(cur);
    if constexpr (SP2) {
        PG8_STAGE(PG8_SB(0, 0), cB, voffB); PG8_STAGE(PG8_SB(0, 1), cB + hstepB, voffB); PG8_STAGE(PG8_SA(0, 0), cA, voffA); PG8_STAGE(PG8_SA(0, 1), cA + hstepA, voffA);
        if (wr == 1) PG8_BAR;
        PG8_WAIT_V(2); PG8_BAR;
        PG8_STAGE(PG8_SB(1, 0), cB + kstep, voffB); PG8_STAGE(PG8_SA(1, 0), cA + kstep, voffA); PG8_STAGE(PG8_SB(1, 1), cB + hstepB + kstep, voffB);
        PG8_WAIT_V(6); PG8_BAR;
    } else {
        PG8_STAGE(PG8_SB(0, 0), cB, voffB); PG8_STAGE(PG8_SA(0, 0), cA, voffA); PG8_STAGE(PG8_SB(0, 1), cB + hstepB, voffB); PG8_STAGE(PG8_SA(0, 1), cA + hstepA, voffA);
        if (wr == 1) PG8_BAR;
        PG8_WAIT_V(4); PG8_BAR;
        PG8_STAGE(PG8_SB(1, 0), cB + kstep, voffB); PG8_STAGE(PG8_SA(1, 0), cA + kstep, voffA); PG8_STAGE(PG8_SB(1, 1), cB + hstepB + kstep, voffB);
        PG8_WAIT_V(6); PG8_BAR;
    }
    for (;;) {
        const bool has_next = S.next(ui + 1, nxt);
        const char* nA = has_next ? (const char*)g.A + (size_t)nxt.pm * tstepA : cA; const char* nB = has_next ? (const char*)g.Bt + (size_t)nxt.pn * tstepB : cB;
#pragma unroll 1
        for (int t = 0; t < nt; t += 2) {
            const bool last = (t == nt - 2);
            const char* a1 = cA + (size_t)(t + 1) * kstep;
            const char* a2 = last ? nA : cA + (size_t)(t + 2) * kstep; const char* b2 = last ? nB : cB + (size_t)(t + 2) * kstep;
            const char* a3 = a2 + kstep; const char* b3 = b2 + kstep;
            if (last && has_next) S.a_ready(nxt);
            if constexpr (SP2) {
            PG8_LDB(B0, 0, 0); PG8_LDB(B1, 0, 1); PG8_SCHED; PG8_LDA(At, 0, 0); PG8_STAGE(PG8_SA(1, 1), a1 + hstepA, voffA);
            PG8_WAIT_V(8); PG8_WAIT_L(0); PG8_BAR; PG8_MMA(0, 0, At, B0); PG8_MMA(0, 1, At, B1); PG8_BAR; PG8_SCHED;
            PG8_LDA(At, 0, 1); PG8_STAGE(PG8_SB(0, 0), b2, voffB); PG8_STAGE(PG8_SB(0, 1), b2 + hstepB, voffB); PG8_STAGE(PG8_SA(0, 0), a2, voffA);
            PG8_WAIT_V(8); PG8_WAIT_L(0); PG8_BAR; PG8_MMA(1, 0, At, B0); PG8_MMA(1, 1, At, B1); PG8_BAR; PG8_SCHED;
            PG8_LDB(B0, 1, 0); PG8_LDB(B1, 1, 1); PG8_SCHED; PG8_LDA(At, 1, 0); PG8_STAGE(PG8_SA(0, 1), a2 + hstepA, voffA);
            PG8_WAIT_V(8); PG8_WAIT_L(0); PG8_BAR; PG8_MMA(0, 0, At, B0); PG8_MMA(0, 1, At, B1); PG8_BAR; PG8_SCHED;
            PG8_LDA(At, 1, 1); PG8_STAGE(PG8_SB(1, 0), b3, voffB); PG8_STAGE(PG8_SB(1, 1), b3 + hstepB, voffB); PG8_STAGE(PG8_SA(1, 0), a3, voffA);
            PG8_WAIT_V(8); PG8_WAIT_L(0); PG8_BAR; PG8_MMA(1, 0, At, B0); PG8_MMA(1, 1, At, B1); PG8_BAR; PG8_SCHED;
            } else {
            PG8_LDB(B0, 0, 0); PG8_SCHED; PG8_LDA(At, 0, 0); PG8_STAGE(PG8_SA(1, 1), a1 + hstepA, voffA);
            PG8_WAIT_L(8); PG8_BAR; PG8_WAIT_L(0); PG8_MMA(0, 0, At, B0); PG8_BAR; PG8_SCHED;
            PG8_LDB(B1, 0, 1); PG8_STAGE(PG8_SB(0, 0), b2, voffB);
            PG8_BAR; PG8_WAIT_L(0); PG8_MMA(0, 1, At, B1); PG8_BAR;
            PG8_LDA(At, 0, 1); PG8_STAGE(PG8_SA(0, 0), a2, voffA);
            PG8_BAR; PG8_WAIT_L(0); PG8_MMA(1, 0, At, B0); PG8_BAR; PG8_SCHED;
            PG8_STAGE(PG8_SB(0, 1), b2 + hstepB, voffB);
            PG8_WAIT_V(6); PG8_BAR; PG8_MMA(1, 1, At, B1); PG8_BAR;
            PG8_LDB(B0, 1, 0); PG8_SCHED; PG8_LDA(At, 1, 0); PG8_STAGE(PG8_SA(0, 1), a2 + hstepA, voffA);
            PG8_WAIT_L(8); PG8_BAR; PG8_WAIT_L(0); PG8_MMA(0, 0, At, B0); PG8_BAR; PG8_SCHED;
            PG8_LDB(B1, 1, 1); PG8_STAGE(PG8_SB(1, 0), b3, voffB);
            PG8_BAR; PG8_WAIT_L(0); PG8_MMA(0, 1, At, B1); PG8_BAR;
            PG8_LDA(At, 1, 1); PG8_STAGE(PG8_SA(1, 0), a3, voffA);
            PG8_BAR; PG8_WAIT_L(0); PG8_MMA(1, 0, At, B0); PG8_BAR; PG8_SCHED;
            PG8_STAGE(PG8_SB(1, 1), b3 + hstepB, voffB);
            PG8_WAIT_V(6); PG8_BAR; PG8_MMA(1, 1, At, B1); PG8_BAR;
            }
        }
        if constexpr (ALIGN_EPI) { if (wr == 0) PG8_BAR; }
        if constexpr (!Epi::AFTER_DRAIN) { E(acc, cur, wr, wc, fr, fq); S.done(cur); }
        if (!has_next) break;
#pragma unroll
        for (int a = 0; a < 2; ++a)
#pragma unroll
            for (int b = 0; b < 2; ++b)
#pragma unroll
                for (int m = 0; m < 4; ++m)
#pragma unroll
                    for (int n = 0; n < 2; ++n) acc[a][b][m][n] = (f32x4){0.f, 0.f, 0.f, 0.f};
        cur = nxt; cA = nA; cB = nB; ++ui;
        if constexpr (ALIGN_EPI) { if (wr == 1) PG8_BAR; }
    }
    PG8_WAIT_V(0);
    if constexpr (!ALIGN_EPI) { if (wr == 0) PG8_BAR; }
    PG8_BAR;
    if constexpr (Epi::AFTER_DRAIN) { E.fused(acc, cur, wr, wc, fr, fq, lds, wid, lane); S.done(cur); }
#undef PG8_SA
#undef PG8_SB
#undef PG8_STAGE
#undef PG8_LDA
#undef PG8_LDB
#undef PG8_MMA
#undef PG8_WAIT_V
#undef PG8_WAIT_L
#undef PG8_BAR
#undef PG8_SCHED
}
}

constexpr int NWAVES = 8;
constexpr int D = 1024, BATCH = 2, SEQ = 8192, CTXL = 256;
constexpr int TL = BATCH * SEQ;
constexpr int TC = BATCH * CTXL;
constexpr int TT = TL + TC;
constexpr int EVEN_IN = 1184, EVEN_IN_PAD = 1280, CQKV_LD = 672;
constexpr int FFH = 2816, FFG = 1408;
constexpr int TQK = SEQ + CTXL;
constexpr float NORM_EPS = 1e-6f;
constexpr float DN_ALPHA = 1.41421356237f;
constexpr float QSCALE = 0.10206207261596577f * 1.4426950408889634f;

constexpr size_t MiB = 1u << 20;
constexpr size_t WS_CTL = 0, CTL_ZERO_BYTES = 1 * MiB;
constexpr size_t WS_MOD = 1 * MiB;
constexpr size_t WS_LBV = WS_MOD + 160 * 1024;
constexpr size_t WS_ROPE = WS_LBV + 16 * 1024;
constexpr size_t WS_CWT = WS_ROPE + 16 * 1024;
constexpr size_t WS_HGINT = 2 * MiB, WS_HGOUTT = 12 * MiB, WS_F1T1 = 14 * MiB, WS_F2T1 = 25 * MiB;
constexpr size_t WS_A = 31 * MiB;
constexpr size_t WS_XC = 64 * MiB;
constexpr size_t WS_WIN0 = 66 * MiB, WS_WUQ = WS_WIN0 + 2560 * 1024, WS_WUKV = WS_WUQ + 768 * 1024, WS_WGLU = WS_WUKV + 512 * 1024,
                 WS_WOUT0 = WS_WGLU + 512 * 1024, WS_F1T0 = 72 * MiB + 512 * 1024, WS_F2T0 = WS_F1T0 + 11 * MiB;
constexpr size_t WS_R = 89 * MiB;
constexpr size_t WS_CQKV = WS_R;
constexpr size_t WS_UG = WS_R + 22 * MiB;
constexpr size_t WS_WF = WS_R + 39 * MiB;
constexpr size_t WS_WC = WS_R + 64 * MiB;
constexpr size_t WS_TOEP = WS_R + 80 * MiB;
constexpr size_t WS_T0 = WS_R + 82 * MiB;
constexpr size_t WS_A64 = WS_T0 + 128 * 1024;
constexpr size_t WS_FIN = WS_R + 83 * MiB;
constexpr size_t WS_SIN = WS_R + 92 * MiB;
constexpr size_t WS_Z = WS_R + 97 * MiB;
constexpr size_t WS_MIX = WS_R + 134 * MiB;
constexpr size_t WS_QB = WS_R + 39 * MiB;
constexpr size_t WS_KB = 31 * MiB;
constexpr size_t WS_VB = WS_R + 114 * MiB;
constexpr size_t WS_AB = WS_R;
constexpr size_t WS_GB = WS_R + 8 * MiB;
constexpr size_t WS_H = WS_R;
constexpr size_t WS_HG = WS_R + 16 * MiB;
constexpr size_t WS_QFFI = 66 * MiB;
constexpr size_t WS_G = 198 * MiB;
constexpr size_t WS_O = WS_A;
constexpr size_t WS_SLAB1 = WS_R;
constexpr size_t WS_SLAB2 = WS_R + 110 * MiB;
constexpr size_t WS_END = 256 * MiB;
static_assert(WS_F2T0 + 5632 * 1024 <= WS_R, "layer-0 weights");
static_assert(WS_MIX + (size_t)TT * 1024 * 2 <= WS_END && WS_G + (size_t)TT * 1024 * 2 <= WS_END && WS_HG + (size_t)TT * FFH * 2 <= WS_END, "ws map");
static_assert(WS_WF + 16 * MiB <= WS_WC && WS_QB + (size_t)16 * TQK * 96 * 2 <= WS_WC && WS_WC + 16 * MiB <= WS_TOEP && WS_TOEP + 2 * MiB <= WS_T0 && WS_T0 + MiB <= WS_FIN && WS_FIN + (size_t)32 * 264 * 256 * 4 <= WS_SIN && WS_SIN + (size_t)32 * 264 * 256 * 2 <= WS_Z && WS_Z + (size_t)TT * 512 * 2 <= WS_VB && WS_VB + (size_t)16 * TQK * 64 * 2 <= WS_MIX && WS_KB + (size_t)16 * TQK * 96 * 2 <= WS_XC, "ws map 2");

constexpr int CW_BAR = 4096;
constexpr int RING_OFF = 0, RING_BYTES = 131072;
constexpr int LDSCTL_OFF = RING_BYTES, MISC_OFF = LDSCTL_OFF + 320;
constexpr int LDS_BYTES = 147456;

#define GAS __attribute__((address_space(1)))
#define LAS __attribute__((address_space(3)))
typedef unsigned short bf16;
typedef unsigned v4u __attribute__((ext_vector_type(4)));
typedef unsigned v2u __attribute__((ext_vector_type(2)));
typedef float f32x4 __attribute__((ext_vector_type(4)));
typedef GAS unsigned gu32;
#define RLX_AGENT __ATOMIC_RELAXED, __HIP_MEMORY_SCOPE_AGENT
#define LDS_WAIT() asm volatile("s_waitcnt lgkmcnt(0)" ::: "memory")
__device__ __forceinline__ unsigned f2bf(float f) { unsigned u = __builtin_bit_cast(unsigned, f); return (u + 0x7fffu + ((u >> 16) & 1u)) >> 16; }
__device__ __forceinline__ unsigned pk2(float lo, float hi) { return f2bf(lo) | (f2bf(hi) << 16); }
__device__ __forceinline__ float bflo(unsigned w) { return __builtin_bit_cast(float, w << 16); }
__device__ __forceinline__ float bfhi(unsigned w) { return __builtin_bit_cast(float, w & 0xffff0000u); }
__device__ __forceinline__ float bf2f(bf16 h) { return __builtin_bit_cast(float, (unsigned)h << 16); }
__device__ __forceinline__ void unpack8(v4u w, float* x) { x[0] = bflo(w.x); x[1] = bfhi(w.x); x[2] = bflo(w.y); x[3] = bfhi(w.y); x[4] = bflo(w.z); x[5] = bfhi(w.z); x[6] = bflo(w.w); x[7] = bfhi(w.w); }
__device__ __forceinline__ v4u pack8(const float* x) { v4u w; w.x = pk2(x[0], x[1]); w.y = pk2(x[2], x[3]); w.z = pk2(x[4], x[5]); w.w = pk2(x[6], x[7]); return w; }
__device__ __forceinline__ float sigmoidf_(float x) { return 1.0f / (1.0f + __expf(-x)); }
__device__ __forceinline__ float siluf_(float x) { return x / (1.0f + __expf(-x)); }
__device__ __forceinline__ float gelu_tanh(float x) { const float u = 0.7978845608028654f * (x + 0.044715f * x * x * x); return 0.5f * x * (1.0f + tanhf(u)); }
__device__ __forceinline__ float wave_sum(float v) {
#pragma unroll
    for (int o = 1; o < 64; o <<= 1) v += __shfl_xor(v, o);
    return v;
}

#define XB_TMO      128
#define XB_XCNT(j)  (256  + 64 * (j))
#define XB_XSUB(j)  (1280 + 64 * (j))
#define XB_XGEN(j)  (2304 + 64 * (j))
#define XB_TOP      3328
#define XB_TOPGEN   3392
#define XCD_BAR_WORDS 3456
#define XB_SPIN_CAP (1u << 18)

__device__ __forceinline__ unsigned xb_ld(unsigned* p)              { return __hip_atomic_load(p, __ATOMIC_RELAXED, __HIP_MEMORY_SCOPE_AGENT); }
__device__ __forceinline__ unsigned xb_add(unsigned* p, unsigned v) { return __hip_atomic_fetch_add(p, v, __ATOMIC_RELAXED, __HIP_MEMORY_SCOPE_AGENT); }
__device__ __forceinline__ unsigned xb_xcc_id() { return (unsigned)__builtin_amdgcn_s_getreg((3 << 11) | 20) & 0xFu; }
#define XB_SPIN(cond, bar) do { unsigned _sp = 0; while (cond) { __builtin_amdgcn_s_sleep(1); \
    if ((++_sp & 255u) == 0u) { if (xb_ld(&(bar)[XB_TMO])) break; if (_sp > XB_SPIN_CAP) { atomicAdd(&(bar)[XB_TMO], 1u); break; } } } } while (0)

struct XcdBarrier {
    unsigned* bar; unsigned x;
    volatile LAS unsigned* st;
};

__device__ __forceinline__ XcdBarrier xcd_barrier_post(unsigned* bar, volatile LAS unsigned* st) {
    XcdBarrier b; b.bar = bar; b.x = xb_xcc_id(); b.st = st;
    if (threadIdx.x == 0) (void)xb_add(&bar[XB_XCNT(b.x)], 1u);
    return b;
}
__device__ __forceinline__ void xcd_barrier_complete(unsigned* bar, unsigned x, unsigned& nloc, unsigned& nx) {
    const unsigned G = gridDim.x * gridDim.y * gridDim.z;
    unsigned sum, cnt, mine, sp = 0u;
    for (;;) {
        sum = 0u; cnt = 0u; mine = 0u;
#pragma unroll
        for (unsigned j = 0; j < 16; ++j) { const unsigned c = xb_ld(&bar[XB_XCNT(j)]); sum += c; cnt += (c > 0u) ? 1u : 0u; mine = (j == x) ? c : mine; }
        if (sum == G) break;
        __builtin_amdgcn_s_sleep(1);
        if ((++sp & 255u) == 0u) { if (xb_ld(&bar[XB_TMO])) break; if (sp > XB_SPIN_CAP) { atomicAdd(&bar[XB_TMO], 1u); break; } }
    }
    nloc = mine > 0u ? mine : 1u; nx = cnt > 0u ? cnt : 1u;
}

__device__ __forceinline__ void xcd_barrier(const XcdBarrier& b) {
    asm volatile("s_waitcnt vmcnt(0)" ::: "memory");
    __syncthreads();
    if (threadIdx.x == 0) {
        unsigned* bar = b.bar;
        __builtin_amdgcn_s_waitcnt(0);
        unsigned nloc = b.st[0], nx = b.st[1];
        if (nloc == 0u) { xcd_barrier_complete(bar, b.x, nloc, nx); b.st[0] = nloc; b.st[1] = nx; }
        const unsigned old = xb_add(&bar[XB_XSUB(b.x)], 1u);
        const unsigned gen = old / nloc;
        if (old + 1u == (gen + 1u) * nloc) {
            __builtin_amdgcn_fence(__ATOMIC_RELEASE, "agent");
            asm volatile("s_waitcnt vmcnt(0)" ::: "memory");
            const unsigned og = xb_add(&bar[XB_TOP], 1u);
            const unsigned tg = og / nx;
            if (og + 1u == (tg + 1u) * nx) xb_add(&bar[XB_TOPGEN], 1u);
            else XB_SPIN(xb_ld(&bar[XB_TOPGEN]) == tg, bar);
            __builtin_amdgcn_fence(__ATOMIC_ACQUIRE, "agent");
            xb_add(&bar[XB_XGEN(b.x)], 1u);
            asm volatile("s_waitcnt vmcnt(0)" ::: "memory");
        } else {
            XB_SPIN(xb_ld(&bar[XB_XGEN(b.x)]) == gen, bar);
            __builtin_amdgcn_fence(__ATOMIC_ACQUIRE, "agent");
            asm volatile("s_waitcnt vmcnt(0)" ::: "memory");
        }
    }
    __syncthreads();
}


struct Frame {
    LAS unsigned char* lds;
    int tid, lane, wave, vcu, G;
};
constexpr int PTR_OFF = LDSCTL_OFF + 1024;
__device__ __forceinline__ const float* inp(const Frame& F, int i) {
    const LAS unsigned* p = (const LAS unsigned*)(F.lds + PTR_OFF) + 2 * i;
    const unsigned lo = __builtin_amdgcn_readfirstlane(p[0]), hi = __builtin_amdgcn_readfirstlane(p[1]);
    return (const float*)(const GAS float*)(((unsigned long long)hi << 32) | lo);
}
__device__ __forceinline__ unsigned char* ws_(const Frame& F) { return (unsigned char*)inp(F, 31); }
__device__ __forceinline__ float* out_(const Frame& F) { return (float*)inp(F, 32); }
__device__ __forceinline__ int modrow_of(int m) { return m < TL ? (m >> 13) : 2; }
__device__ __forceinline__ const float* xin_row(const Frame& F, int m) { return m < TL ? inp(F, 0) + (size_t)m * D : inp(F, 2) + (size_t)(m - TL) * D; }
__device__ __forceinline__ float* xres_row(const Frame& F, int m) { return m < TL ? out_(F) + (size_t)m * D : (float*)(ws_(F) + WS_XC) + (size_t)(m - TL) * D; }
__device__ __forceinline__ const float* modvec(const Frame& F, int layer, int mr, int part) { return (const float*)(ws_(F) + WS_MOD) + (size_t)(layer * 3 + mr) * 6144 + part * 1024; }

__device__ __forceinline__ void tr_item(const float* W, int ldw, int k0, int n0, bf16* dst, int dpitch, LAS float* scr, int lane) {
    { f32x4 v[8];
#pragma unroll
      for (int i = 0; i < 8; ++i) v[i] = *(const GAS f32x4*)(W + (size_t)(k0 + 8 * i + (lane >> 3)) * ldw + n0 + 4 * (lane & 7));
#pragma unroll
      for (int i = 0; i < 8; ++i) { LAS float* d = scr + (8 * i + (lane >> 3)) * 33 + 4 * (lane & 7); d[0] = v[i].x; d[1] = v[i].y; d[2] = v[i].z; d[3] = v[i].w; } }
    LDS_WAIT(); asm volatile("" ::: "memory");
    const int c = lane & 7;
#pragma unroll
    for (int j = 0; j < 4; ++j) { const int n = (lane >> 3) + 8 * j; const LAS float* s = scr + (8 * c) * 33 + n;
        v4u o; o.x = pk2(s[0 * 33], s[1 * 33]); o.y = pk2(s[2 * 33], s[3 * 33]); o.z = pk2(s[4 * 33], s[5 * 33]); o.w = pk2(s[6 * 33], s[7 * 33]);
        *(GAS v4u*)(dst + (size_t)n * dpitch + 8 * c) = o; }
    LDS_WAIT(); asm volatile("" ::: "memory");
}
__device__ __forceinline__ bool tr_plain(int& r, const float* W, int K, int N, bf16* WT, LAS float* scr, int lane) {
    const int nblk = N / 32, cnt = (K / 64) * nblk;
    if (r >= cnt) { r -= cnt; return false; }
    const int kb = r / nblk, nb = r % nblk;
    tr_item(W, N, 64 * kb, 32 * nb, WT + (size_t)(32 * nb) * K + 64 * kb, K, scr, lane); return true;
}
__device__ __forceinline__ bool tr_ffn1(int& r, const float* W, bf16* WT, LAS float* scr, int lane) {
    const int nblk = 5632 / 32, cnt = 16 * nblk;
    if (r >= cnt) { r -= cnt; return false; }
    const int kb = r / nblk, nb = r % nblk, n0 = 32 * nb, half = n0 / FFH, j = n0 % FFH, drow = (j >> 7) * 256 + half * 128 + (j & 127);
    tr_item(W, 5632, 64 * kb, n0, WT + (size_t)drow * 1024 + 64 * kb, 1024, scr, lane); return true;
}
#ifndef DUP_GEMV
#define DUP_GEMV 1
#endif
#ifndef DUP_TR
#define DUP_TR 1
#endif
#ifndef DUP_S5T
#define DUP_S5T 1
#endif
__device__ __forceinline__ void p0_prologue(Frame& F) {
    {
        LAS float* sv = (LAS float*)(F.lds + RING_OFF);
        LAS float* red = sv + 3072;
        for (int i = F.tid; i < 3072; i += 512) { const int r = i >> 10, k = i & 1023; const float cv = (r < 2) ? inp(F, 1)[r * 1024 + k] : inp(F, 3)[k]; sv[i] = cv / (1.0f + __expf(-cv)); }
        __syncthreads();
        for (int rep_ = 0; rep_ < DUP_GEMV; ++rep_)
        for (int it = blockIdx.x; it < 192; it += F.G) {
            const int layer = it / 96, cg = it % 96, col = cg * 64 + F.lane, k0 = F.wave * 128;
            const float* w = inp(F, 4) + ((size_t)layer * 1024 + k0) * 6144 + col;
            float a0 = 0.f, a1 = 0.f, a2 = 0.f;
#pragma unroll 16
            for (int k = 0; k < 128; ++k) { const float wv = w[(size_t)k * 6144]; a0 += sv[k0 + k] * wv; a1 += sv[1024 + k0 + k] * wv; a2 += sv[2048 + k0 + k] * wv; }
            red[(F.wave * 3 + 0) * 64 + F.lane] = a0; red[(F.wave * 3 + 1) * 64 + F.lane] = a1; red[(F.wave * 3 + 2) * 64 + F.lane] = a2;
            __syncthreads();
            if (F.tid < 192) { const int r = F.tid >> 6, l = F.tid & 63; float s = inp(F, 5)[layer * 6144 + cg * 64 + l];
#pragma unroll
                for (int wv = 0; wv < 8; ++wv) s += red[(wv * 3 + r) * 64 + l];
                ((float*)(ws_(F) + WS_MOD))[(size_t)(layer * 3 + r) * 6144 + cg * 64 + l] = s; }
            __syncthreads();
        }
        __syncthreads();
    }
    {
        const int gt = F.vcu * 512 + F.tid, NT = F.G * 512;
        for (int i = gt; i < 2048; i += NT) { const int dir = i >> 10, c = i & 1023; const float l0 = inp(F, 28)[(0 * 2 + dir) * 1024 + c], l1 = inp(F, 28)[(1 * 2 + dir) * 1024 + c];
            ((float*)(ws_(F) + WS_LBV))[i] = 1.0f / (1.0f + expf(l0 - l1)); }
        for (int i = gt; i < 1024; i += NT) { const int pos = i >> 3, f = i & 7; const float inv = powf(10000.0f, -(float)f / 8.0f); const float ang = (float)pos * inv;
            ((float*)(ws_(F) + WS_ROPE))[2 * i] = cosf(ang); ((float*)(ws_(F) + WS_ROPE))[2 * i + 1] = sinf(ang); }
        for (int i = gt; i < 2 * FFH; i += NT) { const int layer = i / FFH, j = i % FFH; const float* cwp = inp(F, 9) + (size_t)layer * 3 * FFH + j;
            v2u w; w.x = pk2(cwp[0], cwp[FFH]); w.y = pk2(cwp[2 * FFH], inp(F, 10)[(size_t)layer * FFH + j]); *(GAS v2u*)((bf16*)(ws_(F) + WS_CWT) + (size_t)i * 4) = w; }
        for (int i = gt; i < 96 * 1024 / 8; i += NT) ((GAS v4u*)(ws_(F) + WS_WIN0 + (size_t)1184 * 1024 * 2))[i] = (v4u){0u, 0u, 0u, 0u};
    }
    {
        LAS float* scr = (LAS float*)(F.lds + RING_OFF + F.wave * 16384);
        const int gw = F.vcu * NWAVES + F.wave, NGW = F.G * NWAVES;
        constexpr int NITEMS = 592 + 144 + 128 + 128 + 512 + 2 * 2816 + 2 * 1408 + 2560 + 512;
        for (int rep_ = 0; rep_ < DUP_TR; ++rep_)
        for (int it = gw; it < NITEMS; it += NGW) {
            int r = it;
            if (tr_plain(r, inp(F, 12), 1024, 1184, (bf16*)(ws_(F) + WS_WIN0), scr, F.lane)) continue;
            if (tr_plain(r, inp(F, 14), 384, 768, (bf16*)(ws_(F) + WS_WUQ), scr, F.lane)) continue;
            if (tr_plain(r, inp(F, 16), 256, 1024, (bf16*)(ws_(F) + WS_WUKV), scr, F.lane)) continue;
            if (tr_plain(r, inp(F, 25), 512, 512, (bf16*)(ws_(F) + WS_WGLU), scr, F.lane)) continue;
            if (tr_plain(r, inp(F, 26), 1024, 1024, (bf16*)(ws_(F) + WS_WOUT0), scr, F.lane)) continue;
            if (tr_ffn1(r, inp(F, 8), (bf16*)(ws_(F) + WS_F1T0), scr, F.lane)) continue;
            if (tr_ffn1(r, inp(F, 8) + (size_t)1024 * 5632, (bf16*)(ws_(F) + WS_F1T1), scr, F.lane)) continue;
            if (tr_plain(r, inp(F, 11), 2816, 1024, (bf16*)(ws_(F) + WS_F2T0), scr, F.lane)) continue;
            if (tr_plain(r, inp(F, 11) + (size_t)2816 * 1024, 2816, 1024, (bf16*)(ws_(F) + WS_F2T1), scr, F.lane)) continue;
            if (tr_plain(r, inp(F, 27), 1024, 5120, (bf16*)(ws_(F) + WS_HGINT), scr, F.lane)) continue;
            tr_plain(r, inp(F, 30), 1024, 1024, (bf16*)(ws_(F) + WS_HGOUTT), scr, F.lane);
        }
    }
}

__device__ __forceinline__ void store_mod_bf16(const Frame& F, const f32x4 (&v)[4], int m, int layer, int part_sh) {
    const int mr = modrow_of(m);
    const GAS f32x4* sh = (const GAS f32x4*)modvec(F, layer, mr, part_sh) + F.lane;
    const GAS f32x4* sc = (const GAS f32x4*)modvec(F, layer, mr, part_sh + 1) + F.lane;
    GAS v2u* o = (GAS v2u*)((bf16*)(ws_(F) + WS_A) + (size_t)m * D) + F.lane;
#pragma unroll
    for (int j = 0; j < 4; ++j) { const f32x4 s = sc[64 * j], h = sh[64 * j]; const f32x4 y = v[j] * (s + 1.0f) + h; v2u w; w.x = pk2(y.x, y.y); w.y = pk2(y.z, y.w); o[64 * j] = w; }
}
__device__ __forceinline__ void ph_init_rows(Frame& F) {
    const int gw = F.vcu * NWAVES + F.wave, NGW = F.G * NWAVES;
    for (int m = gw; m < TT; m += NGW) {
        const GAS f32x4* xr = (const GAS f32x4*)xin_row(F, m) + F.lane; GAS f32x4* xo = (GAS f32x4*)xres_row(F, m) + F.lane;
        f32x4 v[4];
#pragma unroll
        for (int j = 0; j < 4; ++j) { v[j] = xr[64 * j]; xo[64 * j] = (m >= TL) ? v[j] * DN_ALPHA : v[j]; }
        store_mod_bf16(F, v, m, 0, 0);
    }
}
__device__ __forceinline__ void ph_layernorm(Frame& F, int nrows, int layer, int which, int next_layer, int next_part_sh, const float* slabs = nullptr, int nslabs = 0) {
    const int gw = F.vcu * NWAVES + F.wave, NGW = F.G * NWAVES;
    const GAS f32x4* gg = (const GAS f32x4*)(inp(F, 6) + (size_t)(layer * 2 + which) * D) + F.lane;
    const GAS f32x4* bb = (const GAS f32x4*)(inp(F, 7) + (size_t)(layer * 2 + which) * D) + F.lane;
    for (int m0 = gw; m0 < nrows; m0 += 2 * NGW) {
        const int m1 = m0 + NGW; const bool has1 = m1 < nrows; const int m1c = has1 ? m1 : m0;
        GAS f32x4* xr0 = (GAS f32x4*)xres_row(F, m0) + F.lane; GAS f32x4* xr1 = (GAS f32x4*)xres_row(F, m1c) + F.lane;
        f32x4 v[4], w[4]; float s0 = 0.f, s1 = 0.f;
#pragma unroll
        for (int j = 0; j < 4; ++j) { v[j] = xr0[64 * j]; w[j] = xr1[64 * j]; }
        if (nslabs > 0 && m1c >= TL) {
            for (int sl = 0; sl < nslabs; ++sl) { const GAS f32x4* p1 = (const GAS f32x4*)(slabs + ((size_t)sl * TC + (m1c - TL)) * D) + F.lane;
#pragma unroll
                for (int j = 0; j < 4; ++j) w[j] += p1[64 * j];
                if (m0 >= TL) { const GAS f32x4* p0 = (const GAS f32x4*)(slabs + ((size_t)sl * TC + (m0 - TL)) * D) + F.lane;
#pragma unroll
                    for (int j = 0; j < 4; ++j) v[j] += p0[64 * j]; } }
        }
#pragma unroll
        for (int j = 0; j < 4; ++j) { s0 += (v[j].x + v[j].y) + (v[j].z + v[j].w); s1 += (w[j].x + w[j].y) + (w[j].z + w[j].w); }
        const float mean0 = wave_sum(s0) * (1.f / D), mean1 = wave_sum(s1) * (1.f / D); float q0 = 0.f, q1 = 0.f;
#pragma unroll
        for (int j = 0; j < 4; ++j) { v[j] = v[j] - mean0; w[j] = w[j] - mean1; q0 += (v[j].x * v[j].x + v[j].y * v[j].y) + (v[j].z * v[j].z + v[j].w * v[j].w); q1 += (w[j].x * w[j].x + w[j].y * w[j].y) + (w[j].z * w[j].z + w[j].w * w[j].w); }
        const float r0 = 1.f / sqrtf(wave_sum(q0) * (1.f / D) + NORM_EPS), r1 = 1.f / sqrtf(wave_sum(q1) * (1.f / D) + NORM_EPS);
#pragma unroll
        for (int j = 0; j < 4; ++j) { const f32x4 g4 = gg[64 * j], b4 = bb[64 * j]; v[j] = v[j] * r0 * g4 + b4; w[j] = w[j] * r1 * g4 + b4; xr0[64 * j] = (m0 >= TL) ? v[j] * DN_ALPHA : v[j]; if (has1) xr1[64 * j] = (m1 >= TL) ? w[j] * DN_ALPHA : w[j]; }
        if (next_layer >= 0) { store_mod_bf16(F, v, m0, next_layer, next_part_sh); if (has1) store_mod_bf16(F, w, m1, next_layer, next_part_sh); }
    }
}
__device__ __forceinline__ void ph_mla_norm(Frame& F) {
    const int gw = F.vcu * NWAVES + F.wave, NGW = F.G * NWAVES;
    bf16* CQ = (bf16*)(ws_(F) + WS_CQKV); bf16* Kb = (bf16*)(ws_(F) + WS_KB); const float* rope = (const float*)(ws_(F) + WS_ROPE);
    for (int m = gw; m < TT; m += NGW) {
        bf16* row = CQ + (size_t)m * CQKV_LD;
        {
            float x[8]; float ss = 0.f; const bool act = F.lane < 48;
            if (act) { unpack8(*(const GAS v4u*)(row + 8 * F.lane), x);
#pragma unroll
                for (int j = 0; j < 8; ++j) ss += x[j] * x[j]; }
            const float sc = 1.f / sqrtf(wave_sum(ss) * (1.f / 384.f) + NORM_EPS);
            if (act) {
#pragma unroll
                for (int j = 0; j < 8; ++j) x[j] = x[j] * sc * inp(F, 13)[8 * F.lane + j];
                *(GAS v4u*)(row + 8 * F.lane) = pack8(x); }
        }
        {
            float x[8]; float ss = 0.f; const bool act = F.lane < 32;
            if (act) { unpack8(*(const GAS v4u*)(row + 384 + 8 * F.lane), x);
#pragma unroll
                for (int j = 0; j < 8; ++j) ss += x[j] * x[j]; }
            const float sc = 1.f / sqrtf(wave_sum(ss) * (1.f / 256.f) + NORM_EPS);
            if (act) {
#pragma unroll
                for (int j = 0; j < 8; ++j) x[j] = x[j] * sc * inp(F, 15)[8 * F.lane + j];
                *(GAS v4u*)(row + 384 + 8 * F.lane) = pack8(x); }
        }
        {
            const bool isctx = m >= TL; const int b = isctx ? ((m - TL) >> 8) : (m >> 13), t = isctx ? ((m - TL) & 255) : (m & 8191), tk = isctx ? t : CTXL + t;
            const int h = F.lane >> 3, i0 = (F.lane & 7) * 4;
            const v2u w = *(const GAS v2u*)(row + 640 + i0);
            float x[4] = {bflo(w.x), bfhi(w.x), bflo(w.y), bfhi(w.y)}, o[4];
#pragma unroll
            for (int j = 0; j < 4; ++j) { const float p = __shfl_xor(x[j], 2); const int idx = i0 + j, a = idx >> 4, half = (idx >> 3) & 1, f = idx & 7, pos = a ? (t & 63) : (t >> 6);
                const float cs = rope[2 * (pos * 8 + f)], sn = rope[2 * (pos * 8 + f) + 1];
                o[j] = isctx ? x[j] : (half ? x[j] * cs + p * sn : x[j] * cs - p * sn); }
            v2u ow; ow.x = pk2(o[0], o[1]); ow.y = pk2(o[2], o[3]);
            *(GAS v2u*)(Kb + ((size_t)(b * 8 + h) * TQK + tk) * 96 + 64 + i0) = ow;
        }
    }
}
__device__ __forceinline__ void ph_convfix(Frame& F, int nrows, int layer) {
    const int gw = F.vcu * NWAVES + F.wave, NGW = F.G * NWAVES;
    const bf16* AB = (const bf16*)(ws_(F) + WS_AB); const bf16* GB = (const bf16*)(ws_(F) + WS_GB); bf16* HG = (bf16*)(ws_(F) + WS_HG);
    const float* cw = inp(F, 9) + (size_t)layer * 3 * FFH; const float* cb = inp(F, 10) + (size_t)layer * FFH;
    const int nedge = (nrows / 64) * 2;
    for (int er = gw; er < nedge; er += NGW) {
        const int g64 = er >> 1, which = er & 1, m = 64 * g64 + (which ? 63 : 0);
        const bool isctx = m >= TL; const int t = isctx ? ((m - TL) & 255) : (m & 8191), len = isctx ? CTXL : SEQ;
        const bool hp = t > 0, hn = t < len - 1;
        const bf16* ac_ = AB + (size_t)(g64 * 4 + (which ? 3 : 0)) * FFH;
        const bf16* ap_ = which ? AB + (size_t)(g64 * 4 + 2) * FFH : AB + (size_t)((g64 - 1) * 4 + 3) * FFH;
        const bf16* an_ = which ? AB + (size_t)((g64 + 1) * 4 + 0) * FFH : AB + (size_t)(g64 * 4 + 1) * FFH;
        const bf16* gt_ = GB + (size_t)(g64 * 2 + which) * FFH;
#pragma unroll
        for (int ci = 0; ci < 6; ++ci) { const int ch = F.lane + 64 * ci; if (ch >= FFH / 8) break;
            const int j0 = 8 * ch; float ac[8], ap[8], an[8], gt[8], o[8];
            unpack8(*(const GAS v4u*)(ac_ + j0), ac); unpack8(*(const GAS v4u*)(gt_ + j0), gt);
            if (hp) unpack8(*(const GAS v4u*)(ap_ + j0), ap); else {
#pragma unroll
                for (int j = 0; j < 8; ++j) ap[j] = 0.f; }
            if (hn) unpack8(*(const GAS v4u*)(an_ + j0), an); else {
#pragma unroll
                for (int j = 0; j < 8; ++j) an[j] = 0.f; }
#pragma unroll
            for (int j = 0; j < 8; ++j) { const float cv = cb[j0 + j] + cw[j0 + j] * ap[j] + cw[FFH + j0 + j] * ac[j] + cw[2 * FFH + j0 + j] * an[j]; o[j] = siluf_(cv) * gt[j]; }
            *(GAS v4u*)(HG + (size_t)m * FFH + j0) = pack8(o);
        }
    }
}
__device__ __forceinline__ void ph_hg_gate(Frame& F) {
    const int gw = F.vcu * NWAVES + F.wave, NGW = F.G * NWAVES;
    bf16* O = (bf16*)(ws_(F) + WS_O); const bf16* G = (const bf16*)(ws_(F) + WS_G);
    const int c0 = 16 * F.lane; float ng[16];
#pragma unroll
    for (int j = 0; j < 16; ++j) ng[j] = inp(F, 29)[(c0 + j) & 127];
    for (int m = gw; m < TL; m += NGW) {
        float o[16], g[16]; unpack8(*(const GAS v4u*)(O + (size_t)m * D + c0), o); unpack8(*(const GAS v4u*)(O + (size_t)m * D + c0 + 8), o + 8);
        unpack8(*(const GAS v4u*)(G + (size_t)m * D + c0), g); unpack8(*(const GAS v4u*)(G + (size_t)m * D + c0 + 8), g + 8);
        float ss = 0.f;
#pragma unroll
        for (int j = 0; j < 16; ++j) ss += o[j] * o[j];
        ss += __shfl_xor(ss, 1); ss += __shfl_xor(ss, 2); ss += __shfl_xor(ss, 4);
        const float sc = 1.f / sqrtf(ss * (1.f / 128.f) + NORM_EPS);
#pragma unroll
        for (int j = 0; j < 16; ++j) o[j] = o[j] * sc * ng[j] * siluf_(g[j]);
        *(GAS v4u*)(O + (size_t)m * D + c0) = pack8(o); *(GAS v4u*)(O + (size_t)m * D + c0 + 8) = pack8(o + 8);
    }
}

typedef short bf16x8_t __attribute__((ext_vector_type(8)));
typedef float f32x16 __attribute__((ext_vector_type(16)));
__device__ __forceinline__ int crow(int r, int hi) { return (r & 3) + 8 * (r >> 2) + 4 * hi; }
constexpr int NCH = TT / 64;
__device__ __forceinline__ void p0_s5_tables(Frame& F) {
    LAS unsigned char* L = F.lds + RING_OFF;
    LAS double* lam = (LAS double*)L;
    LAS float* bb = (LAS float*)(L + 1024);
    LAS float* cc = (LAS float*)(L + 1024 + 8192);
    LAS float* pw = (LAS float*)(L + 1024 + 16384);
    unsigned char* ws = ws_(F);
    for (int item4 = blockIdx.x; item4 < 256; item4 += F.G) {
        const int item = item4 >> 2, part = item4 & 3;
        const int g = item >> 1, d = item & 1;
        __syncthreads();
        if (F.tid < 64) { const int n = F.tid, pi = (d * 32 + g) * 64 + n;
            const double lre = inp(F, 17)[pi], lim = inp(F, 18)[pi], dt = exp((double)inp(F, 19)[d * 32 + g]);
            const double mag = exp(lre * dt), are = mag * cos(lim * dt), aim = mag * sin(lim * dt), den = lre * lre + lim * lim, nr = are - 1.0;
            const double fr = (nr * lre + aim * lim) / den, fi = (aim * lre - nr * lim) / den;
            for (int q = 0; q < 16; ++q) { const double br = inp(F, 20)[(size_t)pi * 16 + q], bi = inp(F, 21)[(size_t)pi * 16 + q];
                bb[(n * 16 + q) * 2] = (float)(fr * br - fi * bi); bb[(n * 16 + q) * 2 + 1] = (float)(fr * bi + fi * br); }
            double pr = 1.0, pim = 0.0;
            for (int e = 0; e <= 64; ++e) { pw[(e * 64 + n) * 2] = (float)pr; pw[(e * 64 + n) * 2 + 1] = (float)pim; const double n_r = pr * are - pim * aim, n_i = pr * aim + pim * are; pr = n_r; pim = n_i; } }
        for (int i = F.tid; i < 1024; i += 512) { const int p = i >> 6, n = i & 63; cc[i * 2] = inp(F, 22)[((size_t)(d * 32 + g) * 16 + p) * 64 + n]; cc[i * 2 + 1] = inp(F, 23)[((size_t)(d * 32 + g) * 16 + p) * 64 + n]; }
        __syncthreads();
        { bf16* WF = (bf16*)(ws + WS_WF) + (size_t)g * 256 * 1024;
          for (int i = part * 4096 + F.tid; i < (part + 1) * 4096; i += 512) { const int row = i >> 7, grp = i & 127, c = row >> 6, n = row & 63, sI = grp >> 1, q0 = (grp & 1) * 8, e = d ? sI : 63 - sI;
              const float pr = pw[(e * 64 + n) * 2], pim = pw[(e * 64 + n) * 2 + 1]; float o[8];
              const LAS f32x4* bq = (const LAS f32x4*)(bb + (n * 16 + q0) * 2);
#pragma unroll
              for (int j4 = 0; j4 < 4; ++j4) { const f32x4 v = bq[j4]; o[2 * j4] = c ? (pr * v.y + pim * v.x) : (pr * v.x - pim * v.y); o[2 * j4 + 1] = c ? (pr * v.w + pim * v.z) : (pr * v.z - pim * v.w); }
              *(GAS v4u*)(WF + (size_t)(d * 128 + row) * 1024 + sI * 16 + q0) = pack8(o); } }
        { bf16* WC = (bf16*)(ws + WS_WC) + (size_t)g * 1024 * 256;
          for (int i = part * 4096 + F.tid; i < (part + 1) * 4096; i += 512) { const int row = i >> 4, grp = i & 15, t = row >> 4, p = row & 15, c = grp >> 3, n0 = (grp & 7) * 8, ex = d ? 64 - t : t + 1; float o[8];
              const LAS f32x4* pq = (const LAS f32x4*)(pw + (ex * 64 + n0) * 2); const LAS f32x4* cq = (const LAS f32x4*)(cc + (p * 64 + n0) * 2);
#pragma unroll
              for (int j4 = 0; j4 < 4; ++j4) { const f32x4 pv = pq[j4], cv = cq[j4];
                  o[2 * j4] = c ? -(cv.x * pv.y + cv.y * pv.x) : (cv.x * pv.x - cv.y * pv.y); o[2 * j4 + 1] = c ? -(cv.z * pv.w + cv.w * pv.z) : (cv.z * pv.z - cv.w * pv.w); }
              *(GAS v4u*)(WC + (size_t)row * 256 + d * 128 + c * 64 + n0) = pack8(o); } }
        { bf16* TP = (bf16*)(ws + WS_TOEP) + (size_t)g * 127 * 256; float* T0 = (float*)(ws + WS_T0) + (size_t)(g * 2 + d) * 256;
          for (int i = part * 256 + F.tid; i < (part + 1) * 256; i += 512) { const int tau = i >> 4, p = i & 15; float acc[16];
#pragma unroll
              for (int q = 0; q < 16; ++q) acc[q] = 0.f;
              for (int n = 0; n < 64; ++n) { const float pr = pw[(tau * 64 + n) * 2], pim = pw[(tau * 64 + n) * 2 + 1], cr = cc[(p * 64 + n) * 2], ci = cc[(p * 64 + n) * 2 + 1];
                  const float tr = cr * pr - ci * pim, ti = cr * pim + ci * pr;
                  const LAS f32x4* bq = (const LAS f32x4*)(bb + n * 32);
#pragma unroll
                  for (int q4 = 0; q4 < 8; ++q4) { const f32x4 v = bq[q4]; acc[2 * q4] += tr * v.x - ti * v.y; acc[2 * q4 + 1] += tr * v.z - ti * v.w; } }
              if (tau == 0) {
#pragma unroll
                  for (int q = 0; q < 16; ++q) T0[p * 16 + q] = acc[q]; }
              else { bf16* o = TP + (size_t)(d ? 63 - tau : 63 + tau) * 256 + p * 16; *(GAS v4u*)o = pack8(acc); *(GAS v4u*)(o + 8) = pack8(acc + 8); } } }
        if (part == 0 && F.tid < 64) { float* A64 = (float*)(ws + WS_A64) + (size_t)((g * 2 + d) * 64 + F.tid) * 2; A64[0] = pw[(64 * 64 + F.tid) * 2]; A64[1] = pw[(64 * 64 + F.tid) * 2 + 1]; }
    }
    __syncthreads();
}
__device__ __forceinline__ void ph_s5_finals(Frame& F) {
    const int lane = F.lane, r32 = lane & 31, hh = lane >> 5, wave = F.wave;
    unsigned char* ws = ws_(F);
    for (int u = blockIdx.x; u < 288; u += F.G) {
        const int g = u / 9, nb = u % 9; int chunk = nb * 32 + r32; const bool valid = chunk < NCH; if (!valid) chunk = NCH - 1;
        const bf16* ub = (const bf16*)(ws + WS_UG) + ((size_t)g * TT + (size_t)chunk * 64) * 16 + 8 * hh;
        const bf16* wf = (const bf16*)(ws + WS_WF) + ((size_t)(g * 256 + 32 * wave + r32)) * 1024 + 8 * hh;
        f32x16 acc;
#pragma unroll
        for (int r = 0; r < 16; ++r) acc[r] = 0.f;
#pragma unroll 16
        for (int sI = 0; sI < 64; ++sI) { const bf16x8_t a = *(const GAS bf16x8_t*)(wf + 16 * sI), b = *(const GAS bf16x8_t*)(ub + 16 * sI); acc = __builtin_amdgcn_mfma_f32_32x32x16_bf16(a, b, acc, 0, 0, 0); }
        if (valid) { float* fo = (float*)(ws + WS_FIN) + ((size_t)g * NCH + chunk) * 256 + 32 * wave + 4 * hh;
#pragma unroll
            for (int k = 0; k < 4; ++k) *(GAS f32x4*)(fo + 8 * k) = (f32x4){acc[4 * k], acc[4 * k + 1], acc[4 * k + 2], acc[4 * k + 3]}; }
    }
}
__device__ __forceinline__ int s5_chunk_of(int step, int d, int b) { return step < 4 ? 256 + 4 * b + (d ? 3 - step : step) : 128 * b + (d ? 127 - (step - 4) : step - 4); }
__device__ __forceinline__ void ph_s5_carry(Frame& F) {
    if (F.wave >= 3) return;
    unsigned char* ws = ws_(F);
    for (int item = ((int)F.G - 1 - (int)blockIdx.x) * 3 + F.wave; item < 128; item += 3 * F.G) {
        const int g = item >> 2, d = (item >> 1) & 1, b = item & 1, n = F.lane;
        const float a_r = ((const float*)(ws + WS_A64))[((g * 2 + d) * 64 + n) * 2], a_i = ((const float*)(ws + WS_A64))[((g * 2 + d) * 64 + n) * 2 + 1];
        const float* Fb = (const float*)(ws + WS_FIN) + (size_t)g * NCH * 256 + d * 128 + n; bf16* Sb = (bf16*)(ws + WS_SIN) + (size_t)g * NCH * 256 + d * 128 + n;
        float sr = 0.f, si = 0.f;
        for (int s0 = 0; s0 < 132; s0 += 12) {
            float fr[12], fi[12];
#pragma unroll
            for (int j = 0; j < 12; ++j) { const int c = s5_chunk_of(s0 + j, d, b); fr[j] = Fb[(size_t)c * 256]; fi[j] = Fb[(size_t)c * 256 + 64]; }
#pragma unroll
            for (int j = 0; j < 12; ++j) { const int c = s5_chunk_of(s0 + j, d, b); Sb[(size_t)c * 256] = (bf16)f2bf(sr); Sb[(size_t)c * 256 + 64] = (bf16)f2bf(si);
                const float nr = a_r * sr - a_i * si + fr[j], ni = a_r * si + a_i * sr + fi[j]; sr = nr; si = ni; }
        }
    }
}
constexpr int TP_PITCH = 48;
__device__ __forceinline__ void ph_s5_out(Frame& F) {
    LAS unsigned char* L = F.lds + RING_OFF;
    const int lane = F.lane, r32 = lane & 31, hh = lane >> 5, wave = F.wave, tid = F.tid;
    unsigned char* ws = ws_(F);
    for (int u = blockIdx.x; u < 288; u += F.G) {
        const int g = u / 9, nb = u % 9; int chunk = nb * 32 + r32; const bool valid = chunk < NCH; if (!valid) chunk = NCH - 1;
        __syncthreads();
        { const GAS v4u* tp = (const GAS v4u*)((const bf16*)(ws + WS_TOEP) + (size_t)g * 127 * 256); const float* t0 = (const float*)(ws + WS_T0) + (size_t)g * 512;
          for (int c = tid; c < 127 * 32; c += 512) { const int di = c >> 5, p = (c >> 1) & 15, half = c & 1; v4u v;
              if (di == 63) { float o[8];
#pragma unroll
                  for (int j = 0; j < 8; ++j) o[j] = t0[p * 16 + half * 8 + j] + t0[256 + p * 16 + half * 8 + j];
                  v = pack8(o); }
              else v = tp[c];
              *(LAS v4u*)(L + (di * 16 + p) * TP_PITCH + half * 16) = v; } }
        __syncthreads();
        const bf16* ub = (const bf16*)(ws + WS_UG) + ((size_t)g * TT + (size_t)chunk * 64) * 16 + 8 * hh;
        f32x16 acc[4];
#pragma unroll
        for (int i = 0; i < 4; ++i)
#pragma unroll
            for (int r = 0; r < 16; ++r) acc[i][r] = 0.f;
        const LAS unsigned char* tl = L + ((63 + 2 * wave + (r32 >> 4)) * 16 + (r32 & 15)) * TP_PITCH + hh * 16;
#pragma unroll 1
        for (int s0 = 0; s0 < 64; s0 += 16) {
            bf16x8_t bq[16];
#pragma unroll
            for (int e = 0; e < 16; ++e) bq[e] = *(const GAS bf16x8_t*)(ub + 16 * (s0 + e));
#pragma unroll
            for (int e = 0; e < 16; ++e) { const int sI = s0 + e; const bf16x8_t b = bq[e];
#pragma unroll
            for (int i = 0; i < 4; ++i) { const bf16x8_t a = *(const LAS bf16x8_t*)(tl + (16 * i - sI) * 16 * TP_PITCH); acc[i] = __builtin_amdgcn_mfma_f32_32x32x16_bf16(a, b, acc[i], 0, 0, 0); }
            }
        }
        { const bf16* sb = (const bf16*)(ws + WS_SIN) + ((size_t)g * NCH + chunk) * 256 + 8 * hh;
          const bf16* wc = (const bf16*)(ws + WS_WC) + ((size_t)g * 1024 + 32 * wave + r32) * 256 + 8 * hh;
#pragma unroll 4
          for (int kk = 0; kk < 16; ++kk) {
              const bf16x8_t b = *(const GAS bf16x8_t*)(sb + 16 * kk);
#pragma unroll
              for (int i = 0; i < 4; ++i) { const bf16x8_t a = *(const GAS bf16x8_t*)(wc + (size_t)(256 * i) * 256 + 16 * kk); acc[i] = __builtin_amdgcn_mfma_f32_32x32x16_bf16(a, b, acc[i], 0, 0, 0); }
          } }
        if (valid) {
            const float* dsk = inp(F, 24) + 16 * g;
#pragma unroll
            for (int i = 0; i < 4; ++i)
#pragma unroll
                for (int k = 0; k < 4; ++k) { const int tloc = 2 * (wave + 8 * i) + (k >> 1), p0 = 8 * (k & 1) + 4 * hh; const size_t m = (size_t)chunk * 64 + tloc;
                    const v2u uw = *(const GAS v2u*)((const bf16*)(ws + WS_UG) + ((size_t)g * TT + m) * 16 + p0);
                    const float y0 = gelu_tanh(acc[i][4 * k] + dsk[p0] * bflo(uw.x)), y1 = gelu_tanh(acc[i][4 * k + 1] + dsk[p0 + 1] * bfhi(uw.x));
                    const float y2 = gelu_tanh(acc[i][4 * k + 2] + dsk[p0 + 2] * bflo(uw.y)), y3 = gelu_tanh(acc[i][4 * k + 3] + dsk[p0 + 3] * bfhi(uw.y));
                    v2u zw; zw.x = pk2(y0, y1); zw.y = pk2(y2, y3);
                    *(GAS v2u*)((bf16*)(ws + WS_Z) + m * 512 + 16 * g + p0) = zw; }
        }
    }
}

__device__ __forceinline__ bf16x8_t pack_frag(const f32x16& p, int base) {
    v4u w; w.x = pg8::cvt_pk_bf16(p[base + 0], p[base + 1]); w.y = pg8::cvt_pk_bf16(p[base + 2], p[base + 3]); w.z = pg8::cvt_pk_bf16(p[base + 4], p[base + 5]); w.w = pg8::cvt_pk_bf16(p[base + 6], p[base + 7]);
    return __builtin_bit_cast(bf16x8_t, w);
}
constexpr int AT_KP = 208, AT_VP = 272;
constexpr int AT_KB = 128 * AT_KP, AT_VB = 64 * AT_VP;
constexpr int AT_K0 = 0, AT_V0 = 2 * AT_KB, AT_WS = 2 * AT_KB + 2 * AT_VB;
__device__ __forceinline__ void ph_attn(Frame& F) {
    LAS unsigned char* L = F.lds + RING_OFF;
    const int lane = F.lane, r32 = lane & 31, hi = lane >> 5, wave = F.wave, tid = F.tid;
    volatile LAS float* wsf = (volatile LAS float*)(L + AT_WS) + wave * 32;
    const bf16* Qb = (const bf16*)(ws_(F) + WS_QB); const bf16* Kb = (const bf16*)(ws_(F) + WS_KB); const bf16* Vt = (const bf16*)(ws_(F) + WS_VB);
    bf16* MIX = (bf16*)(ws_(F) + WS_MIX);
    int kl[3], vl[2];
#pragma unroll
    for (int i = 0; i < 3; ++i) { const int c = tid + 512 * i; kl[i] = (c / 12) * AT_KP + (c % 12) * 16; }
#pragma unroll
    for (int i = 0; i < 2; ++i) { const int c = tid + 512 * i; vl[i] = ((c & 511) >> 3) * AT_VP + (c >> 9) * 128 + (c & 7) * 16; }
    for (int it = 0; it < 3; ++it) {
        int u; if (it < 2) u = it * 256 + F.vcu; else { if (F.vcu >= 16) break; u = 512 + F.vcu; }
        int b, h, tq0, NT, m0;
        if (u < 512) { b = u >> 8; h = (u >> 5) & 7; tq0 = (u & 31) * 256; NT = TQK / 128; m0 = b * SEQ + tq0; }
        else { const int uc = u - 512; b = uc >> 3; h = uc & 7; tq0 = SEQ; NT = CTXL / 128; m0 = TL + b * CTXL; }
        const size_t bh = (size_t)(b * 8 + h);
        const GAS v4u* Kg = (const GAS v4u*)(Kb + bh * TQK * 96);
        const GAS v4u* Vg = (const GAS v4u*)(Vt + bh * (TQK / 64) * 4096);
        bf16x8_t qf[6];
        { const bf16* qp = Qb + (bh * TQK + tq0 + wave * 32 + r32) * 96 + hi * 8;
#pragma unroll
          for (int ks = 0; ks < 6; ++ks) qf[ks] = *(const GAS bf16x8_t*)(qp + ks * 16); }
        f32x16 o0, o1;
#pragma unroll
        for (int r = 0; r < 16; ++r) { o0[r] = 0.f; o1[r] = 0.f; }
        float m_run = -1e30f, l_run = 0.f;
        __syncthreads();
        { v4u a[3], v[2];
#pragma unroll
          for (int i = 0; i < 3; ++i) a[i] = Kg[tid + 512 * i];
#pragma unroll
          for (int i = 0; i < 2; ++i) v[i] = Vg[tid + 512 * i];
#pragma unroll
          for (int i = 0; i < 3; ++i) *(LAS v4u*)(L + AT_K0 + kl[i]) = a[i];
#pragma unroll
          for (int i = 0; i < 2; ++i) *(LAS v4u*)(L + AT_V0 + vl[i]) = v[i]; }
        __syncthreads();
        for (int t = 0; t < NT; ++t) {
            const int cur = t & 1, nxt = cur ^ 1; const bool more = (t + 1 < NT);
            v4u na[3], nv[2];
#pragma unroll
            for (int i = 0; i < 3; ++i) na[i] = (v4u){0u, 0u, 0u, 0u};
#pragma unroll
            for (int i = 0; i < 2; ++i) nv[i] = (v4u){0u, 0u, 0u, 0u};
            if (more) {
#pragma unroll
                for (int i = 0; i < 3; ++i) na[i] = Kg[(size_t)(t + 1) * 1536 + tid + 512 * i];
#pragma unroll
                for (int i = 0; i < 2; ++i) nv[i] = Vg[(size_t)(t + 1) * 1024 + tid + 512 * i]; }
            const LAS unsigned char* Kl = L + AT_K0 + cur * AT_KB + r32 * AT_KP + hi * 16;
            const LAS unsigned char* Vl = L + AT_V0 + cur * AT_VB + r32 * AT_VP + hi * 16;
            f32x16 p[4];
#pragma unroll
            for (int kb = 0; kb < 4; ++kb) {
#pragma unroll
                for (int r = 0; r < 16; ++r) p[kb][r] = 0.f;
#pragma unroll
                for (int ks = 0; ks < 6; ++ks) p[kb] = __builtin_amdgcn_mfma_f32_32x32x16_bf16(*(const LAS bf16x8_t*)(Kl + kb * 32 * AT_KP + ks * 32), qf[ks], p[kb], 0, 0, 0);
            }
            float mt = fmaxf(fmaxf(p[0][0], p[1][0]), fmaxf(p[2][0], p[3][0]));
#pragma unroll
            for (int r = 1; r < 16; ++r) mt = fmaxf(mt, fmaxf(fmaxf(p[0][r], p[1][r]), fmaxf(p[2][r], p[3][r])));
            mt = fmaxf(mt, __shfl_xor(mt, 32));
            const bool need = mt > m_run + 8.0f;
            if (__any(need)) {
                const float mn = need ? mt : m_run, alpha = __builtin_amdgcn_exp2f(m_run - mn);
                l_run *= alpha; m_run = mn;
                if (hi == 0) wsf[r32] = alpha;
#pragma unroll
                for (int r = 0; r < 16; ++r) { const float a = wsf[crow(r, hi)]; o0[r] *= a; o1[r] *= a; }
            }
            float sum = 0.f;
#pragma unroll
            for (int kb = 0; kb < 4; ++kb)
#pragma unroll
                for (int r = 0; r < 16; ++r) { p[kb][r] = __builtin_amdgcn_exp2f(p[kb][r] - m_run); sum += p[kb][r]; }
            l_run += sum;
#pragma unroll
            for (int kb = 0; kb < 4; ++kb) {
                const bf16x8_t pa = pack_frag(p[kb], 0), pb = pack_frag(p[kb], 8);
                const LAS unsigned char* vp = Vl + (kb >> 1) * 128 + (kb & 1) * 64;
                o0 = __builtin_amdgcn_mfma_f32_32x32x16_bf16(pa, *(const LAS bf16x8_t*)(vp), o0, 0, 0, 0);
                o0 = __builtin_amdgcn_mfma_f32_32x32x16_bf16(pb, *(const LAS bf16x8_t*)(vp + 32), o0, 0, 0, 0);
                o1 = __builtin_amdgcn_mfma_f32_32x32x16_bf16(pa, *(const LAS bf16x8_t*)(vp + 32 * AT_VP), o1, 0, 0, 0);
                o1 = __builtin_amdgcn_mfma_f32_32x32x16_bf16(pb, *(const LAS bf16x8_t*)(vp + 32 * AT_VP + 32), o1, 0, 0, 0);
            }
            if (more) {
#pragma unroll
                for (int i = 0; i < 3; ++i) *(LAS v4u*)(L + AT_K0 + nxt * AT_KB + kl[i]) = na[i];
#pragma unroll
                for (int i = 0; i < 2; ++i) *(LAS v4u*)(L + AT_V0 + nxt * AT_VB + vl[i]) = nv[i]; }
            __syncthreads();
        }
        l_run += __shfl_xor(l_run, 32);
        if (hi == 0) wsf[r32] = 1.0f / l_run;
#pragma unroll
        for (int r = 0; r < 16; ++r) { const int q = crow(r, hi); const float inv = wsf[q];
            bf16* op = MIX + (size_t)(m0 + wave * 32 + q) * D + h * 64 + r32;
            op[0] = (bf16)f2bf(o0[r] * inv); op[32] = (bf16)f2bf(o1[r] * inv); }
    }
}

constexpr int HG_QT = 0, HG_KT = 17408, HG_KH = 34816, HG_VT = 53248, HG_ST = 71680, HG_DEC = 106496, HG_TOT = 107008;
constexpr int HG_NSC = 17;
constexpr size_t WS_SD = 231 * MiB;
constexpr size_t WS_DECS = WS_SD + 18 * MiB;
static_assert(WS_DECS + 32 * 17 * 128 * 4 <= WS_END, "hgrn ws");
template <bool OUT>
__device__ __forceinline__ void hgrn_pass(Frame& F, int b, int h, int dir, int sc, f32x16 (&st)[2], float& dsum) {
    LAS unsigned char* L = F.lds + RING_OFF;
    unsigned char* ws = ws_(F);
    const int tid = F.tid, lane = F.lane, r32 = lane & 31, hh = lane >> 5, wave = F.wave;
    const int k = tid & 127, tg = tid >> 7;
    const int nch = sc == 0 ? 4 : 8; const size_t rowbase = sc == 0 ? (size_t)TL + b * CTXL : (size_t)b * SEQ + (size_t)(sc - 1) * 512;
    const bf16* QF = (const bf16*)(ws + WS_QFFI);
    const float lb = ((const float*)(ws + WS_LBV))[dir * 1024 + h * 128 + k];
    const int colf = 1024 * (1 + dir) + h * 128 + k, colq = h * 128 + k, colv = 3072 + h * 128 + k;
    const int dvb = wave & 3, jb = wave >> 2;
    bf16 rq[16], rf[16], rv[16];
#define HG_LOAD(ci) do { const int cc_ = dir ? nch - 1 - (ci) : (ci); const int tl0_ = dir ? 63 - 16 * tg : 16 * tg; \
        const GAS bf16* pf_ = (const GAS bf16*)(QF + (rowbase + 64 * cc_ + tl0_) * 4096 + colf); const GAS bf16* pv_ = pf_ + (colv - colf); const GAS bf16* pq_ = pf_ + (colq - colf); const long stp_ = dir ? -4096 : 4096; \
        _Pragma("unroll") for (int jj = 0; jj < 16; ++jj) { rf[jj] = *pf_; rv[jj] = *pv_; if (OUT) rq[jj] = *pq_; pf_ += stp_; pv_ += stp_; pq_ += stp_; asm volatile("" : "+v"(pf_), "+v"(pv_), "+v"(pq_)); } } while (0)
    HG_LOAD(0);
    for (int ci = 0; ci < nch; ++ci) {
        const int cc = dir ? nch - 1 - ci : ci;
        float cum[16], kk[16];
        { float run = 0.f;
#pragma unroll
          for (int jj = 0; jj < 16; ++jj) { const float f = lb + (1.f - lb) * sigmoidf_(bf2f(rf[jj])); run += __log2f(f); cum[jj] = run; kk[jj] = 1.f - f; }
          ((LAS float*)(L + HG_TOT))[tg * 128 + k] = run; }
        __syncthreads();
        { const LAS float* tot = (const LAS float*)(L + HG_TOT) + k; const float t0 = tot[0], t1 = tot[128], t2 = tot[256], t3 = tot[384];
          const float pre = tg == 0 ? 0.f : (tg == 1 ? t0 : (tg == 2 ? t0 + t1 : t0 + t1 + t2)), total = (t0 + t1) + (t2 + t3);
          if (tg == 0) { ((LAS float*)(L + HG_DEC))[k] = __builtin_amdgcn_exp2f(total); dsum += total; }
#define HG_KH(jj) (kk[jj] * __builtin_amdgcn_exp2f(total - (pre + cum[jj])))
#define HG_PKV(a, b_) ((unsigned)rv[a] | ((unsigned)rv[b_] << 16))
          if (OUT) {
#pragma unroll
              for (int jj = 0; jj < 16; ++jj) { const float c = pre + cum[jj]; const int j = 16 * tg + jj;
                  *(LAS bf16*)(L + HG_QT + j * 272 + k * 2) = (bf16)f2bf(bf2f(rq[jj]) * __builtin_amdgcn_exp2f(c)); *(LAS bf16*)(L + HG_KT + j * 272 + k * 2) = (bf16)f2bf(kk[jj] * __builtin_amdgcn_exp2f(-c)); } }
          v4u w0, w1;
          w0.x = pk2(HG_KH(0), HG_KH(1)); w0.y = pk2(HG_KH(2), HG_KH(3)); w0.z = pk2(HG_KH(8), HG_KH(9)); w0.w = pk2(HG_KH(10), HG_KH(11));
          w1.x = pk2(HG_KH(4), HG_KH(5)); w1.y = pk2(HG_KH(6), HG_KH(7)); w1.z = pk2(HG_KH(12), HG_KH(13)); w1.w = pk2(HG_KH(14), HG_KH(15));
          *(LAS v4u*)(L + HG_KH + k * 144 + tg * 32) = w0; *(LAS v4u*)(L + HG_KH + k * 144 + tg * 32 + 16) = w1;
          w0.x = HG_PKV(0, 1); w0.y = HG_PKV(2, 3); w0.z = HG_PKV(8, 9); w0.w = HG_PKV(10, 11);
          w1.x = HG_PKV(4, 5); w1.y = HG_PKV(6, 7); w1.z = HG_PKV(12, 13); w1.w = HG_PKV(14, 15);
          *(LAS v4u*)(L + HG_VT + k * 144 + tg * 32) = w0; *(LAS v4u*)(L + HG_VT + k * 144 + tg * 32 + 16) = w1; }
#undef HG_KH
#undef HG_PKV
        if (ci + 1 < nch) HG_LOAD(ci + 1);
        __syncthreads();
        if (OUT) {
            f32x16 oacc;
#pragma unroll
            for (int r = 0; r < 16; ++r) oacc[r] = 0.f;
            const LAS unsigned char* qrow = L + HG_QT + (32 * jb + r32) * 272 + hh * 16;
            const LAS unsigned char* srow = L + HG_ST + (32 * dvb + r32) * 272 + hh * 16;
            const LAS unsigned char* vrow = L + HG_VT + (32 * dvb + r32) * 144 + hh * 16;
#pragma unroll
            for (int ks = 0; ks < 8; ++ks) oacc = __builtin_amdgcn_mfma_f32_32x32x16_bf16(*(const LAS bf16x8_t*)(qrow + ks * 32), *(const LAS bf16x8_t*)(srow + ks * 32), oacc, 0, 0, 0);
            {
                f32x16 at;
#pragma unroll
                for (int r = 0; r < 16; ++r) at[r] = 0.f;
                const LAS unsigned char* krow = L + HG_KT + r32 * 272 + hh * 16;
#pragma unroll
                for (int ks = 0; ks < 8; ++ks) at = __builtin_amdgcn_mfma_f32_32x32x16_bf16(*(const LAS bf16x8_t*)(krow + ks * 32), *(const LAS bf16x8_t*)(qrow + ks * 32), at, 0, 0, 0);
                if (jb == 0) {
#pragma unroll
                    for (int r = 0; r < 16; ++r) if (crow(r, hh) > r32) at[r] = 0.f; }
                oacc = __builtin_amdgcn_mfma_f32_32x32x16_bf16(pack_frag(at, 0), *(const LAS bf16x8_t*)(vrow + 0), oacc, 0, 0, 0);
                oacc = __builtin_amdgcn_mfma_f32_32x32x16_bf16(pack_frag(at, 8), *(const LAS bf16x8_t*)(vrow + 32), oacc, 0, 0, 0);
            }
            if (jb == 1) {
                f32x16 at;
#pragma unroll
                for (int r = 0; r < 16; ++r) at[r] = 0.f;
                const LAS unsigned char* krow = L + HG_KT + (32 + r32) * 272 + hh * 16;
#pragma unroll
                for (int ks = 0; ks < 8; ++ks) at = __builtin_amdgcn_mfma_f32_32x32x16_bf16(*(const LAS bf16x8_t*)(krow + ks * 32), *(const LAS bf16x8_t*)(qrow + ks * 32), at, 0, 0, 0);
#pragma unroll
                for (int r = 0; r < 16; ++r) if (crow(r, hh) > r32) at[r] = 0.f;
                oacc = __builtin_amdgcn_mfma_f32_32x32x16_bf16(pack_frag(at, 0), *(const LAS bf16x8_t*)(vrow + 64), oacc, 0, 0, 0);
                oacc = __builtin_amdgcn_mfma_f32_32x32x16_bf16(pack_frag(at, 8), *(const LAS bf16x8_t*)(vrow + 96), oacc, 0, 0, 0);
            }
            bf16* O = (bf16*)(ws + WS_O);
#pragma unroll
            for (int r = 0; r < 16; ++r) { const int j = 32 * jb + crow(r, hh), tl = dir ? 63 - j : j;
                bf16* op = O + (rowbase + 64 * cc + tl) * D + h * 128 + 32 * dvb + r32; float ov = oacc[r];
                if (dir) ov += bf2f(*op);
                *op = (bf16)f2bf(ov); }
        }
#pragma unroll
        for (int t = 0; t < 2; ++t) { const int dkb = 2 * (wave >> 2) + t;
#pragma unroll
            for (int q4 = 0; q4 < 4; ++q4) { const f32x4 dd = *(const LAS f32x4*)(L + HG_DEC + (32 * dkb + 8 * q4 + 4 * hh) * 4);
                st[t][4 * q4] *= dd[0]; st[t][4 * q4 + 1] *= dd[1]; st[t][4 * q4 + 2] *= dd[2]; st[t][4 * q4 + 3] *= dd[3]; }
            const LAS unsigned char* arow = L + HG_KH + (32 * dkb + r32) * 144 + hh * 16; const LAS unsigned char* vrow = L + HG_VT + (32 * dvb + r32) * 144 + hh * 16;
#pragma unroll
            for (int ks = 0; ks < 4; ++ks) st[t] = __builtin_amdgcn_mfma_f32_32x32x16_bf16(*(const LAS bf16x8_t*)(arow + ks * 32), *(const LAS bf16x8_t*)(vrow + ks * 32), st[t], 0, 0, 0); }
        __syncthreads();
        if (OUT && ci + 1 < nch) {
#pragma unroll
            for (int t = 0; t < 2; ++t) { const int dkb = 2 * (wave >> 2) + t;
#pragma unroll
                for (int q4 = 0; q4 < 4; ++q4) { v2u w; w.x = pk2(st[t][4 * q4], st[t][4 * q4 + 1]); w.y = pk2(st[t][4 * q4 + 2], st[t][4 * q4 + 3]);
                    *(LAS v2u*)(L + HG_ST + (32 * dvb + r32) * 272 + (32 * dkb + 8 * q4 + 4 * hh) * 2) = w; } }
        }
    }
#undef HG_LOAD
}
__device__ __forceinline__ void ph_hgrn_states(Frame& F) {
    unsigned char* ws = ws_(F);
    for (int item = blockIdx.x; item < 32 * HG_NSC; item += F.G) {
        const int chain = item / HG_NSC, sc = item % HG_NSC, b = chain >> 4, h = (chain >> 1) & 7, dir = chain & 1;
        f32x16 st[2];
#pragma unroll
        for (int t = 0; t < 2; ++t)
#pragma unroll
            for (int r = 0; r < 16; ++r) st[t][r] = 0.f;
        float dsum = 0.f;
        hgrn_pass<false>(F, b, h, dir, sc, st, dsum);
        bf16* sd = (bf16*)(ws + WS_SD) + ((size_t)(chain * HG_NSC + sc) * 8 + F.wave) * 2048 + F.lane;
#pragma unroll
        for (int t = 0; t < 2; ++t)
#pragma unroll
            for (int r = 0; r < 16; ++r) sd[(t * 16 + r) * 64] = (bf16)f2bf(st[t][r]);
        if (F.tid < 128) ((float*)(ws + WS_DECS))[(size_t)(chain * HG_NSC + sc) * 128 + F.tid] = dsum;
    }
}
__device__ __forceinline__ void ph_hgrn_carry(Frame& F) {
    unsigned char* ws = ws_(F);
    const int gt = F.vcu * 512 + F.tid, NT = F.G * 512;
    for (int idx = gt; idx < 32 * 16384; idx += NT) {
        const int chain = idx >> 14, e = idx & 16383, dir = chain & 1;
        const int lane = e & 63, r = (e >> 6) & 15, t = (e >> 10) & 1, wv = e >> 11, dk = 32 * (2 * (wv >> 2) + t) + crow(r, lane >> 5);
        bf16* sd = (bf16*)(ws + WS_SD) + (size_t)chain * HG_NSC * 16384 + e; const float* dl = (const float*)(ws + WS_DECS) + (size_t)chain * HG_NSC * 128 + dk;
        float v[HG_NSC], dd[HG_NSC];
#pragma unroll
        for (int i = 0; i < HG_NSC; ++i) { const int sp = (i == 0) ? 0 : (dir ? 17 - i : i); v[i] = bf2f(sd[(size_t)sp * 16384]); dd[i] = dl[sp * 128]; }
        float S = 0.f;
#pragma unroll
        for (int i = 0; i < HG_NSC; ++i) { const int sp = (i == 0) ? 0 : (dir ? 17 - i : i); sd[(size_t)sp * 16384] = (bf16)f2bf(S); S = __builtin_amdgcn_exp2f(dd[i]) * S + v[i]; }
    }
}
__device__ __forceinline__ void ph_hgrn_out(Frame& F) {
    LAS unsigned char* L = F.lds + RING_OFF;
    unsigned char* ws = ws_(F);
    const int lane = F.lane, r32 = lane & 31, hh = lane >> 5, wave = F.wave, dvb = wave & 3;
    for (int item = blockIdx.x; item < 256; item += F.G) {
        const int b = item >> 7, h = (item >> 4) & 7, Lsc = item & 15, sc = Lsc + 1;
        for (int dir = 0; dir < 2; ++dir) {
            const int chain = (b * 8 + h) * 2 + dir;
            f32x16 st[2];
#pragma unroll
            for (int t = 0; t < 2; ++t)
#pragma unroll
                for (int r = 0; r < 16; ++r) st[t][r] = 0.f;
            { const bf16* sd = (const bf16*)(ws + WS_SD) + ((size_t)(chain * HG_NSC + sc) * 8 + wave) * 2048 + lane;
#pragma unroll
              for (int t = 0; t < 2; ++t)
#pragma unroll
                  for (int r = 0; r < 16; ++r) st[t][r] = bf2f(sd[(t * 16 + r) * 64]); }
            __syncthreads();
#pragma unroll
            for (int t = 0; t < 2; ++t) { const int dkb = 2 * (wave >> 2) + t;
#pragma unroll
                for (int q4 = 0; q4 < 4; ++q4) { v2u w; w.x = pk2(st[t][4 * q4], st[t][4 * q4 + 1]); w.y = pk2(st[t][4 * q4 + 2], st[t][4 * q4 + 3]);
                    *(LAS v2u*)(L + HG_ST + (32 * dvb + r32) * 272 + (32 * dkb + 8 * q4 + 4 * hh) * 2) = w; } }
            float dsum = 0.f;
            hgrn_pass<true>(F, b, h, dir, sc, st, dsum);
            __syncthreads();
        }
    }
}

struct FInProj {
    bf16* cqkv; bf16* ug;
    __device__ __forceinline__ void operator()(int row, int col, f32x4 v0, f32x4 v1) const {
        v4u w; w.x = pg8::cvt_pk_bf16(v0[0], v0[1]); w.y = pg8::cvt_pk_bf16(v0[2], v0[3]); w.z = pg8::cvt_pk_bf16(v1[0], v1[1]); w.w = pg8::cvt_pk_bf16(v1[2], v1[3]);
        if (col < 672) *(GAS v4u*)(cqkv + (size_t)row * CQKV_LD + col) = w;
        else if (col < EVEN_IN) { const int c = col - 672; *(GAS v4u*)(ug + ((size_t)(c >> 4) * TT + row) * 16 + (c & 15)) = w; }
    }
};
struct FBf16 {
    bf16* o; int ld;
    __device__ __forceinline__ void operator()(int row, int col, f32x4 v0, f32x4 v1) const {
        v4u w; w.x = pg8::cvt_pk_bf16(v0[0], v0[1]); w.y = pg8::cvt_pk_bf16(v0[2], v0[3]); w.z = pg8::cvt_pk_bf16(v1[0], v1[1]); w.w = pg8::cvt_pk_bf16(v1[2], v1[3]);
        *(GAS v4u*)(o + (size_t)row * ld + col) = w;
    }
};
struct EpiGlu {
    static constexpr bool PERM = true, AFTER_DRAIN = false;
    const bf16* z; bf16* mix;
    __device__ __forceinline__ void operator()(const pg8::f32x4 (&acc)[2][2][4][2], const pg8::Unit& u, int wr, int wc, int fr, int fq) const {
        const int row0 = u.pm * 256 + wr * 64 + fr, col0 = u.pn * 256 + wc * 32 + 8 * fq;
#pragma unroll
        for (int ai = 0; ai < 2; ++ai) {
            v4u zz[4][2];
#pragma unroll
            for (int m = 0; m < 4; ++m)
#pragma unroll
                for (int bj = 0; bj < 2; ++bj) zz[m][bj] = *(const GAS v4u*)(z + (size_t)(row0 + ai * 128 + m * 16) * 512 + col0 + bj * 128);
#pragma unroll
            for (int m = 0; m < 4; ++m)
#pragma unroll
                for (int bj = 0; bj < 2; ++bj) { float zf[8], o[8]; unpack8(zz[m][bj], zf);
#pragma unroll
                    for (int j = 0; j < 4; ++j) { o[j] = zf[j] * sigmoidf_(acc[ai][bj][m][0][j]); o[4 + j] = zf[4 + j] * sigmoidf_(acc[ai][bj][m][1][j]); }
                    *(GAS v4u*)(mix + (size_t)(row0 + ai * 128 + m * 16) * D + 512 + col0 + bj * 128) = pack8(o); }
        }
    }
};
struct FQ {
    bf16* qb; const float* rope;
    __device__ __forceinline__ void operator()(int row, int col, f32x4 v0, f32x4 v1) const {
        float x[8] = {v0[0], v0[1], v0[2], v0[3], v1[0], v1[1], v1[2], v1[3]}, p[8];
#pragma unroll
        for (int j = 0; j < 8; ++j) p[j] = __shfl_xor(x[j], 16);
        const bool isctx = row >= TL; const int b = isctx ? ((row - TL) >> 8) : (row >> 13), t = isctx ? ((row - TL) & 255) : (row & 8191), tq = isctx ? SEQ + t : t;
        const int h = col / 96, d = col - h * 96;
        if (d >= 64 && !isctx) { const int idx = d - 64, a = idx >> 4, half = (idx >> 3) & 1, pos = a ? (t & 63) : (t >> 6);
#pragma unroll
            for (int f = 0; f < 8; ++f) { const float cs = rope[2 * (pos * 8 + f)], sn = rope[2 * (pos * 8 + f) + 1]; x[f] = half ? x[f] * cs + p[f] * sn : x[f] * cs - p[f] * sn; } }
#pragma unroll
        for (int j = 0; j < 8; ++j) x[j] *= QSCALE;
        *(GAS v4u*)(qb + ((size_t)(b * 8 + h) * TQK + tq) * 96 + d) = pack8(x);
        asm volatile("" ::: "memory");
    }
};
struct FKV {
    bf16* kb; bf16* vb;
    __device__ __forceinline__ void operator()(int row, int col, f32x4 v0, f32x4 v1) const {
        v4u w; w.x = pg8::cvt_pk_bf16(v0[0], v0[1]); w.y = pg8::cvt_pk_bf16(v0[2], v0[3]); w.z = pg8::cvt_pk_bf16(v1[0], v1[1]); w.w = pg8::cvt_pk_bf16(v1[2], v1[3]);
        const bool isctx = row >= TL; const int b = isctx ? ((row - TL) >> 8) : (row >> 13), t = isctx ? ((row - TL) & 255) : (row & 8191), tk = isctx ? t : CTXL + t;
        const int h = col >> 7, e = col & 127;
        if (e < 64) *(GAS v4u*)(kb + ((size_t)(b * 8 + h) * TQK + tk) * 96 + e) = w;
        else { const int kk = tk & 63, pos = (kk & 48) | (kk & 3) | ((kk & 4) << 1) | ((kk & 8) >> 1);
            bf16* p = vb + (((size_t)(b * 8 + h) * (TQK / 64) + (tk >> 6)) * 64 + (e - 64)) * 64 + pos;
            p[0] = (bf16)(w.x & 0xffffu); p[64] = (bf16)(w.x >> 16); p[128] = (bf16)(w.y & 0xffffu); p[192] = (bf16)(w.y >> 16);
            p[256] = (bf16)(w.z & 0xffffu); p[320] = (bf16)(w.z >> 16); p[384] = (bf16)(w.w & 0xffffu); p[448] = (bf16)(w.w >> 16); }
    }
};
struct EpiResid {
    static constexpr bool PERM = false, AFTER_DRAIN = false;
    float* xl; float* xc; const float* gate; int first; int row_off; float* slab;
    __device__ __forceinline__ void operator()(const pg8::f32x4 (&acc)[2][2][4][2], const pg8::Unit& u, int wr, int wc, int fr, int fq) const {
        const int trow = u.pm * 256 + row_off, col0 = u.pn * 256 + wc * 32 + 4 * fq;
        if (slab) {
            GAS float* sb = (GAS float*)slab + (size_t)(trow - TL + wr * 64 + fr) * D + col0; const GAS float* gq = (const GAS float*)gate + (size_t)2 * 6144 + col0;
            f32x4 g2[2][2];
#pragma unroll
            for (int bj = 0; bj < 2; ++bj)
#pragma unroll
                for (int n = 0; n < 2; ++n) g2[bj][n] = *(const GAS f32x4*)(gq + bj * 128 + n * 16);
#pragma unroll
            for (int ai = 0; ai < 2; ++ai)
#pragma unroll
                for (int m = 0; m < 4; ++m)
#pragma unroll
                    for (int bj = 0; bj < 2; ++bj)
#pragma unroll
                        for (int n = 0; n < 2; ++n) *(GAS f32x4*)(sb + (size_t)(ai * 128 + m * 16) * D + bj * 128 + n * 16) = g2[bj][n] * acc[ai][bj][m][n];
            return;
        }
        const bool lat = trow < TL;
        GAS float* xb = (GAS float*)(lat ? xl + (size_t)trow * D : xc + (size_t)(trow - TL) * D) + (size_t)(wr * 64 + fr) * D + col0;
        const GAS float* gp = (const GAS float*)gate + (size_t)modrow_of(trow) * 6144 + col0;
        f32x4 gv[2][2];
#pragma unroll
        for (int bj = 0; bj < 2; ++bj)
#pragma unroll
            for (int n = 0; n < 2; ++n) gv[bj][n] = *(const GAS f32x4*)(gp + bj * 128 + n * 16);
        const float a0 = (first && lat) ? DN_ALPHA : 1.0f;
#pragma unroll
        for (int ai = 0; ai < 2; ++ai) {
            f32x4 xo[4][2][2];
#pragma unroll
            for (int m = 0; m < 4; ++m)
#pragma unroll
                for (int bj = 0; bj < 2; ++bj)
#pragma unroll
                    for (int n = 0; n < 2; ++n) xo[m][bj][n] = *(const GAS f32x4*)(xb + (size_t)(ai * 128 + m * 16) * D + bj * 128 + n * 16);
#pragma unroll
            for (int m = 0; m < 4; ++m)
#pragma unroll
                for (int bj = 0; bj < 2; ++bj)
#pragma unroll
                    for (int n = 0; n < 2; ++n) *(GAS f32x4*)(xb + (size_t)(ai * 128 + m * 16) * D + bj * 128 + n * 16) = xo[m][bj][n] * a0 + gv[bj][n] * acc[ai][bj][m][n];
            __builtin_amdgcn_sched_barrier(0);
        }
    }
};
struct FHgIn {
    bf16* qffi; bf16* g;
    __device__ __forceinline__ void operator()(int row, int col, f32x4 v0, f32x4 v1) const {
        v4u w; w.x = pg8::cvt_pk_bf16(v0[0], v0[1]); w.y = pg8::cvt_pk_bf16(v0[2], v0[3]); w.z = pg8::cvt_pk_bf16(v1[0], v1[1]); w.w = pg8::cvt_pk_bf16(v1[2], v1[3]);
        if (col < 4096) *(GAS v4u*)(qffi + (size_t)row * 4096 + col) = w; else *(GAS v4u*)(g + (size_t)row * D + (col - 4096)) = w;
    }
};
struct EpiConvGate {
    static constexpr bool PERM = true, AFTER_DRAIN = false;
    bf16* hg; bf16* ab; bf16* gb; const bf16* cwt;
    __device__ __forceinline__ void operator()(const pg8::f32x4 (&acc)[2][2][4][2], const pg8::Unit& u, int wr, int wc, int fr, int fq) const {
        const int hc0 = 128 * u.pn + 32 * wc + 8 * fq;
        v4u wq[4];
#pragma unroll
        for (int i = 0; i < 4; ++i) wq[i] = *(const GAS v4u*)(cwt + (size_t)(hc0 + 2 * i) * 4);
#pragma unroll
        for (int ai = 0; ai < 2; ++ai) {
            const int rowbase = u.pm * 256 + 128 * ai + 64 * wr, g64 = rowbase >> 6;
#pragma unroll
            for (int n = 0; n < 2; ++n) {
                const int hc = hc0 + 4 * n;
                float out[4][4];
#pragma unroll
                for (int e = 0; e < 4; ++e) { const int c = 4 * n + e; const unsigned pw0 = (c & 1) ? wq[c >> 1].z : wq[c >> 1].x, pw1 = (c & 1) ? wq[c >> 1].w : wq[c >> 1].y;
                    const float w0 = bflo(pw0), w1 = bfhi(pw0), w2 = bflo(pw1), b0 = bfhi(pw1);
                    float a[4], up[4], dn[4];
#pragma unroll
                    for (int m = 0; m < 4; ++m) { a[m] = acc[ai][0][m][n][e];
                        up[m] = __builtin_bit_cast(float, __builtin_amdgcn_mov_dpp(__builtin_bit_cast(int, a[m]), 0x121, 0xf, 0xf, false));
                        dn[m] = __builtin_bit_cast(float, __builtin_amdgcn_mov_dpp(__builtin_bit_cast(int, a[m]), 0x12f, 0xf, 0xf, false)); }
#pragma unroll
                    for (int m = 0; m < 4; ++m) { const float prev = fr > 0 ? up[m] : (m > 0 ? up[m > 0 ? m - 1 : 0] : 0.f), next = fr < 15 ? dn[m] : (m < 3 ? dn[m < 3 ? m + 1 : 3] : 0.f);
                        const float cv = b0 + w0 * prev + w1 * a[m] + w2 * next; out[m][e] = siluf_(cv) * acc[ai][1][m][n][e]; } }
#pragma unroll
                for (int m = 0; m < 4; ++m) { const int r64 = 16 * m + fr, row = rowbase + r64;
                    if (r64 != 0 && r64 != 63) { v2u w; w.x = pk2(out[m][0], out[m][1]); w.y = pk2(out[m][2], out[m][3]); *(GAS v2u*)(hg + (size_t)row * FFH + hc) = w; }
                    if (r64 <= 1 || r64 >= 62) { const int slot = r64 <= 1 ? r64 : r64 - 60; const f32x4 ra = acc[ai][0][m][n];
                        v2u w; w.x = pk2(ra[0], ra[1]); w.y = pk2(ra[2], ra[3]); *(GAS v2u*)(ab + (size_t)(g64 * 4 + slot) * FFH + hc) = w;
                        if (r64 == 0 || r64 == 63) { const f32x4 rg = acc[ai][1][m][n]; v2u wg; wg.x = pk2(rg[0], rg[1]); wg.y = pk2(rg[2], rg[3]); *(GAS v2u*)(gb + (size_t)(g64 * 2 + (r64 == 63 ? 1 : 0)) * FFH + hc) = wg; } }
                }
                __builtin_amdgcn_sched_barrier(0);
            }
        }
    }
};
template <class E> __device__ __forceinline__ void run_gemm_off(Frame& F, const bf16* A, int lda, const bf16* Bt, int ldb, int M, int N, int K, const E& e, int boff) {
    pg8::Gemm g{A, Bt, M, N, K, lda, ldb}; pg8::StaticOrder S; S.init(M, N, F.G, (int)((blockIdx.x + F.G - boff) % F.G));
    pg8::gemm_phase<E, pg8::StaticOrder, true, true>(F.lds + RING_OFF, g, S, e);
}
template <class E> __device__ __forceinline__ void run_gemm(Frame& F, const bf16* A, int lda, const bf16* Bt, int ldb, int M, int N, int K, const E& e) {
    pg8::Gemm g{A, Bt, M, N, K, lda, ldb}; pg8::StaticOrder S; S.init(M, N, F.G, (int)blockIdx.x);
    pg8::gemm_phase<E, pg8::StaticOrder, true, true>(F.lds + RING_OFF, g, S, e);
}

constexpr int NPH = 27;
struct Args { const float* in[31]; float* out; unsigned char* ws; int ph_lo, ph_hi; };
__global__ void __launch_bounds__(NWAVES * 64, 2) mk_fwd(Args args) {
    extern __shared__ __attribute__((aligned(16))) unsigned char lds[];
    Frame F;
    F.lds = (LAS unsigned char*)lds;
    F.tid = threadIdx.x; F.lane = F.tid & 63; F.wave = __builtin_amdgcn_readfirstlane(F.tid >> 6);
    F.G = gridDim.x; { const int bx = blockIdx.x; F.vcu = (F.G % 8 == 0) ? (bx % 8) * (F.G / 8) + bx / 8 : bx; }
    for (int u = F.tid; u < (LDS_BYTES - LDSCTL_OFF) / 4; u += NWAVES * 64) ((LAS unsigned*)(F.lds + LDSCTL_OFF))[u] = 0u;
    __syncthreads();
    if (F.tid == 0) {
#pragma unroll
        for (int i = 0; i < 31; ++i) ((LAS unsigned long long*)(F.lds + PTR_OFF))[i] = (unsigned long long)args.in[i];
        ((LAS unsigned long long*)(F.lds + PTR_OFF))[31] = (unsigned long long)args.ws; ((LAS unsigned long long*)(F.lds + PTR_OFF))[32] = (unsigned long long)args.out;
    }
    __syncthreads();
    const int lo = args.ph_lo, hi = args.ph_hi;
    const bool multi = (hi - lo) > 1;
    if (multi) (void)xcd_barrier_post((unsigned*)ws_(F) + CW_BAR, (volatile LAS unsigned*)(F.lds + MISC_OFF) + 8);
#ifndef ONLY_PHASE
#define ONLY_PHASE -1
#endif
#define WSP ws_(F)
#define MODP ((const float*)(ws_(F) + WS_MOD))
#define ABUF ((bf16*)(ws_(F) + WS_A))
#ifndef SKIP_PHASE
#define SKIP_PHASE -1
#endif
#define IN(k) ((ONLY_PHASE < 0 || ONLY_PHASE == (k)) && SKIP_PHASE != (k) && lo <= (k) && (k) < hi)
#define SEAM(k) do { if (IN(k) && IN((k) + 1)) { XcdBarrier bar_; bar_.bar = (unsigned*)ws_(F) + CW_BAR; bar_.x = xb_xcc_id(); bar_.st = (volatile LAS unsigned*)(F.lds + MISC_OFF) + 8; xcd_barrier(bar_); } asm volatile("" : "+v"(F.tid), "+v"(F.lane)); } while (0)
    int pk = 0;
#ifndef REPEAT_PHASE
#define REPEAT_PHASE -1
#endif
#define PHASE(...) do { if (IN(pk)) { __VA_ARGS__ } if (REPEAT_PHASE == pk && IN(pk)) { { XcdBarrier bar_; bar_.bar = (unsigned*)ws_(F) + CW_BAR; bar_.x = xb_xcc_id(); bar_.st = (volatile LAS unsigned*)(F.lds + MISC_OFF) + 8; xcd_barrier(bar_); } asm volatile("" : "+v"(F.tid), "+v"(F.lane)); { __VA_ARGS__ } } SEAM(pk); ++pk; } while (0)
    PHASE( p0_prologue(F); for (int rep_ = 0; rep_ < DUP_S5T; ++rep_) p0_s5_tables(F); );
    PHASE( ph_init_rows(F); );
    PHASE( pg8::Epi8<FInProj> e{{(bf16*)(WSP + WS_CQKV), (bf16*)(WSP + WS_UG)}}; run_gemm(F, ABUF, D, (const bf16*)(WSP + WS_WIN0), D, TT, EVEN_IN_PAD, D, e); );
    PHASE( ph_s5_finals(F); );
    PHASE( ph_s5_carry(F); );
    PHASE( ph_mla_norm(F); );
    PHASE(
#ifndef DUPQ
#define DUPQ 1
#endif
#ifndef DUPKV
#define DUPKV 1
#endif
        _Pragma("unroll") for (int rep = 0; rep < DUPQ; ++rep) { pg8::Epi8<FQ> e{{(bf16*)(WSP + WS_QB), (const float*)(WSP + WS_ROPE)}}; run_gemm(F, (const bf16*)(WSP + WS_CQKV), CQKV_LD, (const bf16*)(WSP + WS_WUQ), 384, TT, 768, 384, e); }
        _Pragma("unroll") for (int rep = 0; rep < DUPKV; ++rep) { pg8::Epi8<FKV> e{{(bf16*)(WSP + WS_KB), (bf16*)(WSP + WS_VB)}}; run_gemm(F, (const bf16*)(WSP + WS_CQKV) + 384, CQKV_LD, (const bf16*)(WSP + WS_WUKV), 256, TT, 1024, 256, e); }
    );
    PHASE( ph_s5_out(F); );
    PHASE( ph_attn(F); );
    PHASE( EpiGlu e{(const bf16*)(WSP + WS_Z), (bf16*)(WSP + WS_MIX)}; run_gemm(F, (const bf16*)(WSP + WS_Z), 512, (const bf16*)(WSP + WS_WGLU), 512, TT, 512, 512, e); );
    PHASE(
        { EpiResid e{out_(F), (float*)(WSP + WS_XC), MODP + 0 * 3 * 6144 + 2 * 1024, 1, 0, nullptr}; run_gemm(F, (const bf16*)(WSP + WS_MIX), D, (const bf16*)(WSP + WS_WOUT0), D, TL, D, D, e); }
        _Pragma("unroll") for (int sp = 0; sp < 4; ++sp) { EpiResid e{out_(F), (float*)(WSP + WS_XC), MODP + 0 * 3 * 6144 + 2 * 1024, 1, TL, (float*)(WSP + WS_SLAB1) + (size_t)sp * TC * D};
            run_gemm_off(F, (const bf16*)(WSP + WS_MIX) + (size_t)TL * D + 256 * sp, D, (const bf16*)(WSP + WS_WOUT0) + 256 * sp, D, TC, D, 256, e, 8 * sp); }
    );
    PHASE( ph_layernorm(F, TT, 0, 0, 0, 3, (const float*)(WSP + WS_SLAB1), 4); );
    PHASE( EpiConvGate e{(bf16*)(WSP + WS_HG), (bf16*)(WSP + WS_AB), (bf16*)(WSP + WS_GB), (const bf16*)(WSP + WS_CWT)}; run_gemm(F, ABUF, D, (const bf16*)(WSP + WS_F1T0), D, TT, 2 * FFH, D, e); );
    PHASE( ph_convfix(F, TT, 0); );
    PHASE(
        { EpiResid e{out_(F), (float*)(WSP + WS_XC), MODP + 0 * 3 * 6144 + 5 * 1024, 1, 0, nullptr}; run_gemm(F, (const bf16*)(WSP + WS_HG), FFH, (const bf16*)(WSP + WS_F2T0), FFH, TL, D, FFH, e); }
        _Pragma("unroll") for (int sp = 0; sp < 6; ++sp) { EpiResid e{out_(F), (float*)(WSP + WS_XC), MODP + 0 * 3 * 6144 + 5 * 1024, 1, TL, (float*)(WSP + WS_SLAB2) + (size_t)sp * TC * D};
            run_gemm_off(F, (const bf16*)(WSP + WS_HG) + (size_t)TL * FFH + 512 * sp, FFH, (const bf16*)(WSP + WS_F2T0) + 512 * sp, FFH, TC, D, sp == 5 ? 256 : 512, e, 8 * sp); }
    );
    PHASE( ph_layernorm(F, TT, 0, 1, 1, 0, (const float*)(WSP + WS_SLAB2), 6); );
    PHASE( pg8::Epi8<FHgIn> e{{(bf16*)(WSP + WS_QFFI), (bf16*)(WSP + WS_G)}}; run_gemm(F, ABUF, D, (const bf16*)(WSP + WS_HGINT), D, TT, 5120, D, e); );
    PHASE( ph_hgrn_states(F); );
    PHASE( ph_hgrn_carry(F); );
    PHASE( ph_hgrn_out(F); );
    PHASE( ph_hg_gate(F); );
    PHASE( EpiResid e{out_(F), (float*)(WSP + WS_XC), MODP + 1 * 3 * 6144 + 2 * 1024, 1, 0, nullptr}; run_gemm(F, (const bf16*)(WSP + WS_O), D, (const bf16*)(WSP + WS_HGOUTT), D, TL, D, D, e); );
    PHASE( ph_layernorm(F, TL, 1, 0, 1, 3); );
    PHASE( EpiConvGate e{(bf16*)(WSP + WS_HG), (bf16*)(WSP + WS_AB), (bf16*)(WSP + WS_GB), (const bf16*)(WSP + WS_CWT) + (size_t)FFH * 4}; run_gemm(F, ABUF, D, (const bf16*)(WSP + WS_F1T1), D, TL, 2 * FFH, D, e); );
    PHASE( ph_convfix(F, TL, 1); );
    PHASE( EpiResid e{out_(F), (float*)(WSP + WS_XC), MODP + 1 * 3 * 6144 + 5 * 1024, 1, 0, nullptr}; run_gemm(F, (const bf16*)(WSP + WS_HG), FFH, (const bf16*)(WSP + WS_F2T1), FFH, TL, D, FFH, e); );
    PHASE( ph_layernorm(F, TL, 1, 1, -1, 0); );
#undef PHASE
#undef IN
#undef SEAM
}

extern "C" void kernel_launch(void* const* d_in, const int* in_sizes, int n_in, void* d_out, int out_size, void* d_ws, size_t ws_size, hipStream_t stream) {
    static int grid = 0;
    if (grid == 0) {
        if (n_in != 31 || out_size != TL * D || ws_size < WS_END) { fprintf(stderr, "kernel_launch: unexpected shapes n_in %d out %d ws %zu\n", n_in, out_size, ws_size); grid = -1; return; }
        int dev = 0, cus = 0;
        if (hipGetDevice(&dev) != hipSuccess || hipDeviceGetAttribute(&cus, hipDeviceAttributeMultiprocessorCount, dev) != hipSuccess) { grid = -1; return; }
        if (hipFuncSetAttribute((const void*)mk_fwd, hipFuncAttributeMaxDynamicSharedMemorySize, LDS_BYTES) != hipSuccess) { fprintf(stderr, "kernel_launch: hipFuncSetAttribute failed\n"); grid = -1; return; }
        int per_cu = 0;
        if (hipOccupancyMaxActiveBlocksPerMultiprocessor(&per_cu, (const void*)mk_fwd, NWAVES * 64, LDS_BYTES) != hipSuccess || per_cu < 1) fprintf(stderr, "kernel_launch: occupancy query says %d\n", per_cu);
        (void)hipGetLastError();
        grid = cus;
    }
    if (grid < 0) return;
    if (hipMemsetAsync((char*)d_ws + WS_CTL, 0, CTL_ZERO_BYTES, stream) != hipSuccess) return;
    Args a{};
    for (int i = 0; i < 31; ++i) a.in[i] = (const float*)d_in[i];
    a.out = (float*)d_out; a.ws = (unsigned char*)d_ws;
#ifndef MK_ONE_LAUNCH
#define MK_ONE_LAUNCH 1
#endif
    if (MK_ONE_LAUNCH) { a.ph_lo = 0; a.ph_hi = NPH; hipLaunchKernelGGL(mk_fwd, dim3(grid), dim3(NWAVES * 64), LDS_BYTES, stream, a); }
    else for (int p = 0; p < NPH; ++p) { a.ph_lo = p; a.ph_hi = p + 1; hipLaunchKernelGGL(mk_fwd, dim3(grid), dim3(NWAVES * 64), LDS_BYTES, stream, a); }
}
```

```cpp
#include <hip/hip_runtime.h>
#include <cstdio>
#include <cstdint>
#include <cmath>
namespace pg8 {
#define PG8_LAS __attribute__((address_space(3)))
typedef unsigned short bf16_t;
typedef short bf16x8 __attribute__((ext_vector_type(8)));
typedef float f32x4 __attribute__((ext_vector_type(4)));
typedef unsigned u32x4 __attribute__((ext_vector_type(4)));
constexpr int BM = 256, BK = 64, HALF = 128, HTB = HALF * BK * 2  , STAGE_BYTES = 8 * HTB, NXCD = 8, WGM = 8;

__host__ __device__ __forceinline__ int lds_byte(int r, int c) { const int st = (r >> 4) * 2 + (c >> 5), rr = r & 15, cc = c & 31, ob = rr * 64 + cc * 2; return st * 1024 + (ob ^ (((ob >> 9) & 1) << 5)); }
__host__ __device__ __forceinline__ void stage_rc(int b, int& R, int& C) { const int st = b / 1024, sb = b % 1024, swz = sb ^ (((sb >> 9) & 1) << 5); R = (st >> 1) * 16 + swz / 64; C = (st & 1) * 32 + (swz % 64) / 2; }
__host__ __device__ __forceinline__ int perm32(int rho) { const int n = rho >> 4, i = rho & 15; return 8 * (i >> 2) + 4 * n + (i & 3); }

struct Unit { int pm, pn; };
struct Gemm { const bf16_t* A; const bf16_t* Bt; int M, N, K, lda, ldb; };

struct StaticOrder {
    int nM, nN, nwg, G, c;
    __host__ __device__ void init(int M, int N, int G_, int c_) { nM = M / BM; nN = N / BM; nwg = nM * nN; G = G_; c = c_; }
    __host__ __device__ bool next(int i, Unit& u) const {
        const long L = (long)i * G + c; if (L >= nwg) return false;
        int wgid = (int)L; { const int q = nwg / NXCD, r = nwg % NXCD, xcd = wgid % NXCD, off = wgid / NXCD; wgid = (xcd < r ? xcd * (q + 1) : r * (q + 1) + (xcd - r) * q) + off; }
        const int nig = WGM * nN, gid = wgid / nig, fm = gid * WGM, gsz = (nM - fm) < WGM ? (nM - fm) : WGM;
        u.pm = fm + ((wgid % nig) % gsz); u.pn = (wgid % nig) / gsz; return true;
    }
    __device__ __forceinline__ void a_ready(const Unit&) const {}
    __device__ __forceinline__ void done(const Unit&) const {}
};

__device__ __forceinline__ unsigned cvt_pk_bf16(float lo, float hi) { unsigned r; asm volatile("v_cvt_pk_bf16_f32 %0, %1, %2" : "=v"(r) : "v"(lo), "v"(hi)); return r; }
template <class F> struct Epi8 {
    static constexpr bool PERM = true, AFTER_DRAIN = false; F f;
    __device__ __forceinline__ void operator()(const f32x4 (&acc)[2][2][4][2], const Unit& u, int wr, int wc, int fr, int fq) const {
        const int row0 = u.pm * BM + wr * 64 + fr, col0 = u.pn * BM + wc * 32 + 8 * fq;
#pragma unroll
        for (int ai = 0; ai < 2; ++ai)
#pragma unroll
            for (int m = 0; m < 4; ++m)
#pragma unroll
                for (int bj = 0; bj < 2; ++bj) { f(row0 + ai * HALF + m * 16, col0 + bj * HALF, acc[ai][bj][m][0], acc[ai][bj][m][1]); }
    }
};
template <class F> struct Epi4 {
    static constexpr bool PERM = false, AFTER_DRAIN = false; F f;
    __device__ __forceinline__ void operator()(const f32x4 (&acc)[2][2][4][2], const Unit& u, int wr, int wc, int fr, int fq) const {
        const int row0 = u.pm * BM + wr * 64 + fr, col0 = u.pn * BM + wc * 32 + 4 * fq;
#pragma unroll
        for (int ai = 0; ai < 2; ++ai)
#pragma unroll
            for (int m = 0; m < 4; ++m)
#pragma unroll
                for (int bj = 0; bj < 2; ++bj)
#pragma unroll
                    for (int n = 0; n < 2; ++n) { f(row0 + ai * HALF + m * 16, col0 + bj * HALF + n * 16, acc[ai][bj][m][n]); }
    }
};
template <class Epi, class Sched, bool ALIGN_EPI = false, bool SP2 = false>
__device__ __forceinline__ void gemm_phase(PG8_LAS unsigned char* lds, const Gemm g, const Sched& S, const Epi& E) {
    int tid_ = threadIdx.x; asm volatile("" : "+v"(tid_));
    const int tid = tid_, wid = __builtin_amdgcn_readfirstlane(tid >> 6), lane = tid & 63, wr = wid >> 2, wc = wid & 3, fr = lane & 15, fq = lane >> 4;
    const int K = g.K, nt = K / BK;
    unsigned voffA[2], voffB[2];
#pragma unroll
    for (int i = 0; i < 2; ++i) { int R, C; stage_rc(tid * 16 + i * 8192, R, C); const int Rb = Epi::PERM ? ((R & ~31) + perm32(R & 31)) : R;
        voffA[i] = (unsigned)(R * g.lda + C) * 2u; voffB[i] = (unsigned)(Rb * g.ldb + C) * 2u; }
    const size_t kstep = (size_t)(BK * 2);
    const size_t hstepA = (size_t)HALF * g.lda * 2, hstepB = (size_t)HALF * g.ldb * 2;
    const size_t tstepA = 2 * hstepA, tstepB = 2 * hstepB;
    const unsigned ldsw = (unsigned)wid * 1024u;
    const int aoff = lds_byte(wr * 64 + fr, fq * 8), boff = lds_byte(wc * 32 + fr, fq * 8);
#define PG8_SA(b, h) (((b) * 2 + (h)) * HTB)
#define PG8_SB(b, h) ((4 + (b) * 2 + (h)) * HTB)
#define PG8_STAGE(bufoff, gbase, voff) do { _Pragma("unroll") for (int _i = 0; _i < 2; ++_i) \
        __builtin_amdgcn_global_load_lds((const unsigned*)((const char*)(gbase) + (voff)[_i]), (PG8_LAS unsigned*)(lds + (bufoff) + ldsw + _i * 8192), 16, 0, 0); } while (0)
#define PG8_LDA(dst, b, h) do { _Pragma("unroll") for (int m = 0; m < 4; ++m) _Pragma("unroll") for (int k = 0; k < 2; ++k) dst[m][k] = *(const PG8_LAS bf16x8*)(lds + PG8_SA(b, h) + aoff + m * 2048 + k * 1024); } while (0)
#define PG8_LDB(dst, b, h) do { _Pragma("unroll") for (int n = 0; n < 2; ++n) _Pragma("unroll") for (int k = 0; k < 2; ++k) dst[n][k] = *(const PG8_LAS bf16x8*)(lds + PG8_SB(b, h) + boff + n * 2048 + k * 1024); } while (0)
#define PG8_MMA(ai, bj, At, Bt) do { __builtin_amdgcn_s_setprio(1); _Pragma("unroll") for (int m = 0; m < 4; ++m) _Pragma("unroll") for (int n = 0; n < 2; ++n) _Pragma("unroll") for (int k = 0; k < 2; ++k) \
        acc[ai][bj][m][n] = __builtin_amdgcn_mfma_f32_16x16x32_bf16(Bt[n][k], At[m][k], acc[ai][bj][m][n], 0, 0, 0); __builtin_amdgcn_s_setprio(0); } while (0)
#define PG8_WAIT_V(n) asm volatile("s_waitcnt vmcnt(" #n ")" ::: "memory")
#define PG8_WAIT_L(n) asm volatile("s_waitcnt lgkmcnt(" #n ")" ::: "memory")
#define PG8_BAR __builtin_amdgcn_s_barrier()
#define PG8_SCHED __builtin_amdgcn_sched_barrier(0)
    Unit cur, nxt; int ui = 0;
    if (!S.next(0, cur)) return;
    f32x4 acc[2][2][4][2];
#pragma unroll
    for (int a = 0; a < 2; ++a)
#pragma unroll
        for (int b = 0; b < 2; ++b)
#pragma unroll
            for (int m = 0; m < 4; ++m)
#pragma unroll
                for (int n = 0; n < 2; ++n) acc[a][b][m][n] = (f32x4){0.f, 0.f, 0.f, 0.f};
    bf16x8 At[4][2], B0[2][2], B1[2][2];
    const char* cA = (const char*)g.A + (size_t)cur.pm * tstepA; const char* cB = (const char*)g.Bt + (size_t)cur.pn * tstepB;
    S.a_ready(cur);
    if constexpr (SP2) {
        PG8_STAGE(PG8_SB(0, 0), cB, voffB); PG8_STAGE(PG8_SB(0, 1), cB + hstepB, voffB); PG8_STAGE(PG8_SA(0, 0), cA, voffA); PG8_STAGE(PG8_SA(0, 1), cA + hstepA, voffA);
        if (wr == 1) PG8_BAR;
        PG8_WAIT_V(2); PG8_BAR;
        PG8_STAGE(PG8_SB(1, 0), cB + kstep, voffB); PG8_STAGE(PG8_SA(1, 0), cA + kstep, voffA); PG8_STAGE(PG8_SB(1, 1), cB + hstepB + kstep, voffB);
        PG8_WAIT_V(6); PG8_BAR;
    } else {
        PG8_STAGE(PG8_SB(0, 0), cB, voffB); PG8_STAGE(PG8_SA(0, 0), cA, voffA); PG8_STAGE(PG8_SB(0, 1), cB + hstepB, voffB); PG8_STAGE(PG8_SA(0, 1), cA + hstepA, voffA);
        if (wr == 1) PG8_BAR;
        PG8_WAIT_V(4); PG8_BAR;
        PG8_STAGE(PG8_SB(1, 0), cB + kstep, voffB); PG8_STAGE(PG8_SA(1, 0), cA + kstep, voffA); PG8_STAGE(PG8_SB(1, 1), cB + hstepB + kstep, voffB);
        PG8_WAIT_V(6); PG8_BAR;
    }
    for (;;) {
        const bool has_next = S.next(ui + 1, nxt);
        const char* nA = has_next ? (const char*)g.A + (size_t)nxt.pm * tstepA : cA; const char* nB = has_next ? (const char*)g.Bt + (size_t)nxt.pn * tstepB : cB;
#pragma unroll 1
        for (int t = 0; t < nt; t += 2) {
            const bool last = (t == nt - 2);
            const char* a1 = cA + (size_t)(t + 1) * kstep;
            const char* a2 = last ? nA : cA + (size_t)(t + 2) * kstep; const char* b2 = last ? nB : cB + (size_t)(t + 2) * kstep;
            const char* a3 = a2 + kstep; const char* b3 = b2 + kstep;
            if (last && has_next) S.a_ready(nxt);
            if constexpr (SP2) {
            PG8_LDB(B0, 0, 0); PG8_LDB(B1, 0, 1); PG8_SCHED; PG8_LDA(At, 0, 0); PG8_STAGE(PG8_SA(1, 1), a1 + hstepA, voffA);
            PG8_WAIT_V(8); PG8_WAIT_L(0); PG8_BAR; PG8_MMA(0, 0, At, B0); PG8_MMA(0, 1, At, B1); PG8_BAR; PG8_SCHED;
            PG8_LDA(At, 0, 1); PG8_STAGE(PG8_SB(0, 0), b2, voffB); PG8_STAGE(PG8_SB(0, 1), b2 + hstepB, voffB); PG8_STAGE(PG8_SA(0, 0), a2, voffA);
            PG8_WAIT_V(8); PG8_WAIT_L(0); PG8_BAR; PG8_MMA(1, 0, At, B0); PG8_MMA(1, 1, At, B1); PG8_BAR; PG8_SCHED;
            PG8_LDB(B0, 1, 0); PG8_LDB(B1, 1, 1); PG8_SCHED; PG8_LDA(At, 1, 0); PG8_STAGE(PG8_SA(0, 1), a2 + hstepA, voffA);
            PG8_WAIT_V(8); PG8_WAIT_L(0); PG8_BAR; PG8_MMA(0, 0, At, B0); PG8_MMA(0, 1, At, B1); PG8_BAR; PG8_SCHED;
            PG8_LDA(At, 1, 1); PG8_STAGE(PG8_SB(1, 0), b3, voffB); PG8_STAGE(PG8_SB(1, 1), b3 + hstepB, voffB); PG8_STAGE(PG8_SA(1, 0), a3, voffA);
            PG8_WAIT_V(8); PG8_WAIT_L(0); PG8_BAR; PG8_MMA(1, 0, At, B0); PG8_MMA(1, 1, At, B1); PG8_BAR; PG8_SCHED;
            } else {
            PG8_LDB(B0, 0, 0); PG8_SCHED; PG8_LDA(At, 0, 0); PG8_STAGE(PG8_SA(1, 1), a1 + hstepA, voffA);
            PG8_WAIT_L(8); PG8_BAR; PG8_WAIT_L(0); PG8_MMA(0, 0, At, B0); PG8_BAR; PG8_SCHED;
            PG8_LDB(B1, 0, 1); PG8_STAGE(PG8_SB(0, 0), b2, voffB);
            PG8_BAR; PG8_WAIT_L(0); PG8_MMA(0, 1, At, B1); PG8_BAR;
            PG8_LDA(At, 0, 1); PG8_STAGE(PG8_SA(0, 0), a2, voffA);
            PG8_BAR; PG8_WAIT_L(0); PG8_MMA(1, 0, At, B0); PG8_BAR; PG8_SCHED;
            PG8_STAGE(PG8_SB(0, 1), b2 + hstepB, voffB);
            PG8_WAIT_V(6); PG8_BAR; PG8_MMA(1, 1, At, B1); PG8_BAR;
            PG8_LDB(B0, 1, 0); PG8_SCHED; PG8_LDA(At, 1, 0); PG8_STAGE(PG8_SA(0, 1), a2 + hstepA, voffA);
            PG8_WAIT_L(8); PG8_BAR; PG8_WAIT_L(0); PG8_MMA(0, 0, At, B0); PG8_BAR; PG8_SCHED;
            PG8_LDB(B1, 1, 1); PG8_STAGE(PG8_SB(1, 0), b3, voffB);
            PG8_BAR; PG8_WAIT_L(0); PG8_MMA(0, 1, At, B1); PG8_BAR;
            PG8_LDA(At, 1, 1); PG8_STAGE(PG8_SA(1, 0), a3, voffA);
            PG8_BAR; PG8_WAIT_L(0); PG8_MMA(1, 0, At, B0); PG8_BAR; PG8_SCHED;
            PG8_STAGE(PG8_SB(1, 1), b3 + hstepB, voffB);
            PG8_WAIT_V(6); PG8_BAR; PG8_MMA(1, 1, At, B1); PG8_BAR;
            }
        }
        if constexpr (ALIGN_EPI) { if (wr == 0) PG8_BAR; }
        if constexpr (!Epi::AFTER_DRAIN) { E(acc, cur, wr, wc, fr, fq); S.done(cur); }
        if (!has_next) break;
#pragma unroll
        for (int a = 0; a < 2; ++a)
#pragma unroll
            for (int b = 0; b < 2; ++b)
#pragma unroll
                for (int m = 0; m < 4; ++m)
#pragma unroll
                    for (int n = 0; n < 2; ++n) acc[a][b][m][n] = (f32x4){0.f, 0.f, 0.f, 0.f};
        cur = nxt; cA = nA; cB = nB; ++ui;
        if constexpr (ALIGN_EPI) { if (wr == 1) PG8_BAR; }
    }
    PG8_WAIT_V(0);
    if constexpr (!ALIGN_EPI) { if (wr == 0) PG8_BAR; }
    PG8_BAR;
    if constexpr (Epi::AFTER_DRAIN) { E.fused(acc, cur, wr, wc, fr, fq, lds, wid, lane); S.done(cur); }
#undef PG8_SA
#undef PG8_SB
#undef PG8_STAGE
#undef PG8_LDA
#undef PG8_LDB
#undef PG8_MMA
#undef PG8_WAIT_V
#undef PG8_WAIT_L
#undef PG8_BAR
#undef PG8_SCHED
}
}

constexpr int NWAVES = 8;
constexpr int D = 1024, BATCH = 2, SEQ = 8192, CTXL = 256;
constexpr int TL = BATCH * SEQ;
constexpr int TC = BATCH * CTXL;
constexpr int TT = TL + TC;
constexpr int EVEN_IN = 1184, EVEN_IN_PAD = 1280, CQKV_LD = 672;
constexpr int FFH = 2816, FFG = 1408;
constexpr int TQK = SEQ + CTXL;
constexpr float NORM_EPS = 1e-6f;
constexpr float DN_ALPHA = 1.41421356237f;
constexpr float QSCALE = 0.10206207261596577f * 1.4426950408889634f;

constexpr size_t MiB = 1u << 20;
constexpr size_t WS_CTL = 0, CTL_ZERO_BYTES = 1 * MiB;
constexpr size_t WS_MOD = 1 * MiB;
constexpr size_t WS_LBV = WS_MOD + 160 * 1024;
constexpr size_t WS_ROPE = WS_LBV + 16 * 1024;
constexpr size_t WS_CWT = WS_ROPE + 16 * 1024;
constexpr size_t WS_HGINT = 2 * MiB, WS_HGOUTT = 12 * MiB, WS_F1T1 = 14 * MiB, WS_F2T1 = 25 * MiB;
constexpr size_t WS_A = 31 * MiB;
constexpr size_t WS_XC = 64 * MiB;
constexpr size_t WS_WIN0 = 66 * MiB, WS_WUQ = WS_WIN0 + 2560 * 1024, WS_WUKV = WS_WUQ + 768 * 1024, WS_WGLU = WS_WUKV + 512 * 1024,
                 WS_WOUT0 = WS_WGLU + 512 * 1024, WS_F1T0 = 72 * MiB + 512 * 1024, WS_F2T0 = WS_F1T0 + 11 * MiB;
constexpr size_t WS_R = 89 * MiB;
constexpr size_t WS_CQKV = WS_R;
constexpr size_t WS_UG = WS_R + 22 * MiB;
constexpr size_t WS_WF = WS_R + 39 * MiB;
constexpr size_t WS_WC = WS_R + 64 * MiB;
constexpr size_t WS_TOEP = WS_R + 80 * MiB;
constexpr size_t WS_T0 = WS_R + 82 * MiB;
constexpr size_t WS_A64 = WS_T0 + 128 * 1024;
constexpr size_t WS_FIN = WS_R + 83 * MiB;
constexpr size_t WS_SIN = WS_R + 92 * MiB;
constexpr size_t WS_Z = WS_R + 97 * MiB;
constexpr size_t WS_MIX = WS_R + 134 * MiB;
constexpr size_t WS_QB = WS_R + 39 * MiB;
constexpr size_t WS_KB = 31 * MiB;
constexpr size_t WS_VB = WS_R + 114 * MiB;
constexpr size_t WS_AB = WS_R;
constexpr size_t WS_GB = WS_R + 8 * MiB;
constexpr size_t WS_H = WS_R;
constexpr size_t WS_HG = WS_R + 16 * MiB;
constexpr size_t WS_QFFI = 66 * MiB;
constexpr size_t WS_G = 198 * MiB;
constexpr size_t WS_O = WS_A;
constexpr size_t WS_SLAB1 = WS_R;
constexpr size_t WS_SLAB2 = WS_R + 110 * MiB;
constexpr size_t WS_END = 256 * MiB;
static_assert(WS_F2T0 + 5632 * 1024 <= WS_R, "layer-0 weights");
static_assert(WS_MIX + (size_t)TT * 1024 * 2 <= WS_END && WS_G + (size_t)TT * 1024 * 2 <= WS_END && WS_HG + (size_t)TT * FFH * 2 <= WS_END, "ws map");
static_assert(WS_WF + 16 * MiB <= WS_WC && WS_QB + (size_t)16 * TQK * 96 * 2 <= WS_WC && WS_WC + 16 * MiB <= WS_TOEP && WS_TOEP + 2 * MiB <= WS_T0 && WS_T0 + MiB <= WS_FIN && WS_FIN + (size_t)32 * 264 * 256 * 4 <= WS_SIN && WS_SIN + (size_t)32 * 264 * 256 * 2 <= WS_Z && WS_Z + (size_t)TT * 512 * 2 <= WS_VB && WS_VB + (size_t)16 * TQK * 64 * 2 <= WS_MIX && WS_KB + (size_t)16 * TQK * 96 * 2 <= WS_XC, "ws map 2");

constexpr int CW_BAR = 4096;
constexpr int RING_OFF = 0, RING_BYTES = 131072;
constexpr int LDSCTL_OFF = RING_BYTES, MISC_OFF = LDSCTL_OFF + 320;
constexpr int LDS_BYTES = 147456;

#define GAS __attribute__((address_space(1)))
#define LAS __attribute__((address_space(3)))
typedef unsigned short bf16;
typedef unsigned v4u __attribute__((ext_vector_type(4)));
typedef unsigned v2u __attribute__((ext_vector_type(2)));
typedef float f32x4 __attribute__((ext_vector_type(4)));
typedef GAS unsigned gu32;
#define RLX_AGENT __ATOMIC_RELAXED, __HIP_MEMORY_SCOPE_AGENT
#define LDS_WAIT() asm volatile("s_waitcnt lgkmcnt(0)" ::: "memory")
__device__ __forceinline__ unsigned f2bf(float f) { unsigned u = __builtin_bit_cast(unsigned, f); return (u + 0x7fffu + ((u >> 16) & 1u)) >> 16; }
__device__ __forceinline__ unsigned pk2(float lo, float hi) { return f2bf(lo) | (f2bf(hi) << 16); }
__device__ __forceinline__ float bflo(unsigned w) { return __builtin_bit_cast(float, w << 16); }
__device__ __forceinline__ float bfhi(unsigned w) { return __builtin_bit_cast(float, w & 0xffff0000u); }
__device__ __forceinline__ float bf2f(bf16 h) { return __builtin_bit_cast(float, (unsigned)h << 16); }
__device__ __forceinline__ void unpack8(v4u w, float* x) { x[0] = bflo(w.x); x[1] = bfhi(w.x); x[2] = bflo(w.y); x[3] = bfhi(w.y); x[4] = bflo(w.z); x[5] = bfhi(w.z); x[6] = bflo(w.w); x[7] = bfhi(w.w); }
__device__ __forceinline__ v4u pack8(const float* x) { v4u w; w.x = pk2(x[0], x[1]); w.y = pk2(x[2], x[3]); w.z = pk2(x[4], x[5]); w.w = pk2(x[6], x[7]); return w; }
__device__ __forceinline__ float sigmoidf_(float x) { return 1.0f / (1.0f + __expf(-x)); }
__device__ __forceinline__ float siluf_(float x) { return x / (1.0f + __expf(-x)); }
__device__ __forceinline__ float gelu_tanh(float x) { const float u = 0.7978845608028654f * (x + 0.044715f * x * x * x); return 0.5f * x * (1.0f + tanhf(u)); }
__device__ __forceinline__ float wave_sum(float v) {
#pragma unroll
    for (int o = 1; o < 64; o <<= 1) v += __shfl_xor(v, o);
    return v;
}

#define XB_TMO      128
#define XB_XCNT(j)  (256  + 64 * (j))
#define XB_XSUB(j)  (1280 + 64 * (j))
#define XB_XGEN(j)  (2304 + 64 * (j))
#define XB_TOP      3328
#define XB_TOPGEN   3392
#define XCD_BAR_WORDS 3456
#define XB_SPIN_CAP (1u << 18)

__device__ __forceinline__ unsigned xb_ld(unsigned* p)              { return __hip_atomic_load(p, __ATOMIC_RELAXED, __HIP_MEMORY_SCOPE_AGENT); }
__device__ __forceinline__ unsigned xb_add(unsigned* p, unsigned v) { return __hip_atomic_fetch_add(p, v, __ATOMIC_RELAXED, __HIP_MEMORY_SCOPE_AGENT); }
__device__ __forceinline__ unsigned xb_xcc_id() { return (unsigned)__builtin_amdgcn_s_getreg((3 << 11) | 20) & 0xFu; }
#define XB_SPIN(cond, bar) do { unsigned _sp = 0; while (cond) { __builtin_amdgcn_s_sleep(1); \
    if ((++_sp & 255u) == 0u) { if (xb_ld(&(bar)[XB_TMO])) break; if (_sp > XB_SPIN_CAP) { atomicAdd(&(bar)[XB_TMO], 1u); break; } } } } while (0)

struct XcdBarrier {
    unsigned* bar; unsigned x;
    volatile LAS unsigned* st;
};

__device__ __forceinline__ XcdBarrier xcd_barrier_post(unsigned* bar, volatile LAS unsigned* st) {
    XcdBarrier b; b.bar = bar; b.x = xb_xcc_id(); b.st = st;
    if (threadIdx.x == 0) (void)xb_add(&bar[XB_XCNT(b.x)], 1u);
    return b;
}
__device__ __forceinline__ void xcd_barrier_complete(unsigned* bar, unsigned x, unsigned& nloc, unsigned& nx) {
    const unsigned G = gridDim.x * gridDim.y * gridDim.z;
    unsigned sum, cnt, mine, sp = 0u;
    for (;;) {
        sum = 0u; cnt = 0u; mine = 0u;
#pragma unroll
        for (unsigned j = 0; j < 16; ++j) { const unsigned c = xb_ld(&bar[XB_XCNT(j)]); sum += c; cnt += (c > 0u) ? 1u : 0u; mine = (j == x) ? c : mine; }
        if (sum == G) break;
        __builtin_amdgcn_s_sleep(1);
        if ((++sp & 255u) == 0u) { if (xb_ld(&bar[XB_TMO])) break; if (sp > XB_SPIN_CAP) { atomicAdd(&bar[XB_TMO], 1u); break; } }
    }
    nloc = mine > 0u ? mine : 1u; nx = cnt > 0u ? cnt : 1u;
}

__device__ __forceinline__ void xcd_barrier(const XcdBarrier& b) {
    asm volatile("s_waitcnt vmcnt(0)" ::: "memory");
    __syncthreads();
    if (threadIdx.x == 0) {
        unsigned* bar = b.bar;
        __builtin_amdgcn_s_waitcnt(0);
        unsigned nloc = b.st[0], nx = b.st[1];
        if (nloc == 0u) { xcd_barrier_complete(bar, b.x, nloc, nx); b.st[0] = nloc; b.st[1] = nx; }
        const unsigned old = xb_add(&bar[XB_XSUB(b.x)], 1u);
        const unsigned gen = old / nloc;
        if (old + 1u == (gen + 1u) * nloc) {
            __builtin_amdgcn_fence(__ATOMIC_RELEASE, "agent");
            asm volatile("s_waitcnt vmcnt(0)" ::: "memory");
            const unsigned og = xb_add(&bar[XB_TOP], 1u);
            const unsigned tg = og / nx;
            if (og + 1u == (tg + 1u) * nx) xb_add(&bar[XB_TOPGEN], 1u);
            else XB_SPIN(xb_ld(&bar[XB_TOPGEN]) == tg, bar);
            __builtin_amdgcn_fence(__ATOMIC_ACQUIRE, "agent");
            xb_add(&bar[XB_XGEN(b.x)], 1u);
            asm volatile("s_waitcnt vmcnt(0)" ::: "memory");
        } else {
            XB_SPIN(xb_ld(&bar[XB_XGEN(b.x)]) == gen, bar);
            __builtin_amdgcn_fence(__ATOMIC_ACQUIRE, "agent");
            asm volatile("s_waitcnt vmcnt(0)" ::: "memory");
        }
    }
    __syncthreads();
}


struct Frame {
    LAS unsigned char* lds;
    int tid, lane, wave, vcu, G;
};
constexpr int PTR_OFF = LDSCTL_OFF + 1024;
__device__ __forceinline__ const float* inp(const Frame& F, int i) {
    const LAS unsigned* p = (const LAS unsigned*)(F.lds + PTR_OFF) + 2 * i;
    const unsigned lo = __builtin_amdgcn_readfirstlane(p[0]), hi = __builtin_amdgcn_readfirstlane(p[1]);
    return (const float*)(const GAS float*)(((unsigned long long)hi << 32) | lo);
}
__device__ __forceinline__ unsigned char* ws_(const Frame& F) { return (unsigned char*)inp(F, 31); }
__device__ __forceinline__ float* out_(const Frame& F) { return (float*)inp(F, 32); }
__device__ __forceinline__ int modrow_of(int m) { return m < TL ? (m >> 13) : 2; }
__device__ __forceinline__ const float* xin_row(const Frame& F, int m) { return m < TL ? inp(F, 0) + (size_t)m * D : inp(F, 2) + (size_t)(m - TL) * D; }
__device__ __forceinline__ float* xres_row(const Frame& F, int m) { return m < TL ? out_(F) + (size_t)m * D : (float*)(ws_(F) + WS_XC) + (size_t)(m - TL) * D; }
__device__ __forceinline__ const float* modvec(const Frame& F, int layer, int mr, int part) { return (const float*)(ws_(F) + WS_MOD) + (size_t)(layer * 3 + mr) * 6144 + part * 1024; }

__device__ __forceinline__ void tr_item(const float* W, int ldw, int k0, int n0, bf16* dst, int dpitch, LAS float* scr, int lane) {
    { f32x4 v[8];
#pragma unroll
      for (int i = 0; i < 8; ++i) v[i] = *(const GAS f32x4*)(W + (size_t)(k0 + 8 * i + (lane >> 3)) * ldw + n0 + 4 * (lane & 7));
#pragma unroll
      for (int i = 0; i < 8; ++i) { LAS float* d = scr + (8 * i + (lane >> 3)) * 33 + 4 * (lane & 7); d[0] = v[i].x; d[1] = v[i].y; d[2] = v[i].z; d[3] = v[i].w; } }
    LDS_WAIT(); asm volatile("" ::: "memory");
    const int c = lane & 7;
#pragma unroll
    for (int j = 0; j < 4; ++j) { const int n = (lane >> 3) + 8 * j; const LAS float* s = scr + (8 * c) * 33 + n;
        v4u o; o.x = pk2(s[0 * 33], s[1 * 33]); o.y = pk2(s[2 * 33], s[3 * 33]); o.z = pk2(s[4 * 33], s[5 * 33]); o.w = pk2(s[6 * 33], s[7 * 33]);
        *(GAS v4u*)(dst + (size_t)n * dpitch + 8 * c) = o; }
    LDS_WAIT(); asm volatile("" ::: "memory");
}
__device__ __forceinline__ bool tr_plain(int& r, const float* W, int K, int N, bf16* WT, LAS float* scr, int lane) {
    const int nblk = N / 32, cnt = (K / 64) * nblk;
    if (r >= cnt) { r -= cnt; return false; }
    const int kb = r / nblk, nb = r % nblk;
    tr_item(W, N, 64 * kb, 32 * nb, WT + (size_t)(32 * nb) * K + 64 * kb, K, scr, lane); return true;
}
__device__ __forceinline__ bool tr_ffn1(int& r, const float* W, bf16* WT, LAS float* scr, int lane) {
    const int nblk = 5632 / 32, cnt = 16 * nblk;
    if (r >= cnt) { r -= cnt; return false; }
    const int kb = r / nblk, nb = r % nblk, n0 = 32 * nb, half = n0 / FFH, j = n0 % FFH, drow = (j >> 7) * 256 + half * 128 + (j & 127);
    tr_item(W, 5632, 64 * kb, n0, WT + (size_t)drow * 1024 + 64 * kb, 1024, scr, lane); return true;
}
#ifndef DUP_GEMV
#define DUP_GEMV 1
#endif
#ifndef DUP_TR
#define DUP_TR 1
#endif
#ifndef DUP_S5T
#define DUP_S5T 1
#endif
__device__ __forceinline__ void p0_prologue(Frame& F) {
    {
        LAS float* sv = (LAS float*)(F.lds + RING_OFF);
        LAS float* red = sv + 3072;
        for (int i = F.tid; i < 3072; i += 512) { const int r = i >> 10, k = i & 1023; const float cv = (r < 2) ? inp(F, 1)[r * 1024 + k] : inp(F, 3)[k]; sv[i] = cv / (1.0f + __expf(-cv)); }
        __syncthreads();
        for (int rep_ = 0; rep_ < DUP_GEMV; ++rep_)
        for (int it = blockIdx.x; it < 192; it += F.G) {
            const int layer = it / 96, cg = it % 96, col = cg * 64 + F.lane, k0 = F.wave * 128;
            const float* w = inp(F, 4) + ((size_t)layer * 1024 + k0) * 6144 + col;
            float a0 = 0.f, a1 = 0.f, a2 = 0.f;
#pragma unroll 16
            for (int k = 0; k < 128; ++k) { const float wv = w[(size_t)k * 6144]; a0 += sv[k0 + k] * wv; a1 += sv[1024 + k0 + k] * wv; a2 += sv[2048 + k0 + k] * wv; }
            red[(F.wave * 3 + 0) * 64 + F.lane] = a0; red[(F.wave * 3 + 1) * 64 + F.lane] = a1; red[(F.wave * 3 + 2) * 64 + F.lane] = a2;
            __syncthreads();
            if (F.tid < 192) { const int r = F.tid >> 6, l = F.tid & 63; float s = inp(F, 5)[layer * 6144 + cg * 64 + l];
#pragma unroll
                for (int wv = 0; wv < 8; ++wv) s += red[(wv * 3 + r) * 64 + l];
                ((float*)(ws_(F) + WS_MOD))[(size_t)(layer * 3 + r) * 6144 + cg * 64 + l] = s; }
            __syncthreads();
        }
        __syncthreads();
    }
    {
        const int gt = F.vcu * 512 + F.tid, NT = F.G * 512;
        for (int i = gt; i < 2048; i += NT) { const int dir = i >> 10, c = i & 1023; const float l0 = inp(F, 28)[(0 * 2 + dir) * 1024 + c], l1 = inp(F, 28)[(1 * 2 + dir) * 1024 + c];
            ((float*)(ws_(F) + WS_LBV))[i] = 1.0f / (1.0f + expf(l0 - l1)); }
        for (int i = gt; i < 1024; i += NT) { const int pos = i >> 3, f = i & 7; const float inv = powf(10000.0f, -(float)f / 8.0f); const float ang = (float)pos * inv;
            ((float*)(ws_(F) + WS_ROPE))[2 * i] = cosf(ang); ((float*)(ws_(F) + WS_ROPE))[2 * i + 1] = sinf(ang); }
        for (int i = gt; i < 2 * FFH; i += NT) { const int layer = i / FFH, j = i % FFH; const float* cwp = inp(F, 9) + (size_t)layer * 3 * FFH + j;
            v2u w; w.x = pk2(cwp[0], cwp[FFH]); w.y = pk2(cwp[2 * FFH], inp(F, 10)[(size_t)layer * FFH + j]); *(GAS v2u*)((bf16*)(ws_(F) + WS_CWT) + (size_t)i * 4) = w; }
        for (int i = gt; i < 96 * 1024 / 8; i += NT) ((GAS v4u*)(ws_(F) + WS_WIN0 + (size_t)1184 * 1024 * 2))[i] = (v4u){0u, 0u, 0u, 0u};
    }
    {
        LAS float* scr = (LAS float*)(F.lds + RING_OFF + F.wave * 16384);
        const int gw = F.vcu * NWAVES + F.wave, NGW = F.G * NWAVES;
        constexpr int NITEMS = 592 + 144 + 128 + 128 + 512 + 2 * 2816 + 2 * 1408 + 2560 + 512;
        for (int rep_ = 0; rep_ < DUP_TR; ++rep_)
        for (int it = gw; it < NITEMS; it += NGW) {
            int r = it;
            if (tr_plain(r, inp(F, 12), 1024, 1184, (bf16*)(ws_(F) + WS_WIN0), scr, F.lane)) continue;
            if (tr_plain(r, inp(F, 14), 384, 768, (bf16*)(ws_(F) + WS_WUQ), scr, F.lane)) continue;
            if (tr_plain(r, inp(F, 16), 256, 1024, (bf16*)(ws_(F) + WS_WUKV), scr, F.lane)) continue;
            if (tr_plain(r, inp(F, 25), 512, 512, (bf16*)(ws_(F) + WS_WGLU), scr, F.lane)) continue;
            if (tr_plain(r, inp(F, 26), 1024, 1024, (bf16*)(ws_(F) + WS_WOUT0), scr, F.lane)) continue;
            if (tr_ffn1(r, inp(F, 8), (bf16*)(ws_(F) + WS_F1T0), scr, F.lane)) continue;
            if (tr_ffn1(r, inp(F, 8) + (size_t)1024 * 5632, (bf16*)(ws_(F) + WS_F1T1), scr, F.lane)) continue;
            if (tr_plain(r, inp(F, 11), 2816, 1024, (bf16*)(ws_(F) + WS_F2T0), scr, F.lane)) continue;
            if (tr_plain(r, inp(F, 11) + (size_t)2816 * 1024, 2816, 1024, (bf16*)(ws_(F) + WS_F2T1), scr, F.lane)) continue;
            if (tr_plain(r, inp(F, 27), 1024, 5120, (bf16*)(ws_(F) + WS_HGINT), scr, F.lane)) continue;
            tr_plain(r, inp(F, 30), 1024, 1024, (bf16*)(ws_(F) + WS_HGOUTT), scr, F.lane);
        }
    }
}

__device__ __forceinline__ void store_mod_bf16(const Frame& F, const f32x4 (&v)[4], int m, int layer, int part_sh) {
    const int mr = modrow_of(m);
    const GAS f32x4* sh = (const GAS f32x4*)modvec(F, layer, mr, part_sh) + F.lane;
    const GAS f32x4* sc = (const GAS f32x4*)modvec(F, layer, mr, part_sh + 1) + F.lane;
    GAS v2u* o = (GAS v2u*)((bf16*)(ws_(F) + WS_A) + (size_t)m * D) + F.lane;
#pragma unroll
    for (int j = 0; j < 4; ++j) { const f32x4 s = sc[64 * j], h = sh[64 * j]; const f32x4 y = v[j] * (s + 1.0f) + h; v2u w; w.x = pk2(y.x, y.y); w.y = pk2(y.z, y.w); o[64 * j] = w; }
}
__device__ __forceinline__ void ph_init_rows(Frame& F) {
    const int gw = F.vcu * NWAVES + F.wave, NGW = F.G * NWAVES;
    for (int m = gw; m < TT; m += NGW) {
        const GAS f32x4* xr = (const GAS f32x4*)xin_row(F, m) + F.lane; GAS f32x4* xo = (GAS f32x4*)xres_row(F, m) + F.lane;
        f32x4 v[4];
#pragma unroll
        for (int j = 0; j < 4; ++j) { v[j] = xr[64 * j]; if (m >= TL) xo[64 * j] = v[j] * DN_ALPHA; }
        store_mod_bf16(F, v, m, 0, 0);
    }
}
__device__ __forceinline__ void ph_layernorm(Frame& F, int nrows, int layer, int which, int next_layer, int next_part_sh, const float* slabs = nullptr, int nslabs = 0) {
    const int gw = F.vcu * NWAVES + F.wave, NGW = F.G * NWAVES;
    const GAS f32x4* gg = (const GAS f32x4*)(inp(F, 6) + (size_t)(layer * 2 + which) * D) + F.lane;
    const GAS f32x4* bb = (const GAS f32x4*)(inp(F, 7) + (size_t)(layer * 2 + which) * D) + F.lane;
    for (int m0 = gw; m0 < nrows; m0 += 2 * NGW) {
        const int m1 = m0 + NGW; const bool has1 = m1 < nrows; const int m1c = has1 ? m1 : m0;
        GAS f32x4* xr0 = (GAS f32x4*)xres_row(F, m0) + F.lane; GAS f32x4* xr1 = (GAS f32x4*)xres_row(F, m1c) + F.lane;
        f32x4 v[4], w[4]; float s0 = 0.f, s1 = 0.f;
#pragma unroll
        for (int j = 0; j < 4; ++j) { v[j] = xr0[64 * j]; w[j] = xr1[64 * j]; }
        if (nslabs > 0 && m1c >= TL) {
            for (int sl = 0; sl < nslabs; ++sl) { const GAS f32x4* p1 = (const GAS f32x4*)(slabs + ((size_t)sl * TC + (m1c - TL)) * D) + F.lane;
#pragma unroll
                for (int j = 0; j < 4; ++j) w[j] += p1[64 * j];
                if (m0 >= TL) { const GAS f32x4* p0 = (const GAS f32x4*)(slabs + ((size_t)sl * TC + (m0 - TL)) * D) + F.lane;
#pragma unroll
                    for (int j = 0; j < 4; ++j) v[j] += p0[64 * j]; } }
        }
#pragma unroll
        for (int j = 0; j < 4; ++j) { s0 += (v[j].x + v[j].y) + (v[j].z + v[j].w); s1 += (w[j].x + w[j].y) + (w[j].z + w[j].w); }
        const float mean0 = wave_sum(s0) * (1.f / D), mean1 = wave_sum(s1) * (1.f / D); float q0 = 0.f, q1 = 0.f;
#pragma unroll
        for (int j = 0; j < 4; ++j) { v[j] = v[j] - mean0; w[j] = w[j] - mean1; q0 += (v[j].x * v[j].x + v[j].y * v[j].y) + (v[j].z * v[j].z + v[j].w * v[j].w); q1 += (w[j].x * w[j].x + w[j].y * w[j].y) + (w[j].z * w[j].z + w[j].w * w[j].w); }
        const float r0 = 1.f / sqrtf(wave_sum(q0) * (1.f / D) + NORM_EPS), r1 = 1.f / sqrtf(wave_sum(q1) * (1.f / D) + NORM_EPS);
#pragma unroll
        for (int j = 0; j < 4; ++j) { const f32x4 g4 = gg[64 * j], b4 = bb[64 * j]; v[j] = v[j] * r0 * g4 + b4; w[j] = w[j] * r1 * g4 + b4; xr0[64 * j] = (m0 >= TL) ? v[j] * DN_ALPHA : v[j]; if (has1) xr1[64 * j] = (m1 >= TL) ? w[j] * DN_ALPHA : w[j]; }
        if (next_layer >= 0) { store_mod_bf16(F, v, m0, next_layer, next_part_sh); if (has1) store_mod_bf16(F, w, m1, next_layer, next_part_sh); }
    }
}
__device__ __forceinline__ void ph_mla_norm(Frame& F) {
    const int gw = F.vcu * NWAVES + F.wave, NGW = F.G * NWAVES;
    bf16* CQ = (bf16*)(ws_(F) + WS_CQKV); bf16* Kb = (bf16*)(ws_(F) + WS_KB); const float* rope = (const float*)(ws_(F) + WS_ROPE);
    for (int m = gw; m < TT; m += NGW) {
        bf16* row = CQ + (size_t)m * CQKV_LD;
        {
            float x[8]; float ss = 0.f; const bool act = F.lane < 48;
            if (act) { unpack8(*(const GAS v4u*)(row + 8 * F.lane), x);
#pragma unroll
                for (int j = 0; j < 8; ++j) ss += x[j] * x[j]; }
            const float sc = 1.f / sqrtf(wave_sum(ss) * (1.f / 384.f) + NORM_EPS);
            if (act) {
#pragma unroll
                for (int j = 0; j < 8; ++j) x[j] = x[j] * sc * inp(F, 13)[8 * F.lane + j];
                *(GAS v4u*)(row + 8 * F.lane) = pack8(x); }
        }
        {
            float x[8]; float ss = 0.f; const bool act = F.lane < 32;
            if (act) { unpack8(*(const GAS v4u*)(row + 384 + 8 * F.lane), x);
#pragma unroll
                for (int j = 0; j < 8; ++j) ss += x[j] * x[j]; }
            const float sc = 1.f / sqrtf(wave_sum(ss) * (1.f / 256.f) + NORM_EPS);
            if (act) {
#pragma unroll
                for (int j = 0; j < 8; ++j) x[j] = x[j] * sc * inp(F, 15)[8 * F.lane + j];
                *(GAS v4u*)(row + 384 + 8 * F.lane) = pack8(x); }
        }
        {
            const bool isctx = m >= TL; const int b = isctx ? ((m - TL) >> 8) : (m >> 13), t = isctx ? ((m - TL) & 255) : (m & 8191), tk = isctx ? t : CTXL + t;
            const int h = F.lane >> 3, i0 = (F.lane & 7) * 4;
            const v2u w = *(const GAS v2u*)(row + 640 + i0);
            float x[4] = {bflo(w.x), bfhi(w.x), bflo(w.y), bfhi(w.y)}, o[4];
#pragma unroll
            for (int j = 0; j < 4; ++j) { const float p = __shfl_xor(x[j], 2); const int idx = i0 + j, a = idx >> 4, half = (idx >> 3) & 1, f = idx & 7, pos = a ? (t & 63) : (t >> 6);
                const float cs = rope[2 * (pos * 8 + f)], sn = rope[2 * (pos * 8 + f) + 1];
                o[j] = isctx ? x[j] : (half ? x[j] * cs + p * sn : x[j] * cs - p * sn); }
            v2u ow; ow.x = pk2(o[0], o[1]); ow.y = pk2(o[2], o[3]);
            *(GAS v2u*)(Kb + ((size_t)(b * 8 + h) * TQK + tk) * 96 + 64 + i0) = ow;
        }
    }
}
__device__ __forceinline__ void ph_convfix(Frame& F, int nrows, int layer) {
    const int gw = F.vcu * NWAVES + F.wave, NGW = F.G * NWAVES;
    const bf16* AB = (const bf16*)(ws_(F) + WS_AB); const bf16* GB = (const bf16*)(ws_(F) + WS_GB); bf16* HG = (bf16*)(ws_(F) + WS_HG);
    const float* cw = inp(F, 9) + (size_t)layer * 3 * FFH; const float* cb = inp(F, 10) + (size_t)layer * FFH;
    const int nedge = (nrows / 64) * 2;
    for (int er = gw; er < nedge; er += NGW) {
        const int g64 = er >> 1, which = er & 1, m = 64 * g64 + (which ? 63 : 0);
        const bool isctx = m >= TL; const int t = isctx ? ((m - TL) & 255) : (m & 8191), len = isctx ? CTXL : SEQ;
        const bool hp = t > 0, hn = t < len - 1;
        const bf16* ac_ = AB + (size_t)(g64 * 4 + (which ? 3 : 0)) * FFH;
        const bf16* ap_ = which ? AB + (size_t)(g64 * 4 + 2) * FFH : AB + (size_t)((g64 - 1) * 4 + 3) * FFH;
        const bf16* an_ = which ? AB + (size_t)((g64 + 1) * 4 + 0) * FFH : AB + (size_t)(g64 * 4 + 1) * FFH;
        const bf16* gt_ = GB + (size_t)(g64 * 2 + which) * FFH;
#pragma unroll
        for (int ci = 0; ci < 6; ++ci) { const int ch = F.lane + 64 * ci; if (ch >= FFH / 8) break;
            const int j0 = 8 * ch; float ac[8], ap[8], an[8], gt[8], o[8];
            unpack8(*(const GAS v4u*)(ac_ + j0), ac); unpack8(*(const GAS v4u*)(gt_ + j0), gt);
            if (hp) unpack8(*(const GAS v4u*)(ap_ + j0), ap); else {
#pragma unroll
                for (int j = 0; j < 8; ++j) ap[j] = 0.f; }
            if (hn) unpack8(*(const GAS v4u*)(an_ + j0), an); else {
#pragma unroll
                for (int j = 0; j < 8; ++j) an[j] = 0.f; }
#pragma unroll
            for (int j = 0; j < 8; ++j) { const float cv = cb[j0 + j] + cw[j0 + j] * ap[j] + cw[FFH + j0 + j] * ac[j] + cw[2 * FFH + j0 + j] * an[j]; o[j] = siluf_(cv) * gt[j]; }
            *(GAS v4u*)(HG + (size_t)m * FFH + j0) = pack8(o);
        }
    }
}
__device__ __forceinline__ void ph_hg_gate(Frame& F) {
    const int gw = F.vcu * NWAVES + F.wave, NGW = F.G * NWAVES;
    bf16* O = (bf16*)(ws_(F) + WS_O); const bf16* G = (const bf16*)(ws_(F) + WS_G);
    const int c0 = 16 * F.lane; float ng[16];
#pragma unroll
    for (int j = 0; j < 16; ++j) ng[j] = inp(F, 29)[(c0 + j) & 127];
    for (int m = gw; m < TL; m += NGW) {
        float o[16], g[16]; unpack8(*(const GAS v4u*)(O + (size_t)m * D + c0), o); unpack8(*(const GAS v4u*)(O + (size_t)m * D + c0 + 8), o + 8);
        unpack8(*(const GAS v4u*)(G + (size_t)m * D + c0), g); unpack8(*(const GAS v4u*)(G + (size_t)m * D + c0 + 8), g + 8);
        float ss = 0.f;
#pragma unroll
        for (int j = 0; j < 16; ++j) ss += o[j] * o[j];
        ss += __shfl_xor(ss, 1); ss += __shfl_xor(ss, 2); ss += __shfl_xor(ss, 4);
        const float sc = 1.f / sqrtf(ss * (1.f / 128.f) + NORM_EPS);
#pragma unroll
        for (int j = 0; j < 16; ++j) o[j] = o[j] * sc * ng[j] * siluf_(g[j]);
        *(GAS v4u*)(O + (size_t)m * D + c0) = pack8(o); *(GAS v4u*)(O + (size_t)m * D + c0 + 8) = pack8(o + 8);
    }
}

typedef short bf16x8_t __attribute__((ext_vector_type(8)));
typedef float f32x16 __attribute__((ext_vector_type(16)));
__device__ __forceinline__ int crow(int r, int hi) { return (r & 3) + 8 * (r >> 2) + 4 * hi; }
constexpr int NCH = TT / 64;
__device__ __forceinline__ void p0_s5_tables(Frame& F) {
    LAS unsigned char* L = F.lds + RING_OFF;
    LAS double* lam = (LAS double*)L;
    LAS float* bb = (LAS float*)(L + 1024);
    LAS float* cc = (LAS float*)(L + 1024 + 8192);
    LAS float* pw = (LAS float*)(L + 1024 + 16384);
    unsigned char* ws = ws_(F);
    for (int item4 = blockIdx.x; item4 < 256; item4 += F.G) {
        const int item = item4 >> 2, part = item4 & 3;
        const int g = item >> 1, d = item & 1;
        __syncthreads();
        if (F.tid < 64) { const int n = F.tid, pi = (d * 32 + g) * 64 + n;
            const double lre = inp(F, 17)[pi], lim = inp(F, 18)[pi], dt = exp((double)inp(F, 19)[d * 32 + g]);
            const double mag = exp(lre * dt), are = mag * cos(lim * dt), aim = mag * sin(lim * dt), den = lre * lre + lim * lim, nr = are - 1.0;
            const double fr = (nr * lre + aim * lim) / den, fi = (aim * lre - nr * lim) / den;
            for (int q = 0; q < 16; ++q) { const double br = inp(F, 20)[(size_t)pi * 16 + q], bi = inp(F, 21)[(size_t)pi * 16 + q];
                bb[(n * 16 + q) * 2] = (float)(fr * br - fi * bi); bb[(n * 16 + q) * 2 + 1] = (float)(fr * bi + fi * br); }
            double pr = 1.0, pim = 0.0;
            for (int e = 0; e <= 64; ++e) { pw[(e * 64 + n) * 2] = (float)pr; pw[(e * 64 + n) * 2 + 1] = (float)pim; const double n_r = pr * are - pim * aim, n_i = pr * aim + pim * are; pr = n_r; pim = n_i; } }
        for (int i = F.tid; i < 1024; i += 512) { const int p = i >> 6, n = i & 63; cc[i * 2] = inp(F, 22)[((size_t)(d * 32 + g) * 16 + p) * 64 + n]; cc[i * 2 + 1] = inp(F, 23)[((size_t)(d * 32 + g) * 16 + p) * 64 + n]; }
        __syncthreads();
        { bf16* WF = (bf16*)(ws + WS_WF) + (size_t)g * 256 * 1024;
          for (int i = part * 4096 + F.tid; i < (part + 1) * 4096; i += 512) { const int row = i >> 7, grp = i & 127, c = row >> 6, n = row & 63, sI = grp >> 1, q0 = (grp & 1) * 8, e = d ? sI : 63 - sI;
              const float pr = pw[(e * 64 + n) * 2], pim = pw[(e * 64 + n) * 2 + 1]; float o[8];
              const LAS f32x4* bq = (const LAS f32x4*)(bb + (n * 16 + q0) * 2);
#pragma unroll
              for (int j4 = 0; j4 < 4; ++j4) { const f32x4 v = bq[j4]; o[2 * j4] = c ? (pr * v.y + pim * v.x) : (pr * v.x - pim * v.y); o[2 * j4 + 1] = c ? (pr * v.w + pim * v.z) : (pr * v.z - pim * v.w); }
              *(GAS v4u*)(WF + (size_t)(d * 128 + row) * 1024 + sI * 16 + q0) = pack8(o); } }
        { bf16* WC = (bf16*)(ws + WS_WC) + (size_t)g * 1024 * 256;
          for (int i = part * 4096 + F.tid; i < (part + 1) * 4096; i += 512) { const int row = i >> 4, grp = i & 15, t = row >> 4, p = row & 15, c = grp >> 3, n0 = (grp & 7) * 8, ex = d ? 64 - t : t + 1; float o[8];
              const LAS f32x4* pq = (const LAS f32x4*)(pw + (ex * 64 + n0) * 2); const LAS f32x4* cq = (const LAS f32x4*)(cc + (p * 64 + n0) * 2);
#pragma unroll
              for (int j4 = 0; j4 < 4; ++j4) { const f32x4 pv = pq[j4], cv = cq[j4];
                  o[2 * j4] = c ? -(cv.x * pv.y + cv.y * pv.x) : (cv.x * pv.x - cv.y * pv.y); o[2 * j4 + 1] = c ? -(cv.z * pv.w + cv.w * pv.z) : (cv.z * pv.z - cv.w * pv.w); }
              *(GAS v4u*)(WC + (size_t)row * 256 + d * 128 + c * 64 + n0) = pack8(o); } }
        { bf16* TP = (bf16*)(ws + WS_TOEP) + (size_t)g * 127 * 256; float* T0 = (float*)(ws + WS_T0) + (size_t)(g * 2 + d) * 256;
          for (int i = part * 256 + F.tid; i < (part + 1) * 256; i += 512) { const int tau = i >> 4, p = i & 15; float acc[16];
#pragma unroll
              for (int q = 0; q < 16; ++q) acc[q] = 0.f;
              for (int n = 0; n < 64; ++n) { const float pr = pw[(tau * 64 + n) * 2], pim = pw[(tau * 64 + n) * 2 + 1], cr = cc[(p * 64 + n) * 2], ci = cc[(p * 64 + n) * 2 + 1];
                  const float tr = cr * pr - ci * pim, ti = cr * pim + ci * pr;
                  const LAS f32x4* bq = (const LAS f32x4*)(bb + n * 32);
#pragma unroll
                  for (int q4 = 0; q4 < 8; ++q4) { const f32x4 v = bq[q4]; acc[2 * q4] += tr * v.x - ti * v.y; acc[2 * q4 + 1] += tr * v.z - ti * v.w; } }
              if (tau == 0) {
#pragma unroll
                  for (int q = 0; q < 16; ++q) T0[p * 16 + q] = acc[q]; }
              else { bf16* o = TP + (size_t)(d ? 63 - tau : 63 + tau) * 256 + p * 16; *(GAS v4u*)o = pack8(acc); *(GAS v4u*)(o + 8) = pack8(acc + 8); } } }
        if (part == 0 && F.tid < 64) { float* A64 = (float*)(ws + WS_A64) + (size_t)((g * 2 + d) * 64 + F.tid) * 2; A64[0] = pw[(64 * 64 + F.tid) * 2]; A64[1] = pw[(64 * 64 + F.tid) * 2 + 1]; }
    }
    __syncthreads();
}
__device__ __forceinline__ void ph_s5_finals(Frame& F) {
    const int lane = F.lane, r32 = lane & 31, hh = lane >> 5, wave = F.wave;
    unsigned char* ws = ws_(F);
    for (int u = blockIdx.x; u < 288; u += F.G) {
        const int g = u / 9, nb = u % 9; int chunk = nb * 32 + r32; const bool valid = chunk < NCH; if (!valid) chunk = NCH - 1;
        const bf16* ub = (const bf16*)(ws + WS_UG) + ((size_t)g * TT + (size_t)chunk * 64) * 16 + 8 * hh;
        const bf16* wf = (const bf16*)(ws + WS_WF) + ((size_t)(g * 256 + 32 * wave + r32)) * 1024 + 8 * hh;
        f32x16 acc;
#pragma unroll
        for (int r = 0; r < 16; ++r) acc[r] = 0.f;
#pragma unroll 16
        for (int sI = 0; sI < 64; ++sI) { const bf16x8_t a = *(const GAS bf16x8_t*)(wf + 16 * sI), b = *(const GAS bf16x8_t*)(ub + 16 * sI); acc = __builtin_amdgcn_mfma_f32_32x32x16_bf16(a, b, acc, 0, 0, 0); }
        if (valid) { float* fo = (float*)(ws + WS_FIN) + ((size_t)g * NCH + chunk) * 256 + 32 * wave + 4 * hh;
#pragma unroll
            for (int k = 0; k < 4; ++k) *(GAS f32x4*)(fo + 8 * k) = (f32x4){acc[4 * k], acc[4 * k + 1], acc[4 * k + 2], acc[4 * k + 3]}; }
    }
}
__device__ __forceinline__ int s5_chunk_of(int step, int d, int b) { return step < 4 ? 256 + 4 * b + (d ? 3 - step : step) : 128 * b + (d ? 127 - (step - 4) : step - 4); }
__device__ __forceinline__ void ph_s5_carry(Frame& F) {
    if (F.wave >= 3) return;
    unsigned char* ws = ws_(F);
    for (int item = ((int)F.G - 1 - (int)blockIdx.x) * 3 + F.wave; item < 128; item += 3 * F.G) {
        const int g = item >> 2, d = (item >> 1) & 1, b = item & 1, n = F.lane;
        const float a_r = ((const float*)(ws + WS_A64))[((g * 2 + d) * 64 + n) * 2], a_i = ((const float*)(ws + WS_A64))[((g * 2 + d) * 64 + n) * 2 + 1];
        const float* Fb = (const float*)(ws + WS_FIN) + (size_t)g * NCH * 256 + d * 128 + n; bf16* Sb = (bf16*)(ws + WS_SIN) + (size_t)g * NCH * 256 + d * 128 + n;
        float sr = 0.f, si = 0.f;
        for (int s0 = 0; s0 < 132; s0 += 12) {
            float fr[12], fi[12];
#pragma unroll
            for (int j = 0; j < 12; ++j) { const int c = s5_chunk_of(s0 + j, d, b); fr[j] = Fb[(size_t)c * 256]; fi[j] = Fb[(size_t)c * 256 + 64]; }
#pragma unroll
            for (int j = 0; j < 12; ++j) { const int c = s5_chunk_of(s0 + j, d, b); Sb[(size_t)c * 256] = (bf16)f2bf(sr); Sb[(size_t)c * 256 + 64] = (bf16)f2bf(si);
                const float nr = a_r * sr - a_i * si + fr[j], ni = a_r * si + a_i * sr + fi[j]; sr = nr; si = ni; }
        }
    }
}
constexpr int TP_PITCH = 48;
__device__ __forceinline__ void ph_s5_out(Frame& F) {
    LAS unsigned char* L = F.lds + RING_OFF;
    const int lane = F.lane, r32 = lane & 31, hh = lane >> 5, wave = F.wave, tid = F.tid;
    unsigned char* ws = ws_(F);
    for (int u = blockIdx.x; u < 288; u += F.G) {
        const int g = u / 9, nb = u % 9; int chunk = nb * 32 + r32; const bool valid = chunk < NCH; if (!valid) chunk = NCH - 1;
        __syncthreads();
        { const GAS v4u* tp = (const GAS v4u*)((const bf16*)(ws + WS_TOEP) + (size_t)g * 127 * 256); const float* t0 = (const float*)(ws + WS_T0) + (size_t)g * 512;
          for (int c = tid; c < 127 * 32; c += 512) { const int di = c >> 5, p = (c >> 1) & 15, half = c & 1; v4u v;
              if (di == 63) { float o[8];
#pragma unroll
                  for (int j = 0; j < 8; ++j) o[j] = t0[p * 16 + half * 8 + j] + t0[256 + p * 16 + half * 8 + j];
                  v = pack8(o); }
              else v = tp[c];
              *(LAS v4u*)(L + (di * 16 + p) * TP_PITCH + half * 16) = v; } }
        __syncthreads();
        const bf16* ub = (const bf16*)(ws + WS_UG) + ((size_t)g * TT + (size_t)chunk * 64) * 16 + 8 * hh;
        f32x16 acc[4];
#pragma unroll
        for (int i = 0; i < 4; ++i)
#pragma unroll
            for (int r = 0; r < 16; ++r) acc[i][r] = 0.f;
        const LAS unsigned char* tl = L + ((63 + 2 * wave + (r32 >> 4)) * 16 + (r32 & 15)) * TP_PITCH + hh * 16;
#pragma unroll 1
        for (int s0 = 0; s0 < 64; s0 += 16) {
            bf16x8_t bq[16];
#pragma unroll
            for (int e = 0; e < 16; ++e) bq[e] = *(const GAS bf16x8_t*)(ub + 16 * (s0 + e));
#pragma unroll
            for (int e = 0; e < 16; ++e) { const int sI = s0 + e; const bf16x8_t b = bq[e];
#pragma unroll
            for (int i = 0; i < 4; ++i) { const bf16x8_t a = *(const LAS bf16x8_t*)(tl + (16 * i - sI) * 16 * TP_PITCH); acc[i] = __builtin_amdgcn_mfma_f32_32x32x16_bf16(a, b, acc[i], 0, 0, 0); }
            }
        }
        { const bf16* sb = (const bf16*)(ws + WS_SIN) + ((size_t)g * NCH + chunk) * 256 + 8 * hh;
          const bf16* wc = (const bf16*)(ws + WS_WC) + ((size_t)g * 1024 + 32 * wave + r32) * 256 + 8 * hh;
#pragma unroll 4
          for (int kk = 0; kk < 16; ++kk) {
              const bf16x8_t b = *(const GAS bf16x8_t*)(sb + 16 * kk);
#pragma unroll
              for (int i = 0; i < 4; ++i) { const bf16x8_t a = *(const GAS bf16x8_t*)(wc + (size_t)(256 * i) * 256 + 16 * kk); acc[i] = __builtin_amdgcn_mfma_f32_32x32x16_bf16(a, b, acc[i], 0, 0, 0); }
          } }
        if (valid) {
            const float* dsk = inp(F, 24) + 16 * g;
#pragma unroll
            for (int i = 0; i < 4; ++i)
#pragma unroll
                for (int k = 0; k < 4; ++k) { const int tloc = 2 * (wave + 8 * i) + (k >> 1), p0 = 8 * (k & 1) + 4 * hh; const size_t m = (size_t)chunk * 64 + tloc;
                    const v2u uw = *(const GAS v2u*)((const bf16*)(ws + WS_UG) + ((size_t)g * TT + m) * 16 + p0);
                    const float y0 = gelu_tanh(acc[i][4 * k] + dsk[p0] * bflo(uw.x)), y1 = gelu_tanh(acc[i][4 * k + 1] + dsk[p0 + 1] * bfhi(uw.x));
                    const float y2 = gelu_tanh(acc[i][4 * k + 2] + dsk[p0 + 2] * bflo(uw.y)), y3 = gelu_tanh(acc[i][4 * k + 3] + dsk[p0 + 3] * bfhi(uw.y));
                    v2u zw; zw.x = pk2(y0, y1); zw.y = pk2(y2, y3);
                    *(GAS v2u*)((bf16*)(ws + WS_Z) + m * 512 + 16 * g + p0) = zw; }
        }
    }
}

__device__ __forceinline__ bf16x8_t pack_frag(const f32x16& p, int base) {
    v4u w; w.x = pg8::cvt_pk_bf16(p[base + 0], p[base + 1]); w.y = pg8::cvt_pk_bf16(p[base + 2], p[base + 3]); w.z = pg8::cvt_pk_bf16(p[base + 4], p[base + 5]); w.w = pg8::cvt_pk_bf16(p[base + 6], p[base + 7]);
    return __builtin_bit_cast(bf16x8_t, w);
}
constexpr int AT_KP = 208, AT_VP = 272;
constexpr int AT_KB = 128 * AT_KP, AT_VB = 64 * AT_VP;
constexpr int AT_K0 = 0, AT_V0 = 2 * AT_KB, AT_WS = 2 * AT_KB + 2 * AT_VB;
__device__ __forceinline__ void ph_attn(Frame& F) {
    LAS unsigned char* L = F.lds + RING_OFF;
    const int lane = F.lane, r32 = lane & 31, hi = lane >> 5, wave = F.wave, tid = F.tid;
    volatile LAS float* wsf = (volatile LAS float*)(L + AT_WS) + wave * 32;
    const bf16* Qb = (const bf16*)(ws_(F) + WS_QB); const bf16* Kb = (const bf16*)(ws_(F) + WS_KB); const bf16* Vt = (const bf16*)(ws_(F) + WS_VB);
    bf16* MIX = (bf16*)(ws_(F) + WS_MIX);
    int kl[3], vl[2];
#pragma unroll
    for (int i = 0; i < 3; ++i) { const int c = tid + 512 * i; kl[i] = (c / 12) * AT_KP + (c % 12) * 16; }
#pragma unroll
    for (int i = 0; i < 2; ++i) { const int c = tid + 512 * i; vl[i] = ((c & 511) >> 3) * AT_VP + (c >> 9) * 128 + (c & 7) * 16; }
    for (int it = 0; it < 3; ++it) {
        int u; if (it < 2) u = it * 256 + F.vcu; else { if (F.vcu >= 16) break; u = 512 + F.vcu; }
        int b, h, tq0, NT, m0;
        if (u < 512) { b = u >> 8; h = (u >> 5) & 7; tq0 = (u & 31) * 256; NT = TQK / 128; m0 = b * SEQ + tq0; }
        else { const int uc = u - 512; b = uc >> 3; h = uc & 7; tq0 = SEQ; NT = CTXL / 128; m0 = TL + b * CTXL; }
        const size_t bh = (size_t)(b * 8 + h);
        const GAS v4u* Kg = (const GAS v4u*)(Kb + bh * TQK * 96);
        const GAS v4u* Vg = (const GAS v4u*)(Vt + bh * (TQK / 64) * 4096);
        bf16x8_t qf[6];
        { const bf16* qp = Qb + (bh * TQK + tq0 + wave * 32 + r32) * 96 + hi * 8;
#pragma unroll
          for (int ks = 0; ks < 6; ++ks) qf[ks] = *(const GAS bf16x8_t*)(qp + ks * 16); }
        f32x16 o0, o1;
#pragma unroll
        for (int r = 0; r < 16; ++r) { o0[r] = 0.f; o1[r] = 0.f; }
        float m_run = -1e30f, l_run = 0.f;
        __syncthreads();
        { v4u a[3], v[2];
#pragma unroll
          for (int i = 0; i < 3; ++i) a[i] = Kg[tid + 512 * i];
#pragma unroll
          for (int i = 0; i < 2; ++i) v[i] = Vg[tid + 512 * i];
#pragma unroll
          for (int i = 0; i < 3; ++i) *(LAS v4u*)(L + AT_K0 + kl[i]) = a[i];
#pragma unroll
          for (int i = 0; i < 2; ++i) *(LAS v4u*)(L + AT_V0 + vl[i]) = v[i]; }
        __syncthreads();
        for (int t = 0; t < NT; ++t) {
            const int cur = t & 1, nxt = cur ^ 1; const bool more = (t + 1 < NT);
            v4u na[3], nv[2];
#pragma unroll
            for (int i = 0; i < 3; ++i) na[i] = (v4u){0u, 0u, 0u, 0u};
#pragma unroll
            for (int i = 0; i < 2; ++i) nv[i] = (v4u){0u, 0u, 0u, 0u};
            if (more) {
#pragma unroll
                for (int i = 0; i < 3; ++i) na[i] = Kg[(size_t)(t + 1) * 1536 + tid + 512 * i];
#pragma unroll
                for (int i = 0; i < 2; ++i) nv[i] = Vg[(size_t)(t + 1) * 1024 + tid + 512 * i]; }
            const LAS unsigned char* Kl = L + AT_K0 + cur * AT_KB + r32 * AT_KP + hi * 16;
            const LAS unsigned char* Vl = L + AT_V0 + cur * AT_VB + r32 * AT_VP + hi * 16;
            f32x16 p[4];
#pragma unroll
            for (int kb = 0; kb < 4; ++kb) {
#pragma unroll
                for (int r = 0; r < 16; ++r) p[kb][r] = 0.f;
#pragma unroll
                for (int ks = 0; ks < 6; ++ks) p[kb] = __builtin_amdgcn_mfma_f32_32x32x16_bf16(*(const LAS bf16x8_t*)(Kl + kb * 32 * AT_KP + ks * 32), qf[ks], p[kb], 0, 0, 0);
            }
            float mt = fmaxf(fmaxf(p[0][0], p[1][0]), fmaxf(p[2][0], p[3][0]));
#pragma unroll
            for (int r = 1; r < 16; ++r) mt = fmaxf(mt, fmaxf(fmaxf(p[0][r], p[1][r]), fmaxf(p[2][r], p[3][r])));
            mt = fmaxf(mt, __shfl_xor(mt, 32));
            const bool need = mt > m_run + 8.0f;
            if (__any(need)) {
                const float mn = need ? mt : m_run, alpha = __builtin_amdgcn_exp2f(m_run - mn);
                l_run *= alpha; m_run = mn;
                if (hi == 0) wsf[r32] = alpha;
#pragma unroll
                for (int r = 0; r < 16; ++r) { const float a = wsf[crow(r, hi)]; o0[r] *= a; o1[r] *= a; }
            }
            float sum = 0.f;
#pragma unroll
            for (int kb = 0; kb < 4; ++kb)
#pragma unroll
                for (int r = 0; r < 16; ++r) { p[kb][r] = __builtin_amdgcn_exp2f(p[kb][r] - m_run); sum += p[kb][r]; }
            l_run += sum;
#pragma unroll
            for (int kb = 0; kb < 4; ++kb) {
                const bf16x8_t pa = pack_frag(p[kb], 0), pb = pack_frag(p[kb], 8);
                const LAS unsigned char* vp = Vl + (kb >> 1) * 128 + (kb & 1) * 64;
                o0 = __builtin_amdgcn_mfma_f32_32x32x16_bf16(pa, *(const LAS bf16x8_t*)(vp), o0, 0, 0, 0);
                o0 = __builtin_amdgcn_mfma_f32_32x32x16_bf16(pb, *(const LAS bf16x8_t*)(vp + 32), o0, 0, 0, 0);
                o1 = __builtin_amdgcn_mfma_f32_32x32x16_bf16(pa, *(const LAS bf16x8_t*)(vp + 32 * AT_VP), o1, 0, 0, 0);
                o1 = __builtin_amdgcn_mfma_f32_32x32x16_bf16(pb, *(const LAS bf16x8_t*)(vp + 32 * AT_VP + 32), o1, 0, 0, 0);
            }
            if (more) {
#pragma unroll
                for (int i = 0; i < 3; ++i) *(LAS v4u*)(L + AT_K0 + nxt * AT_KB + kl[i]) = na[i];
#pragma unroll
                for (int i = 0; i < 2; ++i) *(LAS v4u*)(L + AT_V0 + nxt * AT_VB + vl[i]) = nv[i]; }
            __syncthreads();
        }
        l_run += __shfl_xor(l_run, 32);
        if (hi == 0) wsf[r32] = 1.0f / l_run;
#pragma unroll
        for (int r = 0; r < 16; ++r) { const int q = crow(r, hi); const float inv = wsf[q];
            bf16* op = MIX + (size_t)(m0 + wave * 32 + q) * D + h * 64 + r32;
            op[0] = (bf16)f2bf(o0[r] * inv); op[32] = (bf16)f2bf(o1[r] * inv); }
    }
}

constexpr int HG_QT = 0, HG_KT = 17408, HG_KH = 34816, HG_VT = 53248, HG_ST = 71680, HG_DEC = 106496, HG_TOT = 107008;
constexpr int HG_NSC = 17;
constexpr size_t WS_SD = 231 * MiB;
constexpr size_t WS_DECS = WS_SD + 18 * MiB;
static_assert(WS_DECS + 32 * 17 * 128 * 4 <= WS_END, "hgrn ws");
template <bool OUT>
__device__ __forceinline__ void hgrn_pass(Frame& F, int b, int h, int dir, int sc, f32x16 (&st)[2], float& dsum) {
    LAS unsigned char* L = F.lds + RING_OFF;
    unsigned char* ws = ws_(F);
    const int tid = F.tid, lane = F.lane, r32 = lane & 31, hh = lane >> 5, wave = F.wave;
    const int k = tid & 127, tg = tid >> 7;
    const int nch = sc == 0 ? 4 : 8; const size_t rowbase = sc == 0 ? (size_t)TL + b * CTXL : (size_t)b * SEQ + (size_t)(sc - 1) * 512;
    const bf16* QF = (const bf16*)(ws + WS_QFFI);
    const float lb = ((const float*)(ws + WS_LBV))[dir * 1024 + h * 128 + k];
    const int colf = 1024 * (1 + dir) + h * 128 + k, colq = h * 128 + k, colv = 3072 + h * 128 + k;
    const int dvb = wave & 3, jb = wave >> 2;
    bf16 rq[16], rf[16], rv[16];
#define HG_LOAD(ci) do { const int cc_ = dir ? nch - 1 - (ci) : (ci); const int tl0_ = dir ? 63 - 16 * tg : 16 * tg; \
        const GAS bf16* pf_ = (const GAS bf16*)(QF + (rowbase + 64 * cc_ + tl0_) * 4096 + colf); const GAS bf16* pv_ = pf_ + (colv - colf); const GAS bf16* pq_ = pf_ + (colq - colf); const long stp_ = dir ? -4096 : 4096; \
        _Pragma("unroll") for (int jj = 0; jj < 16; ++jj) { rf[jj] = *pf_; rv[jj] = *pv_; if (OUT) rq[jj] = *pq_; pf_ += stp_; pv_ += stp_; pq_ += stp_; asm volatile("" : "+v"(pf_), "+v"(pv_), "+v"(pq_)); } } while (0)
    HG_LOAD(0);
    for (int ci = 0; ci < nch; ++ci) {
        const int cc = dir ? nch - 1 - ci : ci;
        float cum[16], kk[16];
        { float run = 0.f;
#pragma unroll
          for (int jj = 0; jj < 16; ++jj) { const float f = lb + (1.f - lb) * sigmoidf_(bf2f(rf[jj])); run += __log2f(f); cum[jj] = run; kk[jj] = 1.f - f; }
          ((LAS float*)(L + HG_TOT))[tg * 128 + k] = run; }
        __syncthreads();
        { const LAS float* tot = (const LAS float*)(L + HG_TOT) + k; const float t0 = tot[0], t1 = tot[128], t2 = tot[256], t3 = tot[384];
          const float pre = tg == 0 ? 0.f : (tg == 1 ? t0 : (tg == 2 ? t0 + t1 : t0 + t1 + t2)), total = (t0 + t1) + (t2 + t3);
          if (tg == 0) { ((LAS float*)(L + HG_DEC))[k] = __builtin_amdgcn_exp2f(total); dsum += total; }
#define HG_KH(jj) (kk[jj] * __builtin_amdgcn_exp2f(total - (pre + cum[jj])))
#define HG_PKV(a, b_) ((unsigned)rv[a] | ((unsigned)rv[b_] << 16))
          if (OUT) {
#pragma unroll
              for (int jj = 0; jj < 16; ++jj) { const float c = pre + cum[jj]; const int j = 16 * tg + jj;
                  *(LAS bf16*)(L + HG_QT + j * 272 + k * 2) = (bf16)f2bf(bf2f(rq[jj]) * __builtin_amdgcn_exp2f(c)); *(LAS bf16*)(L + HG_KT + j * 272 + k * 2) = (bf16)f2bf(kk[jj] * __builtin_amdgcn_exp2f(-c)); } }
          v4u w0, w1;
          w0.x = pk2(HG_KH(0), HG_KH(1)); w0.y = pk2(HG_KH(2), HG_KH(3)); w0.z = pk2(HG_KH(8), HG_KH(9)); w0.w = pk2(HG_KH(10), HG_KH(11));
          w1.x = pk2(HG_KH(4), HG_KH(5)); w1.y = pk2(HG_KH(6), HG_KH(7)); w1.z = pk2(HG_KH(12), HG_KH(13)); w1.w = pk2(HG_KH(14), HG_KH(15));
          *(LAS v4u*)(L + HG_KH + k * 144 + tg * 32) = w0; *(LAS v4u*)(L + HG_KH + k * 144 + tg * 32 + 16) = w1;
          w0.x = HG_PKV(0, 1); w0.y = HG_PKV(2, 3); w0.z = HG_PKV(8, 9); w0.w = HG_PKV(10, 11);
          w1.x = HG_PKV(4, 5); w1.y = HG_PKV(6, 7); w1.z = HG_PKV(12, 13); w1.w = HG_PKV(14, 15);
          *(LAS v4u*)(L + HG_VT + k * 144 + tg * 32) = w0; *(LAS v4u*)(L + HG_VT + k * 144 + tg * 32 + 16) = w1; }
#undef HG_KH
#undef HG_PKV
        if (ci + 1 < nch) HG_LOAD(ci + 1);
        __syncthreads();
        if (OUT) {
            f32x16 oacc;
#pragma unroll
            for (int r = 0; r < 16; ++r) oacc[r] = 0.f;
            const LAS unsigned char* qrow = L + HG_QT + (32 * jb + r32) * 272 + hh * 16;
            const LAS unsigned char* srow = L + HG_ST + (32 * dvb + r32) * 272 + hh * 16;
            const LAS unsigned char* vrow = L + HG_VT + (32 * dvb + r32) * 144 + hh * 16;
#pragma unroll
            for (int ks = 0; ks < 8; ++ks) oacc = __builtin_amdgcn_mfma_f32_32x32x16_bf16(*(const LAS bf16x8_t*)(qrow + ks * 32), *(const LAS bf16x8_t*)(srow + ks * 32), oacc, 0, 0, 0);
            {
                f32x16 at;
#pragma unroll
                for (int r = 0; r < 16; ++r) at[r] = 0.f;
                const LAS unsigned char* krow = L + HG_KT + r32 * 272 + hh * 16;
#pragma unroll
                for (int ks = 0; ks < 8; ++ks) at = __builtin_amdgcn_mfma_f32_32x32x16_bf16(*(const LAS bf16x8_t*)(krow + ks * 32), *(const LAS bf16x8_t*)(qrow + ks * 32), at, 0, 0, 0);
                if (jb == 0) {
#pragma unroll
                    for (int r = 0; r < 16; ++r) if (crow(r, hh) > r32) at[r] = 0.f; }
                oacc = __builtin_amdgcn_mfma_f32_32x32x16_bf16(pack_frag(at, 0), *(const LAS bf16x8_t*)(vrow + 0), oacc, 0, 0, 0);
                oacc = __builtin_amdgcn_mfma_f32_32x32x16_bf16(pack_frag(at, 8), *(const LAS bf16x8_t*)(vrow + 32), oacc, 0, 0, 0);
            }
            if (jb == 1) {
                f32x16 at;
#pragma unroll
                for (int r = 0; r < 16; ++r) at[r] = 0.f;
                const LAS unsigned char* krow = L + HG_KT + (32 + r32) * 272 + hh * 16;
#pragma unroll
                for (int ks = 0; ks < 8; ++ks) at = __builtin_amdgcn_mfma_f32_32x32x16_bf16(*(const LAS bf16x8_t*)(krow + ks * 32), *(const LAS bf16x8_t*)(qrow + ks * 32), at, 0, 0, 0);
#pragma unroll
                for (int r = 0; r < 16; ++r) if (crow(r, hh) > r32) at[r] = 0.f;
                oacc = __builtin_amdgcn_mfma_f32_32x32x16_bf16(pack_frag(at, 0), *(const LAS bf16x8_t*)(vrow + 64), oacc, 0, 0, 0);
                oacc = __builtin_amdgcn_mfma_f32_32x32x16_bf16(pack_frag(at, 8), *(const LAS bf16x8_t*)(vrow + 96), oacc, 0, 0, 0);
            }
            bf16* O = (bf16*)(ws + WS_O);
#pragma unroll
            for (int r = 0; r < 16; ++r) { const int j = 32 * jb + crow(r, hh), tl = dir ? 63 - j : j;
                bf16* op = O + (rowbase + 64 * cc + tl) * D + h * 128 + 32 * dvb + r32; float ov = oacc[r];
                if (dir) ov += bf2f(*op);
                *op = (bf16)f2bf(ov); }
        }
#pragma unroll
        for (int t = 0; t < 2; ++t) { const int dkb = 2 * (wave >> 2) + t;
#pragma unroll
            for (int q4 = 0; q4 < 4; ++q4) { const f32x4 dd = *(const LAS f32x4*)(L + HG_DEC + (32 * dkb + 8 * q4 + 4 * hh) * 4);
                st[t][4 * q4] *= dd[0]; st[t][4 * q4 + 1] *= dd[1]; st[t][4 * q4 + 2] *= dd[2]; st[t][4 * q4 + 3] *= dd[3]; }
            const LAS unsigned char* arow = L + HG_KH + (32 * dkb + r32) * 144 + hh * 16; const LAS unsigned char* vrow = L + HG_VT + (32 * dvb + r32) * 144 + hh * 16;
#pragma unroll
            for (int ks = 0; ks < 4; ++ks) st[t] = __builtin_amdgcn_mfma_f32_32x32x16_bf16(*(const LAS bf16x8_t*)(arow + ks * 32), *(const LAS bf16x8_t*)(vrow + ks * 32), st[t], 0, 0, 0); }
        __syncthreads();
        if (OUT && ci + 1 < nch) {
#pragma unroll
            for (int t = 0; t < 2; ++t) { const int dkb = 2 * (wave >> 2) + t;
#pragma unroll
                for (int q4 = 0; q4 < 4; ++q4) { v2u w; w.x = pk2(st[t][4 * q4], st[t][4 * q4 + 1]); w.y = pk2(st[t][4 * q4 + 2], st[t][4 * q4 + 3]);
                    *(LAS v2u*)(L + HG_ST + (32 * dvb + r32) * 272 + (32 * dkb + 8 * q4 + 4 * hh) * 2) = w; } }
        }
    }
#undef HG_LOAD
}
__device__ __forceinline__ void ph_hgrn_states(Frame& F) {
    unsigned char* ws = ws_(F);
    for (int item = blockIdx.x; item < 32 * HG_NSC; item += F.G) {
        const int chain = item / HG_NSC, sc = item % HG_NSC, b = chain >> 4, h = (chain >> 1) & 7, dir = chain & 1;
        f32x16 st[2];
#pragma unroll
        for (int t = 0; t < 2; ++t)
#pragma unroll
            for (int r = 0; r < 16; ++r) st[t][r] = 0.f;
        float dsum = 0.f;
        hgrn_pass<false>(F, b, h, dir, sc, st, dsum);
        bf16* sd = (bf16*)(ws + WS_SD) + ((size_t)(chain * HG_NSC + sc) * 8 + F.wave) * 2048 + F.lane;
#pragma unroll
        for (int t = 0; t < 2; ++t)
#pragma unroll
            for (int r = 0; r < 16; ++r) sd[(t * 16 + r) * 64] = (bf16)f2bf(st[t][r]);
        if (F.tid < 128) ((float*)(ws + WS_DECS))[(size_t)(chain * HG_NSC + sc) * 128 + F.tid] = dsum;
    }
}
__device__ __forceinline__ void ph_hgrn_carry(Frame& F) {
    unsigned char* ws = ws_(F);
    const int gt = F.vcu * 512 + F.tid, NT = F.G * 512;
    for (int idx = gt; idx < 32 * 16384; idx += NT) {
        const int chain = idx >> 14, e = idx & 16383, dir = chain & 1;
        const int lane = e & 63, r = (e >> 6) & 15, t = (e >> 10) & 1, wv = e >> 11, dk = 32 * (2 * (wv >> 2) + t) + crow(r, lane >> 5);
        bf16* sd = (bf16*)(ws + WS_SD) + (size_t)chain * HG_NSC * 16384 + e; const float* dl = (const float*)(ws + WS_DECS) + (size_t)chain * HG_NSC * 128 + dk;
        float v[HG_NSC], dd[HG_NSC];
#pragma unroll
        for (int i = 0; i < HG_NSC; ++i) { const int sp = (i == 0) ? 0 : (dir ? 17 - i : i); v[i] = bf2f(sd[(size_t)sp * 16384]); dd[i] = dl[sp * 128]; }
        float S = 0.f;
#pragma unroll
        for (int i = 0; i < HG_NSC; ++i) { const int sp = (i == 0) ? 0 : (dir ? 17 - i : i); sd[(size_t)sp * 16384] = (bf16)f2bf(S); S = __builtin_amdgcn_exp2f(dd[i]) * S + v[i]; }
    }
}
__device__ __forceinline__ void ph_hgrn_out(Frame& F) {
    LAS unsigned char* L = F.lds + RING_OFF;
    unsigned char* ws = ws_(F);
    const int lane = F.lane, r32 = lane & 31, hh = lane >> 5, wave = F.wave, dvb = wave & 3;
    for (int item = blockIdx.x; item < 256; item += F.G) {
        const int b = item >> 7, h = (item >> 4) & 7, Lsc = item & 15, sc = Lsc + 1;
        for (int dir = 0; dir < 2; ++dir) {
            const int chain = (b * 8 + h) * 2 + dir;
            f32x16 st[2];
#pragma unroll
            for (int t = 0; t < 2; ++t)
#pragma unroll
                for (int r = 0; r < 16; ++r) st[t][r] = 0.f;
            { const bf16* sd = (const bf16*)(ws + WS_SD) + ((size_t)(chain * HG_NSC + sc) * 8 + wave) * 2048 + lane;
#pragma unroll
              for (int t = 0; t < 2; ++t)
#pragma unroll
                  for (int r = 0; r < 16; ++r) st[t][r] = bf2f(sd[(t * 16 + r) * 64]); }
            __syncthreads();
#pragma unroll
            for (int t = 0; t < 2; ++t) { const int dkb = 2 * (wave >> 2) + t;
#pragma unroll
                for (int q4 = 0; q4 < 4; ++q4) { v2u w; w.x = pk2(st[t][4 * q4], st[t][4 * q4 + 1]); w.y = pk2(st[t][4 * q4 + 2], st[t][4 * q4 + 3]);
                    *(LAS v2u*)(L + HG_ST + (32 * dvb + r32) * 272 + (32 * dkb + 8 * q4 + 4 * hh) * 2) = w; } }
            float dsum = 0.f;
            hgrn_pass<true>(F, b, h, dir, sc, st, dsum);
            __syncthreads();
        }
    }
}

struct FInProj {
    bf16* cqkv; bf16* ug;
    __device__ __forceinline__ void operator()(int row, int col, f32x4 v0, f32x4 v1) const {
        v4u w; w.x = pg8::cvt_pk_bf16(v0[0], v0[1]); w.y = pg8::cvt_pk_bf16(v0[2], v0[3]); w.z = pg8::cvt_pk_bf16(v1[0], v1[1]); w.w = pg8::cvt_pk_bf16(v1[2], v1[3]);
        if (col < 672) *(GAS v4u*)(cqkv + (size_t)row * CQKV_LD + col) = w;
        else if (col < EVEN_IN) { const int c = col - 672; *(GAS v4u*)(ug + ((size_t)(c >> 4) * TT + row) * 16 + (c & 15)) = w; }
    }
};
struct FBf16 {
    bf16* o; int ld;
    __device__ __forceinline__ void operator()(int row, int col, f32x4 v0, f32x4 v1) const {
        v4u w; w.x = pg8::cvt_pk_bf16(v0[0], v0[1]); w.y = pg8::cvt_pk_bf16(v0[2], v0[3]); w.z = pg8::cvt_pk_bf16(v1[0], v1[1]); w.w = pg8::cvt_pk_bf16(v1[2], v1[3]);
        *(GAS v4u*)(o + (size_t)row * ld + col) = w;
    }
};
struct EpiGlu {
    static constexpr bool PERM = true, AFTER_DRAIN = false;
    const bf16* z; bf16* mix;
    __device__ __forceinline__ void operator()(const pg8::f32x4 (&acc)[2][2][4][2], const pg8::Unit& u, int wr, int wc, int fr, int fq) const {
        const int row0 = u.pm * 256 + wr * 64 + fr, col0 = u.pn * 256 + wc * 32 + 8 * fq;
#pragma unroll
        for (int ai = 0; ai < 2; ++ai) {
            v4u zz[4][2];
#pragma unroll
            for (int m = 0; m < 4; ++m)
#pragma unroll
                for (int bj = 0; bj < 2; ++bj) zz[m][bj] = *(const GAS v4u*)(z + (size_t)(row0 + ai * 128 + m * 16) * 512 + col0 + bj * 128);
#pragma unroll
            for (int m = 0; m < 4; ++m)
#pragma unroll
                for (int bj = 0; bj < 2; ++bj) { float zf[8], o[8]; unpack8(zz[m][bj], zf);
#pragma unroll
                    for (int j = 0; j < 4; ++j) { o[j] = zf[j] * sigmoidf_(acc[ai][bj][m][0][j]); o[4 + j] = zf[4 + j] * sigmoidf_(acc[ai][bj][m][1][j]); }
                    *(GAS v4u*)(mix + (size_t)(row0 + ai * 128 + m * 16) * D + 512 + col0 + bj * 128) = pack8(o); }
        }
    }
};
struct FQ {
    bf16* qb; const float* rope;
    __device__ __forceinline__ void operator()(int row, int col, f32x4 v0, f32x4 v1) const {
        float x[8] = {v0[0], v0[1], v0[2], v0[3], v1[0], v1[1], v1[2], v1[3]}, p[8];
#pragma unroll
        for (int j = 0; j < 8; ++j) p[j] = __shfl_xor(x[j], 16);
        const bool isctx = row >= TL; const int b = isctx ? ((row - TL) >> 8) : (row >> 13), t = isctx ? ((row - TL) & 255) : (row & 8191), tq = isctx ? SEQ + t : t;
        const int h = col / 96, d = col - h * 96;
        if (d >= 64 && !isctx) { const int idx = d - 64, a = idx >> 4, half = (idx >> 3) & 1, pos = a ? (t & 63) : (t >> 6);
#pragma unroll
            for (int f = 0; f < 8; ++f) { const float cs = rope[2 * (pos * 8 + f)], sn = rope[2 * (pos * 8 + f) + 1]; x[f] = half ? x[f] * cs + p[f] * sn : x[f] * cs - p[f] * sn; } }
#pragma unroll
        for (int j = 0; j < 8; ++j) x[j] *= QSCALE;
        *(GAS v4u*)(qb + ((size_t)(b * 8 + h) * TQK + tq) * 96 + d) = pack8(x);
        asm volatile("" ::: "memory");
    }
};
struct FKV {
    bf16* kb; bf16* vb;
    __device__ __forceinline__ void operator()(int row, int col, f32x4 v0, f32x4 v1) const {
        v4u w; w.x = pg8::cvt_pk_bf16(v0[0], v0[1]); w.y = pg8::cvt_pk_bf16(v0[2], v0[3]); w.z = pg8::cvt_pk_bf16(v1[0], v1[1]); w.w = pg8::cvt_pk_bf16(v1[2], v1[3]);
        const bool isctx = row >= TL; const int b = isctx ? ((row - TL) >> 8) : (row >> 13), t = isctx ? ((row - TL) & 255) : (row & 8191), tk = isctx ? t : CTXL + t;
        const int h = col >> 7, e = col & 127;
        if (e < 64) *(GAS v4u*)(kb + ((size_t)(b * 8 + h) * TQK + tk) * 96 + e) = w;
        else { const int kk = tk & 63, pos = (kk & 48) | (kk & 3) | ((kk & 4) << 1) | ((kk & 8) >> 1);
            bf16* p = vb + (((size_t)(b * 8 + h) * (TQK / 64) + (tk >> 6)) * 64 + (e - 64)) * 64 + pos;
            p[0] = (bf16)(w.x & 0xffffu); p[64] = (bf16)(w.x >> 16); p[128] = (bf16)(w.y & 0xffffu); p[192] = (bf16)(w.y >> 16);
            p[256] = (bf16)(w.z & 0xffffu); p[320] = (bf16)(w.z >> 16); p[384] = (bf16)(w.w & 0xffffu); p[448] = (bf16)(w.w >> 16); }
    }
};
struct EpiResid {
    static constexpr bool PERM = false, AFTER_DRAIN = false;
    float* xl; float* xc; const float* gate; int first; int row_off; float* slab; const float* rl = nullptr;
    __device__ __forceinline__ void operator()(const pg8::f32x4 (&acc)[2][2][4][2], const pg8::Unit& u, int wr, int wc, int fr, int fq) const {
        const int trow = u.pm * 256 + row_off, col0 = u.pn * 256 + wc * 32 + 4 * fq;
        if (slab) {
            GAS float* sb = (GAS float*)slab + (size_t)(trow - TL + wr * 64 + fr) * D + col0; const GAS float* gq = (const GAS float*)gate + (size_t)2 * 6144 + col0;
            f32x4 g2[2][2];
#pragma unroll
            for (int bj = 0; bj < 2; ++bj)
#pragma unroll
                for (int n = 0; n < 2; ++n) g2[bj][n] = *(const GAS f32x4*)(gq + bj * 128 + n * 16);
#pragma unroll
            for (int ai = 0; ai < 2; ++ai)
#pragma unroll
                for (int m = 0; m < 4; ++m)
#pragma unroll
                    for (int bj = 0; bj < 2; ++bj)
#pragma unroll
                        for (int n = 0; n < 2; ++n) *(GAS f32x4*)(sb + (size_t)(ai * 128 + m * 16) * D + bj * 128 + n * 16) = g2[bj][n] * acc[ai][bj][m][n];
            return;
        }
        const bool lat = trow < TL;
        GAS float* xb = (GAS float*)(lat ? xl + (size_t)trow * D : xc + (size_t)(trow - TL) * D) + (size_t)(wr * 64 + fr) * D + col0;
        const GAS float* rb = (lat && rl) ? (const GAS float*)rl + (size_t)trow * D + (size_t)(wr * 64 + fr) * D + col0 : (const GAS float*)xb;
        const GAS float* gp = (const GAS float*)gate + (size_t)modrow_of(trow) * 6144 + col0;
        f32x4 gv[2][2];
#pragma unroll
        for (int bj = 0; bj < 2; ++bj)
#pragma unroll
            for (int n = 0; n < 2; ++n) gv[bj][n] = *(const GAS f32x4*)(gp + bj * 128 + n * 16);
        const float a0 = (first && lat) ? DN_ALPHA : 1.0f;
#pragma unroll
        for (int ai = 0; ai < 2; ++ai) {
            f32x4 xo[4][2][2];
#pragma unroll
            for (int m = 0; m < 4; ++m)
#pragma unroll
                for (int bj = 0; bj < 2; ++bj)
#pragma unroll
                    for (int n = 0; n < 2; ++n) xo[m][bj][n] = *(const GAS f32x4*)(rb + (size_t)(ai * 128 + m * 16) * D + bj * 128 + n * 16);
#pragma unroll
            for (int m = 0; m < 4; ++m)
#pragma unroll
                for (int bj = 0; bj < 2; ++bj)
#pragma unroll
                    for (int n = 0; n < 2; ++n) *(GAS f32x4*)(xb + (size_t)(ai * 128 + m * 16) * D + bj * 128 + n * 16) = xo[m][bj][n] * a0 + gv[bj][n] * acc[ai][bj][m][n];
            __builtin_amdgcn_sched_barrier(0);
        }
    }
};
struct FHgIn {
    bf16* qffi; bf16* g;
    __device__ __forceinline__ void operator()(int row, int col, f32x4 v0, f32x4 v1) const {
        v4u w; w.x = pg8::cvt_pk_bf16(v0[0], v0[1]); w.y = pg8::cvt_pk_bf16(v0[2], v0[3]); w.z = pg8::cvt_pk_bf16(v1[0], v1[1]); w.w = pg8::cvt_pk_bf16(v1[2], v1[3]);
        if (col < 4096) *(GAS v4u*)(qffi + (size_t)row * 4096 + col) = w; else *(GAS v4u*)(g + (size_t)row * D + (col - 4096)) = w;
    }
};
struct EpiConvGate {
    static constexpr bool PERM = true, AFTER_DRAIN = false;
    bf16* hg; bf16* ab; bf16* gb; const bf16* cwt;
    __device__ __forceinline__ void operator()(const pg8::f32x4 (&acc)[2][2][4][2], const pg8::Unit& u, int wr, int wc, int fr, int fq) const {
        const int hc0 = 128 * u.pn + 32 * wc + 8 * fq;
        v4u wq[4];
#pragma unroll
        for (int i = 0; i < 4; ++i) wq[i] = *(const GAS v4u*)(cwt + (size_t)(hc0 + 2 * i) * 4);
#pragma unroll
        for (int ai = 0; ai < 2; ++ai) {
            const int rowbase = u.pm * 256 + 128 * ai + 64 * wr, g64 = rowbase >> 6;
#pragma unroll
            for (int n = 0; n < 2; ++n) {
                const int hc = hc0 + 4 * n;
                float out[4][4];
#pragma unroll
                for (int e = 0; e < 4; ++e) { const int c = 4 * n + e; const unsigned pw0 = (c & 1) ? wq[c >> 1].z : wq[c >> 1].x, pw1 = (c & 1) ? wq[c >> 1].w : wq[c >> 1].y;
                    const float w0 = bflo(pw0), w1 = bfhi(pw0), w2 = bflo(pw1), b0 = bfhi(pw1);
                    float a[4], up[4], dn[4];
#pragma unroll
                    for (int m = 0; m < 4; ++m) { a[m] = acc[ai][0][m][n][e];
                        up[m] = __builtin_bit_cast(float, __builtin_amdgcn_mov_dpp(__builtin_bit_cast(int, a[m]), 0x121, 0xf, 0xf, false));
                        dn[m] = __builtin_bit_cast(float, __builtin_amdgcn_mov_dpp(__builtin_bit_cast(int, a[m]), 0x12f, 0xf, 0xf, false)); }
#pragma unroll
                    for (int m = 0; m < 4; ++m) { const float prev = fr > 0 ? up[m] : (m > 0 ? up[m > 0 ? m - 1 : 0] : 0.f), next = fr < 15 ? dn[m] : (m < 3 ? dn[m < 3 ? m + 1 : 3] : 0.f);
                        const float cv = b0 + w0 * prev + w1 * a[m] + w2 * next; out[m][e] = siluf_(cv) * acc[ai][1][m][n][e]; } }
#pragma unroll
                for (int m = 0; m < 4; ++m) { const int r64 = 16 * m + fr, row = rowbase + r64;
                    if (r64 != 0 && r64 != 63) { v2u w; w.x = pk2(out[m][0], out[m][1]); w.y = pk2(out[m][2], out[m][3]); *(GAS v2u*)(hg + (size_t)row * FFH + hc) = w; }
                    if (r64 <= 1 || r64 >= 62) { const int slot = r64 <= 1 ? r64 : r64 - 60; const f32x4 ra = acc[ai][0][m][n];
                        v2u w; w.x = pk2(ra[0], ra[1]); w.y = pk2(ra[2], ra[3]); *(GAS v2u*)(ab + (size_t)(g64 * 4 + slot) * FFH + hc) = w;
                        if (r64 == 0 || r64 == 63) { const f32x4 rg = acc[ai][1][m][n]; v2u wg; wg.x = pk2(rg[0], rg[1]); wg.y = pk2(rg[2], rg[3]); *(GAS v2u*)(gb + (size_t)(g64 * 2 + (r64 == 63 ? 1 : 0)) * FFH + hc) = wg; } }
                }
                __builtin_amdgcn_sched_barrier(0);
            }
        }
    }
};
template <class E> __device__ __forceinline__ void run_gemm_off(Frame& F, const bf16* A, int lda, const bf16* Bt, int ldb, int M, int N, int K, const E& e, int boff) {
    pg8::Gemm g{A, Bt, M, N, K, lda, ldb}; pg8::StaticOrder S; S.init(M, N, F.G, (int)((blockIdx.x + F.G - boff) % F.G));
    pg8::gemm_phase<E, pg8::StaticOrder, true, true>(F.lds + RING_OFF, g, S, e);
}
template <class E> __device__ __forceinline__ void run_gemm(Frame& F, const bf16* A, int lda, const bf16* Bt, int ldb, int M, int N, int K, const E& e) {
    pg8::Gemm g{A, Bt, M, N, K, lda, ldb}; pg8::StaticOrder S; S.init(M, N, F.G, (int)blockIdx.x);
    pg8::gemm_phase<E, pg8::StaticOrder, true, true>(F.lds + RING_OFF, g, S, e);
}

constexpr int NPH = 27;
struct Args { const float* in[31]; float* out; unsigned char* ws; int ph_lo, ph_hi; };
__global__ void __launch_bounds__(NWAVES * 64, 2) mk_fwd(Args args) {
    extern __shared__ __attribute__((aligned(16))) unsigned char lds[];
    Frame F;
    F.lds = (LAS unsigned char*)lds;
    F.tid = threadIdx.x; F.lane = F.tid & 63; F.wave = __builtin_amdgcn_readfirstlane(F.tid >> 6);
    F.G = gridDim.x; { const int bx = blockIdx.x; F.vcu = (F.G % 8 == 0) ? (bx % 8) * (F.G / 8) + bx / 8 : bx; }
    for (int u = F.tid; u < (LDS_BYTES - LDSCTL_OFF) / 4; u += NWAVES * 64) ((LAS unsigned*)(F.lds + LDSCTL_OFF))[u] = 0u;
    __syncthreads();
    if (F.tid == 0) {
#pragma unroll
        for (int i = 0; i < 31; ++i) ((LAS unsigned long long*)(F.lds + PTR_OFF))[i] = (unsigned long long)args.in[i];
        ((LAS unsigned long long*)(F.lds + PTR_OFF))[31] = (unsigned long long)args.ws; ((LAS unsigned long long*)(F.lds + PTR_OFF))[32] = (unsigned long long)args.out;
    }
    __syncthreads();
    const int lo = args.ph_lo, hi = args.ph_hi;
    const bool multi = (hi - lo) > 1;
    if (multi) (void)xcd_barrier_post((unsigned*)ws_(F) + CW_BAR, (volatile LAS unsigned*)(F.lds + MISC_OFF) + 8);
#ifndef ONLY_PHASE
#define ONLY_PHASE -1
#endif
#define WSP ws_(F)
#define MODP ((const float*)(ws_(F) + WS_MOD))
#define ABUF ((bf16*)(ws_(F) + WS_A))
#ifndef SKIP_PHASE
#define SKIP_PHASE -1
#endif
#define IN(k) ((ONLY_PHASE < 0 || ONLY_PHASE == (k)) && SKIP_PHASE != (k) && lo <= (k) && (k) < hi)
#define SEAM(k) do { if (IN(k) && IN((k) + 1)) { XcdBarrier bar_; bar_.bar = (unsigned*)ws_(F) + CW_BAR; bar_.x = xb_xcc_id(); bar_.st = (volatile LAS unsigned*)(F.lds + MISC_OFF) + 8; xcd_barrier(bar_); } asm volatile("" : "+v"(F.tid), "+v"(F.lane)); } while (0)
    int pk = 0;
#ifndef REPEAT_PHASE
#define REPEAT_PHASE -1
#endif
#define PHASE(...) do { if (IN(pk)) { __VA_ARGS__ } if (REPEAT_PHASE == pk && IN(pk)) { { XcdBarrier bar_; bar_.bar = (unsigned*)ws_(F) + CW_BAR; bar_.x = xb_xcc_id(); bar_.st = (volatile LAS unsigned*)(F.lds + MISC_OFF) + 8; xcd_barrier(bar_); } asm volatile("" : "+v"(F.tid), "+v"(F.lane)); { __VA_ARGS__ } } SEAM(pk); ++pk; } while (0)
    PHASE( p0_prologue(F); for (int rep_ = 0; rep_ < DUP_S5T; ++rep_) p0_s5_tables(F); );
    PHASE( ph_init_rows(F); );
    PHASE( pg8::Epi8<FInProj> e{{(bf16*)(WSP + WS_CQKV), (bf16*)(WSP + WS_UG)}}; run_gemm(F, ABUF, D, (const bf16*)(WSP + WS_WIN0), D, TT, EVEN_IN_PAD, D, e); );
    PHASE( ph_s5_finals(F); );
    PHASE( ph_s5_carry(F); );
    PHASE( ph_mla_norm(F); );
    PHASE(
#ifndef DUPQ
#define DUPQ 1
#endif
#ifndef DUPKV
#define DUPKV 1
#endif
        _Pragma("unroll") for (int rep = 0; rep < DUPQ; ++rep) { pg8::Epi8<FQ> e{{(bf16*)(WSP + WS_QB), (const float*)(WSP + WS_ROPE)}}; run_gemm(F, (const bf16*)(WSP + WS_CQKV), CQKV_LD, (const bf16*)(WSP + WS_WUQ), 384, TT, 768, 384, e); }
        _Pragma("unroll") for (int rep = 0; rep < DUPKV; ++rep) { pg8::Epi8<FKV> e{{(bf16*)(WSP + WS_KB), (bf16*)(WSP + WS_VB)}}; run_gemm(F, (const bf16*)(WSP + WS_CQKV) + 384, CQKV_LD, (const bf16*)(WSP + WS_WUKV), 256, TT, 1024, 256, e); }
    );
    PHASE( ph_s5_out(F); );
    PHASE( ph_attn(F); );
    PHASE( EpiGlu e{(const bf16*)(WSP + WS_Z), (bf16*)(WSP + WS_MIX)}; run_gemm(F, (const bf16*)(WSP + WS_Z), 512, (const bf16*)(WSP + WS_WGLU), 512, TT, 512, 512, e); );
    PHASE(
        { EpiResid e{out_(F), (float*)(WSP + WS_XC), MODP + 0 * 3 * 6144 + 2 * 1024, 1, 0, nullptr, inp(F, 0)}; run_gemm(F, (const bf16*)(WSP + WS_MIX), D, (const bf16*)(WSP + WS_WOUT0), D, TL, D, D, e); }
        _Pragma("unroll") for (int sp = 0; sp < 4; ++sp) { EpiResid e{out_(F), (float*)(WSP + WS_XC), MODP + 0 * 3 * 6144 + 2 * 1024, 1, TL, (float*)(WSP + WS_SLAB1) + (size_t)sp * TC * D};
            run_gemm_off(F, (const bf16*)(WSP + WS_MIX) + (size_t)TL * D + 256 * sp, D, (const bf16*)(WSP + WS_WOUT0) + 256 * sp, D, TC, D, 256, e, 8 * sp); }
    );
    PHASE( ph_layernorm(F, TT, 0, 0, 0, 3, (const float*)(WSP + WS_SLAB1), 4); );
    PHASE( EpiConvGate e{(bf16*)(WSP + WS_HG), (bf16*)(WSP + WS_AB), (bf16*)(WSP + WS_GB), (const bf16*)(WSP + WS_CWT)}; run_gemm(F, ABUF, D, (const bf16*)(WSP + WS_F1T0), D, TT, 2 * FFH, D, e); );
    PHASE( ph_convfix(F, TT, 0); );
    PHASE(
        { EpiResid e{out_(F), (float*)(WSP + WS_XC), MODP + 0 * 3 * 6144 + 5 * 1024, 1, 0, nullptr}; run_gemm(F, (const bf16*)(WSP + WS_HG), FFH, (const bf16*)(WSP + WS_F2T0), FFH, TL, D, FFH, e); }
        _Pragma("unroll") for (int sp = 0; sp < 6; ++sp) { EpiResid e{out_(F), (float*)(WSP + WS_XC), MODP + 0 * 3 * 6144 + 5 * 1024, 1, TL, (float*)(WSP + WS_SLAB2) + (size_t)sp * TC * D};
            run_gemm_off(F, (const bf16*)(WSP + WS_HG) + (size_t)TL * FFH + 512 * sp, FFH, (const bf16*)(WSP + WS_F2T0) + 512 * sp, FFH, TC, D, sp == 5 ? 256 : 512, e, 8 * sp); }
    );
    PHASE( ph_layernorm(F, TT, 0, 1, 1, 0, (const float*)(WSP + WS_SLAB2), 6); );
    PHASE( pg8::Epi8<FHgIn> e{{(bf16*)(WSP + WS_QFFI), (bf16*)(WSP + WS_G)}}; run_gemm(F, ABUF, D, (const bf16*)(WSP + WS_HGINT), D, TT, 5120, D, e); );
    PHASE( ph_hgrn_states(F); );
    PHASE( ph_hgrn_carry(F); );
    PHASE( ph_hgrn_out(F); );
    PHASE( ph_hg_gate(F); );
    PHASE( EpiResid e{out_(F), (float*)(WSP + WS_XC), MODP + 1 * 3 * 6144 + 2 * 1024, 1, 0, nullptr}; run_gemm(F, (const bf16*)(WSP + WS_O), D, (const bf16*)(WSP + WS_HGOUTT), D, TL, D, D, e); );
    PHASE( ph_layernorm(F, TL, 1, 0, 1, 3); );
    PHASE( EpiConvGate e{(bf16*)(WSP + WS_HG), (bf16*)(WSP + WS_AB), (bf16*)(WSP + WS_GB), (const bf16*)(WSP + WS_CWT) + (size_t)FFH * 4}; run_gemm(F, ABUF, D, (const bf16*)(WSP + WS_F1T1), D, TL, 2 * FFH, D, e); );
    PHASE( ph_convfix(F, TL, 1); );
    PHASE( EpiResid e{out_(F), (float*)(WSP + WS_XC), MODP + 1 * 3 * 6144 + 5 * 1024, 1, 0, nullptr}; run_gemm(F, (const bf16*)(WSP + WS_HG), FFH, (const bf16*)(WSP + WS_F2T1), FFH, TL, D, FFH, e); );
    PHASE( ph_layernorm(F, TL, 1, 1, -1, 0); );
#undef PHASE
#undef IN
#undef SEAM
}

extern "C" void kernel_launch(void* const* d_in, const int* in_sizes, int n_in, void* d_out, int out_size, void* d_ws, size_t ws_size, hipStream_t stream) {
    static int grid = 0;
    if (grid == 0) {
        if (n_in != 31 || out_size != TL * D || ws_size < WS_END) { fprintf(stderr, "kernel_launch: unexpected shapes n_in %d out %d ws %zu\n", n_in, out_size, ws_size); grid = -1; return; }
        int dev = 0, cus = 0;
        if (hipGetDevice(&dev) != hipSuccess || hipDeviceGetAttribute(&cus, hipDeviceAttributeMultiprocessorCount, dev) != hipSuccess) { grid = -1; return; }
        if (hipFuncSetAttribute((const void*)mk_fwd, hipFuncAttributeMaxDynamicSharedMemorySize, LDS_BYTES) != hipSuccess) { fprintf(stderr, "kernel_launch: hipFuncSetAttribute failed\n"); grid = -1; return; }
        int per_cu = 0;
        if (hipOccupancyMaxActiveBlocksPerMultiprocessor(&per_cu, (const void*)mk_fwd, NWAVES * 64, LDS_BYTES) != hipSuccess || per_cu < 1) fprintf(stderr, "kernel_launch: occupancy query says %d\n", per_cu);
        (void)hipGetLastError();
        grid = cus;
    }
    if (grid < 0) return;
    if (hipMemsetAsync((char*)d_ws + WS_CTL, 0, CTL_ZERO_BYTES, stream) != hipSuccess) return;
    Args a{};
    for (int i = 0; i < 31; ++i) a.in[i] = (const float*)d_in[i];
    a.out = (float*)d_out; a.ws = (unsigned char*)d_ws;
#ifndef MK_ONE_LAUNCH
#define MK_ONE_LAUNCH 1
#endif
    if (MK_ONE_LAUNCH) { a.ph_lo = 0; a.ph_hi = NPH; hipLaunchKernelGGL(mk_fwd, dim3(grid), dim3(NWAVES * 64), LDS_BYTES, stream, a); }
    else for (int p = 0; p < NPH; ++p) { a.ph_lo = p; a.ph_hi = p + 1; hipLaunchKernelGGL(mk_fwd, dim3(grid), dim3(NWAVES * 64), LDS_BYTES, stream, a); }
}
```

```cpp
#include <hip/hip_runtime.h>
#include <cstdio>
#include <cstdint>
#include <cmath>
namespace pg8 {
#define PG8_LAS __attribute__((address_space(3)))
typedef unsigned short bf16_t;
typedef short bf16x8 __attribute__((ext_vector_type(8)));
typedef float f32x4 __attribute__((ext_vector_type(4)));
typedef unsigned u32x4 __attribute__((ext_vector_type(4)));
constexpr int BM = 256, BK = 64, HALF = 128, HTB = HALF * BK * 2  , STAGE_BYTES = 8 * HTB, NXCD = 8, WGM = 8;

__host__ __device__ __forceinline__ int lds_byte(int r, int c) { const int st = (r >> 4) * 2 + (c >> 5), rr = r & 15, cc = c & 31, ob = rr * 64 + cc * 2; return st * 1024 + (ob ^ (((ob >> 9) & 1) << 5)); }
__host__ __device__ __forceinline__ void stage_rc(int b, int& R, int& C) { const int st = b / 1024, sb = b % 1024, swz = sb ^ (((sb >> 9) & 1) << 5); R = (st >> 1) * 16 + swz / 64; C = (st & 1) * 32 + (swz % 64) / 2; }
__host__ __device__ __forceinline__ int perm32(int rho) { const int n = rho >> 4, i = rho & 15; return 8 * (i >> 2) + 4 * n + (i & 3); }

struct Unit { int pm, pn; };
struct Gemm { const bf16_t* A; const bf16_t* Bt; int M, N, K, lda, ldb; };

struct StaticOrder {
    int nM, nN, nwg, G, c;
    __host__ __device__ void init(int M, int N, int G_, int c_) { nM = M / BM; nN = N / BM; nwg = nM * nN; G = G_; c = c_; }
    __host__ __device__ bool next(int i, Unit& u) const {
        const long L = (long)i * G + c; if (L >= nwg) return false;
        int wgid = (int)L; { const int q = nwg / NXCD, r = nwg % NXCD, xcd = wgid % NXCD, off = wgid / NXCD; wgid = (xcd < r ? xcd * (q + 1) : r * (q + 1) + (xcd - r) * q) + off; }
        const int nig = WGM * nN, gid = wgid / nig, fm = gid * WGM, gsz = (nM - fm) < WGM ? (nM - fm) : WGM;
        u.pm = fm + ((wgid % nig) % gsz); u.pn = (wgid % nig) / gsz; return true;
    }
    __device__ __forceinline__ void a_ready(const Unit&) const {}
    __device__ __forceinline__ void done(const Unit&) const {}
};

__device__ __forceinline__ unsigned cvt_pk_bf16(float lo, float hi) { unsigned r; asm volatile("v_cvt_pk_bf16_f32 %0, %1, %2" : "=v"(r) : "v"(lo), "v"(hi)); return r; }
template <class F> struct Epi8 {
    static constexpr bool PERM = true, AFTER_DRAIN = false; F f;
    __device__ __forceinline__ void operator()(const f32x4 (&acc)[2][2][4][2], const Unit& u, int wr, int wc, int fr, int fq) const {
        const int row0 = u.pm * BM + wr * 64 + fr, col0 = u.pn * BM + wc * 32 + 8 * fq;
#pragma unroll
        for (int ai = 0; ai < 2; ++ai)
#pragma unroll
            for (int m = 0; m < 4; ++m)
#pragma unroll
                for (int bj = 0; bj < 2; ++bj) { f(row0 + ai * HALF + m * 16, col0 + bj * HALF, acc[ai][bj][m][0], acc[ai][bj][m][1]); }
    }
};
template <class F> struct Epi4 {
    static constexpr bool PERM = false, AFTER_DRAIN = false; F f;
    __device__ __forceinline__ void operator()(const f32x4 (&acc)[2][2][4][2], const Unit& u, int wr, int wc, int fr, int fq) const {
        const int row0 = u.pm * BM + wr * 64 + fr, col0 = u.pn * BM + wc * 32 + 4 * fq;
#pragma unroll
        for (int ai = 0; ai < 2; ++ai)
#pragma unroll
            for (int m = 0; m < 4; ++m)
#pragma unroll
                for (int bj = 0; bj < 2; ++bj)
#pragma unroll
                    for (int n = 0; n < 2; ++n) { f(row0 + ai * HALF + m * 16, col0 + bj * HALF + n * 16, acc[ai][bj][m][n]); }
    }
};
template <class Epi, class Sched, bool ALIGN_EPI = false, bool SP2 = false>
__device__ __forceinline__ void gemm_phase(PG8_LAS unsigned char* lds, const Gemm g, const Sched& S, const Epi& E) {
    int tid_ = threadIdx.x; asm volatile("" : "+v"(tid_));
    const int tid = tid_, wid = __builtin_amdgcn_readfirstlane(tid >> 6), lane = tid & 63, wr = wid >> 2, wc = wid & 3, fr = lane & 15, fq = lane >> 4;
    const int K = g.K, nt = K / BK;
    unsigned voffA[2], voffB[2];
#pragma unroll
    for (int i = 0; i < 2; ++i) { int R, C; stage_rc(tid * 16 + i * 8192, R, C); const int Rb = Epi::PERM ? ((R & ~31) + perm32(R & 31)) : R;
        voffA[i] = (unsigned)(R * g.lda + C) * 2u; voffB[i] = (unsigned)(Rb * g.ldb + C) * 2u; }
    const size_t kstep = (size_t)(BK * 2);
    const size_t hstepA = (size_t)HALF * g.lda * 2, hstepB = (size_t)HALF * g.ldb * 2;
    const size_t tstepA = 2 * hstepA, tstepB = 2 * hstepB;
    const unsigned ldsw = (unsigned)wid * 1024u;
    const int aoff = lds_byte(wr * 64 + fr, fq * 8), boff = lds_byte(wc * 32 + fr, fq * 8);
#define PG8_SA(b, h) (((b) * 2 + (h)) * HTB)
#define PG8_SB(b, h) ((4 + (b) * 2 + (h)) * HTB)
#define PG8_STAGE(bufoff, gbase, voff) do { _Pragma("unroll") for (int _i = 0; _i < 2; ++_i) \
        __builtin_amdgcn_global_load_lds((const unsigned*)((const char*)(gbase) + (voff)[_i]), (PG8_LAS unsigned*)(lds + (bufoff) + ldsw + _i * 8192), 16, 0, 0); } while (0)
#define PG8_LDA(dst, b, h) do { _Pragma("unroll") for (int m = 0; m < 4; ++m) _Pragma("unroll") for (int k = 0; k < 2; ++k) dst[m][k] = *(const PG8_LAS bf16x8*)(lds + PG8_SA(b, h) + aoff + m * 2048 + k * 1024); } while (0)
#define PG8_LDB(dst, b, h) do { _Pragma("unroll") for (int n = 0; n < 2; ++n) _Pragma("unroll") for (int k = 0; k < 2; ++k) dst[n][k] = *(const PG8_LAS bf16x8*)(lds + PG8_SB(b, h) + boff + n * 2048 + k * 1024); } while (0)
#define PG8_MMA(ai, bj, At, Bt) do { __builtin_amdgcn_s_setprio(1); _Pragma("unroll") for (int m = 0; m < 4; ++m) _Pragma("unroll") for (int n = 0; n < 2; ++n) _Pragma("unroll") for (int k = 0; k < 2; ++k) \
        acc[ai][bj][m][n] = __builtin_amdgcn_mfma_f32_16x16x32_bf16(Bt[n][k], At[m][k], acc[ai][bj][m][n], 0, 0, 0); __builtin_amdgcn_s_setprio(0); } while (0)
#define PG8_WAIT_V(n) asm volatile("s_waitcnt vmcnt(" #n ")" ::: "memory")
#define PG8_WAIT_L(n) asm volatile("s_waitcnt lgkmcnt(" #n ")" ::: "memory")
#define PG8_BAR __builtin_amdgcn_s_barrier()
#define PG8_SCHED __builtin_amdgcn_sched_barrier(0)
    Unit cur, nxt; int ui = 0;
    if (!S.next(0, cur)) return;
    f32x4 acc[2][2][4][2];
#pragma unroll
    for (int a = 0; a < 2; ++a)
#pragma unroll
        for (int b = 0; b < 2; ++b)
#pragma unroll
            for (int m = 0; m < 4; ++m)
#pragma unroll
                for (int n = 0; n < 2; ++n) acc[a][b][m][n] = (f32x4){0.f, 0.f, 0.f, 0.f};
    bf16x8 At[4][2], B0[2][2], B1[2][2];
    const char* cA = (const char*)g.A + (size_t)cur.pm * tstepA; const char* cB = (const char*)g.Bt + (size_t)cur.pn * tstepB;
    S.a_ready(cur);
    if constexpr (SP2) {
        PG8_STAGE(PG8_SB(0, 0), cB, voffB); PG8_STAGE(PG8_SB(0, 1), cB + hstepB, voffB); PG8_STAGE(PG8_SA(0, 0), cA, voffA); PG8_STAGE(PG8_SA(0, 1), cA + hstepA, voffA);
        if (wr == 1) PG8_BAR;
        PG8_WAIT_V(2); PG8_BAR;
        PG8_STAGE(PG8_SB(1, 0), cB + kstep, voffB); PG8_STAGE(PG8_SA(1, 0), cA + kstep, voffA); PG8_STAGE(PG8_SB(1, 1), cB + hstepB + kstep, voffB);
        PG8_WAIT_V(6); PG8_BAR;
    } else {
        PG8_STAGE(PG8_SB(0, 0), cB, voffB); PG8_STAGE(PG8_SA(0, 0), cA, voffA); PG8_STAGE(PG8_SB(0, 1), cB + hstepB, voffB); PG8_STAGE(PG8_SA(0, 1), cA + hstepA, voffA);
        if (wr == 1) PG8_BAR;
        PG8_WAIT_V(4); PG8_BAR;
        PG8_STAGE(PG8_SB(1, 0), cB + kstep, voffB); PG8_STAGE(PG8_SA(1, 0), cA + kstep, voffA); PG8_STAGE(PG8_SB(1, 1), cB + hstepB + kstep, voffB);
        PG8_WAIT_V(6); PG8_BAR;
    }
    for (;;) {
        const bool has_next = S.next(ui + 1, nxt);
        const char* nA = has_next ? (const char*)g.A + (size_t)nxt.pm * tstepA : cA; const char* nB = has_next ? (const char*)g.Bt + (size_t)nxt.pn * tstepB : cB;
#pragma unroll 1
        for (int t = 0; t < nt; t += 2) {
            const bool last = (t == nt - 2);
            const char* a1 = cA + (size_t)(t + 1) * kstep;
            const char* a2 = last ? nA : cA + (size_t)(t + 2) * kstep; const char* b2 = last ? nB : cB + (size_t)(t + 2) * kstep;
            const char* a3 = a2 + kstep; const char* b3 = b2 + kstep;
            if (last && has_next) S.a_ready(nxt);
            if constexpr (SP2) {
            PG8_LDB(B0, 0, 0); PG8_LDB(B1, 0, 1); PG8_SCHED; PG8_LDA(At, 0, 0); PG8_STAGE(PG8_SA(1, 1), a1 + hstepA, voffA);
            PG8_WAIT_V(8); PG8_WAIT_L(0); PG8_BAR; PG8_MMA(0, 0, At, B0); PG8_MMA(0, 1, At, B1); PG8_BAR; PG8_SCHED;
            PG8_LDA(At, 0, 1); PG8_STAGE(PG8_SB(0, 0), b2, voffB); PG8_STAGE(PG8_SB(0, 1), b2 + hstepB, voffB); PG8_STAGE(PG8_SA(0, 0), a2, voffA);
            PG8_WAIT_V(8); PG8_WAIT_L(0); PG8_BAR; PG8_MMA(1, 0, At, B0); PG8_MMA(1, 1, At, B1); PG8_BAR; PG8_SCHED;
            PG8_LDB(B0, 1, 0); PG8_LDB(B1, 1, 1); PG8_SCHED; PG8_LDA(At, 1, 0); PG8_STAGE(PG8_SA(0, 1), a2 + hstepA, voffA);
            PG8_WAIT_V(8); PG8_WAIT_L(0); PG8_BAR; PG8_MMA(0, 0, At, B0); PG8_MMA(0, 1, At, B1); PG8_BAR; PG8_SCHED;
            PG8_LDA(At, 1, 1); PG8_STAGE(PG8_SB(1, 0), b3, voffB); PG8_STAGE(PG8_SB(1, 1), b3 + hstepB, voffB); PG8_STAGE(PG8_SA(1, 0), a3, voffA);
            PG8_WAIT_V(8); PG8_WAIT_L(0); PG8_BAR; PG8_MMA(1, 0, At, B0); PG8_MMA(1, 1, At, B1); PG8_BAR; PG8_SCHED;
            } else {
            PG8_LDB(B0, 0, 0); PG8_SCHED; PG8_LDA(At, 0, 0); PG8_STAGE(PG8_SA(1, 1), a1 + hstepA, voffA);
            PG8_WAIT_L(8); PG8_BAR; PG8_WAIT_L(0); PG8_MMA(0, 0, At, B0); PG8_BAR; PG8_SCHED;
            PG8_LDB(B1, 0, 1); PG8_STAGE(PG8_SB(0, 0), b2, voffB);
            PG8_BAR; PG8_WAIT_L(0); PG8_MMA(0, 1, At, B1); PG8_BAR;
            PG8_LDA(At, 0, 1); PG8_STAGE(PG8_SA(0, 0), a2, voffA);
            PG8_BAR; PG8_WAIT_L(0); PG8_MMA(1, 0, At, B0); PG8_BAR; PG8_SCHED;
            PG8_STAGE(PG8_SB(0, 1), b2 + hstepB, voffB);
            PG8_WAIT_V(6); PG8_BAR; PG8_MMA(1, 1, At, B1); PG8_BAR;
            PG8_LDB(B0, 1, 0); PG8_SCHED; PG8_LDA(At, 1, 0); PG8_STAGE(PG8_SA(0, 1), a2 + hstepA, voffA);
            PG8_WAIT_L(8); PG8_BAR; PG8_WAIT_L(0); PG8_MMA(0, 0, At, B0); PG8_BAR; PG8_SCHED;
            PG8_LDB(B1, 1, 1); PG8_STAGE(PG8_SB(1, 0), b3, voffB);
            PG8_BAR; PG8_WAIT_L(0); PG8_MMA(0, 1, At, B1); PG8_BAR;
            PG8_LDA(At, 1, 1); PG8_STAGE(PG8_SA(1, 0), a3, voffA);
            PG8_BAR; PG8_WAIT_L(0); PG8_MMA(1, 0, At, B0); PG8_BAR; PG8_SCHED;
            PG8_STAGE(PG8_SB(1, 1), b3 + hstepB, voffB);
            PG8_WAIT_V(6); PG8_BAR; PG8_MMA(1, 1, At, B1); PG8_BAR;
            }
        }
        if constexpr (ALIGN_EPI) { if (wr == 0) PG8_BAR; }
        if constexpr (!Epi::AFTER_DRAIN) { E(acc, cur, wr, wc, fr, fq); S.done(cur); }
        if (!has_next) break;
#pragma unroll
        for (int a = 0; a < 2; ++a)
#pragma unroll
            for (int b = 0; b < 2; ++b)
#pragma unroll
                for (int m = 0; m < 4; ++m)
#pragma unroll
                    for (int n = 0; n < 2; ++n) acc[a][b][m][n] = (f32x4){0.f, 0.f, 0.f, 0.f};
        cur = nxt; cA = nA; cB = nB; ++ui;
        if constexpr (ALIGN_EPI) { if (wr == 1) PG8_BAR; }
    }
    PG8_WAIT_V(0);
    if constexpr (!ALIGN_EPI) { if (wr == 0) PG8_BAR; }
    PG8_BAR;
    if constexpr (Epi::AFTER_DRAIN) { E.fused(acc, cur, wr, wc, fr, fq, lds, wid, lane); S.done(cur); }
#undef PG8_SA
#undef PG8_SB
#undef PG8_STAGE
#undef PG8_LDA
#undef PG8_LDB
#undef PG8_MMA
#undef PG8_WAIT_V
#undef PG8_WAIT_L
#undef PG8_BAR
#undef PG8_SCHED
}
}

constexpr int NWAVES = 8;
constexpr int D = 1024, BATCH = 2, SEQ = 8192, CTXL = 256;
constexpr int TL = BATCH * SEQ;
constexpr int TC = BATCH * CTXL;
constexpr int TT = TL + TC;
constexpr int EVEN_IN = 1184, EVEN_IN_PAD = 1280, CQKV_LD = 672;
constexpr int FFH = 2816, FFG = 1408;
constexpr int TQK = SEQ + CTXL;
constexpr float NORM_EPS = 1e-6f;
constexpr float DN_ALPHA = 1.41421356237f;
constexpr float QSCALE = 0.10206207261596577f * 1.4426950408889634f;

constexpr size_t MiB = 1u << 20;
constexpr size_t WS_CTL = 0, CTL_ZERO_BYTES = 1 * MiB;
constexpr size_t WS_MOD = 1 * MiB;
constexpr size_t WS_LBV = WS_MOD + 160 * 1024;
constexpr size_t WS_ROPE = WS_LBV + 16 * 1024;
constexpr size_t WS_CWT = WS_ROPE + 16 * 1024;
constexpr size_t WS_HGINT = 2 * MiB, WS_HGOUTT = 12 * MiB, WS_F1T1 = 14 * MiB, WS_F2T1 = 25 * MiB;
constexpr size_t WS_A = 31 * MiB;
constexpr size_t WS_XC = 64 * MiB;
constexpr size_t WS_WIN0 = 66 * MiB, WS_WUQ = WS_WIN0 + 2560 * 1024, WS_WUKV = WS_WUQ + 768 * 1024, WS_WGLU = WS_WUKV + 512 * 1024,
                 WS_WOUT0 = WS_WGLU + 512 * 1024, WS_F1T0 = 72 * MiB + 512 * 1024, WS_F2T0 = WS_F1T0 + 11 * MiB;
constexpr size_t WS_R = 89 * MiB;
constexpr size_t WS_CQKV = WS_R;
constexpr size_t WS_UG = WS_R + 22 * MiB;
constexpr size_t WS_WF = WS_R + 39 * MiB;
constexpr size_t WS_WC = WS_R + 64 * MiB;
constexpr size_t WS_TOEP = WS_R + 80 * MiB;
constexpr size_t WS_T0 = WS_R + 82 * MiB;
constexpr size_t WS_A64 = WS_T0 + 128 * 1024;
constexpr size_t WS_FIN = WS_R + 83 * MiB;
constexpr size_t WS_SIN = WS_R + 92 * MiB;
constexpr size_t WS_Z = WS_R + 97 * MiB;
constexpr size_t WS_MIX = WS_R + 134 * MiB;
constexpr size_t WS_QB = WS_R + 39 * MiB;
constexpr size_t WS_KB = 31 * MiB;
constexpr size_t WS_VB = WS_R + 114 * MiB;
constexpr size_t WS_AB = WS_R;
constexpr size_t WS_GB = WS_R + 8 * MiB;
constexpr size_t WS_H = WS_R;
constexpr size_t WS_HG = WS_R + 16 * MiB;
constexpr size_t WS_QFFI = 66 * MiB;
constexpr size_t WS_G = 198 * MiB;
constexpr size_t WS_O = WS_A;
constexpr size_t WS_SLAB1 = WS_R;
constexpr size_t WS_SLAB2 = WS_R + 110 * MiB;
constexpr size_t WS_END = 256 * MiB;
static_assert(WS_F2T0 + 5632 * 1024 <= WS_R, "layer-0 weights");
static_assert(WS_MIX + (size_t)TT * 1024 * 2 <= WS_END && WS_G + (size_t)TT * 1024 * 2 <= WS_END && WS_HG + (size_t)TT * FFH * 2 <= WS_END, "ws map");
static_assert(WS_WF + 16 * MiB <= WS_WC && WS_QB + (size_t)16 * TQK * 96 * 2 <= WS_WC && WS_WC + 16 * MiB <= WS_TOEP && WS_TOEP + 2 * MiB <= WS_T0 && WS_T0 + MiB <= WS_FIN && WS_FIN + (size_t)32 * 264 * 256 * 4 <= WS_SIN && WS_SIN + (size_t)32 * 264 * 256 * 2 <= WS_Z && WS_Z + (size_t)TT * 512 * 2 <= WS_VB && WS_VB + (size_t)16 * TQK * 64 * 2 <= WS_MIX && WS_KB + (size_t)16 * TQK * 96 * 2 <= WS_XC, "ws map 2");

constexpr int CW_BAR = 4096;
constexpr int RING_OFF = 0, RING_BYTES = 131072;
constexpr int LDSCTL_OFF = RING_BYTES, MISC_OFF = LDSCTL_OFF + 320;
constexpr int LDS_BYTES = 147456;

#define GAS __attribute__((address_space(1)))
#define LAS __attribute__((address_space(3)))
typedef unsigned short bf16;
typedef unsigned v4u __attribute__((ext_vector_type(4)));
typedef unsigned v2u __attribute__((ext_vector_type(2)));
typedef float f32x4 __attribute__((ext_vector_type(4)));
typedef GAS unsigned gu32;
#define RLX_AGENT __ATOMIC_RELAXED, __HIP_MEMORY_SCOPE_AGENT
#define LDS_WAIT() asm volatile("s_waitcnt lgkmcnt(0)" ::: "memory")
__device__ __forceinline__ unsigned f2bf(float f) { unsigned u = __builtin_bit_cast(unsigned, f); return (u + 0x7fffu + ((u >> 16) & 1u)) >> 16; }
__device__ __forceinline__ unsigned pk2(float lo, float hi) { return f2bf(lo) | (f2bf(hi) << 16); }
__device__ __forceinline__ float bflo(unsigned w) { return __builtin_bit_cast(float, w << 16); }
__device__ __forceinline__ float bfhi(unsigned w) { return __builtin_bit_cast(float, w & 0xffff0000u); }
__device__ __forceinline__ float bf2f(bf16 h) { return __builtin_bit_cast(float, (unsigned)h << 16); }
__device__ __forceinline__ void unpack8(v4u w, float* x) { x[0] = bflo(w.x); x[1] = bfhi(w.x); x[2] = bflo(w.y); x[3] = bfhi(w.y); x[4] = bflo(w.z); x[5] = bfhi(w.z); x[6] = bflo(w.w); x[7] = bfhi(w.w); }
__device__ __forceinline__ v4u pack8(const float* x) { v4u w; w.x = pk2(x[0], x[1]); w.y = pk2(x[2], x[3]); w.z = pk2(x[4], x[5]); w.w = pk2(x[6], x[7]); return w; }
__device__ __forceinline__ float sigmoidf_(float x) { return 1.0f / (1.0f + __expf(-x)); }
__device__ __forceinline__ float siluf_(float x) { return x / (1.0f + __expf(-x)); }
__device__ __forceinline__ float gelu_tanh(float x) { const float u = 0.7978845608028654f * (x + 0.044715f * x * x * x); return 0.5f * x * (1.0f + tanhf(u)); }
__device__ __forceinline__ float wave_sum(float v) {
#pragma unroll
    for (int o = 1; o < 64; o <<= 1) v += __shfl_xor(v, o);
    return v;
}

#define XB_TMO      128
#define XB_XCNT(j)  (256  + 64 * (j))
#define XB_XSUB(j)  (1280 + 64 * (j))
#define XB_XGEN(j)  (2304 + 64 * (j))
#define XB_TOP      3328
#define XB_TOPGEN   3392
#define XCD_BAR_WORDS 3456
#define XB_SPIN_CAP (1u << 18)

__device__ __forceinline__ unsigned xb_ld(unsigned* p)              { return __hip_atomic_load(p, __ATOMIC_RELAXED, __HIP_MEMORY_SCOPE_AGENT); }
__device__ __forceinline__ unsigned xb_add(unsigned* p, unsigned v) { return __hip_atomic_fetch_add(p, v, __ATOMIC_RELAXED, __HIP_MEMORY_SCOPE_AGENT); }
__device__ __forceinline__ unsigned xb_xcc_id() { return (unsigned)__builtin_amdgcn_s_getreg((3 << 11) | 20) & 0xFu; }
#define XB_SPIN(cond, bar) do { unsigned _sp = 0; while (cond) { __builtin_amdgcn_s_sleep(1); \
    if ((++_sp & 255u) == 0u) { if (xb_ld(&(bar)[XB_TMO])) break; if (_sp > XB_SPIN_CAP) { atomicAdd(&(bar)[XB_TMO], 1u); break; } } } } while (0)

struct XcdBarrier {
    unsigned* bar; unsigned x;
    volatile LAS unsigned* st;
};

__device__ __forceinline__ XcdBarrier xcd_barrier_post(unsigned* bar, volatile LAS unsigned* st) {
    XcdBarrier b; b.bar = bar; b.x = xb_xcc_id(); b.st = st;
    if (threadIdx.x == 0) (void)xb_add(&bar[XB_XCNT(b.x)], 1u);
    return b;
}
__device__ __forceinline__ void xcd_barrier_complete(unsigned* bar, unsigned x, unsigned& nloc, unsigned& nx) {
    const unsigned G = gridDim.x * gridDim.y * gridDim.z;
    unsigned sum, cnt, mine, sp = 0u;
    for (;;) {
        sum = 0u; cnt = 0u; mine = 0u;
#pragma unroll
        for (unsigned j = 0; j < 16; ++j) { const unsigned c = xb_ld(&bar[XB_XCNT(j)]); sum += c; cnt += (c > 0u) ? 1u : 0u; mine = (j == x) ? c : mine; }
        if (sum == G) break;
        __builtin_amdgcn_s_sleep(1);
        if ((++sp & 255u) == 0u) { if (xb_ld(&bar[XB_TMO])) break; if (sp > XB_SPIN_CAP) { atomicAdd(&bar[XB_TMO], 1u); break; } }
    }
    nloc = mine > 0u ? mine : 1u; nx = cnt > 0u ? cnt : 1u;
}

__device__ __forceinline__ void xcd_barrier(const XcdBarrier& b) {
    asm volatile("s_waitcnt vmcnt(0)" ::: "memory");
    __syncthreads();
    if (threadIdx.x == 0) {
        unsigned* bar = b.bar;
        __builtin_amdgcn_s_waitcnt(0);
        unsigned nloc = b.st[0], nx = b.st[1];
        if (nloc == 0u) { xcd_barrier_complete(bar, b.x, nloc, nx); b.st[0] = nloc; b.st[1] = nx; }
        const unsigned old = xb_add(&bar[XB_XSUB(b.x)], 1u);
        const unsigned gen = old / nloc;
        if (old + 1u == (gen + 1u) * nloc) {
            __builtin_amdgcn_fence(__ATOMIC_RELEASE, "agent");
            asm volatile("s_waitcnt vmcnt(0)" ::: "memory");
            const unsigned og = xb_add(&bar[XB_TOP], 1u);
            const unsigned tg = og / nx;
            if (og + 1u == (tg + 1u) * nx) xb_add(&bar[XB_TOPGEN], 1u);
            else XB_SPIN(xb_ld(&bar[XB_TOPGEN]) == tg, bar);
            __builtin_amdgcn_fence(__ATOMIC_ACQUIRE, "agent");
            xb_add(&bar[XB_XGEN(b.x)], 1u);
            asm volatile("s_waitcnt vmcnt(0)" ::: "memory");
        } else {
            XB_SPIN(xb_ld(&bar[XB_XGEN(b.x)]) == gen, bar);
            __builtin_amdgcn_fence(__ATOMIC_ACQUIRE, "agent");
            asm volatile("s_waitcnt vmcnt(0)" ::: "memory");
        }
    }
    __syncthreads();
}


struct Frame {
    LAS unsigned char* lds;
    int tid, lane, wave, vcu, G;
};
constexpr int PTR_OFF = LDSCTL_OFF + 1024;
__device__ __forceinline__ const float* inp(const Frame& F, int i) {
    const LAS unsigned* p = (const LAS unsigned*)(F.lds + PTR_OFF) + 2 * i;
    const unsigned lo = __builtin_amdgcn_readfirstlane(p[0]), hi = __builtin_amdgcn_readfirstlane(p[1]);
    return (const float*)(const GAS float*)(((unsigned long long)hi << 32) | lo);
}
__device__ __forceinline__ unsigned char* ws_(const Frame& F) { return (unsigned char*)inp(F, 31); }
__device__ __forceinline__ float* out_(const Frame& F) { return (float*)inp(F, 32); }
__device__ __forceinline__ int modrow_of(int m) { return m < TL ? (m >> 13) : 2; }
__device__ __forceinline__ const float* xin_row(const Frame& F, int m) { return m < TL ? inp(F, 0) + (size_t)m * D : inp(F, 2) + (size_t)(m - TL) * D; }
__device__ __forceinline__ float* xres_row(const Frame& F, int m) { return m < TL ? out_(F) + (size_t)m * D : (float*)(ws_(F) + WS_XC) + (size_t)(m - TL) * D; }
__device__ __forceinline__ const float* modvec(const Frame& F, int layer, int mr, int part) { return (const float*)(ws_(F) + WS_MOD) + (size_t)(layer * 3 + mr) * 6144 + part * 1024; }

__device__ __forceinline__ void tr_item(const float* W, int ldw, int k0, int n0, bf16* dst, int dpitch, LAS float* scr, int lane) {
    { f32x4 v[8];
#pragma unroll
      for (int i = 0; i < 8; ++i) v[i] = *(const GAS f32x4*)(W + (size_t)(k0 + 8 * i + (lane >> 3)) * ldw + n0 + 4 * (lane & 7));
#pragma unroll
      for (int i = 0; i < 8; ++i) { LAS float* d = scr + (8 * i + (lane >> 3)) * 33 + 4 * (lane & 7); d[0] = v[i].x; d[1] = v[i].y; d[2] = v[i].z; d[3] = v[i].w; } }
    LDS_WAIT(); asm volatile("" ::: "memory");
    const int c = lane & 7;
#pragma unroll
    for (int j = 0; j < 4; ++j) { const int n = (lane >> 3) + 8 * j; const LAS float* s = scr + (8 * c) * 33 + n;
        v4u o; o.x = pk2(s[0 * 33], s[1 * 33]); o.y = pk2(s[2 * 33], s[3 * 33]); o.z = pk2(s[4 * 33], s[5 * 33]); o.w = pk2(s[6 * 33], s[7 * 33]);
        *(GAS v4u*)(dst + (size_t)n * dpitch + 8 * c) = o; }
    LDS_WAIT(); asm volatile("" ::: "memory");
}
__device__ __forceinline__ bool tr_plain(int& r, const float* W, int K, int N, bf16* WT, LAS float* scr, int lane) {
    const int nblk = N / 32, cnt = (K / 64) * nblk;
    if (r >= cnt) { r -= cnt; return false; }
    const int kb = r / nblk, nb = r % nblk;
    tr_item(W, N, 64 * kb, 32 * nb, WT + (size_t)(32 * nb) * K + 64 * kb, K, scr, lane); return true;
}
__device__ __forceinline__ bool tr_ffn1(int& r, const float* W, bf16* WT, LAS float* scr, int lane) {
    const int nblk = 5632 / 32, cnt = 16 * nblk;
    if (r >= cnt) { r -= cnt; return false; }
    const int kb = r / nblk, nb = r % nblk, n0 = 32 * nb, half = n0 / FFH, j = n0 % FFH, drow = (j >> 7) * 256 + half * 128 + (j & 127);
    tr_item(W, 5632, 64 * kb, n0, WT + (size_t)drow * 1024 + 64 * kb, 1024, scr, lane); return true;
}
#ifndef DUP_GEMV
#define DUP_GEMV 1
#endif
#ifndef DUP_TR
#define DUP_TR 1
#endif
#ifndef DUP_S5T
#define DUP_S5T 1
#endif
__device__ __forceinline__ void p0_prologue(Frame& F) {
    {
        LAS float* sv = (LAS float*)(F.lds + RING_OFF);
        LAS float* red = sv + 3072;
        for (int i = F.tid; i < 3072; i += 512) { const int r = i >> 10, k = i & 1023; const float cv = (r < 2) ? inp(F, 1)[r * 1024 + k] : inp(F, 3)[k]; sv[i] = cv / (1.0f + __expf(-cv)); }
        __syncthreads();
        for (int rep_ = 0; rep_ < DUP_GEMV; ++rep_)
        for (int it = blockIdx.x; it < 192; it += F.G) {
            const int layer = it / 96, cg = it % 96, col = cg * 64 + F.lane, k0 = F.wave * 128;
            const float* w = inp(F, 4) + ((size_t)layer * 1024 + k0) * 6144 + col;
            float a0 = 0.f, a1 = 0.f, a2 = 0.f;
#pragma unroll 16
            for (int k = 0; k < 128; ++k) { const float wv = w[(size_t)k * 6144]; a0 += sv[k0 + k] * wv; a1 += sv[1024 + k0 + k] * wv; a2 += sv[2048 + k0 + k] * wv; }
            red[(F.wave * 3 + 0) * 64 + F.lane] = a0; red[(F.wave * 3 + 1) * 64 + F.lane] = a1; red[(F.wave * 3 + 2) * 64 + F.lane] = a2;
            __syncthreads();
            if (F.tid < 192) { const int r = F.tid >> 6, l = F.tid & 63; float s = inp(F, 5)[layer * 6144 + cg * 64 + l];
#pragma unroll
                for (int wv = 0; wv < 8; ++wv) s += red[(wv * 3 + r) * 64 + l];
                ((float*)(ws_(F) + WS_MOD))[(size_t)(layer * 3 + r) * 6144 + cg * 64 + l] = s; }
            __syncthreads();
        }
        __syncthreads();
    }
    {
        const int gt = F.vcu * 512 + F.tid, NT = F.G * 512;
        for (int i = gt; i < 2048; i += NT) { const int dir = i >> 10, c = i & 1023; const float l0 = inp(F, 28)[(0 * 2 + dir) * 1024 + c], l1 = inp(F, 28)[(1 * 2 + dir) * 1024 + c];
            ((float*)(ws_(F) + WS_LBV))[i] = 1.0f / (1.0f + expf(l0 - l1)); }
        for (int i = gt; i < 1024; i += NT) { const int pos = i >> 3, f = i & 7; const float inv = powf(10000.0f, -(float)f / 8.0f); const float ang = (float)pos * inv;
            ((float*)(ws_(F) + WS_ROPE))[2 * i] = cosf(ang); ((float*)(ws_(F) + WS_ROPE))[2 * i + 1] = sinf(ang); }
        for (int i = gt; i < 2 * FFH; i += NT) { const int layer = i / FFH, j = i % FFH; const float* cwp = inp(F, 9) + (size_t)layer * 3 * FFH + j;
            v2u w; w.x = pk2(cwp[0], cwp[FFH]); w.y = pk2(cwp[2 * FFH], inp(F, 10)[(size_t)layer * FFH + j]); *(GAS v2u*)((bf16*)(ws_(F) + WS_CWT) + (size_t)i * 4) = w; }
        for (int i = gt; i < 96 * 1024 / 8; i += NT) ((GAS v4u*)(ws_(F) + WS_WIN0 + (size_t)1184 * 1024 * 2))[i] = (v4u){0u, 0u, 0u, 0u};
    }
    {
        LAS float* scr = (LAS float*)(F.lds + RING_OFF + F.wave * 16384);
        const int gw = F.vcu * NWAVES + F.wave, NGW = F.G * NWAVES;
        constexpr int NITEMS = 592 + 144 + 128 + 128 + 512 + 2 * 2816 + 2 * 1408 + 2560 + 512;
        for (int rep_ = 0; rep_ < DUP_TR; ++rep_)
        for (int it = gw; it < NITEMS; it += NGW) {
            int r = it;
            if (tr_plain(r, inp(F, 12), 1024, 1184, (bf16*)(ws_(F) + WS_WIN0), scr, F.lane)) continue;
            if (tr_plain(r, inp(F, 14), 384, 768, (bf16*)(ws_(F) + WS_WUQ), scr, F.lane)) continue;
            if (tr_plain(r, inp(F, 16), 256, 1024, (bf16*)(ws_(F) + WS_WUKV), scr, F.lane)) continue;
            if (tr_plain(r, inp(F, 25), 512, 512, (bf16*)(ws_(F) + WS_WGLU), scr, F.lane)) continue;
            if (tr_plain(r, inp(F, 26), 1024, 1024, (bf16*)(ws_(F) + WS_WOUT0), scr, F.lane)) continue;
            if (tr_ffn1(r, inp(F, 8), (bf16*)(ws_(F) + WS_F1T0), scr, F.lane)) continue;
            if (tr_ffn1(r, inp(F, 8) + (size_t)1024 * 5632, (bf16*)(ws_(F) + WS_F1T1), scr, F.lane)) continue;
            if (tr_plain(r, inp(F, 11), 2816, 1024, (bf16*)(ws_(F) + WS_F2T0), scr, F.lane)) continue;
            if (tr_plain(r, inp(F, 11) + (size_t)2816 * 1024, 2816, 1024, (bf16*)(ws_(F) + WS_F2T1), scr, F.lane)) continue;
            if (tr_plain(r, inp(F, 27), 1024, 5120, (bf16*)(ws_(F) + WS_HGINT), scr, F.lane)) continue;
            tr_plain(r, inp(F, 30), 1024, 1024, (bf16*)(ws_(F) + WS_HGOUTT), scr, F.lane);
        }
    }
}

__device__ __forceinline__ void store_mod_bf16(const Frame& F, const f32x4 (&v)[4], int m, int layer, int part_sh) {
    const int mr = modrow_of(m);
    const GAS f32x4* sh = (const GAS f32x4*)modvec(F, layer, mr, part_sh) + F.lane;
    const GAS f32x4* sc = (const GAS f32x4*)modvec(F, layer, mr, part_sh + 1) + F.lane;
    GAS v2u* o = (GAS v2u*)((bf16*)(ws_(F) + WS_A) + (size_t)m * D) + F.lane;
#pragma unroll
    for (int j = 0; j < 4; ++j) { const f32x4 s = sc[64 * j], h = sh[64 * j]; const f32x4 y = v[j] * (s + 1.0f) + h; v2u w; w.x = pk2(y.x, y.y); w.y = pk2(y.z, y.w); o[64 * j] = w; }
}
__device__ __forceinline__ void ph_init_rows(Frame& F) {
    const int gw = F.vcu * NWAVES + F.wave, NGW = F.G * NWAVES;
    for (int m = gw; m < TT; m += NGW) {
        const GAS f32x4* xr = (const GAS f32x4*)xin_row(F, m) + F.lane; GAS f32x4* xo = (GAS f32x4*)xres_row(F, m) + F.lane;
        f32x4 v[4];
#pragma unroll
        for (int j = 0; j < 4; ++j) { v[j] = xr[64 * j]; if (m >= TL) xo[64 * j] = v[j] * DN_ALPHA; }
        store_mod_bf16(F, v, m, 0, 0);
    }
}
__device__ __forceinline__ void ph_layernorm(Frame& F, int nrows, int layer, int which, int next_layer, int next_part_sh, const float* slabs = nullptr, int nslabs = 0) {
    const int gw = F.vcu * NWAVES + F.wave, NGW = F.G * NWAVES;
    const GAS f32x4* gg = (const GAS f32x4*)(inp(F, 6) + (size_t)(layer * 2 + which) * D) + F.lane;
    const GAS f32x4* bb = (const GAS f32x4*)(inp(F, 7) + (size_t)(layer * 2 + which) * D) + F.lane;
    for (int m0 = gw; m0 < nrows; m0 += 2 * NGW) {
        const int m1 = m0 + NGW; const bool has1 = m1 < nrows; const int m1c = has1 ? m1 : m0;
        GAS f32x4* xr0 = (GAS f32x4*)xres_row(F, m0) + F.lane; GAS f32x4* xr1 = (GAS f32x4*)xres_row(F, m1c) + F.lane;
        f32x4 v[4], w[4]; float s0 = 0.f, s1 = 0.f;
#pragma unroll
        for (int j = 0; j < 4; ++j) { v[j] = xr0[64 * j]; w[j] = xr1[64 * j]; }
        if (nslabs > 0 && m1c >= TL) {
            for (int sl = 0; sl < nslabs; ++sl) { const GAS f32x4* p1 = (const GAS f32x4*)(slabs + ((size_t)sl * TC + (m1c - TL)) * D) + F.lane;
#pragma unroll
                for (int j = 0; j < 4; ++j) w[j] += p1[64 * j];
                if (m0 >= TL) { const GAS f32x4* p0 = (const GAS f32x4*)(slabs + ((size_t)sl * TC + (m0 - TL)) * D) + F.lane;
#pragma unroll
                    for (int j = 0; j < 4; ++j) v[j] += p0[64 * j]; } }
        }
#pragma unroll
        for (int j = 0; j < 4; ++j) { s0 += (v[j].x + v[j].y) + (v[j].z + v[j].w); s1 += (w[j].x + w[j].y) + (w[j].z + w[j].w); }
        const float mean0 = wave_sum(s0) * (1.f / D), mean1 = wave_sum(s1) * (1.f / D); float q0 = 0.f, q1 = 0.f;
#pragma unroll
        for (int j = 0; j < 4; ++j) { v[j] = v[j] - mean0; w[j] = w[j] - mean1; q0 += (v[j].x * v[j].x + v[j].y * v[j].y) + (v[j].z * v[j].z + v[j].w * v[j].w); q1 += (w[j].x * w[j].x + w[j].y * w[j].y) + (w[j].z * w[j].z + w[j].w * w[j].w); }
        const float r0 = 1.f / sqrtf(wave_sum(q0) * (1.f / D) + NORM_EPS), r1 = 1.f / sqrtf(wave_sum(q1) * (1.f / D) + NORM_EPS);
#pragma unroll
        for (int j = 0; j < 4; ++j) { const f32x4 g4 = gg[64 * j], b4 = bb[64 * j]; v[j] = v[j] * r0 * g4 + b4; w[j] = w[j] * r1 * g4 + b4; xr0[64 * j] = (m0 >= TL) ? v[j] * DN_ALPHA : v[j]; if (has1) xr1[64 * j] = (m1 >= TL) ? w[j] * DN_ALPHA : w[j]; }
        if (next_layer >= 0) { store_mod_bf16(F, v, m0, next_layer, next_part_sh); if (has1) store_mod_bf16(F, w, m1, next_layer, next_part_sh); }
    }
}
__device__ __forceinline__ void ph_mla_norm(Frame& F) {
    const int gw = F.vcu * NWAVES + F.wave, NGW = F.G * NWAVES;
    bf16* CQ = (bf16*)(ws_(F) + WS_CQKV); bf16* Kb = (bf16*)(ws_(F) + WS_KB); const float* rope = (const float*)(ws_(F) + WS_ROPE);
    for (int m = gw; m < TT; m += NGW) {
        bf16* row = CQ + (size_t)m * CQKV_LD;
        {
            float x[8]; float ss = 0.f; const bool act = F.lane < 48;
            if (act) { unpack8(*(const GAS v4u*)(row + 8 * F.lane), x);
#pragma unroll
                for (int j = 0; j < 8; ++j) ss += x[j] * x[j]; }
            const float sc = 1.f / sqrtf(wave_sum(ss) * (1.f / 384.f) + NORM_EPS);
            if (act) {
#pragma unroll
                for (int j = 0; j < 8; ++j) x[j] = x[j] * sc * inp(F, 13)[8 * F.lane + j];
                *(GAS v4u*)(row + 8 * F.lane) = pack8(x); }
        }
        {
            float x[8]; float ss = 0.f; const bool act = F.lane < 32;
            if (act) { unpack8(*(const GAS v4u*)(row + 384 + 8 * F.lane), x);
#pragma unroll
                for (int j = 0; j < 8; ++j) ss += x[j] * x[j]; }
            const float sc = 1.f / sqrtf(wave_sum(ss) * (1.f / 256.f) + NORM_EPS);
            if (act) {
#pragma unroll
                for (int j = 0; j < 8; ++j) x[j] = x[j] * sc * inp(F, 15)[8 * F.lane + j];
                *(GAS v4u*)(row + 384 + 8 * F.lane) = pack8(x); }
        }
        {
            const bool isctx = m >= TL; const int b = isctx ? ((m - TL) >> 8) : (m >> 13), t = isctx ? ((m - TL) & 255) : (m & 8191), tk = isctx ? t : CTXL + t;
            const int h = F.lane >> 3, i0 = (F.lane & 7) * 4;
            const v2u w = *(const GAS v2u*)(row + 640 + i0);
            float x[4] = {bflo(w.x), bfhi(w.x), bflo(w.y), bfhi(w.y)}, o[4];
#pragma unroll
            for (int j = 0; j < 4; ++j) { const float p = __shfl_xor(x[j], 2); const int idx = i0 + j, a = idx >> 4, half = (idx >> 3) & 1, f = idx & 7, pos = a ? (t & 63) : (t >> 6);
                const float cs = rope[2 * (pos * 8 + f)], sn = rope[2 * (pos * 8 + f) + 1];
                o[j] = isctx ? x[j] : (half ? x[j] * cs + p * sn : x[j] * cs - p * sn); }
            v2u ow; ow.x = pk2(o[0], o[1]); ow.y = pk2(o[2], o[3]);
            *(GAS v2u*)(Kb + ((size_t)(b * 8 + h) * TQK + tk) * 96 + 64 + i0) = ow;
        }
    }
}
__device__ __forceinline__ void ph_convfix(Frame& F, int nrows, int layer) {
    const int gw = F.vcu * NWAVES + F.wave, NGW = F.G * NWAVES;
    const bf16* AB = (const bf16*)(ws_(F) + WS_AB); const bf16* GB = (const bf16*)(ws_(F) + WS_GB); bf16* HG = (bf16*)(ws_(F) + WS_HG);
    const float* cw = inp(F, 9) + (size_t)layer * 3 * FFH; const float* cb = inp(F, 10) + (size_t)layer * FFH;
    const int nedge = (nrows / 64) * 2;
    for (int er = gw; er < nedge; er += NGW) {
        const int g64 = er >> 1, which = er & 1, m = 64 * g64 + (which ? 63 : 0);
        const bool isctx = m >= TL; const int t = isctx ? ((m - TL) & 255) : (m & 8191), len = isctx ? CTXL : SEQ;
        const bool hp = t > 0, hn = t < len - 1;
        const bf16* ac_ = AB + (size_t)(g64 * 4 + (which ? 3 : 0)) * FFH;
        const bf16* ap_ = which ? AB + (size_t)(g64 * 4 + 2) * FFH : AB + (size_t)((g64 - 1) * 4 + 3) * FFH;
        const bf16* an_ = which ? AB + (size_t)((g64 + 1) * 4 + 0) * FFH : AB + (size_t)(g64 * 4 + 1) * FFH;
        const bf16* gt_ = GB + (size_t)(g64 * 2 + which) * FFH;
#pragma unroll
        for (int ci = 0; ci < 6; ++ci) { const int ch = F.lane + 64 * ci; if (ch >= FFH / 8) break;
            const int j0 = 8 * ch; float ac[8], ap[8], an[8], gt[8], o[8];
            unpack8(*(const GAS v4u*)(ac_ + j0), ac); unpack8(*(const GAS v4u*)(gt_ + j0), gt);
            if (hp) unpack8(*(const GAS v4u*)(ap_ + j0), ap); else {
#pragma unroll
                for (int j = 0; j < 8; ++j) ap[j] = 0.f; }
            if (hn) unpack8(*(const GAS v4u*)(an_ + j0), an); else {
#pragma unroll
                for (int j = 0; j < 8; ++j) an[j] = 0.f; }
#pragma unroll
            for (int j = 0; j < 8; ++j) { const float cv = cb[j0 + j] + cw[j0 + j] * ap[j] + cw[FFH + j0 + j] * ac[j] + cw[2 * FFH + j0 + j] * an[j]; o[j] = siluf_(cv) * gt[j]; }
            *(GAS v4u*)(HG + (size_t)m * FFH + j0) = pack8(o);
        }
    }
}
__device__ __forceinline__ void ph_hg_gate(Frame& F) {
    const int gw = F.vcu * NWAVES + F.wave, NGW = F.G * NWAVES;
    bf16* O = (bf16*)(ws_(F) + WS_O); const bf16* G = (const bf16*)(ws_(F) + WS_G);
    const int c0 = 16 * F.lane; float ng[16];
#pragma unroll
    for (int j = 0; j < 16; ++j) ng[j] = inp(F, 29)[(c0 + j) & 127];
    for (int m = gw; m < TL; m += NGW) {
        float o[16], g[16]; unpack8(*(const GAS v4u*)(O + (size_t)m * D + c0), o); unpack8(*(const GAS v4u*)(O + (size_t)m * D + c0 + 8), o + 8);
        unpack8(*(const GAS v4u*)(G + (size_t)m * D + c0), g); unpack8(*(const GAS v4u*)(G + (size_t)m * D + c0 + 8), g + 8);
        float ss = 0.f;
#pragma unroll
        for (int j = 0; j < 16; ++j) ss += o[j] * o[j];
        ss += __shfl_xor(ss, 1); ss += __shfl_xor(ss, 2); ss += __shfl_xor(ss, 4);
        const float sc = 1.f / sqrtf(ss * (1.f / 128.f) + NORM_EPS);
#pragma unroll
        for (int j = 0; j < 16; ++j) o[j] = o[j] * sc * ng[j] * siluf_(g[j]);
        *(GAS v4u*)(O + (size_t)m * D + c0) = pack8(o); *(GAS v4u*)(O + (size_t)m * D + c0 + 8) = pack8(o + 8);
    }
}

typedef short bf16x8_t __attribute__((ext_vector_type(8)));
typedef float f32x16 __attribute__((ext_vector_type(16)));
__device__ __forceinline__ int crow(int r, int hi) { return (r & 3) + 8 * (r >> 2) + 4 * hi; }
constexpr int NCH = TT / 64;
__device__ __forceinline__ void p0_s5_tables(Frame& F) {
    LAS unsigned char* L = F.lds + RING_OFF;
    LAS double* lam = (LAS double*)L;
    LAS float* bb = (LAS float*)(L + 1024);
    LAS float* cc = (LAS float*)(L + 1024 + 8192);
    LAS float* pw = (LAS float*)(L + 1024 + 16384);
    unsigned char* ws = ws_(F);
    for (int item4 = blockIdx.x; item4 < 256; item4 += F.G) {
        const int item = item4 >> 2, part = item4 & 3;
        const int g = item >> 1, d = item & 1;
        __syncthreads();
        if (F.tid < 64) { const int n = F.tid, pi = (d * 32 + g) * 64 + n;
            const double lre = inp(F, 17)[pi], lim = inp(F, 18)[pi], dt = exp((double)inp(F, 19)[d * 32 + g]);
            const double mag = exp(lre * dt), are = mag * cos(lim * dt), aim = mag * sin(lim * dt), den = lre * lre + lim * lim, nr = are - 1.0;
            const double fr = (nr * lre + aim * lim) / den, fi = (aim * lre - nr * lim) / den;
            for (int q = 0; q < 16; ++q) { const double br = inp(F, 20)[(size_t)pi * 16 + q], bi = inp(F, 21)[(size_t)pi * 16 + q];
                bb[(n * 16 + q) * 2] = (float)(fr * br - fi * bi); bb[(n * 16 + q) * 2 + 1] = (float)(fr * bi + fi * br); }
            double pr = 1.0, pim = 0.0;
            for (int e = 0; e <= 64; ++e) { pw[(e * 64 + n) * 2] = (float)pr; pw[(e * 64 + n) * 2 + 1] = (float)pim; const double n_r = pr * are - pim * aim, n_i = pr * aim + pim * are; pr = n_r; pim = n_i; } }
        for (int i = F.tid; i < 1024; i += 512) { const int p = i >> 6, n = i & 63; cc[i * 2] = inp(F, 22)[((size_t)(d * 32 + g) * 16 + p) * 64 + n]; cc[i * 2 + 1] = inp(F, 23)[((size_t)(d * 32 + g) * 16 + p) * 64 + n]; }
        __syncthreads();
        { bf16* WF = (bf16*)(ws + WS_WF) + (size_t)g * 256 * 1024;
          for (int i = part * 4096 + F.tid; i < (part + 1) * 4096; i += 512) { const int row = i >> 7, grp = i & 127, c = row >> 6, n = row & 63, sI = grp >> 1, q0 = (grp & 1) * 8, e = d ? sI : 63 - sI;
              const float pr = pw[(e * 64 + n) * 2], pim = pw[(e * 64 + n) * 2 + 1]; float o[8];
              const LAS f32x4* bq = (const LAS f32x4*)(bb + (n * 16 + q0) * 2);
#pragma unroll
              for (int j4 = 0; j4 < 4; ++j4) { const f32x4 v = bq[j4]; o[2 * j4] = c ? (pr * v.y + pim * v.x) : (pr * v.x - pim * v.y); o[2 * j4 + 1] = c ? (pr * v.w + pim * v.z) : (pr * v.z - pim * v.w); }
              *(GAS v4u*)(WF + (size_t)(d * 128 + row) * 1024 + sI * 16 + q0) = pack8(o); } }
        { bf16* WC = (bf16*)(ws + WS_WC) + (size_t)g * 1024 * 256;
          for (int i = part * 4096 + F.tid; i < (part + 1) * 4096; i += 512) { const int row = i >> 4, grp = i & 15, t = row >> 4, p = row & 15, c = grp >> 3, n0 = (grp & 7) * 8, ex = d ? 64 - t : t + 1; float o[8];
              const LAS f32x4* pq = (const LAS f32x4*)(pw + (ex * 64 + n0) * 2); const LAS f32x4* cq = (const LAS f32x4*)(cc + (p * 64 + n0) * 2);
#pragma unroll
              for (int j4 = 0; j4 < 4; ++j4) { const f32x4 pv = pq[j4], cv = cq[j4];
                  o[2 * j4] = c ? -(cv.x * pv.y + cv.y * pv.x) : (cv.x * pv.x - cv.y * pv.y); o[2 * j4 + 1] = c ? -(cv.z * pv.w + cv.w * pv.z) : (cv.z * pv.z - cv.w * pv.w); }
              *(GAS v4u*)(WC + (size_t)row * 256 + d * 128 + c * 64 + n0) = pack8(o); } }
        { bf16* TP = (bf16*)(ws + WS_TOEP) + (size_t)g * 127 * 256; float* T0 = (float*)(ws + WS_T0) + (size_t)(g * 2 + d) * 256;
          for (int i = part * 256 + F.tid; i < (part + 1) * 256; i += 512) { const int tau = i >> 4, p = i & 15; float acc[16];
#pragma unroll
              for (int q = 0; q < 16; ++q) acc[q] = 0.f;
              for (int n = 0; n < 64; ++n) { const float pr = pw[(tau * 64 + n) * 2], pim = pw[(tau * 64 + n) * 2 + 1], cr = cc[(p * 64 + n) * 2], ci = cc[(p * 64 + n) * 2 + 1];
                  const float tr = cr * pr - ci * pim, ti = cr * pim + ci * pr;
                  const LAS f32x4* bq = (const LAS f32x4*)(bb + n * 32);
#pragma unroll
                  for (int q4 = 0; q4 < 8; ++q4) { const f32x4 v = bq[q4]; acc[2 * q4] += tr * v.x - ti * v.y; acc[2 * q4 + 1] += tr * v.z - ti * v.w; } }
              if (tau == 0) {
#pragma unroll
                  for (int q = 0; q < 16; ++q) T0[p * 16 + q] = acc[q]; }
              else { bf16* o = TP + (size_t)(d ? 63 - tau : 63 + tau) * 256 + p * 16; *(GAS v4u*)o = pack8(acc); *(GAS v4u*)(o + 8) = pack8(acc + 8); } } }
        if (part == 0 && F.tid < 64) { float* A64 = (float*)(ws + WS_A64) + (size_t)((g * 2 + d) * 64 + F.tid) * 2; A64[0] = pw[(64 * 64 + F.tid) * 2]; A64[1] = pw[(64 * 64 + F.tid) * 2 + 1]; }
    }
    __syncthreads();
}
__device__ __forceinline__ void ph_s5_finals(Frame& F) {
    const int lane = F.lane, r32 = lane & 31, hh = lane >> 5, wave = F.wave;
    unsigned char* ws = ws_(F);
    for (int u = blockIdx.x; u < 288; u += F.G) {
        const int g = u / 9, nb = u % 9; int chunk = nb * 32 + r32; const bool valid = chunk < NCH; if (!valid) chunk = NCH - 1;
        const bf16* ub = (const bf16*)(ws + WS_UG) + ((size_t)g * TT + (size_t)chunk * 64) * 16 + 8 * hh;
        const bf16* wf = (const bf16*)(ws + WS_WF) + ((size_t)(g * 256 + 32 * wave + r32)) * 1024 + 8 * hh;
        f32x16 acc;
#pragma unroll
        for (int r = 0; r < 16; ++r) acc[r] = 0.f;
#pragma unroll 16
        for (int sI = 0; sI < 64; ++sI) { const bf16x8_t a = *(const GAS bf16x8_t*)(wf + 16 * sI), b = *(const GAS bf16x8_t*)(ub + 16 * sI); acc = __builtin_amdgcn_mfma_f32_32x32x16_bf16(a, b, acc, 0, 0, 0); }
        if (valid) { float* fo = (float*)(ws + WS_FIN) + ((size_t)g * NCH + chunk) * 256 + 32 * wave + 4 * hh;
#pragma unroll
            for (int k = 0; k < 4; ++k) *(GAS f32x4*)(fo + 8 * k) = (f32x4){acc[4 * k], acc[4 * k + 1], acc[4 * k + 2], acc[4 * k + 3]}; }
    }
}
__device__ __forceinline__ int s5_chunk_of(int step, int d, int b) { return step < 4 ? 256 + 4 * b + (d ? 3 - step : step) : 128 * b + (d ? 127 - (step - 4) : step - 4); }
__device__ __forceinline__ void ph_s5_carry(Frame& F) {
    if (F.wave >= 3) return;
    unsigned char* ws = ws_(F);
    for (int item = ((int)F.G - 1 - (int)blockIdx.x) * 3 + F.wave; item < 128; item += 3 * F.G) {
        const int g = item >> 2, d = (item >> 1) & 1, b = item & 1, n = F.lane;
        const float a_r = ((const float*)(ws + WS_A64))[((g * 2 + d) * 64 + n) * 2], a_i = ((const float*)(ws + WS_A64))[((g * 2 + d) * 64 + n) * 2 + 1];
        const float* Fb = (const float*)(ws + WS_FIN) + (size_t)g * NCH * 256 + d * 128 + n; bf16* Sb = (bf16*)(ws + WS_SIN) + (size_t)g * NCH * 256 + d * 128 + n;
        float sr = 0.f, si = 0.f;
        for (int s0 = 0; s0 < 132; s0 += 12) {
            float fr[12], fi[12];
#pragma unroll
            for (int j = 0; j < 12; ++j) { const int c = s5_chunk_of(s0 + j, d, b); fr[j] = Fb[(size_t)c * 256]; fi[j] = Fb[(size_t)c * 256 + 64]; }
#pragma unroll
            for (int j = 0; j < 12; ++j) { const int c = s5_chunk_of(s0 + j, d, b); Sb[(size_t)c * 256] = (bf16)f2bf(sr); Sb[(size_t)c * 256 + 64] = (bf16)f2bf(si);
                const float nr = a_r * sr - a_i * si + fr[j], ni = a_r * si + a_i * sr + fi[j]; sr = nr; si = ni; }
        }
    }
}
constexpr int TP_PITCH = 48;
__device__ __forceinline__ void ph_s5_out(Frame& F) {
    LAS unsigned char* L = F.lds + RING_OFF;
    const int lane = F.lane, r32 = lane & 31, hh = lane >> 5, wave = F.wave, tid = F.tid;
    unsigned char* ws = ws_(F);
    for (int u = blockIdx.x; u < 288; u += F.G) {
        const int g = u / 9, nb = u % 9; int chunk = nb * 32 + r32; const bool valid = chunk < NCH; if (!valid) chunk = NCH - 1;
        __syncthreads();
        { const GAS v4u* tp = (const GAS v4u*)((const bf16*)(ws + WS_TOEP) + (size_t)g * 127 * 256); const float* t0 = (const float*)(ws + WS_T0) + (size_t)g * 512;
          for (int c = tid; c < 127 * 32; c += 512) { const int di = c >> 5, p = (c >> 1) & 15, half = c & 1; v4u v;
              if (di == 63) { float o[8];
#pragma unroll
                  for (int j = 0; j < 8; ++j) o[j] = t0[p * 16 + half * 8 + j] + t0[256 + p * 16 + half * 8 + j];
                  v = pack8(o); }
              else v = tp[c];
              *(LAS v4u*)(L + (di * 16 + p) * TP_PITCH + half * 16) = v; } }
        __syncthreads();
        const bf16* ub = (const bf16*)(ws + WS_UG) + ((size_t)g * TT + (size_t)chunk * 64) * 16 + 8 * hh;
        f32x16 acc[4];
#pragma unroll
        for (int i = 0; i < 4; ++i)
#pragma unroll
            for (int r = 0; r < 16; ++r) acc[i][r] = 0.f;
        const LAS unsigned char* tl = L + ((63 + 2 * wave + (r32 >> 4)) * 16 + (r32 & 15)) * TP_PITCH + hh * 16;
#pragma unroll 1
        for (int s0 = 0; s0 < 64; s0 += 16) {
            bf16x8_t bq[16];
#pragma unroll
            for (int e = 0; e < 16; ++e) bq[e] = *(const GAS bf16x8_t*)(ub + 16 * (s0 + e));
#pragma unroll
            for (int e = 0; e < 16; ++e) { const int sI = s0 + e; const bf16x8_t b = bq[e];
#pragma unroll
            for (int i = 0; i < 4; ++i) { const bf16x8_t a = *(const LAS bf16x8_t*)(tl + (16 * i - sI) * 16 * TP_PITCH); acc[i] = __builtin_amdgcn_mfma_f32_32x32x16_bf16(a, b, acc[i], 0, 0, 0); }
            }
        }
        { const bf16* sb = (const bf16*)(ws + WS_SIN) + ((size_t)g * NCH + chunk) * 256 + 8 * hh;
          const bf16* wc = (const bf16*)(ws + WS_WC) + ((size_t)g * 1024 + 32 * wave + r32) * 256 + 8 * hh;
#pragma unroll 4
          for (int kk = 0; kk < 16; ++kk) {
              const bf16x8_t b = *(const GAS bf16x8_t*)(sb + 16 * kk);
#pragma unroll
              for (int i = 0; i < 4; ++i) { const bf16x8_t a = *(const GAS bf16x8_t*)(wc + (size_t)(256 * i) * 256 + 16 * kk); acc[i] = __builtin_amdgcn_mfma_f32_32x32x16_bf16(a, b, acc[i], 0, 0, 0); }
          } }
        if (valid) {
            const float* dsk = inp(F, 24) + 16 * g;
#pragma unroll
            for (int i = 0; i < 4; ++i)
#pragma unroll
                for (int k = 0; k < 4; ++k) { const int tloc = 2 * (wave + 8 * i) + (k >> 1), p0 = 8 * (k & 1) + 4 * hh; const size_t m = (size_t)chunk * 64 + tloc;
                    const v2u uw = *(const GAS v2u*)((const bf16*)(ws + WS_UG) + ((size_t)g * TT + m) * 16 + p0);
                    const float y0 = gelu_tanh(acc[i][4 * k] + dsk[p0] * bflo(uw.x)), y1 = gelu_tanh(acc[i][4 * k + 1] + dsk[p0 + 1] * bfhi(uw.x));
                    const float y2 = gelu_tanh(acc[i][4 * k + 2] + dsk[p0 + 2] * bflo(uw.y)), y3 = gelu_tanh(acc[i][4 * k + 3] + dsk[p0 + 3] * bfhi(uw.y));
                    v2u zw; zw.x = pk2(y0, y1); zw.y = pk2(y2, y3);
                    *(GAS v2u*)((bf16*)(ws + WS_Z) + m * 512 + 16 * g + p0) = zw; }
        }
    }
}

__device__ __forceinline__ bf16x8_t pack_frag(const f32x16& p, int base) {
    v4u w; w.x = pg8::cvt_pk_bf16(p[base + 0], p[base + 1]); w.y = pg8::cvt_pk_bf16(p[base + 2], p[base + 3]); w.z = pg8::cvt_pk_bf16(p[base + 4], p[base + 5]); w.w = pg8::cvt_pk_bf16(p[base + 6], p[base + 7]);
    return __builtin_bit_cast(bf16x8_t, w);
}
constexpr int AT_KP = 208, AT_VP = 272;
constexpr int AT_KB = 128 * AT_KP, AT_VB = 64 * AT_VP;
constexpr int AT_K0 = 0, AT_V0 = 2 * AT_KB, AT_WS = 2 * AT_KB + 2 * AT_VB;
__device__ __forceinline__ void ph_attn(Frame& F) {
    LAS unsigned char* L = F.lds + RING_OFF;
    const int lane = F.lane, r32 = lane & 31, hi = lane >> 5, wave = F.wave, tid = F.tid;
    volatile LAS float* wsf = (volatile LAS float*)(L + AT_WS) + wave * 32;
    const bf16* Qb = (const bf16*)(ws_(F) + WS_QB); const bf16* Kb = (const bf16*)(ws_(F) + WS_KB); const bf16* Vt = (const bf16*)(ws_(F) + WS_VB);
    bf16* MIX = (bf16*)(ws_(F) + WS_MIX);
    int kl[3], vl[2];
#pragma unroll
    for (int i = 0; i < 3; ++i) { const int c = tid + 512 * i; kl[i] = (c / 12) * AT_KP + (c % 12) * 16; }
#pragma unroll
    for (int i = 0; i < 2; ++i) { const int c = tid + 512 * i; vl[i] = ((c & 511) >> 3) * AT_VP + (c >> 9) * 128 + (c & 7) * 16; }
    for (int it = 0; it < 3; ++it) {
        int u; if (it < 2) u = it * 256 + F.vcu; else { if (F.vcu >= 16) break; u = 512 + F.vcu; }
        int b, h, tq0, NT, m0;
        if (u < 512) { b = u >> 8; h = (u >> 5) & 7; tq0 = (u & 31) * 256; NT = TQK / 128; m0 = b * SEQ + tq0; }
        else { const int uc = u - 512; b = uc >> 3; h = uc & 7; tq0 = SEQ; NT = CTXL / 128; m0 = TL + b * CTXL; }
        const size_t bh = (size_t)(b * 8 + h);
        const GAS v4u* Kg = (const GAS v4u*)(Kb + bh * TQK * 96);
        const GAS v4u* Vg = (const GAS v4u*)(Vt + bh * (TQK / 64) * 4096);
        bf16x8_t qf[6];
        { const bf16* qp = Qb + (bh * TQK + tq0 + wave * 32 + r32) * 96 + hi * 8;
#pragma unroll
          for (int ks = 0; ks < 6; ++ks) qf[ks] = *(const GAS bf16x8_t*)(qp + ks * 16); }
        f32x16 o0, o1;
#pragma unroll
        for (int r = 0; r < 16; ++r) { o0[r] = 0.f; o1[r] = 0.f; }
        float m_run = -1e30f, l_run = 0.f;
        __syncthreads();
        { v4u a[3], v[2];
#pragma unroll
          for (int i = 0; i < 3; ++i) a[i] = Kg[tid + 512 * i];
#pragma unroll
          for (int i = 0; i < 2; ++i) v[i] = Vg[tid + 512 * i];
#pragma unroll
          for (int i = 0; i < 3; ++i) *(LAS v4u*)(L + AT_K0 + kl[i]) = a[i];
#pragma unroll
          for (int i = 0; i < 2; ++i) *(LAS v4u*)(L + AT_V0 + vl[i]) = v[i]; }
        __syncthreads();
        for (int t = 0; t < NT; ++t) {
            const int cur = t & 1, nxt = cur ^ 1; const bool more = (t + 1 < NT);
            v4u na[3], nv[2];
#pragma unroll
            for (int i = 0; i < 3; ++i) na[i] = (v4u){0u, 0u, 0u, 0u};
#pragma unroll
            for (int i = 0; i < 2; ++i) nv[i] = (v4u){0u, 0u, 0u, 0u};
            if (more) {
#pragma unroll
                for (int i = 0; i < 3; ++i) na[i] = Kg[(size_t)(t + 1) * 1536 + tid + 512 * i];
#pragma unroll
                for (int i = 0; i < 2; ++i) nv[i] = Vg[(size_t)(t + 1) * 1024 + tid + 512 * i]; }
            const LAS unsigned char* Kl = L + AT_K0 + cur * AT_KB + r32 * AT_KP + hi * 16;
            const LAS unsigned char* Vl = L + AT_V0 + cur * AT_VB + r32 * AT_VP + hi * 16;
            f32x16 p[4];
#pragma unroll
            for (int kb = 0; kb < 4; ++kb) {
#pragma unroll
                for (int r = 0; r < 16; ++r) p[kb][r] = 0.f;
#pragma unroll
                for (int ks = 0; ks < 6; ++ks) p[kb] = __builtin_amdgcn_mfma_f32_32x32x16_bf16(*(const LAS bf16x8_t*)(Kl + kb * 32 * AT_KP + ks * 32), qf[ks], p[kb], 0, 0, 0);
            }
            float mt = fmaxf(fmaxf(p[0][0], p[1][0]), fmaxf(p[2][0], p[3][0]));
#pragma unroll
            for (int r = 1; r < 16; ++r) mt = fmaxf(mt, fmaxf(fmaxf(p[0][r], p[1][r]), fmaxf(p[2][r], p[3][r])));
            mt = fmaxf(mt, __shfl_xor(mt, 32));
            const bool need = mt > m_run + 8.0f;
            if (__any(need)) {
                const float mn = need ? mt : m_run, alpha = __builtin_amdgcn_exp2f(m_run - mn);
                l_run *= alpha; m_run = mn;
                if (hi == 0) wsf[r32] = alpha;
#pragma unroll
                for (int r = 0; r < 16; ++r) { const float a = wsf[crow(r, hi)]; o0[r] *= a; o1[r] *= a; }
            }
            float sum = 0.f;
#pragma unroll
            for (int kb = 0; kb < 4; ++kb)
#pragma unroll
                for (int r = 0; r < 16; ++r) { p[kb][r] = __builtin_amdgcn_exp2f(p[kb][r] - m_run); sum += p[kb][r]; }
            l_run += sum;
#pragma unroll
            for (int kb = 0; kb < 4; ++kb) {
                const bf16x8_t pa = pack_frag(p[kb], 0), pb = pack_frag(p[kb], 8);
                const LAS unsigned char* vp = Vl + (kb >> 1) * 128 + (kb & 1) * 64;
                o0 = __builtin_amdgcn_mfma_f32_32x32x16_bf16(pa, *(const LAS bf16x8_t*)(vp), o0, 0, 0, 0);
                o0 = __builtin_amdgcn_mfma_f32_32x32x16_bf16(pb, *(const LAS bf16x8_t*)(vp + 32), o0, 0, 0, 0);
                o1 = __builtin_amdgcn_mfma_f32_32x32x16_bf16(pa, *(const LAS bf16x8_t*)(vp + 32 * AT_VP), o1, 0, 0, 0);
                o1 = __builtin_amdgcn_mfma_f32_32x32x16_bf16(pb, *(const LAS bf16x8_t*)(vp + 32 * AT_VP + 32), o1, 0, 0, 0);
            }
            if (more) {
#pragma unroll
                for (int i = 0; i < 3; ++i) *(LAS v4u*)(L + AT_K0 + nxt * AT_KB + kl[i]) = na[i];
#pragma unroll
                for (int i = 0; i < 2; ++i) *(LAS v4u*)(L + AT_V0 + nxt * AT_VB + vl[i]) = nv[i]; }
            __syncthreads();
        }
        l_run += __shfl_xor(l_run, 32);
        if (hi == 0) wsf[r32] = 1.0f / l_run;
#pragma unroll
        for (int r = 0; r < 16; ++r) { const int q = crow(r, hi); const float inv = wsf[q];
            bf16* op = MIX + (size_t)(m0 + wave * 32 + q) * D + h * 64 + r32;
            op[0] = (bf16)f2bf(o0[r] * inv); op[32] = (bf16)f2bf(o1[r] * inv); }
    }
}

constexpr int HG_QT = 0, HG_KT = 17408, HG_KH = 34816, HG_VT = 53248, HG_ST = 71680, HG_DEC = 106496, HG_TOT = 107008;
constexpr int HG_NSC = 17;
constexpr size_t WS_SD = 231 * MiB;
constexpr size_t WS_DECS = WS_SD + 18 * MiB;
static_assert(WS_DECS + 32 * 17 * 128 * 4 <= WS_END, "hgrn ws");
template <bool OUT>
__device__ __forceinline__ void hgrn_pass(Frame& F, int b, int h, int dir, int sc, f32x16 (&st)[2], float& dsum) {
    LAS unsigned char* L = F.lds + RING_OFF;
    unsigned char* ws = ws_(F);
    const int tid = F.tid, lane = F.lane, r32 = lane & 31, hh = lane >> 5, wave = F.wave;
    const int k = tid & 127, tg = tid >> 7;
    const int nch = sc == 0 ? 4 : 8; const size_t rowbase = sc == 0 ? (size_t)TL + b * CTXL : (size_t)b * SEQ + (size_t)(sc - 1) * 512;
    const bf16* QF = (const bf16*)(ws + WS_QFFI);
    const float lb = ((const float*)(ws + WS_LBV))[dir * 1024 + h * 128 + k];
    const int colf = 1024 * (1 + dir) + h * 128 + k, colq = h * 128 + k, colv = 3072 + h * 128 + k;
    const int dvb = wave & 3, jb = wave >> 2;
    bf16 rq[16], rf[16], rv[16];
#define HG_LOAD(ci) do { const int cc_ = dir ? nch - 1 - (ci) : (ci); const int tl0_ = dir ? 63 - 16 * tg : 16 * tg; \
        const GAS bf16* pf_ = (const GAS bf16*)(QF + (rowbase + 64 * cc_ + tl0_) * 4096 + colf); const GAS bf16* pv_ = pf_ + (colv - colf); const GAS bf16* pq_ = pf_ + (colq - colf); const long stp_ = dir ? -4096 : 4096; \
        _Pragma("unroll") for (int jj = 0; jj < 16; ++jj) { rf[jj] = *pf_; rv[jj] = *pv_; if (OUT) rq[jj] = *pq_; pf_ += stp_; pv_ += stp_; pq_ += stp_; asm volatile("" : "+v"(pf_), "+v"(pv_), "+v"(pq_)); } } while (0)
    HG_LOAD(0);
    for (int ci = 0; ci < nch; ++ci) {
        const int cc = dir ? nch - 1 - ci : ci;
        float cum[16], kk[16];
        { float run = 0.f;
#pragma unroll
          for (int jj = 0; jj < 16; ++jj) { const float f = lb + (1.f - lb) * sigmoidf_(bf2f(rf[jj])); run += __log2f(f); cum[jj] = run; kk[jj] = 1.f - f; }
          ((LAS float*)(L + HG_TOT))[tg * 128 + k] = run; }
        __syncthreads();
        { const LAS float* tot = (const LAS float*)(L + HG_TOT) + k; const float t0 = tot[0], t1 = tot[128], t2 = tot[256], t3 = tot[384];
          const float pre = tg == 0 ? 0.f : (tg == 1 ? t0 : (tg == 2 ? t0 + t1 : t0 + t1 + t2)), total = (t0 + t1) + (t2 + t3);
          if (tg == 0) { ((LAS float*)(L + HG_DEC))[k] = __builtin_amdgcn_exp2f(total); dsum += total; }
#define HG_KH(jj) (kk[jj] * __builtin_amdgcn_exp2f(total - (pre + cum[jj])))
#define HG_PKV(a, b_) ((unsigned)rv[a] | ((unsigned)rv[b_] << 16))
          if (OUT) {
#pragma unroll
              for (int jj = 0; jj < 16; ++jj) { const float c = pre + cum[jj]; const int j = 16 * tg + jj;
                  *(LAS bf16*)(L + HG_QT + j * 272 + k * 2) = (bf16)f2bf(bf2f(rq[jj]) * __builtin_amdgcn_exp2f(c)); *(LAS bf16*)(L + HG_KT + j * 272 + k * 2) = (bf16)f2bf(kk[jj] * __builtin_amdgcn_exp2f(-c)); } }
          v4u w0, w1;
          w0.x = pk2(HG_KH(0), HG_KH(1)); w0.y = pk2(HG_KH(2), HG_KH(3)); w0.z = pk2(HG_KH(8), HG_KH(9)); w0.w = pk2(HG_KH(10), HG_KH(11));
          w1.x = pk2(HG_KH(4), HG_KH(5)); w1.y = pk2(HG_KH(6), HG_KH(7)); w1.z = pk2(HG_KH(12), HG_KH(13)); w1.w = pk2(HG_KH(14), HG_KH(15));
          *(LAS v4u*)(L + HG_KH + k * 144 + tg * 32) = w0; *(LAS v4u*)(L + HG_KH + k * 144 + tg * 32 + 16) = w1;
          w0.x = HG_PKV(0, 1); w0.y = HG_PKV(2, 3); w0.z = HG_PKV(8, 9); w0.w = HG_PKV(10, 11);
          w1.x = HG_PKV(4, 5); w1.y = HG_PKV(6, 7); w1.z = HG_PKV(12, 13); w1.w = HG_PKV(14, 15);
          *(LAS v4u*)(L + HG_VT + k * 144 + tg * 32) = w0; *(LAS v4u*)(L + HG_VT + k * 144 + tg * 32 + 16) = w1; }
#undef HG_KH
#undef HG_PKV
        if (ci + 1 < nch) HG_LOAD(ci + 1);
        __syncthreads();
        if (OUT) {
            f32x16 oacc;
#pragma unroll
            for (int r = 0; r < 16; ++r) oacc[r] = 0.f;
            const LAS unsigned char* qrow = L + HG_QT + (32 * jb + r32) * 272 + hh * 16;
            const LAS unsigned char* srow = L + HG_ST + (32 * dvb + r32) * 272 + hh * 16;
            const LAS unsigned char* vrow = L + HG_VT + (32 * dvb + r32) * 144 + hh * 16;
#pragma unroll
            for (int ks = 0; ks < 8; ++ks) oacc = __builtin_amdgcn_mfma_f32_32x32x16_bf16(*(const LAS bf16x8_t*)(qrow + ks * 32), *(const LAS bf16x8_t*)(srow + ks * 32), oacc, 0, 0, 0);
            {
                f32x16 at;
#pragma unroll
                for (int r = 0; r < 16; ++r) at[r] = 0.f;
                const LAS unsigned char* krow = L + HG_KT + r32 * 272 + hh * 16;
#pragma unroll
                for (int ks = 0; ks < 8; ++ks) at = __builtin_amdgcn_mfma_f32_32x32x16_bf16(*(const LAS bf16x8_t*)(krow + ks * 32), *(const LAS bf16x8_t*)(qrow + ks * 32), at, 0, 0, 0);
                if (jb == 0) {
#pragma unroll
                    for (int r = 0; r < 16; ++r) if (crow(r, hh) > r32) at[r] = 0.f; }
                oacc = __builtin_amdgcn_mfma_f32_32x32x16_bf16(pack_frag(at, 0), *(const LAS bf16x8_t*)(vrow + 0), oacc, 0, 0, 0);
                oacc = __builtin_amdgcn_mfma_f32_32x32x16_bf16(pack_frag(at, 8), *(const LAS bf16x8_t*)(vrow + 32), oacc, 0, 0, 0);
            }
            if (jb == 1) {
                f32x16 at;
#pragma unroll
                for (int r = 0; r < 16; ++r) at[r] = 0.f;
                const LAS unsigned char* krow = L + HG_KT + (32 + r32) * 272 + hh * 16;
#pragma unroll
                for (int ks = 0; ks < 8; ++ks) at = __builtin_amdgcn_mfma_f32_32x32x16_bf16(*(const LAS bf16x8_t*)(krow + ks * 32), *(const LAS bf16x8_t*)(qrow + ks * 32), at, 0, 0, 0);
#pragma unroll
                for (int r = 0; r < 16; ++r) if (crow(r, hh) > r32) at[r] = 0.f;
                oacc = __builtin_amdgcn_mfma_f32_32x32x16_bf16(pack_frag(at, 0), *(const LAS bf16x8_t*)(vrow + 64), oacc, 0, 0, 0);
                oacc = __builtin_amdgcn_mfma_f32_32x32x16_bf16(pack_frag(at, 8), *(const LAS bf16x8_t*)(vrow + 96), oacc, 0, 0, 0);
            }
            bf16* O = (bf16*)(ws + WS_O);
#pragma unroll
            for (int r = 0; r < 16; ++r) { const int j = 32 * jb + crow(r, hh), tl = dir ? 63 - j : j;
                bf16* op = O + (rowbase + 64 * cc + tl) * D + h * 128 + 32 * dvb + r32; float ov = oacc[r];
                if (dir) ov += bf2f(*op);
                *op = (bf16)f2bf(ov); }
        }
#pragma unroll
        for (int t = 0; t < 2; ++t) { const int dkb = 2 * (wave >> 2) + t;
#pragma unroll
            for (int q4 = 0; q4 < 4; ++q4) { const f32x4 dd = *(const LAS f32x4*)(L + HG_DEC + (32 * dkb + 8 * q4 + 4 * hh) * 4);
                st[t][4 * q4] *= dd[0]; st[t][4 * q4 + 1] *= dd[1]; st[t][4 * q4 + 2] *= dd[2]; st[t][4 * q4 + 3] *= dd[3]; }
            const LAS unsigned char* arow = L + HG_KH + (32 * dkb + r32) * 144 + hh * 16; const LAS unsigned char* vrow = L + HG_VT + (32 * dvb + r32) * 144 + hh * 16;
#pragma unroll
            for (int ks = 0; ks < 4; ++ks) st[t] = __builtin_amdgcn_mfma_f32_32x32x16_bf16(*(const LAS bf16x8_t*)(arow + ks * 32), *(const LAS bf16x8_t*)(vrow + ks * 32), st[t], 0, 0, 0); }
        __syncthreads();
        if (OUT && ci + 1 < nch) {
#pragma unroll
            for (int t = 0; t < 2; ++t) { const int dkb = 2 * (wave >> 2) + t;
#pragma unroll
                for (int q4 = 0; q4 < 4; ++q4) { v2u w; w.x = pk2(st[t][4 * q4], st[t][4 * q4 + 1]); w.y = pk2(st[t][4 * q4 + 2], st[t][4 * q4 + 3]);
                    *(LAS v2u*)(L + HG_ST + (32 * dvb + r32) * 272 + (32 * dkb + 8 * q4 + 4 * hh) * 2) = w; } }
        }
    }
#undef HG_LOAD
}
__device__ __forceinline__ void ph_hgrn_states(Frame& F) {
    unsigned char* ws = ws_(F);
    for (int item = blockIdx.x; item < 32 * HG_NSC; item += F.G) {
        const int chain = item / HG_NSC, sc = item % HG_NSC, b = chain >> 4, h = (chain >> 1) & 7, dir = chain & 1;
        f32x16 st[2];
#pragma unroll
        for (int t = 0; t < 2; ++t)
#pragma unroll
            for (int r = 0; r < 16; ++r) st[t][r] = 0.f;
        float dsum = 0.f;
        hgrn_pass<false>(F, b, h, dir, sc, st, dsum);
        bf16* sd = (bf16*)(ws + WS_SD) + ((size_t)(chain * HG_NSC + sc) * 8 + F.wave) * 2048 + F.lane;
#pragma unroll
        for (int t = 0; t < 2; ++t)
#pragma unroll
            for (int r = 0; r < 16; ++r) sd[(t * 16 + r) * 64] = (bf16)f2bf(st[t][r]);
        if (F.tid < 128) ((float*)(ws + WS_DECS))[(size_t)(chain * HG_NSC + sc) * 128 + F.tid] = dsum;
    }
}
__device__ __forceinline__ void ph_hgrn_carry(Frame& F) {
    unsigned char* ws = ws_(F);
    const int gt = F.vcu * 512 + F.tid, NT = F.G * 512;
    for (int idx = gt; idx < 32 * 16384; idx += NT) {
        const int chain = idx >> 14, e = idx & 16383, dir = chain & 1;
        const int lane = e & 63, r = (e >> 6) & 15, t = (e >> 10) & 1, wv = e >> 11, dk = 32 * (2 * (wv >> 2) + t) + crow(r, lane >> 5);
        bf16* sd = (bf16*)(ws + WS_SD) + (size_t)chain * HG_NSC * 16384 + e; const float* dl = (const float*)(ws + WS_DECS) + (size_t)chain * HG_NSC * 128 + dk;
        float v[HG_NSC], dd[HG_NSC];
#pragma unroll
        for (int i = 0; i < HG_NSC; ++i) { const int sp = (i == 0) ? 0 : (dir ? 17 - i : i); v[i] = bf2f(sd[(size_t)sp * 16384]); dd[i] = dl[sp * 128]; }
        float S = 0.f;
#pragma unroll
        for (int i = 0; i < HG_NSC; ++i) { const int sp = (i == 0) ? 0 : (dir ? 17 - i : i); sd[(size_t)sp * 16384] = (bf16)f2bf(S); S = __builtin_amdgcn_exp2f(dd[i]) * S + v[i]; }
    }
}
__device__ __forceinline__ void ph_hgrn_out(Frame& F) {
    LAS unsigned char* L = F.lds + RING_OFF;
    unsigned char* ws = ws_(F);
    const int lane = F.lane, r32 = lane & 31, hh = lane >> 5, wave = F.wave, dvb = wave & 3;
    for (int item = blockIdx.x; item < 256; item += F.G) {
        const int b = item >> 7, h = (item >> 4) & 7, Lsc = item & 15, sc = Lsc + 1;
        for (int dir = 0; dir < 2; ++dir) {
            const int chain = (b * 8 + h) * 2 + dir;
            f32x16 st[2];
#pragma unroll
            for (int t = 0; t < 2; ++t)
#pragma unroll
                for (int r = 0; r < 16; ++r) st[t][r] = 0.f;
            { const bf16* sd = (const bf16*)(ws + WS_SD) + ((size_t)(chain * HG_NSC + sc) * 8 + wave) * 2048 + lane;
#pragma unroll
              for (int t = 0; t < 2; ++t)
#pragma unroll
                  for (int r = 0; r < 16; ++r) st[t][r] = bf2f(sd[(t * 16 + r) * 64]); }
            __syncthreads();
#pragma unroll
            for (int t = 0; t < 2; ++t) { const int dkb = 2 * (wave >> 2) + t;
#pragma unroll
                for (int q4 = 0; q4 < 4; ++q4) { v2u w; w.x = pk2(st[t][4 * q4], st[t][4 * q4 + 1]); w.y = pk2(st[t][4 * q4 + 2], st[t][4 * q4 + 3]);
                    *(LAS v2u*)(L + HG_ST + (32 * dvb + r32) * 272 + (32 * dkb + 8 * q4 + 4 * hh) * 2) = w; } }
            float dsum = 0.f;
            hgrn_pass<true>(F, b, h, dir, sc, st, dsum);
            __syncthreads();
        }
        { GAS bf16* O = (GAS bf16*)(ws + WS_O); const GAS bf16* G = (const GAS bf16*)(ws + WS_G);
          const int c0 = h * 128 + 16 * (lane & 7); float ng[16];
#pragma unroll
          for (int j = 0; j < 16; ++j) ng[j] = inp(F, 29)[16 * (lane & 7) + j];
#pragma unroll 2
          for (int it8 = 0; it8 < 8; ++it8) { const size_t m = (size_t)b * SEQ + (size_t)Lsc * 512 + it8 * 64 + wave * 8 + (lane >> 3);
              float o[16], g[16]; unpack8(*(const GAS v4u*)(O + m * D + c0), o); unpack8(*(const GAS v4u*)(O + m * D + c0 + 8), o + 8);
              unpack8(*(const GAS v4u*)(G + m * D + c0), g); unpack8(*(const GAS v4u*)(G + m * D + c0 + 8), g + 8);
              float ss = 0.f;
#pragma unroll
              for (int j = 0; j < 16; ++j) ss += o[j] * o[j];
              ss += __shfl_xor(ss, 1); ss += __shfl_xor(ss, 2); ss += __shfl_xor(ss, 4);
              const float scl = 1.f / sqrtf(ss * (1.f / 128.f) + NORM_EPS);
#pragma unroll
              for (int j = 0; j < 16; ++j) o[j] = o[j] * scl * ng[j] * siluf_(g[j]);
              *(GAS v4u*)(O + m * D + c0) = pack8(o); *(GAS v4u*)(O + m * D + c0 + 8) = pack8(o + 8); }
          __syncthreads(); }
    }
}

struct FInProj {
    bf16* cqkv; bf16* ug;
    __device__ __forceinline__ void operator()(int row, int col, f32x4 v0, f32x4 v1) const {
        v4u w; w.x = pg8::cvt_pk_bf16(v0[0], v0[1]); w.y = pg8::cvt_pk_bf16(v0[2], v0[3]); w.z = pg8::cvt_pk_bf16(v1[0], v1[1]); w.w = pg8::cvt_pk_bf16(v1[2], v1[3]);
        if (col < 672) *(GAS v4u*)(cqkv + (size_t)row * CQKV_LD + col) = w;
        else if (col < EVEN_IN) { const int c = col - 672; *(GAS v4u*)(ug + ((size_t)(c >> 4) * TT + row) * 16 + (c & 15)) = w; }
    }
};
struct FBf16 {
    bf16* o; int ld;
    __device__ __forceinline__ void operator()(int row, int col, f32x4 v0, f32x4 v1) const {
        v4u w; w.x = pg8::cvt_pk_bf16(v0[0], v0[1]); w.y = pg8::cvt_pk_bf16(v0[2], v0[3]); w.z = pg8::cvt_pk_bf16(v1[0], v1[1]); w.w = pg8::cvt_pk_bf16(v1[2], v1[3]);
        *(GAS v4u*)(o + (size_t)row * ld + col) = w;
    }
};
struct EpiGlu {
    static constexpr bool PERM = true, AFTER_DRAIN = false;
    const bf16* z; bf16* mix;
    __device__ __forceinline__ void operator()(const pg8::f32x4 (&acc)[2][2][4][2], const pg8::Unit& u, int wr, int wc, int fr, int fq) const {
        const int row0 = u.pm * 256 + wr * 64 + fr, col0 = u.pn * 256 + wc * 32 + 8 * fq;
#pragma unroll
        for (int ai = 0; ai < 2; ++ai) {
            v4u zz[4][2];
#pragma unroll
            for (int m = 0; m < 4; ++m)
#pragma unroll
                for (int bj = 0; bj < 2; ++bj) zz[m][bj] = *(const GAS v4u*)(z + (size_t)(row0 + ai * 128 + m * 16) * 512 + col0 + bj * 128);
#pragma unroll
            for (int m = 0; m < 4; ++m)
#pragma unroll
                for (int bj = 0; bj < 2; ++bj) { float zf[8], o[8]; unpack8(zz[m][bj], zf);
#pragma unroll
                    for (int j = 0; j < 4; ++j) { o[j] = zf[j] * sigmoidf_(acc[ai][bj][m][0][j]); o[4 + j] = zf[4 + j] * sigmoidf_(acc[ai][bj][m][1][j]); }
                    *(GAS v4u*)(mix + (size_t)(row0 + ai * 128 + m * 16) * D + 512 + col0 + bj * 128) = pack8(o); }
        }
    }
};
struct FQ {
    bf16* qb; const float* rope;
    __device__ __forceinline__ void operator()(int row, int col, f32x4 v0, f32x4 v1) const {
        float x[8] = {v0[0], v0[1], v0[2], v0[3], v1[0], v1[1], v1[2], v1[3]}, p[8];
#pragma unroll
        for (int j = 0; j < 8; ++j) p[j] = __shfl_xor(x[j], 16);
        const bool isctx = row >= TL; const int b = isctx ? ((row - TL) >> 8) : (row >> 13), t = isctx ? ((row - TL) & 255) : (row & 8191), tq = isctx ? SEQ + t : t;
        const int h = col / 96, d = col - h * 96;
        if (d >= 64 && !isctx) { const int idx = d - 64, a = idx >> 4, half = (idx >> 3) & 1, pos = a ? (t & 63) : (t >> 6);
#pragma unroll
            for (int f = 0; f < 8; ++f) { const float cs = rope[2 * (pos * 8 + f)], sn = rope[2 * (pos * 8 + f) + 1]; x[f] = half ? x[f] * cs + p[f] * sn : x[f] * cs - p[f] * sn; } }
#pragma unroll
        for (int j = 0; j < 8; ++j) x[j] *= QSCALE;
        *(GAS v4u*)(qb + ((size_t)(b * 8 + h) * TQK + tq) * 96 + d) = pack8(x);
        asm volatile("" ::: "memory");
    }
};
struct FKV {
    bf16* kb; bf16* vb;
    __device__ __forceinline__ void operator()(int row, int col, f32x4 v0, f32x4 v1) const {
        v4u w; w.x = pg8::cvt_pk_bf16(v0[0], v0[1]); w.y = pg8::cvt_pk_bf16(v0[2], v0[3]); w.z = pg8::cvt_pk_bf16(v1[0], v1[1]); w.w = pg8::cvt_pk_bf16(v1[2], v1[3]);
        const bool isctx = row >= TL; const int b = isctx ? ((row - TL) >> 8) : (row >> 13), t = isctx ? ((row - TL) & 255) : (row & 8191), tk = isctx ? t : CTXL + t;
        const int h = col >> 7, e = col & 127;
        if (e < 64) *(GAS v4u*)(kb + ((size_t)(b * 8 + h) * TQK + tk) * 96 + e) = w;
        else { const int kk = tk & 63, pos = (kk & 48) | (kk & 3) | ((kk & 4) << 1) | ((kk & 8) >> 1);
            bf16* p = vb + (((size_t)(b * 8 + h) * (TQK / 64) + (tk >> 6)) * 64 + (e - 64)) * 64 + pos;
            p[0] = (bf16)(w.x & 0xffffu); p[64] = (bf16)(w.x >> 16); p[128] = (bf16)(w.y & 0xffffu); p[192] = (bf16)(w.y >> 16);
            p[256] = (bf16)(w.z & 0xffffu); p[320] = (bf16)(w.z >> 16); p[384] = (bf16)(w.w & 0xffffu); p[448] = (bf16)(w.w >> 16); }
    }
};
struct EpiResid {
    static constexpr bool PERM = false, AFTER_DRAIN = false;
    float* xl; float* xc; const float* gate; int first; int row_off; float* slab; const float* rl = nullptr;
    __device__ __forceinline__ void operator()(const pg8::f32x4 (&acc)[2][2][4][2], const pg8::Unit& u, int wr, int wc, int fr, int fq) const {
        const int trow = u.pm * 256 + row_off, col0 = u.pn * 256 + wc * 32 + 4 * fq;
        if (slab) {
            GAS float* sb = (GAS float*)slab + (size_t)(trow - TL + wr * 64 + fr) * D + col0; const GAS float* gq = (const GAS float*)gate + (size_t)2 * 6144 + col0;
            f32x4 g2[2][2];
#pragma unroll
            for (int bj = 0; bj < 2; ++bj)
#pragma unroll
                for (int n = 0; n < 2; ++n) g2[bj][n] = *(const GAS f32x4*)(gq + bj * 128 + n * 16);
#pragma unroll
            for (int ai = 0; ai < 2; ++ai)
#pragma unroll
                for (int m = 0; m < 4; ++m)
#pragma unroll
                    for (int bj = 0; bj < 2; ++bj)
#pragma unroll
                        for (int n = 0; n < 2; ++n) *(GAS f32x4*)(sb + (size_t)(ai * 128 + m * 16) * D + bj * 128 + n * 16) = g2[bj][n] * acc[ai][bj][m][n];
            return;
        }
        const bool lat = trow < TL;
        GAS float* xb = (GAS float*)(lat ? xl + (size_t)trow * D : xc + (size_t)(trow - TL) * D) + (size_t)(wr * 64 + fr) * D + col0;
        const GAS float* rb = (lat && rl) ? (const GAS float*)rl + (size_t)trow * D + (size_t)(wr * 64 + fr) * D + col0 : (const GAS float*)xb;
        const GAS float* gp = (const GAS float*)gate + (size_t)modrow_of(trow) * 6144 + col0;
        f32x4 gv[2][2];
#pragma unroll
        for (int bj = 0; bj < 2; ++bj)
#pragma unroll
            for (int n = 0; n < 2; ++n) gv[bj][n] = *(const GAS f32x4*)(gp + bj * 128 + n * 16);
        const float a0 = (first && lat) ? DN_ALPHA : 1.0f;
#pragma unroll
        for (int ai = 0; ai < 2; ++ai) {
            f32x4 xo[4][2][2];
#pragma unroll
            for (int m = 0; m < 4; ++m)
#pragma unroll
                for (int bj = 0; bj < 2; ++bj)
#pragma unroll
                    for (int n = 0; n < 2; ++n) xo[m][bj][n] = *(const GAS f32x4*)(rb + (size_t)(ai * 128 + m * 16) * D + bj * 128 + n * 16);
#pragma unroll
            for (int m = 0; m < 4; ++m)
#pragma unroll
                for (int bj = 0; bj < 2; ++bj)
#pragma unroll
                    for (int n = 0; n < 2; ++n) *(GAS f32x4*)(xb + (size_t)(ai * 128 + m * 16) * D + bj * 128 + n * 16) = xo[m][bj][n] * a0 + gv[bj][n] * acc[ai][bj][m][n];
            __builtin_amdgcn_sched_barrier(0);
        }
    }
};
struct FHgIn {
    bf16* qffi; bf16* g;
    __device__ __forceinline__ void operator()(int row, int col, f32x4 v0, f32x4 v1) const {
        v4u w; w.x = pg8::cvt_pk_bf16(v0[0], v0[1]); w.y = pg8::cvt_pk_bf16(v0[2], v0[3]); w.z = pg8::cvt_pk_bf16(v1[0], v1[1]); w.w = pg8::cvt_pk_bf16(v1[2], v1[3]);
        if (col < 4096) *(GAS v4u*)(qffi + (size_t)row * 4096 + col) = w; else *(GAS v4u*)(g + (size_t)row * D + (col - 4096)) = w;
    }
};
struct EpiConvGate {
    static constexpr bool PERM = true, AFTER_DRAIN = false;
    bf16* hg; bf16* ab; bf16* gb; const bf16* cwt;
    __device__ __forceinline__ void operator()(const pg8::f32x4 (&acc)[2][2][4][2], const pg8::Unit& u, int wr, int wc, int fr, int fq) const {
        const int hc0 = 128 * u.pn + 32 * wc + 8 * fq;
        v4u wq[4];
#pragma unroll
        for (int i = 0; i < 4; ++i) wq[i] = *(const GAS v4u*)(cwt + (size_t)(hc0 + 2 * i) * 4);
#pragma unroll
        for (int ai = 0; ai < 2; ++ai) {
            const int rowbase = u.pm * 256 + 128 * ai + 64 * wr, g64 = rowbase >> 6;
#pragma unroll
            for (int n = 0; n < 2; ++n) {
                const int hc = hc0 + 4 * n;
                float out[4][4];
#pragma unroll
                for (int e = 0; e < 4; ++e) { const int c = 4 * n + e; const unsigned pw0 = (c & 1) ? wq[c >> 1].z : wq[c >> 1].x, pw1 = (c & 1) ? wq[c >> 1].w : wq[c >> 1].y;
                    const float w0 = bflo(pw0), w1 = bfhi(pw0), w2 = bflo(pw1), b0 = bfhi(pw1);
                    float a[4], up[4], dn[4];
#pragma unroll
                    for (int m = 0; m < 4; ++m) { a[m] = acc[ai][0][m][n][e];
                        up[m] = __builtin_bit_cast(float, __builtin_amdgcn_mov_dpp(__builtin_bit_cast(int, a[m]), 0x121, 0xf, 0xf, false));
                        dn[m] = __builtin_bit_cast(float, __builtin_amdgcn_mov_dpp(__builtin_bit_cast(int, a[m]), 0x12f, 0xf, 0xf, false)); }
#pragma unroll
                    for (int m = 0; m < 4; ++m) { const float prev = fr > 0 ? up[m] : (m > 0 ? up[m > 0 ? m - 1 : 0] : 0.f), next = fr < 15 ? dn[m] : (m < 3 ? dn[m < 3 ? m + 1 : 3] : 0.f);
                        const float cv = b0 + w0 * prev + w1 * a[m] + w2 * next; out[m][e] = siluf_(cv) * acc[ai][1][m][n][e]; } }
#pragma unroll
                for (int m = 0; m < 4; ++m) { const int r64 = 16 * m + fr, row = rowbase + r64;
                    if (r64 != 0 && r64 != 63) { v2u w; w.x = pk2(out[m][0], out[m][1]); w.y = pk2(out[m][2], out[m][3]); *(GAS v2u*)(hg + (size_t)row * FFH + hc) = w; }
                    if (r64 <= 1 || r64 >= 62) { const int slot = r64 <= 1 ? r64 : r64 - 60; const f32x4 ra = acc[ai][0][m][n];
                        v2u w; w.x = pk2(ra[0], ra[1]); w.y = pk2(ra[2], ra[3]); *(GAS v2u*)(ab + (size_t)(g64 * 4 + slot) * FFH + hc) = w;
                        if (r64 == 0 || r64 == 63) { const f32x4 rg = acc[ai][1][m][n]; v2u wg; wg.x = pk2(rg[0], rg[1]); wg.y = pk2(rg[2], rg[3]); *(GAS v2u*)(gb + (size_t)(g64 * 2 + (r64 == 63 ? 1 : 0)) * FFH + hc) = wg; } }
                }
                __builtin_amdgcn_sched_barrier(0);
            }
        }
    }
};
template <class E> __device__ __forceinline__ void run_gemm_off(Frame& F, const bf16* A, int lda, const bf16* Bt, int ldb, int M, int N, int K, const E& e, int boff) {
    pg8::Gemm g{A, Bt, M, N, K, lda, ldb}; pg8::StaticOrder S; S.init(M, N, F.G, (int)((blockIdx.x + F.G - boff) % F.G));
    pg8::gemm_phase<E, pg8::StaticOrder, true, true>(F.lds + RING_OFF, g, S, e);
}
template <class E> __device__ __forceinline__ void run_gemm(Frame& F, const bf16* A, int lda, const bf16* Bt, int ldb, int M, int N, int K, const E& e) {
    pg8::Gemm g{A, Bt, M, N, K, lda, ldb}; pg8::StaticOrder S; S.init(M, N, F.G, (int)blockIdx.x);
    pg8::gemm_phase<E, pg8::StaticOrder, true, true>(F.lds + RING_OFF, g, S, e);
}

constexpr int NPH = 26;
struct Args { const float* in[31]; float* out; unsigned char* ws; int ph_lo, ph_hi; };
__global__ void __launch_bounds__(NWAVES * 64, 2) mk_fwd(Args args) {
    extern __shared__ __attribute__((aligned(16))) unsigned char lds[];
    Frame F;
    F.lds = (LAS unsigned char*)lds;
    F.tid = threadIdx.x; F.lane = F.tid & 63; F.wave = __builtin_amdgcn_readfirstlane(F.tid >> 6);
    F.G = gridDim.x; { const int bx = blockIdx.x; F.vcu = (F.G % 8 == 0) ? (bx % 8) * (F.G / 8) + bx / 8 : bx; }
    for (int u = F.tid; u < (LDS_BYTES - LDSCTL_OFF) / 4; u += NWAVES * 64) ((LAS unsigned*)(F.lds + LDSCTL_OFF))[u] = 0u;
    __syncthreads();
    if (F.tid == 0) {
#pragma unroll
        for (int i = 0; i < 31; ++i) ((LAS unsigned long long*)(F.lds + PTR_OFF))[i] = (unsigned long long)args.in[i];
        ((LAS unsigned long long*)(F.lds + PTR_OFF))[31] = (unsigned long long)args.ws; ((LAS unsigned long long*)(F.lds + PTR_OFF))[32] = (unsigned long long)args.out;
    }
    __syncthreads();
    const int lo = args.ph_lo, hi = args.ph_hi;
    const bool multi = (hi - lo) > 1;
    if (multi) (void)xcd_barrier_post((unsigned*)ws_(F) + CW_BAR, (volatile LAS unsigned*)(F.lds + MISC_OFF) + 8);
#ifndef ONLY_PHASE
#define ONLY_PHASE -1
#endif
#define WSP ws_(F)
#define MODP ((const float*)(ws_(F) + WS_MOD))
#define ABUF ((bf16*)(ws_(F) + WS_A))
#ifndef SKIP_PHASE
#define SKIP_PHASE -1
#endif
#define IN(k) ((ONLY_PHASE < 0 || ONLY_PHASE == (k)) && SKIP_PHASE != (k) && lo <= (k) && (k) < hi)
#define SEAM(k) do { if (IN(k) && IN((k) + 1)) { XcdBarrier bar_; bar_.bar = (unsigned*)ws_(F) + CW_BAR; bar_.x = xb_xcc_id(); bar_.st = (volatile LAS unsigned*)(F.lds + MISC_OFF) + 8; xcd_barrier(bar_); } asm volatile("" : "+v"(F.tid), "+v"(F.lane)); } while (0)
    int pk = 0;
#ifndef REPEAT_PHASE
#define REPEAT_PHASE -1
#endif
#define PHASE(...) do { if (IN(pk)) { __VA_ARGS__ } if (REPEAT_PHASE == pk && IN(pk)) { { XcdBarrier bar_; bar_.bar = (unsigned*)ws_(F) + CW_BAR; bar_.x = xb_xcc_id(); bar_.st = (volatile LAS unsigned*)(F.lds + MISC_OFF) + 8; xcd_barrier(bar_); } asm volatile("" : "+v"(F.tid), "+v"(F.lane)); { __VA_ARGS__ } } SEAM(pk); ++pk; } while (0)
    PHASE( p0_prologue(F); for (int rep_ = 0; rep_ < DUP_S5T; ++rep_) p0_s5_tables(F); );
    PHASE( ph_init_rows(F); );
    PHASE( pg8::Epi8<FInProj> e{{(bf16*)(WSP + WS_CQKV), (bf16*)(WSP + WS_UG)}}; run_gemm(F, ABUF, D, (const bf16*)(WSP + WS_WIN0), D, TT, EVEN_IN_PAD, D, e); );
    PHASE( ph_s5_finals(F); );
    PHASE( ph_s5_carry(F); );
    PHASE( ph_mla_norm(F); );
    PHASE(
#ifndef DUPQ
#define DUPQ 1
#endif
#ifndef DUPKV
#define DUPKV 1
#endif
        _Pragma("unroll") for (int rep = 0; rep < DUPQ; ++rep) { pg8::Epi8<FQ> e{{(bf16*)(WSP + WS_QB), (const float*)(WSP + WS_ROPE)}}; run_gemm(F, (const bf16*)(WSP + WS_CQKV), CQKV_LD, (const bf16*)(WSP + WS_WUQ), 384, TT, 768, 384, e); }
        _Pragma("unroll") for (int rep = 0; rep < DUPKV; ++rep) { pg8::Epi8<FKV> e{{(bf16*)(WSP + WS_KB), (bf16*)(WSP + WS_VB)}}; run_gemm(F, (const bf16*)(WSP + WS_CQKV) + 384, CQKV_LD, (const bf16*)(WSP + WS_WUKV), 256, TT, 1024, 256, e); }
    );
    PHASE( ph_s5_out(F); );
    PHASE( ph_attn(F); );
    PHASE( EpiGlu e{(const bf16*)(WSP + WS_Z), (bf16*)(WSP + WS_MIX)}; run_gemm(F, (const bf16*)(WSP + WS_Z), 512, (const bf16*)(WSP + WS_WGLU), 512, TT, 512, 512, e); );
    PHASE(
        { EpiResid e{out_(F), (float*)(WSP + WS_XC), MODP + 0 * 3 * 6144 + 2 * 1024, 1, 0, nullptr, inp(F, 0)}; run_gemm(F, (const bf16*)(WSP + WS_MIX), D, (const bf16*)(WSP + WS_WOUT0), D, TL, D, D, e); }
        _Pragma("unroll") for (int sp = 0; sp < 4; ++sp) { EpiResid e{out_(F), (float*)(WSP + WS_XC), MODP + 0 * 3 * 6144 + 2 * 1024, 1, TL, (float*)(WSP + WS_SLAB1) + (size_t)sp * TC * D};
            run_gemm_off(F, (const bf16*)(WSP + WS_MIX) + (size_t)TL * D + 256 * sp, D, (const bf16*)(WSP + WS_WOUT0) + 256 * sp, D, TC, D, 256, e, 8 * sp); }
    );
    PHASE( ph_layernorm(F, TT, 0, 0, 0, 3, (const float*)(WSP + WS_SLAB1), 4); );
    PHASE( EpiConvGate e{(bf16*)(WSP + WS_HG), (bf16*)(WSP + WS_AB), (bf16*)(WSP + WS_GB), (const bf16*)(WSP + WS_CWT)}; run_gemm(F, ABUF, D, (const bf16*)(WSP + WS_F1T0), D, TT, 2 * FFH, D, e); );
    PHASE( ph_convfix(F, TT, 0); );
    PHASE(
        { EpiResid e{out_(F), (float*)(WSP + WS_XC), MODP + 0 * 3 * 6144 + 5 * 1024, 1, 0, nullptr}; run_gemm(F, (const bf16*)(WSP + WS_HG), FFH, (const bf16*)(WSP + WS_F2T0), FFH, TL, D, FFH, e); }
        _Pragma("unroll") for (int sp = 0; sp < 6; ++sp) { EpiResid e{out_(F), (float*)(WSP + WS_XC), MODP + 0 * 3 * 6144 + 5 * 1024, 1, TL, (float*)(WSP + WS_SLAB2) + (size_t)sp * TC * D};
            run_gemm_off(F, (const bf16*)(WSP + WS_HG) + (size_t)TL * FFH + 512 * sp, FFH, (const bf16*)(WSP + WS_F2T0) + 512 * sp, FFH, TC, D, sp == 5 ? 256 : 512, e, 8 * sp); }
    );
    PHASE( ph_layernorm(F, TT, 0, 1, 1, 0, (const float*)(WSP + WS_SLAB2), 6); );
    PHASE( pg8::Epi8<FHgIn> e{{(bf16*)(WSP + WS_QFFI), (bf16*)(WSP + WS_G)}}; run_gemm(F, ABUF, D, (const bf16*)(WSP + WS_HGINT), D, TT, 5120, D, e); );
    PHASE( ph_hgrn_states(F); );
    PHASE( ph_hgrn_carry(F); );
    PHASE( ph_hgrn_out(F); );
    PHASE( EpiResid e{out_(F), (float*)(WSP + WS_XC), MODP + 1 * 3 * 6144 + 2 * 1024, 1, 0, nullptr}; run_gemm(F, (const bf16*)(WSP + WS_O), D, (const bf16*)(WSP + WS_HGOUTT), D, TL, D, D, e); );
    PHASE( ph_layernorm(F, TL, 1, 0, 1, 3); );
    PHASE( EpiConvGate e{(bf16*)(WSP + WS_HG), (bf16*)(WSP + WS_AB), (bf16*)(WSP + WS_GB), (const bf16*)(WSP + WS_CWT) + (size_t)FFH * 4}; run_gemm(F, ABUF, D, (const bf16*)(WSP + WS_F1T1), D, TL, 2 * FFH, D, e); );
    PHASE( ph_convfix(F, TL, 1); );
    PHASE( EpiResid e{out_(F), (float*)(WSP + WS_XC), MODP + 1 * 3 * 6144 + 5 * 1024, 1, 0, nullptr}; run_gemm(F, (const bf16*)(WSP + WS_HG), FFH, (const bf16*)(WSP + WS_F2T1), FFH, TL, D, FFH, e); );
    PHASE( ph_layernorm(F, TL, 1, 1, -1, 0); );
#undef PHASE
#undef IN
#undef SEAM
}

extern "C" void kernel_launch(void* const* d_in, const int* in_sizes, int n_in, void* d_out, int out_size, void* d_ws, size_t ws_size, hipStream_t stream) {
    static int grid = 0;
    if (grid == 0) {
        if (n_in != 31 || out_size != TL * D || ws_size < WS_END) { fprintf(stderr, "kernel_launch: unexpected shapes n_in %d out %d ws %zu\n", n_in, out_size, ws_size); grid = -1; return; }
        int dev = 0, cus = 0;
        if (hipGetDevice(&dev) != hipSuccess || hipDeviceGetAttribute(&cus, hipDeviceAttributeMultiprocessorCount, dev) != hipSuccess) { grid = -1; return; }
        if (hipFuncSetAttribute((const void*)mk_fwd, hipFuncAttributeMaxDynamicSharedMemorySize, LDS_BYTES) != hipSuccess) { fprintf(stderr, "kernel_launch: hipFuncSetAttribute failed\n"); grid = -1; return; }
        int per_cu = 0;
        if (hipOccupancyMaxActiveBlocksPerMultiprocessor(&per_cu, (const void*)mk_fwd, NWAVES * 64, LDS_BYTES) != hipSuccess || per_cu < 1) fprintf(stderr, "kernel_launch: occupancy query says %d\n", per_cu);
        (void)hipGetLastError();
        grid = cus;
    }
    if (grid < 0) return;
    if (hipMemsetAsync((char*)d_ws + WS_CTL, 0, CTL_ZERO_BYTES, stream) != hipSuccess) return;
    Args a{};
    for (int i = 0; i < 31; ++i) a.in[i] = (const float*)d_in[i];
    a.out = (float*)d_out; a.ws = (unsigned char*)d_ws;
#ifndef MK_ONE_LAUNCH
#define MK_ONE_LAUNCH 1
#endif
    if (MK_ONE_LAUNCH) { a.ph_lo = 0; a.ph_hi = NPH; hipLaunchKernelGGL(mk_fwd, dim3(grid), dim3(NWAVES * 64), LDS_BYTES, stream, a); }
    else for (int p = 0; p < NPH; ++p) { a.ph_lo = p; a.ph_hi = p + 1; hipLaunchKernelGGL(mk_fwd, dim3(grid), dim3(NWAVES * 64), LDS_BYTES, stream, a); }
}
```

```cpp
#include <hip/hip_runtime.h>
#include <cstdio>
#include <cstdint>
#include <cmath>
namespace pg8 {
#define PG8_LAS __attribute__((address_space(3)))
typedef unsigned short bf16_t;
typedef short bf16x8 __attribute__((ext_vector_type(8)));
typedef float f32x4 __attribute__((ext_vector_type(4)));
typedef unsigned u32x4 __attribute__((ext_vector_type(4)));
constexpr int BM = 256, BK = 64, HALF = 128, HTB = HALF * BK * 2  , STAGE_BYTES = 8 * HTB, NXCD = 8, WGM = 8;

__host__ __device__ __forceinline__ int lds_byte(int r, int c) { const int st = (r >> 4) * 2 + (c >> 5), rr = r & 15, cc = c & 31, ob = rr * 64 + cc * 2; return st * 1024 + (ob ^ (((ob >> 9) & 1) << 5)); }
__host__ __device__ __forceinline__ void stage_rc(int b, int& R, int& C) { const int st = b / 1024, sb = b % 1024, swz = sb ^ (((sb >> 9) & 1) << 5); R = (st >> 1) * 16 + swz / 64; C = (st & 1) * 32 + (swz % 64) / 2; }
__host__ __device__ __forceinline__ int perm32(int rho) { const int n = rho >> 4, i = rho & 15; return 8 * (i >> 2) + 4 * n + (i & 3); }

struct Unit { int pm, pn; };
struct Gemm { const bf16_t* A; const bf16_t* Bt; int M, N, K, lda, ldb; };

struct StaticOrder {
    int nM, nN, nwg, G, c;
    __host__ __device__ void init(int M, int N, int G_, int c_) { nM = M / BM; nN = N / BM; nwg = nM * nN; G = G_; c = c_; }
    __host__ __device__ bool next(int i, Unit& u) const {
        const long L = (long)i * G + c; if (L >= nwg) return false;
        int wgid = (int)L; { const int q = nwg / NXCD, r = nwg % NXCD, xcd = wgid % NXCD, off = wgid / NXCD; wgid = (xcd < r ? xcd * (q + 1) : r * (q + 1) + (xcd - r) * q) + off; }
        const int nig = WGM * nN, gid = wgid / nig, fm = gid * WGM, gsz = (nM - fm) < WGM ? (nM - fm) : WGM;
        u.pm = fm + ((wgid % nig) % gsz); u.pn = (wgid % nig) / gsz; return true;
    }
    __device__ __forceinline__ void a_ready(const Unit&) const {}
    __device__ __forceinline__ void done(const Unit&) const {}
};

__device__ __forceinline__ unsigned cvt_pk_bf16(float lo, float hi) { unsigned r; asm volatile("v_cvt_pk_bf16_f32 %0, %1, %2" : "=v"(r) : "v"(lo), "v"(hi)); return r; }
template <class F> struct Epi8 {
    static constexpr bool PERM = true, AFTER_DRAIN = false; F f;
    __device__ __forceinline__ void operator()(const f32x4 (&acc)[2][2][4][2], const Unit& u, int wr, int wc, int fr, int fq) const {
        const int row0 = u.pm * BM + wr * 64 + fr, col0 = u.pn * BM + wc * 32 + 8 * fq;
#pragma unroll
        for (int ai = 0; ai < 2; ++ai)
#pragma unroll
            for (int m = 0; m < 4; ++m)
#pragma unroll
                for (int bj = 0; bj < 2; ++bj) { f(row0 + ai * HALF + m * 16, col0 + bj * HALF, acc[ai][bj][m][0], acc[ai][bj][m][1]); }
    }
};
template <class F> struct Epi4 {
    static constexpr bool PERM = false, AFTER_DRAIN = false; F f;
    __device__ __forceinline__ void operator()(const f32x4 (&acc)[2][2][4][2], const Unit& u, int wr, int wc, int fr, int fq) const {
        const int row0 = u.pm * BM + wr * 64 + fr, col0 = u.pn * BM + wc * 32 + 4 * fq;
#pragma unroll
        for (int ai = 0; ai < 2; ++ai)
#pragma unroll
            for (int m = 0; m < 4; ++m)
#pragma unroll
                for (int bj = 0; bj < 2; ++bj)
#pragma unroll
                    for (int n = 0; n < 2; ++n) { f(row0 + ai * HALF + m * 16, col0 + bj * HALF + n * 16, acc[ai][bj][m][n]); }
    }
};
template <class Epi, class Sched, bool ALIGN_EPI = false, bool SP2 = false>
__device__ __forceinline__ void gemm_phase(PG8_LAS unsigned char* lds, const Gemm g, const Sched& S, const Epi& E) {
    int tid_ = threadIdx.x; asm volatile("" : "+v"(tid_));
    const int tid = tid_, wid = __builtin_amdgcn_readfirstlane(tid >> 6), lane = tid & 63, wr = wid >> 2, wc = wid & 3, fr = lane & 15, fq = lane >> 4;
    const int K = g.K, nt = K / BK;
    unsigned voffA[2], voffB[2];
#pragma unroll
    for (int i = 0; i < 2; ++i) { int R, C; stage_rc(tid * 16 + i * 8192, R, C); const int Rb = Epi::PERM ? ((R & ~31) + perm32(R & 31)) : R;
        voffA[i] = (unsigned)(R * g.lda + C) * 2u; voffB[i] = (unsigned)(Rb * g.ldb + C) * 2u; }
    const size_t kstep = (size_t)(BK * 2);
    const size_t hstepA = (size_t)HALF * g.lda * 2, hstepB = (size_t)HALF * g.ldb * 2;
    const size_t tstepA = 2 * hstepA, tstepB = 2 * hstepB;
    const unsigned ldsw = (unsigned)wid * 1024u;
    const int aoff = lds_byte(wr * 64 + fr, fq * 8), boff = lds_byte(wc * 32 + fr, fq * 8);
#define PG8_SA(b, h) (((b) * 2 + (h)) * HTB)
#define PG8_SB(b, h) ((4 + (b) * 2 + (h)) * HTB)
#define PG8_STAGE(bufoff, gbase, voff) do { _Pragma("unroll") for (int _i = 0; _i < 2; ++_i) \
        __builtin_amdgcn_global_load_lds((const unsigned*)((const char*)(gbase) + (voff)[_i]), (PG8_LAS unsigned*)(lds + (bufoff) + ldsw + _i * 8192), 16, 0, 0); } while (0)
#define PG8_LDA(dst, b, h) do { _Pragma("unroll") for (int m = 0; m < 4; ++m) _Pragma("unroll") for (int k = 0; k < 2; ++k) dst[m][k] = *(const PG8_LAS bf16x8*)(lds + PG8_SA(b, h) + aoff + m * 2048 + k * 1024); } while (0)
#define PG8_LDB(dst, b, h) do { _Pragma("unroll") for (int n = 0; n < 2; ++n) _Pragma("unroll") for (int k = 0; k < 2; ++k) dst[n][k] = *(const PG8_LAS bf16x8*)(lds + PG8_SB(b, h) + boff + n * 2048 + k * 1024); } while (0)
#define PG8_MMA(ai, bj, At, Bt) do { __builtin_amdgcn_s_setprio(1); _Pragma("unroll") for (int m = 0; m < 4; ++m) _Pragma("unroll") for (int n = 0; n < 2; ++n) _Pragma("unroll") for (int k = 0; k < 2; ++k) \
        acc[ai][bj][m][n] = __builtin_amdgcn_mfma_f32_16x16x32_bf16(Bt[n][k], At[m][k], acc[ai][bj][m][n], 0, 0, 0); __builtin_amdgcn_s_setprio(0); } while (0)
#define PG8_WAIT_V(n) asm volatile("s_waitcnt vmcnt(" #n ")" ::: "memory")
#define PG8_WAIT_L(n) asm volatile("s_waitcnt lgkmcnt(" #n ")" ::: "memory")
#define PG8_BAR __builtin_amdgcn_s_barrier()
#define PG8_SCHED __builtin_amdgcn_sched_barrier(0)
    Unit cur, nxt; int ui = 0;
    if (!S.next(0, cur)) return;
    f32x4 acc[2][2][4][2];
#pragma unroll
    for (int a = 0; a < 2; ++a)
#pragma unroll
        for (int b = 0; b < 2; ++b)
#pragma unroll
            for (int m = 0; m < 4; ++m)
#pragma unroll
                for (int n = 0; n < 2; ++n) acc[a][b][m][n] = (f32x4){0.f, 0.f, 0.f, 0.f};
    bf16x8 At[4][2], B0[2][2], B1[2][2];
    const char* cA = (const char*)g.A + (size_t)cur.pm * tstepA; const char* cB = (const char*)g.Bt + (size_t)cur.pn * tstepB;
    S.a_ready(cur);
    if constexpr (SP2) {
        PG8_STAGE(PG8_SB(0, 0), cB, voffB); PG8_STAGE(PG8_SB(0, 1), cB + hstepB, voffB); PG8_STAGE(PG8_SA(0, 0), cA, voffA); PG8_STAGE(PG8_SA(0, 1), cA + hstepA, voffA);
        if (wr == 1) PG8_BAR;
        PG8_WAIT_V(2); PG8_BAR;
        PG8_STAGE(PG8_SB(1, 0), cB + kstep, voffB); PG8_STAGE(PG8_SA(1, 0), cA + kstep, voffA); PG8_STAGE(PG8_SB(1, 1), cB + hstepB + kstep, voffB);
        PG8_WAIT_V(6); PG8_BAR;
    } else {
        PG8_STAGE(PG8_SB(0, 0), cB, voffB); PG8_STAGE(PG8_SA(0, 0), cA, voffA); PG8_STAGE(PG8_SB(0, 1), cB + hstepB, voffB); PG8_STAGE(PG8_SA(0, 1), cA + hstepA, voffA);
        if (wr == 1) PG8_BAR;
        PG8_WAIT_V(4); PG8_BAR;
        PG8_STAGE(PG8_SB(1, 0), cB + kstep, voffB); PG8_STAGE(PG8_SA(1, 0), cA + kstep, voffA); PG8_STAGE(PG8_SB(1, 1), cB + hstepB + kstep, voffB);
        PG8_WAIT_V(6); PG8_BAR;
    }
    for (;;) {
        const bool has_next = S.next(ui + 1, nxt);
        const char* nA = has_next ? (const char*)g.A + (size_t)nxt.pm * tstepA : cA; const char* nB = has_next ? (const char*)g.Bt + (size_t)nxt.pn * tstepB : cB;
#pragma unroll 1
        for (int t = 0; t < nt; t += 2) {
            const bool last = (t == nt - 2);
            const char* a1 = cA + (size_t)(t + 1) * kstep;
            const char* a2 = last ? nA : cA + (size_t)(t + 2) * kstep; const char* b2 = last ? nB : cB + (size_t)(t + 2) * kstep;
            const char* a3 = a2 + kstep; const char* b3 = b2 + kstep;
            if (last && has_next) S.a_ready(nxt);
            if constexpr (SP2) {
            PG8_LDB(B0, 0, 0); PG8_LDB(B1, 0, 1); PG8_SCHED; PG8_LDA(At, 0, 0); PG8_STAGE(PG8_SA(1, 1), a1 + hstepA, voffA);
            PG8_WAIT_V(8); PG8_WAIT_L(0); PG8_BAR; PG8_MMA(0, 0, At, B0); PG8_MMA(0, 1, At, B1); PG8_BAR; PG8_SCHED;
            PG8_LDA(At, 0, 1); PG8_STAGE(PG8_SB(0, 0), b2, voffB); PG8_STAGE(PG8_SB(0, 1), b2 + hstepB, voffB); PG8_STAGE(PG8_SA(0, 0), a2, voffA);
            PG8_WAIT_V(8); PG8_WAIT_L(0); PG8_BAR; PG8_MMA(1, 0, At, B0); PG8_MMA(1, 1, At, B1); PG8_BAR; PG8_SCHED;
            PG8_LDB(B0, 1, 0); PG8_LDB(B1, 1, 1); PG8_SCHED; PG8_LDA(At, 1, 0); PG8_STAGE(PG8_SA(0, 1), a2 + hstepA, voffA);
            PG8_WAIT_V(8); PG8_WAIT_L(0); PG8_BAR; PG8_MMA(0, 0, At, B0); PG8_MMA(0, 1, At, B1); PG8_BAR; PG8_SCHED;
            PG8_LDA(At, 1, 1); PG8_STAGE(PG8_SB(1, 0), b3, voffB); PG8_STAGE(PG8_SB(1, 1), b3 + hstepB, voffB); PG8_STAGE(PG8_SA(1, 0), a3, voffA);
            PG8_WAIT_V(8); PG8_WAIT_L(0); PG8_BAR; PG8_MMA(1, 0, At, B0); PG8_MMA(1, 1, At, B1); PG8_BAR; PG8_SCHED;
            } else {
            PG8_LDB(B0, 0, 0); PG8_SCHED; PG8_LDA(At, 0, 0); PG8_STAGE(PG8_SA(1, 1), a1 + hstepA, voffA);
            PG8_WAIT_L(8); PG8_BAR; PG8_WAIT_L(0); PG8_MMA(0, 0, At, B0); PG8_BAR; PG8_SCHED;
            PG8_LDB(B1, 0, 1); PG8_STAGE(PG8_SB(0, 0), b2, voffB);
            PG8_BAR; PG8_WAIT_L(0); PG8_MMA(0, 1, At, B1); PG8_BAR;
            PG8_LDA(At, 0, 1); PG8_STAGE(PG8_SA(0, 0), a2, voffA);
            PG8_BAR; PG8_WAIT_L(0); PG8_MMA(1, 0, At, B0); PG8_BAR; PG8_SCHED;
            PG8_STAGE(PG8_SB(0, 1), b2 + hstepB, voffB);
            PG8_WAIT_V(6); PG8_BAR; PG8_MMA(1, 1, At, B1); PG8_BAR;
            PG8_LDB(B0, 1, 0); PG8_SCHED; PG8_LDA(At, 1, 0); PG8_STAGE(PG8_SA(0, 1), a2 + hstepA, voffA);
            PG8_WAIT_L(8); PG8_BAR; PG8_WAIT_L(0); PG8_MMA(0, 0, At, B0); PG8_BAR; PG8_SCHED;
            PG8_LDB(B1, 1, 1); PG8_STAGE(PG8_SB(1, 0), b3, voffB);
            PG8_BAR; PG8_WAIT_L(0); PG8_MMA(0, 1, At, B1); PG8_BAR;
            PG8_LDA(At, 1, 1); PG8_STAGE(PG8_SA(1, 0), a3, voffA);
            PG8_BAR; PG8_WAIT_L(0); PG8_MMA(1, 0, At, B0); PG8_BAR; PG8_SCHED;
            PG8_STAGE(PG8_SB(1, 1), b3 + hstepB, voffB);
            PG8_WAIT_V(6); PG8_BAR; PG8_MMA(1, 1, At, B1); PG8_BAR;
            }
        }
        if constexpr (ALIGN_EPI) { if (wr == 0) PG8_BAR; }
        if constexpr (!Epi::AFTER_DRAIN) { E(acc, cur, wr, wc, fr, fq); S.done(cur); }
        if (!has_next) break;
#pragma unroll
        for (int a = 0; a < 2; ++a)
#pragma unroll
            for (int b = 0; b < 2; ++b)
#pragma unroll
                for (int m = 0; m < 4; ++m)
#pragma unroll
                    for (int n = 0; n < 2; ++n) acc[a][b][m][n] = (f32x4){0.f, 0.f, 0.f, 0.f};
        cur = nxt; cA = nA; cB = nB; ++ui;
        if constexpr (ALIGN_EPI) { if (wr == 1) PG8_BAR; }
    }
    PG8_WAIT_V(0);
    if constexpr (!ALIGN_EPI) { if (wr == 0) PG8_BAR; }
    PG8_BAR;
    if constexpr (Epi::AFTER_DRAIN) { E.fused(acc, cur, wr, wc, fr, fq, lds, wid, lane); S.done(cur); }
#undef PG8_SA
#undef PG8_SB
#undef PG8_STAGE
#undef PG8_LDA
#undef PG8_LDB
#undef PG8_MMA
#undef PG8_WAIT_V
#undef PG8_WAIT_L
#undef PG8_BAR
#undef PG8_SCHED
}
}

constexpr int NWAVES = 8;
constexpr int D = 1024, BATCH = 2, SEQ = 8192, CTXL = 256;
constexpr int TL = BATCH * SEQ;
constexpr int TC = BATCH * CTXL;
constexpr int TT = TL + TC;
constexpr int EVEN_IN = 1184, EVEN_IN_PAD = 1280, CQKV_LD = 672;
constexpr int FFH = 2816, FFG = 1408;
constexpr int TQK = SEQ + CTXL;
constexpr float NORM_EPS = 1e-6f;
constexpr float DN_ALPHA = 1.41421356237f;
constexpr float QSCALE = 0.10206207261596577f * 1.4426950408889634f;

constexpr size_t MiB = 1u << 20;
constexpr size_t WS_CTL = 0, CTL_ZERO_BYTES = 1 * MiB;
constexpr size_t WS_MOD = 1 * MiB;
constexpr size_t WS_LBV = WS_MOD + 160 * 1024;
constexpr size_t WS_ROPE = WS_LBV + 16 * 1024;
constexpr size_t WS_CWT = WS_ROPE + 16 * 1024;
constexpr size_t WS_HGINT = 2 * MiB, WS_HGOUTT = 12 * MiB, WS_F1T1 = 14 * MiB, WS_F2T1 = 25 * MiB;
constexpr size_t WS_A = 31 * MiB;
constexpr size_t WS_XC = 64 * MiB;
constexpr size_t WS_WIN0 = 66 * MiB, WS_WUQ = WS_WIN0 + 2560 * 1024, WS_WUKV = WS_WUQ + 768 * 1024, WS_WGLU = WS_WUKV + 512 * 1024,
                 WS_WOUT0 = WS_WGLU + 512 * 1024, WS_F1T0 = 72 * MiB + 512 * 1024, WS_F2T0 = WS_F1T0 + 11 * MiB;
constexpr size_t WS_R = 89 * MiB;
constexpr size_t WS_CQKV = WS_R;
constexpr size_t WS_UG = WS_R + 22 * MiB;
constexpr size_t WS_WF = WS_R + 39 * MiB;
constexpr size_t WS_WC = WS_R + 64 * MiB;
constexpr size_t WS_TOEP = WS_R + 80 * MiB;
constexpr size_t WS_T0 = WS_R + 82 * MiB;
constexpr size_t WS_A64 = WS_T0 + 128 * 1024;
constexpr size_t WS_FIN = WS_R + 83 * MiB;
constexpr size_t WS_SIN = WS_R + 92 * MiB;
constexpr size_t WS_Z = WS_R + 97 * MiB;
constexpr size_t WS_MIX = WS_R + 134 * MiB;
constexpr size_t WS_QB = WS_R + 39 * MiB;
constexpr size_t WS_KB = 31 * MiB;
constexpr size_t WS_VB = WS_R + 114 * MiB;
constexpr size_t WS_AB = WS_R;
constexpr size_t WS_GB = WS_R + 8 * MiB;
constexpr size_t WS_H = WS_R;
constexpr size_t WS_HG = WS_R + 16 * MiB;
constexpr size_t WS_QFFI = 66 * MiB;
constexpr size_t WS_G = 198 * MiB;
constexpr size_t WS_O = WS_A;
constexpr size_t WS_SLAB1 = WS_R;
constexpr size_t WS_SLAB2 = WS_R + 110 * MiB;
constexpr size_t WS_END = 256 * MiB;
static_assert(WS_F2T0 + 5632 * 1024 <= WS_R, "layer-0 weights");
static_assert(WS_MIX + (size_t)TT * 1024 * 2 <= WS_END && WS_G + (size_t)TT * 1024 * 2 <= WS_END && WS_HG + (size_t)TT * FFH * 2 <= WS_END, "ws map");
static_assert(WS_WF + 16 * MiB <= WS_WC && WS_QB + (size_t)16 * TQK * 96 * 2 <= WS_WC && WS_WC + 16 * MiB <= WS_TOEP && WS_TOEP + 2 * MiB <= WS_T0 && WS_T0 + MiB <= WS_FIN && WS_FIN + (size_t)32 * 264 * 256 * 4 <= WS_SIN && WS_SIN + (size_t)32 * 264 * 256 * 2 <= WS_Z && WS_Z + (size_t)TT * 512 * 2 <= WS_VB && WS_VB + (size_t)16 * TQK * 64 * 2 <= WS_MIX && WS_KB + (size_t)16 * TQK * 96 * 2 <= WS_XC, "ws map 2");

constexpr int CW_BAR = 4096;
constexpr int RING_OFF = 0, RING_BYTES = 131072;
constexpr int LDSCTL_OFF = RING_BYTES, MISC_OFF = LDSCTL_OFF + 320;
constexpr int LDS_BYTES = 147456;

#define GAS __attribute__((address_space(1)))
#define LAS __attribute__((address_space(3)))
typedef unsigned short bf16;
typedef unsigned v4u __attribute__((ext_vector_type(4)));
typedef unsigned v2u __attribute__((ext_vector_type(2)));
typedef float f32x4 __attribute__((ext_vector_type(4)));
typedef GAS unsigned gu32;
#define RLX_AGENT __ATOMIC_RELAXED, __HIP_MEMORY_SCOPE_AGENT
#define LDS_WAIT() asm volatile("s_waitcnt lgkmcnt(0)" ::: "memory")
__device__ __forceinline__ unsigned f2bf(float f) { unsigned u = __builtin_bit_cast(unsigned, f); return (u + 0x7fffu + ((u >> 16) & 1u)) >> 16; }
__device__ __forceinline__ unsigned pk2(float lo, float hi) { return f2bf(lo) | (f2bf(hi) << 16); }
__device__ __forceinline__ float bflo(unsigned w) { return __builtin_bit_cast(float, w << 16); }
__device__ __forceinline__ float bfhi(unsigned w) { return __builtin_bit_cast(float, w & 0xffff0000u); }
__device__ __forceinline__ float bf2f(bf16 h) { return __builtin_bit_cast(float, (unsigned)h << 16); }
__device__ __forceinline__ void unpack8(v4u w, float* x) { x[0] = bflo(w.x); x[1] = bfhi(w.x); x[2] = bflo(w.y); x[3] = bfhi(w.y); x[4] = bflo(w.z); x[5] = bfhi(w.z); x[6] = bflo(w.w); x[7] = bfhi(w.w); }
__device__ __forceinline__ v4u pack8(const float* x) { v4u w; w.x = pk2(x[0], x[1]); w.y = pk2(x[2], x[3]); w.z = pk2(x[4], x[5]); w.w = pk2(x[6], x[7]); return w; }
__device__ __forceinline__ float sigmoidf_(float x) { return 1.0f / (1.0f + __expf(-x)); }
__device__ __forceinline__ float siluf_(float x) { return x / (1.0f + __expf(-x)); }
__device__ __forceinline__ float gelu_tanh(float x) { const float u = 0.7978845608028654f * (x + 0.044715f * x * x * x); return 0.5f * x * (1.0f + tanhf(u)); }
__device__ __forceinline__ float wave_sum(float v) {
#pragma unroll
    for (int o = 1; o < 64; o <<= 1) v += __shfl_xor(v, o);
    return v;
}

#define XB_TMO      128
#define XB_XCNT(j)  (256  + 64 * (j))
#define XB_XSUB(j)  (1280 + 64 * (j))
#define XB_XGEN(j)  (2304 + 64 * (j))
#define XB_TOP      3328
#define XB_TOPGEN   3392
#define XCD_BAR_WORDS 3456
#define XB_SPIN_CAP (1u << 18)

__device__ __forceinline__ unsigned xb_ld(unsigned* p)              { return __hip_atomic_load(p, __ATOMIC_RELAXED, __HIP_MEMORY_SCOPE_AGENT); }
__device__ __forceinline__ unsigned xb_add(unsigned* p, unsigned v) { return __hip_atomic_fetch_add(p, v, __ATOMIC_RELAXED, __HIP_MEMORY_SCOPE_AGENT); }
__device__ __forceinline__ unsigned xb_xcc_id() { return (unsigned)__builtin_amdgcn_s_getreg((3 << 11) | 20) & 0xFu; }
#define XB_SPIN(cond, bar) do { unsigned _sp = 0; while (cond) { __builtin_amdgcn_s_sleep(1); \
    if ((++_sp & 255u) == 0u) { if (xb_ld(&(bar)[XB_TMO])) break; if (_sp > XB_SPIN_CAP) { atomicAdd(&(bar)[XB_TMO], 1u); break; } } } } while (0)

struct XcdBarrier {
    unsigned* bar; unsigned x;
    volatile LAS unsigned* st;
};

__device__ __forceinline__ XcdBarrier xcd_barrier_post(unsigned* bar, volatile LAS unsigned* st) {
    XcdBarrier b; b.bar = bar; b.x = xb_xcc_id(); b.st = st;
    if (threadIdx.x == 0) (void)xb_add(&bar[XB_XCNT(b.x)], 1u);
    return b;
}
__device__ __forceinline__ void xcd_barrier_complete(unsigned* bar, unsigned x, unsigned& nloc, unsigned& nx) {
    const unsigned G = gridDim.x * gridDim.y * gridDim.z;
    unsigned sum, cnt, mine, sp = 0u;
    for (;;) {
        sum = 0u; cnt = 0u; mine = 0u;
#pragma unroll
        for (unsigned j = 0; j < 16; ++j) { const unsigned c = xb_ld(&bar[XB_XCNT(j)]); sum += c; cnt += (c > 0u) ? 1u : 0u; mine = (j == x) ? c : mine; }
        if (sum == G) break;
        __builtin_amdgcn_s_sleep(1);
        if ((++sp & 255u) == 0u) { if (xb_ld(&bar[XB_TMO])) break; if (sp > XB_SPIN_CAP) { atomicAdd(&bar[XB_TMO], 1u); break; } }
    }
    nloc = mine > 0u ? mine : 1u; nx = cnt > 0u ? cnt : 1u;
}

__device__ __forceinline__ void xcd_barrier(const XcdBarrier& b) {
    asm volatile("s_waitcnt vmcnt(0)" ::: "memory");
    __syncthreads();
    if (threadIdx.x == 0) {
        unsigned* bar = b.bar;
        __builtin_amdgcn_s_waitcnt(0);
        unsigned nloc = b.st[0], nx = b.st[1];
        if (nloc == 0u) { xcd_barrier_complete(bar, b.x, nloc, nx); b.st[0] = nloc; b.st[1] = nx; }
        const unsigned old = xb_add(&bar[XB_XSUB(b.x)], 1u);
        const unsigned gen = old / nloc;
        if (old + 1u == (gen + 1u) * nloc) {
            __builtin_amdgcn_fence(__ATOMIC_RELEASE, "agent");
            asm volatile("s_waitcnt vmcnt(0)" ::: "memory");
            const unsigned og = xb_add(&bar[XB_TOP], 1u);
            const unsigned tg = og / nx;
            if (og + 1u == (tg + 1u) * nx) xb_add(&bar[XB_TOPGEN], 1u);
            else XB_SPIN(xb_ld(&bar[XB_TOPGEN]) == tg, bar);
            __builtin_amdgcn_fence(__ATOMIC_ACQUIRE, "agent");
            xb_add(&bar[XB_XGEN(b.x)], 1u);
            asm volatile("s_waitcnt vmcnt(0)" ::: "memory");
        } else {
            XB_SPIN(xb_ld(&bar[XB_XGEN(b.x)]) == gen, bar);
            __builtin_amdgcn_fence(__ATOMIC_ACQUIRE, "agent");
            asm volatile("s_waitcnt vmcnt(0)" ::: "memory");
        }
    }
    __syncthreads();
}


struct Frame {
    LAS unsigned char* lds;
    int tid, lane, wave, vcu, G;
};
constexpr int PTR_OFF = LDSCTL_OFF + 1024;
__device__ __forceinline__ const float* inp(const Frame& F, int i) {
    const LAS unsigned* p = (const LAS unsigned*)(F.lds + PTR_OFF) + 2 * i;
    const unsigned lo = __builtin_amdgcn_readfirstlane(p[0]), hi = __builtin_amdgcn_readfirstlane(p[1]);
    return (const float*)(const GAS float*)(((unsigned long long)hi << 32) | lo);
}
__device__ __forceinline__ unsigned char* ws_(const Frame& F) { return (unsigned char*)inp(F, 31); }
__device__ __forceinline__ float* out_(const Frame& F) { return (float*)inp(F, 32); }
__device__ __forceinline__ int modrow_of(int m) { return m < TL ? (m >> 13) : 2; }
__device__ __forceinline__ const float* xin_row(const Frame& F, int m) { return m < TL ? inp(F, 0) + (size_t)m * D : inp(F, 2) + (size_t)(m - TL) * D; }
__device__ __forceinline__ float* xres_row(const Frame& F, int m) { return m < TL ? out_(F) + (size_t)m * D : (float*)(ws_(F) + WS_XC) + (size_t)(m - TL) * D; }
__device__ __forceinline__ const float* modvec(const Frame& F, int layer, int mr, int part) { return (const float*)(ws_(F) + WS_MOD) + (size_t)(layer * 3 + mr) * 6144 + part * 1024; }

__device__ __forceinline__ void tr_item(const float* W, int ldw, int k0, int n0, bf16* dst, int dpitch, LAS float* scr, int lane) {
    { f32x4 v[8];
#pragma unroll
      for (int i = 0; i < 8; ++i) v[i] = *(const GAS f32x4*)(W + (size_t)(k0 + 8 * i + (lane >> 3)) * ldw + n0 + 4 * (lane & 7));
#pragma unroll
      for (int i = 0; i < 8; ++i) { LAS float* d = scr + (8 * i + (lane >> 3)) * 33 + 4 * (lane & 7); d[0] = v[i].x; d[1] = v[i].y; d[2] = v[i].z; d[3] = v[i].w; } }
    LDS_WAIT(); asm volatile("" ::: "memory");
    const int c = lane & 7;
#pragma unroll
    for (int j = 0; j < 4; ++j) { const int n = (lane >> 3) + 8 * j; const LAS float* s = scr + (8 * c) * 33 + n;
        v4u o; o.x = pk2(s[0 * 33], s[1 * 33]); o.y = pk2(s[2 * 33], s[3 * 33]); o.z = pk2(s[4 * 33], s[5 * 33]); o.w = pk2(s[6 * 33], s[7 * 33]);
        *(GAS v4u*)(dst + (size_t)n * dpitch + 8 * c) = o; }
    LDS_WAIT(); asm volatile("" ::: "memory");
}
__device__ __forceinline__ bool tr_plain(int& r, const float* W, int K, int N, bf16* WT, LAS float* scr, int lane) {
    const int nblk = N / 32, cnt = (K / 64) * nblk;
    if (r >= cnt) { r -= cnt; return false; }
    const int kb = r / nblk, nb = r % nblk;
    tr_item(W, N, 64 * kb, 32 * nb, WT + (size_t)(32 * nb) * K + 64 * kb, K, scr, lane); return true;
}
__device__ __forceinline__ bool tr_ffn1(int& r, const float* W, bf16* WT, LAS float* scr, int lane) {
    const int nblk = 5632 / 32, cnt = 16 * nblk;
    if (r >= cnt) { r -= cnt; return false; }
    const int kb = r / nblk, nb = r % nblk, n0 = 32 * nb, half = n0 / FFH, j = n0 % FFH, drow = (j >> 7) * 256 + half * 128 + (j & 127);
    tr_item(W, 5632, 64 * kb, n0, WT + (size_t)drow * 1024 + 64 * kb, 1024, scr, lane); return true;
}
#ifndef DUP_GEMV
#define DUP_GEMV 1
#endif
#ifndef DUP_TR
#define DUP_TR 1
#endif
#ifndef DUP_S5T
#define DUP_S5T 1
#endif
__device__ __forceinline__ void p0_prologue(Frame& F) {
    {
        LAS float* sv = (LAS float*)(F.lds + RING_OFF);
        LAS float* red = sv + 3072;
        for (int i = F.tid; i < 3072; i += 512) { const int r = i >> 10, k = i & 1023; const float cv = (r < 2) ? inp(F, 1)[r * 1024 + k] : inp(F, 3)[k]; sv[i] = cv / (1.0f + __expf(-cv)); }
        __syncthreads();
        for (int rep_ = 0; rep_ < DUP_GEMV; ++rep_)
        for (int it = blockIdx.x; it < 192; it += F.G) {
            const int layer = it / 96, cg = it % 96, col = cg * 64 + F.lane, k0 = F.wave * 128;
            const float* w = inp(F, 4) + ((size_t)layer * 1024 + k0) * 6144 + col;
            float a0 = 0.f, a1 = 0.f, a2 = 0.f;
#pragma unroll 16
            for (int k = 0; k < 128; ++k) { const float wv = w[(size_t)k * 6144]; a0 += sv[k0 + k] * wv; a1 += sv[1024 + k0 + k] * wv; a2 += sv[2048 + k0 + k] * wv; }
            red[(F.wave * 3 + 0) * 64 + F.lane] = a0; red[(F.wave * 3 + 1) * 64 + F.lane] = a1; red[(F.wave * 3 + 2) * 64 + F.lane] = a2;
            __syncthreads();
            if (F.tid < 192) { const int r = F.tid >> 6, l = F.tid & 63; float s = inp(F, 5)[layer * 6144 + cg * 64 + l];
#pragma unroll
                for (int wv = 0; wv < 8; ++wv) s += red[(wv * 3 + r) * 64 + l];
                ((float*)(ws_(F) + WS_MOD))[(size_t)(layer * 3 + r) * 6144 + cg * 64 + l] = s; }
            __syncthreads();
        }
        __syncthreads();
    }
    {
        const int gt = F.vcu * 512 + F.tid, NT = F.G * 512;
        for (int i = gt; i < 2048; i += NT) { const int dir = i >> 10, c = i & 1023; const float l0 = inp(F, 28)[(0 * 2 + dir) * 1024 + c], l1 = inp(F, 28)[(1 * 2 + dir) * 1024 + c];
            ((float*)(ws_(F) + WS_LBV))[i] = 1.0f / (1.0f + expf(l0 - l1)); }
        for (int i = gt; i < 1024; i += NT) { const int pos = i >> 3, f = i & 7; const float inv = powf(10000.0f, -(float)f / 8.0f); const float ang = (float)pos * inv;
            ((float*)(ws_(F) + WS_ROPE))[2 * i] = cosf(ang); ((float*)(ws_(F) + WS_ROPE))[2 * i + 1] = sinf(ang); }
        for (int i = gt; i < 2 * FFH; i += NT) { const int layer = i / FFH, j = i % FFH; const float* cwp = inp(F, 9) + (size_t)layer * 3 * FFH + j;
            v2u w; w.x = pk2(cwp[0], cwp[FFH]); w.y = pk2(cwp[2 * FFH], inp(F, 10)[(size_t)layer * FFH + j]); *(GAS v2u*)((bf16*)(ws_(F) + WS_CWT) + (size_t)i * 4) = w; }
        for (int i = gt; i < 96 * 1024 / 8; i += NT) ((GAS v4u*)(ws_(F) + WS_WIN0 + (size_t)1184 * 1024 * 2))[i] = (v4u){0u, 0u, 0u, 0u};
    }
    {
        LAS float* scr = (LAS float*)(F.lds + RING_OFF + F.wave * 16384);
        const int gw = F.vcu * NWAVES + F.wave, NGW = F.G * NWAVES;
        constexpr int NITEMS = 592 + 144 + 128 + 128 + 512 + 2 * 2816 + 2 * 1408 + 2560 + 512;
        for (int rep_ = 0; rep_ < DUP_TR; ++rep_)
        for (int it = gw; it < NITEMS; it += NGW) {
            int r = it;
            if (tr_plain(r, inp(F, 12), 1024, 1184, (bf16*)(ws_(F) + WS_WIN0), scr, F.lane)) continue;
            if (tr_plain(r, inp(F, 14), 384, 768, (bf16*)(ws_(F) + WS_WUQ), scr, F.lane)) continue;
            if (tr_plain(r, inp(F, 16), 256, 1024, (bf16*)(ws_(F) + WS_WUKV), scr, F.lane)) continue;
            if (tr_plain(r, inp(F, 25), 512, 512, (bf16*)(ws_(F) + WS_WGLU), scr, F.lane)) continue;
            if (tr_plain(r, inp(F, 26), 1024, 1024, (bf16*)(ws_(F) + WS_WOUT0), scr, F.lane)) continue;
            if (tr_ffn1(r, inp(F, 8), (bf16*)(ws_(F) + WS_F1T0), scr, F.lane)) continue;
            if (tr_ffn1(r, inp(F, 8) + (size_t)1024 * 5632, (bf16*)(ws_(F) + WS_F1T1), scr, F.lane)) continue;
            if (tr_plain(r, inp(F, 11), 2816, 1024, (bf16*)(ws_(F) + WS_F2T0), scr, F.lane)) continue;
            if (tr_plain(r, inp(F, 11) + (size_t)2816 * 1024, 2816, 1024, (bf16*)(ws_(F) + WS_F2T1), scr, F.lane)) continue;
            if (tr_plain(r, inp(F, 27), 1024, 5120, (bf16*)(ws_(F) + WS_HGINT), scr, F.lane)) continue;
            tr_plain(r, inp(F, 30), 1024, 1024, (bf16*)(ws_(F) + WS_HGOUTT), scr, F.lane);
        }
    }
}

__device__ __forceinline__ void store_mod_bf16(const Frame& F, const f32x4 (&v)[4], int m, int layer, int part_sh) {
    const int mr = modrow_of(m);
    const GAS f32x4* sh = (const GAS f32x4*)modvec(F, layer, mr, part_sh) + F.lane;
    const GAS f32x4* sc = (const GAS f32x4*)modvec(F, layer, mr, part_sh + 1) + F.lane;
    GAS v2u* o = (GAS v2u*)((bf16*)(ws_(F) + WS_A) + (size_t)m * D) + F.lane;
#pragma unroll
    for (int j = 0; j < 4; ++j) { const f32x4 s = sc[64 * j], h = sh[64 * j]; const f32x4 y = v[j] * (s + 1.0f) + h; v2u w; w.x = pk2(y.x, y.y); w.y = pk2(y.z, y.w); o[64 * j] = w; }
}
__device__ __forceinline__ void ph_init_rows(Frame& F) {
    const int gw = F.vcu * NWAVES + F.wave, NGW = F.G * NWAVES;
    for (int m = gw; m < TT; m += NGW) {
        const GAS f32x4* xr = (const GAS f32x4*)xin_row(F, m) + F.lane; GAS f32x4* xo = (GAS f32x4*)xres_row(F, m) + F.lane;
        f32x4 v[4];
#pragma unroll
        for (int j = 0; j < 4; ++j) { v[j] = xr[64 * j]; if (m >= TL) xo[64 * j] = v[j] * DN_ALPHA; }
        store_mod_bf16(F, v, m, 0, 0);
    }
}
__device__ __forceinline__ void ph_layernorm(Frame& F, int nrows, int layer, int which, int next_layer, int next_part_sh, const float* slabs = nullptr, int nslabs = 0) {
    const int gw = F.vcu * NWAVES + F.wave, NGW = F.G * NWAVES;
    const GAS f32x4* gg = (const GAS f32x4*)(inp(F, 6) + (size_t)(layer * 2 + which) * D) + F.lane;
    const GAS f32x4* bb = (const GAS f32x4*)(inp(F, 7) + (size_t)(layer * 2 + which) * D) + F.lane;
    for (int m0 = gw; m0 < nrows; m0 += 2 * NGW) {
        const int m1 = m0 + NGW; const bool has1 = m1 < nrows; const int m1c = has1 ? m1 : m0;
        GAS f32x4* xr0 = (GAS f32x4*)xres_row(F, m0) + F.lane; GAS f32x4* xr1 = (GAS f32x4*)xres_row(F, m1c) + F.lane;
        f32x4 v[4], w[4]; float s0 = 0.f, s1 = 0.f;
#pragma unroll
        for (int j = 0; j < 4; ++j) { v[j] = xr0[64 * j]; w[j] = xr1[64 * j]; }
        if (nslabs > 0 && m1c >= TL) {
            for (int sl = 0; sl < nslabs; ++sl) { const GAS f32x4* p1 = (const GAS f32x4*)(slabs + ((size_t)sl * TC + (m1c - TL)) * D) + F.lane;
#pragma unroll
                for (int j = 0; j < 4; ++j) w[j] += p1[64 * j];
                if (m0 >= TL) { const GAS f32x4* p0 = (const GAS f32x4*)(slabs + ((size_t)sl * TC + (m0 - TL)) * D) + F.lane;
#pragma unroll
                    for (int j = 0; j < 4; ++j) v[j] += p0[64 * j]; } }
        }
#pragma unroll
        for (int j = 0; j < 4; ++j) { s0 += (v[j].x + v[j].y) + (v[j].z + v[j].w); s1 += (w[j].x + w[j].y) + (w[j].z + w[j].w); }
        const float mean0 = wave_sum(s0) * (1.f / D), mean1 = wave_sum(s1) * (1.f / D); float q0 = 0.f, q1 = 0.f;
#pragma unroll
        for (int j = 0; j < 4; ++j) { v[j] = v[j] - mean0; w[j] = w[j] - mean1; q0 += (v[j].x * v[j].x + v[j].y * v[j].y) + (v[j].z * v[j].z + v[j].w * v[j].w); q1 += (w[j].x * w[j].x + w[j].y * w[j].y) + (w[j].z * w[j].z + w[j].w * w[j].w); }
        const float r0 = 1.f / sqrtf(wave_sum(q0) * (1.f / D) + NORM_EPS), r1 = 1.f / sqrtf(wave_sum(q1) * (1.f / D) + NORM_EPS);
#pragma unroll
        for (int j = 0; j < 4; ++j) { const f32x4 g4 = gg[64 * j], b4 = bb[64 * j]; v[j] = v[j] * r0 * g4 + b4; w[j] = w[j] * r1 * g4 + b4; xr0[64 * j] = (m0 >= TL) ? v[j] * DN_ALPHA : v[j]; if (has1) xr1[64 * j] = (m1 >= TL) ? w[j] * DN_ALPHA : w[j]; }
        if (next_layer >= 0) { store_mod_bf16(F, v, m0, next_layer, next_part_sh); if (has1) store_mod_bf16(F, w, m1, next_layer, next_part_sh); }
    }
}
__device__ __forceinline__ void ph_mla_norm(Frame& F) {
    const int gw = F.vcu * NWAVES + F.wave, NGW = F.G * NWAVES;
    bf16* CQ = (bf16*)(ws_(F) + WS_CQKV); bf16* Kb = (bf16*)(ws_(F) + WS_KB); const float* rope = (const float*)(ws_(F) + WS_ROPE);
    for (int m = gw; m < TT; m += NGW) {
        bf16* row = CQ + (size_t)m * CQKV_LD;
        {
            float x[8]; float ss = 0.f; const bool act = F.lane < 48;
            if (act) { unpack8(*(const GAS v4u*)(row + 8 * F.lane), x);
#pragma unroll
                for (int j = 0; j < 8; ++j) ss += x[j] * x[j]; }
            const float sc = 1.f / sqrtf(wave_sum(ss) * (1.f / 384.f) + NORM_EPS);
            if (act) {
#pragma unroll
                for (int j = 0; j < 8; ++j) x[j] = x[j] * sc * inp(F, 13)[8 * F.lane + j];
                *(GAS v4u*)(row + 8 * F.lane) = pack8(x); }
        }
        {
            float x[8]; float ss = 0.f; const bool act = F.lane < 32;
            if (act) { unpack8(*(const GAS v4u*)(row + 384 + 8 * F.lane), x);
#pragma unroll
                for (int j = 0; j < 8; ++j) ss += x[j] * x[j]; }
            const float sc = 1.f / sqrtf(wave_sum(ss) * (1.f / 256.f) + NORM_EPS);
            if (act) {
#pragma unroll
                for (int j = 0; j < 8; ++j) x[j] = x[j] * sc * inp(F, 15)[8 * F.lane + j];
                *(GAS v4u*)(row + 384 + 8 * F.lane) = pack8(x); }
        }
        {
            const bool isctx = m >= TL; const int b = isctx ? ((m - TL) >> 8) : (m >> 13), t = isctx ? ((m - TL) & 255) : (m & 8191), tk = isctx ? t : CTXL + t;
            const int h = F.lane >> 3, i0 = (F.lane & 7) * 4;
            const v2u w = *(const GAS v2u*)(row + 640 + i0);
            float x[4] = {bflo(w.x), bfhi(w.x), bflo(w.y), bfhi(w.y)}, o[4];
#pragma unroll
            for (int j = 0; j < 4; ++j) { const float p = __shfl_xor(x[j], 2); const int idx = i0 + j, a = idx >> 4, half = (idx >> 3) & 1, f = idx & 7, pos = a ? (t & 63) : (t >> 6);
                const float cs = rope[2 * (pos * 8 + f)], sn = rope[2 * (pos * 8 + f) + 1];
                o[j] = isctx ? x[j] : (half ? x[j] * cs + p * sn : x[j] * cs - p * sn); }
            v2u ow; ow.x = pk2(o[0], o[1]); ow.y = pk2(o[2], o[3]);
            *(GAS v2u*)(Kb + ((size_t)(b * 8 + h) * TQK + tk) * 96 + 64 + i0) = ow;
        }
    }
}
__device__ __forceinline__ void ph_convfix(Frame& F, int nrows, int layer) {
    const int gw = F.vcu * NWAVES + F.wave, NGW = F.G * NWAVES;
    const bf16* AB = (const bf16*)(ws_(F) + WS_AB); const bf16* GB = (const bf16*)(ws_(F) + WS_GB); bf16* HG = (bf16*)(ws_(F) + WS_HG);
    const float* cw = inp(F, 9) + (size_t)layer * 3 * FFH; const float* cb = inp(F, 10) + (size_t)layer * FFH;
    const int nedge = (nrows / 64) * 2;
    for (int er = gw; er < nedge; er += NGW) {
        const int g64 = er >> 1, which = er & 1, m = 64 * g64 + (which ? 63 : 0);
        const bool isctx = m >= TL; const int t = isctx ? ((m - TL) & 255) : (m & 8191), len = isctx ? CTXL : SEQ;
        const bool hp = t > 0, hn = t < len - 1;
        const bf16* ac_ = AB + (size_t)(g64 * 4 + (which ? 3 : 0)) * FFH;
        const bf16* ap_ = which ? AB + (size_t)(g64 * 4 + 2) * FFH : AB + (size_t)((g64 - 1) * 4 + 3) * FFH;
        const bf16* an_ = which ? AB + (size_t)((g64 + 1) * 4 + 0) * FFH : AB + (size_t)(g64 * 4 + 1) * FFH;
        const bf16* gt_ = GB + (size_t)(g64 * 2 + which) * FFH;
#pragma unroll
        for (int ci = 0; ci < 6; ++ci) { const int ch = F.lane + 64 * ci; if (ch >= FFH / 8) break;
            const int j0 = 8 * ch; float ac[8], ap[8], an[8], gt[8], o[8];
            unpack8(*(const GAS v4u*)(ac_ + j0), ac); unpack8(*(const GAS v4u*)(gt_ + j0), gt);
            if (hp) unpack8(*(const GAS v4u*)(ap_ + j0), ap); else {
#pragma unroll
                for (int j = 0; j < 8; ++j) ap[j] = 0.f; }
            if (hn) unpack8(*(const GAS v4u*)(an_ + j0), an); else {
#pragma unroll
                for (int j = 0; j < 8; ++j) an[j] = 0.f; }
#pragma unroll
            for (int j = 0; j < 8; ++j) { const float cv = cb[j0 + j] + cw[j0 + j] * ap[j] + cw[FFH + j0 + j] * ac[j] + cw[2 * FFH + j0 + j] * an[j]; o[j] = siluf_(cv) * gt[j]; }
            *(GAS v4u*)(HG + (size_t)m * FFH + j0) = pack8(o);
        }
    }
}
__device__ __forceinline__ void ph_hg_gate(Frame& F) {
    const int gw = F.vcu * NWAVES + F.wave, NGW = F.G * NWAVES;
    bf16* O = (bf16*)(ws_(F) + WS_O); const bf16* G = (const bf16*)(ws_(F) + WS_G);
    const int c0 = 16 * F.lane; float ng[16];
#pragma unroll
    for (int j = 0; j < 16; ++j) ng[j] = inp(F, 29)[(c0 + j) & 127];
    for (int m = gw; m < TL; m += NGW) {
        float o[16], g[16]; unpack8(*(const GAS v4u*)(O + (size_t)m * D + c0), o); unpack8(*(const GAS v4u*)(O + (size_t)m * D + c0 + 8), o + 8);
        unpack8(*(const GAS v4u*)(G + (size_t)m * D + c0), g); unpack8(*(const GAS v4u*)(G + (size_t)m * D + c0 + 8), g + 8);
        float ss = 0.f;
#pragma unroll
        for (int j = 0; j < 16; ++j) ss += o[j] * o[j];
        ss += __shfl_xor(ss, 1); ss += __shfl_xor(ss, 2); ss += __shfl_xor(ss, 4);
        const float sc = 1.f / sqrtf(ss * (1.f / 128.f) + NORM_EPS);
#pragma unroll
        for (int j = 0; j < 16; ++j) o[j] = o[j] * sc * ng[j] * siluf_(g[j]);
        *(GAS v4u*)(O + (size_t)m * D + c0) = pack8(o); *(GAS v4u*)(O + (size_t)m * D + c0 + 8) = pack8(o + 8);
    }
}

typedef short bf16x8_t __attribute__((ext_vector_type(8)));
typedef float f32x16 __attribute__((ext_vector_type(16)));
__device__ __forceinline__ int crow(int r, int hi) { return (r & 3) + 8 * (r >> 2) + 4 * hi; }
constexpr int NCH = TT / 64;
__device__ __forceinline__ void p0_s5_tables(Frame& F) {
    LAS unsigned char* L = F.lds + RING_OFF;
    LAS double* lam = (LAS double*)L;
    LAS float* bb = (LAS float*)(L + 1024);
    LAS float* cc = (LAS float*)(L + 1024 + 8192);
    LAS float* pw = (LAS float*)(L + 1024 + 16384);
    unsigned char* ws = ws_(F);
    for (int item4 = blockIdx.x; item4 < 256; item4 += F.G) {
        const int item = item4 >> 2, part = item4 & 3;
        const int g = item >> 1, d = item & 1;
        __syncthreads();
        if (F.tid < 64) { const int n = F.tid, pi = (d * 32 + g) * 64 + n;
            const double lre = inp(F, 17)[pi], lim = inp(F, 18)[pi], dt = exp((double)inp(F, 19)[d * 32 + g]);
            const double mag = exp(lre * dt), are = mag * cos(lim * dt), aim = mag * sin(lim * dt), den = lre * lre + lim * lim, nr = are - 1.0;
            const double fr = (nr * lre + aim * lim) / den, fi = (aim * lre - nr * lim) / den;
            for (int q = 0; q < 16; ++q) { const double br = inp(F, 20)[(size_t)pi * 16 + q], bi = inp(F, 21)[(size_t)pi * 16 + q];
                bb[(n * 16 + q) * 2] = (float)(fr * br - fi * bi); bb[(n * 16 + q) * 2 + 1] = (float)(fr * bi + fi * br); }
            double pr = 1.0, pim = 0.0;
            for (int e = 0; e <= 64; ++e) { pw[(e * 64 + n) * 2] = (float)pr; pw[(e * 64 + n) * 2 + 1] = (float)pim; const double n_r = pr * are - pim * aim, n_i = pr * aim + pim * are; pr = n_r; pim = n_i; } }
        for (int i = F.tid; i < 1024; i += 512) { const int p = i >> 6, n = i & 63; cc[i * 2] = inp(F, 22)[((size_t)(d * 32 + g) * 16 + p) * 64 + n]; cc[i * 2 + 1] = inp(F, 23)[((size_t)(d * 32 + g) * 16 + p) * 64 + n]; }
        __syncthreads();
        { bf16* WF = (bf16*)(ws + WS_WF) + (size_t)g * 256 * 1024;
          for (int i = part * 4096 + F.tid; i < (part + 1) * 4096; i += 512) { const int row = i >> 7, grp = i & 127, c = row >> 6, n = row & 63, sI = grp >> 1, q0 = (grp & 1) * 8, e = d ? sI : 63 - sI;
              const float pr = pw[(e * 64 + n) * 2], pim = pw[(e * 64 + n) * 2 + 1]; float o[8];
              const LAS f32x4* bq = (const LAS f32x4*)(bb + (n * 16 + q0) * 2);
#pragma unroll
              for (int j4 = 0; j4 < 4; ++j4) { const f32x4 v = bq[j4]; o[2 * j4] = c ? (pr * v.y + pim * v.x) : (pr * v.x - pim * v.y); o[2 * j4 + 1] = c ? (pr * v.w + pim * v.z) : (pr * v.z - pim * v.w); }
              *(GAS v4u*)(WF + (size_t)(d * 128 + row) * 1024 + sI * 16 + q0) = pack8(o); } }
        { bf16* WC = (bf16*)(ws + WS_WC) + (size_t)g * 1024 * 256;
          for (int i = part * 4096 + F.tid; i < (part + 1) * 4096; i += 512) { const int row = i >> 4, grp = i & 15, t = row >> 4, p = row & 15, c = grp >> 3, n0 = (grp & 7) * 8, ex = d ? 64 - t : t + 1; float o[8];
              const LAS f32x4* pq = (const LAS f32x4*)(pw + (ex * 64 + n0) * 2); const LAS f32x4* cq = (const LAS f32x4*)(cc + (p * 64 + n0) * 2);
#pragma unroll
              for (int j4 = 0; j4 < 4; ++j4) { const f32x4 pv = pq[j4], cv = cq[j4];
                  o[2 * j4] = c ? -(cv.x * pv.y + cv.y * pv.x) : (cv.x * pv.x - cv.y * pv.y); o[2 * j4 + 1] = c ? -(cv.z * pv.w + cv.w * pv.z) : (cv.z * pv.z - cv.w * pv.w); }
              *(GAS v4u*)(WC + (size_t)row * 256 + d * 128 + c * 64 + n0) = pack8(o); } }
        { bf16* TP = (bf16*)(ws + WS_TOEP) + (size_t)g * 127 * 256; float* T0 = (float*)(ws + WS_T0) + (size_t)(g * 2 + d) * 256;
          for (int i = part * 256 + F.tid; i < (part + 1) * 256; i += 512) { const int tau = i >> 4, p = i & 15; float acc[16];
#pragma unroll
              for (int q = 0; q < 16; ++q) acc[q] = 0.f;
              for (int n = 0; n < 64; ++n) { const float pr = pw[(tau * 64 + n) * 2], pim = pw[(tau * 64 + n) * 2 + 1], cr = cc[(p * 64 + n) * 2], ci = cc[(p * 64 + n) * 2 + 1];
                  const float tr = cr * pr - ci * pim, ti = cr * pim + ci * pr;
                  const LAS f32x4* bq = (const LAS f32x4*)(bb + n * 32);
#pragma unroll
                  for (int q4 = 0; q4 < 8; ++q4) { const f32x4 v = bq[q4]; acc[2 * q4] += tr * v.x - ti * v.y; acc[2 * q4 + 1] += tr * v.z - ti * v.w; } }
              if (tau == 0) {
#pragma unroll
                  for (int q = 0; q < 16; ++q) T0[p * 16 + q] = acc[q]; }
              else { bf16* o = TP + (size_t)(d ? 63 - tau : 63 + tau) * 256 + p * 16; *(GAS v4u*)o = pack8(acc); *(GAS v4u*)(o + 8) = pack8(acc + 8); } } }
        if (part == 0 && F.tid < 64) { float* A64 = (float*)(ws + WS_A64) + (size_t)((g * 2 + d) * 64 + F.tid) * 2; A64[0] = pw[(64 * 64 + F.tid) * 2]; A64[1] = pw[(64 * 64 + F.tid) * 2 + 1]; }
    }
    __syncthreads();
}
__device__ __forceinline__ void ph_s5_finals(Frame& F) {
    const int lane = F.lane, r32 = lane & 31, hh = lane >> 5, wave = F.wave;
    unsigned char* ws = ws_(F);
    for (int u = blockIdx.x; u < 288; u += F.G) {
        const int g = u / 9, nb = u % 9; int chunk = nb * 32 + r32; const bool valid = chunk < NCH; if (!valid) chunk = NCH - 1;
        const bf16* ub = (const bf16*)(ws + WS_UG) + ((size_t)g * TT + (size_t)chunk * 64) * 16 + 8 * hh;
        const bf16* wf = (const bf16*)(ws + WS_WF) + ((size_t)(g * 256 + 32 * wave + r32)) * 1024 + 8 * hh;
        f32x16 acc;
#pragma unroll
        for (int r = 0; r < 16; ++r) acc[r] = 0.f;
#pragma unroll 16
        for (int sI = 0; sI < 64; ++sI) { const bf16x8_t a = *(const GAS bf16x8_t*)(wf + 16 * sI), b = *(const GAS bf16x8_t*)(ub + 16 * sI); acc = __builtin_amdgcn_mfma_f32_32x32x16_bf16(a, b, acc, 0, 0, 0); }
        if (valid) { float* fo = (float*)(ws + WS_FIN) + ((size_t)g * NCH + chunk) * 256 + 32 * wave + 4 * hh;
#pragma unroll
            for (int k = 0; k < 4; ++k) *(GAS f32x4*)(fo + 8 * k) = (f32x4){acc[4 * k], acc[4 * k + 1], acc[4 * k + 2], acc[4 * k + 3]}; }
    }
}
__device__ __forceinline__ int s5_chunk_of(int step, int d, int b) { return step < 4 ? 256 + 4 * b + (d ? 3 - step : step) : 128 * b + (d ? 127 - (step - 4) : step - 4); }
__device__ __forceinline__ void ph_s5_carry(Frame& F) {
    if (F.wave >= 3) return;
    unsigned char* ws = ws_(F);
    for (int item = ((int)F.G - 1 - (int)blockIdx.x) * 3 + F.wave; item < 128; item += 3 * F.G) {
        const int g = item >> 2, d = (item >> 1) & 1, b = item & 1, n = F.lane;
        const float a_r = ((const float*)(ws + WS_A64))[((g * 2 + d) * 64 + n) * 2], a_i = ((const float*)(ws + WS_A64))[((g * 2 + d) * 64 + n) * 2 + 1];
        const float* Fb = (const float*)(ws + WS_FIN) + (size_t)g * NCH * 256 + d * 128 + n; bf16* Sb = (bf16*)(ws + WS_SIN) + (size_t)g * NCH * 256 + d * 128 + n;
        float sr = 0.f, si = 0.f;
        for (int s0 = 0; s0 < 132; s0 += 12) {
            float fr[12], fi[12];
#pragma unroll
            for (int j = 0; j < 12; ++j) { const int c = s5_chunk_of(s0 + j, d, b); fr[j] = Fb[(size_t)c * 256]; fi[j] = Fb[(size_t)c * 256 + 64]; }
#pragma unroll
            for (int j = 0; j < 12; ++j) { const int c = s5_chunk_of(s0 + j, d, b); Sb[(size_t)c * 256] = (bf16)f2bf(sr); Sb[(size_t)c * 256 + 64] = (bf16)f2bf(si);
                const float nr = a_r * sr - a_i * si + fr[j], ni = a_r * si + a_i * sr + fi[j]; sr = nr; si = ni; }
        }
    }
}
constexpr int TP_PITCH = 48;
__device__ __forceinline__ void ph_s5_out(Frame& F) {
    LAS unsigned char* L = F.lds + RING_OFF;
    const int lane = F.lane, r32 = lane & 31, hh = lane >> 5, wave = F.wave, tid = F.tid;
    unsigned char* ws = ws_(F);
    for (int u = blockIdx.x; u < 288; u += F.G) {
        const int g = u / 9, nb = u % 9; int chunk = nb * 32 + r32; const bool valid = chunk < NCH; if (!valid) chunk = NCH - 1;
        __syncthreads();
        { const GAS v4u* tp = (const GAS v4u*)((const bf16*)(ws + WS_TOEP) + (size_t)g * 127 * 256); const float* t0 = (const float*)(ws + WS_T0) + (size_t)g * 512;
          for (int c = tid; c < 127 * 32; c += 512) { const int di = c >> 5, p = (c >> 1) & 15, half = c & 1; v4u v;
              if (di == 63) { float o[8];
#pragma unroll
                  for (int j = 0; j < 8; ++j) o[j] = t0[p * 16 + half * 8 + j] + t0[256 + p * 16 + half * 8 + j];
                  v = pack8(o); }
              else v = tp[c];
              *(LAS v4u*)(L + (di * 16 + p) * TP_PITCH + half * 16) = v; } }
        __syncthreads();
        const bf16* ub = (const bf16*)(ws + WS_UG) + ((size_t)g * TT + (size_t)chunk * 64) * 16 + 8 * hh;
        f32x16 acc[4];
#pragma unroll
        for (int i = 0; i < 4; ++i)
#pragma unroll
            for (int r = 0; r < 16; ++r) acc[i][r] = 0.f;
        const LAS unsigned char* tl = L + ((63 + 2 * wave + (r32 >> 4)) * 16 + (r32 & 15)) * TP_PITCH + hh * 16;
#pragma unroll 1
        for (int s0 = 0; s0 < 64; s0 += 16) {
            bf16x8_t bq[16];
#pragma unroll
            for (int e = 0; e < 16; ++e) bq[e] = *(const GAS bf16x8_t*)(ub + 16 * (s0 + e));
#pragma unroll
            for (int e = 0; e < 16; ++e) { const int sI = s0 + e; const bf16x8_t b = bq[e];
#pragma unroll
            for (int i = 0; i < 4; ++i) { const bf16x8_t a = *(const LAS bf16x8_t*)(tl + (16 * i - sI) * 16 * TP_PITCH); acc[i] = __builtin_amdgcn_mfma_f32_32x32x16_bf16(a, b, acc[i], 0, 0, 0); }
            }
        }
        { const bf16* sb = (const bf16*)(ws + WS_SIN) + ((size_t)g * NCH + chunk) * 256 + 8 * hh;
          const bf16* wc = (const bf16*)(ws + WS_WC) + ((size_t)g * 1024 + 32 * wave + r32) * 256 + 8 * hh;
#pragma unroll 4
          for (int kk = 0; kk < 16; ++kk) {
              const bf16x8_t b = *(const GAS bf16x8_t*)(sb + 16 * kk);
#pragma unroll
              for (int i = 0; i < 4; ++i) { const bf16x8_t a = *(const GAS bf16x8_t*)(wc + (size_t)(256 * i) * 256 + 16 * kk); acc[i] = __builtin_amdgcn_mfma_f32_32x32x16_bf16(a, b, acc[i], 0, 0, 0); }
          } }
        if (valid) {
            const float* dsk = inp(F, 24) + 16 * g;
#pragma unroll
            for (int i = 0; i < 4; ++i)
#pragma unroll
                for (int k = 0; k < 4; ++k) { const int tloc = 2 * (wave + 8 * i) + (k >> 1), p0 = 8 * (k & 1) + 4 * hh; const size_t m = (size_t)chunk * 64 + tloc;
                    const v2u uw = *(const GAS v2u*)((const bf16*)(ws + WS_UG) + ((size_t)g * TT + m) * 16 + p0);
                    const float y0 = gelu_tanh(acc[i][4 * k] + dsk[p0] * bflo(uw.x)), y1 = gelu_tanh(acc[i][4 * k + 1] + dsk[p0 + 1] * bfhi(uw.x));
                    const float y2 = gelu_tanh(acc[i][4 * k + 2] + dsk[p0 + 2] * bflo(uw.y)), y3 = gelu_tanh(acc[i][4 * k + 3] + dsk[p0 + 3] * bfhi(uw.y));
                    v2u zw; zw.x = pk2(y0, y1); zw.y = pk2(y2, y3);
                    *(GAS v2u*)((bf16*)(ws + WS_Z) + m * 512 + 16 * g + p0) = zw; }
        }
    }
}

__device__ __forceinline__ bf16x8_t pack_frag(const f32x16& p, int base) {
    v4u w; w.x = pg8::cvt_pk_bf16(p[base + 0], p[base + 1]); w.y = pg8::cvt_pk_bf16(p[base + 2], p[base + 3]); w.z = pg8::cvt_pk_bf16(p[base + 4], p[base + 5]); w.w = pg8::cvt_pk_bf16(p[base + 6], p[base + 7]);
    return __builtin_bit_cast(bf16x8_t, w);
}
constexpr int AT_KP = 208, AT_VP = 272;
constexpr int AT_KB = 128 * AT_KP, AT_VB = 64 * AT_VP;
constexpr int AT_K0 = 0, AT_V0 = 2 * AT_KB, AT_WS = 2 * AT_KB + 2 * AT_VB;
__device__ __forceinline__ void ph_attn(Frame& F) {
    LAS unsigned char* L = F.lds + RING_OFF;
    const int lane = F.lane, r32 = lane & 31, hi = lane >> 5, wave = F.wave, tid = F.tid;
    volatile LAS float* wsf = (volatile LAS float*)(L + AT_WS) + wave * 32;
    const bf16* Qb = (const bf16*)(ws_(F) + WS_QB); const bf16* Kb = (const bf16*)(ws_(F) + WS_KB); const bf16* Vt = (const bf16*)(ws_(F) + WS_VB);
    bf16* MIX = (bf16*)(ws_(F) + WS_MIX);
    int kl[3], vl[2];
#pragma unroll
    for (int i = 0; i < 3; ++i) { const int c = tid + 512 * i; kl[i] = (c / 12) * AT_KP + (c % 12) * 16; }
#pragma unroll
    for (int i = 0; i < 2; ++i) { const int c = tid + 512 * i; vl[i] = ((c & 511) >> 3) * AT_VP + (c >> 9) * 128 + (c & 7) * 16; }
    for (int it = 0; it < 3; ++it) {
        int u; if (it < 2) u = it * 256 + F.vcu; else { if (F.vcu >= 16) break; u = 512 + F.vcu; }
        int b, h, tq0, NT, m0;
        if (u < 512) { b = u >> 8; h = (u >> 5) & 7; tq0 = (u & 31) * 256; NT = TQK / 128; m0 = b * SEQ + tq0; }
        else { const int uc = u - 512; b = uc >> 3; h = uc & 7; tq0 = SEQ; NT = CTXL / 128; m0 = TL + b * CTXL; }
        const size_t bh = (size_t)(b * 8 + h);
        const GAS v4u* Kg = (const GAS v4u*)(Kb + bh * TQK * 96);
        const GAS v4u* Vg = (const GAS v4u*)(Vt + bh * (TQK / 64) * 4096);
        bf16x8_t qf[6];
        { const bf16* qp = Qb + (bh * TQK + tq0 + wave * 32 + r32) * 96 + hi * 8;
#pragma unroll
          for (int ks = 0; ks < 6; ++ks) qf[ks] = *(const GAS bf16x8_t*)(qp + ks * 16); }
        f32x16 o0, o1;
#pragma unroll
        for (int r = 0; r < 16; ++r) { o0[r] = 0.f; o1[r] = 0.f; }
        float m_run = -1e30f, l_run = 0.f;
        __syncthreads();
        { v4u a[3], v[2];
#pragma unroll
          for (int i = 0; i < 3; ++i) a[i] = Kg[tid + 512 * i];
#pragma unroll
          for (int i = 0; i < 2; ++i) v[i] = Vg[tid + 512 * i];
#pragma unroll
          for (int i = 0; i < 3; ++i) *(LAS v4u*)(L + AT_K0 + kl[i]) = a[i];
#pragma unroll
          for (int i = 0; i < 2; ++i) *(LAS v4u*)(L + AT_V0 + vl[i]) = v[i]; }
        __syncthreads();
        for (int t = 0; t < NT; ++t) {
            const int cur = t & 1, nxt = cur ^ 1; const bool more = (t + 1 < NT);
            v4u na[3], nv[2];
#pragma unroll
            for (int i = 0; i < 3; ++i) na[i] = (v4u){0u, 0u, 0u, 0u};
#pragma unroll
            for (int i = 0; i < 2; ++i) nv[i] = (v4u){0u, 0u, 0u, 0u};
            if (more) {
#pragma unroll
                for (int i = 0; i < 3; ++i) na[i] = Kg[(size_t)(t + 1) * 1536 + tid + 512 * i];
#pragma unroll
                for (int i = 0; i < 2; ++i) nv[i] = Vg[(size_t)(t + 1) * 1024 + tid + 512 * i]; }
            const LAS unsigned char* Kl = L + AT_K0 + cur * AT_KB + r32 * AT_KP + hi * 16;
            const LAS unsigned char* Vl = L + AT_V0 + cur * AT_VB + r32 * AT_VP + hi * 16;
            f32x16 p[4];
#pragma unroll
            for (int kb = 0; kb < 4; ++kb) {
#pragma unroll
                for (int r = 0; r < 16; ++r) p[kb][r] = 0.f;
#pragma unroll
                for (int ks = 0; ks < 6; ++ks) p[kb] = __builtin_amdgcn_mfma_f32_32x32x16_bf16(*(const LAS bf16x8_t*)(Kl + kb * 32 * AT_KP + ks * 32), qf[ks], p[kb], 0, 0, 0);
            }
            float mt = fmaxf(fmaxf(p[0][0], p[1][0]), fmaxf(p[2][0], p[3][0]));
#pragma unroll
            for (int r = 1; r < 16; ++r) mt = fmaxf(mt, fmaxf(fmaxf(p[0][r], p[1][r]), fmaxf(p[2][r], p[3][r])));
            mt = fmaxf(mt, __shfl_xor(mt, 32));
            const bool need = mt > m_run + 8.0f;
            if (__any(need)) {
                const float mn = need ? mt : m_run, alpha = __builtin_amdgcn_exp2f(m_run - mn);
                l_run *= alpha; m_run = mn;
                if (hi == 0) wsf[r32] = alpha;
#pragma unroll
                for (int r = 0; r < 16; ++r) { const float a = wsf[crow(r, hi)]; o0[r] *= a; o1[r] *= a; }
            }
            float sum = 0.f;
#pragma unroll
            for (int kb = 0; kb < 4; ++kb)
#pragma unroll
                for (int r = 0; r < 16; ++r) { p[kb][r] = __builtin_amdgcn_exp2f(p[kb][r] - m_run); sum += p[kb][r]; }
            l_run += sum;
#pragma unroll
            for (int kb = 0; kb < 4; ++kb) {
                const bf16x8_t pa = pack_frag(p[kb], 0), pb = pack_frag(p[kb], 8);
                const LAS unsigned char* vp = Vl + (kb >> 1) * 128 + (kb & 1) * 64;
                o0 = __builtin_amdgcn_mfma_f32_32x32x16_bf16(pa, *(const LAS bf16x8_t*)(vp), o0, 0, 0, 0);
                o0 = __builtin_amdgcn_mfma_f32_32x32x16_bf16(pb, *(const LAS bf16x8_t*)(vp + 32), o0, 0, 0, 0);
                o1 = __builtin_amdgcn_mfma_f32_32x32x16_bf16(pa, *(const LAS bf16x8_t*)(vp + 32 * AT_VP), o1, 0, 0, 0);
                o1 = __builtin_amdgcn_mfma_f32_32x32x16_bf16(pb, *(const LAS bf16x8_t*)(vp + 32 * AT_VP + 32), o1, 0, 0, 0);
            }
            if (more) {
#pragma unroll
                for (int i = 0; i < 3; ++i) *(LAS v4u*)(L + AT_K0 + nxt * AT_KB + kl[i]) = na[i];
#pragma unroll
                for (int i = 0; i < 2; ++i) *(LAS v4u*)(L + AT_V0 + nxt * AT_VB + vl[i]) = nv[i]; }
            __syncthreads();
        }
        l_run += __shfl_xor(l_run, 32);
        if (hi == 0) wsf[r32] = 1.0f / l_run;
#pragma unroll
        for (int r = 0; r < 16; ++r) { const int q = crow(r, hi); const float inv = wsf[q];
            bf16* op = MIX + (size_t)(m0 + wave * 32 + q) * D + h * 64 + r32;
            op[0] = (bf16)f2bf(o0[r] * inv); op[32] = (bf16)f2bf(o1[r] * inv); }
    }
}

constexpr int HG_QT = 0, HG_KT = 17408, HG_KH = 34816, HG_VT = 53248, HG_ST = 71680, HG_DEC = 106496, HG_TOT = 107008;
constexpr int HG_NSC = 17;
constexpr size_t WS_SD = 231 * MiB;
constexpr size_t WS_DECS = WS_SD + 18 * MiB;
static_assert(WS_DECS + 32 * 17 * 128 * 4 <= WS_END, "hgrn ws");
template <bool OUT>
__device__ __forceinline__ void hgrn_pass(Frame& F, int b, int h, int dir, int sc, f32x16 (&st)[2], float& dsum) {
    LAS unsigned char* L = F.lds + RING_OFF;
    unsigned char* ws = ws_(F);
    const int tid = F.tid, lane = F.lane, r32 = lane & 31, hh = lane >> 5, wave = F.wave;
    const int k = tid & 127, tg = tid >> 7;
    const int nch = sc == 0 ? 4 : 8; const size_t rowbase = sc == 0 ? (size_t)TL + b * CTXL : (size_t)b * SEQ + (size_t)(sc - 1) * 512;
    const bf16* QF = (const bf16*)(ws + WS_QFFI);
    const float lb = ((const float*)(ws + WS_LBV))[dir * 1024 + h * 128 + k];
    const int colf = 1024 * (1 + dir) + h * 128 + k, colq = h * 128 + k, colv = 3072 + h * 128 + k;
    const int dvb = wave & 3, jb = wave >> 2;
    bf16 rq[16], rf[16], rv[16];
#define HG_LOAD(ci) do { const int cc_ = dir ? nch - 1 - (ci) : (ci); const int tl0_ = dir ? 63 - 16 * tg : 16 * tg; \
        const GAS bf16* pf_ = (const GAS bf16*)(QF + (rowbase + 64 * cc_ + tl0_) * 4096 + colf); const GAS bf16* pv_ = pf_ + (colv - colf); const GAS bf16* pq_ = pf_ + (colq - colf); const long stp_ = dir ? -4096 : 4096; \
        _Pragma("unroll") for (int jj = 0; jj < 16; ++jj) { rf[jj] = *pf_; rv[jj] = *pv_; if (OUT) rq[jj] = *pq_; pf_ += stp_; pv_ += stp_; pq_ += stp_; asm volatile("" : "+v"(pf_), "+v"(pv_), "+v"(pq_)); } } while (0)
    HG_LOAD(0);
    for (int ci = 0; ci < nch; ++ci) {
        const int cc = dir ? nch - 1 - ci : ci;
        float cum[16], kk[16];
        { float run = 0.f;
#pragma unroll
          for (int jj = 0; jj < 16; ++jj) { const float f = lb + (1.f - lb) * sigmoidf_(bf2f(rf[jj])); run += __log2f(f); cum[jj] = run; kk[jj] = 1.f - f; }
          ((LAS float*)(L + HG_TOT))[tg * 128 + k] = run; }
        __syncthreads();
        { const LAS float* tot = (const LAS float*)(L + HG_TOT) + k; const float t0 = tot[0], t1 = tot[128], t2 = tot[256], t3 = tot[384];
          const float pre = tg == 0 ? 0.f : (tg == 1 ? t0 : (tg == 2 ? t0 + t1 : t0 + t1 + t2)), total = (t0 + t1) + (t2 + t3);
          if (tg == 0) { ((LAS float*)(L + HG_DEC))[k] = __builtin_amdgcn_exp2f(total); dsum += total; }
#define HG_KH(jj) (kk[jj] * __builtin_amdgcn_exp2f(total - (pre + cum[jj])))
#define HG_PKV(a, b_) ((unsigned)rv[a] | ((unsigned)rv[b_] << 16))
          if (OUT) {
#pragma unroll
              for (int jj = 0; jj < 16; ++jj) { const float c = pre + cum[jj]; const int j = 16 * tg + jj;
                  *(LAS bf16*)(L + HG_QT + j * 272 + k * 2) = (bf16)f2bf(bf2f(rq[jj]) * __builtin_amdgcn_exp2f(c)); *(LAS bf16*)(L + HG_KT + j * 272 + k * 2) = (bf16)f2bf(kk[jj] * __builtin_amdgcn_exp2f(-c)); } }
          v4u w0, w1;
          w0.x = pk2(HG_KH(0), HG_KH(1)); w0.y = pk2(HG_KH(2), HG_KH(3)); w0.z = pk2(HG_KH(8), HG_KH(9)); w0.w = pk2(HG_KH(10), HG_KH(11));
          w1.x = pk2(HG_KH(4), HG_KH(5)); w1.y = pk2(HG_KH(6), HG_KH(7)); w1.z = pk2(HG_KH(12), HG_KH(13)); w1.w = pk2(HG_KH(14), HG_KH(15));
          *(LAS v4u*)(L + HG_KH + k * 144 + tg * 32) = w0; *(LAS v4u*)(L + HG_KH + k * 144 + tg * 32 + 16) = w1;
          w0.x = HG_PKV(0, 1); w0.y = HG_PKV(2, 3); w0.z = HG_PKV(8, 9); w0.w = HG_PKV(10, 11);
          w1.x = HG_PKV(4, 5); w1.y = HG_PKV(6, 7); w1.z = HG_PKV(12, 13); w1.w = HG_PKV(14, 15);
          *(LAS v4u*)(L + HG_VT + k * 144 + tg * 32) = w0; *(LAS v4u*)(L + HG_VT + k * 144 + tg * 32 + 16) = w1; }
#undef HG_KH
#undef HG_PKV
        if (ci + 1 < nch) HG_LOAD(ci + 1);
        __syncthreads();
        if (OUT) {
            f32x16 oacc;
#pragma unroll
            for (int r = 0; r < 16; ++r) oacc[r] = 0.f;
            const LAS unsigned char* qrow = L + HG_QT + (32 * jb + r32) * 272 + hh * 16;
            const LAS unsigned char* srow = L + HG_ST + (32 * dvb + r32) * 272 + hh * 16;
            const LAS unsigned char* vrow = L + HG_VT + (32 * dvb + r32) * 144 + hh * 16;
#pragma unroll
            for (int ks = 0; ks < 8; ++ks) oacc = __builtin_amdgcn_mfma_f32_32x32x16_bf16(*(const LAS bf16x8_t*)(qrow + ks * 32), *(const LAS bf16x8_t*)(srow + ks * 32), oacc, 0, 0, 0);
            {
                f32x16 at;
#pragma unroll
                for (int r = 0; r < 16; ++r) at[r] = 0.f;
                const LAS unsigned char* krow = L + HG_KT + r32 * 272 + hh * 16;
#pragma unroll
                for (int ks = 0; ks < 8; ++ks) at = __builtin_amdgcn_mfma_f32_32x32x16_bf16(*(const LAS bf16x8_t*)(krow + ks * 32), *(const LAS bf16x8_t*)(qrow + ks * 32), at, 0, 0, 0);
                if (jb == 0) {
#pragma unroll
                    for (int r = 0; r < 16; ++r) if (crow(r, hh) > r32) at[r] = 0.f; }
                oacc = __builtin_amdgcn_mfma_f32_32x32x16_bf16(pack_frag(at, 0), *(const LAS bf16x8_t*)(vrow + 0), oacc, 0, 0, 0);
                oacc = __builtin_amdgcn_mfma_f32_32x32x16_bf16(pack_frag(at, 8), *(const LAS bf16x8_t*)(vrow + 32), oacc, 0, 0, 0);
            }
            if (jb == 1) {
                f32x16 at;
#pragma unroll
                for (int r = 0; r < 16; ++r) at[r] = 0.f;
                const LAS unsigned char* krow = L + HG_KT + (32 + r32) * 272 + hh * 16;
#pragma unroll
                for (int ks = 0; ks < 8; ++ks) at = __builtin_amdgcn_mfma_f32_32x32x16_bf16(*(const LAS bf16x8_t*)(krow + ks * 32), *(const LAS bf16x8_t*)(qrow + ks * 32), at, 0, 0, 0);
#pragma unroll
                for (int r = 0; r < 16; ++r) if (crow(r, hh) > r32) at[r] = 0.f;
                oacc = __builtin_amdgcn_mfma_f32_32x32x16_bf16(pack_frag(at, 0), *(const LAS bf16x8_t*)(vrow + 64), oacc, 0, 0, 0);
                oacc = __builtin_amdgcn_mfma_f32_32x32x16_bf16(pack_frag(at, 8), *(const LAS bf16x8_t*)(vrow + 96), oacc, 0, 0, 0);
            }
            bf16* O = (bf16*)(ws + WS_O);
#pragma unroll
            for (int r = 0; r < 16; ++r) { const int j = 32 * jb + crow(r, hh), tl = dir ? 63 - j : j;
                bf16* op = O + (rowbase + 64 * cc + tl) * D + h * 128 + 32 * dvb + r32; float ov = oacc[r];
                if (dir) ov += bf2f(*op);
                *op = (bf16)f2bf(ov); }
        }
#pragma unroll
        for (int t = 0; t < 2; ++t) { const int dkb = 2 * (wave >> 2) + t;
#pragma unroll
            for (int q4 = 0; q4 < 4; ++q4) { const f32x4 dd = *(const LAS f32x4*)(L + HG_DEC + (32 * dkb + 8 * q4 + 4 * hh) * 4);
                st[t][4 * q4] *= dd[0]; st[t][4 * q4 + 1] *= dd[1]; st[t][4 * q4 + 2] *= dd[2]; st[t][4 * q4 + 3] *= dd[3]; }
            const LAS unsigned char* arow = L + HG_KH + (32 * dkb + r32) * 144 + hh * 16; const LAS unsigned char* vrow = L + HG_VT + (32 * dvb + r32) * 144 + hh * 16;
#pragma unroll
            for (int ks = 0; ks < 4; ++ks) st[t] = __builtin_amdgcn_mfma_f32_32x32x16_bf16(*(const LAS bf16x8_t*)(arow + ks * 32), *(const LAS bf16x8_t*)(vrow + ks * 32), st[t], 0, 0, 0); }
        __syncthreads();
        if (OUT && ci + 1 < nch) {
#pragma unroll
            for (int t = 0; t < 2; ++t) { const int dkb = 2 * (wave >> 2) + t;
#pragma unroll
                for (int q4 = 0; q4 < 4; ++q4) { v2u w; w.x = pk2(st[t][4 * q4], st[t][4 * q4 + 1]); w.y = pk2(st[t][4 * q4 + 2], st[t][4 * q4 + 3]);
                    *(LAS v2u*)(L + HG_ST + (32 * dvb + r32) * 272 + (32 * dkb + 8 * q4 + 4 * hh) * 2) = w; } }
        }
    }
#undef HG_LOAD
}
__device__ __forceinline__ void ph_hgrn_states(Frame& F) {
    unsigned char* ws = ws_(F);
    for (int item = blockIdx.x; item < 32 * HG_NSC; item += F.G) {
        const int chain = item / HG_NSC, sc = item % HG_NSC, b = chain >> 4, h = (chain >> 1) & 7, dir = chain & 1;
        f32x16 st[2];
#pragma unroll
        for (int t = 0; t < 2; ++t)
#pragma unroll
            for (int r = 0; r < 16; ++r) st[t][r] = 0.f;
        float dsum = 0.f;
        hgrn_pass<false>(F, b, h, dir, sc, st, dsum);
        bf16* sd = (bf16*)(ws + WS_SD) + ((size_t)(chain * HG_NSC + sc) * 8 + F.wave) * 2048 + F.lane;
#pragma unroll
        for (int t = 0; t < 2; ++t)
#pragma unroll
            for (int r = 0; r < 16; ++r) sd[(t * 16 + r) * 64] = (bf16)f2bf(st[t][r]);
        if (F.tid < 128) ((float*)(ws + WS_DECS))[(size_t)(chain * HG_NSC + sc) * 128 + F.tid] = dsum;
    }
}
__device__ __forceinline__ void ph_hgrn_carry(Frame& F) {
    unsigned char* ws = ws_(F);
    const int gt = F.vcu * 512 + F.tid, NT = F.G * 512;
    for (int idx = gt; idx < 32 * 16384; idx += NT) {
        const int chain = idx >> 14, e = idx & 16383, dir = chain & 1;
        const int lane = e & 63, r = (e >> 6) & 15, t = (e >> 10) & 1, wv = e >> 11, dk = 32 * (2 * (wv >> 2) + t) + crow(r, lane >> 5);
        bf16* sd = (bf16*)(ws + WS_SD) + (size_t)chain * HG_NSC * 16384 + e; const float* dl = (const float*)(ws + WS_DECS) + (size_t)chain * HG_NSC * 128 + dk;
        float v[HG_NSC], dd[HG_NSC];
#pragma unroll
        for (int i = 0; i < HG_NSC; ++i) { const int sp = (i == 0) ? 0 : (dir ? 17 - i : i); v[i] = bf2f(sd[(size_t)sp * 16384]); dd[i] = dl[sp * 128]; }
        float S = 0.f;
#pragma unroll
        for (int i = 0; i < HG_NSC; ++i) { const int sp = (i == 0) ? 0 : (dir ? 17 - i : i); sd[(size_t)sp * 16384] = (bf16)f2bf(S); S = __builtin_amdgcn_exp2f(dd[i]) * S + v[i]; }
    }
}
__device__ __forceinline__ void ph_hgrn_out(Frame& F) {
    LAS unsigned char* L = F.lds + RING_OFF;
    unsigned char* ws = ws_(F);
    const int lane = F.lane, r32 = lane & 31, hh = lane >> 5, wave = F.wave, dvb = wave & 3;
    for (int item = blockIdx.x; item < 256; item += F.G) {
        const int b = item >> 7, h = (item >> 4) & 7, Lsc = item & 15, sc = Lsc + 1;
        for (int dir = 0; dir < 2; ++dir) {
            const int chain = (b * 8 + h) * 2 + dir;
            f32x16 st[2];
#pragma unroll
            for (int t = 0; t < 2; ++t)
#pragma unroll
                for (int r = 0; r < 16; ++r) st[t][r] = 0.f;
            { const bf16* sd = (const bf16*)(ws + WS_SD) + ((size_t)(chain * HG_NSC + sc) * 8 + wave) * 2048 + lane;
#pragma unroll
              for (int t = 0; t < 2; ++t)
#pragma unroll
                  for (int r = 0; r < 16; ++r) st[t][r] = bf2f(sd[(t * 16 + r) * 64]); }
            __syncthreads();
#pragma unroll
            for (int t = 0; t < 2; ++t) { const int dkb = 2 * (wave >> 2) + t;
#pragma unroll
                for (int q4 = 0; q4 < 4; ++q4) { v2u w; w.x = pk2(st[t][4 * q4], st[t][4 * q4 + 1]); w.y = pk2(st[t][4 * q4 + 2], st[t][4 * q4 + 3]);
                    *(LAS v2u*)(L + HG_ST + (32 * dvb + r32) * 272 + (32 * dkb + 8 * q4 + 4 * hh) * 2) = w; } }
            float dsum = 0.f;
            hgrn_pass<true>(F, b, h, dir, sc, st, dsum);
            __syncthreads();
        }
        { GAS bf16* O = (GAS bf16*)(ws + WS_O); const GAS bf16* G = (const GAS bf16*)(ws + WS_G);
          const int c0 = h * 128 + 16 * (lane & 7); float ng[16];
#pragma unroll
          for (int j = 0; j < 16; ++j) ng[j] = inp(F, 29)[16 * (lane & 7) + j];
#pragma unroll 2
          for (int it8 = 0; it8 < 8; ++it8) { const size_t m = (size_t)b * SEQ + (size_t)Lsc * 512 + it8 * 64 + wave * 8 + (lane >> 3);
              float o[16], g[16]; unpack8(*(const GAS v4u*)(O + m * D + c0), o); unpack8(*(const GAS v4u*)(O + m * D + c0 + 8), o + 8);
              unpack8(*(const GAS v4u*)(G + m * D + c0), g); unpack8(*(const GAS v4u*)(G + m * D + c0 + 8), g + 8);
              float ss = 0.f;
#pragma unroll
              for (int j = 0; j < 16; ++j) ss += o[j] * o[j];
              ss += __shfl_xor(ss, 1); ss += __shfl_xor(ss, 2); ss += __shfl_xor(ss, 4);
              const float scl = 1.f / sqrtf(ss * (1.f / 128.f) + NORM_EPS);
#pragma unroll
              for (int j = 0; j < 16; ++j) o[j] = o[j] * scl * ng[j] * siluf_(g[j]);
              *(GAS v4u*)(O + m * D + c0) = pack8(o); *(GAS v4u*)(O + m * D + c0 + 8) = pack8(o + 8); }
          __syncthreads(); }
    }
}

struct FInProj {
    bf16* cqkv; bf16* ug;
    __device__ __forceinline__ void operator()(int row, int col, f32x4 v0, f32x4 v1) const {
        v4u w; w.x = pg8::cvt_pk_bf16(v0[0], v0[1]); w.y = pg8::cvt_pk_bf16(v0[2], v0[3]); w.z = pg8::cvt_pk_bf16(v1[0], v1[1]); w.w = pg8::cvt_pk_bf16(v1[2], v1[3]);
        if (col < 672) *(GAS v4u*)(cqkv + (size_t)row * CQKV_LD + col) = w;
        else if (col < EVEN_IN) { const int c = col - 672; *(GAS v4u*)(ug + ((size_t)(c >> 4) * TT + row) * 16 + (c & 15)) = w; }
    }
};
struct FBf16 {
    bf16* o; int ld;
    __device__ __forceinline__ void operator()(int row, int col, f32x4 v0, f32x4 v1) const {
        v4u w; w.x = pg8::cvt_pk_bf16(v0[0], v0[1]); w.y = pg8::cvt_pk_bf16(v0[2], v0[3]); w.z = pg8::cvt_pk_bf16(v1[0], v1[1]); w.w = pg8::cvt_pk_bf16(v1[2], v1[3]);
        *(GAS v4u*)(o + (size_t)row * ld + col) = w;
    }
};
struct EpiGlu {
    static constexpr bool PERM = true, AFTER_DRAIN = false;
    const bf16* z; bf16* mix;
    __device__ __forceinline__ void operator()(const pg8::f32x4 (&acc)[2][2][4][2], const pg8::Unit& u, int wr, int wc, int fr, int fq) const {
        const int row0 = u.pm * 256 + wr * 64 + fr, col0 = u.pn * 256 + wc * 32 + 8 * fq;
#pragma unroll
        for (int ai = 0; ai < 2; ++ai) {
            v4u zz[4][2];
#pragma unroll
            for (int m = 0; m < 4; ++m)
#pragma unroll
                for (int bj = 0; bj < 2; ++bj) zz[m][bj] = *(const GAS v4u*)(z + (size_t)(row0 + ai * 128 + m * 16) * 512 + col0 + bj * 128);
#pragma unroll
            for (int m = 0; m < 4; ++m)
#pragma unroll
                for (int bj = 0; bj < 2; ++bj) { float zf[8], o[8]; unpack8(zz[m][bj], zf);
#pragma unroll
                    for (int j = 0; j < 4; ++j) { o[j] = zf[j] * sigmoidf_(acc[ai][bj][m][0][j]); o[4 + j] = zf[4 + j] * sigmoidf_(acc[ai][bj][m][1][j]); }
                    *(GAS v4u*)(mix + (size_t)(row0 + ai * 128 + m * 16) * D + 512 + col0 + bj * 128) = pack8(o); }
        }
    }
};
struct FQ {
    bf16* qb; const float* rope;
    __device__ __forceinline__ void operator()(int row, int col, f32x4 v0, f32x4 v1) const {
        float x[8] = {v0[0], v0[1], v0[2], v0[3], v1[0], v1[1], v1[2], v1[3]}, p[8];
#pragma unroll
        for (int j = 0; j < 8; ++j) p[j] = __shfl_xor(x[j], 16);
        const bool isctx = row >= TL; const int b = isctx ? ((row - TL) >> 8) : (row >> 13), t = isctx ? ((row - TL) & 255) : (row & 8191), tq = isctx ? SEQ + t : t;
        const int h = col / 96, d = col - h * 96;
        if (d >= 64 && !isctx) { const int idx = d - 64, a = idx >> 4, half = (idx >> 3) & 1, pos = a ? (t & 63) : (t >> 6);
#pragma unroll
            for (int f = 0; f < 8; ++f) { const float cs = rope[2 * (pos * 8 + f)], sn = rope[2 * (pos * 8 + f) + 1]; x[f] = half ? x[f] * cs + p[f] * sn : x[f] * cs - p[f] * sn; } }
#pragma unroll
        for (int j = 0; j < 8; ++j) x[j] *= QSCALE;
        *(GAS v4u*)(qb + ((size_t)(b * 8 + h) * TQK + tq) * 96 + d) = pack8(x);
        asm volatile("" ::: "memory");
    }
};
struct FKV {
    bf16* kb; bf16* vb;
    __device__ __forceinline__ void operator()(int row, int col, f32x4 v0, f32x4 v1) const {
        v4u w; w.x = pg8::cvt_pk_bf16(v0[0], v0[1]); w.y = pg8::cvt_pk_bf16(v0[2], v0[3]); w.z = pg8::cvt_pk_bf16(v1[0], v1[1]); w.w = pg8::cvt_pk_bf16(v1[2], v1[3]);
        const bool isctx = row >= TL; const int b = isctx ? ((row - TL) >> 8) : (row >> 13), t = isctx ? ((row - TL) & 255) : (row & 8191), tk = isctx ? t : CTXL + t;
        const int h = col >> 7, e = col & 127;
        if (e < 64) *(GAS v4u*)(kb + ((size_t)(b * 8 + h) * TQK + tk) * 96 + e) = w;
        else { const int kk = tk & 63, pos = (kk & 48) | (kk & 3) | ((kk & 4) << 1) | ((kk & 8) >> 1);
            bf16* p = vb + (((size_t)(b * 8 + h) * (TQK / 64) + (tk >> 6)) * 64 + (e - 64)) * 64 + pos;
            p[0] = (bf16)(w.x & 0xffffu); p[64] = (bf16)(w.x >> 16); p[128] = (bf16)(w.y & 0xffffu); p[192] = (bf16)(w.y >> 16);
            p[256] = (bf16)(w.z & 0xffffu); p[320] = (bf16)(w.z >> 16); p[384] = (bf16)(w.w & 0xffffu); p[448] = (bf16)(w.w >> 16); }
    }
};
struct EpiResid {
    static constexpr bool PERM = false, AFTER_DRAIN = false;
    float* xl; float* xc; const float* gate; int first; int row_off; float* slab; const float* rl = nullptr;
    __device__ __forceinline__ void operator()(const pg8::f32x4 (&acc)[2][2][4][2], const pg8::Unit& u, int wr, int wc, int fr, int fq) const {
        const int trow = u.pm * 256 + row_off, col0 = u.pn * 256 + wc * 32 + 4 * fq;
        if (slab) {
            GAS float* sb = (GAS float*)slab + (size_t)(trow - TL + wr * 64 + fr) * D + col0; const GAS float* gq = (const GAS float*)gate + (size_t)2 * 6144 + col0;
            f32x4 g2[2][2];
#pragma unroll
            for (int bj = 0; bj < 2; ++bj)
#pragma unroll
                for (int n = 0; n < 2; ++n) g2[bj][n] = *(const GAS f32x4*)(gq + bj * 128 + n * 16);
#pragma unroll
            for (int ai = 0; ai < 2; ++ai)
#pragma unroll
                for (int m = 0; m < 4; ++m)
#pragma unroll
                    for (int bj = 0; bj < 2; ++bj)
#pragma unroll
                        for (int n = 0; n < 2; ++n) *(GAS f32x4*)(sb + (size_t)(ai * 128 + m * 16) * D + bj * 128 + n * 16) = g2[bj][n] * acc[ai][bj][m][n];
            return;
        }
        const bool lat = trow < TL;
        GAS float* xb = (GAS float*)(lat ? xl + (size_t)trow * D : xc + (size_t)(trow - TL) * D) + (size_t)(wr * 64 + fr) * D + col0;
        const GAS float* rb = (lat && rl) ? (const GAS float*)rl + (size_t)trow * D + (size_t)(wr * 64 + fr) * D + col0 : (const GAS float*)xb;
        const GAS float* gp = (const GAS float*)gate + (size_t)modrow_of(trow) * 6144 + col0;
        f32x4 gv[2][2];
#pragma unroll
        for (int bj = 0; bj < 2; ++bj)
#pragma unroll
            for (int n = 0; n < 2; ++n) gv[bj][n] = *(const GAS f32x4*)(gp + bj * 128 + n * 16);
        const float a0 = (first && lat) ? DN_ALPHA : 1.0f;
#pragma unroll
        for (int ai = 0; ai < 2; ++ai) {
            f32x4 xo[4][2][2];
#pragma unroll
            for (int m = 0; m < 4; ++m)
#pragma unroll
                for (int bj = 0; bj < 2; ++bj)
#pragma unroll
                    for (int n = 0; n < 2; ++n) xo[m][bj][n] = *(const GAS f32x4*)(rb + (size_t)(ai * 128 + m * 16) * D + bj * 128 + n * 16);
#pragma unroll
            for (int m = 0; m < 4; ++m)
#pragma unroll
                for (int bj = 0; bj < 2; ++bj)
#pragma unroll
                    for (int n = 0; n < 2; ++n) *(GAS f32x4*)(xb + (size_t)(ai * 128 + m * 16) * D + bj * 128 + n * 16) = xo[m][bj][n] * a0 + gv[bj][n] * acc[ai][bj][m][n];
            __builtin_amdgcn_sched_barrier(0);
        }
    }
};
struct FHgIn {
    bf16* qffi; bf16* g;
    __device__ __forceinline__ void operator()(int row, int col, f32x4 v0, f32x4 v1) const {
        v4u w; w.x = pg8::cvt_pk_bf16(v0[0], v0[1]); w.y = pg8::cvt_pk_bf16(v0[2], v0[3]); w.z = pg8::cvt_pk_bf16(v1[0], v1[1]); w.w = pg8::cvt_pk_bf16(v1[2], v1[3]);
        if (col < 4096) *(GAS v4u*)(qffi + (size_t)row * 4096 + col) = w; else *(GAS v4u*)(g + (size_t)row * D + (col - 4096)) = w;
    }
};
struct EpiConvGate {
    static constexpr bool PERM = true, AFTER_DRAIN = false;
    bf16* hg; bf16* ab; bf16* gb; const bf16* cwt;
    __device__ __forceinline__ void operator()(const pg8::f32x4 (&acc)[2][2][4][2], const pg8::Unit& u, int wr, int wc, int fr, int fq) const {
        const int hc0 = 128 * u.pn + 32 * wc + 8 * fq;
        v4u wq[4];
#pragma unroll
        for (int i = 0; i < 4; ++i) wq[i] = *(const GAS v4u*)(cwt + (size_t)(hc0 + 2 * i) * 4);
#pragma unroll
        for (int ai = 0; ai < 2; ++ai) {
            const int rowbase = u.pm * 256 + 128 * ai + 64 * wr, g64 = rowbase >> 6;
#pragma unroll
            for (int n = 0; n < 2; ++n) {
                const int hc = hc0 + 4 * n;
                float out[4][4];
#pragma unroll
                for (int e = 0; e < 4; ++e) { const int c = 4 * n + e; const unsigned pw0 = (c & 1) ? wq[c >> 1].z : wq[c >> 1].x, pw1 = (c & 1) ? wq[c >> 1].w : wq[c >> 1].y;
                    const float w0 = bflo(pw0), w1 = bfhi(pw0), w2 = bflo(pw1), b0 = bfhi(pw1);
                    float a[4], up[4], dn[4];
#pragma unroll
                    for (int m = 0; m < 4; ++m) { a[m] = acc[ai][0][m][n][e];
                        up[m] = __builtin_bit_cast(float, __builtin_amdgcn_mov_dpp(__builtin_bit_cast(int, a[m]), 0x121, 0xf, 0xf, false));
                        dn[m] = __builtin_bit_cast(float, __builtin_amdgcn_mov_dpp(__builtin_bit_cast(int, a[m]), 0x12f, 0xf, 0xf, false)); }
#pragma unroll
                    for (int m = 0; m < 4; ++m) { const float prev = fr > 0 ? up[m] : (m > 0 ? up[m > 0 ? m - 1 : 0] : 0.f), next = fr < 15 ? dn[m] : (m < 3 ? dn[m < 3 ? m + 1 : 3] : 0.f);
                        const float cv = b0 + w0 * prev + w1 * a[m] + w2 * next; out[m][e] = siluf_(cv) * acc[ai][1][m][n][e]; } }
#pragma unroll
                for (int m = 0; m < 4; ++m) { const int r64 = 16 * m + fr, row = rowbase + r64;
                    if (r64 != 0 && r64 != 63) { v2u w; w.x = pk2(out[m][0], out[m][1]); w.y = pk2(out[m][2], out[m][3]); *(GAS v2u*)(hg + (size_t)row * FFH + hc) = w; }
                    if (r64 <= 1 || r64 >= 62) { const int slot = r64 <= 1 ? r64 : r64 - 60; const f32x4 ra = acc[ai][0][m][n];
                        v2u w; w.x = pk2(ra[0], ra[1]); w.y = pk2(ra[2], ra[3]); *(GAS v2u*)(ab + (size_t)(g64 * 4 + slot) * FFH + hc) = w;
                        if (r64 == 0 || r64 == 63) { const f32x4 rg = acc[ai][1][m][n]; v2u wg; wg.x = pk2(rg[0], rg[1]); wg.y = pk2(rg[2], rg[3]); *(GAS v2u*)(gb + (size_t)(g64 * 2 + (r64 == 63 ? 1 : 0)) * FFH + hc) = wg; } }
                }
                __builtin_amdgcn_sched_barrier(0);
            }
        }
    }
};
template <class E> __device__ __forceinline__ void run_gemm_off(Frame& F, const bf16* A, int lda, const bf16* Bt, int ldb, int M, int N, int K, const E& e, int boff) {
    pg8::Gemm g{A, Bt, M, N, K, lda, ldb}; pg8::StaticOrder S; S.init(M, N, F.G, (int)((blockIdx.x + F.G - boff) % F.G));
    pg8::gemm_phase<E, pg8::StaticOrder, true, true>(F.lds + RING_OFF, g, S, e);
}
template <class E> __device__ __forceinline__ void run_gemm(Frame& F, const bf16* A, int lda, const bf16* Bt, int ldb, int M, int N, int K, const E& e) {
    pg8::Gemm g{A, Bt, M, N, K, lda, ldb}; pg8::StaticOrder S; S.init(M, N, F.G, (int)blockIdx.x);
    pg8::gemm_phase<E, pg8::StaticOrder, true, true>(F.lds + RING_OFF, g, S, e);
}

constexpr int NPH = 23;
struct Args { const float* in[31]; float* out; unsigned char* ws; int ph_lo, ph_hi; };
__global__ void __launch_bounds__(NWAVES * 64, 2) mk_fwd(Args args) {
    extern __shared__ __attribute__((aligned(16))) unsigned char lds[];
    Frame F;
    F.lds = (LAS unsigned char*)lds;
    F.tid = threadIdx.x; F.lane = F.tid & 63; F.wave = __builtin_amdgcn_readfirstlane(F.tid >> 6);
    F.G = gridDim.x; { const int bx = blockIdx.x; F.vcu = (F.G % 8 == 0) ? (bx % 8) * (F.G / 8) + bx / 8 : bx; }
    for (int u = F.tid; u < (LDS_BYTES - LDSCTL_OFF) / 4; u += NWAVES * 64) ((LAS unsigned*)(F.lds + LDSCTL_OFF))[u] = 0u;
    __syncthreads();
    if (F.tid == 0) {
#pragma unroll
        for (int i = 0; i < 31; ++i) ((LAS unsigned long long*)(F.lds + PTR_OFF))[i] = (unsigned long long)args.in[i];
        ((LAS unsigned long long*)(F.lds + PTR_OFF))[31] = (unsigned long long)args.ws; ((LAS unsigned long long*)(F.lds + PTR_OFF))[32] = (unsigned long long)args.out;
    }
    __syncthreads();
    const int lo = args.ph_lo, hi = args.ph_hi;
    const bool multi = (hi - lo) > 1;
    if (multi) (void)xcd_barrier_post((unsigned*)ws_(F) + CW_BAR, (volatile LAS unsigned*)(F.lds + MISC_OFF) + 8);
#ifndef ONLY_PHASE
#define ONLY_PHASE -1
#endif
#define WSP ws_(F)
#define MODP ((const float*)(ws_(F) + WS_MOD))
#define ABUF ((bf16*)(ws_(F) + WS_A))
#ifndef SKIP_PHASE
#define SKIP_PHASE -1
#endif
#define IN(k) ((ONLY_PHASE < 0 || ONLY_PHASE == (k)) && SKIP_PHASE != (k) && lo <= (k) && (k) < hi)
#define SEAM(k) do { if (IN(k) && IN((k) + 1)) { XcdBarrier bar_; bar_.bar = (unsigned*)ws_(F) + CW_BAR; bar_.x = xb_xcc_id(); bar_.st = (volatile LAS unsigned*)(F.lds + MISC_OFF) + 8; xcd_barrier(bar_); } asm volatile("" : "+v"(F.tid), "+v"(F.lane)); } while (0)
    int pk = 0;
#ifndef REPEAT_PHASE
#define REPEAT_PHASE -1
#endif
#define PHASE(...) do { if (IN(pk)) { __VA_ARGS__ } if (REPEAT_PHASE == pk && IN(pk)) { { XcdBarrier bar_; bar_.bar = (unsigned*)ws_(F) + CW_BAR; bar_.x = xb_xcc_id(); bar_.st = (volatile LAS unsigned*)(F.lds + MISC_OFF) + 8; xcd_barrier(bar_); } asm volatile("" : "+v"(F.tid), "+v"(F.lane)); { __VA_ARGS__ } } SEAM(pk); ++pk; } while (0)
    PHASE( p0_prologue(F); for (int rep_ = 0; rep_ < DUP_S5T; ++rep_) p0_s5_tables(F); );
    PHASE( ph_init_rows(F); );
    PHASE( pg8::Epi8<FInProj> e{{(bf16*)(WSP + WS_CQKV), (bf16*)(WSP + WS_UG)}}; run_gemm(F, ABUF, D, (const bf16*)(WSP + WS_WIN0), D, TT, EVEN_IN_PAD, D, e); );
    PHASE( ph_s5_finals(F); ph_mla_norm(F); );
    PHASE(
        ph_s5_carry(F);
#ifndef DUPQ
#define DUPQ 1
#endif
#ifndef DUPKV
#define DUPKV 1
#endif
        _Pragma("unroll") for (int rep = 0; rep < DUPQ; ++rep) { pg8::Epi8<FQ> e{{(bf16*)(WSP + WS_QB), (const float*)(WSP + WS_ROPE)}}; run_gemm(F, (const bf16*)(WSP + WS_CQKV), CQKV_LD, (const bf16*)(WSP + WS_WUQ), 384, TT, 768, 384, e); }
        _Pragma("unroll") for (int rep = 0; rep < DUPKV; ++rep) { pg8::Epi8<FKV> e{{(bf16*)(WSP + WS_KB), (bf16*)(WSP + WS_VB)}}; run_gemm(F, (const bf16*)(WSP + WS_CQKV) + 384, CQKV_LD, (const bf16*)(WSP + WS_WUKV), 256, TT, 1024, 256, e); }
    );
    PHASE( ph_s5_out(F); ph_attn(F); );
    PHASE( EpiGlu e{(const bf16*)(WSP + WS_Z), (bf16*)(WSP + WS_MIX)}; run_gemm(F, (const bf16*)(WSP + WS_Z), 512, (const bf16*)(WSP + WS_WGLU), 512, TT, 512, 512, e); );
    PHASE(
        { EpiResid e{out_(F), (float*)(WSP + WS_XC), MODP + 0 * 3 * 6144 + 2 * 1024, 1, 0, nullptr, inp(F, 0)}; run_gemm(F, (const bf16*)(WSP + WS_MIX), D, (const bf16*)(WSP + WS_WOUT0), D, TL, D, D, e); }
        _Pragma("unroll") for (int sp = 0; sp < 4; ++sp) { EpiResid e{out_(F), (float*)(WSP + WS_XC), MODP + 0 * 3 * 6144 + 2 * 1024, 1, TL, (float*)(WSP + WS_SLAB1) + (size_t)sp * TC * D};
            run_gemm_off(F, (const bf16*)(WSP + WS_MIX) + (size_t)TL * D + 256 * sp, D, (const bf16*)(WSP + WS_WOUT0) + 256 * sp, D, TC, D, 256, e, 8 * sp); }
    );
    PHASE( ph_layernorm(F, TT, 0, 0, 0, 3, (const float*)(WSP + WS_SLAB1), 4); );
    PHASE( EpiConvGate e{(bf16*)(WSP + WS_HG), (bf16*)(WSP + WS_AB), (bf16*)(WSP + WS_GB), (const bf16*)(WSP + WS_CWT)}; run_gemm(F, ABUF, D, (const bf16*)(WSP + WS_F1T0), D, TT, 2 * FFH, D, e); );
    PHASE( ph_convfix(F, TT, 0); );
    PHASE(
        { EpiResid e{out_(F), (float*)(WSP + WS_XC), MODP + 0 * 3 * 6144 + 5 * 1024, 1, 0, nullptr}; run_gemm(F, (const bf16*)(WSP + WS_HG), FFH, (const bf16*)(WSP + WS_F2T0), FFH, TL, D, FFH, e); }
        _Pragma("unroll") for (int sp = 0; sp < 6; ++sp) { EpiResid e{out_(F), (float*)(WSP + WS_XC), MODP + 0 * 3 * 6144 + 5 * 1024, 1, TL, (float*)(WSP + WS_SLAB2) + (size_t)sp * TC * D};
            run_gemm_off(F, (const bf16*)(WSP + WS_HG) + (size_t)TL * FFH + 512 * sp, FFH, (const bf16*)(WSP + WS_F2T0) + 512 * sp, FFH, TC, D, sp == 5 ? 256 : 512, e, 8 * sp); }
    );
    PHASE( ph_layernorm(F, TT, 0, 1, 1, 0, (const float*)(WSP + WS_SLAB2), 6); );
    PHASE( pg8::Epi8<FHgIn> e{{(bf16*)(WSP + WS_QFFI), (bf16*)(WSP + WS_G)}}; run_gemm(F, ABUF, D, (const bf16*)(WSP + WS_HGINT), D, TT, 5120, D, e); );
    PHASE( ph_hgrn_states(F); );
    PHASE( ph_hgrn_carry(F); );
    PHASE( ph_hgrn_out(F); );
    PHASE( EpiResid e{out_(F), (float*)(WSP + WS_XC), MODP + 1 * 3 * 6144 + 2 * 1024, 1, 0, nullptr}; run_gemm(F, (const bf16*)(WSP + WS_O), D, (const bf16*)(WSP + WS_HGOUTT), D, TL, D, D, e); );
    PHASE( ph_layernorm(F, TL, 1, 0, 1, 3); );
    PHASE( EpiConvGate e{(bf16*)(WSP + WS_HG), (bf16*)(WSP + WS_AB), (bf16*)(WSP + WS_GB), (const bf16*)(WSP + WS_CWT) + (size_t)FFH * 4}; run_gemm(F, ABUF, D, (const bf16*)(WSP + WS_F1T1), D, TL, 2 * FFH, D, e); );
    PHASE( ph_convfix(F, TL, 1); );
    PHASE( EpiResid e{out_(F), (float*)(WSP + WS_XC), MODP + 1 * 3 * 6144 + 5 * 1024, 1, 0, nullptr}; run_gemm(F, (const bf16*)(WSP + WS_HG), FFH, (const bf16*)(WSP + WS_F2T1), FFH, TL, D, FFH, e); );
    PHASE( ph_layernorm(F, TL, 1, 1, -1, 0); );
#undef PHASE
#undef IN
#undef SEAM
}

extern "C" void kernel_launch(void* const* d_in, const int* in_sizes, int n_in, void* d_out, int out_size, void* d_ws, size_t ws_size, hipStream_t stream) {
    static int grid = 0;
    if (grid == 0) {
        if (n_in != 31 || out_size != TL * D || ws_size < WS_END) { fprintf(stderr, "kernel_launch: unexpected shapes n_in %d out %d ws %zu\n", n_in, out_size, ws_size); grid = -1; return; }
        int dev = 0, cus = 0;
        if (hipGetDevice(&dev) != hipSuccess || hipDeviceGetAttribute(&cus, hipDeviceAttributeMultiprocessorCount, dev) != hipSuccess) { grid = -1; return; }
        if (hipFuncSetAttribute((const void*)mk_fwd, hipFuncAttributeMaxDynamicSharedMemorySize, LDS_BYTES) != hipSuccess) { fprintf(stderr, "kernel_launch: hipFuncSetAttribute failed\n"); grid = -1; return; }
        int per_cu = 0;
        if (hipOccupancyMaxActiveBlocksPerMultiprocessor(&per_cu, (const void*)mk_fwd, NWAVES * 64, LDS_BYTES) != hipSuccess || per_cu < 1) fprintf(stderr, "kernel_launch: occupancy query says %d\n", per_cu);
        (void)hipGetLastError();
        grid = cus;
    }
    if (grid < 0) return;
    if (hipMemsetAsync((char*)d_ws + WS_CTL, 0, CTL_ZERO_BYTES, stream) != hipSuccess) return;
    Args a{};
    for (int i = 0; i < 31; ++i) a.in[i] = (const float*)d_in[i];
    a.out = (float*)d_out; a.ws = (unsigned char*)d_ws;
#ifndef MK_ONE_LAUNCH
#define MK_ONE_LAUNCH 1
#endif
    if (MK_ONE_LAUNCH) { a.ph_lo = 0; a.ph_hi = NPH; hipLaunchKernelGGL(mk_fwd, dim3(grid), dim3(NWAVES * 64), LDS_BYTES, stream, a); }
    else for (int p = 0; p < NPH; ++p) { a.ph_lo = p; a.ph_hi = p + 1; hipLaunchKernelGGL(mk_fwd, dim3(grid), dim3(NWAVES * 64), LDS_BYTES, stream, a); }
}
```
